# Optimizing an MI355X kernel written in HIP

```python
import math
import numpy as np
import jax
import jax.numpy as jnp
from jax import lax

D_MODEL = 1024
BATCH = 2
SEQ = 16384
DEPTH = 2
DEC_BATCH = 4
DEC_SEQ = 4096
PAST_LEN = 128

GLA_HEADS = 4
GLA_DK = 128
GLA_DV = 128
GLA_KW = GLA_HEADS * GLA_DK
GLA_WIDTH = GLA_HEADS * GLA_DV
GLA_RANK = 16
GLA_TAU = 16.0
GLA_CHUNK = 64
SWA_HEADS = 8
SWA_KV_HEADS = 2
SWA_GROUP = SWA_HEADS // SWA_KV_HEADS
SWA_HD = 64
SWA_WIDTH = SWA_HEADS * SWA_HD
SWA_KVW = SWA_KV_HEADS * SWA_HD
WINDOW = 128
BLOCK = 128
REL_BUCKETS = 32
REL_MAX_DIST = 128
CONV_WIDTH = D_MODEL
CONV_K = 3
DN_ALPHA = (2 * DEPTH) ** 0.25
DN_BETA = (8 * DEPTH) ** -0.25
LN_EPS = 1e-5
NORM_EPS = 1e-6
N_EVEN = (DEPTH + 1) // 2
N_ODD = DEPTH // 2
EVEN_SPLITS = (GLA_KW, GLA_KW, GLA_WIDTH, GLA_WIDTH, 2 * GLA_RANK, SWA_WIDTH, SWA_KVW, SWA_KVW, SWA_WIDTH)
EVEN_IN = sum(EVEN_SPLITS)
EVEN_MIX = GLA_WIDTH + SWA_WIDTH
ODD_IN = 4 * CONV_WIDTH

kernel_name = "hybrid_gla_swa_shortconv_encoder"


def _offsets(splits):
    out, acc = [], 0
    for s in splits[:-1]:
        acc += s
        out.append(acc)
    return out


def layer_norm(x, g, b):
    xf = x.astype(jnp.float32)
    mu = jnp.mean(xf, -1, keepdims=True)
    var = jnp.mean(jnp.square(xf - mu), -1, keepdims=True)
    y = (xf - mu) * lax.rsqrt(var + LN_EPS) * g.astype(jnp.float32) + b.astype(jnp.float32)
    return y.astype(x.dtype)


def _gla_scan(q, k, v, logd, strict):
    Bn, H, L, dk = q.shape
    dv = v.shape[-1]
    n = L // GLA_CHUNK

    def chunks(t):
        return t.reshape(Bn, H, n, GLA_CHUNK, t.shape[-1]).transpose(2, 0, 1, 3, 4)

    qc, kc, vc, gc = chunks(q), chunks(k), chunks(v), chunks(logd)
    idx = jnp.arange(GLA_CHUNK)
    mask = (idx[None, :] < idx[:, None]) if strict else (idx[None, :] <= idx[:, None])

    def step(S, inp):
        qi, ki, vi, gi = inp
        b = jnp.cumsum(gi, axis=2)
        inter = jnp.einsum('bhcd,bhde->bhce', qi * jnp.exp(b), S)
        diff = b[:, :, :, None, :] - b[:, :, None, :, :]
        decay = jnp.exp(jnp.where(mask[:, :, None], diff, -jnp.inf))
        scores = jnp.sum(qi[:, :, :, None, :] * ki[:, :, None, :, :] * decay, axis=-1)
        intra = jnp.einsum('bhij,bhje->bhie', scores, vi)
        b_last = b[:, :, -1:, :]
        S_new = jnp.exp(b_last[:, :, 0, :])[..., None] * S + jnp.einsum(
            'bhcd,bhce->bhde', ki * jnp.exp(b_last - b), vi)
        return S_new, inter + intra

    S0 = jnp.zeros((Bn, H, dk, dv), jnp.float32)
    _, out = lax.scan(step, S0, (qc, kc, vc, gc))
    return out.transpose(1, 2, 0, 3, 4).reshape(Bn, H, L, dv)


def gla_mixer(q, k, v, z, gdown, w_up_f, b_f, w_up_b, b_b, norm_g):
    Bn, L, _ = q.shape
    f32 = jnp.float32

    def heads(t, d):
        return t.astype(f32).reshape(Bn, L, GLA_HEADS, d).transpose(0, 2, 1, 3)

    qh = heads(q, GLA_DK) * (GLA_DK ** -0.5)
    kh = heads(k, GLA_DK)
    vh = heads(v, GLA_DV)
    gd_f, gd_b = gdown[..., :GLA_RANK], gdown[..., GLA_RANK:]
    logd_f = heads(jax.nn.log_sigmoid((gd_f @ w_up_f + b_f).astype(f32)) / GLA_TAU, GLA_DK)
    logd_b = heads(jax.nn.log_sigmoid((gd_b @ w_up_b + b_b).astype(f32)) / GLA_TAU, GLA_DK)
    o_f = _gla_scan(qh, kh, vh, logd_f, strict=False)
    flip = lambda t: t[:, :, ::-1]
    o_b = flip(_gla_scan(flip(qh), flip(kh), flip(vh), flip(logd_b), strict=True))
    o = o_f + o_b
    o = o * lax.rsqrt(jnp.mean(jnp.square(o), -1, keepdims=True) + NORM_EPS) * norm_g.astype(f32)
    o = o.transpose(0, 2, 1, 3).reshape(Bn, L, GLA_WIDTH).astype(v.dtype)
    return o * jax.nn.silu(z)


def _rel_buckets():
    i = np.arange(BLOCK)[:, None]
    j = np.arange(3 * BLOCK)[None, :]
    rel = j - BLOCK - i
    half = REL_BUCKETS // 2
    max_exact = half // 2
    n = np.abs(rel)
    large = max_exact + (np.log(np.maximum(n, 1) / max_exact) / np.log(REL_MAX_DIST / max_exact)
                         * (half - max_exact)).astype(np.int32)
    large = np.minimum(large, half - 1)
    bucket = (rel > 0).astype(np.int32) * half + np.where(n < max_exact, n, large)
    return bucket.astype(np.int32), rel


def swa_mixer(q, k, v, z, rel_bias, sink):
    Bn, L, _ = q.shape
    nb = L // BLOCK
    qh = q.reshape(Bn, nb, BLOCK, SWA_KV_HEADS, SWA_GROUP, SWA_HD) * (SWA_HD ** -0.5)

    def banded(t):
        tp = jnp.pad(t.reshape(Bn, L, SWA_KV_HEADS, SWA_HD), ((0, 0), (BLOCK, BLOCK), (0, 0), (0, 0)))
        tp = tp.reshape(Bn, nb + 2, BLOCK, SWA_KV_HEADS, SWA_HD)
        return jnp.concatenate([tp[:, :-2], tp[:, 1:-1], tp[:, 2:]], axis=2)

    kb, vb = banded(k), banded(v)
    bucket, rel = _rel_buckets()
    key_pos = np.arange(nb)[:, None] * BLOCK - BLOCK + np.arange(3 * BLOCK)[None, :]
    valid = (key_pos >= 0) & (key_pos < L)
    mask = jnp.asarray((np.abs(rel) <= WINDOW)[None] & valid[:, None, :])[:, None, None]
    bias = rel_bias.astype(jnp.float32)[bucket]
    bias = bias.transpose(2, 0, 1).reshape(SWA_KV_HEADS, SWA_GROUP, BLOCK, 3 * BLOCK)

    s = jnp.einsum('bnqkgd,bnskd->bnkgqs', qh, kb).astype(jnp.float32) + bias
    s = jnp.where(mask, s, -jnp.inf)
    sk = sink.astype(jnp.float32).reshape(SWA_KV_HEADS, SWA_GROUP)[:, :, None, None]
    m = jnp.maximum(jnp.max(s, -1, keepdims=True), sk)
    e = jnp.exp(s - m)
    p = e / (jnp.sum(e, -1, keepdims=True) + jnp.exp(sk - m))
    o = jnp.einsum('bnkgqs,bnskd->bnqkgd', p.astype(v.dtype), vb).reshape(Bn, L, SWA_WIDTH)
    return o * jax.nn.silu(z)


def even_sublayer(x, w_in, w_up_f, b_f, w_up_b, b_b, norm_g, sink, rel_bias, w_out):
    u = x @ w_in
    qa, ka, va, za, gd, qb, kb, vb, zb = jnp.split(u, _offsets(EVEN_SPLITS), axis=-1)
    ya = gla_mixer(qa, ka, va, za, gd, w_up_f, b_f, w_up_b, b_b, norm_g)
    yb = swa_mixer(qb, kb, vb, zb, rel_bias, sink)
    return jnp.concatenate([ya, yb], axis=-1) @ w_out


def odd_sublayer(x, w_in, conv_w, w_out):
    u = x @ w_in
    bg, cg, h, z = jnp.split(u, 4, axis=-1)
    t = jnp.pad(cg * h, ((0, 0), (1, 1), (0, 0)))
    conv = conv_w[0] * t[:, :-2] + conv_w[1] * t[:, 1:-1] + conv_w[2] * t[:, 2:]
    return (jax.nn.silu(z) * bg * conv) @ w_out


def trunk(x, w_in_even, gla_w_up_fwd, gla_b_fwd, gla_w_up_bwd, gla_b_bwd, gla_norm_g, swa_sink,
          rel_bias, w_out_even, w_in_odd, conv_w, w_out_odd, ln_g, ln_b):
    for l in range(DEPTH):
        i = l // 2
        if l % 2 == 0:
            sub = even_sublayer(x, w_in_even[i], gla_w_up_fwd[i], gla_b_fwd[i], gla_w_up_bwd[i], gla_b_bwd[i],
                                gla_norm_g[i], swa_sink[i], rel_bias, w_out_even[i])
        else:
            sub = odd_sublayer(x, w_in_odd[i], conv_w[i], w_out_odd[i])
        x = layer_norm(DN_ALPHA * x + sub, ln_g[l], ln_b[l])
    return x


def setup_inputs(seed: int = 0) -> dict:
    key = jax.random.key(seed)
    ks = jax.random.split(key, 20)
    nrm = lambda k, shape, s: jax.random.normal(k, shape, jnp.float32) * s
    return {
        "x_prompt": nrm(ks[0], (BATCH, SEQ, D_MODEL), 1.0),
        "x_sample": nrm(ks[1], (DEC_BATCH, DEC_SEQ, D_MODEL), 1.0),
        "w_in_even": nrm(ks[2], (N_EVEN, D_MODEL, EVEN_IN), D_MODEL ** -0.5),
        "gla_w_up_fwd": nrm(ks[3], (N_EVEN, GLA_RANK, GLA_KW), GLA_RANK ** -0.5),
        "gla_b_fwd": nrm(ks[4], (N_EVEN, GLA_KW), 0.01),
        "gla_w_up_bwd": nrm(ks[5], (N_EVEN, GLA_RANK, GLA_KW), GLA_RANK ** -0.5),
        "gla_b_bwd": nrm(ks[6], (N_EVEN, GLA_KW), 0.01),
        "gla_norm_g": 1.0 + nrm(ks[7], (N_EVEN, GLA_DV), 0.01),
        "swa_sink": nrm(ks[8], (N_EVEN, SWA_HEADS), 0.5),
        "rel_bias": nrm(ks[9], (REL_BUCKETS, SWA_HEADS), 0.5),
        "w_out_even": nrm(ks[10], (N_EVEN, EVEN_MIX, D_MODEL), EVEN_MIX ** -0.5 * DN_BETA),
        "w_in_odd": nrm(ks[11], (N_ODD, D_MODEL, ODD_IN), D_MODEL ** -0.5),
        "conv_w": nrm(ks[12], (N_ODD, CONV_K, CONV_WIDTH), CONV_K ** -0.5),
        "w_out_odd": nrm(ks[13], (N_ODD, CONV_WIDTH, D_MODEL), CONV_WIDTH ** -0.5 * DN_BETA),
        "ln_g": 1.0 + nrm(ks[14], (DEPTH, D_MODEL), 0.01),
        "ln_b": nrm(ks[15], (DEPTH, D_MODEL), 0.01),
    }


def reference(x_prompt, x_sample, w_in_even, gla_w_up_fwd, gla_b_fwd, gla_w_up_bwd, gla_b_bwd, gla_norm_g,
              swa_sink, rel_bias, w_out_even, w_in_odd, conv_w, w_out_odd, ln_g, ln_b):
    y_prompt = trunk(x_prompt, w_in_even, gla_w_up_fwd, gla_b_fwd, gla_w_up_bwd, gla_b_bwd, gla_norm_g,
                     swa_sink, rel_bias, w_out_even, w_in_odd, conv_w, w_out_odd, ln_g, ln_b)
    y_sample = trunk(x_sample, w_in_even, gla_w_up_fwd, gla_b_fwd, gla_w_up_bwd, gla_b_bwd, gla_norm_g,
                     swa_sink, rel_bias, w_out_even, w_in_odd, conv_w, w_out_odd, ln_g, ln_b)
    return (y_prompt, y_sample)
```

```cpp
#include <hip/hip_runtime.h>
#include <cstdio>

typedef unsigned short bf16_t;
typedef short bf16x8 __attribute__((ext_vector_type(8)));
typedef float f32x4 __attribute__((ext_vector_type(4)));
typedef float f32x2 __attribute__((ext_vector_type(2)));
typedef unsigned u32x4 __attribute__((ext_vector_type(4)));
typedef unsigned u32x2 __attribute__((ext_vector_type(2)));
#define LAS __attribute__((address_space(3)))

constexpr int DM = 1024, NTOK = 49152, NPROMPT = 32768, LP = 16384, LS = 4096;
constexpr int UP = 3584;
constexpr int C_QA = 0, C_KA = 512, C_VA = 1024, C_ZA = 1536, C_QB = 2048, C_KB = 2560, C_VB = 2688, C_ZB = 2816, C_GD = 3328;
constexpr int EVEN_IN = 3360, ODD_IN = 4096;
constexpr float DN_ALPHA = 1.41421356237309515f;
constexpr float LN_EPS = 1e-5f, NORM_EPS = 1e-6f;

constexpr size_t MiB = 1u << 20;
constexpr size_t WS_CTL = 0, WS_W1T = 1 * MiB, WS_W2T = 8 * MiB, WS_W3T = 10 * MiB, WS_W4T = 18 * MiB, WS_STAT1 = 20 * MiB, WS_MR1 = 26 * MiB,
                 WS_XB = 27 * MiB  , WS_U = 123 * MiB, WS_ST = 459 * MiB, WS_END = 507 * MiB;
constexpr size_t WS_X1B = WS_U, WS_P = WS_U + 96 * MiB, WS_S = WS_U + 192 * MiB, WS_STAT2 = WS_U + 288 * MiB;

__device__ __forceinline__ float bf2f(bf16_t b) { return __uint_as_float(((unsigned)b) << 16); }
__device__ __forceinline__ bf16_t f2bf(float f) { unsigned u = __float_as_uint(f); u += 0x7fffu + ((u >> 16) & 1u); return (bf16_t)(u >> 16); }
__device__ __forceinline__ unsigned pk2(float lo, float hi) { return (unsigned)f2bf(lo) | ((unsigned)f2bf(hi) << 16); }
__device__ __forceinline__ float silu(float x) { return x / (1.0f + __expf(-x)); }
__device__ __forceinline__ float wave_sum(float v) {
#pragma unroll
    for (int o = 1; o < 64; o <<= 1) v += __shfl_xor(v, o);
    return v;
}
__device__ __forceinline__ float wave_max(float v) {
#pragma unroll
    for (int o = 1; o < 64; o <<= 1) v = fmaxf(v, __shfl_xor(v, o));
    return v;
}
__device__ __forceinline__ void seq_of(int row, int& s0, int& L) {
    if (row < NPROMPT) { L = LP; s0 = row & ~(LP - 1); } else { L = LS; s0 = NPROMPT + ((row - NPROMPT) & ~(LS - 1)); }
}

namespace pg8 {
constexpr int BM = 256, BK = 64, HALF = 128, HTB = HALF * BK * 2, STAGE_BYTES = 8 * HTB, NXCD = 8, WGM = 8;
__host__ __device__ __forceinline__ int lds_byte(int r, int c) { const int st = (r >> 4) * 2 + (c >> 5), rr = r & 15, cc = c & 31, ob = rr * 64 + cc * 2; return st * 1024 + (ob ^ (((ob >> 9) & 1) << 5)); }
__host__ __device__ __forceinline__ void stage_rc(int b, int& R, int& C) { const int st = b / 1024, sb = b % 1024, swz = sb ^ (((sb >> 9) & 1) << 5); R = (st >> 1) * 16 + swz / 64; C = (st & 1) * 32 + (swz % 64) / 2; }
__host__ __device__ __forceinline__ int perm32(int rho) { const int n = rho >> 4, i = rho & 15; return 8 * (i >> 2) + 4 * n + (i & 3); }
struct Unit { int pm, pn; };
struct Gemm { const bf16_t* A; const bf16_t* Bt; int M, N, K, pad; };
struct StaticOrder {
    int nM, nN, nwg, G, c;
    __host__ __device__ void init(int M, int N, int G_, int c_) { nM = M / BM; nN = N / BM; nwg = nM * nN; G = G_; c = c_; }
    __host__ __device__ bool next(int i, Unit& u) const {
        const long L = (long)i * G + c; if (L >= nwg) return false;
        int wgid = (int)L; { const int q = nwg / NXCD, r = nwg % NXCD, xcd = wgid % NXCD, off = wgid / NXCD; wgid = (xcd < r ? xcd * (q + 1) : r * (q + 1) + (xcd - r) * q) + off; }
        const int nig = WGM * nN, gid = wgid / nig, fm = gid * WGM, gsz = (nM - fm) < WGM ? (nM - fm) : WGM;
        u.pm = fm + ((wgid % nig) % gsz); u.pn = (wgid % nig) / gsz; return true;
    }
    __device__ __forceinline__ void a_ready(const Unit&) const {}
    __device__ __forceinline__ void done(const Unit&) const {}
};

template <class Epi, class Sched>
__device__ __forceinline__ void gemm_phase(LAS unsigned char* lds, const Gemm g, const Sched& S, const Epi& E) {
    const int tid = threadIdx.x, wid = __builtin_amdgcn_readfirstlane(tid >> 6), lane = tid & 63, wr = wid >> 2, wc = wid & 3, fr = lane & 15, fq = lane >> 4;
    const int K = g.K, nt = K / BK;
    unsigned voffA[2], voffB[2];
#pragma unroll
    for (int i = 0; i < 2; ++i) { int R, C; stage_rc(tid * 16 + i * 8192, R, C); const int Rb = Epi::PERM ? ((R & ~31) + perm32(R & 31)) : R;
        voffA[i] = (unsigned)(R * K + C) * 2u; voffB[i] = (unsigned)(Rb * K + C) * 2u; }
    const size_t kstep = (size_t)(BK * 2);
    const size_t hstep = (size_t)HALF * K * 2;
    const size_t tstep = 2 * hstep;
    const unsigned ldsw = (unsigned)wid * 1024u;
    const int aoff = lds_byte(wr * 64 + fr, fq * 8), boff = lds_byte(wc * 32 + fr, fq * 8);
#define PG8_SA(b, h) (((b) * 2 + (h)) * HTB)
#define PG8_SB(b, h) ((4 + (b) * 2 + (h)) * HTB)
#define PG8_STAGE(bufoff, gbase, voff) do { _Pragma("unroll") for (int _i = 0; _i < 2; ++_i) \
        __builtin_amdgcn_global_load_lds((const unsigned*)((const char*)(gbase) + (voff)[_i]), (LAS unsigned*)(lds + (bufoff) + ldsw + _i * 8192), 16, 0, 0); } while (0)
#define PG8_LDA(dst, b, h) do { _Pragma("unroll") for (int m = 0; m < 4; ++m) _Pragma("unroll") for (int k = 0; k < 2; ++k) dst[m][k] = *(const LAS bf16x8*)(lds + PG8_SA(b, h) + aoff + m * 2048 + k * 1024); } while (0)
#define PG8_LDB(dst, b, h) do { _Pragma("unroll") for (int n = 0; n < 2; ++n) _Pragma("unroll") for (int k = 0; k < 2; ++k) dst[n][k] = *(const LAS bf16x8*)(lds + PG8_SB(b, h) + boff + n * 2048 + k * 1024); } while (0)
#define PG8_MMA(ai, bj, At, Bt) do { __builtin_amdgcn_s_setprio(1); _Pragma("unroll") for (int m = 0; m < 4; ++m) _Pragma("unroll") for (int n = 0; n < 2; ++n) _Pragma("unroll") for (int k = 0; k < 2; ++k) \
        acc[ai][bj][m][n] = __builtin_amdgcn_mfma_f32_16x16x32_bf16(Bt[n][k], At[m][k], acc[ai][bj][m][n], 0, 0, 0); __builtin_amdgcn_s_setprio(0); } while (0)
#define PG8_WAIT_V(n) asm volatile("s_waitcnt vmcnt(" #n ")" ::: "memory")
#define PG8_WAIT_L(n) asm volatile("s_waitcnt lgkmcnt(" #n ")" ::: "memory")
#define PG8_BAR __builtin_amdgcn_s_barrier()
#define PG8_SCHED __builtin_amdgcn_sched_barrier(0)
    Unit cur, nxt; int ui = 0;
    if (!S.next(0, cur)) return;
    f32x4 acc[2][2][4][2];
#pragma unroll
    for (int a = 0; a < 2; ++a)
#pragma unroll
        for (int b = 0; b < 2; ++b)
#pragma unroll
            for (int m = 0; m < 4; ++m)
#pragma unroll
                for (int n = 0; n < 2; ++n) acc[a][b][m][n] = (f32x4){0.f, 0.f, 0.f, 0.f};
    bf16x8 At[4][2], B0[2][2], B1[2][2];
    const char* cA = (const char*)g.A + (size_t)cur.pm * tstep; const char* cB = (const char*)g.Bt + (size_t)cur.pn * tstep;
    S.a_ready(cur);
    PG8_STAGE(PG8_SB(0, 0), cB, voffB); PG8_STAGE(PG8_SA(0, 0), cA, voffA); PG8_STAGE(PG8_SB(0, 1), cB + hstep, voffB); PG8_STAGE(PG8_SA(0, 1), cA + hstep, voffA);
    if (wr == 1) PG8_BAR;
    PG8_WAIT_V(4); PG8_BAR;
    PG8_STAGE(PG8_SB(1, 0), cB + kstep, voffB); PG8_STAGE(PG8_SA(1, 0), cA + kstep, voffA); PG8_STAGE(PG8_SB(1, 1), cB + hstep + kstep, voffB);
    PG8_WAIT_V(6); PG8_BAR;
    for (;;) {
        const bool has_next = S.next(ui + 1, nxt);
        const char* nA = has_next ? (const char*)g.A + (size_t)nxt.pm * tstep : cA; const char* nB = has_next ? (const char*)g.Bt + (size_t)nxt.pn * tstep : cB;
        for (int t = 0; t < nt; t += 2) {
            const bool last = (t == nt - 2);
            const char* a1 = cA + (size_t)(t + 1) * kstep;
            const char* a2 = last ? nA : cA + (size_t)(t + 2) * kstep; const char* b2 = last ? nB : cB + (size_t)(t + 2) * kstep;
            const char* a3 = a2 + kstep; const char* b3 = b2 + kstep;
            if (last && has_next) S.a_ready(nxt);
            PG8_LDB(B0, 0, 0); PG8_SCHED; PG8_LDA(At, 0, 0); PG8_STAGE(PG8_SA(1, 1), a1 + hstep, voffA);
            PG8_WAIT_L(8); PG8_BAR; PG8_WAIT_L(0); PG8_MMA(0, 0, At, B0); PG8_BAR; PG8_SCHED;
            PG8_LDB(B1, 0, 1); PG8_STAGE(PG8_SB(0, 0), b2, voffB);
            PG8_BAR; PG8_WAIT_L(0); PG8_MMA(0, 1, At, B1); PG8_BAR;
            PG8_LDA(At, 0, 1); PG8_STAGE(PG8_SA(0, 0), a2, voffA);
            PG8_BAR; PG8_WAIT_L(0); PG8_MMA(1, 0, At, B0); PG8_BAR; PG8_SCHED;
            PG8_STAGE(PG8_SB(0, 1), b2 + hstep, voffB);
            PG8_WAIT_V(6); PG8_BAR; PG8_MMA(1, 1, At, B1); PG8_BAR;
            PG8_LDB(B0, 1, 0); PG8_SCHED; PG8_LDA(At, 1, 0); PG8_STAGE(PG8_SA(0, 1), a2 + hstep, voffA);
            PG8_WAIT_L(8); PG8_BAR; PG8_WAIT_L(0); PG8_MMA(0, 0, At, B0); PG8_BAR; PG8_SCHED;
            PG8_LDB(B1, 1, 1); PG8_STAGE(PG8_SB(1, 0), b3, voffB);
            PG8_BAR; PG8_WAIT_L(0); PG8_MMA(0, 1, At, B1); PG8_BAR;
            PG8_LDA(At, 1, 1); PG8_STAGE(PG8_SA(1, 0), a3, voffA);
            PG8_BAR; PG8_WAIT_L(0); PG8_MMA(1, 0, At, B0); PG8_BAR; PG8_SCHED;
            PG8_STAGE(PG8_SB(1, 1), b3 + hstep, voffB);
            PG8_WAIT_V(6); PG8_BAR; PG8_MMA(1, 1, At, B1); PG8_BAR;
        }
        E(acc, cur, wr, wc, fr, fq); S.done(cur);
        if (!has_next) break;
#pragma unroll
        for (int a = 0; a < 2; ++a)
#pragma unroll
            for (int b = 0; b < 2; ++b)
#pragma unroll
                for (int m = 0; m < 4; ++m)
#pragma unroll
                    for (int n = 0; n < 2; ++n) acc[a][b][m][n] = (f32x4){0.f, 0.f, 0.f, 0.f};
        cur = nxt; cA = nA; cB = nB; ++ui;
    }
    PG8_WAIT_V(0);
    if (wr == 0) PG8_BAR;
    PG8_BAR;
#undef PG8_SA
#undef PG8_SB
#undef PG8_STAGE
#undef PG8_LDA
#undef PG8_LDB
#undef PG8_MMA
#undef PG8_WAIT_V
#undef PG8_WAIT_L
#undef PG8_BAR
#undef PG8_SCHED
}
}

struct EpiU {
    static constexpr bool PERM = true, AFTER_DRAIN = false;
    bf16_t* O;
    __device__ __forceinline__ void operator()(const f32x4 (&acc)[2][2][4][2], const pg8::Unit& u, int wr, int wc, int fr, int fq) const {
        const int row0 = u.pm * 256 + wr * 64 + fr, col0 = u.pn * 256 + wc * 32 + 8 * fq;
#pragma unroll
        for (int ai = 0; ai < 2; ++ai)
#pragma unroll
            for (int m = 0; m < 4; ++m) { bf16_t* rowp = O + (size_t)(row0 + ai * 128 + m * 16) * UP + col0;
#pragma unroll
                for (int bj = 0; bj < 2; ++bj) { const f32x4 v0 = acc[ai][bj][m][0], v1 = acc[ai][bj][m][1];
                    u32x4 w; w.x = pk2(v0[0], v0[1]); w.y = pk2(v0[2], v0[3]); w.z = pk2(v1[0], v1[1]); w.w = pk2(v1[2], v1[3]);
                    *(u32x4*)(rowp + bj * 128) = w; } }
    }
};
template <int LAYER> struct EpiY {
    static constexpr bool PERM = false, AFTER_DRAIN = false;
    const float* xp; const float* xs; float* Y; f32x2* stat; const f32x2* mr; const float* lg; const float* lb;
    __device__ __forceinline__ void operator()(const f32x4 (&acc)[2][2][4][2], const pg8::Unit& u, int wr, int wc, int fr, int fq) const {
        const int col0 = u.pn * 256 + wc * 32 + 4 * fq;
        f32x4 gv[2][2], bv[2][2];
        if (LAYER == 1) {
#pragma unroll
            for (int bj = 0; bj < 2; ++bj)
#pragma unroll
                for (int n = 0; n < 2; ++n) { gv[bj][n] = *(const f32x4*)(lg + col0 + bj * 128 + n * 16); bv[bj][n] = *(const f32x4*)(lb + col0 + bj * 128 + n * 16); }
        }
#pragma unroll
        for (int ai = 0; ai < 2; ++ai)
#pragma unroll
            for (int m = 0; m < 4; ++m) {
                const int row = u.pm * 256 + ai * 128 + wr * 64 + m * 16 + fr;
                const float* rp; f32x2 mrv = (f32x2){0.f, 1.f};
                if (LAYER == 0) rp = (row < NPROMPT) ? xp + (size_t)row * DM : xs + (size_t)(row - NPROMPT) * DM;
                else { rp = Y + (size_t)row * DM; mrv = mr[row]; }
                float* yp = Y + (size_t)row * DM;
                float s = 0.f, q = 0.f;
#pragma unroll
                for (int bj = 0; bj < 2; ++bj)
#pragma unroll
                    for (int n = 0; n < 2; ++n) {
                        const int c = col0 + bj * 128 + n * 16;
                        f32x4 r = *(const f32x4*)(rp + c);
                        if (LAYER == 1) r = (r - mrv.x) * mrv.y * gv[bj][n] + bv[bj][n];
                        const f32x4 y = r * DN_ALPHA + acc[ai][bj][m][n];
                        *(f32x4*)(yp + c) = y;
                        s += (y[0] + y[1]) + (y[2] + y[3]); q += (y[0] * y[0] + y[1] * y[1]) + (y[2] * y[2] + y[3] * y[3]);
                    }
                s += __shfl_xor(s, 16); s += __shfl_xor(s, 32); q += __shfl_xor(q, 16); q += __shfl_xor(q, 32);
                if (fq == 0) stat[(size_t)row * 16 + u.pn * 4 + wc] = (f32x2){s, q};
            }
    }
};
struct EpiPS {
    static constexpr bool PERM = true, AFTER_DRAIN = false;
    bf16_t* P; bf16_t* S;
    __device__ __forceinline__ void operator()(const f32x4 (&acc)[2][2][4][2], const pg8::Unit& u, int wr, int wc, int fr, int fq) const {
        const int row0 = u.pm * 256 + wr * 64 + fr, off = (wc & 1) * 32 + 8 * fq;
        bf16_t* dst = (wc < 2 ? S : P) + u.pn * 64 + off;
#pragma unroll
        for (int ai = 0; ai < 2; ++ai)
#pragma unroll
            for (int m = 0; m < 4; ++m) {
                float o[8];
#pragma unroll
                for (int n = 0; n < 2; ++n)
#pragma unroll
                    for (int j = 0; j < 4; ++j) { const float a = acc[ai][0][m][n][j], b = acc[ai][1][m][n][j];
                        o[4 * n + j] = (wc < 2) ? silu(b) * a : a * b; }
                u32x4 w; w.x = pk2(o[0], o[1]); w.y = pk2(o[2], o[3]); w.z = pk2(o[4], o[5]); w.w = pk2(o[6], o[7]);
                *(u32x4*)(dst + (size_t)(row0 + ai * 128 + m * 16) * DM) = w;
            }
    }
};

constexpr int GEMM_LDS = 147456;
template <class Epi>
__global__ void __launch_bounds__(512, 2) gemm_kernel(pg8::Gemm g, Epi E) {
    extern __shared__ __attribute__((aligned(16))) unsigned char lds[];
    pg8::StaticOrder S; S.init(g.M, g.N, gridDim.x, blockIdx.x);
    pg8::gemm_phase<Epi, pg8::StaticOrder>((LAS unsigned char*)lds, g, S, E);
}

template <int MODE> __device__ __forceinline__ int wmap(int n, float& sc) {
    sc = 1.f;
    if (MODE == 0) return n;
    if (MODE == 1) {
        if (n < 512) sc = 0.08838834764831845f;
        if (n >= C_QB && n < C_KB) sc = 0.125f;
        if (n < 2048) return n;
        if (n < C_GD) return n + 32;
        if (n < C_GD + 32) return n - C_GD + 2048;
        return -1;
    }
    const int w = n & 255, grp = w >> 6, ch = (n >> 8) * 64 + (w & 63);
    const int base = grp == 0 ? 0 : (grp == 1 ? 1024 : (grp == 2 ? 3072 : 2048));
    return base + ch;
}
template <int MODE>
__global__ void __launch_bounds__(256) wconv_kernel(const float* __restrict__ W, int Nsrc, bf16_t* __restrict__ Wt, int Ndst) {
    __shared__ float tile[64][65];
    const int nb = blockIdx.x % (Ndst / 64), kb = blockIdx.x / (Ndst / 64), n0 = nb * 64, k0 = kb * 64;
    const int tx = threadIdx.x & 63, ty = threadIdx.x >> 6;
    float sc; const int src = wmap<MODE>(n0 + tx, sc);
    for (int kk = ty; kk < 64; kk += 4) tile[kk][tx] = src >= 0 ? W[(size_t)(k0 + kk) * Nsrc + src] * sc : 0.f;
    __syncthreads();
    for (int nn = ty; nn < 64; nn += 4) Wt[(size_t)(n0 + nn) * 1024 + k0 + tx] = f2bf(tile[tx][nn]);
}
__global__ void __launch_bounds__(256) xconv_kernel(const float* __restrict__ xp, const float* __restrict__ xs, bf16_t* __restrict__ xb) {
    const size_t n8 = (size_t)NTOK * DM / 8;
    for (size_t i = (size_t)blockIdx.x * blockDim.x + threadIdx.x; i < n8; i += (size_t)gridDim.x * blockDim.x) {
        const size_t e = i * 8; const float* src = e < (size_t)NPROMPT * DM ? xp + e : xs + (e - (size_t)NPROMPT * DM);
        const f32x4 a = *(const f32x4*)src, b = *(const f32x4*)(src + 4);
        u32x4 w; w.x = pk2(a[0], a[1]); w.y = pk2(a[2], a[3]); w.z = pk2(b[0], b[1]); w.w = pk2(b[2], b[3]);
        *(u32x4*)(xb + e) = w;
    }
}

__global__ void __launch_bounds__(128) gla_naive_kernel(const bf16_t* __restrict__ U, const float* __restrict__ wuf, const float* __restrict__ bf_, const float* __restrict__ wub, const float* __restrict__ bb_, float* __restrict__ OF, float* __restrict__ OB) {
    __shared__ __attribute__((aligned(16))) float sq[16][128], sk[16][128], sd[16][128];
    const int b = blockIdx.x, dir = b & 1, h = (b >> 1) & 3, s = b >> 3, tid = threadIdx.x;
    const int L = s < 2 ? LP : LS, start = s < 2 ? s * LP : NPROMPT + (s - 2) * LS;
    const float* wu = dir ? wub : wuf; const float* bias = dir ? bb_ : bf_; float* O = dir ? OB : OF;
    float wr[16];
#pragma unroll
    for (int r = 0; r < 16; ++r) wr[r] = wu[r * 512 + h * 128 + tid];
    const float bb = bias[h * 128 + tid];
    float S[128];
#pragma unroll
    for (int i = 0; i < 128; ++i) S[i] = 0.f;
    for (int t0 = 0; t0 < L; t0 += 16) {
        for (int tt = 0; tt < 16; ++tt) {
            const int p = t0 + tt, tok = start + (dir ? L - 1 - p : p);
            const bf16_t* ur = U + (size_t)tok * UP;
            float x = bb;
#pragma unroll
            for (int r = 0; r < 16; ++r) x += bf2f(ur[C_GD + dir * 16 + r]) * wr[r];
            const float ls = fminf(x, 0.f) - log1pf(expf(-fabsf(x)));
            sd[tt][tid] = expf(ls * (1.0f / 16.0f));
            sq[tt][tid] = bf2f(ur[C_QA + h * 128 + tid]);
            sk[tt][tid] = bf2f(ur[C_KA + h * 128 + tid]);
        }
        __syncthreads();
        for (int tt = 0; tt < 16; ++tt) {
            const int p = t0 + tt, tok = start + (dir ? L - 1 - p : p);
            const float v = bf2f(U[(size_t)tok * UP + C_VA + h * 128 + tid]);
            float acc = 0.f;
#pragma unroll
            for (int dk = 0; dk < 128; dk += 4) {
                const f32x4 d4 = *(const f32x4*)&sd[tt][dk], q4 = *(const f32x4*)&sq[tt][dk], k4 = *(const f32x4*)&sk[tt][dk];
#pragma unroll
                for (int j = 0; j < 4; ++j) {
                    const float sdec = S[dk + j] * d4[j];
                    const float sn = sdec + k4[j] * v;
                    acc += q4[j] * (dir ? sdec : sn);
                    S[dk + j] = sn;
                }
            }
            O[(size_t)tok * 512 + h * 128 + tid] = acc;
        }
        __syncthreads();
    }
}
__global__ void __launch_bounds__(256) gla_combine_kernel(const float* __restrict__ OF, const float* __restrict__ OB, const bf16_t* __restrict__ U, const float* __restrict__ ng, bf16_t* __restrict__ ymix) {
    const int w = blockIdx.x * 4 + (threadIdx.x >> 6), lane = threadIdx.x & 63, tok = w >> 2, h = w & 3;
    const size_t o = (size_t)tok * 512 + h * 128 + lane * 2;
    const float a0 = OF[o] + OB[o], a1 = OF[o + 1] + OB[o + 1];
    const float ss = wave_sum(a0 * a0 + a1 * a1);
    const float rstd = rsqrtf(ss * (1.0f / 128.0f) + NORM_EPS);
    const bf16_t* z = U + (size_t)tok * UP + C_ZA + h * 128 + lane * 2;
    const float y0 = a0 * rstd * ng[lane * 2] * silu(bf2f(z[0])), y1 = a1 * rstd * ng[lane * 2 + 1] * silu(bf2f(z[1]));
    *(unsigned*)(ymix + (size_t)tok * DM + h * 128 + lane * 2) = pk2(y0, y1);
}
__device__ __forceinline__ int t5_bucket(int rel) {
    const int n = rel < 0 ? -rel : rel;
    int b = n < 8 ? n : (n < 12 ? 8 : (n < 16 ? 9 : (n < 23 ? 10 : (n < 32 ? 11 : (n < 46 ? 12 : (n < 64 ? 13 : (n < 91 ? 14 : 15)))))));
    return b + (rel > 0 ? 16 : 0);
}
__global__ void __launch_bounds__(256) swa_naive_kernel(const bf16_t* __restrict__ U, const float* __restrict__ sink, const float* __restrict__ relb, bf16_t* __restrict__ ymix) {
    __shared__ float sq[4][64]; __shared__ float sp[4][320];
    const int wv = threadIdx.x >> 6, lane = threadIdx.x & 63, tok = blockIdx.x >> 1, kv = blockIdx.x & 1, hq = kv * 4 + wv;
    int s0, L; seq_of(tok, s0, L); const int i = tok - s0;
    sq[wv][lane] = bf2f(U[(size_t)tok * UP + C_QB + hq * 64 + lane]);
    __syncthreads();
    const float snk = sink[hq];
    float sc[5]; float mx = snk;
#pragma unroll
    for (int c = 0; c < 5; ++c) {
        const int jj = c * 64 + lane, j = i - 128 + jj; const bool valid = jj <= 256 && j >= 0 && j < L;
        float d = -INFINITY;
        if (valid) {
            const bf16_t* kr = U + (size_t)(s0 + j) * UP + C_KB + kv * 64; d = 0.f;
#pragma unroll
            for (int e = 0; e < 64; e += 8) { const u32x4 kk = *(const u32x4*)(kr + e);
                d += sq[wv][e] * __uint_as_float(kk.x << 16) + sq[wv][e + 1] * __uint_as_float(kk.x & 0xffff0000u) + sq[wv][e + 2] * __uint_as_float(kk.y << 16) + sq[wv][e + 3] * __uint_as_float(kk.y & 0xffff0000u)
                   + sq[wv][e + 4] * __uint_as_float(kk.z << 16) + sq[wv][e + 5] * __uint_as_float(kk.z & 0xffff0000u) + sq[wv][e + 6] * __uint_as_float(kk.w << 16) + sq[wv][e + 7] * __uint_as_float(kk.w & 0xffff0000u); }
            d += relb[t5_bucket(j - i) * 8 + hq];
        }
        sc[c] = d; mx = fmaxf(mx, d);
    }
    mx = wave_max(mx);
    float den = 0.f;
#pragma unroll
    for (int c = 0; c < 5; ++c) { sc[c] = sc[c] == -INFINITY ? 0.f : __expf(sc[c] - mx); den += sc[c]; }
    den = wave_sum(den) + __expf(snk - mx);
    const float inv = 1.0f / den;
#pragma unroll
    for (int c = 0; c < 5; ++c) sp[wv][c * 64 + lane] = sc[c] * inv;
    __syncthreads();
    float o = 0.f;
    for (int jj = 0; jj <= 256; ++jj) { const int j = i - 128 + jj; if (j >= 0 && j < L) o += sp[wv][jj] * bf2f(U[(size_t)(s0 + j) * UP + C_VB + kv * 64 + lane]); }
    const float z = bf2f(U[(size_t)tok * UP + C_ZB + hq * 64 + lane]);
    ymix[(size_t)tok * DM + 512 + hq * 64 + lane] = f2bf(o * silu(z));
}
template <int FINAL>
__global__ void __launch_bounds__(256) ln_kernel(float* __restrict__ Y, const f32x2* __restrict__ stat, f32x2* __restrict__ mr, const float* __restrict__ lg, const float* __restrict__ lb, bf16_t* __restrict__ xb) {
    const int row = blockIdx.x * 4 + (threadIdx.x >> 6), lane = threadIdx.x & 63;
    f32x2 p = lane < 16 ? stat[(size_t)row * 16 + lane] : (f32x2){0.f, 0.f};
    const float s = wave_sum(p.x), q = wave_sum(p.y);
    const float mean = s * (1.0f / DM), var = q * (1.0f / DM) - mean * mean, rstd = rsqrtf(fmaxf(var, 0.f) + LN_EPS);
    if (!FINAL && lane == 0) mr[row] = (f32x2){mean, rstd};
#pragma unroll
    for (int j = 0; j < 4; ++j) {
        const int c = j * 256 + lane * 4;
        const f32x4 y = *(const f32x4*)(Y + (size_t)row * DM + c), g = *(const f32x4*)(lg + c), b = *(const f32x4*)(lb + c);
        const f32x4 o = (y - mean) * rstd * g + b;
        if (FINAL) *(f32x4*)(Y + (size_t)row * DM + c) = o;
        else { u32x2 w; w.x = pk2(o[0], o[1]); w.y = pk2(o[2], o[3]); *(u32x2*)(xb + (size_t)row * DM + c) = w; }
    }
}
__global__ void __launch_bounds__(256) convgate_kernel(const bf16_t* __restrict__ P, const bf16_t* __restrict__ S, const float* __restrict__ cw, bf16_t* __restrict__ G) {
    const size_t n8 = (size_t)NTOK * DM / 8;
    for (size_t i = (size_t)blockIdx.x * blockDim.x + threadIdx.x; i < n8; i += (size_t)gridDim.x * blockDim.x) {
        const int row = (int)(i >> 7), c = (int)(i & 127) * 8; int s0, L; seq_of(row, s0, L);
        const bool hasl = row > s0, hasr = row < s0 + L - 1;
        const u32x4 pm = *(const u32x4*)(P + (size_t)row * DM + c), sv = *(const u32x4*)(S + (size_t)row * DM + c);
        u32x4 pl = (u32x4){0, 0, 0, 0}, pr = (u32x4){0, 0, 0, 0};
        if (hasl) pl = *(const u32x4*)(P + (size_t)(row - 1) * DM + c);
        if (hasr) pr = *(const u32x4*)(P + (size_t)(row + 1) * DM + c);
        float o[8];
#pragma unroll
        for (int j = 0; j < 4; ++j) {
            const unsigned l = pl[j], m = pm[j], r = pr[j], sw = sv[j];
            const int cc = c + 2 * j;
            o[2 * j] = __uint_as_float(sw << 16) * (cw[cc] * __uint_as_float(l << 16) + cw[1024 + cc] * __uint_as_float(m << 16) + cw[2048 + cc] * __uint_as_float(r << 16));
            o[2 * j + 1] = __uint_as_float(sw & 0xffff0000u) * (cw[cc + 1] * __uint_as_float(l & 0xffff0000u) + cw[1024 + cc + 1] * __uint_as_float(m & 0xffff0000u) + cw[2048 + cc + 1] * __uint_as_float(r & 0xffff0000u));
        }
        u32x4 w; w.x = pk2(o[0], o[1]); w.y = pk2(o[2], o[3]); w.z = pk2(o[4], o[5]); w.w = pk2(o[6], o[7]);
        *(u32x4*)(G + (size_t)row * DM + c) = w;
    }
}

extern "C" void kernel_launch(void* const* d_in, const int* in_sizes, int n_in, void* d_out, int out_size, void* d_ws, size_t ws_size, hipStream_t stream) {
    static int ok = 0;
    if (ok == 0) {
        ok = 1;
        if (n_in != 16 || out_size != NTOK * DM || ws_size < WS_END) { fprintf(stderr, "kernel_launch: unexpected shapes (n_in %d out %d ws %zu)\n", n_in, out_size, ws_size); ok = -1; }
        if (hipFuncSetAttribute((const void*)gemm_kernel<EpiU>, hipFuncAttributeMaxDynamicSharedMemorySize, GEMM_LDS) != hipSuccess) ok = -1;
        if (hipFuncSetAttribute((const void*)gemm_kernel<EpiY<0>>, hipFuncAttributeMaxDynamicSharedMemorySize, GEMM_LDS) != hipSuccess) ok = -1;
        if (hipFuncSetAttribute((const void*)gemm_kernel<EpiY<1>>, hipFuncAttributeMaxDynamicSharedMemorySize, GEMM_LDS) != hipSuccess) ok = -1;
        if (hipFuncSetAttribute((const void*)gemm_kernel<EpiPS>, hipFuncAttributeMaxDynamicSharedMemorySize, GEMM_LDS) != hipSuccess) ok = -1;
        if (ok < 0) fprintf(stderr, "kernel_launch: setup failed\n");
    }
    if (ok < 0) return;
    const float* xp = (const float*)d_in[0]; const float* xs = (const float*)d_in[1]; const float* w_in_even = (const float*)d_in[2];
    const float* wuf = (const float*)d_in[3]; const float* bfw = (const float*)d_in[4]; const float* wub = (const float*)d_in[5]; const float* bbw = (const float*)d_in[6];
    const float* ng = (const float*)d_in[7]; const float* sink = (const float*)d_in[8]; const float* relb = (const float*)d_in[9]; const float* w_out_even = (const float*)d_in[10];
    const float* w_in_odd = (const float*)d_in[11]; const float* cw = (const float*)d_in[12]; const float* w_out_odd = (const float*)d_in[13]; const float* lng = (const float*)d_in[14]; const float* lnb = (const float*)d_in[15];
    unsigned char* ws = (unsigned char*)d_ws; float* out = (float*)d_out;
    bf16_t* W1t = (bf16_t*)(ws + WS_W1T); bf16_t* W2t = (bf16_t*)(ws + WS_W2T); bf16_t* W3t = (bf16_t*)(ws + WS_W3T); bf16_t* W4t = (bf16_t*)(ws + WS_W4T);
    bf16_t* xb = (bf16_t*)(ws + WS_XB); bf16_t* ymix = xb; bf16_t* G = xb; bf16_t* U = (bf16_t*)(ws + WS_U);
    bf16_t* x1b = (bf16_t*)(ws + WS_X1B); bf16_t* P = (bf16_t*)(ws + WS_P); bf16_t* Sg = (bf16_t*)(ws + WS_S);
    f32x2* stat1 = (f32x2*)(ws + WS_STAT1); f32x2* stat2 = (f32x2*)(ws + WS_STAT2); f32x2* mr1 = (f32x2*)(ws + WS_MR1);

    wconv_kernel<1><<<(UP / 64) * 16, 256, 0, stream>>>(w_in_even, EVEN_IN, W1t, UP);
    wconv_kernel<0><<<16 * 16, 256, 0, stream>>>(w_out_even, 1024, W2t, 1024);
    wconv_kernel<2><<<64 * 16, 256, 0, stream>>>(w_in_odd, ODD_IN, W3t, 4096);
    wconv_kernel<0><<<16 * 16, 256, 0, stream>>>(w_out_odd, 1024, W4t, 1024);
    xconv_kernel<<<2048, 256, 0, stream>>>(xp, xs, xb);
    { pg8::Gemm g{xb, W1t, NTOK, UP, DM, 0}; EpiU E{U}; gemm_kernel<EpiU><<<256, 512, GEMM_LDS, stream>>>(g, E); }
    float* OF = out; float* OB = out + (size_t)NTOK * 512;
    gla_naive_kernel<<<48, 128, 0, stream>>>(U, wuf, bfw, wub, bbw, OF, OB);
    gla_combine_kernel<<<NTOK, 256, 0, stream>>>(OF, OB, U, ng, ymix);
    swa_naive_kernel<<<NTOK * 2, 256, 0, stream>>>(U, sink, relb, ymix);
    { pg8::Gemm g{ymix, W2t, NTOK, DM, DM, 0}; EpiY<0> E{xp, xs, out, stat1, nullptr, nullptr, nullptr}; gemm_kernel<EpiY<0>><<<256, 512, GEMM_LDS, stream>>>(g, E); }
    ln_kernel<0><<<NTOK / 4, 256, 0, stream>>>(out, stat1, mr1, lng, lnb, x1b);
    { pg8::Gemm g{x1b, W3t, NTOK, 4096, DM, 0}; EpiPS E{P, Sg}; gemm_kernel<EpiPS><<<256, 512, GEMM_LDS, stream>>>(g, E); }
    convgate_kernel<<<2048, 256, 0, stream>>>(P, Sg, cw, G);
    { pg8::Gemm g{G, W4t, NTOK, DM, DM, 0}; EpiY<1> E{nullptr, nullptr, out, stat2, mr1, lng, lnb}; gemm_kernel<EpiY<1>><<<256, 512, GEMM_LDS, stream>>>(g, E); }
    ln_kernel<1><<<NTOK / 4, 256, 0, stream>>>(out, stat2, nullptr, lng + DM, lnb + DM, nullptr);
}
```

```cpp
#include <hip/hip_runtime.h>
#include <cstdio>

typedef unsigned short bf16_t;
typedef short bf16x8 __attribute__((ext_vector_type(8)));
typedef float f32x4 __attribute__((ext_vector_type(4)));
typedef float f32x2 __attribute__((ext_vector_type(2)));
typedef unsigned u32x4 __attribute__((ext_vector_type(4)));
typedef unsigned u32x2 __attribute__((ext_vector_type(2)));
#define LAS __attribute__((address_space(3)))

constexpr int DM = 1024, NTOK = 49152, NPROMPT = 32768, LP = 16384, LS = 4096;
constexpr int UP = 3584;
constexpr int C_QA = 0, C_KA = 512, C_VA = 1024, C_ZA = 1536, C_QB = 2048, C_KB = 2560, C_VB = 2688, C_ZB = 2816, C_GD = 3328;
constexpr int EVEN_IN = 3360, ODD_IN = 4096;
constexpr float DN_ALPHA = 1.41421356237309515f;
constexpr float LN_EPS = 1e-5f, NORM_EPS = 1e-6f;

constexpr size_t MiB = 1u << 20;
constexpr size_t WS_CTL = 0, WS_W1T = 1 * MiB, WS_W2T = 8 * MiB, WS_W3T = 10 * MiB, WS_W4T = 18 * MiB, WS_STAT1 = 20 * MiB, WS_MR1 = 26 * MiB,
                 WS_XB = 27 * MiB  , WS_U = 123 * MiB, WS_ST = 459 * MiB, WS_END = 507 * MiB;
constexpr size_t WS_X1B = WS_U, WS_P = WS_U + 96 * MiB, WS_S = WS_U + 192 * MiB, WS_STAT2 = WS_U + 288 * MiB;

__device__ __forceinline__ float bf2f(bf16_t b) { return __uint_as_float(((unsigned)b) << 16); }
__device__ __forceinline__ bf16_t f2bf(float f) { unsigned u = __float_as_uint(f); u += 0x7fffu + ((u >> 16) & 1u); return (bf16_t)(u >> 16); }
__device__ __forceinline__ unsigned pk2(float lo, float hi) { return (unsigned)f2bf(lo) | ((unsigned)f2bf(hi) << 16); }
__device__ __forceinline__ float silu(float x) { return x / (1.0f + __expf(-x)); }
__device__ __forceinline__ float wave_sum(float v) {
#pragma unroll
    for (int o = 1; o < 64; o <<= 1) v += __shfl_xor(v, o);
    return v;
}
__device__ __forceinline__ float wave_max(float v) {
#pragma unroll
    for (int o = 1; o < 64; o <<= 1) v = fmaxf(v, __shfl_xor(v, o));
    return v;
}
__device__ __forceinline__ void seq_of(int row, int& s0, int& L) {
    if (row < NPROMPT) { L = LP; s0 = row & ~(LP - 1); } else { L = LS; s0 = NPROMPT + ((row - NPROMPT) & ~(LS - 1)); }
}

namespace pg8 {
constexpr int BM = 256, BK = 64, HALF = 128, HTB = HALF * BK * 2, STAGE_BYTES = 8 * HTB, NXCD = 8, WGM = 8;
__host__ __device__ __forceinline__ int lds_byte(int r, int c) { const int st = (r >> 4) * 2 + (c >> 5), rr = r & 15, cc = c & 31, ob = rr * 64 + cc * 2; return st * 1024 + (ob ^ (((ob >> 9) & 1) << 5)); }
__host__ __device__ __forceinline__ void stage_rc(int b, int& R, int& C) { const int st = b / 1024, sb = b % 1024, swz = sb ^ (((sb >> 9) & 1) << 5); R = (st >> 1) * 16 + swz / 64; C = (st & 1) * 32 + (swz % 64) / 2; }
__host__ __device__ __forceinline__ int perm32(int rho) { const int n = rho >> 4, i = rho & 15; return 8 * (i >> 2) + 4 * n + (i & 3); }
struct Unit { int pm, pn; };
struct Gemm { const bf16_t* A; const bf16_t* Bt; int M, N, K, pad; };
struct StaticOrder {
    int nM, nN, nwg, G, c;
    __host__ __device__ void init(int M, int N, int G_, int c_) { nM = M / BM; nN = N / BM; nwg = nM * nN; G = G_; c = c_; }
    __host__ __device__ bool next(int i, Unit& u) const {
        const long L = (long)i * G + c; if (L >= nwg) return false;
        int wgid = (int)L; { const int q = nwg / NXCD, r = nwg % NXCD, xcd = wgid % NXCD, off = wgid / NXCD; wgid = (xcd < r ? xcd * (q + 1) : r * (q + 1) + (xcd - r) * q) + off; }
        const int nig = WGM * nN, gid = wgid / nig, fm = gid * WGM, gsz = (nM - fm) < WGM ? (nM - fm) : WGM;
        u.pm = fm + ((wgid % nig) % gsz); u.pn = (wgid % nig) / gsz; return true;
    }
    __device__ __forceinline__ void a_ready(const Unit&) const {}
    __device__ __forceinline__ void done(const Unit&) const {}
};

template <class Epi, class Sched>
__device__ __forceinline__ void gemm_phase(LAS unsigned char* lds, const Gemm g, const Sched& S, const Epi& E) {
    const int tid = threadIdx.x, wid = __builtin_amdgcn_readfirstlane(tid >> 6), lane = tid & 63, wr = wid >> 2, wc = wid & 3, fr = lane & 15, fq = lane >> 4;
    const int K = g.K, nt = K / BK;
    unsigned voffA[2], voffB[2];
#pragma unroll
    for (int i = 0; i < 2; ++i) { int R, C; stage_rc(tid * 16 + i * 8192, R, C); const int Rb = Epi::PERM ? ((R & ~31) + perm32(R & 31)) : R;
        voffA[i] = (unsigned)(R * K + C) * 2u; voffB[i] = (unsigned)(Rb * K + C) * 2u; }
    const size_t kstep = (size_t)(BK * 2);
    const size_t hstep = (size_t)HALF * K * 2;
    const size_t tstep = 2 * hstep;
    const unsigned ldsw = (unsigned)wid * 1024u;
    const int aoff = lds_byte(wr * 64 + fr, fq * 8), boff = lds_byte(wc * 32 + fr, fq * 8);
#define PG8_SA(b, h) (((b) * 2 + (h)) * HTB)
#define PG8_SB(b, h) ((4 + (b) * 2 + (h)) * HTB)
#define PG8_STAGE(bufoff, gbase, voff) do { _Pragma("unroll") for (int _i = 0; _i < 2; ++_i) \
        __builtin_amdgcn_global_load_lds((const unsigned*)((const char*)(gbase) + (voff)[_i]), (LAS unsigned*)(lds + (bufoff) + ldsw + _i * 8192), 16, 0, 0); } while (0)
#define PG8_LDA(dst, b, h) do { _Pragma("unroll") for (int m = 0; m < 4; ++m) _Pragma("unroll") for (int k = 0; k < 2; ++k) dst[m][k] = *(const LAS bf16x8*)(lds + PG8_SA(b, h) + aoff + m * 2048 + k * 1024); } while (0)
#define PG8_LDB(dst, b, h) do { _Pragma("unroll") for (int n = 0; n < 2; ++n) _Pragma("unroll") for (int k = 0; k < 2; ++k) dst[n][k] = *(const LAS bf16x8*)(lds + PG8_SB(b, h) + boff + n * 2048 + k * 1024); } while (0)
#define PG8_MMA(ai, bj, At, Bt) do { __builtin_amdgcn_s_setprio(1); _Pragma("unroll") for (int m = 0; m < 4; ++m) _Pragma("unroll") for (int n = 0; n < 2; ++n) _Pragma("unroll") for (int k = 0; k < 2; ++k) \
        acc[ai][bj][m][n] = __builtin_amdgcn_mfma_f32_16x16x32_bf16(Bt[n][k], At[m][k], acc[ai][bj][m][n], 0, 0, 0); __builtin_amdgcn_s_setprio(0); } while (0)
#define PG8_WAIT_V(n) asm volatile("s_waitcnt vmcnt(" #n ")" ::: "memory")
#define PG8_WAIT_L(n) asm volatile("s_waitcnt lgkmcnt(" #n ")" ::: "memory")
#define PG8_BAR __builtin_amdgcn_s_barrier()
#define PG8_SCHED __builtin_amdgcn_sched_barrier(0)
    Unit cur, nxt; int ui = 0;
    if (!S.next(0, cur)) return;
    f32x4 acc[2][2][4][2];
#pragma unroll
    for (int a = 0; a < 2; ++a)
#pragma unroll
        for (int b = 0; b < 2; ++b)
#pragma unroll
            for (int m = 0; m < 4; ++m)
#pragma unroll
                for (int n = 0; n < 2; ++n) acc[a][b][m][n] = (f32x4){0.f, 0.f, 0.f, 0.f};
    bf16x8 At[4][2], B0[2][2], B1[2][2];
    const char* cA = (const char*)g.A + (size_t)cur.pm * tstep; const char* cB = (const char*)g.Bt + (size_t)cur.pn * tstep;
    S.a_ready(cur);
    PG8_STAGE(PG8_SB(0, 0), cB, voffB); PG8_STAGE(PG8_SA(0, 0), cA, voffA); PG8_STAGE(PG8_SB(0, 1), cB + hstep, voffB); PG8_STAGE(PG8_SA(0, 1), cA + hstep, voffA);
    if (wr == 1) PG8_BAR;
    PG8_WAIT_V(4); PG8_BAR;
    PG8_STAGE(PG8_SB(1, 0), cB + kstep, voffB); PG8_STAGE(PG8_SA(1, 0), cA + kstep, voffA); PG8_STAGE(PG8_SB(1, 1), cB + hstep + kstep, voffB);
    PG8_WAIT_V(6); PG8_BAR;
    for (;;) {
        const bool has_next = S.next(ui + 1, nxt);
        const char* nA = has_next ? (const char*)g.A + (size_t)nxt.pm * tstep : cA; const char* nB = has_next ? (const char*)g.Bt + (size_t)nxt.pn * tstep : cB;
        for (int t = 0; t < nt; t += 2) {
            const bool last = (t == nt - 2);
            const char* a1 = cA + (size_t)(t + 1) * kstep;
            const char* a2 = last ? nA : cA + (size_t)(t + 2) * kstep; const char* b2 = last ? nB : cB + (size_t)(t + 2) * kstep;
            const char* a3 = a2 + kstep; const char* b3 = b2 + kstep;
            if (last && has_next) S.a_ready(nxt);
            PG8_LDB(B0, 0, 0); PG8_SCHED; PG8_LDA(At, 0, 0); PG8_STAGE(PG8_SA(1, 1), a1 + hstep, voffA);
            PG8_WAIT_L(8); PG8_BAR; PG8_WAIT_L(0); PG8_MMA(0, 0, At, B0); PG8_BAR; PG8_SCHED;
            PG8_LDB(B1, 0, 1); PG8_STAGE(PG8_SB(0, 0), b2, voffB);
            PG8_BAR; PG8_WAIT_L(0); PG8_MMA(0, 1, At, B1); PG8_BAR;
            PG8_LDA(At, 0, 1); PG8_STAGE(PG8_SA(0, 0), a2, voffA);
            PG8_BAR; PG8_WAIT_L(0); PG8_MMA(1, 0, At, B0); PG8_BAR; PG8_SCHED;
            PG8_STAGE(PG8_SB(0, 1), b2 + hstep, voffB);
            PG8_WAIT_V(6); PG8_BAR; PG8_MMA(1, 1, At, B1); PG8_BAR;
            PG8_LDB(B0, 1, 0); PG8_SCHED; PG8_LDA(At, 1, 0); PG8_STAGE(PG8_SA(0, 1), a2 + hstep, voffA);
            PG8_WAIT_L(8); PG8_BAR; PG8_WAIT_L(0); PG8_MMA(0, 0, At, B0); PG8_BAR; PG8_SCHED;
            PG8_LDB(B1, 1, 1); PG8_STAGE(PG8_SB(1, 0), b3, voffB);
            PG8_BAR; PG8_WAIT_L(0); PG8_MMA(0, 1, At, B1); PG8_BAR;
            PG8_LDA(At, 1, 1); PG8_STAGE(PG8_SA(1, 0), a3, voffA);
            PG8_BAR; PG8_WAIT_L(0); PG8_MMA(1, 0, At, B0); PG8_BAR; PG8_SCHED;
            PG8_STAGE(PG8_SB(1, 1), b3 + hstep, voffB);
            PG8_WAIT_V(6); PG8_BAR; PG8_MMA(1, 1, At, B1); PG8_BAR;
        }
        E(acc, cur, wr, wc, fr, fq); S.done(cur);
        if (!has_next) break;
#pragma unroll
        for (int a = 0; a < 2; ++a)
#pragma unroll
            for (int b = 0; b < 2; ++b)
#pragma unroll
                for (int m = 0; m < 4; ++m)
#pragma unroll
                    for (int n = 0; n < 2; ++n) acc[a][b][m][n] = (f32x4){0.f, 0.f, 0.f, 0.f};
        cur = nxt; cA = nA; cB = nB; ++ui;
    }
    PG8_WAIT_V(0);
    if (wr == 0) PG8_BAR;
    PG8_BAR;
#undef PG8_SA
#undef PG8_SB
#undef PG8_STAGE
#undef PG8_LDA
#undef PG8_LDB
#undef PG8_MMA
#undef PG8_WAIT_V
#undef PG8_WAIT_L
#undef PG8_BAR
#undef PG8_SCHED
}
}

struct EpiU {
    static constexpr bool PERM = true, AFTER_DRAIN = false;
    bf16_t* O;
    __device__ __forceinline__ void operator()(const f32x4 (&acc)[2][2][4][2], const pg8::Unit& u, int wr, int wc, int fr, int fq) const {
        const int row0 = u.pm * 256 + wr * 64 + fr, col0 = u.pn * 256 + wc * 32 + 8 * fq;
#pragma unroll
        for (int ai = 0; ai < 2; ++ai)
#pragma unroll
            for (int m = 0; m < 4; ++m) { bf16_t* rowp = O + (size_t)(row0 + ai * 128 + m * 16) * UP + col0;
#pragma unroll
                for (int bj = 0; bj < 2; ++bj) { const f32x4 v0 = acc[ai][bj][m][0], v1 = acc[ai][bj][m][1];
                    u32x4 w; w.x = pk2(v0[0], v0[1]); w.y = pk2(v0[2], v0[3]); w.z = pk2(v1[0], v1[1]); w.w = pk2(v1[2], v1[3]);
                    *(u32x4*)(rowp + bj * 128) = w; } }
    }
};
template <int LAYER> struct EpiY {
    static constexpr bool PERM = false, AFTER_DRAIN = false;
    const float* xp; const float* xs; float* Y; f32x2* stat; const f32x2* mr; const float* lg; const float* lb;
    __device__ __forceinline__ void operator()(const f32x4 (&acc)[2][2][4][2], const pg8::Unit& u, int wr, int wc, int fr, int fq) const {
        const int col0 = u.pn * 256 + wc * 32 + 4 * fq;
        f32x4 gv[2][2], bv[2][2];
        if (LAYER == 1) {
#pragma unroll
            for (int bj = 0; bj < 2; ++bj)
#pragma unroll
                for (int n = 0; n < 2; ++n) { gv[bj][n] = *(const f32x4*)(lg + col0 + bj * 128 + n * 16); bv[bj][n] = *(const f32x4*)(lb + col0 + bj * 128 + n * 16); }
        }
#pragma unroll
        for (int ai = 0; ai < 2; ++ai)
#pragma unroll
            for (int m = 0; m < 4; ++m) {
                const int row = u.pm * 256 + ai * 128 + wr * 64 + m * 16 + fr;
                const float* rp; f32x2 mrv = (f32x2){0.f, 1.f};
                if (LAYER == 0) rp = (row < NPROMPT) ? xp + (size_t)row * DM : xs + (size_t)(row - NPROMPT) * DM;
                else { rp = Y + (size_t)row * DM; mrv = mr[row]; }
                float* yp = Y + (size_t)row * DM;
                float s = 0.f, q = 0.f;
#pragma unroll
                for (int bj = 0; bj < 2; ++bj)
#pragma unroll
                    for (int n = 0; n < 2; ++n) {
                        const int c = col0 + bj * 128 + n * 16;
                        f32x4 r = *(const f32x4*)(rp + c);
                        if (LAYER == 1) r = (r - mrv.x) * mrv.y * gv[bj][n] + bv[bj][n];
                        const f32x4 y = r * DN_ALPHA + acc[ai][bj][m][n];
                        *(f32x4*)(yp + c) = y;
                        s += (y[0] + y[1]) + (y[2] + y[3]); q += (y[0] * y[0] + y[1] * y[1]) + (y[2] * y[2] + y[3] * y[3]);
                    }
                s += __shfl_xor(s, 16); s += __shfl_xor(s, 32); q += __shfl_xor(q, 16); q += __shfl_xor(q, 32);
                if (fq == 0) stat[(size_t)row * 16 + u.pn * 4 + wc] = (f32x2){s, q};
            }
    }
};
struct EpiPS {
    static constexpr bool PERM = true, AFTER_DRAIN = false;
    bf16_t* P; bf16_t* S;
    __device__ __forceinline__ void operator()(const f32x4 (&acc)[2][2][4][2], const pg8::Unit& u, int wr, int wc, int fr, int fq) const {
        const int row0 = u.pm * 256 + wr * 64 + fr, off = (wc & 1) * 32 + 8 * fq;
        bf16_t* dst = (wc < 2 ? S : P) + u.pn * 64 + off;
#pragma unroll
        for (int ai = 0; ai < 2; ++ai)
#pragma unroll
            for (int m = 0; m < 4; ++m) {
                float o[8];
#pragma unroll
                for (int n = 0; n < 2; ++n)
#pragma unroll
                    for (int j = 0; j < 4; ++j) { const float a = acc[ai][0][m][n][j], b = acc[ai][1][m][n][j];
                        o[4 * n + j] = (wc < 2) ? silu(b) * a : a * b; }
                u32x4 w; w.x = pk2(o[0], o[1]); w.y = pk2(o[2], o[3]); w.z = pk2(o[4], o[5]); w.w = pk2(o[6], o[7]);
                *(u32x4*)(dst + (size_t)(row0 + ai * 128 + m * 16) * DM) = w;
            }
    }
};

#define XB_TMO      128
#define XB_XCNT(j)  (256  + 64 * (j))
#define XB_XSUB(j)  (1280 + 64 * (j))
#define XB_XGEN(j)  (2304 + 64 * (j))
#define XB_TOP      3328
#define XB_TOPGEN   3392
#define XCD_BAR_WORDS 3456
#define XB_SPIN_CAP (1u << 27)
__device__ __forceinline__ unsigned xb_ld(unsigned* p)              { return __hip_atomic_load(p, __ATOMIC_RELAXED, __HIP_MEMORY_SCOPE_AGENT); }
__device__ __forceinline__ unsigned xb_add(unsigned* p, unsigned v) { return __hip_atomic_fetch_add(p, v, __ATOMIC_RELAXED, __HIP_MEMORY_SCOPE_AGENT); }
__device__ __forceinline__ unsigned xb_xcc_id() { return (unsigned)__builtin_amdgcn_s_getreg((3 << 11) | 20) & 0xFu; }
#define XB_SPIN(cond, bar) do { unsigned _sp = 0; while (cond) { __builtin_amdgcn_s_sleep(1); \
    if ((++_sp & 255u) == 0u) { if (xb_ld(&(bar)[XB_TMO])) break; if (_sp > XB_SPIN_CAP) { atomicAdd(&(bar)[XB_TMO], 1u); break; } } } } while (0)
struct XcdBarrier { unsigned* bar; unsigned x; volatile LAS unsigned* st; };
__device__ __forceinline__ XcdBarrier xcd_barrier_post(unsigned* bar, volatile LAS unsigned* st) {
    XcdBarrier b; b.bar = bar; b.x = xb_xcc_id(); b.st = st;
    if (threadIdx.x == 0) (void)xb_add(&bar[XB_XCNT(b.x)], 1u);
    return b;
}
__device__ __forceinline__ void xcd_barrier_complete(unsigned* bar, unsigned x, unsigned& nloc, unsigned& nx) {
    const unsigned G = gridDim.x * gridDim.y * gridDim.z;
    unsigned sum, cnt, mine, sp = 0u;
    for (;;) {
        sum = 0u; cnt = 0u; mine = 0u;
#pragma unroll
        for (unsigned j = 0; j < 16; ++j) { const unsigned c = xb_ld(&bar[XB_XCNT(j)]); sum += c; cnt += (c > 0u) ? 1u : 0u; mine = (j == x) ? c : mine; }
        if (sum == G) break;
        __builtin_amdgcn_s_sleep(1);
        if ((++sp & 255u) == 0u) { if (xb_ld(&bar[XB_TMO])) break; if (sp > XB_SPIN_CAP) { atomicAdd(&bar[XB_TMO], 1u); break; } }
    }
    nloc = mine > 0u ? mine : 1u; nx = cnt > 0u ? cnt : 1u;
}
__device__ __forceinline__ void xcd_barrier(const XcdBarrier& b) {
    asm volatile("s_waitcnt vmcnt(0)" ::: "memory");
    __syncthreads();
    if (threadIdx.x == 0) {
        unsigned* bar = b.bar;
        __builtin_amdgcn_s_waitcnt(0);
        unsigned nloc = b.st[0], nx = b.st[1];
        if (nloc == 0u) { xcd_barrier_complete(bar, b.x, nloc, nx); b.st[0] = nloc; b.st[1] = nx; }
        const unsigned old = xb_add(&bar[XB_XSUB(b.x)], 1u);
        const unsigned gen = old / nloc;
        if (old + 1u == (gen + 1u) * nloc) {
            __builtin_amdgcn_fence(__ATOMIC_RELEASE, "agent");
            asm volatile("s_waitcnt vmcnt(0)" ::: "memory");
            const unsigned og = xb_add(&bar[XB_TOP], 1u);
            const unsigned tg = og / nx;
            if (og + 1u == (tg + 1u) * nx) xb_add(&bar[XB_TOPGEN], 1u);
            else XB_SPIN(xb_ld(&bar[XB_TOPGEN]) == tg, bar);
            __builtin_amdgcn_fence(__ATOMIC_ACQUIRE, "agent");
            xb_add(&bar[XB_XGEN(b.x)], 1u);
            asm volatile("s_waitcnt vmcnt(0)" ::: "memory");
        } else {
            XB_SPIN(xb_ld(&bar[XB_XGEN(b.x)]) == gen, bar);
            __builtin_amdgcn_fence(__ATOMIC_ACQUIRE, "agent");
            asm volatile("s_waitcnt vmcnt(0)" ::: "memory");
        }
    }
    __syncthreads();
}

struct Args {
    const float *xp, *xs, *w_in_even, *wuf, *bfw, *wub, *bbw, *ng, *sink, *relb, *w_out_even, *w_in_odd, *cw, *w_out_odd, *lng, *lnb;
    float* out; unsigned char* ws;
};
constexpr int NTHR = 512;
constexpr int LDS_BYTES = 147456, MISC_OFF = 131072 + 1024;

template <int MODE> __device__ __forceinline__ int wmap(int n, float& sc) {
    sc = 1.f;
    if (MODE == 0) return n;
    if (MODE == 1) {
        if (n < 512) sc = 0.08838834764831845f;
        if (n >= C_QB && n < C_KB) sc = 0.125f;
        if (n < 2048) return n;
        if (n < C_GD) return n + 32;
        if (n < C_GD + 32) return n - C_GD + 2048;
        return -1;
    }
    const int w = n & 255, grp = w >> 6, ch = (n >> 8) * 64 + (w & 63);
    const int base = grp == 0 ? 0 : (grp == 1 ? 1024 : (grp == 2 ? 3072 : 2048));
    return base + ch;
}
template <int MODE> __device__ __forceinline__ void wconv_item(const float* __restrict__ W, int Nsrc, bf16_t* __restrict__ Wt, int Ndst, int item, LAS float* tile, int t256) {
    const int nb = item % (Ndst / 64), kb = item / (Ndst / 64), n0 = nb * 64, k0 = kb * 64;
    const int tx = t256 & 63, ty = t256 >> 6;
    float sc; const int src = wmap<MODE>(n0 + tx, sc);
    for (int kk = ty; kk < 64; kk += 4) tile[kk * 65 + tx] = src >= 0 ? W[(size_t)(k0 + kk) * Nsrc + src] * sc : 0.f;
    __syncthreads();
    for (int nn = ty; nn < 64; nn += 4) Wt[(size_t)(n0 + nn) * 1024 + k0 + tx] = f2bf(tile[tx * 65 + nn]);
    __syncthreads();
}
__device__ __forceinline__ void phase_convert(const Args& a, LAS unsigned char* lds) {
    unsigned char* ws = a.ws;
    bf16_t* W1t = (bf16_t*)(ws + WS_W1T); bf16_t* W2t = (bf16_t*)(ws + WS_W2T); bf16_t* W3t = (bf16_t*)(ws + WS_W3T); bf16_t* W4t = (bf16_t*)(ws + WS_W4T);
    const int half = threadIdx.x >> 8, t256 = threadIdx.x & 255;
    LAS float* tile = (LAS float*)lds + half * (64 * 65);
    constexpr int I1 = (UP / 64) * 16, I2 = 16 * 16, I3 = 64 * 16, I4 = 16 * 16, NIT = I1 + I2 + I3 + I4;
    for (int it0 = blockIdx.x * 2; it0 < NIT; it0 += gridDim.x * 2) {
        int r = it0 + half;
        if (r < I1) wconv_item<1>(a.w_in_even, EVEN_IN, W1t, UP, r, tile, t256);
        else if ((r -= I1) < I2) wconv_item<0>(a.w_out_even, 1024, W2t, 1024, r, tile, t256);
        else if ((r -= I2) < I3) wconv_item<2>(a.w_in_odd, ODD_IN, W3t, 4096, r, tile, t256);
        else if ((r -= I3) < I4) wconv_item<0>(a.w_out_odd, 1024, W4t, 1024, r, tile, t256);
        else { __syncthreads(); __syncthreads(); }
    }
    bf16_t* xb = (bf16_t*)(ws + WS_XB);
    const size_t n8 = (size_t)NTOK * DM / 8;
    for (size_t i = (size_t)blockIdx.x * NTHR + threadIdx.x; i < n8; i += (size_t)gridDim.x * NTHR) {
        const size_t e = i * 8; const float* src = e < (size_t)NPROMPT * DM ? a.xp + e : a.xs + (e - (size_t)NPROMPT * DM);
        const f32x4 v0 = *(const f32x4*)src, v1 = *(const f32x4*)(src + 4);
        u32x4 w; w.x = pk2(v0[0], v0[1]); w.y = pk2(v0[2], v0[3]); w.z = pk2(v1[0], v1[1]); w.w = pk2(v1[2], v1[3]);
        *(u32x4*)(xb + e) = w;
    }
}

__device__ __forceinline__ void phase_gla_naive(const Args& a, LAS unsigned char* lds, float* OF, float* OB) {
    if (blockIdx.x >= 12) return;
    const bf16_t* U = (const bf16_t*)(a.ws + WS_U);
    const int grp = threadIdx.x >> 7, tid = threadIdx.x & 127, b = blockIdx.x * 4 + grp, dir = b & 1, h = (b >> 1) & 3, s = b >> 3;
    LAS float* sq = (LAS float*)lds + grp * (3 * 16 * 128); LAS float* sk = sq + 16 * 128; LAS float* sd = sk + 16 * 128;
    const int L = s < 2 ? LP : LS, start = s < 2 ? s * LP : NPROMPT + (s - 2) * LS;
    const float* wu = dir ? a.wub : a.wuf; const float* bias = dir ? a.bbw : a.bfw; float* O = dir ? OB : OF;
    float wr[16];
#pragma unroll
    for (int r = 0; r < 16; ++r) wr[r] = wu[r * 512 + h * 128 + tid];
    const float bb = bias[h * 128 + tid];
    float S[128];
#pragma unroll
    for (int i = 0; i < 128; ++i) S[i] = 0.f;
    for (int t0 = 0; t0 < L; t0 += 16) {
        for (int tt = 0; tt < 16; ++tt) {
            const int p = t0 + tt, tok = start + (dir ? L - 1 - p : p);
            const bf16_t* ur = U + (size_t)tok * UP;
            float x = bb;
#pragma unroll
            for (int r = 0; r < 16; ++r) x += bf2f(ur[C_GD + dir * 16 + r]) * wr[r];
            const float ls = fminf(x, 0.f) - log1pf(expf(-fabsf(x)));
            sd[tt * 128 + tid] = expf(ls * (1.0f / 16.0f));
            sq[tt * 128 + tid] = bf2f(ur[C_QA + h * 128 + tid]);
            sk[tt * 128 + tid] = bf2f(ur[C_KA + h * 128 + tid]);
        }
        __syncthreads();
        for (int tt = 0; tt < 16; ++tt) {
            const int p = t0 + tt, tok = start + (dir ? L - 1 - p : p);
            const float v = bf2f(U[(size_t)tok * UP + C_VA + h * 128 + tid]);
            float acc = 0.f;
#pragma unroll
            for (int dk = 0; dk < 128; dk += 4) {
                const f32x4 d4 = *(const LAS f32x4*)&sd[tt * 128 + dk], q4 = *(const LAS f32x4*)&sq[tt * 128 + dk], k4 = *(const LAS f32x4*)&sk[tt * 128 + dk];
#pragma unroll
                for (int j = 0; j < 4; ++j) {
                    const float sdec = S[dk + j] * d4[j];
                    const float sn = sdec + k4[j] * v;
                    acc += q4[j] * (dir ? sdec : sn);
                    S[dk + j] = sn;
                }
            }
            O[(size_t)tok * 512 + h * 128 + tid] = acc;
        }
        __syncthreads();
    }
}
__device__ __forceinline__ void phase_gla_combine(const Args& a, const float* OF, const float* OB) {
    const bf16_t* U = (const bf16_t*)(a.ws + WS_U); bf16_t* ymix = (bf16_t*)(a.ws + WS_XB);
    const int lane = threadIdx.x & 63;
    for (int w = blockIdx.x * 8 + (threadIdx.x >> 6); w < NTOK * 4; w += gridDim.x * 8) {
        const int tok = w >> 2, h = w & 3;
        const size_t o = (size_t)tok * 512 + h * 128 + lane * 2;
        const float a0 = OF[o] + OB[o], a1 = OF[o + 1] + OB[o + 1];
        const float ss = wave_sum(a0 * a0 + a1 * a1);
        const float rstd = rsqrtf(ss * (1.0f / 128.0f) + NORM_EPS);
        const bf16_t* z = U + (size_t)tok * UP + C_ZA + h * 128 + lane * 2;
        const float y0 = a0 * rstd * a.ng[lane * 2] * silu(bf2f(z[0])), y1 = a1 * rstd * a.ng[lane * 2 + 1] * silu(bf2f(z[1]));
        *(unsigned*)(ymix + (size_t)tok * DM + h * 128 + lane * 2) = pk2(y0, y1);
    }
}
__device__ __forceinline__ int t5_bucket(int rel) {
    const int n = rel < 0 ? -rel : rel;
    int b = n < 8 ? n : (n < 12 ? 8 : (n < 16 ? 9 : (n < 23 ? 10 : (n < 32 ? 11 : (n < 46 ? 12 : (n < 64 ? 13 : (n < 91 ? 14 : 15)))))));
    return b + (rel > 0 ? 16 : 0);
}
__device__ __forceinline__ void phase_swa_naive(const Args& a, LAS unsigned char* lds) {
    const bf16_t* U = (const bf16_t*)(a.ws + WS_U); bf16_t* ymix = (bf16_t*)(a.ws + WS_XB);
    const int wv = threadIdx.x >> 6, lane = threadIdx.x & 63;
    LAS float* sq = (LAS float*)(lds + 65536) + wv * 64; LAS float* sp = (LAS float*)(lds + 65536 + 2048) + wv * 320;
    for (int w = blockIdx.x * 8 + wv; w < NTOK * 8; w += gridDim.x * 8) {
        const int tok = w >> 3, hq = w & 7, kv = hq >> 2;
        int s0, L; seq_of(tok, s0, L); const int i = tok - s0;
        sq[lane] = bf2f(U[(size_t)tok * UP + C_QB + hq * 64 + lane]);
        const float snk = a.sink[hq];
        float sc[5]; float mx = snk;
#pragma unroll
        for (int c = 0; c < 5; ++c) {
            const int jj = c * 64 + lane, j = i - 128 + jj; const bool valid = jj <= 256 && j >= 0 && j < L;
            float d = -INFINITY;
            if (valid) {
                const bf16_t* kr = U + (size_t)(s0 + j) * UP + C_KB + kv * 64; d = 0.f;
#pragma unroll
                for (int e = 0; e < 64; e += 8) { const u32x4 kk = *(const u32x4*)(kr + e);
                    d += sq[e] * __uint_as_float(kk.x << 16) + sq[e + 1] * __uint_as_float(kk.x & 0xffff0000u) + sq[e + 2] * __uint_as_float(kk.y << 16) + sq[e + 3] * __uint_as_float(kk.y & 0xffff0000u)
                       + sq[e + 4] * __uint_as_float(kk.z << 16) + sq[e + 5] * __uint_as_float(kk.z & 0xffff0000u) + sq[e + 6] * __uint_as_float(kk.w << 16) + sq[e + 7] * __uint_as_float(kk.w & 0xffff0000u); }
                d += a.relb[t5_bucket(j - i) * 8 + hq];
            }
            sc[c] = d; mx = fmaxf(mx, d);
        }
        mx = wave_max(mx);
        float den = 0.f;
#pragma unroll
        for (int c = 0; c < 5; ++c) { sc[c] = sc[c] == -INFINITY ? 0.f : __expf(sc[c] - mx); den += sc[c]; }
        den = wave_sum(den) + __expf(snk - mx);
        const float inv = 1.0f / den;
#pragma unroll
        for (int c = 0; c < 5; ++c) sp[c * 64 + lane] = sc[c] * inv;
        float o = 0.f;
        for (int jj = 0; jj <= 256; ++jj) { const int j = i - 128 + jj; if (j >= 0 && j < L) o += sp[jj] * bf2f(U[(size_t)(s0 + j) * UP + C_VB + kv * 64 + lane]); }
        const float z = bf2f(U[(size_t)tok * UP + C_ZB + hq * 64 + lane]);
        ymix[(size_t)tok * DM + 512 + hq * 64 + lane] = f2bf(o * silu(z));
    }
}
template <int FINAL>
__device__ __forceinline__ void phase_ln(float* Y, const f32x2* stat, f32x2* mr, const float* lg, const float* lb, bf16_t* xb) {
    const int lane = threadIdx.x & 63;
    for (int row = blockIdx.x * 8 + (threadIdx.x >> 6); row < NTOK; row += gridDim.x * 8) {
        f32x2 p = lane < 16 ? stat[(size_t)row * 16 + lane] : (f32x2){0.f, 0.f};
        const float s = wave_sum(p.x), q = wave_sum(p.y);
        const float mean = s * (1.0f / DM), var = q * (1.0f / DM) - mean * mean, rstd = rsqrtf(fmaxf(var, 0.f) + LN_EPS);
        if (!FINAL && lane == 0) mr[row] = (f32x2){mean, rstd};
#pragma unroll
        for (int j = 0; j < 4; ++j) {
            const int c = j * 256 + lane * 4;
            const f32x4 y = *(const f32x4*)(Y + (size_t)row * DM + c), g = *(const f32x4*)(lg + c), b = *(const f32x4*)(lb + c);
            const f32x4 o = (y - mean) * rstd * g + b;
            if (FINAL) *(f32x4*)(Y + (size_t)row * DM + c) = o;
            else { u32x2 w; w.x = pk2(o[0], o[1]); w.y = pk2(o[2], o[3]); *(u32x2*)(xb + (size_t)row * DM + c) = w; }
        }
    }
}
__device__ __forceinline__ void phase_convgate(const bf16_t* P, const bf16_t* S, const float* cw, bf16_t* G) {
    const size_t n8 = (size_t)NTOK * DM / 8;
    for (size_t i = (size_t)blockIdx.x * NTHR + threadIdx.x; i < n8; i += (size_t)gridDim.x * NTHR) {
        const int row = (int)(i >> 7), c = (int)(i & 127) * 8; int s0, L; seq_of(row, s0, L);
        const bool hasl = row > s0, hasr = row < s0 + L - 1;
        const u32x4 pm = *(const u32x4*)(P + (size_t)row * DM + c), sv = *(const u32x4*)(S + (size_t)row * DM + c);
        u32x4 pl = (u32x4){0, 0, 0, 0}, pr = (u32x4){0, 0, 0, 0};
        if (hasl) pl = *(const u32x4*)(P + (size_t)(row - 1) * DM + c);
        if (hasr) pr = *(const u32x4*)(P + (size_t)(row + 1) * DM + c);
        float o[8];
#pragma unroll
        for (int j = 0; j < 4; ++j) {
            const unsigned l = pl[j], m = pm[j], r = pr[j], sw = sv[j];
            const int cc = c + 2 * j;
            o[2 * j] = __uint_as_float(sw << 16) * (cw[cc] * __uint_as_float(l << 16) + cw[1024 + cc] * __uint_as_float(m << 16) + cw[2048 + cc] * __uint_as_float(r << 16));
            o[2 * j + 1] = __uint_as_float(sw & 0xffff0000u) * (cw[cc + 1] * __uint_as_float(l & 0xffff0000u) + cw[1024 + cc + 1] * __uint_as_float(m & 0xffff0000u) + cw[2048 + cc + 1] * __uint_as_float(r & 0xffff0000u));
        }
        u32x4 w; w.x = pk2(o[0], o[1]); w.y = pk2(o[2], o[3]); w.z = pk2(o[4], o[5]); w.w = pk2(o[6], o[7]);
        *(u32x4*)(G + (size_t)row * DM + c) = w;
    }
}

__global__ void __launch_bounds__(NTHR, 2) mega(Args a) {
    extern __shared__ __attribute__((aligned(16))) unsigned char lds_raw[];
    LAS unsigned char* lds = (LAS unsigned char*)lds_raw;
    volatile LAS unsigned* MISC = (volatile LAS unsigned*)(lds + MISC_OFF);
    if (threadIdx.x < 32) MISC[threadIdx.x] = 0u;
    __syncthreads();
    unsigned char* ws = a.ws; float* out = a.out;
    XcdBarrier bar = xcd_barrier_post((unsigned*)(ws + WS_CTL) + 4096, MISC + 8);
    bf16_t* W1t = (bf16_t*)(ws + WS_W1T); bf16_t* W2t = (bf16_t*)(ws + WS_W2T); bf16_t* W3t = (bf16_t*)(ws + WS_W3T); bf16_t* W4t = (bf16_t*)(ws + WS_W4T);
    bf16_t* xb = (bf16_t*)(ws + WS_XB); bf16_t* ymix = xb; bf16_t* G = xb; bf16_t* U = (bf16_t*)(ws + WS_U);
    bf16_t* x1b = (bf16_t*)(ws + WS_X1B); bf16_t* P = (bf16_t*)(ws + WS_P); bf16_t* Sg = (bf16_t*)(ws + WS_S);
    f32x2* stat1 = (f32x2*)(ws + WS_STAT1); f32x2* stat2 = (f32x2*)(ws + WS_STAT2); f32x2* mr1 = (f32x2*)(ws + WS_MR1);
    float* OF = out; float* OB = out + (size_t)NTOK * 512;

    phase_convert(a, lds);
    xcd_barrier(bar);
    { pg8::Gemm g{xb, W1t, NTOK, UP, DM, 0}; pg8::StaticOrder S; S.init(NTOK, UP, gridDim.x, blockIdx.x); EpiU E{U}; pg8::gemm_phase<EpiU, pg8::StaticOrder>(lds, g, S, E); }
    xcd_barrier(bar);
    phase_gla_naive(a, lds, OF, OB);
    phase_swa_naive(a, lds);
    xcd_barrier(bar);
    phase_gla_combine(a, OF, OB);
    xcd_barrier(bar);
    { pg8::Gemm g{ymix, W2t, NTOK, DM, DM, 0}; pg8::StaticOrder S; S.init(NTOK, DM, gridDim.x, blockIdx.x); EpiY<0> E{a.xp, a.xs, out, stat1, nullptr, nullptr, nullptr}; pg8::gemm_phase<EpiY<0>, pg8::StaticOrder>(lds, g, S, E); }
    xcd_barrier(bar);
    phase_ln<0>(out, stat1, mr1, a.lng, a.lnb, x1b);
    xcd_barrier(bar);
    { pg8::Gemm g{x1b, W3t, NTOK, 4096, DM, 0}; pg8::StaticOrder S; S.init(NTOK, 4096, gridDim.x, blockIdx.x); EpiPS E{P, Sg}; pg8::gemm_phase<EpiPS, pg8::StaticOrder>(lds, g, S, E); }
    xcd_barrier(bar);
    phase_convgate(P, Sg, a.cw, G);
    xcd_barrier(bar);
    { pg8::Gemm g{G, W4t, NTOK, DM, DM, 0}; pg8::StaticOrder S; S.init(NTOK, DM, gridDim.x, blockIdx.x); EpiY<1> E{nullptr, nullptr, out, stat2, mr1, a.lng, a.lnb}; pg8::gemm_phase<EpiY<1>, pg8::StaticOrder>(lds, g, S, E); }
    xcd_barrier(bar);
    phase_ln<1>(out, stat2, nullptr, a.lng + DM, a.lnb + DM, nullptr);
}

extern "C" void kernel_launch(void* const* d_in, const int* in_sizes, int n_in, void* d_out, int out_size, void* d_ws, size_t ws_size, hipStream_t stream) {
    static int grid = 0;
    if (grid == 0) {
        if (n_in != 16 || out_size != NTOK * DM || ws_size < WS_END) { fprintf(stderr, "kernel_launch: unexpected shapes (n_in %d out %d ws %zu)\n", n_in, out_size, ws_size); grid = -1; return; }
        int dev = 0, cus = 0, per_cu = 0;
        if (hipGetDevice(&dev) != hipSuccess || hipDeviceGetAttribute(&cus, hipDeviceAttributeMultiprocessorCount, dev) != hipSuccess) { grid = -1; return; }
        if (hipFuncSetAttribute((const void*)mega, hipFuncAttributeMaxDynamicSharedMemorySize, LDS_BYTES) != hipSuccess) { fprintf(stderr, "kernel_launch: hipFuncSetAttribute failed\n"); grid = -1; return; }
        if (hipOccupancyMaxActiveBlocksPerMultiprocessor(&per_cu, (const void*)mega, NTHR, LDS_BYTES) != hipSuccess || per_cu < 1) { fprintf(stderr, "kernel_launch: occupancy query says %d blocks per CU\n", per_cu); (void)hipGetLastError(); grid = -1; return; }
        grid = cus;
    }
    if (grid < 0) return;
    (void)hipMemsetAsync((char*)d_ws + WS_CTL, 0, 65536, stream);
    Args a{};
    a.xp = (const float*)d_in[0]; a.xs = (const float*)d_in[1]; a.w_in_even = (const float*)d_in[2]; a.wuf = (const float*)d_in[3]; a.bfw = (const float*)d_in[4];
    a.wub = (const float*)d_in[5]; a.bbw = (const float*)d_in[6]; a.ng = (const float*)d_in[7]; a.sink = (const float*)d_in[8]; a.relb = (const float*)d_in[9];
    a.w_out_even = (const float*)d_in[10]; a.w_in_odd = (const float*)d_in[11]; a.cw = (const float*)d_in[12]; a.w_out_odd = (const float*)d_in[13];
    a.lng = (const float*)d_in[14]; a.lnb = (const float*)d_in[15]; a.out = (float*)d_out; a.ws = (unsigned char*)d_ws;
    hipLaunchKernelGGL(mega, dim3(grid), dim3(NTHR), LDS_BYTES, stream, a);
}
```

```cpp
#include <hip/hip_runtime.h>
#include <cstdio>

typedef unsigned short bf16_t;
typedef short bf16x8 __attribute__((ext_vector_type(8)));
typedef float f32x4 __attribute__((ext_vector_type(4)));
typedef float f32x2 __attribute__((ext_vector_type(2)));
typedef unsigned u32x4 __attribute__((ext_vector_type(4)));
typedef unsigned u32x2 __attribute__((ext_vector_type(2)));
#define LAS __attribute__((address_space(3)))

constexpr int DM = 1024, NTOK = 49152, NPROMPT = 32768, LP = 16384, LS = 4096;
constexpr int UP = 3584;
constexpr int C_QA = 0, C_KA = 512, C_VA = 1024, C_ZA = 1536, C_QB = 2048, C_KB = 2560, C_VB = 2688, C_ZB = 2816, C_GD = 3328;
constexpr int EVEN_IN = 3360, ODD_IN = 4096;
constexpr float DN_ALPHA = 1.41421356237309515f;
constexpr float LN_EPS = 1e-5f, NORM_EPS = 1e-6f;

constexpr size_t MiB = 1u << 20;
constexpr size_t WS_CTL = 0, WS_W1T = 1 * MiB, WS_W2T = 8 * MiB, WS_W3T = 10 * MiB, WS_W4T = 18 * MiB, WS_STAT1 = 20 * MiB, WS_MR1 = 26 * MiB, WS_DEC = 27 * MiB,
                 WS_XB = 28 * MiB  , WS_U = 124 * MiB, WS_ST = 460 * MiB, WS_END = 508 * MiB;
constexpr size_t WS_X1B = WS_U, WS_P = WS_U + 96 * MiB, WS_S = WS_U + 192 * MiB, WS_STAT2 = WS_U + 288 * MiB;

__device__ __forceinline__ float bf2f(bf16_t b) { return __uint_as_float(((unsigned)b) << 16); }
__device__ __forceinline__ bf16_t f2bf(float f) { unsigned u = __float_as_uint(f); u += 0x7fffu + ((u >> 16) & 1u); return (bf16_t)(u >> 16); }
__device__ __forceinline__ unsigned pk2(float lo, float hi) { return (unsigned)f2bf(lo) | ((unsigned)f2bf(hi) << 16); }
__device__ __forceinline__ float silu(float x) { return x / (1.0f + __expf(-x)); }
__device__ __forceinline__ float wave_sum(float v) {
#pragma unroll
    for (int o = 1; o < 64; o <<= 1) v += __shfl_xor(v, o);
    return v;
}
__device__ __forceinline__ float wave_max(float v) {
#pragma unroll
    for (int o = 1; o < 64; o <<= 1) v = fmaxf(v, __shfl_xor(v, o));
    return v;
}
__device__ __forceinline__ void seq_of(int row, int& s0, int& L) {
    if (row < NPROMPT) { L = LP; s0 = row & ~(LP - 1); } else { L = LS; s0 = NPROMPT + ((row - NPROMPT) & ~(LS - 1)); }
}

namespace pg8 {
constexpr int BM = 256, BK = 64, HALF = 128, HTB = HALF * BK * 2, STAGE_BYTES = 8 * HTB, NXCD = 8, WGM = 8;
__host__ __device__ __forceinline__ int lds_byte(int r, int c) { const int st = (r >> 4) * 2 + (c >> 5), rr = r & 15, cc = c & 31, ob = rr * 64 + cc * 2; return st * 1024 + (ob ^ (((ob >> 9) & 1) << 5)); }
__host__ __device__ __forceinline__ void stage_rc(int b, int& R, int& C) { const int st = b / 1024, sb = b % 1024, swz = sb ^ (((sb >> 9) & 1) << 5); R = (st >> 1) * 16 + swz / 64; C = (st & 1) * 32 + (swz % 64) / 2; }
__host__ __device__ __forceinline__ int perm32(int rho) { const int n = rho >> 4, i = rho & 15; return 8 * (i >> 2) + 4 * n + (i & 3); }
struct Unit { int pm, pn; };
struct Gemm { const bf16_t* A; const bf16_t* Bt; int M, N, K, pad; };
struct StaticOrder {
    int nM, nN, nwg, G, c;
    __host__ __device__ void init(int M, int N, int G_, int c_) { nM = M / BM; nN = N / BM; nwg = nM * nN; G = G_; c = c_; }
    __host__ __device__ bool next(int i, Unit& u) const {
        const long L = (long)i * G + c; if (L >= nwg) return false;
        int wgid = (int)L; { const int q = nwg / NXCD, r = nwg % NXCD, xcd = wgid % NXCD, off = wgid / NXCD; wgid = (xcd < r ? xcd * (q + 1) : r * (q + 1) + (xcd - r) * q) + off; }
        const int nig = WGM * nN, gid = wgid / nig, fm = gid * WGM, gsz = (nM - fm) < WGM ? (nM - fm) : WGM;
        u.pm = fm + ((wgid % nig) % gsz); u.pn = (wgid % nig) / gsz; return true;
    }
    __device__ __forceinline__ void a_ready(const Unit&) const {}
    __device__ __forceinline__ void done(const Unit&) const {}
};

template <class Epi, class Sched>
__device__ __forceinline__ void gemm_phase(LAS unsigned char* lds, const Gemm g, const Sched& S, const Epi& E) {
    const int tid = threadIdx.x, wid = __builtin_amdgcn_readfirstlane(tid >> 6), lane = tid & 63, wr = wid >> 2, wc = wid & 3, fr = lane & 15, fq = lane >> 4;
    const int K = g.K, nt = K / BK;
    unsigned voffA[2], voffB[2];
#pragma unroll
    for (int i = 0; i < 2; ++i) { int R, C; stage_rc(tid * 16 + i * 8192, R, C); const int Rb = Epi::PERM ? ((R & ~31) + perm32(R & 31)) : R;
        voffA[i] = (unsigned)(R * K + C) * 2u; voffB[i] = (unsigned)(Rb * K + C) * 2u; }
    const size_t kstep = (size_t)(BK * 2);
    const size_t hstep = (size_t)HALF * K * 2;
    const size_t tstep = 2 * hstep;
    const unsigned ldsw = (unsigned)wid * 1024u;
    const int aoff = lds_byte(wr * 64 + fr, fq * 8), boff = lds_byte(wc * 32 + fr, fq * 8);
#define PG8_SA(b, h) (((b) * 2 + (h)) * HTB)
#define PG8_SB(b, h) ((4 + (b) * 2 + (h)) * HTB)
#define PG8_STAGE(bufoff, gbase, voff) do { _Pragma("unroll") for (int _i = 0; _i < 2; ++_i) \
        __builtin_amdgcn_global_load_lds((const unsigned*)((const char*)(gbase) + (voff)[_i]), (LAS unsigned*)(lds + (bufoff) + ldsw + _i * 8192), 16, 0, 0); } while (0)
#define PG8_LDA(dst, b, h) do { _Pragma("unroll") for (int m = 0; m < 4; ++m) _Pragma("unroll") for (int k = 0; k < 2; ++k) dst[m][k] = *(const LAS bf16x8*)(lds + PG8_SA(b, h) + aoff + m * 2048 + k * 1024); } while (0)
#define PG8_LDB(dst, b, h) do { _Pragma("unroll") for (int n = 0; n < 2; ++n) _Pragma("unroll") for (int k = 0; k < 2; ++k) dst[n][k] = *(const LAS bf16x8*)(lds + PG8_SB(b, h) + boff + n * 2048 + k * 1024); } while (0)
#define PG8_MMA(ai, bj, At, Bt) do { __builtin_amdgcn_s_setprio(1); _Pragma("unroll") for (int m = 0; m < 4; ++m) _Pragma("unroll") for (int n = 0; n < 2; ++n) _Pragma("unroll") for (int k = 0; k < 2; ++k) \
        acc[ai][bj][m][n] = __builtin_amdgcn_mfma_f32_16x16x32_bf16(Bt[n][k], At[m][k], acc[ai][bj][m][n], 0, 0, 0); __builtin_amdgcn_s_setprio(0); } while (0)
#define PG8_WAIT_V(n) asm volatile("s_waitcnt vmcnt(" #n ")" ::: "memory")
#define PG8_WAIT_L(n) asm volatile("s_waitcnt lgkmcnt(" #n ")" ::: "memory")
#define PG8_BAR __builtin_amdgcn_s_barrier()
#define PG8_SCHED __builtin_amdgcn_sched_barrier(0)
    Unit cur, nxt; int ui = 0;
    if (!S.next(0, cur)) return;
    f32x4 acc[2][2][4][2];
#pragma unroll
    for (int a = 0; a < 2; ++a)
#pragma unroll
        for (int b = 0; b < 2; ++b)
#pragma unroll
            for (int m = 0; m < 4; ++m)
#pragma unroll
                for (int n = 0; n < 2; ++n) acc[a][b][m][n] = (f32x4){0.f, 0.f, 0.f, 0.f};
    bf16x8 At[4][2], B0[2][2], B1[2][2];
    const char* cA = (const char*)g.A + (size_t)cur.pm * tstep; const char* cB = (const char*)g.Bt + (size_t)cur.pn * tstep;
    S.a_ready(cur);
    PG8_STAGE(PG8_SB(0, 0), cB, voffB); PG8_STAGE(PG8_SA(0, 0), cA, voffA); PG8_STAGE(PG8_SB(0, 1), cB + hstep, voffB); PG8_STAGE(PG8_SA(0, 1), cA + hstep, voffA);
    if (wr == 1) PG8_BAR;
    PG8_WAIT_V(4); PG8_BAR;
    PG8_STAGE(PG8_SB(1, 0), cB + kstep, voffB); PG8_STAGE(PG8_SA(1, 0), cA + kstep, voffA); PG8_STAGE(PG8_SB(1, 1), cB + hstep + kstep, voffB);
    PG8_WAIT_V(6); PG8_BAR;
    for (;;) {
        const bool has_next = S.next(ui + 1, nxt);
        const char* nA = has_next ? (const char*)g.A + (size_t)nxt.pm * tstep : cA; const char* nB = has_next ? (const char*)g.Bt + (size_t)nxt.pn * tstep : cB;
        for (int t = 0; t < nt; t += 2) {
            const bool last = (t == nt - 2);
            const char* a1 = cA + (size_t)(t + 1) * kstep;
            const char* a2 = last ? nA : cA + (size_t)(t + 2) * kstep; const char* b2 = last ? nB : cB + (size_t)(t + 2) * kstep;
            const char* a3 = a2 + kstep; const char* b3 = b2 + kstep;
            if (last && has_next) S.a_ready(nxt);
            PG8_LDB(B0, 0, 0); PG8_SCHED; PG8_LDA(At, 0, 0); PG8_STAGE(PG8_SA(1, 1), a1 + hstep, voffA);
            PG8_WAIT_L(8); PG8_BAR; PG8_WAIT_L(0); PG8_MMA(0, 0, At, B0); PG8_BAR; PG8_SCHED;
            PG8_LDB(B1, 0, 1); PG8_STAGE(PG8_SB(0, 0), b2, voffB);
            PG8_BAR; PG8_WAIT_L(0); PG8_MMA(0, 1, At, B1); PG8_BAR;
            PG8_LDA(At, 0, 1); PG8_STAGE(PG8_SA(0, 0), a2, voffA);
            PG8_BAR; PG8_WAIT_L(0); PG8_MMA(1, 0, At, B0); PG8_BAR; PG8_SCHED;
            PG8_STAGE(PG8_SB(0, 1), b2 + hstep, voffB);
            PG8_WAIT_V(6); PG8_BAR; PG8_MMA(1, 1, At, B1); PG8_BAR;
            PG8_LDB(B0, 1, 0); PG8_SCHED; PG8_LDA(At, 1, 0); PG8_STAGE(PG8_SA(0, 1), a2 + hstep, voffA);
            PG8_WAIT_L(8); PG8_BAR; PG8_WAIT_L(0); PG8_MMA(0, 0, At, B0); PG8_BAR; PG8_SCHED;
            PG8_LDB(B1, 1, 1); PG8_STAGE(PG8_SB(1, 0), b3, voffB);
            PG8_BAR; PG8_WAIT_L(0); PG8_MMA(0, 1, At, B1); PG8_BAR;
            PG8_LDA(At, 1, 1); PG8_STAGE(PG8_SA(1, 0), a3, voffA);
            PG8_BAR; PG8_WAIT_L(0); PG8_MMA(1, 0, At, B0); PG8_BAR; PG8_SCHED;
            PG8_STAGE(PG8_SB(1, 1), b3 + hstep, voffB);
            PG8_WAIT_V(6); PG8_BAR; PG8_MMA(1, 1, At, B1); PG8_BAR;
        }
        E(acc, cur, wr, wc, fr, fq); S.done(cur);
        if (!has_next) break;
#pragma unroll
        for (int a = 0; a < 2; ++a)
#pragma unroll
            for (int b = 0; b < 2; ++b)
#pragma unroll
                for (int m = 0; m < 4; ++m)
#pragma unroll
                    for (int n = 0; n < 2; ++n) acc[a][b][m][n] = (f32x4){0.f, 0.f, 0.f, 0.f};
        cur = nxt; cA = nA; cB = nB; ++ui;
    }
    PG8_WAIT_V(0);
    if (wr == 0) PG8_BAR;
    PG8_BAR;
#undef PG8_SA
#undef PG8_SB
#undef PG8_STAGE
#undef PG8_LDA
#undef PG8_LDB
#undef PG8_MMA
#undef PG8_WAIT_V
#undef PG8_WAIT_L
#undef PG8_BAR
#undef PG8_SCHED
}
}

struct EpiU {
    static constexpr bool PERM = true, AFTER_DRAIN = false;
    bf16_t* O;
    __device__ __forceinline__ void operator()(const f32x4 (&acc)[2][2][4][2], const pg8::Unit& u, int wr, int wc, int fr, int fq) const {
        const int row0 = u.pm * 256 + wr * 64 + fr, col0 = u.pn * 256 + wc * 32 + 8 * fq;
#pragma unroll
        for (int ai = 0; ai < 2; ++ai)
#pragma unroll
            for (int m = 0; m < 4; ++m) { bf16_t* rowp = O + (size_t)(row0 + ai * 128 + m * 16) * UP + col0;
#pragma unroll
                for (int bj = 0; bj < 2; ++bj) { const f32x4 v0 = acc[ai][bj][m][0], v1 = acc[ai][bj][m][1];
                    u32x4 w; w.x = pk2(v0[0], v0[1]); w.y = pk2(v0[2], v0[3]); w.z = pk2(v1[0], v1[1]); w.w = pk2(v1[2], v1[3]);
                    *(u32x4*)(rowp + bj * 128) = w; } }
    }
};
template <int LAYER> struct EpiY {
    static constexpr bool PERM = false, AFTER_DRAIN = false;
    const float* xp; const float* xs; float* Y; f32x2* stat; const f32x2* mr; const float* lg; const float* lb;
    __device__ __forceinline__ void operator()(const f32x4 (&acc)[2][2][4][2], const pg8::Unit& u, int wr, int wc, int fr, int fq) const {
        const int col0 = u.pn * 256 + wc * 32 + 4 * fq;
        f32x4 gv[2][2], bv[2][2];
        if (LAYER == 1) {
#pragma unroll
            for (int bj = 0; bj < 2; ++bj)
#pragma unroll
                for (int n = 0; n < 2; ++n) { gv[bj][n] = *(const f32x4*)(lg + col0 + bj * 128 + n * 16); bv[bj][n] = *(const f32x4*)(lb + col0 + bj * 128 + n * 16); }
        }
#pragma unroll
        for (int ai = 0; ai < 2; ++ai)
#pragma unroll
            for (int m = 0; m < 4; ++m) {
                const int row = u.pm * 256 + ai * 128 + wr * 64 + m * 16 + fr;
                const float* rp; f32x2 mrv = (f32x2){0.f, 1.f};
                if (LAYER == 0) rp = (row < NPROMPT) ? xp + (size_t)row * DM : xs + (size_t)(row - NPROMPT) * DM;
                else { rp = Y + (size_t)row * DM; mrv = mr[row]; }
                float* yp = Y + (size_t)row * DM;
                float s = 0.f, q = 0.f;
#pragma unroll
                for (int bj = 0; bj < 2; ++bj)
#pragma unroll
                    for (int n = 0; n < 2; ++n) {
                        const int c = col0 + bj * 128 + n * 16;
                        f32x4 r = *(const f32x4*)(rp + c);
                        if (LAYER == 1) r = (r - mrv.x) * mrv.y * gv[bj][n] + bv[bj][n];
                        const f32x4 y = r * DN_ALPHA + acc[ai][bj][m][n];
                        *(f32x4*)(yp + c) = y;
                        s += (y[0] + y[1]) + (y[2] + y[3]); q += (y[0] * y[0] + y[1] * y[1]) + (y[2] * y[2] + y[3] * y[3]);
                    }
                s += __shfl_xor(s, 16); s += __shfl_xor(s, 32); q += __shfl_xor(q, 16); q += __shfl_xor(q, 32);
                if (fq == 0) stat[(size_t)row * 16 + u.pn * 4 + wc] = (f32x2){s, q};
            }
    }
};
struct EpiPS {
    static constexpr bool PERM = true, AFTER_DRAIN = false;
    bf16_t* P; bf16_t* S;
    __device__ __forceinline__ void operator()(const f32x4 (&acc)[2][2][4][2], const pg8::Unit& u, int wr, int wc, int fr, int fq) const {
        const int row0 = u.pm * 256 + wr * 64 + fr, off = (wc & 1) * 32 + 8 * fq;
        bf16_t* dst = (wc < 2 ? S : P) + u.pn * 64 + off;
#pragma unroll
        for (int ai = 0; ai < 2; ++ai)
#pragma unroll
            for (int m = 0; m < 4; ++m) {
                float o[8];
#pragma unroll
                for (int n = 0; n < 2; ++n)
#pragma unroll
                    for (int j = 0; j < 4; ++j) { const float a = acc[ai][0][m][n][j], b = acc[ai][1][m][n][j];
                        o[4 * n + j] = (wc < 2) ? silu(b) * a : a * b; }
                u32x4 w; w.x = pk2(o[0], o[1]); w.y = pk2(o[2], o[3]); w.z = pk2(o[4], o[5]); w.w = pk2(o[6], o[7]);
                *(u32x4*)(dst + (size_t)(row0 + ai * 128 + m * 16) * DM) = w;
            }
    }
};

#define XB_TMO      128
#define XB_XCNT(j)  (256  + 64 * (j))
#define XB_XSUB(j)  (1280 + 64 * (j))
#define XB_XGEN(j)  (2304 + 64 * (j))
#define XB_TOP      3328
#define XB_TOPGEN   3392
#define XCD_BAR_WORDS 3456
#define XB_SPIN_CAP (1u << 27)
__device__ __forceinline__ unsigned xb_ld(unsigned* p)              { return __hip_atomic_load(p, __ATOMIC_RELAXED, __HIP_MEMORY_SCOPE_AGENT); }
__device__ __forceinline__ unsigned xb_add(unsigned* p, unsigned v) { return __hip_atomic_fetch_add(p, v, __ATOMIC_RELAXED, __HIP_MEMORY_SCOPE_AGENT); }
__device__ __forceinline__ unsigned xb_xcc_id() { return (unsigned)__builtin_amdgcn_s_getreg((3 << 11) | 20) & 0xFu; }
#define XB_SPIN(cond, bar) do { unsigned _sp = 0; while (cond) { __builtin_amdgcn_s_sleep(1); \
    if ((++_sp & 255u) == 0u) { if (xb_ld(&(bar)[XB_TMO])) break; if (_sp > XB_SPIN_CAP) { atomicAdd(&(bar)[XB_TMO], 1u); break; } } } } while (0)
struct XcdBarrier { unsigned* bar; unsigned x; volatile LAS unsigned* st; };
__device__ __forceinline__ XcdBarrier xcd_barrier_post(unsigned* bar, volatile LAS unsigned* st) {
    XcdBarrier b; b.bar = bar; b.x = xb_xcc_id(); b.st = st;
    if (threadIdx.x == 0) (void)xb_add(&bar[XB_XCNT(b.x)], 1u);
    return b;
}
__device__ __forceinline__ void xcd_barrier_complete(unsigned* bar, unsigned x, unsigned& nloc, unsigned& nx) {
    const unsigned G = gridDim.x * gridDim.y * gridDim.z;
    unsigned sum, cnt, mine, sp = 0u;
    for (;;) {
        sum = 0u; cnt = 0u; mine = 0u;
#pragma unroll
        for (unsigned j = 0; j < 16; ++j) { const unsigned c = xb_ld(&bar[XB_XCNT(j)]); sum += c; cnt += (c > 0u) ? 1u : 0u; mine = (j == x) ? c : mine; }
        if (sum == G) break;
        __builtin_amdgcn_s_sleep(1);
        if ((++sp & 255u) == 0u) { if (xb_ld(&bar[XB_TMO])) break; if (sp > XB_SPIN_CAP) { atomicAdd(&bar[XB_TMO], 1u); break; } }
    }
    nloc = mine > 0u ? mine : 1u; nx = cnt > 0u ? cnt : 1u;
}
__device__ __forceinline__ void xcd_barrier(const XcdBarrier& b) {
    asm volatile("s_waitcnt vmcnt(0)" ::: "memory");
    __syncthreads();
    if (threadIdx.x == 0) {
        unsigned* bar = b.bar;
        __builtin_amdgcn_s_waitcnt(0);
        unsigned nloc = b.st[0], nx = b.st[1];
        if (nloc == 0u) { xcd_barrier_complete(bar, b.x, nloc, nx); b.st[0] = nloc; b.st[1] = nx; }
        const unsigned old = xb_add(&bar[XB_XSUB(b.x)], 1u);
        const unsigned gen = old / nloc;
        if (old + 1u == (gen + 1u) * nloc) {
            __builtin_amdgcn_fence(__ATOMIC_RELEASE, "agent");
            asm volatile("s_waitcnt vmcnt(0)" ::: "memory");
            const unsigned og = xb_add(&bar[XB_TOP], 1u);
            const unsigned tg = og / nx;
            if (og + 1u == (tg + 1u) * nx) xb_add(&bar[XB_TOPGEN], 1u);
            else XB_SPIN(xb_ld(&bar[XB_TOPGEN]) == tg, bar);
            __builtin_amdgcn_fence(__ATOMIC_ACQUIRE, "agent");
            xb_add(&bar[XB_XGEN(b.x)], 1u);
            asm volatile("s_waitcnt vmcnt(0)" ::: "memory");
        } else {
            XB_SPIN(xb_ld(&bar[XB_XGEN(b.x)]) == gen, bar);
            __builtin_amdgcn_fence(__ATOMIC_ACQUIRE, "agent");
            asm volatile("s_waitcnt vmcnt(0)" ::: "memory");
        }
    }
    __syncthreads();
}

struct Args {
    const float *xp, *xs, *w_in_even, *wuf, *bfw, *wub, *bbw, *ng, *sink, *relb, *w_out_even, *w_in_odd, *cw, *w_out_odd, *lng, *lnb;
    float* out; unsigned char* ws;
};
constexpr int NTHR = 512;
constexpr int LDS_BYTES = 147456, MISC_OFF = 131072 + 1024;

template <int MODE> __device__ __forceinline__ int wmap(int n, float& sc) {
    sc = 1.f;
    if (MODE == 0) return n;
    if (MODE == 1) {
        if (n < 512) sc = 0.08838834764831845f;
        if (n >= C_QB && n < C_KB) sc = 0.125f;
        if (n < 2048) return n;
        if (n < C_GD) return n + 32;
        if (n < C_GD + 32) return n - C_GD + 2048;
        return -1;
    }
    const int w = n & 255, grp = w >> 6, ch = (n >> 8) * 64 + (w & 63);
    const int base = grp == 0 ? 0 : (grp == 1 ? 1024 : (grp == 2 ? 3072 : 2048));
    return base + ch;
}
template <int MODE> __device__ __forceinline__ void wconv_item(const float* __restrict__ W, int Nsrc, bf16_t* __restrict__ Wt, int Ndst, int item, LAS float* tile, int t256) {
    const int nb = item % (Ndst / 64), kb = item / (Ndst / 64), n0 = nb * 64, k0 = kb * 64;
    const int tx = t256 & 63, ty = t256 >> 6;
    float sc; const int src = wmap<MODE>(n0 + tx, sc);
    for (int kk = ty; kk < 64; kk += 4) tile[kk * 65 + tx] = src >= 0 ? W[(size_t)(k0 + kk) * Nsrc + src] * sc : 0.f;
    __syncthreads();
    for (int nn = ty; nn < 64; nn += 4) Wt[(size_t)(n0 + nn) * 1024 + k0 + tx] = f2bf(tile[tx * 65 + nn]);
    __syncthreads();
}
__device__ __forceinline__ void phase_convert(const Args& a, LAS unsigned char* lds) {
    unsigned char* ws = a.ws;
    bf16_t* W1t = (bf16_t*)(ws + WS_W1T); bf16_t* W2t = (bf16_t*)(ws + WS_W2T); bf16_t* W3t = (bf16_t*)(ws + WS_W3T); bf16_t* W4t = (bf16_t*)(ws + WS_W4T);
    const int half = threadIdx.x >> 8, t256 = threadIdx.x & 255;
    LAS float* tile = (LAS float*)lds + half * (64 * 65);
    constexpr int I1 = (UP / 64) * 16, I2 = 16 * 16, I3 = 64 * 16, I4 = 16 * 16, NIT = I1 + I2 + I3 + I4;
    for (int it0 = blockIdx.x * 2; it0 < NIT; it0 += gridDim.x * 2) {
        int r = it0 + half;
        if (r < I1) wconv_item<1>(a.w_in_even, EVEN_IN, W1t, UP, r, tile, t256);
        else if ((r -= I1) < I2) wconv_item<0>(a.w_out_even, 1024, W2t, 1024, r, tile, t256);
        else if ((r -= I2) < I3) wconv_item<2>(a.w_in_odd, ODD_IN, W3t, 4096, r, tile, t256);
        else if ((r -= I3) < I4) wconv_item<0>(a.w_out_odd, 1024, W4t, 1024, r, tile, t256);
        else { __syncthreads(); __syncthreads(); }
    }
    bf16_t* xb = (bf16_t*)(ws + WS_XB);
    const size_t n8 = (size_t)NTOK * DM / 8;
    for (size_t i = (size_t)blockIdx.x * NTHR + threadIdx.x; i < n8; i += (size_t)gridDim.x * NTHR) {
        const size_t e = i * 8; const float* src = e < (size_t)NPROMPT * DM ? a.xp + e : a.xs + (e - (size_t)NPROMPT * DM);
        const f32x4 v0 = *(const f32x4*)src, v1 = *(const f32x4*)(src + 4);
        u32x4 w; w.x = pk2(v0[0], v0[1]); w.y = pk2(v0[2], v0[3]); w.z = pk2(v1[0], v1[1]); w.w = pk2(v1[2], v1[3]);
        *(u32x4*)(xb + e) = w;
    }
}

__device__ __forceinline__ void phase_gla_naive(const Args& a, LAS unsigned char* lds, float* OF, float* OB) {
    if (blockIdx.x >= 12) return;
    const bf16_t* U = (const bf16_t*)(a.ws + WS_U);
    const int grp = threadIdx.x >> 7, tid = threadIdx.x & 127, b = blockIdx.x * 4 + grp, dir = b & 1, h = (b >> 1) & 3, s = b >> 3;
    LAS float* sq = (LAS float*)lds + grp * (3 * 16 * 128); LAS float* sk = sq + 16 * 128; LAS float* sd = sk + 16 * 128;
    const int L = s < 2 ? LP : LS, start = s < 2 ? s * LP : NPROMPT + (s - 2) * LS;
    const float* wu = dir ? a.wub : a.wuf; const float* bias = dir ? a.bbw : a.bfw; float* O = dir ? OB : OF;
    float wr[16];
#pragma unroll
    for (int r = 0; r < 16; ++r) wr[r] = wu[r * 512 + h * 128 + tid];
    const float bb = bias[h * 128 + tid];
    float S[128];
#pragma unroll
    for (int i = 0; i < 128; ++i) S[i] = 0.f;
    for (int t0 = 0; t0 < L; t0 += 16) {
        for (int tt = 0; tt < 16; ++tt) {
            const int p = t0 + tt, tok = start + (dir ? L - 1 - p : p);
            const bf16_t* ur = U + (size_t)tok * UP;
            float x = bb;
#pragma unroll
            for (int r = 0; r < 16; ++r) x += bf2f(ur[C_GD + dir * 16 + r]) * wr[r];
            const float ls = fminf(x, 0.f) - log1pf(expf(-fabsf(x)));
            sd[tt * 128 + tid] = expf(ls * (1.0f / 16.0f));
            sq[tt * 128 + tid] = bf2f(ur[C_QA + h * 128 + tid]);
            sk[tt * 128 + tid] = bf2f(ur[C_KA + h * 128 + tid]);
        }
        __syncthreads();
        for (int tt = 0; tt < 16; ++tt) {
            const int p = t0 + tt, tok = start + (dir ? L - 1 - p : p);
            const float v = bf2f(U[(size_t)tok * UP + C_VA + h * 128 + tid]);
            float acc = 0.f;
#pragma unroll
            for (int dk = 0; dk < 128; dk += 4) {
                const f32x4 d4 = *(const LAS f32x4*)&sd[tt * 128 + dk], q4 = *(const LAS f32x4*)&sq[tt * 128 + dk], k4 = *(const LAS f32x4*)&sk[tt * 128 + dk];
#pragma unroll
                for (int j = 0; j < 4; ++j) {
                    const float sdec = S[dk + j] * d4[j];
                    const float sn = sdec + k4[j] * v;
                    acc += q4[j] * (dir ? sdec : sn);
                    S[dk + j] = sn;
                }
            }
            O[(size_t)tok * 512 + h * 128 + tid] = acc;
        }
        __syncthreads();
    }
}
__device__ __forceinline__ void phase_gla_combine(const Args& a, const float* OF, const float* OB) {
    const bf16_t* U = (const bf16_t*)(a.ws + WS_U); bf16_t* ymix = (bf16_t*)(a.ws + WS_XB);
    const int lane = threadIdx.x & 63;
    for (int w = blockIdx.x * 8 + (threadIdx.x >> 6); w < NTOK * 4; w += gridDim.x * 8) {
        const int tok = w >> 2, h = w & 3;
        const size_t o = (size_t)tok * 512 + h * 128 + lane * 2;
        const float a0 = OF[o] + OB[o], a1 = OF[o + 1] + OB[o + 1];
        const float ss = wave_sum(a0 * a0 + a1 * a1);
        const float rstd = rsqrtf(ss * (1.0f / 128.0f) + NORM_EPS);
        const bf16_t* z = U + (size_t)tok * UP + C_ZA + h * 128 + lane * 2;
        const float y0 = a0 * rstd * a.ng[lane * 2] * silu(bf2f(z[0])), y1 = a1 * rstd * a.ng[lane * 2 + 1] * silu(bf2f(z[1]));
        *(unsigned*)(ymix + (size_t)tok * DM + h * 128 + lane * 2) = pk2(y0, y1);
    }
}
__device__ __forceinline__ int t5_bucket(int rel) {
    const int n = rel < 0 ? -rel : rel;
    int b = n < 8 ? n : (n < 12 ? 8 : (n < 16 ? 9 : (n < 23 ? 10 : (n < 32 ? 11 : (n < 46 ? 12 : (n < 64 ? 13 : (n < 91 ? 14 : 15)))))));
    return b + (rel > 0 ? 16 : 0);
}
__device__ __forceinline__ void phase_swa_naive(const Args& a, LAS unsigned char* lds) {
    const bf16_t* U = (const bf16_t*)(a.ws + WS_U); bf16_t* ymix = (bf16_t*)(a.ws + WS_XB);
    const int wv = threadIdx.x >> 6, lane = threadIdx.x & 63;
    LAS float* sq = (LAS float*)(lds + 65536) + wv * 64; LAS float* sp = (LAS float*)(lds + 65536 + 2048) + wv * 320;
    for (int w = blockIdx.x * 8 + wv; w < NTOK * 8; w += gridDim.x * 8) {
        const int tok = w >> 3, hq = w & 7, kv = hq >> 2;
        int s0, L; seq_of(tok, s0, L); const int i = tok - s0;
        sq[lane] = bf2f(U[(size_t)tok * UP + C_QB + hq * 64 + lane]);
        const float snk = a.sink[hq];
        float sc[5]; float mx = snk;
#pragma unroll
        for (int c = 0; c < 5; ++c) {
            const int jj = c * 64 + lane, j = i - 128 + jj; const bool valid = jj <= 256 && j >= 0 && j < L;
            float d = -INFINITY;
            if (valid) {
                const bf16_t* kr = U + (size_t)(s0 + j) * UP + C_KB + kv * 64; d = 0.f;
#pragma unroll
                for (int e = 0; e < 64; e += 8) { const u32x4 kk = *(const u32x4*)(kr + e);
                    d += sq[e] * __uint_as_float(kk.x << 16) + sq[e + 1] * __uint_as_float(kk.x & 0xffff0000u) + sq[e + 2] * __uint_as_float(kk.y << 16) + sq[e + 3] * __uint_as_float(kk.y & 0xffff0000u)
                       + sq[e + 4] * __uint_as_float(kk.z << 16) + sq[e + 5] * __uint_as_float(kk.z & 0xffff0000u) + sq[e + 6] * __uint_as_float(kk.w << 16) + sq[e + 7] * __uint_as_float(kk.w & 0xffff0000u); }
                d += a.relb[t5_bucket(j - i) * 8 + hq];
            }
            sc[c] = d; mx = fmaxf(mx, d);
        }
        mx = wave_max(mx);
        float den = 0.f;
#pragma unroll
        for (int c = 0; c < 5; ++c) { sc[c] = sc[c] == -INFINITY ? 0.f : __expf(sc[c] - mx); den += sc[c]; }
        den = wave_sum(den) + __expf(snk - mx);
        const float inv = 1.0f / den;
#pragma unroll
        for (int c = 0; c < 5; ++c) sp[c * 64 + lane] = sc[c] * inv;
        float o = 0.f;
        for (int jj = 0; jj <= 256; ++jj) { const int j = i - 128 + jj; if (j >= 0 && j < L) o += sp[jj] * bf2f(U[(size_t)(s0 + j) * UP + C_VB + kv * 64 + lane]); }
        const float z = bf2f(U[(size_t)tok * UP + C_ZB + hq * 64 + lane]);
        ymix[(size_t)tok * DM + 512 + hq * 64 + lane] = f2bf(o * silu(z));
    }
}
template <int FINAL>
__device__ __forceinline__ void phase_ln(float* Y, const f32x2* stat, f32x2* mr, const float* lg, const float* lb, bf16_t* xb) {
    const int lane = threadIdx.x & 63;
    for (int row = blockIdx.x * 8 + (threadIdx.x >> 6); row < NTOK; row += gridDim.x * 8) {
        f32x2 p = lane < 16 ? stat[(size_t)row * 16 + lane] : (f32x2){0.f, 0.f};
        const float s = wave_sum(p.x), q = wave_sum(p.y);
        const float mean = s * (1.0f / DM), var = q * (1.0f / DM) - mean * mean, rstd = rsqrtf(fmaxf(var, 0.f) + LN_EPS);
        if (!FINAL && lane == 0) mr[row] = (f32x2){mean, rstd};
#pragma unroll
        for (int j = 0; j < 4; ++j) {
            const int c = j * 256 + lane * 4;
            const f32x4 y = *(const f32x4*)(Y + (size_t)row * DM + c), g = *(const f32x4*)(lg + c), b = *(const f32x4*)(lb + c);
            const f32x4 o = (y - mean) * rstd * g + b;
            if (FINAL) *(f32x4*)(Y + (size_t)row * DM + c) = o;
            else { u32x2 w; w.x = pk2(o[0], o[1]); w.y = pk2(o[2], o[3]); *(u32x2*)(xb + (size_t)row * DM + c) = w; }
        }
    }
}
__device__ __forceinline__ void phase_convgate(const bf16_t* P, const bf16_t* S, const float* cw, bf16_t* G) {
    const size_t n8 = (size_t)NTOK * DM / 8;
    for (size_t i = (size_t)blockIdx.x * NTHR + threadIdx.x; i < n8; i += (size_t)gridDim.x * NTHR) {
        const int row = (int)(i >> 7), c = (int)(i & 127) * 8; int s0, L; seq_of(row, s0, L);
        const bool hasl = row > s0, hasr = row < s0 + L - 1;
        const u32x4 pm = *(const u32x4*)(P + (size_t)row * DM + c), sv = *(const u32x4*)(S + (size_t)row * DM + c);
        u32x4 pl = (u32x4){0, 0, 0, 0}, pr = (u32x4){0, 0, 0, 0};
        if (hasl) pl = *(const u32x4*)(P + (size_t)(row - 1) * DM + c);
        if (hasr) pr = *(const u32x4*)(P + (size_t)(row + 1) * DM + c);
        float o[8];
#pragma unroll
        for (int j = 0; j < 4; ++j) {
            const unsigned l = pl[j], m = pm[j], r = pr[j], sw = sv[j];
            const int cc = c + 2 * j;
            o[2 * j] = __uint_as_float(sw << 16) * (cw[cc] * __uint_as_float(l << 16) + cw[1024 + cc] * __uint_as_float(m << 16) + cw[2048 + cc] * __uint_as_float(r << 16));
            o[2 * j + 1] = __uint_as_float(sw & 0xffff0000u) * (cw[cc + 1] * __uint_as_float(l & 0xffff0000u) + cw[1024 + cc + 1] * __uint_as_float(m & 0xffff0000u) + cw[2048 + cc + 1] * __uint_as_float(r & 0xffff0000u));
        }
        u32x4 w; w.x = pk2(o[0], o[1]); w.y = pk2(o[2], o[3]); w.z = pk2(o[4], o[5]); w.w = pk2(o[6], o[7]);
        *(u32x4*)(G + (size_t)row * DM + c) = w;
    }
}

typedef short s16x4 __attribute__((ext_vector_type(4)));
constexpr int GL_QT = 0, GL_KT = 16384, GL_VT = 32768, GL_PT = 49152, GL_B = 57344, GL_GD = 90112, GL_TOT = 94208, GL_EBL = 96256, GL_SSW = 96768, GL_RSTD = 98816;
constexpr int NSEG = NTOK / 256;
__device__ __forceinline__ unsigned offb(unsigned row, unsigned ch) { return 256u * row + 16u * (ch ^ (((row & 3) << 2) | ((row >> 2) & 3))); }
__device__ __forceinline__ unsigned offp(unsigned row, unsigned ch) { return 128u * row + 16u * (ch ^ (row & 7)); }
__device__ __forceinline__ unsigned rr16(unsigned lane, unsigned rb, unsigned s) { return offb((lane & 15) + 16 * rb, 4 * s + (lane >> 4)); }
__device__ __forceinline__ unsigned tr16(unsigned lane, unsigned c, unsigned ks, unsigned t) {
    const unsigned g = lane >> 4, q = (lane & 15) >> 2, p = lane & 3;
    return offb(32 * ks + 8 * g + 4 * t + q, 2 * c + (p >> 1)) + 8 * (p & 1);
}
__device__ __forceinline__ bf16x8 tr_read8(unsigned a0, unsigned a1) {
    s16x4 r0, r1;
    asm volatile("ds_read_b64_tr_b16 %0, %2\n\tds_read_b64_tr_b16 %1, %3\n\ts_waitcnt lgkmcnt(0)" : "=&v"(r0), "=&v"(r1) : "v"(a0), "v"(a1) : "memory");
    return __builtin_shufflevector(r0, r1, 0, 1, 2, 3, 4, 5, 6, 7);
}
__device__ __forceinline__ void unpack8(const u32x4 w, float (&f)[8]) {
#pragma unroll
    for (int j = 0; j < 4; ++j) { f[2 * j] = __uint_as_float(w[j] << 16); f[2 * j + 1] = __uint_as_float(w[j] & 0xffff0000u); }
}
#define MFMA16(a, b, c) __builtin_amdgcn_mfma_f32_16x16x32_bf16((a), (b), (c), 0, 0, 0)

template <int MODE>
__device__ __forceinline__ void gla_chunk(const Args& a, LAS unsigned char* lds, const int tb, const int h, const int dir, const float (&wu)[16], const float wbias,
                                          f32x4 (&Sacc)[8], float& lam, u32x4* stash) {
    const bf16_t* U = (const bf16_t*)(a.ws + WS_U);
    int tid = threadIdx.x; asm volatile("" : "+v"(tid));
    const int lane = tid & 63, w = __builtin_amdgcn_readfirstlane(tid >> 6), n = lane & 15, g = lane >> 4;
    const unsigned lb = (unsigned)(size_t)lds;
    const unsigned fn = ((n & 3) << 2) | ((n >> 2) & 3);
    const unsigned base_rr = 256u * n + 16u * (g ^ fn);
    const unsigned base_c = 256u * n + 16u * ((g >> 1) ^ fn) + 8u * (g & 1);
    const unsigned base_p = 128u * n + 16u * (g ^ (n & 7));
    const unsigned trb0 = tr16(lane, 0, 0, 0), trb1 = tr16(lane, 0, 0, 1);
    int prow[2], pch[2], ptok[2];
    u32x4 qraw[2], kraw[2];
#pragma unroll
    for (int i = 0; i < 2; ++i) {
        const int idx = tid + 512 * i; prow[i] = idx >> 4; pch[i] = idx & 15; ptok[i] = dir ? tb + 63 - prow[i] : tb + prow[i];
        const bf16_t* ur = U + (size_t)ptok[i] * UP + h * 128 + pch[i] * 8;
        const u32x4 vv = *(const u32x4*)(ur + C_VA);
        kraw[i] = *(const u32x4*)(ur + C_KA);
        if (MODE != 0) qraw[i] = *(const u32x4*)(ur + C_QA);
        *(LAS u32x4*)(lds + GL_VT + offb(prow[i], pch[i])) = vv;
    }
    if (tid < 128) {
        const int row = tid >> 1, half = tid & 1, tok = dir ? tb + 63 - row : tb + row;
        const u32x4 gw = *(const u32x4*)(U + (size_t)tok * UP + C_GD + dir * 16 + half * 8);
        float f[8]; unpack8(gw, f);
        LAS f32x4* dst = (LAS f32x4*)(lds + GL_GD + row * 64 + half * 32);
        dst[0] = (f32x4){f[0], f[1], f[2], f[3]}; dst[1] = (f32x4){f[4], f[5], f[6], f[7]};
    }
    __syncthreads();
    {
        const int dk = tid & 127, rg = tid >> 7;
        float bl[16]; float run = 0.f;
#pragma unroll
        for (int rr = 0; rr < 16; ++rr) {
            const LAS f32x4* gp = (const LAS f32x4*)(lds + GL_GD + (rg * 16 + rr) * 64);
            float x = wbias;
#pragma unroll
            for (int q4 = 0; q4 < 4; ++q4) { const f32x4 gv = gp[q4]; x += gv[0] * wu[4 * q4] + gv[1] * wu[4 * q4 + 1] + gv[2] * wu[4 * q4 + 2] + gv[3] * wu[4 * q4 + 3]; }
            const float ls = fminf(x, 0.f) - __logf(1.0f + __expf(-fabsf(x)));
            run += ls * (1.0f / 16.0f); bl[rr] = run;
        }
        LAS float* tot = (LAS float*)(lds + GL_TOT);
        tot[rg * 128 + dk] = run;
        __syncthreads();
        const float t0 = tot[dk], t1 = tot[128 + dk], t2 = tot[256 + dk], t3 = tot[384 + dk];
        const float pre = rg == 0 ? 0.f : (rg == 1 ? t0 : (rg == 2 ? t0 + t1 : t0 + t1 + t2));
        LAS float* B = (LAS float*)(lds + GL_B);
#pragma unroll
        for (int rr = 0; rr < 16; ++rr) B[(rg * 16 + rr) * 128 + dk] = pre + bl[rr];
        if (rg == 0) { const float total = (t0 + t1) + (t2 + t3); ((LAS float*)(lds + GL_EBL))[dk] = __expf(total); lam += total; }
        __syncthreads();
    }
#pragma unroll
    for (int i = 0; i < 2; ++i) {
        const LAS f32x4* bp = (const LAS f32x4*)(lds + GL_B + (prow[i] * 128 + pch[i] * 8) * 4);
        const f32x4 b0 = bp[0], b1 = bp[1];
        float e[8], kf[8];
#pragma unroll
        for (int j = 0; j < 4; ++j) { e[j] = __expf(b0[j]); e[4 + j] = __expf(b1[j]); }
        unpack8(kraw[i], kf);
        u32x4 kw;
#pragma unroll
        for (int j = 0; j < 4; ++j) kw[j] = pk2(kf[2 * j] * __builtin_amdgcn_rcpf(e[2 * j]), kf[2 * j + 1] * __builtin_amdgcn_rcpf(e[2 * j + 1]));
        *(LAS u32x4*)(lds + GL_KT + offb(prow[i], pch[i])) = kw;
        if (MODE != 0) {
            float qf[8]; unpack8(qraw[i], qf);
            u32x4 qw;
#pragma unroll
            for (int j = 0; j < 4; ++j) qw[j] = pk2(qf[2 * j] * e[2 * j], qf[2 * j + 1] * e[2 * j + 1]);
            *(LAS u32x4*)(lds + GL_QT + offb(prow[i], pch[i])) = qw;
        }
    }
    __syncthreads();
    f32x4 Oacc[4];
    if (MODE != 0) {
        const int it = w >> 1;
        bf16x8 qa[4];
#pragma unroll
        for (int s = 0; s < 4; ++s) qa[s] = *(const LAS bf16x8*)(lds + GL_QT + (base_rr ^ (64u * s)) + 4096u * it);
#pragma unroll
        for (int jj = 0; jj < 2; ++jj) {
            const int jt = 2 * (w & 1) + jj;
            f32x4 pacc = (f32x4){0.f, 0.f, 0.f, 0.f};
            if (jt <= it) {
#pragma unroll
                for (int s = 0; s < 4; ++s) { const bf16x8 kb = *(const LAS bf16x8*)(lds + GL_KT + (base_rr ^ (64u * s)) + 4096u * jt); pacc = MFMA16(qa[s], kb, pacc); }
            }
            const int j = 16 * jt + n;
#pragma unroll
            for (int r = 0; r < 4; ++r) {
                const int i = 16 * it + 4 * g + r;
                const bool keep = (MODE == 1) ? (j <= i) : (j < i);
                *(LAS bf16_t*)(lds + GL_PT + offp(i, j >> 3) + 2 * (j & 7)) = keep ? f2bf(pacc[r]) : (bf16_t)0;
            }
        }
        bf16x8 sb[4];
#pragma unroll
        for (int ks = 0; ks < 4; ++ks) {
            u32x4 pw; pw.x = pk2(Sacc[2 * ks][0], Sacc[2 * ks][1]); pw.y = pk2(Sacc[2 * ks][2], Sacc[2 * ks][3]); pw.z = pk2(Sacc[2 * ks + 1][0], Sacc[2 * ks + 1][1]); pw.w = pk2(Sacc[2 * ks + 1][2], Sacc[2 * ks + 1][3]);
            sb[ks] = __builtin_bit_cast(bf16x8, pw);
        }
#pragma unroll
        for (int i2 = 0; i2 < 4; ++i2) {
            Oacc[i2] = (f32x4){0.f, 0.f, 0.f, 0.f};
#pragma unroll
            for (int ks = 0; ks < 4; ++ks) {
                const unsigned alo = base_c ^ (64u * ks);
                const u32x2 lo = *(const LAS u32x2*)(lds + GL_QT + 4096 * i2 + alo);
                const u32x2 hi = *(const LAS u32x2*)(lds + GL_QT + 4096 * i2 + (alo ^ 32u));
                u32x4 aw; aw.x = lo.x; aw.y = lo.y; aw.z = hi.x; aw.w = hi.y;
                Oacc[i2] = MFMA16(__builtin_bit_cast(bf16x8, aw), sb[ks], Oacc[i2]);
            }
        }
        __syncthreads();
    }
    bf16x8 vf[2];
#pragma unroll
    for (int ks = 0; ks < 2; ++ks) vf[ks] = tr_read8(lb + GL_VT + 8192u * ks + (trb0 ^ (32u * w)), lb + GL_VT + 8192u * ks + (trb1 ^ (32u * w)));
    if (MODE != 0) {
#pragma unroll
        for (int i2 = 0; i2 < 4; ++i2)
#pragma unroll
            for (int ks = 0; ks < 2; ++ks) {
                if (ks <= (i2 >> 1)) { const bf16x8 pa = *(const LAS bf16x8*)(lds + GL_PT + 2048 * i2 + (base_p ^ (64u * ks))); Oacc[i2] = MFMA16(pa, vf[ks], Oacc[i2]); }
            }
    }
#pragma unroll
    for (int kt = 0; kt < 8; ++kt) {
#pragma unroll
        for (int ks = 0; ks < 2; ++ks) { const bf16x8 ka = tr_read8(lb + GL_KT + 8192u * ks + (trb0 ^ (32u * kt)), lb + GL_KT + 8192u * ks + (trb1 ^ (32u * kt))); Sacc[kt] = MFMA16(ka, vf[ks], Sacc[kt]); }
        const f32x4 eb = *(const LAS f32x4*)(lds + GL_EBL + (16 * kt + 4 * g) * 4);
        Sacc[kt] = Sacc[kt] * eb;
    }
    if (MODE == 1) {
        u32x4 s0, s1;
        s0.x = pk2(Oacc[3][3], Oacc[3][2]); s0.y = pk2(Oacc[3][1], Oacc[3][0]); s0.z = pk2(Oacc[2][3], Oacc[2][2]); s0.w = pk2(Oacc[2][1], Oacc[2][0]);
        s1.x = pk2(Oacc[1][3], Oacc[1][2]); s1.y = pk2(Oacc[1][1], Oacc[1][0]); s1.z = pk2(Oacc[0][3], Oacc[0][2]); s1.w = pk2(Oacc[0][1], Oacc[0][0]);
        const int tidm = tid ^ 48;
        stash[tidm * 2] = s0; stash[tidm * 2 + 1] = s1;
    }
    if (MODE == 2) {
        const u32x4 s0 = stash[tid * 2], s1 = stash[tid * 2 + 1];
        float fo[16]; { float t8[8]; unpack8(s0, t8);
#pragma unroll
            for (int j = 0; j < 8; ++j) fo[j] = t8[j]; unpack8(s1, t8);
#pragma unroll
            for (int j = 0; j < 8; ++j) fo[8 + j] = t8[j]; }
        LAS float* ssw = (LAS float*)(lds + GL_SSW);
#pragma unroll
        for (int i2 = 0; i2 < 4; ++i2)
#pragma unroll
            for (int r = 0; r < 4; ++r) {
                const float o = Oacc[i2][r] + fo[4 * i2 + r]; Oacc[i2][r] = o;
                float v = o * o; v += __shfl_xor(v, 1); v += __shfl_xor(v, 2); v += __shfl_xor(v, 4); v += __shfl_xor(v, 8);
                if (n == 0) ssw[w * 64 + 16 * i2 + 4 * g + r] = v;
            }
        __syncthreads();
        if (tid < 64) { float s = 0.f;
#pragma unroll
            for (int ww = 0; ww < 8; ++ww) s += ssw[ww * 64 + tid];
            ((LAS float*)(lds + GL_RSTD))[tid] = rsqrtf(s * (1.0f / 128.0f) + NORM_EPS); }
        __syncthreads();
        const float gn = a.ng[16 * w + n];
#pragma unroll
        for (int i2 = 0; i2 < 4; ++i2) {
            const f32x4 rs = *(const LAS f32x4*)(lds + GL_RSTD + (16 * i2 + 4 * g) * 4);
#pragma unroll
            for (int r = 0; r < 4; ++r) *(LAS bf16_t*)(lds + GL_QT + (16 * i2 + 4 * g + r) * 256 + (16 * w + n) * 2) = f2bf(Oacc[i2][r] * rs[r] * gn);
        }
        __syncthreads();
        bf16_t* ymix = (bf16_t*)(a.ws + WS_XB);
#pragma unroll
        for (int i = 0; i < 2; ++i) {
            const u32x4 ov = *(const LAS u32x4*)(lds + GL_QT + prow[i] * 256 + pch[i] * 16);
            const u32x4 zv = *(const u32x4*)(U + (size_t)ptok[i] * UP + C_ZA + h * 128 + pch[i] * 8);
            float of[8], zf[8]; unpack8(ov, of); unpack8(zv, zf);
            u32x4 yw;
#pragma unroll
            for (int j = 0; j < 4; ++j) yw[j] = pk2(of[2 * j] * silu(zf[2 * j]), of[2 * j + 1] * silu(zf[2 * j + 1]));
            *(u32x4*)(ymix + (size_t)ptok[i] * DM + h * 128 + pch[i] * 8) = yw;
        }
    }
    __syncthreads();
}
__device__ __forceinline__ void gla_load_gate(const Args& a, int h, int dir, float (&wu)[16], float& wbias) {
    const float* wup = dir ? a.wub : a.wuf; const float* bias = dir ? a.bbw : a.bfw; const int dk = threadIdx.x & 127;
#pragma unroll
    for (int r = 0; r < 16; ++r) wu[r] = wup[r * 512 + h * 128 + dk];
    wbias = bias[h * 128 + dk];
}
__device__ __forceinline__ void phase_gla_pass1(const Args& a, LAS unsigned char* lds) {
    const int tid = threadIdx.x, w = tid >> 6, lane = tid & 63;
    unsigned char* ST = a.ws + WS_ST;
    for (int item = blockIdx.x; item < NSEG * 8; item += gridDim.x) {
        const int dir = item & 1, h = (item >> 1) & 3, seg = item >> 3;
        float wu[16], wbias; gla_load_gate(a, h, dir, wu, wbias);
        f32x4 Sacc[8];
#pragma unroll
        for (int kt = 0; kt < 8; ++kt) Sacc[kt] = (f32x4){0.f, 0.f, 0.f, 0.f};
        float lam = 0.f;
        for (int cc = 0; cc < 4; ++cc) { const int c = dir ? 3 - cc : cc; gla_chunk<0>(a, lds, seg * 256 + c * 64, h, dir, wu, wbias, Sacc, lam, nullptr); }
        u32x2* dst = (u32x2*)(ST + (size_t)item * 32768) + (size_t)w * 8 * 64 + lane;
#pragma unroll
        for (int kt = 0; kt < 8; ++kt) { u32x2 v; v.x = pk2(Sacc[kt][0], Sacc[kt][1]); v.y = pk2(Sacc[kt][2], Sacc[kt][3]); dst[kt * 64] = v; }
        if (tid < 128) ((float*)(a.ws + WS_DEC))[(size_t)item * 128 + tid] = lam;
    }
}
__device__ __forceinline__ void phase_gla_pass2(const Args& a) {
    unsigned char* ST = a.ws + WS_ST; const float* DEC = (const float*)(a.ws + WS_DEC);
    for (int gidx = blockIdx.x * NTHR + threadIdx.x; gidx < 48 * 4096; gidx += gridDim.x * NTHR) {
        const int chain = gidx >> 12, quad = gidx & 4095, dir = chain & 1, h = (chain >> 1) & 3, s = chain >> 3;
        const int nseg = s < 2 ? LP / 256 : LS / 256, seg0 = s < 2 ? s * (LP / 256) : 2 * (LP / 256) + (s - 2) * (LS / 256);
        const int kt = (quad >> 6) & 7, lane = quad & 63, dk0 = 16 * kt + 4 * (lane >> 4);
        f32x4 S = (f32x4){0.f, 0.f, 0.f, 0.f};
        for (int i0 = 0; i0 < nseg; i0 += 8) {
            u32x2 t[8]; f32x4 lm[8];
#pragma unroll
            for (int j = 0; j < 8; ++j) { const int seg = dir ? seg0 + nseg - 1 - (i0 + j) : seg0 + i0 + j; const size_t idx = (size_t)((seg * 4 + h) * 2 + dir);
                t[j] = ((const u32x2*)(ST + idx * 32768))[quad]; lm[j] = *(const f32x4*)(DEC + idx * 128 + dk0); }
#pragma unroll
            for (int j = 0; j < 8; ++j) { const int seg = dir ? seg0 + nseg - 1 - (i0 + j) : seg0 + i0 + j; const size_t idx = (size_t)((seg * 4 + h) * 2 + dir);
                u32x2 o; o.x = pk2(S[0], S[1]); o.y = pk2(S[2], S[3]); ((u32x2*)(ST + idx * 32768))[quad] = o;
                const f32x4 tv = (f32x4){__uint_as_float(t[j].x << 16), __uint_as_float(t[j].x & 0xffff0000u), __uint_as_float(t[j].y << 16), __uint_as_float(t[j].y & 0xffff0000u)};
                S = (f32x4){__expf(lm[j][0]), __expf(lm[j][1]), __expf(lm[j][2]), __expf(lm[j][3])} * S + tv; }
        }
    }
}
__device__ __forceinline__ void phase_gla_pass3(const Args& a, LAS unsigned char* lds) {
    const int tid = threadIdx.x, w = tid >> 6, lane = tid & 63;
    const unsigned char* ST = a.ws + WS_ST;
    for (int item = blockIdx.x; item < NSEG * 4; item += gridDim.x) {
        const int h = item & 3, seg = item >> 2;
        u32x4* stash = (u32x4*)a.out + (size_t)item * 4 * 1024;
#pragma unroll 1
        for (int dir = 0; dir < 2; ++dir) {
            float wu[16], wbias; gla_load_gate(a, h, dir, wu, wbias);
            f32x4 Sacc[8];
            const u32x2* src = (const u32x2*)(ST + (size_t)((seg * 4 + h) * 2 + dir) * 32768) + (size_t)w * 8 * 64 + lane;
#pragma unroll
            for (int kt = 0; kt < 8; ++kt) { const u32x2 v = src[kt * 64]; Sacc[kt] = (f32x4){__uint_as_float(v.x << 16), __uint_as_float(v.x & 0xffff0000u), __uint_as_float(v.y << 16), __uint_as_float(v.y & 0xffff0000u)}; }
            float lam = 0.f;
            if (dir == 0) { for (int c = 0; c < 4; ++c) gla_chunk<1>(a, lds, seg * 256 + c * 64, h, 0, wu, wbias, Sacc, lam, stash + c * 1024); }
            else { for (int c = 3; c >= 0; --c) gla_chunk<2>(a, lds, seg * 256 + c * 64, h, 1, wu, wbias, Sacc, lam, stash + c * 1024); }
        }
    }
}

__global__ void __launch_bounds__(NTHR, 2) mega(Args a) {
    extern __shared__ __attribute__((aligned(16))) unsigned char lds_raw[];
    LAS unsigned char* lds = (LAS unsigned char*)lds_raw;
    volatile LAS unsigned* MISC = (volatile LAS unsigned*)(lds + MISC_OFF);
    if (threadIdx.x < 32) MISC[threadIdx.x] = 0u;
    __syncthreads();
    unsigned char* ws = a.ws; float* out = a.out;
    XcdBarrier bar = xcd_barrier_post((unsigned*)(ws + WS_CTL) + 4096, MISC + 8);
    bf16_t* W1t = (bf16_t*)(ws + WS_W1T); bf16_t* W2t = (bf16_t*)(ws + WS_W2T); bf16_t* W3t = (bf16_t*)(ws + WS_W3T); bf16_t* W4t = (bf16_t*)(ws + WS_W4T);
    bf16_t* xb = (bf16_t*)(ws + WS_XB); bf16_t* ymix = xb; bf16_t* G = xb; bf16_t* U = (bf16_t*)(ws + WS_U);
    bf16_t* x1b = (bf16_t*)(ws + WS_X1B); bf16_t* P = (bf16_t*)(ws + WS_P); bf16_t* Sg = (bf16_t*)(ws + WS_S);
    f32x2* stat1 = (f32x2*)(ws + WS_STAT1); f32x2* stat2 = (f32x2*)(ws + WS_STAT2); f32x2* mr1 = (f32x2*)(ws + WS_MR1);
    float* OF = out; float* OB = out + (size_t)NTOK * 512;

    phase_convert(a, lds);
    xcd_barrier(bar);
    { pg8::Gemm g{xb, W1t, NTOK, UP, DM, 0}; pg8::StaticOrder S; S.init(NTOK, UP, gridDim.x, blockIdx.x); EpiU E{U}; pg8::gemm_phase<EpiU, pg8::StaticOrder>(lds, g, S, E); }
    xcd_barrier(bar);
    phase_gla_pass1(a, lds);
    xcd_barrier(bar);
    phase_gla_pass2(a);
    phase_swa_naive(a, lds);
    xcd_barrier(bar);
    phase_gla_pass3(a, lds);
    xcd_barrier(bar);
    { pg8::Gemm g{ymix, W2t, NTOK, DM, DM, 0}; pg8::StaticOrder S; S.init(NTOK, DM, gridDim.x, blockIdx.x); EpiY<0> E{a.xp, a.xs, out, stat1, nullptr, nullptr, nullptr}; pg8::gemm_phase<EpiY<0>, pg8::StaticOrder>(lds, g, S, E); }
    xcd_barrier(bar);
    phase_ln<0>(out, stat1, mr1, a.lng, a.lnb, x1b);
    xcd_barrier(bar);
    { pg8::Gemm g{x1b, W3t, NTOK, 4096, DM, 0}; pg8::StaticOrder S; S.init(NTOK, 4096, gridDim.x, blockIdx.x); EpiPS E{P, Sg}; pg8::gemm_phase<EpiPS, pg8::StaticOrder>(lds, g, S, E); }
    xcd_barrier(bar);
    phase_convgate(P, Sg, a.cw, G);
    xcd_barrier(bar);
    { pg8::Gemm g{G, W4t, NTOK, DM, DM, 0}; pg8::StaticOrder S; S.init(NTOK, DM, gridDim.x, blockIdx.x); EpiY<1> E{nullptr, nullptr, out, stat2, mr1, a.lng, a.lnb}; pg8::gemm_phase<EpiY<1>, pg8::StaticOrder>(lds, g, S, E); }
    xcd_barrier(bar);
    phase_ln<1>(out, stat2, nullptr, a.lng + DM, a.lnb + DM, nullptr);
}

extern "C" void kernel_launch(void* const* d_in, const int* in_sizes, int n_in, void* d_out, int out_size, void* d_ws, size_t ws_size, hipStream_t stream) {
    static int grid = 0;
    if (grid == 0) {
        if (n_in != 16 || out_size != NTOK * DM || ws_size < WS_END) { fprintf(stderr, "kernel_launch: unexpected shapes (n_in %d out %d ws %zu)\n", n_in, out_size, ws_size); grid = -1; return; }
        int dev = 0, cus = 0, per_cu = 0;
        if (hipGetDevice(&dev) != hipSuccess || hipDeviceGetAttribute(&cus, hipDeviceAttributeMultiprocessorCount, dev) != hipSuccess) { grid = -1; return; }
        if (hipFuncSetAttribute((const void*)mega, hipFuncAttributeMaxDynamicSharedMemorySize, LDS_BYTES) != hipSuccess) { fprintf(stderr, "kernel_launch: hipFuncSetAttribute failed\n"); grid = -1; return; }
        if (hipOccupancyMaxActiveBlocksPerMultiprocessor(&per_cu, (const void*)mega, NTHR, LDS_BYTES) != hipSuccess || per_cu < 1) { fprintf(stderr, "kernel_launch: occupancy query says %d blocks per CU\n", per_cu); (void)hipGetLastError(); grid = -1; return; }
        grid = cus;
    }
    if (grid < 0) return;
    (void)hipMemsetAsync((char*)d_ws + WS_CTL, 0, 65536, stream);
    Args a{};
    a.xp = (const float*)d_in[0]; a.xs = (const float*)d_in[1]; a.w_in_even = (const float*)d_in[2]; a.wuf = (const float*)d_in[3]; a.bfw = (const float*)d_in[4];
    a.wub = (const float*)d_in[5]; a.bbw = (const float*)d_in[6]; a.ng = (const float*)d_in[7]; a.sink = (const float*)d_in[8]; a.relb = (const float*)d_in[9];
    a.w_out_even = (const float*)d_in[10]; a.w_in_odd = (const float*)d_in[11]; a.cw = (const float*)d_in[12]; a.w_out_odd = (const float*)d_in[13];
    a.lng = (const float*)d_in[14]; a.lnb = (const float*)d_in[15]; a.out = (float*)d_out; a.ws = (unsigned char*)d_ws;
    hipLaunchKernelGGL(mega, dim3(grid), dim3(NTHR), LDS_BYTES, stream, a);
}
```

```cpp
#include <hip/hip_runtime.h>
#include <cstdio>

typedef unsigned short bf16_t;
typedef short bf16x8 __attribute__((ext_vector_type(8)));
typedef float f32x4 __attribute__((ext_vector_type(4)));
typedef float f32x2 __attribute__((ext_vector_type(2)));
typedef unsigned u32x4 __attribute__((ext_vector_type(4)));
typedef unsigned u32x2 __attribute__((ext_vector_type(2)));
#define LAS __attribute__((address_space(3)))

constexpr int DM = 1024, NTOK = 49152, NPROMPT = 32768, LP = 16384, LS = 4096;
constexpr int UP = 3584;
constexpr int C_QA = 0, C_KA = 512, C_VA = 1024, C_ZA = 1536, C_QB = 2048, C_KB = 2560, C_VB = 2688, C_ZB = 2816, C_GD = 3328;
constexpr int EVEN_IN = 3360, ODD_IN = 4096;
constexpr float DN_ALPHA = 1.41421356237309515f;
constexpr float LN_EPS = 1e-5f, NORM_EPS = 1e-6f;

constexpr size_t MiB = 1u << 20;
constexpr size_t WS_CTL = 0, WS_W1T = 1 * MiB, WS_W2T = 8 * MiB, WS_W3T = 10 * MiB, WS_W4T = 18 * MiB, WS_STAT1 = 20 * MiB, WS_MR1 = 26 * MiB, WS_DEC = 27 * MiB,
                 WS_XB = 28 * MiB  , WS_U = 124 * MiB, WS_ST = 460 * MiB, WS_END = 508 * MiB;
constexpr size_t WS_X1B = WS_U, WS_P = WS_U + 96 * MiB, WS_S = WS_U + 192 * MiB, WS_STAT2 = WS_U + 288 * MiB;

__device__ __forceinline__ float bf2f(bf16_t b) { return __uint_as_float(((unsigned)b) << 16); }
__device__ __forceinline__ bf16_t f2bf(float f) { unsigned u = __float_as_uint(f); u += 0x7fffu + ((u >> 16) & 1u); return (bf16_t)(u >> 16); }
__device__ __forceinline__ unsigned pk2(float lo, float hi) { return (unsigned)f2bf(lo) | ((unsigned)f2bf(hi) << 16); }
__device__ __forceinline__ float silu(float x) { return x / (1.0f + __expf(-x)); }
__device__ __forceinline__ float wave_sum(float v) {
#pragma unroll
    for (int o = 1; o < 64; o <<= 1) v += __shfl_xor(v, o);
    return v;
}
__device__ __forceinline__ float wave_max(float v) {
#pragma unroll
    for (int o = 1; o < 64; o <<= 1) v = fmaxf(v, __shfl_xor(v, o));
    return v;
}
__device__ __forceinline__ void seq_of(int row, int& s0, int& L) {
    if (row < NPROMPT) { L = LP; s0 = row & ~(LP - 1); } else { L = LS; s0 = NPROMPT + ((row - NPROMPT) & ~(LS - 1)); }
}

namespace pg8 {
constexpr int BM = 256, BK = 64, HALF = 128, HTB = HALF * BK * 2, STAGE_BYTES = 8 * HTB, NXCD = 8, WGM = 8;
__host__ __device__ __forceinline__ int lds_byte(int r, int c) { const int st = (r >> 4) * 2 + (c >> 5), rr = r & 15, cc = c & 31, ob = rr * 64 + cc * 2; return st * 1024 + (ob ^ (((ob >> 9) & 1) << 5)); }
__host__ __device__ __forceinline__ void stage_rc(int b, int& R, int& C) { const int st = b / 1024, sb = b % 1024, swz = sb ^ (((sb >> 9) & 1) << 5); R = (st >> 1) * 16 + swz / 64; C = (st & 1) * 32 + (swz % 64) / 2; }
__host__ __device__ __forceinline__ int perm32(int rho) { const int n = rho >> 4, i = rho & 15; return 8 * (i >> 2) + 4 * n + (i & 3); }
struct Unit { int pm, pn; };
struct Gemm { const bf16_t* A; const bf16_t* Bt; int M, N, K, pad; };
struct StaticOrder {
    int nM, nN, nwg, G, c;
    __host__ __device__ void init(int M, int N, int G_, int c_) { nM = M / BM; nN = N / BM; nwg = nM * nN; G = G_; c = c_; }
    __host__ __device__ bool next(int i, Unit& u) const {
        const long L = (long)i * G + c; if (L >= nwg) return false;
        int wgid = (int)L; { const int q = nwg / NXCD, r = nwg % NXCD, xcd = wgid % NXCD, off = wgid / NXCD; wgid = (xcd < r ? xcd * (q + 1) : r * (q + 1) + (xcd - r) * q) + off; }
        const int nig = WGM * nN, gid = wgid / nig, fm = gid * WGM, gsz = (nM - fm) < WGM ? (nM - fm) : WGM;
        u.pm = fm + ((wgid % nig) % gsz); u.pn = (wgid % nig) / gsz; return true;
    }
    __device__ __forceinline__ void a_ready(const Unit&) const {}
    __device__ __forceinline__ void done(const Unit&) const {}
};

template <class Epi, class Sched>
__device__ __forceinline__ void gemm_phase(LAS unsigned char* lds, const Gemm g, const Sched& S, const Epi& E) {
    const int tid = threadIdx.x, wid = __builtin_amdgcn_readfirstlane(tid >> 6), lane = tid & 63, wr = wid >> 2, wc = wid & 3, fr = lane & 15, fq = lane >> 4;
    const int K = g.K, nt = K / BK;
    unsigned voffA[2], voffB[2];
#pragma unroll
    for (int i = 0; i < 2; ++i) { int R, C; stage_rc(tid * 16 + i * 8192, R, C); const int Rb = Epi::PERM ? ((R & ~31) + perm32(R & 31)) : R;
        voffA[i] = (unsigned)(R * K + C) * 2u; voffB[i] = (unsigned)(Rb * K + C) * 2u; }
    const size_t kstep = (size_t)(BK * 2);
    const size_t hstep = (size_t)HALF * K * 2;
    const size_t tstep = 2 * hstep;
    const unsigned ldsw = (unsigned)wid * 1024u;
    const int aoff = lds_byte(wr * 64 + fr, fq * 8), boff = lds_byte(wc * 32 + fr, fq * 8);
#define PG8_SA(b, h) (((b) * 2 + (h)) * HTB)
#define PG8_SB(b, h) ((4 + (b) * 2 + (h)) * HTB)
#define PG8_STAGE(bufoff, gbase, voff) do { _Pragma("unroll") for (int _i = 0; _i < 2; ++_i) \
        __builtin_amdgcn_global_load_lds((const unsigned*)((const char*)(gbase) + (voff)[_i]), (LAS unsigned*)(lds + (bufoff) + ldsw + _i * 8192), 16, 0, 0); } while (0)
#define PG8_LDA(dst, b, h) do { _Pragma("unroll") for (int m = 0; m < 4; ++m) _Pragma("unroll") for (int k = 0; k < 2; ++k) dst[m][k] = *(const LAS bf16x8*)(lds + PG8_SA(b, h) + aoff + m * 2048 + k * 1024); } while (0)
#define PG8_LDB(dst, b, h) do { _Pragma("unroll") for (int n = 0; n < 2; ++n) _Pragma("unroll") for (int k = 0; k < 2; ++k) dst[n][k] = *(const LAS bf16x8*)(lds + PG8_SB(b, h) + boff + n * 2048 + k * 1024); } while (0)
#define PG8_MMA(ai, bj, At, Bt) do { __builtin_amdgcn_s_setprio(1); _Pragma("unroll") for (int m = 0; m < 4; ++m) _Pragma("unroll") for (int n = 0; n < 2; ++n) _Pragma("unroll") for (int k = 0; k < 2; ++k) \
        acc[ai][bj][m][n] = __builtin_amdgcn_mfma_f32_16x16x32_bf16(Bt[n][k], At[m][k], acc[ai][bj][m][n], 0, 0, 0); __builtin_amdgcn_s_setprio(0); } while (0)
#define PG8_WAIT_V(n) asm volatile("s_waitcnt vmcnt(" #n ")" ::: "memory")
#define PG8_WAIT_L(n) asm volatile("s_waitcnt lgkmcnt(" #n ")" ::: "memory")
#define PG8_BAR __builtin_amdgcn_s_barrier()
#define PG8_SCHED __builtin_amdgcn_sched_barrier(0)
    Unit cur, nxt; int ui = 0;
    if (!S.next(0, cur)) return;
    f32x4 acc[2][2][4][2];
#pragma unroll
    for (int a = 0; a < 2; ++a)
#pragma unroll
        for (int b = 0; b < 2; ++b)
#pragma unroll
            for (int m = 0; m < 4; ++m)
#pragma unroll
                for (int n = 0; n < 2; ++n) acc[a][b][m][n] = (f32x4){0.f, 0.f, 0.f, 0.f};
    bf16x8 At[4][2], B0[2][2], B1[2][2];
    const char* cA = (const char*)g.A + (size_t)cur.pm * tstep; const char* cB = (const char*)g.Bt + (size_t)cur.pn * tstep;
    S.a_ready(cur);
    PG8_STAGE(PG8_SB(0, 0), cB, voffB); PG8_STAGE(PG8_SA(0, 0), cA, voffA); PG8_STAGE(PG8_SB(0, 1), cB + hstep, voffB); PG8_STAGE(PG8_SA(0, 1), cA + hstep, voffA);
    if (wr == 1) PG8_BAR;
    PG8_WAIT_V(4); PG8_BAR;
    PG8_STAGE(PG8_SB(1, 0), cB + kstep, voffB); PG8_STAGE(PG8_SA(1, 0), cA + kstep, voffA); PG8_STAGE(PG8_SB(1, 1), cB + hstep + kstep, voffB);
    PG8_WAIT_V(6); PG8_BAR;
    for (;;) {
        const bool has_next = S.next(ui + 1, nxt);
        const char* nA = has_next ? (const char*)g.A + (size_t)nxt.pm * tstep : cA; const char* nB = has_next ? (const char*)g.Bt + (size_t)nxt.pn * tstep : cB;
        for (int t = 0; t < nt; t += 2) {
            const bool last = (t == nt - 2);
            const char* a1 = cA + (size_t)(t + 1) * kstep;
            const char* a2 = last ? nA : cA + (size_t)(t + 2) * kstep; const char* b2 = last ? nB : cB + (size_t)(t + 2) * kstep;
            const char* a3 = a2 + kstep; const char* b3 = b2 + kstep;
            if (last && has_next) S.a_ready(nxt);
            PG8_LDB(B0, 0, 0); PG8_SCHED; PG8_LDA(At, 0, 0); PG8_STAGE(PG8_SA(1, 1), a1 + hstep, voffA);
            PG8_WAIT_L(8); PG8_BAR; PG8_WAIT_L(0); PG8_MMA(0, 0, At, B0); PG8_BAR; PG8_SCHED;
            PG8_LDB(B1, 0, 1); PG8_STAGE(PG8_SB(0, 0), b2, voffB);
            PG8_BAR; PG8_WAIT_L(0); PG8_MMA(0, 1, At, B1); PG8_BAR;
            PG8_LDA(At, 0, 1); PG8_STAGE(PG8_SA(0, 0), a2, voffA);
            PG8_BAR; PG8_WAIT_L(0); PG8_MMA(1, 0, At, B0); PG8_BAR; PG8_SCHED;
            PG8_STAGE(PG8_SB(0, 1), b2 + hstep, voffB);
            PG8_WAIT_V(6); PG8_BAR; PG8_MMA(1, 1, At, B1); PG8_BAR;
            PG8_LDB(B0, 1, 0); PG8_SCHED; PG8_LDA(At, 1, 0); PG8_STAGE(PG8_SA(0, 1), a2 + hstep, voffA);
            PG8_WAIT_L(8); PG8_BAR; PG8_WAIT_L(0); PG8_MMA(0, 0, At, B0); PG8_BAR; PG8_SCHED;
            PG8_LDB(B1, 1, 1); PG8_STAGE(PG8_SB(1, 0), b3, voffB);
            PG8_BAR; PG8_WAIT_L(0); PG8_MMA(0, 1, At, B1); PG8_BAR;
            PG8_LDA(At, 1, 1); PG8_STAGE(PG8_SA(1, 0), a3, voffA);
            PG8_BAR; PG8_WAIT_L(0); PG8_MMA(1, 0, At, B0); PG8_BAR; PG8_SCHED;
            PG8_STAGE(PG8_SB(1, 1), b3 + hstep, voffB);
            PG8_WAIT_V(6); PG8_BAR; PG8_MMA(1, 1, At, B1); PG8_BAR;
        }
        E(acc, cur, wr, wc, fr, fq); S.done(cur);
        if (!has_next) break;
#pragma unroll
        for (int a = 0; a < 2; ++a)
#pragma unroll
            for (int b = 0; b < 2; ++b)
#pragma unroll
                for (int m = 0; m < 4; ++m)
#pragma unroll
                    for (int n = 0; n < 2; ++n) acc[a][b][m][n] = (f32x4){0.f, 0.f, 0.f, 0.f};
        cur = nxt; cA = nA; cB = nB; ++ui;
    }
    PG8_WAIT_V(0);
    if (wr == 0) PG8_BAR;
    PG8_BAR;
#undef PG8_SA
#undef PG8_SB
#undef PG8_STAGE
#undef PG8_LDA
#undef PG8_LDB
#undef PG8_MMA
#undef PG8_WAIT_V
#undef PG8_WAIT_L
#undef PG8_BAR
#undef PG8_SCHED
}
}

struct EpiU {
    static constexpr bool PERM = true, AFTER_DRAIN = false;
    bf16_t* O;
    __device__ __forceinline__ void operator()(const f32x4 (&acc)[2][2][4][2], const pg8::Unit& u, int wr, int wc, int fr, int fq) const {
        const int row0 = u.pm * 256 + wr * 64 + fr, col0 = u.pn * 256 + wc * 32 + 8 * fq;
#pragma unroll
        for (int ai = 0; ai < 2; ++ai)
#pragma unroll
            for (int m = 0; m < 4; ++m) { bf16_t* rowp = O + (size_t)(row0 + ai * 128 + m * 16) * UP + col0;
#pragma unroll
                for (int bj = 0; bj < 2; ++bj) { const f32x4 v0 = acc[ai][bj][m][0], v1 = acc[ai][bj][m][1];
                    u32x4 w; w.x = pk2(v0[0], v0[1]); w.y = pk2(v0[2], v0[3]); w.z = pk2(v1[0], v1[1]); w.w = pk2(v1[2], v1[3]);
                    *(u32x4*)(rowp + bj * 128) = w; } }
    }
};
template <int LAYER> struct EpiY {
    static constexpr bool PERM = false, AFTER_DRAIN = false;
    const float* xp; const float* xs; float* Y; f32x2* stat; const f32x2* mr; const float* lg; const float* lb;
    __device__ __forceinline__ void operator()(const f32x4 (&acc)[2][2][4][2], const pg8::Unit& u, int wr, int wc, int fr, int fq) const {
        const int col0 = u.pn * 256 + wc * 32 + 4 * fq;
        f32x4 gv[2][2], bv[2][2];
        if (LAYER == 1) {
#pragma unroll
            for (int bj = 0; bj < 2; ++bj)
#pragma unroll
                for (int n = 0; n < 2; ++n) { gv[bj][n] = *(const f32x4*)(lg + col0 + bj * 128 + n * 16); bv[bj][n] = *(const f32x4*)(lb + col0 + bj * 128 + n * 16); }
        }
#pragma unroll
        for (int ai = 0; ai < 2; ++ai)
#pragma unroll
            for (int m = 0; m < 4; ++m) {
                const int row = u.pm * 256 + ai * 128 + wr * 64 + m * 16 + fr;
                const float* rp; f32x2 mrv = (f32x2){0.f, 1.f};
                if (LAYER == 0) rp = (row < NPROMPT) ? xp + (size_t)row * DM : xs + (size_t)(row - NPROMPT) * DM;
                else { rp = Y + (size_t)row * DM; mrv = mr[row]; }
                float* yp = Y + (size_t)row * DM;
                float s = 0.f, q = 0.f;
#pragma unroll
                for (int bj = 0; bj < 2; ++bj)
#pragma unroll
                    for (int n = 0; n < 2; ++n) {
                        const int c = col0 + bj * 128 + n * 16;
                        f32x4 r = *(const f32x4*)(rp + c);
                        if (LAYER == 1) r = (r - mrv.x) * mrv.y * gv[bj][n] + bv[bj][n];
                        const f32x4 y = r * DN_ALPHA + acc[ai][bj][m][n];
                        *(f32x4*)(yp + c) = y;
                        s += (y[0] + y[1]) + (y[2] + y[3]); q += (y[0] * y[0] + y[1] * y[1]) + (y[2] * y[2] + y[3] * y[3]);
                    }
                s += __shfl_xor(s, 16); s += __shfl_xor(s, 32); q += __shfl_xor(q, 16); q += __shfl_xor(q, 32);
                if (fq == 0) stat[(size_t)row * 16 + u.pn * 4 + wc] = (f32x2){s, q};
            }
    }
};
struct EpiPS {
    static constexpr bool PERM = true, AFTER_DRAIN = false;
    bf16_t* P; bf16_t* S;
    __device__ __forceinline__ void operator()(const f32x4 (&acc)[2][2][4][2], const pg8::Unit& u, int wr, int wc, int fr, int fq) const {
        const int row0 = u.pm * 256 + wr * 64 + fr, off = (wc & 1) * 32 + 8 * fq;
        bf16_t* dst = (wc < 2 ? S : P) + u.pn * 64 + off;
#pragma unroll
        for (int ai = 0; ai < 2; ++ai)
#pragma unroll
            for (int m = 0; m < 4; ++m) {
                float o[8];
#pragma unroll
                for (int n = 0; n < 2; ++n)
#pragma unroll
                    for (int j = 0; j < 4; ++j) { const float a = acc[ai][0][m][n][j], b = acc[ai][1][m][n][j];
                        o[4 * n + j] = (wc < 2) ? silu(b) * a : a * b; }
                u32x4 w; w.x = pk2(o[0], o[1]); w.y = pk2(o[2], o[3]); w.z = pk2(o[4], o[5]); w.w = pk2(o[6], o[7]);
                *(u32x4*)(dst + (size_t)(row0 + ai * 128 + m * 16) * DM) = w;
            }
    }
};

#define XB_TMO      128
#define XB_XCNT(j)  (256  + 64 * (j))
#define XB_XSUB(j)  (1280 + 64 * (j))
#define XB_XGEN(j)  (2304 + 64 * (j))
#define XB_TOP      3328
#define XB_TOPGEN   3392
#define XCD_BAR_WORDS 3456
#define XB_SPIN_CAP (1u << 27)
__device__ __forceinline__ unsigned xb_ld(unsigned* p)              { return __hip_atomic_load(p, __ATOMIC_RELAXED, __HIP_MEMORY_SCOPE_AGENT); }
__device__ __forceinline__ unsigned xb_add(unsigned* p, unsigned v) { return __hip_atomic_fetch_add(p, v, __ATOMIC_RELAXED, __HIP_MEMORY_SCOPE_AGENT); }
__device__ __forceinline__ unsigned xb_xcc_id() { return (unsigned)__builtin_amdgcn_s_getreg((3 << 11) | 20) & 0xFu; }
#define XB_SPIN(cond, bar) do { unsigned _sp = 0; while (cond) { __builtin_amdgcn_s_sleep(1); \
    if ((++_sp & 255u) == 0u) { if (xb_ld(&(bar)[XB_TMO])) break; if (_sp > XB_SPIN_CAP) { atomicAdd(&(bar)[XB_TMO], 1u); break; } } } } while (0)
struct XcdBarrier { unsigned* bar; unsigned x; volatile LAS unsigned* st; };
__device__ __forceinline__ XcdBarrier xcd_barrier_post(unsigned* bar, volatile LAS unsigned* st) {
    XcdBarrier b; b.bar = bar; b.x = xb_xcc_id(); b.st = st;
    if (threadIdx.x == 0) (void)xb_add(&bar[XB_XCNT(b.x)], 1u);
    return b;
}
__device__ __forceinline__ void xcd_barrier_complete(unsigned* bar, unsigned x, unsigned& nloc, unsigned& nx) {
    const unsigned G = gridDim.x * gridDim.y * gridDim.z;
    unsigned sum, cnt, mine, sp = 0u;
    for (;;) {
        sum = 0u; cnt = 0u; mine = 0u;
#pragma unroll
        for (unsigned j = 0; j < 16; ++j) { const unsigned c = xb_ld(&bar[XB_XCNT(j)]); sum += c; cnt += (c > 0u) ? 1u : 0u; mine = (j == x) ? c : mine; }
        if (sum == G) break;
        __builtin_amdgcn_s_sleep(1);
        if ((++sp & 255u) == 0u) { if (xb_ld(&bar[XB_TMO])) break; if (sp > XB_SPIN_CAP) { atomicAdd(&bar[XB_TMO], 1u); break; } }
    }
    nloc = mine > 0u ? mine : 1u; nx = cnt > 0u ? cnt : 1u;
}
__device__ __forceinline__ void xcd_barrier(const XcdBarrier& b) {
    asm volatile("s_waitcnt vmcnt(0)" ::: "memory");
    __syncthreads();
    if (threadIdx.x == 0) {
        unsigned* bar = b.bar;
        __builtin_amdgcn_s_waitcnt(0);
        unsigned nloc = b.st[0], nx = b.st[1];
        if (nloc == 0u) { xcd_barrier_complete(bar, b.x, nloc, nx); b.st[0] = nloc; b.st[1] = nx; }
        const unsigned old = xb_add(&bar[XB_XSUB(b.x)], 1u);
        const unsigned gen = old / nloc;
        if (old + 1u == (gen + 1u) * nloc) {
            __builtin_amdgcn_fence(__ATOMIC_RELEASE, "agent");
            asm volatile("s_waitcnt vmcnt(0)" ::: "memory");
            const unsigned og = xb_add(&bar[XB_TOP], 1u);
            const unsigned tg = og / nx;
            if (og + 1u == (tg + 1u) * nx) xb_add(&bar[XB_TOPGEN], 1u);
            else XB_SPIN(xb_ld(&bar[XB_TOPGEN]) == tg, bar);
            __builtin_amdgcn_fence(__ATOMIC_ACQUIRE, "agent");
            xb_add(&bar[XB_XGEN(b.x)], 1u);
            asm volatile("s_waitcnt vmcnt(0)" ::: "memory");
        } else {
            XB_SPIN(xb_ld(&bar[XB_XGEN(b.x)]) == gen, bar);
            __builtin_amdgcn_fence(__ATOMIC_ACQUIRE, "agent");
            asm volatile("s_waitcnt vmcnt(0)" ::: "memory");
        }
    }
    __syncthreads();
}

struct Args {
    const float *xp, *xs, *w_in_even, *wuf, *bfw, *wub, *bbw, *ng, *sink, *relb, *w_out_even, *w_in_odd, *cw, *w_out_odd, *lng, *lnb;
    float* out; unsigned char* ws;
};
constexpr int NTHR = 512;
constexpr int LDS_BYTES = 147456, MISC_OFF = 131072 + 1024;

template <int MODE> __device__ __forceinline__ int wmap(int n, float& sc) {
    sc = 1.f;
    if (MODE == 0) return n;
    if (MODE == 1) {
        if (n < 512) sc = 0.08838834764831845f;
        if (n >= C_QB && n < C_KB) sc = 0.125f;
        if (n < 2048) return n;
        if (n < C_GD) return n + 32;
        if (n < C_GD + 32) return n - C_GD + 2048;
        return -1;
    }
    const int w = n & 255, grp = w >> 6, ch = (n >> 8) * 64 + (w & 63);
    const int base = grp == 0 ? 0 : (grp == 1 ? 1024 : (grp == 2 ? 3072 : 2048));
    return base + ch;
}
template <int MODE> __device__ __forceinline__ void wconv_item(const float* __restrict__ W, int Nsrc, bf16_t* __restrict__ Wt, int Ndst, int item, LAS float* tile, int t256) {
    const int nb = item % (Ndst / 64), kb = item / (Ndst / 64), n0 = nb * 64, k0 = kb * 64;
    const int tx = t256 & 63, ty = t256 >> 6;
    float sc; const int src = wmap<MODE>(n0 + tx, sc);
    for (int kk = ty; kk < 64; kk += 4) tile[kk * 65 + tx] = src >= 0 ? W[(size_t)(k0 + kk) * Nsrc + src] * sc : 0.f;
    __syncthreads();
    for (int nn = ty; nn < 64; nn += 4) Wt[(size_t)(n0 + nn) * 1024 + k0 + tx] = f2bf(tile[tx * 65 + nn]);
    __syncthreads();
}
__device__ __forceinline__ void phase_convert(const Args& a, LAS unsigned char* lds) {
    unsigned char* ws = a.ws;
    bf16_t* W1t = (bf16_t*)(ws + WS_W1T); bf16_t* W2t = (bf16_t*)(ws + WS_W2T); bf16_t* W3t = (bf16_t*)(ws + WS_W3T); bf16_t* W4t = (bf16_t*)(ws + WS_W4T);
    const int half = threadIdx.x >> 8, t256 = threadIdx.x & 255;
    LAS float* tile = (LAS float*)lds + half * (64 * 65);
    constexpr int I1 = (UP / 64) * 16, I2 = 16 * 16, I3 = 64 * 16, I4 = 16 * 16, NIT = I1 + I2 + I3 + I4;
    for (int it0 = blockIdx.x * 2; it0 < NIT; it0 += gridDim.x * 2) {
        int r = it0 + half;
        if (r < I1) wconv_item<1>(a.w_in_even, EVEN_IN, W1t, UP, r, tile, t256);
        else if ((r -= I1) < I2) wconv_item<0>(a.w_out_even, 1024, W2t, 1024, r, tile, t256);
        else if ((r -= I2) < I3) wconv_item<2>(a.w_in_odd, ODD_IN, W3t, 4096, r, tile, t256);
        else if ((r -= I3) < I4) wconv_item<0>(a.w_out_odd, 1024, W4t, 1024, r, tile, t256);
        else { __syncthreads(); __syncthreads(); }
    }
    bf16_t* xb = (bf16_t*)(ws + WS_XB);
    const size_t n8 = (size_t)NTOK * DM / 8;
    for (size_t i = (size_t)blockIdx.x * NTHR + threadIdx.x; i < n8; i += (size_t)gridDim.x * NTHR) {
        const size_t e = i * 8; const float* src = e < (size_t)NPROMPT * DM ? a.xp + e : a.xs + (e - (size_t)NPROMPT * DM);
        const f32x4 v0 = *(const f32x4*)src, v1 = *(const f32x4*)(src + 4);
        u32x4 w; w.x = pk2(v0[0], v0[1]); w.y = pk2(v0[2], v0[3]); w.z = pk2(v1[0], v1[1]); w.w = pk2(v1[2], v1[3]);
        *(u32x4*)(xb + e) = w;
    }
}

__device__ __forceinline__ void phase_gla_naive(const Args& a, LAS unsigned char* lds, float* OF, float* OB) {
    if (blockIdx.x >= 12) return;
    const bf16_t* U = (const bf16_t*)(a.ws + WS_U);
    const int grp = threadIdx.x >> 7, tid = threadIdx.x & 127, b = blockIdx.x * 4 + grp, dir = b & 1, h = (b >> 1) & 3, s = b >> 3;
    LAS float* sq = (LAS float*)lds + grp * (3 * 16 * 128); LAS float* sk = sq + 16 * 128; LAS float* sd = sk + 16 * 128;
    const int L = s < 2 ? LP : LS, start = s < 2 ? s * LP : NPROMPT + (s - 2) * LS;
    const float* wu = dir ? a.wub : a.wuf; const float* bias = dir ? a.bbw : a.bfw; float* O = dir ? OB : OF;
    float wr[16];
#pragma unroll
    for (int r = 0; r < 16; ++r) wr[r] = wu[r * 512 + h * 128 + tid];
    const float bb = bias[h * 128 + tid];
    float S[128];
#pragma unroll
    for (int i = 0; i < 128; ++i) S[i] = 0.f;
    for (int t0 = 0; t0 < L; t0 += 16) {
        for (int tt = 0; tt < 16; ++tt) {
            const int p = t0 + tt, tok = start + (dir ? L - 1 - p : p);
            const bf16_t* ur = U + (size_t)tok * UP;
            float x = bb;
#pragma unroll
            for (int r = 0; r < 16; ++r) x += bf2f(ur[C_GD + dir * 16 + r]) * wr[r];
            const float ls = fminf(x, 0.f) - log1pf(expf(-fabsf(x)));
            sd[tt * 128 + tid] = expf(ls * (1.0f / 16.0f));
            sq[tt * 128 + tid] = bf2f(ur[C_QA + h * 128 + tid]);
            sk[tt * 128 + tid] = bf2f(ur[C_KA + h * 128 + tid]);
        }
        __syncthreads();
        for (int tt = 0; tt < 16; ++tt) {
            const int p = t0 + tt, tok = start + (dir ? L - 1 - p : p);
            const float v = bf2f(U[(size_t)tok * UP + C_VA + h * 128 + tid]);
            float acc = 0.f;
#pragma unroll
            for (int dk = 0; dk < 128; dk += 4) {
                const f32x4 d4 = *(const LAS f32x4*)&sd[tt * 128 + dk], q4 = *(const LAS f32x4*)&sq[tt * 128 + dk], k4 = *(const LAS f32x4*)&sk[tt * 128 + dk];
#pragma unroll
                for (int j = 0; j < 4; ++j) {
                    const float sdec = S[dk + j] * d4[j];
                    const float sn = sdec + k4[j] * v;
                    acc += q4[j] * (dir ? sdec : sn);
                    S[dk + j] = sn;
                }
            }
            O[(size_t)tok * 512 + h * 128 + tid] = acc;
        }
        __syncthreads();
    }
}
__device__ __forceinline__ void phase_gla_combine(const Args& a, const float* OF, const float* OB) {
    const bf16_t* U = (const bf16_t*)(a.ws + WS_U); bf16_t* ymix = (bf16_t*)(a.ws + WS_XB);
    const int lane = threadIdx.x & 63;
    for (int w = blockIdx.x * 8 + (threadIdx.x >> 6); w < NTOK * 4; w += gridDim.x * 8) {
        const int tok = w >> 2, h = w & 3;
        const size_t o = (size_t)tok * 512 + h * 128 + lane * 2;
        const float a0 = OF[o] + OB[o], a1 = OF[o + 1] + OB[o + 1];
        const float ss = wave_sum(a0 * a0 + a1 * a1);
        const float rstd = rsqrtf(ss * (1.0f / 128.0f) + NORM_EPS);
        const bf16_t* z = U + (size_t)tok * UP + C_ZA + h * 128 + lane * 2;
        const float y0 = a0 * rstd * a.ng[lane * 2] * silu(bf2f(z[0])), y1 = a1 * rstd * a.ng[lane * 2 + 1] * silu(bf2f(z[1]));
        *(unsigned*)(ymix + (size_t)tok * DM + h * 128 + lane * 2) = pk2(y0, y1);
    }
}
__device__ __forceinline__ int t5_bucket(int rel) {
    const int n = rel < 0 ? -rel : rel;
    int b = n < 8 ? n : (n < 12 ? 8 : (n < 16 ? 9 : (n < 23 ? 10 : (n < 32 ? 11 : (n < 46 ? 12 : (n < 64 ? 13 : (n < 91 ? 14 : 15)))))));
    return b + (rel > 0 ? 16 : 0);
}
__device__ __forceinline__ void phase_swa_naive(const Args& a, LAS unsigned char* lds) {
    const bf16_t* U = (const bf16_t*)(a.ws + WS_U); bf16_t* ymix = (bf16_t*)(a.ws + WS_XB);
    const int wv = threadIdx.x >> 6, lane = threadIdx.x & 63;
    LAS float* sq = (LAS float*)(lds + 65536) + wv * 64; LAS float* sp = (LAS float*)(lds + 65536 + 2048) + wv * 320;
    for (int w = blockIdx.x * 8 + wv; w < NTOK * 8; w += gridDim.x * 8) {
        const int tok = w >> 3, hq = w & 7, kv = hq >> 2;
        int s0, L; seq_of(tok, s0, L); const int i = tok - s0;
        sq[lane] = bf2f(U[(size_t)tok * UP + C_QB + hq * 64 + lane]);
        const float snk = a.sink[hq];
        float sc[5]; float mx = snk;
#pragma unroll
        for (int c = 0; c < 5; ++c) {
            const int jj = c * 64 + lane, j = i - 128 + jj; const bool valid = jj <= 256 && j >= 0 && j < L;
            float d = -INFINITY;
            if (valid) {
                const bf16_t* kr = U + (size_t)(s0 + j) * UP + C_KB + kv * 64; d = 0.f;
#pragma unroll
                for (int e = 0; e < 64; e += 8) { const u32x4 kk = *(const u32x4*)(kr + e);
                    d += sq[e] * __uint_as_float(kk.x << 16) + sq[e + 1] * __uint_as_float(kk.x & 0xffff0000u) + sq[e + 2] * __uint_as_float(kk.y << 16) + sq[e + 3] * __uint_as_float(kk.y & 0xffff0000u)
                       + sq[e + 4] * __uint_as_float(kk.z << 16) + sq[e + 5] * __uint_as_float(kk.z & 0xffff0000u) + sq[e + 6] * __uint_as_float(kk.w << 16) + sq[e + 7] * __uint_as_float(kk.w & 0xffff0000u); }
                d += a.relb[t5_bucket(j - i) * 8 + hq];
            }
            sc[c] = d; mx = fmaxf(mx, d);
        }
        mx = wave_max(mx);
        float den = 0.f;
#pragma unroll
        for (int c = 0; c < 5; ++c) { sc[c] = sc[c] == -INFINITY ? 0.f : __expf(sc[c] - mx); den += sc[c]; }
        den = wave_sum(den) + __expf(snk - mx);
        const float inv = 1.0f / den;
#pragma unroll
        for (int c = 0; c < 5; ++c) sp[c * 64 + lane] = sc[c] * inv;
        float o = 0.f;
        for (int jj = 0; jj <= 256; ++jj) { const int j = i - 128 + jj; if (j >= 0 && j < L) o += sp[jj] * bf2f(U[(size_t)(s0 + j) * UP + C_VB + kv * 64 + lane]); }
        const float z = bf2f(U[(size_t)tok * UP + C_ZB + hq * 64 + lane]);
        ymix[(size_t)tok * DM + 512 + hq * 64 + lane] = f2bf(o * silu(z));
    }
}
template <int FINAL>
__device__ __forceinline__ void phase_ln(float* Y, const f32x2* stat, f32x2* mr, const float* lg, const float* lb, bf16_t* xb) {
    const int lane = threadIdx.x & 63;
    for (int row = blockIdx.x * 8 + (threadIdx.x >> 6); row < NTOK; row += gridDim.x * 8) {
        f32x2 p = lane < 16 ? stat[(size_t)row * 16 + lane] : (f32x2){0.f, 0.f};
        const float s = wave_sum(p.x), q = wave_sum(p.y);
        const float mean = s * (1.0f / DM), var = q * (1.0f / DM) - mean * mean, rstd = rsqrtf(fmaxf(var, 0.f) + LN_EPS);
        if (!FINAL && lane == 0) mr[row] = (f32x2){mean, rstd};
#pragma unroll
        for (int j = 0; j < 4; ++j) {
            const int c = j * 256 + lane * 4;
            const f32x4 y = *(const f32x4*)(Y + (size_t)row * DM + c), g = *(const f32x4*)(lg + c), b = *(const f32x4*)(lb + c);
            const f32x4 o = (y - mean) * rstd * g + b;
            if (FINAL) *(f32x4*)(Y + (size_t)row * DM + c) = o;
            else { u32x2 w; w.x = pk2(o[0], o[1]); w.y = pk2(o[2], o[3]); *(u32x2*)(xb + (size_t)row * DM + c) = w; }
        }
    }
}
__device__ __forceinline__ void phase_convgate(const bf16_t* P, const bf16_t* S, const float* cw, bf16_t* G) {
    const size_t n8 = (size_t)NTOK * DM / 8;
    for (size_t i = (size_t)blockIdx.x * NTHR + threadIdx.x; i < n8; i += (size_t)gridDim.x * NTHR) {
        const int row = (int)(i >> 7), c = (int)(i & 127) * 8; int s0, L; seq_of(row, s0, L);
        const bool hasl = row > s0, hasr = row < s0 + L - 1;
        const u32x4 pm = *(const u32x4*)(P + (size_t)row * DM + c), sv = *(const u32x4*)(S + (size_t)row * DM + c);
        u32x4 pl = (u32x4){0, 0, 0, 0}, pr = (u32x4){0, 0, 0, 0};
        if (hasl) pl = *(const u32x4*)(P + (size_t)(row - 1) * DM + c);
        if (hasr) pr = *(const u32x4*)(P + (size_t)(row + 1) * DM + c);
        float o[8];
#pragma unroll
        for (int j = 0; j < 4; ++j) {
            const unsigned l = pl[j], m = pm[j], r = pr[j], sw = sv[j];
            const int cc = c + 2 * j;
            o[2 * j] = __uint_as_float(sw << 16) * (cw[cc] * __uint_as_float(l << 16) + cw[1024 + cc] * __uint_as_float(m << 16) + cw[2048 + cc] * __uint_as_float(r << 16));
            o[2 * j + 1] = __uint_as_float(sw & 0xffff0000u) * (cw[cc + 1] * __uint_as_float(l & 0xffff0000u) + cw[1024 + cc + 1] * __uint_as_float(m & 0xffff0000u) + cw[2048 + cc + 1] * __uint_as_float(r & 0xffff0000u));
        }
        u32x4 w; w.x = pk2(o[0], o[1]); w.y = pk2(o[2], o[3]); w.z = pk2(o[4], o[5]); w.w = pk2(o[6], o[7]);
        *(u32x4*)(G + (size_t)row * DM + c) = w;
    }
}

typedef short s16x4 __attribute__((ext_vector_type(4)));
constexpr int GL_QT = 0, GL_KT = 16384, GL_VT = 32768, GL_PT = 49152, GL_B = 57344, GL_GD = 90112, GL_TOT = 94208, GL_EBL = 96256, GL_SSW = 96768, GL_RSTD = 98816;
constexpr int NSEG = NTOK / 256;
__device__ __forceinline__ unsigned offb(unsigned row, unsigned ch) { return 256u * row + 16u * (ch ^ (((row & 3) << 2) | ((row >> 2) & 3))); }
__device__ __forceinline__ unsigned offp(unsigned row, unsigned ch) { return 128u * row + 16u * (ch ^ (row & 7)); }
__device__ __forceinline__ unsigned rr16(unsigned lane, unsigned rb, unsigned s) { return offb((lane & 15) + 16 * rb, 4 * s + (lane >> 4)); }
__device__ __forceinline__ unsigned tr16(unsigned lane, unsigned c, unsigned ks, unsigned t) {
    const unsigned g = lane >> 4, q = (lane & 15) >> 2, p = lane & 3;
    return offb(32 * ks + 8 * g + 4 * t + q, 2 * c + (p >> 1)) + 8 * (p & 1);
}
__device__ __forceinline__ bf16x8 tr_read8(unsigned a0, unsigned a1) {
    s16x4 r0, r1;
    asm volatile("ds_read_b64_tr_b16 %0, %2\n\tds_read_b64_tr_b16 %1, %3\n\ts_waitcnt lgkmcnt(0)" : "=&v"(r0), "=&v"(r1) : "v"(a0), "v"(a1) : "memory");
    return __builtin_shufflevector(r0, r1, 0, 1, 2, 3, 4, 5, 6, 7);
}
__device__ __forceinline__ void unpack8(const u32x4 w, float (&f)[8]) {
#pragma unroll
    for (int j = 0; j < 4; ++j) { f[2 * j] = __uint_as_float(w[j] << 16); f[2 * j + 1] = __uint_as_float(w[j] & 0xffff0000u); }
}
#define MFMA16(a, b, c) __builtin_amdgcn_mfma_f32_16x16x32_bf16((a), (b), (c), 0, 0, 0)

template <int MODE>
__device__ __forceinline__ void gla_chunk(const Args& a, LAS unsigned char* lds, const int tb, const int h, const int dir, const float (&wu)[16], const float wbias,
                                          f32x4 (&Sacc)[8], float& lam, u32x4* stash) {
    const bf16_t* U = (const bf16_t*)(a.ws + WS_U);
    int tid = threadIdx.x; asm volatile("" : "+v"(tid));
    const int lane = tid & 63, w = __builtin_amdgcn_readfirstlane(tid >> 6), n = lane & 15, g = lane >> 4;
    const unsigned lb = (unsigned)(size_t)lds;
    const unsigned fn = ((n & 3) << 2) | ((n >> 2) & 3);
    const unsigned base_rr = 256u * n + 16u * (g ^ fn);
    const unsigned base_c = 256u * n + 16u * ((g >> 1) ^ fn) + 8u * (g & 1);
    const unsigned base_p = 128u * n + 16u * (g ^ (n & 7));
    const unsigned trb0 = tr16(lane, 0, 0, 0), trb1 = tr16(lane, 0, 0, 1);
    int prow[2], pch[2], ptok[2];
    u32x4 qraw[2], kraw[2];
#pragma unroll
    for (int i = 0; i < 2; ++i) {
        const int idx = tid + 512 * i; prow[i] = idx >> 4; pch[i] = idx & 15; ptok[i] = dir ? tb + 63 - prow[i] : tb + prow[i];
        const bf16_t* ur = U + (size_t)ptok[i] * UP + h * 128 + pch[i] * 8;
        const u32x4 vv = *(const u32x4*)(ur + C_VA);
        kraw[i] = *(const u32x4*)(ur + C_KA);
        if (MODE != 0) qraw[i] = *(const u32x4*)(ur + C_QA);
        *(LAS u32x4*)(lds + GL_VT + offb(prow[i], pch[i])) = vv;
    }
    if (tid < 128) {
        const int row = tid >> 1, half = tid & 1, tok = dir ? tb + 63 - row : tb + row;
        const u32x4 gw = *(const u32x4*)(U + (size_t)tok * UP + C_GD + dir * 16 + half * 8);
        float f[8]; unpack8(gw, f);
        LAS f32x4* dst = (LAS f32x4*)(lds + GL_GD + row * 64 + half * 32);
        dst[0] = (f32x4){f[0], f[1], f[2], f[3]}; dst[1] = (f32x4){f[4], f[5], f[6], f[7]};
    }
    __syncthreads();
    {
        const int dk = tid & 127, rg = tid >> 7;
        float bl[16]; float run = 0.f;
#pragma unroll
        for (int rr = 0; rr < 16; ++rr) {
            const LAS f32x4* gp = (const LAS f32x4*)(lds + GL_GD + (rg * 16 + rr) * 64);
            float x = wbias;
#pragma unroll
            for (int q4 = 0; q4 < 4; ++q4) { const f32x4 gv = gp[q4]; x += gv[0] * wu[4 * q4] + gv[1] * wu[4 * q4 + 1] + gv[2] * wu[4 * q4 + 2] + gv[3] * wu[4 * q4 + 3]; }
            const float ls = fminf(x, 0.f) - __logf(1.0f + __expf(-fabsf(x)));
            run += ls * (1.0f / 16.0f); bl[rr] = run;
        }
        LAS float* tot = (LAS float*)(lds + GL_TOT);
        tot[rg * 128 + dk] = run;
        __syncthreads();
        const float t0 = tot[dk], t1 = tot[128 + dk], t2 = tot[256 + dk], t3 = tot[384 + dk];
        const float pre = rg == 0 ? 0.f : (rg == 1 ? t0 : (rg == 2 ? t0 + t1 : t0 + t1 + t2));
        LAS float* B = (LAS float*)(lds + GL_B);
#pragma unroll
        for (int rr = 0; rr < 16; ++rr) B[(rg * 16 + rr) * 128 + dk] = pre + bl[rr];
        if (rg == 0) { const float total = (t0 + t1) + (t2 + t3); ((LAS float*)(lds + GL_EBL))[dk] = __expf(total); lam += total; }
        __syncthreads();
    }
#pragma unroll
    for (int i = 0; i < 2; ++i) {
        const LAS f32x4* bp = (const LAS f32x4*)(lds + GL_B + (prow[i] * 128 + pch[i] * 8) * 4);
        const f32x4 b0 = bp[0], b1 = bp[1];
        float e[8], kf[8];
#pragma unroll
        for (int j = 0; j < 4; ++j) { e[j] = __expf(b0[j]); e[4 + j] = __expf(b1[j]); }
        unpack8(kraw[i], kf);
        u32x4 kw;
#pragma unroll
        for (int j = 0; j < 4; ++j) kw[j] = pk2(kf[2 * j] * __builtin_amdgcn_rcpf(e[2 * j]), kf[2 * j + 1] * __builtin_amdgcn_rcpf(e[2 * j + 1]));
        *(LAS u32x4*)(lds + GL_KT + offb(prow[i], pch[i])) = kw;
        if (MODE != 0) {
            float qf[8]; unpack8(qraw[i], qf);
            u32x4 qw;
#pragma unroll
            for (int j = 0; j < 4; ++j) qw[j] = pk2(qf[2 * j] * e[2 * j], qf[2 * j + 1] * e[2 * j + 1]);
            *(LAS u32x4*)(lds + GL_QT + offb(prow[i], pch[i])) = qw;
        }
    }
    __syncthreads();
    f32x4 Oacc[4];
    if (MODE != 0) {
        const int it = w >> 1;
        bf16x8 qa[4];
#pragma unroll
        for (int s = 0; s < 4; ++s) qa[s] = *(const LAS bf16x8*)(lds + GL_QT + (base_rr ^ (64u * s)) + 4096u * it);
#pragma unroll
        for (int jj = 0; jj < 2; ++jj) {
            const int jt = 2 * (w & 1) + jj;
            f32x4 pacc = (f32x4){0.f, 0.f, 0.f, 0.f};
            if (jt <= it) {
#pragma unroll
                for (int s = 0; s < 4; ++s) { const bf16x8 kb = *(const LAS bf16x8*)(lds + GL_KT + (base_rr ^ (64u * s)) + 4096u * jt); pacc = MFMA16(qa[s], kb, pacc); }
            }
            const int j = 16 * jt + n;
#pragma unroll
            for (int r = 0; r < 4; ++r) {
                const int i = 16 * it + 4 * g + r;
                const bool keep = (MODE == 1) ? (j <= i) : (j < i);
                *(LAS bf16_t*)(lds + GL_PT + offp(i, j >> 3) + 2 * (j & 7)) = keep ? f2bf(pacc[r]) : (bf16_t)0;
            }
        }
        bf16x8 sb[4];
#pragma unroll
        for (int ks = 0; ks < 4; ++ks) {
            u32x4 pw; pw.x = pk2(Sacc[2 * ks][0], Sacc[2 * ks][1]); pw.y = pk2(Sacc[2 * ks][2], Sacc[2 * ks][3]); pw.z = pk2(Sacc[2 * ks + 1][0], Sacc[2 * ks + 1][1]); pw.w = pk2(Sacc[2 * ks + 1][2], Sacc[2 * ks + 1][3]);
            sb[ks] = __builtin_bit_cast(bf16x8, pw);
        }
#pragma unroll
        for (int i2 = 0; i2 < 4; ++i2) {
            Oacc[i2] = (f32x4){0.f, 0.f, 0.f, 0.f};
#pragma unroll
            for (int ks = 0; ks < 4; ++ks) {
                const unsigned alo = base_c ^ (64u * ks);
                const u32x2 lo = *(const LAS u32x2*)(lds + GL_QT + 4096 * i2 + alo);
                const u32x2 hi = *(const LAS u32x2*)(lds + GL_QT + 4096 * i2 + (alo ^ 32u));
                u32x4 aw; aw.x = lo.x; aw.y = lo.y; aw.z = hi.x; aw.w = hi.y;
                Oacc[i2] = MFMA16(__builtin_bit_cast(bf16x8, aw), sb[ks], Oacc[i2]);
            }
        }
        __syncthreads();
    }
    bf16x8 vf[2];
#pragma unroll
    for (int ks = 0; ks < 2; ++ks) vf[ks] = tr_read8(lb + GL_VT + 8192u * ks + (trb0 ^ (32u * w)), lb + GL_VT + 8192u * ks + (trb1 ^ (32u * w)));
    if (MODE != 0) {
#pragma unroll
        for (int i2 = 0; i2 < 4; ++i2)
#pragma unroll
            for (int ks = 0; ks < 2; ++ks) {
                if (ks <= (i2 >> 1)) { const bf16x8 pa = *(const LAS bf16x8*)(lds + GL_PT + 2048 * i2 + (base_p ^ (64u * ks))); Oacc[i2] = MFMA16(pa, vf[ks], Oacc[i2]); }
            }
    }
#pragma unroll
    for (int kt = 0; kt < 8; ++kt) {
#pragma unroll
        for (int ks = 0; ks < 2; ++ks) { const bf16x8 ka = tr_read8(lb + GL_KT + 8192u * ks + (trb0 ^ (32u * kt)), lb + GL_KT + 8192u * ks + (trb1 ^ (32u * kt))); Sacc[kt] = MFMA16(ka, vf[ks], Sacc[kt]); }
        const f32x4 eb = *(const LAS f32x4*)(lds + GL_EBL + (16 * kt + 4 * g) * 4);
        Sacc[kt] = Sacc[kt] * eb;
    }
    if (MODE == 1) {
        u32x4 s0, s1;
        s0.x = pk2(Oacc[3][3], Oacc[3][2]); s0.y = pk2(Oacc[3][1], Oacc[3][0]); s0.z = pk2(Oacc[2][3], Oacc[2][2]); s0.w = pk2(Oacc[2][1], Oacc[2][0]);
        s1.x = pk2(Oacc[1][3], Oacc[1][2]); s1.y = pk2(Oacc[1][1], Oacc[1][0]); s1.z = pk2(Oacc[0][3], Oacc[0][2]); s1.w = pk2(Oacc[0][1], Oacc[0][0]);
        const int tidm = tid ^ 48;
        stash[tidm * 2] = s0; stash[tidm * 2 + 1] = s1;
    }
    if (MODE == 2) {
        const u32x4 s0 = stash[tid * 2], s1 = stash[tid * 2 + 1];
        float fo[16]; { float t8[8]; unpack8(s0, t8);
#pragma unroll
            for (int j = 0; j < 8; ++j) fo[j] = t8[j]; unpack8(s1, t8);
#pragma unroll
            for (int j = 0; j < 8; ++j) fo[8 + j] = t8[j]; }
        LAS float* ssw = (LAS float*)(lds + GL_SSW);
#pragma unroll
        for (int i2 = 0; i2 < 4; ++i2)
#pragma unroll
            for (int r = 0; r < 4; ++r) {
                const float o = Oacc[i2][r] + fo[4 * i2 + r]; Oacc[i2][r] = o;
                float v = o * o; v += __shfl_xor(v, 1); v += __shfl_xor(v, 2); v += __shfl_xor(v, 4); v += __shfl_xor(v, 8);
                if (n == 0) ssw[w * 64 + 16 * i2 + 4 * g + r] = v;
            }
        __syncthreads();
        if (tid < 64) { float s = 0.f;
#pragma unroll
            for (int ww = 0; ww < 8; ++ww) s += ssw[ww * 64 + tid];
            ((LAS float*)(lds + GL_RSTD))[tid] = rsqrtf(s * (1.0f / 128.0f) + NORM_EPS); }
        __syncthreads();
        const float gn = a.ng[16 * w + n];
#pragma unroll
        for (int i2 = 0; i2 < 4; ++i2) {
            const f32x4 rs = *(const LAS f32x4*)(lds + GL_RSTD + (16 * i2 + 4 * g) * 4);
#pragma unroll
            for (int r = 0; r < 4; ++r) *(LAS bf16_t*)(lds + GL_QT + (16 * i2 + 4 * g + r) * 256 + (16 * w + n) * 2) = f2bf(Oacc[i2][r] * rs[r] * gn);
        }
        __syncthreads();
        bf16_t* ymix = (bf16_t*)(a.ws + WS_XB);
#pragma unroll
        for (int i = 0; i < 2; ++i) {
            const u32x4 ov = *(const LAS u32x4*)(lds + GL_QT + prow[i] * 256 + pch[i] * 16);
            const u32x4 zv = *(const u32x4*)(U + (size_t)ptok[i] * UP + C_ZA + h * 128 + pch[i] * 8);
            float of[8], zf[8]; unpack8(ov, of); unpack8(zv, zf);
            u32x4 yw;
#pragma unroll
            for (int j = 0; j < 4; ++j) yw[j] = pk2(of[2 * j] * silu(zf[2 * j]), of[2 * j + 1] * silu(zf[2 * j + 1]));
            *(u32x4*)(ymix + (size_t)ptok[i] * DM + h * 128 + pch[i] * 8) = yw;
        }
    }
    __syncthreads();
}
__device__ __forceinline__ void gla_load_gate(const Args& a, int h, int dir, float (&wu)[16], float& wbias) {
    const float* wup = dir ? a.wub : a.wuf; const float* bias = dir ? a.bbw : a.bfw; const int dk = threadIdx.x & 127;
#pragma unroll
    for (int r = 0; r < 16; ++r) wu[r] = wup[r * 512 + h * 128 + dk];
    wbias = bias[h * 128 + dk];
}
__device__ __forceinline__ void phase_gla_pass1(const Args& a, LAS unsigned char* lds) {
    const int tid = threadIdx.x, w = tid >> 6, lane = tid & 63;
    unsigned char* ST = a.ws + WS_ST;
    for (int item = blockIdx.x; item < NSEG * 8; item += gridDim.x) {
        const int dir = item & 1, h = (item >> 1) & 3, seg = item >> 3;
        float wu[16], wbias; gla_load_gate(a, h, dir, wu, wbias);
        f32x4 Sacc[8];
#pragma unroll
        for (int kt = 0; kt < 8; ++kt) Sacc[kt] = (f32x4){0.f, 0.f, 0.f, 0.f};
        float lam = 0.f;
        for (int cc = 0; cc < 4; ++cc) { const int c = dir ? 3 - cc : cc; gla_chunk<0>(a, lds, seg * 256 + c * 64, h, dir, wu, wbias, Sacc, lam, nullptr); }
        u32x2* dst = (u32x2*)(ST + (size_t)item * 32768) + (size_t)w * 8 * 64 + lane;
#pragma unroll
        for (int kt = 0; kt < 8; ++kt) { u32x2 v; v.x = pk2(Sacc[kt][0], Sacc[kt][1]); v.y = pk2(Sacc[kt][2], Sacc[kt][3]); dst[kt * 64] = v; }
        if (tid < 128) ((float*)(a.ws + WS_DEC))[(size_t)item * 128 + tid] = lam;
    }
}
__device__ __forceinline__ void phase_gla_pass2(const Args& a) {
    unsigned char* ST = a.ws + WS_ST; const float* DEC = (const float*)(a.ws + WS_DEC);
    for (int gidx = blockIdx.x * NTHR + threadIdx.x; gidx < 48 * 4096; gidx += gridDim.x * NTHR) {
        const int chain = gidx >> 12, quad = gidx & 4095, dir = chain & 1, h = (chain >> 1) & 3, s = chain >> 3;
        const int nseg = s < 2 ? LP / 256 : LS / 256, seg0 = s < 2 ? s * (LP / 256) : 2 * (LP / 256) + (s - 2) * (LS / 256);
        const int kt = (quad >> 6) & 7, lane = quad & 63, dk0 = 16 * kt + 4 * (lane >> 4);
        f32x4 S = (f32x4){0.f, 0.f, 0.f, 0.f};
        for (int i0 = 0; i0 < nseg; i0 += 8) {
            u32x2 t[8]; f32x4 lm[8];
#pragma unroll
            for (int j = 0; j < 8; ++j) { const int seg = dir ? seg0 + nseg - 1 - (i0 + j) : seg0 + i0 + j; const size_t idx = (size_t)((seg * 4 + h) * 2 + dir);
                t[j] = ((const u32x2*)(ST + idx * 32768))[quad]; lm[j] = *(const f32x4*)(DEC + idx * 128 + dk0); }
#pragma unroll
            for (int j = 0; j < 8; ++j) { const int seg = dir ? seg0 + nseg - 1 - (i0 + j) : seg0 + i0 + j; const size_t idx = (size_t)((seg * 4 + h) * 2 + dir);
                u32x2 o; o.x = pk2(S[0], S[1]); o.y = pk2(S[2], S[3]); ((u32x2*)(ST + idx * 32768))[quad] = o;
                const f32x4 tv = (f32x4){__uint_as_float(t[j].x << 16), __uint_as_float(t[j].x & 0xffff0000u), __uint_as_float(t[j].y << 16), __uint_as_float(t[j].y & 0xffff0000u)};
                S = (f32x4){__expf(lm[j][0]), __expf(lm[j][1]), __expf(lm[j][2]), __expf(lm[j][3])} * S + tv; }
        }
    }
}
__device__ __forceinline__ void phase_gla_pass3(const Args& a, LAS unsigned char* lds) {
    const int tid = threadIdx.x, w = tid >> 6, lane = tid & 63;
    const unsigned char* ST = a.ws + WS_ST;
    for (int item = blockIdx.x; item < NSEG * 4; item += gridDim.x) {
        const int h = item & 3, seg = item >> 2;
        u32x4* stash = (u32x4*)a.out + (size_t)item * 4 * 1024;
#pragma unroll 1
        for (int dir = 0; dir < 2; ++dir) {
            float wu[16], wbias; gla_load_gate(a, h, dir, wu, wbias);
            f32x4 Sacc[8];
            const u32x2* src = (const u32x2*)(ST + (size_t)((seg * 4 + h) * 2 + dir) * 32768) + (size_t)w * 8 * 64 + lane;
#pragma unroll
            for (int kt = 0; kt < 8; ++kt) { const u32x2 v = src[kt * 64]; Sacc[kt] = (f32x4){__uint_as_float(v.x << 16), __uint_as_float(v.x & 0xffff0000u), __uint_as_float(v.y << 16), __uint_as_float(v.y & 0xffff0000u)}; }
            float lam = 0.f;
            if (dir == 0) { for (int c = 0; c < 4; ++c) gla_chunk<1>(a, lds, seg * 256 + c * 64, h, 0, wu, wbias, Sacc, lam, stash + c * 1024); }
            else { for (int c = 3; c >= 0; --c) gla_chunk<2>(a, lds, seg * 256 + c * 64, h, 1, wu, wbias, Sacc, lam, stash + c * 1024); }
        }
    }
}

typedef float f32x16 __attribute__((ext_vector_type(16)));
#define MFMA32(a, b, c) __builtin_amdgcn_mfma_f32_32x32x16_bf16((a), (b), (c), 0, 0, 0)
constexpr int SW_K = 0, SW_V = 49152, SW_TB = 98304, SW_TBN = 336, SW_TBH = 4 * SW_TBN * 4;
constexpr float SW_NEG = -1e30f;
__device__ __forceinline__ unsigned offk(unsigned row, unsigned c8) { return 128u * row + 16u * (c8 ^ ((row >> 1) & 7)); }
__device__ __forceinline__ unsigned offv(unsigned row, unsigned c8) { return 128u * row + 16u * (c8 ^ (((row >> 1) & 1) << 2)); }
__device__ __forceinline__ void phase_swa(const Args& a, LAS unsigned char* lds) {
    const bf16_t* U = (const bf16_t*)(a.ws + WS_U); bf16_t* ymix = (bf16_t*)(a.ws + WS_XB);
    const int tid = threadIdx.x, lane = tid & 63, w = __builtin_amdgcn_readfirstlane(tid >> 6), r = lane & 31, hh = lane >> 5;
    const unsigned lb = (unsigned)(size_t)lds;
    for (int item = blockIdx.x; item < (NTOK / 128) * 2; item += gridDim.x) {
        const int kvh = item & 1, tok0 = (item >> 1) * 128; int s0, L; seq_of(tok0, s0, L);
        const bool first = tok0 == s0, last = tok0 + 128 == s0 + L;
        __syncthreads();
#pragma unroll
        for (int i = 0; i < 6; ++i) {
            const int idx = tid + 512 * i, row = idx >> 3, c8 = idx & 7, kpos = tok0 - 128 + row;
            u32x4 kk = (u32x4){0, 0, 0, 0}, vv = (u32x4){0, 0, 0, 0};
            if (kpos >= s0 && kpos < s0 + L) { const bf16_t* ur = U + (size_t)kpos * UP + kvh * 64 + c8 * 8; kk = *(const u32x4*)(ur + C_KB); vv = *(const u32x4*)(ur + C_VB); }
            *(LAS u32x4*)(lds + SW_K + offk(row, c8)) = kk; *(LAS u32x4*)(lds + SW_V + offv(row, c8)) = vv;
        }
        for (int e = tid; e < 4 * SW_TBN; e += NTHR) {
            const int hl = e / SW_TBN, idx = e - hl * SW_TBN, rel = idx - 160;
            const float val = (rel >= -128 && rel <= 128) ? a.relb[t5_bucket(rel) * 8 + kvh * 4 + hl] : SW_NEG;
            LAS float* tb = (LAS float*)(lds + SW_TB + hl * SW_TBH);
#pragma unroll
            for (int s = 0; s < 4; ++s) if (idx - s >= 0) tb[s * SW_TBN + idx - s] = val;
        }
        __syncthreads();
        const int hl = w >> 1, hq = kvh * 4 + hl;
        const float snk = a.sink[hq];
#pragma unroll 1
        for (int ss = 0; ss < 2; ++ss) {
            const int st = (w & 1) * 2 + ss, qtok = tok0 + 32 * st + r;
            bf16x8 Qf[4];
#pragma unroll
            for (int s = 0; s < 4; ++s) Qf[s] = *(const bf16x8*)(U + (size_t)qtok * UP + C_QB + hq * 64 + 16 * s + 8 * hh);
            float m = snk, l = hh == 0 ? 1.0f : 0.0f;
            f32x16 O[2];
#pragma unroll
            for (int i = 0; i < 16; ++i) { O[0][i] = 0.f; O[1][i] = 0.f; }
            const int sft = (-r) & 3;
            const unsigned tbase = SW_TB + hl * SW_TBH + sft * (SW_TBN * 4) + 4 * (32 + 4 * hh - r - sft);
            const unsigned kb0 = SW_K + 128u * r + 16u * (hh ^ ((r >> 1) & 7)) + 4096u * st;
            const int q4 = (lane & 15) >> 2, p4 = lane & 3, g1 = (lane >> 4) & 1, xq = (q4 >> 1) & 1;
            const unsigned vb0 = lb + SW_V + 128u * (4 * hh + q4) + 16u * ((4 * xq) | (2 * g1) | (p4 >> 1)) + 8u * (p4 & 1) + 4096u * st;
#pragma unroll 1
            for (int grp = 0; grp < 3; ++grp) {
                f32x16 S[3];
#pragma unroll
                for (int k3 = 0; k3 < 3; ++k3) {
                    const int kk = 3 * grp + k3, blk = (st + kk) >> 2;
                    const bool valid = !((blk == 0 && first) || (blk == 2 && last));
                    if (valid) {
#pragma unroll
                        for (int i = 0; i < 16; ++i) S[k3][i] = 0.f;
#pragma unroll
                        for (int s = 0; s < 4; ++s) { const bf16x8 Kf = *(const LAS bf16x8*)(lds + (kb0 ^ (32u * s)) + 4096u * kk); S[k3] = MFMA32(Kf, Qf[s], S[k3]); }
#pragma unroll
                        for (int i4 = 0; i4 < 4; ++i4) { const f32x4 bv = *(const LAS f32x4*)(lds + tbase + 4 * (32 * kk + 8 * i4));
#pragma unroll
                            for (int j = 0; j < 4; ++j) S[k3][4 * i4 + j] += bv[j]; }
                    } else {
#pragma unroll
                        for (int i = 0; i < 16; ++i) S[k3][i] = SW_NEG;
                    }
                }
                float mx = SW_NEG;
#pragma unroll
                for (int k3 = 0; k3 < 3; ++k3)
#pragma unroll
                    for (int i = 0; i < 16; ++i) mx = fmaxf(mx, S[k3][i]);
                mx = fmaxf(mx, __shfl_xor(mx, 32));
                const float mn = fmaxf(m, mx), alpha = __expf(m - mn);
                m = mn; l *= alpha;
#pragma unroll
                for (int i = 0; i < 16; ++i) { O[0][i] *= alpha; O[1][i] *= alpha; }
                bf16x8 Pf[3][2];
#pragma unroll
                for (int k3 = 0; k3 < 3; ++k3) {
#pragma unroll
                    for (int i = 0; i < 16; ++i) { const float pv = __expf(S[k3][i] - m); S[k3][i] = pv; l += pv; }
#pragma unroll
                    for (int s2 = 0; s2 < 2; ++s2) {
                        u32x4 pw;
#pragma unroll
                        for (int j = 0; j < 4; ++j) pw[j] = pk2(S[k3][8 * s2 + 2 * j], S[k3][8 * s2 + 2 * j + 1]);
                        Pf[k3][s2] = __builtin_bit_cast(bf16x8, pw);
                    }
                }
#pragma unroll
                for (int k3 = 0; k3 < 3; ++k3) {
                    const int kk = 3 * grp + k3;
#pragma unroll
                    for (int s2 = 0; s2 < 2; ++s2)
#pragma unroll
                        for (int dt = 0; dt < 2; ++dt) {
                            const unsigned va = (vb0 ^ (64u * dt)) + 4096u * kk + 2048u * s2;
                            const bf16x8 Vf = tr_read8(va, va + 1024u);
                            O[dt] = MFMA32(Vf, Pf[k3][s2], O[dt]);
                        }
                }
            }
            l += __shfl_xor(l, 32);
            const float inv = 1.0f / l;
#pragma unroll
            for (int dt = 0; dt < 2; ++dt)
#pragma unroll
                for (int i4 = 0; i4 < 4; ++i4) {
                    const int d0 = 32 * dt + 8 * i4 + 4 * hh;
                    const u32x2 zv = *(const u32x2*)(U + (size_t)qtok * UP + C_ZB + hq * 64 + d0);
                    const float z0 = __uint_as_float(zv.x << 16), z1 = __uint_as_float(zv.x & 0xffff0000u), z2 = __uint_as_float(zv.y << 16), z3 = __uint_as_float(zv.y & 0xffff0000u);
                    u32x2 yw; yw.x = pk2(O[dt][4 * i4] * inv * silu(z0), O[dt][4 * i4 + 1] * inv * silu(z1)); yw.y = pk2(O[dt][4 * i4 + 2] * inv * silu(z2), O[dt][4 * i4 + 3] * inv * silu(z3));
                    *(u32x2*)(ymix + (size_t)qtok * DM + 512 + hq * 64 + d0) = yw;
                }
        }
    }
}

__global__ void __launch_bounds__(NTHR, 2) mega(Args a) {
    extern __shared__ __attribute__((aligned(16))) unsigned char lds_raw[];
    LAS unsigned char* lds = (LAS unsigned char*)lds_raw;
    volatile LAS unsigned* MISC = (volatile LAS unsigned*)(lds + MISC_OFF);
    if (threadIdx.x < 32) MISC[threadIdx.x] = 0u;
    __syncthreads();
    unsigned char* ws = a.ws; float* out = a.out;
    XcdBarrier bar = xcd_barrier_post((unsigned*)(ws + WS_CTL) + 4096, MISC + 8);
    bf16_t* W1t = (bf16_t*)(ws + WS_W1T); bf16_t* W2t = (bf16_t*)(ws + WS_W2T); bf16_t* W3t = (bf16_t*)(ws + WS_W3T); bf16_t* W4t = (bf16_t*)(ws + WS_W4T);
    bf16_t* xb = (bf16_t*)(ws + WS_XB); bf16_t* ymix = xb; bf16_t* G = xb; bf16_t* U = (bf16_t*)(ws + WS_U);
    bf16_t* x1b = (bf16_t*)(ws + WS_X1B); bf16_t* P = (bf16_t*)(ws + WS_P); bf16_t* Sg = (bf16_t*)(ws + WS_S);
    f32x2* stat1 = (f32x2*)(ws + WS_STAT1); f32x2* stat2 = (f32x2*)(ws + WS_STAT2); f32x2* mr1 = (f32x2*)(ws + WS_MR1);
    float* OF = out; float* OB = out + (size_t)NTOK * 512;

    phase_convert(a, lds);
    xcd_barrier(bar);
    { pg8::Gemm g{xb, W1t, NTOK, UP, DM, 0}; pg8::StaticOrder S; S.init(NTOK, UP, gridDim.x, blockIdx.x); EpiU E{U}; pg8::gemm_phase<EpiU, pg8::StaticOrder>(lds, g, S, E); }
    xcd_barrier(bar);
    phase_gla_pass1(a, lds);
    xcd_barrier(bar);
    phase_gla_pass2(a);
    phase_swa(a, lds);
    xcd_barrier(bar);
    phase_gla_pass3(a, lds);
    xcd_barrier(bar);
    { pg8::Gemm g{ymix, W2t, NTOK, DM, DM, 0}; pg8::StaticOrder S; S.init(NTOK, DM, gridDim.x, blockIdx.x); EpiY<0> E{a.xp, a.xs, out, stat1, nullptr, nullptr, nullptr}; pg8::gemm_phase<EpiY<0>, pg8::StaticOrder>(lds, g, S, E); }
    xcd_barrier(bar);
    phase_ln<0>(out, stat1, mr1, a.lng, a.lnb, x1b);
    xcd_barrier(bar);
    { pg8::Gemm g{x1b, W3t, NTOK, 4096, DM, 0}; pg8::StaticOrder S; S.init(NTOK, 4096, gridDim.x, blockIdx.x); EpiPS E{P, Sg}; pg8::gemm_phase<EpiPS, pg8::StaticOrder>(lds, g, S, E); }
    xcd_barrier(bar);
    phase_convgate(P, Sg, a.cw, G);
    xcd_barrier(bar);
    { pg8::Gemm g{G, W4t, NTOK, DM, DM, 0}; pg8::StaticOrder S; S.init(NTOK, DM, gridDim.x, blockIdx.x); EpiY<1> E{nullptr, nullptr, out, stat2, mr1, a.lng, a.lnb}; pg8::gemm_phase<EpiY<1>, pg8::StaticOrder>(lds, g, S, E); }
    xcd_barrier(bar);
    phase_ln<1>(out, stat2, nullptr, a.lng + DM, a.lnb + DM, nullptr);
}

extern "C" void kernel_launch(void* const* d_in, const int* in_sizes, int n_in, void* d_out, int out_size, void* d_ws, size_t ws_size, hipStream_t stream) {
    static int grid = 0;
    if (grid == 0) {
        if (n_in != 16 || out_size != NTOK * DM || ws_size < WS_END) { fprintf(stderr, "kernel_launch: unexpected shapes (n_in %d out %d ws %zu)\n", n_in, out_size, ws_size); grid = -1; return; }
        int dev = 0, cus = 0, per_cu = 0;
        if (hipGetDevice(&dev) != hipSuccess || hipDeviceGetAttribute(&cus, hipDeviceAttributeMultiprocessorCount, dev) != hipSuccess) { grid = -1; return; }
        if (hipFuncSetAttribute((const void*)mega, hipFuncAttributeMaxDynamicSharedMemorySize, LDS_BYTES) != hipSuccess) { fprintf(stderr, "kernel_launch: hipFuncSetAttribute failed\n"); grid = -1; return; }
        if (hipOccupancyMaxActiveBlocksPerMultiprocessor(&per_cu, (const void*)mega, NTHR, LDS_BYTES) != hipSuccess || per_cu < 1) { fprintf(stderr, "kernel_launch: occupancy query says %d blocks per CU\n", per_cu); (void)hipGetLastError(); grid = -1; return; }
        grid = cus;
    }
    if (grid < 0) return;
    (void)hipMemsetAsync((char*)d_ws + WS_CTL, 0, 65536, stream);
    Args a{};
    a.xp = (const float*)d_in[0]; a.xs = (const float*)d_in[1]; a.w_in_even = (const float*)d_in[2]; a.wuf = (const float*)d_in[3]; a.bfw = (const float*)d_in[4];
    a.wub = (const float*)d_in[5]; a.bbw = (const float*)d_in[6]; a.ng = (const float*)d_in[7]; a.sink = (const float*)d_in[8]; a.relb = (const float*)d_in[9];
    a.w_out_even = (const float*)d_in[10]; a.w_in_odd = (const float*)d_in[11]; a.cw = (const float*)d_in[12]; a.w_out_odd = (const float*)d_in[13];
    a.lng = (const float*)d_in[14]; a.lnb = (const float*)d_in[15]; a.out = (float*)d_out; a.ws = (unsigned char*)d_ws;
    hipLaunchKernelGGL(mega, dim3(grid), dim3(NTHR), LDS_BYTES, stream, a);
}
```

```cpp
#include <hip/hip_runtime.h>
#include <cstdio>

typedef unsigned short bf16_t;
typedef short bf16x8 __attribute__((ext_vector_type(8)));
typedef float f32x4 __attribute__((ext_vector_type(4)));
typedef float f32x2 __attribute__((ext_vector_type(2)));
typedef unsigned u32x4 __attribute__((ext_vector_type(4)));
typedef unsigned u32x2 __attribute__((ext_vector_type(2)));
#define LAS __attribute__((address_space(3)))

constexpr int DM = 1024, NTOK = 49152, NPROMPT = 32768, LP = 16384, LS = 4096;
constexpr int UP = 3584;
constexpr int C_QA = 0, C_KA = 512, C_VA = 1024, C_ZA = 1536, C_QB = 2048, C_KB = 2560, C_VB = 2688, C_ZB = 2816, C_GD = 3328;
constexpr int EVEN_IN = 3360, ODD_IN = 4096;
constexpr float DN_ALPHA = 1.41421356237309515f;
constexpr float LN_EPS = 1e-5f, NORM_EPS = 1e-6f;

constexpr size_t MiB = 1u << 20;
constexpr size_t WS_CTL = 0, WS_W1T = 1 * MiB, WS_W2T = 8 * MiB, WS_W3T = 10 * MiB, WS_W4T = 18 * MiB, WS_STAT1 = 20 * MiB, WS_MR1 = 26 * MiB, WS_DEC = 27 * MiB,
                 WS_XB = 28 * MiB  , WS_U = 124 * MiB, WS_ST = 460 * MiB, WS_END = 508 * MiB;
constexpr size_t WS_X1B = WS_U, WS_P = WS_U + 96 * MiB, WS_S = WS_U + 192 * MiB, WS_STAT2 = WS_U + 288 * MiB;

__device__ __forceinline__ float bf2f(bf16_t b) { return __uint_as_float(((unsigned)b) << 16); }
typedef __bf16 nbf16x2 __attribute__((ext_vector_type(2)));
__device__ __forceinline__ bf16_t f2bf(float f) { return __builtin_bit_cast(bf16_t, (__bf16)f); }
__device__ __forceinline__ unsigned pk2(float lo, float hi) { return __builtin_bit_cast(unsigned, __builtin_convertvector((f32x2){lo, hi}, nbf16x2)); }
__device__ __forceinline__ float silu(float x) { return x / (1.0f + __expf(-x)); }
__device__ __forceinline__ float wave_sum(float v) {
#pragma unroll
    for (int o = 1; o < 64; o <<= 1) v += __shfl_xor(v, o);
    return v;
}
__device__ __forceinline__ float wave_max(float v) {
#pragma unroll
    for (int o = 1; o < 64; o <<= 1) v = fmaxf(v, __shfl_xor(v, o));
    return v;
}
__device__ __forceinline__ void seq_of(int row, int& s0, int& L) {
    if (row < NPROMPT) { L = LP; s0 = row & ~(LP - 1); } else { L = LS; s0 = NPROMPT + ((row - NPROMPT) & ~(LS - 1)); }
}

namespace pg8 {
constexpr int BM = 256, BK = 64, HALF = 128, HTB = HALF * BK * 2, STAGE_BYTES = 8 * HTB, NXCD = 8, WGM = 8;
__host__ __device__ __forceinline__ int lds_byte(int r, int c) { const int st = (r >> 4) * 2 + (c >> 5), rr = r & 15, cc = c & 31, ob = rr * 64 + cc * 2; return st * 1024 + (ob ^ (((ob >> 9) & 1) << 5)); }
__host__ __device__ __forceinline__ void stage_rc(int b, int& R, int& C) { const int st = b / 1024, sb = b % 1024, swz = sb ^ (((sb >> 9) & 1) << 5); R = (st >> 1) * 16 + swz / 64; C = (st & 1) * 32 + (swz % 64) / 2; }
__host__ __device__ __forceinline__ int perm32(int rho) { const int n = rho >> 4, i = rho & 15; return 8 * (i >> 2) + 4 * n + (i & 3); }
struct Unit { int pm, pn; };
struct Gemm { const bf16_t* A; const bf16_t* Bt; int M, N, K, pad; };
struct StaticOrder {
    int nM, nN, nwg, G, c;
    __host__ __device__ void init(int M, int N, int G_, int c_) { nM = M / BM; nN = N / BM; nwg = nM * nN; G = G_; c = c_; }
    __host__ __device__ bool next(int i, Unit& u) const {
        const long L = (long)i * G + c; if (L >= nwg) return false;
        int wgid = (int)L; { const int q = nwg / NXCD, r = nwg % NXCD, xcd = wgid % NXCD, off = wgid / NXCD; wgid = (xcd < r ? xcd * (q + 1) : r * (q + 1) + (xcd - r) * q) + off; }
        const int nig = WGM * nN, gid = wgid / nig, fm = gid * WGM, gsz = (nM - fm) < WGM ? (nM - fm) : WGM;
        u.pm = fm + ((wgid % nig) % gsz); u.pn = (wgid % nig) / gsz; return true;
    }
    __device__ __forceinline__ void a_ready(const Unit&) const {}
    __device__ __forceinline__ void done(const Unit&) const {}
};

template <class Epi, class Sched>
__device__ __forceinline__ void gemm_phase(LAS unsigned char* lds, const Gemm g, const Sched& S, const Epi& E) {
    const int tid = threadIdx.x, wid = __builtin_amdgcn_readfirstlane(tid >> 6), lane = tid & 63, wr = wid >> 2, wc = wid & 3, fr = lane & 15, fq = lane >> 4;
    const int K = g.K, nt = K / BK;
    unsigned voffA[2], voffB[2];
#pragma unroll
    for (int i = 0; i < 2; ++i) { int R, C; stage_rc(tid * 16 + i * 8192, R, C); const int Rb = Epi::PERM ? ((R & ~31) + perm32(R & 31)) : R;
        voffA[i] = (unsigned)(R * K + C) * 2u; voffB[i] = (unsigned)(Rb * K + C) * 2u; }
    const size_t kstep = (size_t)(BK * 2);
    const size_t hstep = (size_t)HALF * K * 2;
    const size_t tstep = 2 * hstep;
    const unsigned ldsw = (unsigned)wid * 1024u;
    const int aoff = lds_byte(wr * 64 + fr, fq * 8), boff = lds_byte(wc * 32 + fr, fq * 8);
#define PG8_SA(b, h) (((b) * 2 + (h)) * HTB)
#define PG8_SB(b, h) ((4 + (b) * 2 + (h)) * HTB)
#define PG8_STAGE(bufoff, gbase, voff) do { _Pragma("unroll") for (int _i = 0; _i < 2; ++_i) \
        __builtin_amdgcn_global_load_lds((const unsigned*)((const char*)(gbase) + (voff)[_i]), (LAS unsigned*)(lds + (bufoff) + ldsw + _i * 8192), 16, 0, 0); } while (0)
#define PG8_LDA(dst, b, h) do { _Pragma("unroll") for (int m = 0; m < 4; ++m) _Pragma("unroll") for (int k = 0; k < 2; ++k) dst[m][k] = *(const LAS bf16x8*)(lds + PG8_SA(b, h) + aoff + m * 2048 + k * 1024); } while (0)
#define PG8_LDB(dst, b, h) do { _Pragma("unroll") for (int n = 0; n < 2; ++n) _Pragma("unroll") for (int k = 0; k < 2; ++k) dst[n][k] = *(const LAS bf16x8*)(lds + PG8_SB(b, h) + boff + n * 2048 + k * 1024); } while (0)
#define PG8_MMA(ai, bj, At, Bt) do { __builtin_amdgcn_s_setprio(1); _Pragma("unroll") for (int m = 0; m < 4; ++m) _Pragma("unroll") for (int n = 0; n < 2; ++n) _Pragma("unroll") for (int k = 0; k < 2; ++k) \
        acc[ai][bj][m][n] = __builtin_amdgcn_mfma_f32_16x16x32_bf16(Bt[n][k], At[m][k], acc[ai][bj][m][n], 0, 0, 0); __builtin_amdgcn_s_setprio(0); } while (0)
#define PG8_WAIT_V(n) asm volatile("s_waitcnt vmcnt(" #n ")" ::: "memory")
#define PG8_WAIT_L(n) asm volatile("s_waitcnt lgkmcnt(" #n ")" ::: "memory")
#define PG8_BAR __builtin_amdgcn_s_barrier()
#define PG8_SCHED __builtin_amdgcn_sched_barrier(0)
    Unit cur, nxt; int ui = 0;
    if (!S.next(0, cur)) return;
    f32x4 acc[2][2][4][2];
#pragma unroll
    for (int a = 0; a < 2; ++a)
#pragma unroll
        for (int b = 0; b < 2; ++b)
#pragma unroll
            for (int m = 0; m < 4; ++m)
#pragma unroll
                for (int n = 0; n < 2; ++n) acc[a][b][m][n] = (f32x4){0.f, 0.f, 0.f, 0.f};
    bf16x8 At[4][2], B0[2][2], B1[2][2];
    const char* cA = (const char*)g.A + (size_t)cur.pm * tstep; const char* cB = (const char*)g.Bt + (size_t)cur.pn * tstep;
    S.a_ready(cur);
    PG8_STAGE(PG8_SB(0, 0), cB, voffB); PG8_STAGE(PG8_SA(0, 0), cA, voffA); PG8_STAGE(PG8_SB(0, 1), cB + hstep, voffB); PG8_STAGE(PG8_SA(0, 1), cA + hstep, voffA);
    if (wr == 1) PG8_BAR;
    PG8_WAIT_V(4); PG8_BAR;
    PG8_STAGE(PG8_SB(1, 0), cB + kstep, voffB); PG8_STAGE(PG8_SA(1, 0), cA + kstep, voffA); PG8_STAGE(PG8_SB(1, 1), cB + hstep + kstep, voffB);
    PG8_WAIT_V(6); PG8_BAR;
    for (;;) {
        const bool has_next = S.next(ui + 1, nxt);
        const char* nA = has_next ? (const char*)g.A + (size_t)nxt.pm * tstep : cA; const char* nB = has_next ? (const char*)g.Bt + (size_t)nxt.pn * tstep : cB;
        for (int t = 0; t < nt; t += 2) {
            const bool last = (t == nt - 2);
            const char* a1 = cA + (size_t)(t + 1) * kstep;
            const char* a2 = last ? nA : cA + (size_t)(t + 2) * kstep; const char* b2 = last ? nB : cB + (size_t)(t + 2) * kstep;
            const char* a3 = a2 + kstep; const char* b3 = b2 + kstep;
            if (last && has_next) S.a_ready(nxt);
            PG8_LDB(B0, 0, 0); PG8_SCHED; PG8_LDA(At, 0, 0); PG8_STAGE(PG8_SA(1, 1), a1 + hstep, voffA);
            PG8_WAIT_L(8); PG8_BAR; PG8_WAIT_L(0); PG8_MMA(0, 0, At, B0); PG8_BAR; PG8_SCHED;
            PG8_LDB(B1, 0, 1); PG8_STAGE(PG8_SB(0, 0), b2, voffB);
            PG8_BAR; PG8_WAIT_L(0); PG8_MMA(0, 1, At, B1); PG8_BAR;
            PG8_LDA(At, 0, 1); PG8_STAGE(PG8_SA(0, 0), a2, voffA);
            PG8_BAR; PG8_WAIT_L(0); PG8_MMA(1, 0, At, B0); PG8_BAR; PG8_SCHED;
            PG8_STAGE(PG8_SB(0, 1), b2 + hstep, voffB);
            PG8_WAIT_V(6); PG8_BAR; PG8_MMA(1, 1, At, B1); PG8_BAR;
            PG8_LDB(B0, 1, 0); PG8_SCHED; PG8_LDA(At, 1, 0); PG8_STAGE(PG8_SA(0, 1), a2 + hstep, voffA);
            PG8_WAIT_L(8); PG8_BAR; PG8_WAIT_L(0); PG8_MMA(0, 0, At, B0); PG8_BAR; PG8_SCHED;
            PG8_LDB(B1, 1, 1); PG8_STAGE(PG8_SB(1, 0), b3, voffB);
            PG8_BAR; PG8_WAIT_L(0); PG8_MMA(0, 1, At, B1); PG8_BAR;
            PG8_LDA(At, 1, 1); PG8_STAGE(PG8_SA(1, 0), a3, voffA);
            PG8_BAR; PG8_WAIT_L(0); PG8_MMA(1, 0, At, B0); PG8_BAR; PG8_SCHED;
            PG8_STAGE(PG8_SB(1, 1), b3 + hstep, voffB);
            PG8_WAIT_V(6); PG8_BAR; PG8_MMA(1, 1, At, B1); PG8_BAR;
        }
        E(acc, cur, wr, wc, fr, fq); S.done(cur);
        if (!has_next) break;
#pragma unroll
        for (int a = 0; a < 2; ++a)
#pragma unroll
            for (int b = 0; b < 2; ++b)
#pragma unroll
                for (int m = 0; m < 4; ++m)
#pragma unroll
                    for (int n = 0; n < 2; ++n) acc[a][b][m][n] = (f32x4){0.f, 0.f, 0.f, 0.f};
        cur = nxt; cA = nA; cB = nB; ++ui;
    }
    PG8_WAIT_V(0);
    if (wr == 0) PG8_BAR;
    PG8_BAR;
#undef PG8_SA
#undef PG8_SB
#undef PG8_STAGE
#undef PG8_LDA
#undef PG8_LDB
#undef PG8_MMA
#undef PG8_WAIT_V
#undef PG8_WAIT_L
#undef PG8_BAR
#undef PG8_SCHED
}
}

struct EpiU {
    static constexpr bool PERM = true, AFTER_DRAIN = false;
    bf16_t* O;
    __device__ __forceinline__ void operator()(const f32x4 (&acc)[2][2][4][2], const pg8::Unit& u, int wr, int wc, int fr, int fq) const {
        const int row0 = u.pm * 256 + wr * 64 + fr, col0 = u.pn * 256 + wc * 32 + 8 * fq;
#pragma unroll
        for (int ai = 0; ai < 2; ++ai)
#pragma unroll
            for (int m = 0; m < 4; ++m) { bf16_t* rowp = O + (size_t)(row0 + ai * 128 + m * 16) * UP + col0;
#pragma unroll
                for (int bj = 0; bj < 2; ++bj) { const f32x4 v0 = acc[ai][bj][m][0], v1 = acc[ai][bj][m][1];
                    u32x4 w; w.x = pk2(v0[0], v0[1]); w.y = pk2(v0[2], v0[3]); w.z = pk2(v1[0], v1[1]); w.w = pk2(v1[2], v1[3]);
                    *(u32x4*)(rowp + bj * 128) = w; } }
    }
};
template <int LAYER> struct EpiY {
    static constexpr bool PERM = false, AFTER_DRAIN = false;
    const float* xp; const float* xs; float* Y; f32x2* stat; const f32x2* mr; const float* lg; const float* lb;
    __device__ __forceinline__ void operator()(const f32x4 (&acc)[2][2][4][2], const pg8::Unit& u, int wr, int wc, int fr, int fq) const {
        const int col0 = u.pn * 256 + wc * 32 + 4 * fq;
        f32x4 gv[2][2], bv[2][2];
        if (LAYER == 1) {
#pragma unroll
            for (int bj = 0; bj < 2; ++bj)
#pragma unroll
                for (int n = 0; n < 2; ++n) { gv[bj][n] = *(const f32x4*)(lg + col0 + bj * 128 + n * 16); bv[bj][n] = *(const f32x4*)(lb + col0 + bj * 128 + n * 16); }
        }
#pragma unroll
        for (int ai = 0; ai < 2; ++ai)
#pragma unroll
            for (int m = 0; m < 4; ++m) {
                const int row = u.pm * 256 + ai * 128 + wr * 64 + m * 16 + fr;
                const float* rp; f32x2 mrv = (f32x2){0.f, 1.f};
                if (LAYER == 0) rp = (row < NPROMPT) ? xp + (size_t)row * DM : xs + (size_t)(row - NPROMPT) * DM;
                else { rp = Y + (size_t)row * DM; mrv = mr[row]; }
                float* yp = Y + (size_t)row * DM;
                float s = 0.f, q = 0.f;
#pragma unroll
                for (int bj = 0; bj < 2; ++bj)
#pragma unroll
                    for (int n = 0; n < 2; ++n) {
                        const int c = col0 + bj * 128 + n * 16;
                        f32x4 r = *(const f32x4*)(rp + c);
                        if (LAYER == 1) r = (r - mrv.x) * mrv.y * gv[bj][n] + bv[bj][n];
                        const f32x4 y = r * DN_ALPHA + acc[ai][bj][m][n];
                        *(f32x4*)(yp + c) = y;
                        s += (y[0] + y[1]) + (y[2] + y[3]); q += (y[0] * y[0] + y[1] * y[1]) + (y[2] * y[2] + y[3] * y[3]);
                    }
                s += __shfl_xor(s, 16); s += __shfl_xor(s, 32); q += __shfl_xor(q, 16); q += __shfl_xor(q, 32);
                if (fq == 0) stat[(size_t)row * 16 + u.pn * 4 + wc] = (f32x2){s, q};
            }
    }
};
struct EpiPS {
    static constexpr bool PERM = true, AFTER_DRAIN = false;
    bf16_t* P; bf16_t* S;
    __device__ __forceinline__ void operator()(const f32x4 (&acc)[2][2][4][2], const pg8::Unit& u, int wr, int wc, int fr, int fq) const {
        const int row0 = u.pm * 256 + wr * 64 + fr, off = (wc & 1) * 32 + 8 * fq;
        bf16_t* dst = (wc < 2 ? S : P) + u.pn * 64 + off;
#pragma unroll
        for (int ai = 0; ai < 2; ++ai)
#pragma unroll
            for (int m = 0; m < 4; ++m) {
                float o[8];
#pragma unroll
                for (int n = 0; n < 2; ++n)
#pragma unroll
                    for (int j = 0; j < 4; ++j) { const float a = acc[ai][0][m][n][j], b = acc[ai][1][m][n][j];
                        o[4 * n + j] = (wc < 2) ? silu(b) * a : a * b; }
                u32x4 w; w.x = pk2(o[0], o[1]); w.y = pk2(o[2], o[3]); w.z = pk2(o[4], o[5]); w.w = pk2(o[6], o[7]);
                *(u32x4*)(dst + (size_t)(row0 + ai * 128 + m * 16) * DM) = w;
            }
    }
};

#define XB_TMO      128
#define XB_XCNT(j)  (256  + 64 * (j))
#define XB_XSUB(j)  (1280 + 64 * (j))
#define XB_XGEN(j)  (2304 + 64 * (j))
#define XB_TOP      3328
#define XB_TOPGEN   3392
#define XCD_BAR_WORDS 3456
#define XB_SPIN_CAP (1u << 27)
__device__ __forceinline__ unsigned xb_ld(unsigned* p)              { return __hip_atomic_load(p, __ATOMIC_RELAXED, __HIP_MEMORY_SCOPE_AGENT); }
__device__ __forceinline__ unsigned xb_add(unsigned* p, unsigned v) { return __hip_atomic_fetch_add(p, v, __ATOMIC_RELAXED, __HIP_MEMORY_SCOPE_AGENT); }
__device__ __forceinline__ unsigned xb_xcc_id() { return (unsigned)__builtin_amdgcn_s_getreg((3 << 11) | 20) & 0xFu; }
#define XB_SPIN(cond, bar) do { unsigned _sp = 0; while (cond) { __builtin_amdgcn_s_sleep(1); \
    if ((++_sp & 255u) == 0u) { if (xb_ld(&(bar)[XB_TMO])) break; if (_sp > XB_SPIN_CAP) { atomicAdd(&(bar)[XB_TMO], 1u); break; } } } } while (0)
struct XcdBarrier { unsigned* bar; unsigned x; volatile LAS unsigned* st; };
__device__ __forceinline__ XcdBarrier xcd_barrier_post(unsigned* bar, volatile LAS unsigned* st) {
    XcdBarrier b; b.bar = bar; b.x = xb_xcc_id(); b.st = st;
    if (threadIdx.x == 0) (void)xb_add(&bar[XB_XCNT(b.x)], 1u);
    return b;
}
__device__ __forceinline__ void xcd_barrier_complete(unsigned* bar, unsigned x, unsigned& nloc, unsigned& nx) {
    const unsigned G = gridDim.x * gridDim.y * gridDim.z;
    unsigned sum, cnt, mine, sp = 0u;
    for (;;) {
        sum = 0u; cnt = 0u; mine = 0u;
#pragma unroll
        for (unsigned j = 0; j < 16; ++j) { const unsigned c = xb_ld(&bar[XB_XCNT(j)]); sum += c; cnt += (c > 0u) ? 1u : 0u; mine = (j == x) ? c : mine; }
        if (sum == G) break;
        __builtin_amdgcn_s_sleep(1);
        if ((++sp & 255u) == 0u) { if (xb_ld(&bar[XB_TMO])) break; if (sp > XB_SPIN_CAP) { atomicAdd(&bar[XB_TMO], 1u); break; } }
    }
    nloc = mine > 0u ? mine : 1u; nx = cnt > 0u ? cnt : 1u;
}
__device__ __forceinline__ void xcd_barrier(const XcdBarrier& b) {
    asm volatile("s_waitcnt vmcnt(0)" ::: "memory");
    __syncthreads();
    if (threadIdx.x == 0) {
        unsigned* bar = b.bar;
        __builtin_amdgcn_s_waitcnt(0);
        unsigned nloc = b.st[0], nx = b.st[1];
        if (nloc == 0u) { xcd_barrier_complete(bar, b.x, nloc, nx); b.st[0] = nloc; b.st[1] = nx; }
        const unsigned old = xb_add(&bar[XB_XSUB(b.x)], 1u);
        const unsigned gen = old / nloc;
        if (old + 1u == (gen + 1u) * nloc) {
            __builtin_amdgcn_fence(__ATOMIC_RELEASE, "agent");
            asm volatile("s_waitcnt vmcnt(0)" ::: "memory");
            const unsigned og = xb_add(&bar[XB_TOP], 1u);
            const unsigned tg = og / nx;
            if (og + 1u == (tg + 1u) * nx) xb_add(&bar[XB_TOPGEN], 1u);
            else XB_SPIN(xb_ld(&bar[XB_TOPGEN]) == tg, bar);
            __builtin_amdgcn_fence(__ATOMIC_ACQUIRE, "agent");
            xb_add(&bar[XB_XGEN(b.x)], 1u);
            asm volatile("s_waitcnt vmcnt(0)" ::: "memory");
        } else {
            XB_SPIN(xb_ld(&bar[XB_XGEN(b.x)]) == gen, bar);
            __builtin_amdgcn_fence(__ATOMIC_ACQUIRE, "agent");
            asm volatile("s_waitcnt vmcnt(0)" ::: "memory");
        }
    }
    __syncthreads();
}

struct Args {
    const float *xp, *xs, *w_in_even, *wuf, *bfw, *wub, *bbw, *ng, *sink, *relb, *w_out_even, *w_in_odd, *cw, *w_out_odd, *lng, *lnb;
    float* out; unsigned char* ws;
};
constexpr int NTHR = 512;
constexpr int LDS_BYTES = 147456, MISC_OFF = 131072 + 1024;

template <int MODE> __device__ __forceinline__ int wmap(int n, float& sc) {
    sc = 1.f;
    if (MODE == 0) return n;
    if (MODE == 1) {
        if (n < 512) sc = 0.08838834764831845f;
        if (n >= C_QB && n < C_KB) sc = 0.125f;
        if (n < 2048) return n;
        if (n < C_GD) return n + 32;
        if (n < C_GD + 32) return n - C_GD + 2048;
        return -1;
    }
    const int w = n & 255, grp = w >> 6, ch = (n >> 8) * 64 + (w & 63);
    const int base = grp == 0 ? 0 : (grp == 1 ? 1024 : (grp == 2 ? 3072 : 2048));
    return base + ch;
}
template <int MODE> __device__ __forceinline__ void wconv_item(const float* __restrict__ W, int Nsrc, bf16_t* __restrict__ Wt, int Ndst, int item, LAS float* tile, int t256) {
    const int nb = item % (Ndst / 64), kb = item / (Ndst / 64), n0 = nb * 64, k0 = kb * 64;
    const int tx = t256 & 63, ty = t256 >> 6;
    float sc; const int src = wmap<MODE>(n0 + tx, sc);
    for (int kk = ty; kk < 64; kk += 4) tile[kk * 65 + tx] = src >= 0 ? W[(size_t)(k0 + kk) * Nsrc + src] * sc : 0.f;
    __syncthreads();
    for (int nn = ty; nn < 64; nn += 4) Wt[(size_t)(n0 + nn) * 1024 + k0 + tx] = f2bf(tile[tx * 65 + nn]);
    __syncthreads();
}
__device__ __forceinline__ void phase_convert(const Args& a, LAS unsigned char* lds) {
    unsigned char* ws = a.ws;
    bf16_t* W1t = (bf16_t*)(ws + WS_W1T); bf16_t* W2t = (bf16_t*)(ws + WS_W2T); bf16_t* W3t = (bf16_t*)(ws + WS_W3T); bf16_t* W4t = (bf16_t*)(ws + WS_W4T);
    const int half = threadIdx.x >> 8, t256 = threadIdx.x & 255;
    LAS float* tile = (LAS float*)lds + half * (64 * 65);
    constexpr int I1 = (UP / 64) * 16, I2 = 16 * 16, I3 = 64 * 16, I4 = 16 * 16, NIT = I1 + I2 + I3 + I4;
    for (int it0 = blockIdx.x * 2; it0 < NIT; it0 += gridDim.x * 2) {
        int r = it0 + half;
        if (r < I1) wconv_item<1>(a.w_in_even, EVEN_IN, W1t, UP, r, tile, t256);
        else if ((r -= I1) < I2) wconv_item<0>(a.w_out_even, 1024, W2t, 1024, r, tile, t256);
        else if ((r -= I2) < I3) wconv_item<2>(a.w_in_odd, ODD_IN, W3t, 4096, r, tile, t256);
        else if ((r -= I3) < I4) wconv_item<0>(a.w_out_odd, 1024, W4t, 1024, r, tile, t256);
        else { __syncthreads(); __syncthreads(); }
    }
    bf16_t* xb = (bf16_t*)(ws + WS_XB);
    const size_t n8 = (size_t)NTOK * DM / 8;
    for (size_t i = (size_t)blockIdx.x * NTHR + threadIdx.x; i < n8; i += (size_t)gridDim.x * NTHR) {
        const size_t e = i * 8; const float* src = e < (size_t)NPROMPT * DM ? a.xp + e : a.xs + (e - (size_t)NPROMPT * DM);
        const f32x4 v0 = *(const f32x4*)src, v1 = *(const f32x4*)(src + 4);
        u32x4 w; w.x = pk2(v0[0], v0[1]); w.y = pk2(v0[2], v0[3]); w.z = pk2(v1[0], v1[1]); w.w = pk2(v1[2], v1[3]);
        *(u32x4*)(xb + e) = w;
    }
}

__device__ __forceinline__ void phase_gla_naive(const Args& a, LAS unsigned char* lds, float* OF, float* OB) {
    if (blockIdx.x >= 12) return;
    const bf16_t* U = (const bf16_t*)(a.ws + WS_U);
    const int grp = threadIdx.x >> 7, tid = threadIdx.x & 127, b = blockIdx.x * 4 + grp, dir = b & 1, h = (b >> 1) & 3, s = b >> 3;
    LAS float* sq = (LAS float*)lds + grp * (3 * 16 * 128); LAS float* sk = sq + 16 * 128; LAS float* sd = sk + 16 * 128;
    const int L = s < 2 ? LP : LS, start = s < 2 ? s * LP : NPROMPT + (s - 2) * LS;
    const float* wu = dir ? a.wub : a.wuf; const float* bias = dir ? a.bbw : a.bfw; float* O = dir ? OB : OF;
    float wr[16];
#pragma unroll
    for (int r = 0; r < 16; ++r) wr[r] = wu[r * 512 + h * 128 + tid];
    const float bb = bias[h * 128 + tid];
    float S[128];
#pragma unroll
    for (int i = 0; i < 128; ++i) S[i] = 0.f;
    for (int t0 = 0; t0 < L; t0 += 16) {
        for (int tt = 0; tt < 16; ++tt) {
            const int p = t0 + tt, tok = start + (dir ? L - 1 - p : p);
            const bf16_t* ur = U + (size_t)tok * UP;
            float x = bb;
#pragma unroll
            for (int r = 0; r < 16; ++r) x += bf2f(ur[C_GD + dir * 16 + r]) * wr[r];
            const float ls = fminf(x, 0.f) - log1pf(expf(-fabsf(x)));
            sd[tt * 128 + tid] = expf(ls * (1.0f / 16.0f));
            sq[tt * 128 + tid] = bf2f(ur[C_QA + h * 128 + tid]);
            sk[tt * 128 + tid] = bf2f(ur[C_KA + h * 128 + tid]);
        }
        __syncthreads();
        for (int tt = 0; tt < 16; ++tt) {
            const int p = t0 + tt, tok = start + (dir ? L - 1 - p : p);
            const float v = bf2f(U[(size_t)tok * UP + C_VA + h * 128 + tid]);
            float acc = 0.f;
#pragma unroll
            for (int dk = 0; dk < 128; dk += 4) {
                const f32x4 d4 = *(const LAS f32x4*)&sd[tt * 128 + dk], q4 = *(const LAS f32x4*)&sq[tt * 128 + dk], k4 = *(const LAS f32x4*)&sk[tt * 128 + dk];
#pragma unroll
                for (int j = 0; j < 4; ++j) {
                    const float sdec = S[dk + j] * d4[j];
                    const float sn = sdec + k4[j] * v;
                    acc += q4[j] * (dir ? sdec : sn);
                    S[dk + j] = sn;
                }
            }
            O[(size_t)tok * 512 + h * 128 + tid] = acc;
        }
        __syncthreads();
    }
}
__device__ __forceinline__ void phase_gla_combine(const Args& a, const float* OF, const float* OB) {
    const bf16_t* U = (const bf16_t*)(a.ws + WS_U); bf16_t* ymix = (bf16_t*)(a.ws + WS_XB);
    const int lane = threadIdx.x & 63;
    for (int w = blockIdx.x * 8 + (threadIdx.x >> 6); w < NTOK * 4; w += gridDim.x * 8) {
        const int tok = w >> 2, h = w & 3;
        const size_t o = (size_t)tok * 512 + h * 128 + lane * 2;
        const float a0 = OF[o] + OB[o], a1 = OF[o + 1] + OB[o + 1];
        const float ss = wave_sum(a0 * a0 + a1 * a1);
        const float rstd = rsqrtf(ss * (1.0f / 128.0f) + NORM_EPS);
        const bf16_t* z = U + (size_t)tok * UP + C_ZA + h * 128 + lane * 2;
        const float y0 = a0 * rstd * a.ng[lane * 2] * silu(bf2f(z[0])), y1 = a1 * rstd * a.ng[lane * 2 + 1] * silu(bf2f(z[1]));
        *(unsigned*)(ymix + (size_t)tok * DM + h * 128 + lane * 2) = pk2(y0, y1);
    }
}
__device__ __forceinline__ int t5_bucket(int rel) {
    const int n = rel < 0 ? -rel : rel;
    int b = n < 8 ? n : (n < 12 ? 8 : (n < 16 ? 9 : (n < 23 ? 10 : (n < 32 ? 11 : (n < 46 ? 12 : (n < 64 ? 13 : (n < 91 ? 14 : 15)))))));
    return b + (rel > 0 ? 16 : 0);
}
__device__ __forceinline__ void phase_swa_naive(const Args& a, LAS unsigned char* lds) {
    const bf16_t* U = (const bf16_t*)(a.ws + WS_U); bf16_t* ymix = (bf16_t*)(a.ws + WS_XB);
    const int wv = threadIdx.x >> 6, lane = threadIdx.x & 63;
    LAS float* sq = (LAS float*)(lds + 65536) + wv * 64; LAS float* sp = (LAS float*)(lds + 65536 + 2048) + wv * 320;
    for (int w = blockIdx.x * 8 + wv; w < NTOK * 8; w += gridDim.x * 8) {
        const int tok = w >> 3, hq = w & 7, kv = hq >> 2;
        int s0, L; seq_of(tok, s0, L); const int i = tok - s0;
        sq[lane] = bf2f(U[(size_t)tok * UP + C_QB + hq * 64 + lane]);
        const float snk = a.sink[hq];
        float sc[5]; float mx = snk;
#pragma unroll
        for (int c = 0; c < 5; ++c) {
            const int jj = c * 64 + lane, j = i - 128 + jj; const bool valid = jj <= 256 && j >= 0 && j < L;
            float d = -INFINITY;
            if (valid) {
                const bf16_t* kr = U + (size_t)(s0 + j) * UP + C_KB + kv * 64; d = 0.f;
#pragma unroll
                for (int e = 0; e < 64; e += 8) { const u32x4 kk = *(const u32x4*)(kr + e);
                    d += sq[e] * __uint_as_float(kk.x << 16) + sq[e + 1] * __uint_as_float(kk.x & 0xffff0000u) + sq[e + 2] * __uint_as_float(kk.y << 16) + sq[e + 3] * __uint_as_float(kk.y & 0xffff0000u)
                       + sq[e + 4] * __uint_as_float(kk.z << 16) + sq[e + 5] * __uint_as_float(kk.z & 0xffff0000u) + sq[e + 6] * __uint_as_float(kk.w << 16) + sq[e + 7] * __uint_as_float(kk.w & 0xffff0000u); }
                d += a.relb[t5_bucket(j - i) * 8 + hq];
            }
            sc[c] = d; mx = fmaxf(mx, d);
        }
        mx = wave_max(mx);
        float den = 0.f;
#pragma unroll
        for (int c = 0; c < 5; ++c) { sc[c] = sc[c] == -INFINITY ? 0.f : __expf(sc[c] - mx); den += sc[c]; }
        den = wave_sum(den) + __expf(snk - mx);
        const float inv = 1.0f / den;
#pragma unroll
        for (int c = 0; c < 5; ++c) sp[c * 64 + lane] = sc[c] * inv;
        float o = 0.f;
        for (int jj = 0; jj <= 256; ++jj) { const int j = i - 128 + jj; if (j >= 0 && j < L) o += sp[jj] * bf2f(U[(size_t)(s0 + j) * UP + C_VB + kv * 64 + lane]); }
        const float z = bf2f(U[(size_t)tok * UP + C_ZB + hq * 64 + lane]);
        ymix[(size_t)tok * DM + 512 + hq * 64 + lane] = f2bf(o * silu(z));
    }
}
template <int FINAL>
__device__ __forceinline__ void phase_ln(float* Y, const f32x2* stat, f32x2* mr, const float* lg, const float* lb, bf16_t* xb) {
    const int lane = threadIdx.x & 63;
    for (int row = blockIdx.x * 8 + (threadIdx.x >> 6); row < NTOK; row += gridDim.x * 8) {
        f32x2 p = lane < 16 ? stat[(size_t)row * 16 + lane] : (f32x2){0.f, 0.f};
        const float s = wave_sum(p.x), q = wave_sum(p.y);
        const float mean = s * (1.0f / DM), var = q * (1.0f / DM) - mean * mean, rstd = rsqrtf(fmaxf(var, 0.f) + LN_EPS);
        if (!FINAL && lane == 0) mr[row] = (f32x2){mean, rstd};
#pragma unroll
        for (int j = 0; j < 4; ++j) {
            const int c = j * 256 + lane * 4;
            const f32x4 y = *(const f32x4*)(Y + (size_t)row * DM + c), g = *(const f32x4*)(lg + c), b = *(const f32x4*)(lb + c);
            const f32x4 o = (y - mean) * rstd * g + b;
            if (FINAL) *(f32x4*)(Y + (size_t)row * DM + c) = o;
            else { u32x2 w; w.x = pk2(o[0], o[1]); w.y = pk2(o[2], o[3]); *(u32x2*)(xb + (size_t)row * DM + c) = w; }
        }
    }
}
__device__ __forceinline__ void phase_convgate(const bf16_t* P, const bf16_t* S, const float* cw, bf16_t* G) {
    const size_t n8 = (size_t)NTOK * DM / 8;
    for (size_t i = (size_t)blockIdx.x * NTHR + threadIdx.x; i < n8; i += (size_t)gridDim.x * NTHR) {
        const int row = (int)(i >> 7), c = (int)(i & 127) * 8; int s0, L; seq_of(row, s0, L);
        const bool hasl = row > s0, hasr = row < s0 + L - 1;
        const u32x4 pm = *(const u32x4*)(P + (size_t)row * DM + c), sv = *(const u32x4*)(S + (size_t)row * DM + c);
        u32x4 pl = (u32x4){0, 0, 0, 0}, pr = (u32x4){0, 0, 0, 0};
        if (hasl) pl = *(const u32x4*)(P + (size_t)(row - 1) * DM + c);
        if (hasr) pr = *(const u32x4*)(P + (size_t)(row + 1) * DM + c);
        float o[8];
#pragma unroll
        for (int j = 0; j < 4; ++j) {
            const unsigned l = pl[j], m = pm[j], r = pr[j], sw = sv[j];
            const int cc = c + 2 * j;
            o[2 * j] = __uint_as_float(sw << 16) * (cw[cc] * __uint_as_float(l << 16) + cw[1024 + cc] * __uint_as_float(m << 16) + cw[2048 + cc] * __uint_as_float(r << 16));
            o[2 * j + 1] = __uint_as_float(sw & 0xffff0000u) * (cw[cc + 1] * __uint_as_float(l & 0xffff0000u) + cw[1024 + cc + 1] * __uint_as_float(m & 0xffff0000u) + cw[2048 + cc + 1] * __uint_as_float(r & 0xffff0000u));
        }
        u32x4 w; w.x = pk2(o[0], o[1]); w.y = pk2(o[2], o[3]); w.z = pk2(o[4], o[5]); w.w = pk2(o[6], o[7]);
        *(u32x4*)(G + (size_t)row * DM + c) = w;
    }
}

typedef short s16x4 __attribute__((ext_vector_type(4)));
constexpr int GL_QT = 0, GL_KT = 16384, GL_VT = 32768, GL_PT = 49152, GL_B = 57344, GL_GD = 90112, GL_TOT = 94208, GL_EBL = 96256  , GL_SSW = 97280, GL_RSTD = 99328;
constexpr int NSEG = NTOK / 256;
__device__ __forceinline__ unsigned offb(unsigned row, unsigned ch) { return 256u * row + 16u * (ch ^ (((row & 3) << 2) | ((row >> 2) & 3))); }
__device__ __forceinline__ unsigned offp(unsigned row, unsigned ch) { return 128u * row + 16u * (ch ^ (row & 7)); }
__device__ __forceinline__ unsigned rr16(unsigned lane, unsigned rb, unsigned s) { return offb((lane & 15) + 16 * rb, 4 * s + (lane >> 4)); }
__device__ __forceinline__ unsigned tr16(unsigned lane, unsigned c, unsigned ks, unsigned t) {
    const unsigned g = lane >> 4, q = (lane & 15) >> 2, p = lane & 3;
    return offb(32 * ks + 8 * g + 4 * t + q, 2 * c + (p >> 1)) + 8 * (p & 1);
}
__device__ __forceinline__ bf16x8 tr_read8(unsigned a0, unsigned a1) {
    s16x4 r0, r1;
    asm volatile("ds_read_b64_tr_b16 %0, %2\n\tds_read_b64_tr_b16 %1, %3\n\ts_waitcnt lgkmcnt(0)" : "=&v"(r0), "=&v"(r1) : "v"(a0), "v"(a1) : "memory");
    return __builtin_shufflevector(r0, r1, 0, 1, 2, 3, 4, 5, 6, 7);
}
__device__ __forceinline__ void unpack8(const u32x4 w, float (&f)[8]) {
#pragma unroll
    for (int j = 0; j < 4; ++j) { f[2 * j] = __uint_as_float(w[j] << 16); f[2 * j + 1] = __uint_as_float(w[j] & 0xffff0000u); }
}
#define MFMA16(a, b, c) __builtin_amdgcn_mfma_f32_16x16x32_bf16((a), (b), (c), 0, 0, 0)

struct GlaPre { u32x4 gd[4]; u32x4 q[2], k[2], v[2]; };
template <int MODE>
__device__ __forceinline__ void gla_prefetch(const Args& a, GlaPre& pre, int tid, int tb, int h, int dir) {
    const bf16_t* U = (const bf16_t*)(a.ws + WS_U);
    const int lane = tid & 63, n = lane & 15, g = lane >> 4;
#pragma unroll
    for (int it = 0; it < 4; ++it) { const int row = 16 * it + n, tok = dir ? tb + 63 - row : tb + row; pre.gd[it] = *(const u32x4*)(U + (size_t)tok * UP + C_GD + dir * 16 + 8 * (g & 1)); }
#pragma unroll
    for (int i = 0; i < 2; ++i) {
        const int idx = tid + 512 * i, row = idx >> 4, ch = idx & 15, tok = dir ? tb + 63 - row : tb + row;
        const bf16_t* ur = U + (size_t)tok * UP + h * 128 + ch * 8;
        if (MODE == 0) { pre.v[i] = *(const u32x4*)(ur + C_VA); pre.k[i] = *(const u32x4*)(ur + C_KA); }
    }
}
__device__ __forceinline__ bf16x8 tr_read8(LAS unsigned char* lds, unsigned a0, unsigned a1) {
    const s16x4 r0 = __builtin_amdgcn_ds_read_tr16_b64_v4i16((LAS s16x4*)(lds + a0)), r1 = __builtin_amdgcn_ds_read_tr16_b64_v4i16((LAS s16x4*)(lds + a1));
    return __builtin_shufflevector(r0, r1, 0, 1, 2, 3, 4, 5, 6, 7);
}
template <int MODE>
__device__ __forceinline__ void gla_chunk(const Args& a, LAS unsigned char* lds, const int tb, const int h, const int dir, const bf16x8 wfrag, const float wbias,
                                          f32x4 (&Sacc)[8], float& lam, u32x4* stash, GlaPre& pre, const int ntb, const int nh, const int ndir, const int par) {
    const bf16_t* U = (const bf16_t*)(a.ws + WS_U);
    int tid = threadIdx.x; asm volatile("" : "+v"(tid));
    const int lane = tid & 63, w = __builtin_amdgcn_readfirstlane(tid >> 6), n = lane & 15, g = lane >> 4;
    const unsigned fn = ((n & 3) << 2) | ((n >> 2) & 3);
    const unsigned base_rr = 256u * n + 16u * (g ^ fn);
    const unsigned base_c = 256u * n + 16u * ((g >> 1) ^ fn) + 8u * (g & 1);
    const unsigned base_p = 128u * n + 16u * (g ^ (n & 7));
    const unsigned trb0 = tr16(lane, 0, 0, 0), trb1 = tr16(lane, 0, 0, 1);
    GlaPre cur = pre;
    gla_prefetch<MODE>(a, pre, tid, ntb, nh, ndir);
    int prow[2], pch[2], ptok[2];
#pragma unroll
    for (int i = 0; i < 2; ++i) { const int idx = tid + 512 * i; prow[i] = idx >> 4; pch[i] = idx & 15; ptok[i] = dir ? tb + 63 - prow[i] : tb + prow[i]; }
    if (MODE != 0) {
#pragma unroll
        for (int i = 0; i < 2; ++i) { const bf16_t* ur = U + (size_t)ptok[i] * UP + h * 128 + pch[i] * 8; cur.q[i] = *(const u32x4*)(ur + C_QA); cur.k[i] = *(const u32x4*)(ur + C_KA); cur.v[i] = *(const u32x4*)(ur + C_VA); }
    }
    u32x4 st0, st1, zraw[2];
    {
        LAS float* B = (LAS float*)(lds + GL_B);
        float carry = 0.f;
#pragma unroll
        for (int it = 0; it < 4; ++it) {
            f32x4 x = MFMA16(__builtin_bit_cast(bf16x8, cur.gd[it]), wfrag, ((f32x4){wbias, wbias, wbias, wbias}));
            float pfx[4]; float run = 0.f;
#pragma unroll
            for (int r = 0; r < 4; ++r) { const float xv = x[r]; const float ls = fminf(xv, 0.f) - __logf(1.0f + __expf(-fabsf(xv))); run += ls * (1.0f / 16.0f); pfx[r] = run; }
            const float t0 = __shfl(run, n), t1 = __shfl(run, n + 16), t2 = __shfl(run, n + 32), t3 = __shfl(run, n + 48);
            const float before = carry + (g > 0 ? t0 : 0.f) + (g > 1 ? t1 : 0.f) + (g > 2 ? t2 : 0.f);
#pragma unroll
            for (int r = 0; r < 4; ++r) B[(16 * it + 4 * g + r) * 128 + 16 * w + n] = before + pfx[r];
            carry += (t0 + t1) + (t2 + t3);
        }
        if (g == 0) ((LAS float*)(lds + GL_EBL + par * 512))[16 * w + n] = __expf(carry);
        lam += carry;
    }
    __syncthreads();
#pragma unroll
    for (int i = 0; i < 2; ++i) {
        const LAS f32x4* bp = (const LAS f32x4*)(lds + GL_B + (prow[i] * 128 + pch[i] * 8) * 4);
        const f32x4 b0 = bp[0], b1 = bp[1];
        float e[8], kf[8];
#pragma unroll
        for (int j = 0; j < 4; ++j) { e[j] = __expf(b0[j]); e[4 + j] = __expf(b1[j]); }
        unpack8(cur.k[i], kf);
        u32x4 kw;
#pragma unroll
        for (int j = 0; j < 4; ++j) kw[j] = pk2(kf[2 * j] * __builtin_amdgcn_rcpf(e[2 * j]), kf[2 * j + 1] * __builtin_amdgcn_rcpf(e[2 * j + 1]));
        *(LAS u32x4*)(lds + GL_KT + offb(prow[i], pch[i])) = kw;
        *(LAS u32x4*)(lds + GL_VT + offb(prow[i], pch[i])) = cur.v[i];
        if (MODE != 0) {
            float qf[8]; unpack8(cur.q[i], qf);
            u32x4 qw;
#pragma unroll
            for (int j = 0; j < 4; ++j) qw[j] = pk2(qf[2 * j] * e[2 * j], qf[2 * j + 1] * e[2 * j + 1]);
            *(LAS u32x4*)(lds + GL_QT + offb(prow[i], pch[i])) = qw;
        }
    }
    __syncthreads();
    f32x4 Oacc[4];
    if (MODE != 0) {
        const int it = w >> 1;
        bf16x8 qa[4];
#pragma unroll
        for (int s = 0; s < 4; ++s) qa[s] = *(const LAS bf16x8*)(lds + GL_QT + (base_rr ^ (64u * s)) + 4096u * it);
#pragma unroll
        for (int jj = 0; jj < 2; ++jj) {
            const int jt = 2 * (w & 1) + jj;
            f32x4 pacc = (f32x4){0.f, 0.f, 0.f, 0.f};
            if (jt <= it) {
#pragma unroll
                for (int s = 0; s < 4; ++s) { const bf16x8 kb = *(const LAS bf16x8*)(lds + GL_KT + (base_rr ^ (64u * s)) + 4096u * jt); pacc = MFMA16(qa[s], kb, pacc); }
            }
            const int j = 16 * jt + n;
#pragma unroll
            for (int r = 0; r < 4; ++r) {
                const int i = 16 * it + 4 * g + r;
                const bool keep = (MODE == 1) ? (j <= i) : (j < i);
                *(LAS bf16_t*)(lds + GL_PT + offp(i, j >> 3) + 2 * (j & 7)) = keep ? f2bf(pacc[r]) : (bf16_t)0;
            }
        }
        bf16x8 sb[4];
#pragma unroll
        for (int ks = 0; ks < 4; ++ks) {
            u32x4 pw; pw.x = pk2(Sacc[2 * ks][0], Sacc[2 * ks][1]); pw.y = pk2(Sacc[2 * ks][2], Sacc[2 * ks][3]); pw.z = pk2(Sacc[2 * ks + 1][0], Sacc[2 * ks + 1][1]); pw.w = pk2(Sacc[2 * ks + 1][2], Sacc[2 * ks + 1][3]);
            sb[ks] = __builtin_bit_cast(bf16x8, pw);
        }
#pragma unroll
        for (int i2 = 0; i2 < 4; ++i2) {
            Oacc[i2] = (f32x4){0.f, 0.f, 0.f, 0.f};
#pragma unroll
            for (int ks = 0; ks < 4; ++ks) {
                const unsigned alo = base_c ^ (64u * ks);
                const u32x2 lo = *(const LAS u32x2*)(lds + GL_QT + 4096 * i2 + alo);
                const u32x2 hi = *(const LAS u32x2*)(lds + GL_QT + 4096 * i2 + (alo ^ 32u));
                u32x4 aw; aw.x = lo.x; aw.y = lo.y; aw.z = hi.x; aw.w = hi.y;
                Oacc[i2] = MFMA16(__builtin_bit_cast(bf16x8, aw), sb[ks], Oacc[i2]);
            }
        }
        __syncthreads();
        if (MODE == 2) {
            st0 = stash[tid * 2]; st1 = stash[tid * 2 + 1];
#pragma unroll
            for (int i = 0; i < 2; ++i) zraw[i] = *(const u32x4*)(U + (size_t)ptok[i] * UP + C_ZA + h * 128 + pch[i] * 8);
        }
    }
    bf16x8 vf[2];
#pragma unroll
    for (int ks = 0; ks < 2; ++ks) vf[ks] = tr_read8(lds, GL_VT + 8192u * ks + (trb0 ^ (32u * w)), GL_VT + 8192u * ks + (trb1 ^ (32u * w)));
    if (MODE != 0) {
#pragma unroll
        for (int i2 = 0; i2 < 4; ++i2)
#pragma unroll
            for (int ks = 0; ks < 2; ++ks) {
                if (ks <= (i2 >> 1)) { const bf16x8 pa = *(const LAS bf16x8*)(lds + GL_PT + 2048 * i2 + (base_p ^ (64u * ks))); Oacc[i2] = MFMA16(pa, vf[ks], Oacc[i2]); }
            }
    }
#pragma unroll
    for (int kt = 0; kt < 8; ++kt) {
#pragma unroll
        for (int ks = 0; ks < 2; ++ks) { const bf16x8 ka = tr_read8(lds, GL_KT + 8192u * ks + (trb0 ^ (32u * kt)), GL_KT + 8192u * ks + (trb1 ^ (32u * kt))); Sacc[kt] = MFMA16(ka, vf[ks], Sacc[kt]); }
        const f32x4 eb = *(const LAS f32x4*)(lds + GL_EBL + par * 512 + (16 * kt + 4 * g) * 4);
        Sacc[kt] = Sacc[kt] * eb;
    }
    if (MODE == 1) {
        u32x4 s0, s1;
        s0.x = pk2(Oacc[3][3], Oacc[3][2]); s0.y = pk2(Oacc[3][1], Oacc[3][0]); s0.z = pk2(Oacc[2][3], Oacc[2][2]); s0.w = pk2(Oacc[2][1], Oacc[2][0]);
        s1.x = pk2(Oacc[1][3], Oacc[1][2]); s1.y = pk2(Oacc[1][1], Oacc[1][0]); s1.z = pk2(Oacc[0][3], Oacc[0][2]); s1.w = pk2(Oacc[0][1], Oacc[0][0]);
        const int tidm = tid ^ 48;
        stash[tidm * 2] = s0; stash[tidm * 2 + 1] = s1;
    }
    if (MODE == 2) {
        float fo[16]; { float t8[8]; unpack8(st0, t8);
#pragma unroll
            for (int j = 0; j < 8; ++j) fo[j] = t8[j]; unpack8(st1, t8);
#pragma unroll
            for (int j = 0; j < 8; ++j) fo[8 + j] = t8[j]; }
        LAS float* ssw = (LAS float*)(lds + GL_SSW);
#pragma unroll
        for (int i2 = 0; i2 < 4; ++i2)
#pragma unroll
            for (int r = 0; r < 4; ++r) {
                const float o = Oacc[i2][r] + fo[4 * i2 + r]; Oacc[i2][r] = o;
                float v = o * o; v += __shfl_xor(v, 1); v += __shfl_xor(v, 2); v += __shfl_xor(v, 4); v += __shfl_xor(v, 8);
                if (n == 0) ssw[w * 64 + 16 * i2 + 4 * g + r] = v;
            }
        __syncthreads();
        if (tid < 64) { float s = 0.f;
#pragma unroll
            for (int ww = 0; ww < 8; ++ww) s += ssw[ww * 64 + tid];
            ((LAS float*)(lds + GL_RSTD))[tid] = rsqrtf(s * (1.0f / 128.0f) + NORM_EPS); }
        __syncthreads();
        const float gn = a.ng[16 * w + n];
#pragma unroll
        for (int i2 = 0; i2 < 4; ++i2) {
            const f32x4 rs = *(const LAS f32x4*)(lds + GL_RSTD + (16 * i2 + 4 * g) * 4);
#pragma unroll
            for (int r = 0; r < 4; ++r) *(LAS bf16_t*)(lds + GL_QT + (16 * i2 + 4 * g + r) * 256 + (16 * w + n) * 2) = f2bf(Oacc[i2][r] * rs[r] * gn);
        }
        __syncthreads();
        bf16_t* ymix = (bf16_t*)(a.ws + WS_XB);
#pragma unroll
        for (int i = 0; i < 2; ++i) {
            const u32x4 ov = *(const LAS u32x4*)(lds + GL_QT + prow[i] * 256 + pch[i] * 16);
            float of[8], zf[8]; unpack8(ov, of); unpack8(zraw[i], zf);
            u32x4 yw;
#pragma unroll
            for (int j = 0; j < 4; ++j) yw[j] = pk2(of[2 * j] * silu(zf[2 * j]), of[2 * j + 1] * silu(zf[2 * j + 1]));
            *(u32x4*)(ymix + (size_t)ptok[i] * DM + h * 128 + pch[i] * 8) = yw;
        }
    }
}
__device__ __forceinline__ void gla_load_gate(const Args& a, int h, int dir, bf16x8& wfrag, float& wbias) {
    const float* wup = dir ? a.wub : a.wuf; const float* bias = dir ? a.bbw : a.bfw;
    const int lane = threadIdx.x & 63, w = threadIdx.x >> 6, n = lane & 15, g = lane >> 4, col = h * 128 + 16 * w + n;
    u32x4 pw;
#pragma unroll
    for (int j = 0; j < 4; ++j) {
        const float v0 = wup[(8 * (g & 1) + 2 * j) * 512 + col], v1 = wup[(8 * (g & 1) + 2 * j + 1) * 512 + col];
        const float h0 = bf2f(f2bf(v0)), h1 = bf2f(f2bf(v1));
        pw[j] = g < 2 ? pk2(v0, v1) : pk2(v0 - h0, v1 - h1);
    }
    wfrag = __builtin_bit_cast(bf16x8, pw);
    wbias = bias[col];
}
__device__ __forceinline__ void phase_gla_pass1(const Args& a, LAS unsigned char* lds) {
    const int tid = threadIdx.x, w = tid >> 6, lane = tid & 63;
    unsigned char* ST = a.ws + WS_ST;
    GlaPre pre; int par = 0;
    { const int item = blockIdx.x; if (item < NSEG * 8) { const int dir = item & 1; gla_prefetch<0>(a, pre, tid, (item >> 3) * 256 + (dir ? 3 : 0) * 64, (item >> 1) & 3, dir); } }
    for (int item = blockIdx.x; item < NSEG * 8; item += gridDim.x) {
        const int dir = item & 1, h = (item >> 1) & 3, seg = item >> 3;
        const int nitem = item + gridDim.x < NSEG * 8 ? item + gridDim.x : item;
        bf16x8 wfrag; float wbias; gla_load_gate(a, h, dir, wfrag, wbias);
        f32x4 Sacc[8];
#pragma unroll
        for (int kt = 0; kt < 8; ++kt) Sacc[kt] = (f32x4){0.f, 0.f, 0.f, 0.f};
        float lam = 0.f;
        for (int cc = 0; cc < 4; ++cc) {
            const int c = dir ? 3 - cc : cc;
            int ntb, nh, ndir;
            if (cc < 3) { ntb = seg * 256 + (dir ? c - 1 : c + 1) * 64; nh = h; ndir = dir; }
            else { ndir = nitem & 1; nh = (nitem >> 1) & 3; ntb = (nitem >> 3) * 256 + (ndir ? 3 : 0) * 64; }
            gla_chunk<0>(a, lds, seg * 256 + c * 64, h, dir, wfrag, wbias, Sacc, lam, nullptr, pre, ntb, nh, ndir, par); par ^= 1;
        }
        u32x2* dst = (u32x2*)(ST + (size_t)item * 32768) + (size_t)w * 8 * 64 + lane;
#pragma unroll
        for (int kt = 0; kt < 8; ++kt) { u32x2 v; v.x = pk2(Sacc[kt][0], Sacc[kt][1]); v.y = pk2(Sacc[kt][2], Sacc[kt][3]); dst[kt * 64] = v; }
        if (lane < 16) ((float*)(a.ws + WS_DEC))[(size_t)item * 128 + 16 * w + lane] = lam;
    }
    __syncthreads();
}
__device__ __forceinline__ void phase_gla_pass2(const Args& a) {
    unsigned char* ST = a.ws + WS_ST; const float* DEC = (const float*)(a.ws + WS_DEC);
    for (int gidx = blockIdx.x * NTHR + threadIdx.x; gidx < 48 * 4096; gidx += gridDim.x * NTHR) {
        const int chain = gidx >> 12, quad = gidx & 4095, dir = chain & 1, h = (chain >> 1) & 3, s = chain >> 3;
        const int nseg = s < 2 ? LP / 256 : LS / 256, seg0 = s < 2 ? s * (LP / 256) : 2 * (LP / 256) + (s - 2) * (LS / 256);
        const int kt = (quad >> 6) & 7, lane = quad & 63, dk0 = 16 * kt + 4 * (lane >> 4);
        f32x4 S = (f32x4){0.f, 0.f, 0.f, 0.f};
        for (int i0 = 0; i0 < nseg; i0 += 8) {
            u32x2 t[8]; f32x4 lm[8];
#pragma unroll
            for (int j = 0; j < 8; ++j) { const int seg = dir ? seg0 + nseg - 1 - (i0 + j) : seg0 + i0 + j; const size_t idx = (size_t)((seg * 4 + h) * 2 + dir);
                t[j] = ((const u32x2*)(ST + idx * 32768))[quad]; lm[j] = *(const f32x4*)(DEC + idx * 128 + dk0); }
#pragma unroll
            for (int j = 0; j < 8; ++j) { const int seg = dir ? seg0 + nseg - 1 - (i0 + j) : seg0 + i0 + j; const size_t idx = (size_t)((seg * 4 + h) * 2 + dir);
                u32x2 o; o.x = pk2(S[0], S[1]); o.y = pk2(S[2], S[3]); ((u32x2*)(ST + idx * 32768))[quad] = o;
                const f32x4 tv = (f32x4){__uint_as_float(t[j].x << 16), __uint_as_float(t[j].x & 0xffff0000u), __uint_as_float(t[j].y << 16), __uint_as_float(t[j].y & 0xffff0000u)};
                S = (f32x4){__expf(lm[j][0]), __expf(lm[j][1]), __expf(lm[j][2]), __expf(lm[j][3])} * S + tv; }
        }
    }
}
__device__ __forceinline__ void phase_gla_pass3(const Args& a, LAS unsigned char* lds) {
    const int tid = threadIdx.x, w = tid >> 6, lane = tid & 63;
    const unsigned char* ST = a.ws + WS_ST;
    GlaPre pre; int par = 0;
    if (blockIdx.x < NSEG * 4) gla_prefetch<1>(a, pre, tid, (blockIdx.x >> 2) * 256, blockIdx.x & 3, 0);
    for (int item = blockIdx.x; item < NSEG * 4; item += gridDim.x) {
        const int h = item & 3, seg = item >> 2;
        const int nitem = item + gridDim.x < NSEG * 4 ? item + gridDim.x : item;
        u32x4* stash = (u32x4*)a.out + (size_t)item * 4 * 1024;
#pragma unroll 1
        for (int dir = 0; dir < 2; ++dir) {
            bf16x8 wfrag; float wbias; gla_load_gate(a, h, dir, wfrag, wbias);
            f32x4 Sacc[8];
            const u32x2* src = (const u32x2*)(ST + (size_t)((seg * 4 + h) * 2 + dir) * 32768) + (size_t)w * 8 * 64 + lane;
#pragma unroll
            for (int kt = 0; kt < 8; ++kt) { const u32x2 v = src[kt * 64]; Sacc[kt] = (f32x4){__uint_as_float(v.x << 16), __uint_as_float(v.x & 0xffff0000u), __uint_as_float(v.y << 16), __uint_as_float(v.y & 0xffff0000u)}; }
            float lam = 0.f;
            if (dir == 0) {
                for (int c = 0; c < 4; ++c) { const int ntb = seg * 256 + (c < 3 ? c + 1 : 3) * 64, ndir = c < 3 ? 0 : 1;
                    gla_chunk<1>(a, lds, seg * 256 + c * 64, h, 0, wfrag, wbias, Sacc, lam, stash + c * 1024, pre, ntb, h, ndir, par); par ^= 1; }
            } else {
                for (int c = 3; c >= 0; --c) { const int ntb = c > 0 ? seg * 256 + (c - 1) * 64 : (nitem >> 2) * 256, nh = c > 0 ? h : (nitem & 3), ndir = c > 0 ? 1 : 0;
                    gla_chunk<2>(a, lds, seg * 256 + c * 64, h, 1, wfrag, wbias, Sacc, lam, stash + c * 1024, pre, ntb, nh, ndir, par); par ^= 1; }
            }
        }
    }
    __syncthreads();
}
typedef float f32x16 __attribute__((ext_vector_type(16)));
#define MFMA32(a, b, c) __builtin_amdgcn_mfma_f32_32x32x16_bf16((a), (b), (c), 0, 0, 0)
constexpr int SW_K = 0, SW_V = 49152, SW_TB = 98304, SW_TBN = 336, SW_TBH = 4 * SW_TBN * 4;
constexpr float SW_NEG = -1e30f;
__device__ __forceinline__ unsigned offk(unsigned row, unsigned c8) { return 128u * row + 16u * (c8 ^ ((row >> 1) & 7)); }
__device__ __forceinline__ unsigned offv(unsigned row, unsigned c8) { return 128u * row + 16u * (c8 ^ (((row >> 1) & 1) << 2)); }
__device__ __forceinline__ void phase_swa(const Args& a, LAS unsigned char* lds) {
    const bf16_t* U = (const bf16_t*)(a.ws + WS_U); bf16_t* ymix = (bf16_t*)(a.ws + WS_XB);
    const int tid = threadIdx.x, lane = tid & 63, w = __builtin_amdgcn_readfirstlane(tid >> 6), r = lane & 31, hh = lane >> 5;
    const unsigned lb = (unsigned)(size_t)lds;
    for (int item = blockIdx.x; item < (NTOK / 128) * 2; item += gridDim.x) {
        const int kvh = item & 1, tok0 = (item >> 1) * 128; int s0, L; seq_of(tok0, s0, L);
        const bool first = tok0 == s0, last = tok0 + 128 == s0 + L;
        __syncthreads();
#pragma unroll
        for (int i = 0; i < 6; ++i) {
            const int idx = tid + 512 * i, row = idx >> 3, c8 = idx & 7, kpos = tok0 - 128 + row;
            u32x4 kk = (u32x4){0, 0, 0, 0}, vv = (u32x4){0, 0, 0, 0};
            if (kpos >= s0 && kpos < s0 + L) { const bf16_t* ur = U + (size_t)kpos * UP + kvh * 64 + c8 * 8; kk = *(const u32x4*)(ur + C_KB); vv = *(const u32x4*)(ur + C_VB); }
            *(LAS u32x4*)(lds + SW_K + offk(row, c8)) = kk; *(LAS u32x4*)(lds + SW_V + offv(row, c8)) = vv;
        }
        for (int e = tid; e < 4 * SW_TBN; e += NTHR) {
            const int hl = e / SW_TBN, idx = e - hl * SW_TBN, rel = idx - 160;
            const float val = (rel >= -128 && rel <= 128) ? a.relb[t5_bucket(rel) * 8 + kvh * 4 + hl] : SW_NEG;
            LAS float* tb = (LAS float*)(lds + SW_TB + hl * SW_TBH);
#pragma unroll
            for (int s = 0; s < 4; ++s) if (idx - s >= 0) tb[s * SW_TBN + idx - s] = val;
        }
        __syncthreads();
        const int hl = w >> 1, hq = kvh * 4 + hl;
        const float snk = a.sink[hq];
#pragma unroll 1
        for (int ss = 0; ss < 2; ++ss) {
            const int st = (w & 1) * 2 + ss, qtok = tok0 + 32 * st + r;
            bf16x8 Qf[4];
#pragma unroll
            for (int s = 0; s < 4; ++s) Qf[s] = *(const bf16x8*)(U + (size_t)qtok * UP + C_QB + hq * 64 + 16 * s + 8 * hh);
            float m = snk, l = hh == 0 ? 1.0f : 0.0f;
            f32x16 O[2];
#pragma unroll
            for (int i = 0; i < 16; ++i) { O[0][i] = 0.f; O[1][i] = 0.f; }
            const int sft = (-r) & 3;
            const unsigned tbase = SW_TB + hl * SW_TBH + sft * (SW_TBN * 4) + 4 * (32 + 4 * hh - r - sft);
            const unsigned kb0 = SW_K + 128u * r + 16u * (hh ^ ((r >> 1) & 7)) + 4096u * st;
            const int q4 = (lane & 15) >> 2, p4 = lane & 3, g1 = (lane >> 4) & 1, xq = (q4 >> 1) & 1;
            const unsigned vb0 = SW_V + 128u * (4 * hh + q4) + 16u * ((4 * xq) | (2 * g1) | (p4 >> 1)) + 8u * (p4 & 1) + 4096u * st;
#pragma unroll 1
            for (int grp = 0; grp < 3; ++grp) {
                f32x16 S[3];
#pragma unroll
                for (int k3 = 0; k3 < 3; ++k3) {
                    const int kk = 3 * grp + k3, blk = (st + kk) >> 2;
                    const bool valid = !((blk == 0 && first) || (blk == 2 && last));
                    if (valid) {
#pragma unroll
                        for (int i = 0; i < 16; ++i) S[k3][i] = 0.f;
#pragma unroll
                        for (int s = 0; s < 4; ++s) { const bf16x8 Kf = *(const LAS bf16x8*)(lds + (kb0 ^ (32u * s)) + 4096u * kk); S[k3] = MFMA32(Kf, Qf[s], S[k3]); }
#pragma unroll
                        for (int i4 = 0; i4 < 4; ++i4) { const f32x4 bv = *(const LAS f32x4*)(lds + tbase + 4 * (32 * kk + 8 * i4));
#pragma unroll
                            for (int j = 0; j < 4; ++j) S[k3][4 * i4 + j] += bv[j]; }
                    } else {
#pragma unroll
                        for (int i = 0; i < 16; ++i) S[k3][i] = SW_NEG;
                    }
                }
                float mx = SW_NEG;
#pragma unroll
                for (int k3 = 0; k3 < 3; ++k3)
#pragma unroll
                    for (int i = 0; i < 16; ++i) mx = fmaxf(mx, S[k3][i]);
                mx = fmaxf(mx, __shfl_xor(mx, 32));
                const float mn = fmaxf(m, mx), alpha = __expf(m - mn);
                m = mn; l *= alpha;
#pragma unroll
                for (int i = 0; i < 16; ++i) { O[0][i] *= alpha; O[1][i] *= alpha; }
                bf16x8 Pf[3][2];
#pragma unroll
                for (int k3 = 0; k3 < 3; ++k3) {
#pragma unroll
                    for (int i = 0; i < 16; ++i) { const float pv = __expf(S[k3][i] - m); S[k3][i] = pv; l += pv; }
#pragma unroll
                    for (int s2 = 0; s2 < 2; ++s2) {
                        u32x4 pw;
#pragma unroll
                        for (int j = 0; j < 4; ++j) pw[j] = pk2(S[k3][8 * s2 + 2 * j], S[k3][8 * s2 + 2 * j + 1]);
                        Pf[k3][s2] = __builtin_bit_cast(bf16x8, pw);
                    }
                }
#pragma unroll
                for (int k3 = 0; k3 < 3; ++k3) {
                    const int kk = 3 * grp + k3;
#pragma unroll
                    for (int s2 = 0; s2 < 2; ++s2)
#pragma unroll
                        for (int dt = 0; dt < 2; ++dt) {
                            const unsigned va = (vb0 ^ (64u * dt)) + 4096u * kk + 2048u * s2;
                            const bf16x8 Vf = tr_read8(lds, va, va + 1024u);
                            O[dt] = MFMA32(Vf, Pf[k3][s2], O[dt]);
                        }
                }
            }
            l += __shfl_xor(l, 32);
            const float inv = 1.0f / l;
#pragma unroll
            for (int dt = 0; dt < 2; ++dt)
#pragma unroll
                for (int i4 = 0; i4 < 4; ++i4) {
                    const int d0 = 32 * dt + 8 * i4 + 4 * hh;
                    const u32x2 zv = *(const u32x2*)(U + (size_t)qtok * UP + C_ZB + hq * 64 + d0);
                    const float z0 = __uint_as_float(zv.x << 16), z1 = __uint_as_float(zv.x & 0xffff0000u), z2 = __uint_as_float(zv.y << 16), z3 = __uint_as_float(zv.y & 0xffff0000u);
                    u32x2 yw; yw.x = pk2(O[dt][4 * i4] * inv * silu(z0), O[dt][4 * i4 + 1] * inv * silu(z1)); yw.y = pk2(O[dt][4 * i4 + 2] * inv * silu(z2), O[dt][4 * i4 + 3] * inv * silu(z3));
                    *(u32x2*)(ymix + (size_t)qtok * DM + 512 + hq * 64 + d0) = yw;
                }
        }
    }
}

__global__ void __launch_bounds__(NTHR, 2) mega(Args a) {
    extern __shared__ __attribute__((aligned(16))) unsigned char lds_raw[];
    LAS unsigned char* lds = (LAS unsigned char*)lds_raw;
    volatile LAS unsigned* MISC = (volatile LAS unsigned*)(lds + MISC_OFF);
    if (threadIdx.x < 32) MISC[threadIdx.x] = 0u;
    __syncthreads();
    unsigned char* ws = a.ws; float* out = a.out;
    XcdBarrier bar = xcd_barrier_post((unsigned*)(ws + WS_CTL) + 4096, MISC + 8);
    bf16_t* W1t = (bf16_t*)(ws + WS_W1T); bf16_t* W2t = (bf16_t*)(ws + WS_W2T); bf16_t* W3t = (bf16_t*)(ws + WS_W3T); bf16_t* W4t = (bf16_t*)(ws + WS_W4T);
    bf16_t* xb = (bf16_t*)(ws + WS_XB); bf16_t* ymix = xb; bf16_t* G = xb; bf16_t* U = (bf16_t*)(ws + WS_U);
    bf16_t* x1b = (bf16_t*)(ws + WS_X1B); bf16_t* P = (bf16_t*)(ws + WS_P); bf16_t* Sg = (bf16_t*)(ws + WS_S);
    f32x2* stat1 = (f32x2*)(ws + WS_STAT1); f32x2* stat2 = (f32x2*)(ws + WS_STAT2); f32x2* mr1 = (f32x2*)(ws + WS_MR1);

    phase_convert(a, lds);
    xcd_barrier(bar);
    { pg8::Gemm g{xb, W1t, NTOK, UP, DM, 0}; pg8::StaticOrder S; S.init(NTOK, UP, gridDim.x, blockIdx.x); EpiU E{U}; pg8::gemm_phase<EpiU, pg8::StaticOrder>(lds, g, S, E); }
    xcd_barrier(bar);
    phase_gla_pass1(a, lds);
    xcd_barrier(bar);
    phase_gla_pass2(a);
    phase_swa(a, lds);
    xcd_barrier(bar);
    phase_gla_pass3(a, lds);
    xcd_barrier(bar);
    { pg8::Gemm g{ymix, W2t, NTOK, DM, DM, 0}; pg8::StaticOrder S; S.init(NTOK, DM, gridDim.x, blockIdx.x); EpiY<0> E{a.xp, a.xs, out, stat1, nullptr, nullptr, nullptr}; pg8::gemm_phase<EpiY<0>, pg8::StaticOrder>(lds, g, S, E); }
    xcd_barrier(bar);
    phase_ln<0>(out, stat1, mr1, a.lng, a.lnb, x1b);
    xcd_barrier(bar);
    { pg8::Gemm g{x1b, W3t, NTOK, 4096, DM, 0}; pg8::StaticOrder S; S.init(NTOK, 4096, gridDim.x, blockIdx.x); EpiPS E{P, Sg}; pg8::gemm_phase<EpiPS, pg8::StaticOrder>(lds, g, S, E); }
    xcd_barrier(bar);
    phase_convgate(P, Sg, a.cw, G);
    xcd_barrier(bar);
    { pg8::Gemm g{G, W4t, NTOK, DM, DM, 0}; pg8::StaticOrder S; S.init(NTOK, DM, gridDim.x, blockIdx.x); EpiY<1> E{nullptr, nullptr, out, stat2, mr1, a.lng, a.lnb}; pg8::gemm_phase<EpiY<1>, pg8::StaticOrder>(lds, g, S, E); }
    xcd_barrier(bar);
    phase_ln<1>(out, stat2, nullptr, a.lng + DM, a.lnb + DM, nullptr);
}

extern "C" void kernel_launch(void* const* d_in, const int* in_sizes, int n_in, void* d_out, int out_size, void* d_ws, size_t ws_size, hipStream_t stream) {
    static int grid = 0;
    if (grid == 0) {
        if (n_in != 16 || out_size != NTOK * DM || ws_size < WS_END) { fprintf(stderr, "kernel_launch: unexpected shapes (n_in %d out %d ws %zu)\n", n_in, out_size, ws_size); grid = -1; return; }
        int dev = 0, cus = 0, per_cu = 0;
        if (hipGetDevice(&dev) != hipSuccess || hipDeviceGetAttribute(&cus, hipDeviceAttributeMultiprocessorCount, dev) != hipSuccess) { grid = -1; return; }
        if (hipFuncSetAttribute((const void*)mega, hipFuncAttributeMaxDynamicSharedMemorySize, LDS_BYTES) != hipSuccess) { fprintf(stderr, "kernel_launch: hipFuncSetAttribute failed\n"); grid = -1; return; }
        if (hipOccupancyMaxActiveBlocksPerMultiprocessor(&per_cu, (const void*)mega, NTHR, LDS_BYTES) != hipSuccess || per_cu < 1) { fprintf(stderr, "kernel_launch: occupancy query says %d blocks per CU\n", per_cu); (void)hipGetLastError(); grid = -1; return; }
        grid = cus;
    }
    if (grid < 0) return;
    (void)hipMemsetAsync((char*)d_ws + WS_CTL, 0, 65536, stream);
    Args a{};
    a.xp = (const float*)d_in[0]; a.xs = (const float*)d_in[1]; a.w_in_even = (const float*)d_in[2]; a.wuf = (const float*)d_in[3]; a.bfw = (const float*)d_in[4];
    a.wub = (const float*)d_in[5]; a.bbw = (const float*)d_in[6]; a.ng = (const float*)d_in[7]; a.sink = (const float*)d_in[8]; a.relb = (const float*)d_in[9];
    a.w_out_even = (const float*)d_in[10]; a.w_in_odd = (const float*)d_in[11]; a.cw = (const float*)d_in[12]; a.w_out_odd = (const float*)d_in[13];
    a.lng = (const float*)d_in[14]; a.lnb = (const float*)d_in[15]; a.out = (float*)d_out; a.ws = (unsigned char*)d_ws;
    hipLaunchKernelGGL(mega, dim3(grid), dim3(NTHR), LDS_BYTES, stream, a);
}
```

```cpp
#include <hip/hip_runtime.h>
#include <cstdio>

typedef unsigned short bf16_t;
typedef short bf16x8 __attribute__((ext_vector_type(8)));
typedef float f32x4 __attribute__((ext_vector_type(4)));
typedef float f32x2 __attribute__((ext_vector_type(2)));
typedef unsigned u32x4 __attribute__((ext_vector_type(4)));
typedef unsigned u32x2 __attribute__((ext_vector_type(2)));
#define LAS __attribute__((address_space(3)))

constexpr int DM = 1024, NTOK = 49152, NPROMPT = 32768, LP = 16384, LS = 4096;
constexpr int UP = 3584;
constexpr int C_QA = 0, C_KA = 512, C_VA = 1024, C_ZA = 1536, C_QB = 2048, C_KB = 2560, C_VB = 2688, C_ZB = 2816, C_GD = 3328;
constexpr int EVEN_IN = 3360, ODD_IN = 4096;
constexpr float DN_ALPHA = 1.41421356237309515f;
constexpr float LN_EPS = 1e-5f, NORM_EPS = 1e-6f;

constexpr size_t MiB = 1u << 20;
constexpr size_t WS_CTL = 0, WS_W1T = 1 * MiB, WS_W2T = 8 * MiB, WS_W3T = 10 * MiB, WS_W4T = 18 * MiB, WS_STAT1 = 20 * MiB, WS_MR1 = 26 * MiB, WS_DEC = 27 * MiB,
                 WS_XB = 28 * MiB  , WS_U = 124 * MiB, WS_ST = 460 * MiB, WS_END = 508 * MiB;
constexpr size_t WS_X1B = WS_U, WS_P = WS_U + 96 * MiB, WS_S = WS_U + 192 * MiB, WS_STAT2 = WS_U + 288 * MiB;

__device__ __forceinline__ float bf2f(bf16_t b) { return __uint_as_float(((unsigned)b) << 16); }
typedef __bf16 nbf16x2 __attribute__((ext_vector_type(2)));
__device__ __forceinline__ bf16_t f2bf(float f) { return __builtin_bit_cast(bf16_t, (__bf16)f); }
__device__ __forceinline__ unsigned pk2(float lo, float hi) { return __builtin_bit_cast(unsigned, __builtin_convertvector((f32x2){lo, hi}, nbf16x2)); }
__device__ __forceinline__ float silu(float x) { return x / (1.0f + __expf(-x)); }
__device__ __forceinline__ float wave_sum(float v) {
#pragma unroll
    for (int o = 1; o < 64; o <<= 1) v += __shfl_xor(v, o);
    return v;
}
__device__ __forceinline__ float wave_max(float v) {
#pragma unroll
    for (int o = 1; o < 64; o <<= 1) v = fmaxf(v, __shfl_xor(v, o));
    return v;
}
__device__ __forceinline__ void seq_of(int row, int& s0, int& L) {
    if (row < NPROMPT) { L = LP; s0 = row & ~(LP - 1); } else { L = LS; s0 = NPROMPT + ((row - NPROMPT) & ~(LS - 1)); }
}

namespace pg8 {
constexpr int BM = 256, BK = 64, HALF = 128, HTB = HALF * BK * 2, STAGE_BYTES = 8 * HTB, NXCD = 8, WGM = 8;
__host__ __device__ __forceinline__ int lds_byte(int r, int c) { const int st = (r >> 4) * 2 + (c >> 5), rr = r & 15, cc = c & 31, ob = rr * 64 + cc * 2; return st * 1024 + (ob ^ (((ob >> 9) & 1) << 5)); }
__host__ __device__ __forceinline__ void stage_rc(int b, int& R, int& C) { const int st = b / 1024, sb = b % 1024, swz = sb ^ (((sb >> 9) & 1) << 5); R = (st >> 1) * 16 + swz / 64; C = (st & 1) * 32 + (swz % 64) / 2; }
__host__ __device__ __forceinline__ int perm32(int rho) { const int n = rho >> 4, i = rho & 15; return 8 * (i >> 2) + 4 * n + (i & 3); }
struct Unit { int pm, pn; };
struct Gemm { const bf16_t* A; const bf16_t* Bt; int M, N, K, pad; };
struct StaticOrder {
    int nM, nN, nwg, G, c;
    __host__ __device__ void init(int M, int N, int G_, int c_) { nM = M / BM; nN = N / BM; nwg = nM * nN; G = G_; c = c_; }
    __host__ __device__ bool next(int i, Unit& u) const {
        const long L = (long)i * G + c; if (L >= nwg) return false;
        int wgid = (int)L; { const int q = nwg / NXCD, r = nwg % NXCD, xcd = wgid % NXCD, off = wgid / NXCD; wgid = (xcd < r ? xcd * (q + 1) : r * (q + 1) + (xcd - r) * q) + off; }
        const int nig = WGM * nN, gid = wgid / nig, fm = gid * WGM, gsz = (nM - fm) < WGM ? (nM - fm) : WGM;
        u.pm = fm + ((wgid % nig) % gsz); u.pn = (wgid % nig) / gsz; return true;
    }
    __device__ __forceinline__ void a_ready(const Unit&) const {}
    __device__ __forceinline__ void done(const Unit&) const {}
};

template <class Epi, class Sched>
__device__ __forceinline__ void gemm_phase(LAS unsigned char* lds, const Gemm g, const Sched& S, const Epi& E) {
    int tid = threadIdx.x; asm volatile("" : "+v"(tid));
    const int wid = __builtin_amdgcn_readfirstlane(tid >> 6), lane = tid & 63, wr = wid >> 2, wc = wid & 3, fr = lane & 15, fq = lane >> 4;
    const int K = g.K, nt = K / BK;
    unsigned voffA[2], voffB[2];
#pragma unroll
    for (int i = 0; i < 2; ++i) { int R, C; stage_rc(tid * 16 + i * 8192, R, C); const int Rb = Epi::PERM ? ((R & ~31) + perm32(R & 31)) : R;
        voffA[i] = (unsigned)(R * K + C) * 2u; voffB[i] = (unsigned)(Rb * K + C) * 2u; }
    const size_t kstep = (size_t)(BK * 2);
    const size_t hstep = (size_t)HALF * K * 2;
    const size_t tstep = 2 * hstep;
    const unsigned ldsw = (unsigned)wid * 1024u;
    const int aoff = lds_byte(wr * 64 + fr, fq * 8), boff = lds_byte(wc * 32 + fr, fq * 8);
#define PG8_SA(b, h) (((b) * 2 + (h)) * HTB)
#define PG8_SB(b, h) ((4 + (b) * 2 + (h)) * HTB)
#define PG8_STAGE(bufoff, gbase, voff) do { _Pragma("unroll") for (int _i = 0; _i < 2; ++_i) \
        __builtin_amdgcn_global_load_lds((const unsigned*)((const char*)(gbase) + (voff)[_i]), (LAS unsigned*)(lds + (bufoff) + ldsw + _i * 8192), 16, 0, 0); } while (0)
#define PG8_LDA(dst, b, h) do { _Pragma("unroll") for (int m = 0; m < 4; ++m) _Pragma("unroll") for (int k = 0; k < 2; ++k) dst[m][k] = *(const LAS bf16x8*)(lds + PG8_SA(b, h) + aoff + m * 2048 + k * 1024); } while (0)
#define PG8_LDB(dst, b, h) do { _Pragma("unroll") for (int n = 0; n < 2; ++n) _Pragma("unroll") for (int k = 0; k < 2; ++k) dst[n][k] = *(const LAS bf16x8*)(lds + PG8_SB(b, h) + boff + n * 2048 + k * 1024); } while (0)
#define PG8_MMA(ai, bj, At, Bt) do { __builtin_amdgcn_s_setprio(1); _Pragma("unroll") for (int m = 0; m < 4; ++m) _Pragma("unroll") for (int n = 0; n < 2; ++n) _Pragma("unroll") for (int k = 0; k < 2; ++k) \
        acc[ai][bj][m][n] = __builtin_amdgcn_mfma_f32_16x16x32_bf16(Bt[n][k], At[m][k], acc[ai][bj][m][n], 0, 0, 0); __builtin_amdgcn_s_setprio(0); } while (0)
#define PG8_WAIT_V(n) asm volatile("s_waitcnt vmcnt(" #n ")" ::: "memory")
#define PG8_WAIT_L(n) asm volatile("s_waitcnt lgkmcnt(" #n ")" ::: "memory")
#define PG8_BAR __builtin_amdgcn_s_barrier()
#define PG8_SCHED __builtin_amdgcn_sched_barrier(0)
    Unit cur, nxt; int ui = 0;
    if (!S.next(0, cur)) return;
    f32x4 acc[2][2][4][2];
#pragma unroll
    for (int a = 0; a < 2; ++a)
#pragma unroll
        for (int b = 0; b < 2; ++b)
#pragma unroll
            for (int m = 0; m < 4; ++m)
#pragma unroll
                for (int n = 0; n < 2; ++n) acc[a][b][m][n] = (f32x4){0.f, 0.f, 0.f, 0.f};
    bf16x8 At[4][2], B0[2][2], B1[2][2];
    const char* cA = (const char*)g.A + (size_t)cur.pm * tstep; const char* cB = (const char*)g.Bt + (size_t)cur.pn * tstep;
    S.a_ready(cur);
    PG8_STAGE(PG8_SB(0, 0), cB, voffB); PG8_STAGE(PG8_SA(0, 0), cA, voffA); PG8_STAGE(PG8_SB(0, 1), cB + hstep, voffB); PG8_STAGE(PG8_SA(0, 1), cA + hstep, voffA);
    if (wr == 1) PG8_BAR;
    PG8_WAIT_V(4); PG8_BAR;
    PG8_STAGE(PG8_SB(1, 0), cB + kstep, voffB); PG8_STAGE(PG8_SA(1, 0), cA + kstep, voffA); PG8_STAGE(PG8_SB(1, 1), cB + hstep + kstep, voffB);
    PG8_WAIT_V(6); PG8_BAR;
    for (;;) {
        const bool has_next = S.next(ui + 1, nxt);
        const char* nA = has_next ? (const char*)g.A + (size_t)nxt.pm * tstep : cA; const char* nB = has_next ? (const char*)g.Bt + (size_t)nxt.pn * tstep : cB;
        for (int t = 0; t < nt; t += 2) {
            const bool last = (t == nt - 2);
            const char* a1 = cA + (size_t)(t + 1) * kstep;
            const char* a2 = last ? nA : cA + (size_t)(t + 2) * kstep; const char* b2 = last ? nB : cB + (size_t)(t + 2) * kstep;
            const char* a3 = a2 + kstep; const char* b3 = b2 + kstep;
            if (last && has_next) S.a_ready(nxt);
            PG8_LDB(B0, 0, 0); PG8_SCHED; PG8_LDA(At, 0, 0); PG8_STAGE(PG8_SA(1, 1), a1 + hstep, voffA);
            PG8_WAIT_L(8); PG8_BAR; PG8_WAIT_L(0); PG8_MMA(0, 0, At, B0); PG8_BAR; PG8_SCHED;
            PG8_LDB(B1, 0, 1); PG8_STAGE(PG8_SB(0, 0), b2, voffB);
            PG8_BAR; PG8_WAIT_L(0); PG8_MMA(0, 1, At, B1); PG8_BAR;
            PG8_LDA(At, 0, 1); PG8_STAGE(PG8_SA(0, 0), a2, voffA);
            PG8_BAR; PG8_WAIT_L(0); PG8_MMA(1, 0, At, B0); PG8_BAR; PG8_SCHED;
            PG8_STAGE(PG8_SB(0, 1), b2 + hstep, voffB);
            PG8_WAIT_V(6); PG8_BAR; PG8_MMA(1, 1, At, B1); PG8_BAR;
            PG8_LDB(B0, 1, 0); PG8_SCHED; PG8_LDA(At, 1, 0); PG8_STAGE(PG8_SA(0, 1), a2 + hstep, voffA);
            PG8_WAIT_L(8); PG8_BAR; PG8_WAIT_L(0); PG8_MMA(0, 0, At, B0); PG8_BAR; PG8_SCHED;
            PG8_LDB(B1, 1, 1); PG8_STAGE(PG8_SB(1, 0), b3, voffB);
            PG8_BAR; PG8_WAIT_L(0); PG8_MMA(0, 1, At, B1); PG8_BAR;
            PG8_LDA(At, 1, 1); PG8_STAGE(PG8_SA(1, 0), a3, voffA);
            PG8_BAR; PG8_WAIT_L(0); PG8_MMA(1, 0, At, B0); PG8_BAR; PG8_SCHED;
            PG8_STAGE(PG8_SB(1, 1), b3 + hstep, voffB);
            PG8_WAIT_V(6); PG8_BAR; PG8_MMA(1, 1, At, B1); PG8_BAR;
        }
        if constexpr (Epi::REALIGN) { if (wr == 0) PG8_BAR; }
        E(acc, cur, wr, wc, fr, fq); S.done(cur);
        if constexpr (Epi::REALIGN) { if (wr == 1) PG8_BAR; }
        if (!has_next) break;
#pragma unroll
        for (int a = 0; a < 2; ++a)
#pragma unroll
            for (int b = 0; b < 2; ++b)
#pragma unroll
                for (int m = 0; m < 4; ++m)
#pragma unroll
                    for (int n = 0; n < 2; ++n) acc[a][b][m][n] = (f32x4){0.f, 0.f, 0.f, 0.f};
        cur = nxt; cA = nA; cB = nB; ++ui;
    }
    PG8_WAIT_V(0);
    if (wr == 0) PG8_BAR;
    PG8_BAR;
#undef PG8_SA
#undef PG8_SB
#undef PG8_STAGE
#undef PG8_LDA
#undef PG8_LDB
#undef PG8_MMA
#undef PG8_WAIT_V
#undef PG8_WAIT_L
#undef PG8_BAR
#undef PG8_SCHED
}
}

struct EpiU {
    static constexpr bool PERM = true, AFTER_DRAIN = false, REALIGN = false;
    bf16_t* O;
    __device__ __forceinline__ void operator()(const f32x4 (&acc)[2][2][4][2], const pg8::Unit& u, int wr, int wc, int fr, int fq) const {
        const int row0 = u.pm * 256 + wr * 64 + fr, col0 = u.pn * 256 + wc * 32 + 8 * fq;
#pragma unroll
        for (int ai = 0; ai < 2; ++ai)
#pragma unroll
            for (int m = 0; m < 4; ++m) { bf16_t* rowp = O + (size_t)(row0 + ai * 128 + m * 16) * UP + col0;
#pragma unroll
                for (int bj = 0; bj < 2; ++bj) { const f32x4 v0 = acc[ai][bj][m][0], v1 = acc[ai][bj][m][1];
                    u32x4 w; w.x = pk2(v0[0], v0[1]); w.y = pk2(v0[2], v0[3]); w.z = pk2(v1[0], v1[1]); w.w = pk2(v1[2], v1[3]);
                    *(u32x4*)(rowp + bj * 128) = w; } }
    }
};
template <int LAYER> struct EpiY {
    static constexpr bool PERM = false, AFTER_DRAIN = false, REALIGN = false;
    const float* xp; const float* xs; float* Y; f32x2* stat; const f32x2* mr; const float* lg; const float* lb;
    __device__ __forceinline__ void operator()(const f32x4 (&acc)[2][2][4][2], const pg8::Unit& u, int wr, int wc, int fr, int fq) const {
        const int col0 = u.pn * 256 + wc * 32 + 4 * fq;
        f32x4 gv[2][2], bv[2][2];
        if (LAYER == 1) {
#pragma unroll
            for (int bj = 0; bj < 2; ++bj)
#pragma unroll
                for (int n = 0; n < 2; ++n) { gv[bj][n] = *(const f32x4*)(lg + col0 + bj * 128 + n * 16); bv[bj][n] = *(const f32x4*)(lb + col0 + bj * 128 + n * 16); }
        }
#pragma unroll
        for (int ai = 0; ai < 2; ++ai)
#pragma unroll
            for (int m = 0; m < 4; ++m) {
                const int row = u.pm * 256 + ai * 128 + wr * 64 + m * 16 + fr;
                const float* rp; f32x2 mrv = (f32x2){0.f, 1.f};
                if (LAYER == 0) rp = (row < NPROMPT) ? xp + (size_t)row * DM : xs + (size_t)(row - NPROMPT) * DM;
                else { rp = Y + (size_t)row * DM; mrv = mr[row]; }
                float* yp = Y + (size_t)row * DM;
                float s = 0.f, q = 0.f;
#pragma unroll
                for (int bj = 0; bj < 2; ++bj)
#pragma unroll
                    for (int n = 0; n < 2; ++n) {
                        const int c = col0 + bj * 128 + n * 16;
                        f32x4 r = *(const f32x4*)(rp + c);
                        if (LAYER == 1) r = (r - mrv.x) * mrv.y * gv[bj][n] + bv[bj][n];
                        const f32x4 y = r * DN_ALPHA + acc[ai][bj][m][n];
                        *(f32x4*)(yp + c) = y;
                        s += (y[0] + y[1]) + (y[2] + y[3]); q += (y[0] * y[0] + y[1] * y[1]) + (y[2] * y[2] + y[3] * y[3]);
                    }
                s += __shfl_xor(s, 16); s += __shfl_xor(s, 32); q += __shfl_xor(q, 16); q += __shfl_xor(q, 32);
                if (fq == 0) stat[(size_t)row * 16 + u.pn * 4 + wc] = (f32x2){s, q};
            }
    }
};
#define RLX_AGENT __ATOMIC_RELAXED, __HIP_MEMORY_SCOPE_AGENT
template <int LAYER> struct EpiLN {
    static constexpr bool PERM = true, AFTER_DRAIN = false, REALIGN = true;
    unsigned char* ws; float* Of; const float* lg; const float* lb;
    __device__ __forceinline__ void operator()(f32x4 (&acc)[2][2][4][2], const pg8::Unit& u, int wr, int wc, int fr, int fq) const {
        unsigned char* w2 = ws; asm volatile("" : "+s"(w2));
        const bf16_t* R = (const bf16_t*)(w2 + (LAYER == 0 ? WS_XB : WS_X1B)); bf16_t* Ob = (bf16_t*)(w2 + WS_X1B);
        unsigned long long* xbuf = (unsigned long long*)(w2 + (LAYER == 0 ? WS_STAT1 : WS_STAT2)); unsigned* cnt = (unsigned*)(w2 + WS_CTL) + 16384 + LAYER * 192 * 64;
        const int col0 = u.pn * 256 + wc * 32 + 8 * fq, rowb = u.pm * 256 + wr * 64 + fr;
        float ps[2][4], pq[2][4];
#pragma unroll
        for (int ai = 0; ai < 2; ++ai)
#pragma unroll
            for (int m = 0; m < 4; ++m) {
                const bf16_t* rp = R + (size_t)(rowb + ai * 128 + m * 16) * DM + col0;
                float s = 0.f, q = 0.f;
#pragma unroll
                for (int bj = 0; bj < 2; ++bj) {
                    const u32x4 rw = *(const u32x4*)(rp + bj * 128);
                    f32x4 r0 = (f32x4){__uint_as_float(rw.x << 16), __uint_as_float(rw.x & 0xffff0000u), __uint_as_float(rw.y << 16), __uint_as_float(rw.y & 0xffff0000u)};
                    f32x4 r1 = (f32x4){__uint_as_float(rw.z << 16), __uint_as_float(rw.z & 0xffff0000u), __uint_as_float(rw.w << 16), __uint_as_float(rw.w & 0xffff0000u)};
                    const f32x4 v0 = r0 * DN_ALPHA + acc[ai][bj][m][0], v1 = r1 * DN_ALPHA + acc[ai][bj][m][1];
                    acc[ai][bj][m][0] = v0; acc[ai][bj][m][1] = v1;
                    s += ((v0[0] + v0[1]) + (v0[2] + v0[3])) + ((v1[0] + v1[1]) + (v1[2] + v1[3]));
                    q += ((v0[0] * v0[0] + v0[1] * v0[1]) + (v0[2] * v0[2] + v0[3] * v0[3])) + ((v1[0] * v1[0] + v1[1] * v1[1]) + (v1[2] * v1[2] + v1[3] * v1[3]));
                }
                s += __shfl_xor(s, 16); s += __shfl_xor(s, 32); q += __shfl_xor(q, 16); q += __shfl_xor(q, 32);
                ps[ai][m] = s; pq[ai][m] = q;
            }
        if (fq == 0) {
#pragma unroll
            for (int ai = 0; ai < 2; ++ai)
#pragma unroll
                for (int m = 0; m < 4; ++m)
                    __hip_atomic_store(xbuf + (size_t)(rowb + ai * 128 + m * 16) * 16 + u.pn * 4 + wc, ((unsigned long long)__float_as_uint(pq[ai][m]) << 32) | __float_as_uint(ps[ai][m]), RLX_AGENT);
        }
        asm volatile("s_waitcnt vmcnt(0)" ::: "memory");
        unsigned* c = cnt + 64 * u.pm;
        if ((threadIdx.x & 63) == 0) __hip_atomic_fetch_add(c, 1u, RLX_AGENT);
        { unsigned spins = 0;
          while ((unsigned)__builtin_amdgcn_readfirstlane(__hip_atomic_load(c, RLX_AGENT)) < 32u) { __builtin_amdgcn_s_sleep(2); if (++spins > (1u << 16)) break; }
          __builtin_amdgcn_fence(__ATOMIC_ACQUIRE, "agent"); }
#pragma unroll
        for (int ai = 0; ai < 2; ++ai)
#pragma unroll
            for (int m = 0; m < 4; ++m) {
                const unsigned long long* sp = xbuf + (size_t)(rowb + ai * 128 + m * 16) * 16 + 4 * fq;
                float s = 0.f, q = 0.f;
#pragma unroll
                for (int t = 0; t < 4; ++t) { const unsigned long long w8 = __hip_atomic_load(sp + t, RLX_AGENT); s += __uint_as_float((unsigned)w8); q += __uint_as_float((unsigned)(w8 >> 32)); }
                s += __shfl_xor(s, 16); s += __shfl_xor(s, 32); q += __shfl_xor(q, 16); q += __shfl_xor(q, 32);
                const float mean = s * (1.0f / DM), var = q * (1.0f / DM) - mean * mean;
                ps[ai][m] = mean; pq[ai][m] = rsqrtf(fmaxf(var, 0.f) + LN_EPS);
            }
#pragma unroll
        for (int bj = 0; bj < 2; ++bj) {
            const f32x4 g0 = *(const f32x4*)(lg + col0 + bj * 128), g1 = *(const f32x4*)(lg + col0 + bj * 128 + 4), b0 = *(const f32x4*)(lb + col0 + bj * 128), b1 = *(const f32x4*)(lb + col0 + bj * 128 + 4);
#pragma unroll
            for (int ai = 0; ai < 2; ++ai)
#pragma unroll
                for (int m = 0; m < 4; ++m) {
                    const int row = rowb + ai * 128 + m * 16; const float mean = ps[ai][m], rstd = pq[ai][m];
                    const f32x4 o0 = (acc[ai][bj][m][0] - mean) * rstd * g0 + b0, o1 = (acc[ai][bj][m][1] - mean) * rstd * g1 + b1;
                    if (LAYER == 0) { u32x4 w; w.x = pk2(o0[0], o0[1]); w.y = pk2(o0[2], o0[3]); w.z = pk2(o1[0], o1[1]); w.w = pk2(o1[2], o1[3]); *(u32x4*)(Ob + (size_t)row * DM + col0 + bj * 128) = w; }
                    else { float* op = Of + (size_t)row * DM + col0 + bj * 128; *(f32x4*)op = o0; *(f32x4*)(op + 4) = o1; }
                }
        }
    }
};
struct EpiPS {
    static constexpr bool PERM = true, AFTER_DRAIN = false, REALIGN = false;
    bf16_t* P; bf16_t* S;
    __device__ __forceinline__ void operator()(const f32x4 (&acc)[2][2][4][2], const pg8::Unit& u, int wr, int wc, int fr, int fq) const {
        const int row0 = u.pm * 256 + wr * 64 + fr, off = (wc & 1) * 32 + 8 * fq;
        bf16_t* dst = (wc < 2 ? S : P) + u.pn * 64 + off;
#pragma unroll
        for (int ai = 0; ai < 2; ++ai)
#pragma unroll
            for (int m = 0; m < 4; ++m) {
                float o[8];
#pragma unroll
                for (int n = 0; n < 2; ++n)
#pragma unroll
                    for (int j = 0; j < 4; ++j) { const float a = acc[ai][0][m][n][j], b = acc[ai][1][m][n][j];
                        o[4 * n + j] = (wc < 2) ? silu(b) * a : a * b; }
                u32x4 w; w.x = pk2(o[0], o[1]); w.y = pk2(o[2], o[3]); w.z = pk2(o[4], o[5]); w.w = pk2(o[6], o[7]);
                *(u32x4*)(dst + (size_t)(row0 + ai * 128 + m * 16) * DM) = w;
            }
    }
};

#define XB_TMO      128
#define XB_XCNT(j)  (256  + 64 * (j))
#define XB_XSUB(j)  (1280 + 64 * (j))
#define XB_XGEN(j)  (2304 + 64 * (j))
#define XB_TOP      3328
#define XB_TOPGEN   3392
#define XCD_BAR_WORDS 3456
#define XB_SPIN_CAP (1u << 27)
__device__ __forceinline__ unsigned xb_ld(unsigned* p)              { return __hip_atomic_load(p, __ATOMIC_RELAXED, __HIP_MEMORY_SCOPE_AGENT); }
__device__ __forceinline__ unsigned xb_add(unsigned* p, unsigned v) { return __hip_atomic_fetch_add(p, v, __ATOMIC_RELAXED, __HIP_MEMORY_SCOPE_AGENT); }
__device__ __forceinline__ unsigned xb_xcc_id() { return (unsigned)__builtin_amdgcn_s_getreg((3 << 11) | 20) & 0xFu; }
#define XB_SPIN(cond, bar) do { unsigned _sp = 0; while (cond) { __builtin_amdgcn_s_sleep(1); \
    if ((++_sp & 255u) == 0u) { if (xb_ld(&(bar)[XB_TMO])) break; if (_sp > XB_SPIN_CAP) { atomicAdd(&(bar)[XB_TMO], 1u); break; } } } } while (0)
struct XcdBarrier { unsigned* bar; unsigned x; volatile LAS unsigned* st; };
__device__ __forceinline__ XcdBarrier xcd_barrier_post(unsigned* bar, volatile LAS unsigned* st) {
    XcdBarrier b; b.bar = bar; b.x = xb_xcc_id(); b.st = st;
    if (threadIdx.x == 0) (void)xb_add(&bar[XB_XCNT(b.x)], 1u);
    return b;
}
__device__ __forceinline__ void xcd_barrier_complete(unsigned* bar, unsigned x, unsigned& nloc, unsigned& nx) {
    const unsigned G = gridDim.x * gridDim.y * gridDim.z;
    unsigned sum, cnt, mine, sp = 0u;
    for (;;) {
        sum = 0u; cnt = 0u; mine = 0u;
#pragma unroll
        for (unsigned j = 0; j < 16; ++j) { const unsigned c = xb_ld(&bar[XB_XCNT(j)]); sum += c; cnt += (c > 0u) ? 1u : 0u; mine = (j == x) ? c : mine; }
        if (sum == G) break;
        __builtin_amdgcn_s_sleep(1);
        if ((++sp & 255u) == 0u) { if (xb_ld(&bar[XB_TMO])) break; if (sp > XB_SPIN_CAP) { atomicAdd(&bar[XB_TMO], 1u); break; } }
    }
    nloc = mine > 0u ? mine : 1u; nx = cnt > 0u ? cnt : 1u;
}
__device__ __forceinline__ void xcd_barrier(const XcdBarrier& b) {
    asm volatile("s_waitcnt vmcnt(0)" ::: "memory");
    __syncthreads();
    if (threadIdx.x == 0) {
        unsigned* bar = b.bar;
        __builtin_amdgcn_s_waitcnt(0);
        unsigned nloc = b.st[0], nx = b.st[1];
        if (nloc == 0u) { xcd_barrier_complete(bar, b.x, nloc, nx); b.st[0] = nloc; b.st[1] = nx; }
        const unsigned old = xb_add(&bar[XB_XSUB(b.x)], 1u);
        const unsigned gen = old / nloc;
        if (old + 1u == (gen + 1u) * nloc) {
            __builtin_amdgcn_fence(__ATOMIC_RELEASE, "agent");
            asm volatile("s_waitcnt vmcnt(0)" ::: "memory");
            const unsigned og = xb_add(&bar[XB_TOP], 1u);
            const unsigned tg = og / nx;
            if (og + 1u == (tg + 1u) * nx) xb_add(&bar[XB_TOPGEN], 1u);
            else XB_SPIN(xb_ld(&bar[XB_TOPGEN]) == tg, bar);
            __builtin_amdgcn_fence(__ATOMIC_ACQUIRE, "agent");
            xb_add(&bar[XB_XGEN(b.x)], 1u);
            asm volatile("s_waitcnt vmcnt(0)" ::: "memory");
        } else {
            XB_SPIN(xb_ld(&bar[XB_XGEN(b.x)]) == gen, bar);
            __builtin_amdgcn_fence(__ATOMIC_ACQUIRE, "agent");
            asm volatile("s_waitcnt vmcnt(0)" ::: "memory");
        }
    }
    __syncthreads();
}

struct Args {
    const float *xp, *xs, *w_in_even, *wuf, *bfw, *wub, *bbw, *ng, *sink, *relb, *w_out_even, *w_in_odd, *cw, *w_out_odd, *lng, *lnb;
    float* out; unsigned char* ws;
};
constexpr int NTHR = 512;
constexpr int LDS_BYTES = 147456, MISC_OFF = 131072 + 1024;

template <int MODE> __device__ __forceinline__ int wmap(int n, float& sc) {
    sc = 1.f;
    if (MODE == 0) return n;
    if (MODE == 1) {
        if (n < 512) sc = 0.08838834764831845f;
        if (n >= C_QB && n < C_KB) sc = 0.125f;
        if (n < 2048) return n;
        if (n < C_GD) return n + 32;
        if (n < C_GD + 32) return n - C_GD + 2048;
        return -1;
    }
    const int w = n & 255, grp = w >> 6, ch = (n >> 8) * 64 + (w & 63);
    const int base = grp == 0 ? 0 : (grp == 1 ? 1024 : (grp == 2 ? 3072 : 2048));
    return base + ch;
}
template <int MODE> __device__ __forceinline__ void wconv_item(const float* __restrict__ W, int Nsrc, bf16_t* __restrict__ Wt, int Ndst, int item, LAS float* tile, int t256) {
    const int nb = item % (Ndst / 64), kb = item / (Ndst / 64), n0 = nb * 64, k0 = kb * 64;
    const int tx = t256 & 63, ty = t256 >> 6;
    float sc; const int src = wmap<MODE>(n0 + tx, sc);
    for (int kk = ty; kk < 64; kk += 4) tile[kk * 65 + tx] = src >= 0 ? W[(size_t)(k0 + kk) * Nsrc + src] * sc : 0.f;
    __syncthreads();
    for (int nn = ty; nn < 64; nn += 4) Wt[(size_t)(n0 + nn) * 1024 + k0 + tx] = f2bf(tile[tx * 65 + nn]);
    __syncthreads();
}
__device__ __forceinline__ void phase_convert(const Args& a, LAS unsigned char* lds) {
    unsigned char* ws = a.ws;
    bf16_t* W1t = (bf16_t*)(ws + WS_W1T); bf16_t* W2t = (bf16_t*)(ws + WS_W2T); bf16_t* W3t = (bf16_t*)(ws + WS_W3T); bf16_t* W4t = (bf16_t*)(ws + WS_W4T);
    const int half = threadIdx.x >> 8, t256 = threadIdx.x & 255;
    LAS float* tile = (LAS float*)lds + half * (64 * 65);
    constexpr int I1 = (UP / 64) * 16, I2 = 16 * 16, I3 = 64 * 16, I4 = 16 * 16, NIT = I1 + I2 + I3 + I4;
    for (int it0 = blockIdx.x * 2; it0 < NIT; it0 += gridDim.x * 2) {
        int r = it0 + half;
        if (r < I1) wconv_item<1>(a.w_in_even, EVEN_IN, W1t, UP, r, tile, t256);
        else if ((r -= I1) < I2) wconv_item<0>(a.w_out_even, 1024, W2t, 1024, r, tile, t256);
        else if ((r -= I2) < I3) wconv_item<2>(a.w_in_odd, ODD_IN, W3t, 4096, r, tile, t256);
        else if ((r -= I3) < I4) wconv_item<0>(a.w_out_odd, 1024, W4t, 1024, r, tile, t256);
        else { __syncthreads(); __syncthreads(); }
    }
    bf16_t* xb = (bf16_t*)(ws + WS_XB);
    const size_t n8 = (size_t)NTOK * DM / 8;
    for (size_t i = (size_t)blockIdx.x * NTHR + threadIdx.x; i < n8; i += (size_t)gridDim.x * NTHR) {
        const size_t e = i * 8; const float* src = e < (size_t)NPROMPT * DM ? a.xp + e : a.xs + (e - (size_t)NPROMPT * DM);
        const f32x4 v0 = *(const f32x4*)src, v1 = *(const f32x4*)(src + 4);
        u32x4 w; w.x = pk2(v0[0], v0[1]); w.y = pk2(v0[2], v0[3]); w.z = pk2(v1[0], v1[1]); w.w = pk2(v1[2], v1[3]);
        *(u32x4*)(xb + e) = w;
    }
}

__device__ __forceinline__ void phase_gla_naive(const Args& a, LAS unsigned char* lds, float* OF, float* OB) {
    if (blockIdx.x >= 12) return;
    const bf16_t* U = (const bf16_t*)(a.ws + WS_U);
    const int grp = threadIdx.x >> 7, tid = threadIdx.x & 127, b = blockIdx.x * 4 + grp, dir = b & 1, h = (b >> 1) & 3, s = b >> 3;
    LAS float* sq = (LAS float*)lds + grp * (3 * 16 * 128); LAS float* sk = sq + 16 * 128; LAS float* sd = sk + 16 * 128;
    const int L = s < 2 ? LP : LS, start = s < 2 ? s * LP : NPROMPT + (s - 2) * LS;
    const float* wu = dir ? a.wub : a.wuf; const float* bias = dir ? a.bbw : a.bfw; float* O = dir ? OB : OF;
    float wr[16];
#pragma unroll
    for (int r = 0; r < 16; ++r) wr[r] = wu[r * 512 + h * 128 + tid];
    const float bb = bias[h * 128 + tid];
    float S[128];
#pragma unroll
    for (int i = 0; i < 128; ++i) S[i] = 0.f;
    for (int t0 = 0; t0 < L; t0 += 16) {
        for (int tt = 0; tt < 16; ++tt) {
            const int p = t0 + tt, tok = start + (dir ? L - 1 - p : p);
            const bf16_t* ur = U + (size_t)tok * UP;
            float x = bb;
#pragma unroll
            for (int r = 0; r < 16; ++r) x += bf2f(ur[C_GD + dir * 16 + r]) * wr[r];
            const float ls = fminf(x, 0.f) - log1pf(expf(-fabsf(x)));
            sd[tt * 128 + tid] = expf(ls * (1.0f / 16.0f));
            sq[tt * 128 + tid] = bf2f(ur[C_QA + h * 128 + tid]);
            sk[tt * 128 + tid] = bf2f(ur[C_KA + h * 128 + tid]);
        }
        __syncthreads();
        for (int tt = 0; tt < 16; ++tt) {
            const int p = t0 + tt, tok = start + (dir ? L - 1 - p : p);
            const float v = bf2f(U[(size_t)tok * UP + C_VA + h * 128 + tid]);
            float acc = 0.f;
#pragma unroll
            for (int dk = 0; dk < 128; dk += 4) {
                const f32x4 d4 = *(const LAS f32x4*)&sd[tt * 128 + dk], q4 = *(const LAS f32x4*)&sq[tt * 128 + dk], k4 = *(const LAS f32x4*)&sk[tt * 128 + dk];
#pragma unroll
                for (int j = 0; j < 4; ++j) {
                    const float sdec = S[dk + j] * d4[j];
                    const float sn = sdec + k4[j] * v;
                    acc += q4[j] * (dir ? sdec : sn);
                    S[dk + j] = sn;
                }
            }
            O[(size_t)tok * 512 + h * 128 + tid] = acc;
        }
        __syncthreads();
    }
}
__device__ __forceinline__ void phase_gla_combine(const Args& a, const float* OF, const float* OB) {
    const bf16_t* U = (const bf16_t*)(a.ws + WS_U); bf16_t* ymix = (bf16_t*)((unsigned char*)a.out + 96 * MiB);
    const int lane = threadIdx.x & 63;
    for (int w = blockIdx.x * 8 + (threadIdx.x >> 6); w < NTOK * 4; w += gridDim.x * 8) {
        const int tok = w >> 2, h = w & 3;
        const size_t o = (size_t)tok * 512 + h * 128 + lane * 2;
        const float a0 = OF[o] + OB[o], a1 = OF[o + 1] + OB[o + 1];
        const float ss = wave_sum(a0 * a0 + a1 * a1);
        const float rstd = rsqrtf(ss * (1.0f / 128.0f) + NORM_EPS);
        const bf16_t* z = U + (size_t)tok * UP + C_ZA + h * 128 + lane * 2;
        const float y0 = a0 * rstd * a.ng[lane * 2] * silu(bf2f(z[0])), y1 = a1 * rstd * a.ng[lane * 2 + 1] * silu(bf2f(z[1]));
        *(unsigned*)(ymix + (size_t)tok * DM + h * 128 + lane * 2) = pk2(y0, y1);
    }
}
__device__ __forceinline__ int t5_bucket(int rel) {
    const int n = rel < 0 ? -rel : rel;
    int b = n < 8 ? n : (n < 12 ? 8 : (n < 16 ? 9 : (n < 23 ? 10 : (n < 32 ? 11 : (n < 46 ? 12 : (n < 64 ? 13 : (n < 91 ? 14 : 15)))))));
    return b + (rel > 0 ? 16 : 0);
}
__device__ __forceinline__ void phase_swa_naive(const Args& a, LAS unsigned char* lds) {
    const bf16_t* U = (const bf16_t*)(a.ws + WS_U); bf16_t* ymix = (bf16_t*)((unsigned char*)a.out + 96 * MiB);
    const int wv = threadIdx.x >> 6, lane = threadIdx.x & 63;
    LAS float* sq = (LAS float*)(lds + 65536) + wv * 64; LAS float* sp = (LAS float*)(lds + 65536 + 2048) + wv * 320;
    for (int w = blockIdx.x * 8 + wv; w < NTOK * 8; w += gridDim.x * 8) {
        const int tok = w >> 3, hq = w & 7, kv = hq >> 2;
        int s0, L; seq_of(tok, s0, L); const int i = tok - s0;
        sq[lane] = bf2f(U[(size_t)tok * UP + C_QB + hq * 64 + lane]);
        const float snk = a.sink[hq];
        float sc[5]; float mx = snk;
#pragma unroll
        for (int c = 0; c < 5; ++c) {
            const int jj = c * 64 + lane, j = i - 128 + jj; const bool valid = jj <= 256 && j >= 0 && j < L;
            float d = -INFINITY;
            if (valid) {
                const bf16_t* kr = U + (size_t)(s0 + j) * UP + C_KB + kv * 64; d = 0.f;
#pragma unroll
                for (int e = 0; e < 64; e += 8) { const u32x4 kk = *(const u32x4*)(kr + e);
                    d += sq[e] * __uint_as_float(kk.x << 16) + sq[e + 1] * __uint_as_float(kk.x & 0xffff0000u) + sq[e + 2] * __uint_as_float(kk.y << 16) + sq[e + 3] * __uint_as_float(kk.y & 0xffff0000u)
                       + sq[e + 4] * __uint_as_float(kk.z << 16) + sq[e + 5] * __uint_as_float(kk.z & 0xffff0000u) + sq[e + 6] * __uint_as_float(kk.w << 16) + sq[e + 7] * __uint_as_float(kk.w & 0xffff0000u); }
                d += a.relb[t5_bucket(j - i) * 8 + hq];
            }
            sc[c] = d; mx = fmaxf(mx, d);
        }
        mx = wave_max(mx);
        float den = 0.f;
#pragma unroll
        for (int c = 0; c < 5; ++c) { sc[c] = sc[c] == -INFINITY ? 0.f : __expf(sc[c] - mx); den += sc[c]; }
        den = wave_sum(den) + __expf(snk - mx);
        const float inv = 1.0f / den;
#pragma unroll
        for (int c = 0; c < 5; ++c) sp[c * 64 + lane] = sc[c] * inv;
        float o = 0.f;
        for (int jj = 0; jj <= 256; ++jj) { const int j = i - 128 + jj; if (j >= 0 && j < L) o += sp[jj] * bf2f(U[(size_t)(s0 + j) * UP + C_VB + kv * 64 + lane]); }
        const float z = bf2f(U[(size_t)tok * UP + C_ZB + hq * 64 + lane]);
        ymix[(size_t)tok * DM + 512 + hq * 64 + lane] = f2bf(o * silu(z));
    }
}
template <int FINAL>
__device__ __forceinline__ void phase_ln(float* Y, const f32x2* stat, f32x2* mr, const float* lg, const float* lb, bf16_t* xb) {
    const int lane = threadIdx.x & 63;
    for (int row = blockIdx.x * 8 + (threadIdx.x >> 6); row < NTOK; row += gridDim.x * 8) {
        f32x2 p = lane < 16 ? stat[(size_t)row * 16 + lane] : (f32x2){0.f, 0.f};
        const float s = wave_sum(p.x), q = wave_sum(p.y);
        const float mean = s * (1.0f / DM), var = q * (1.0f / DM) - mean * mean, rstd = rsqrtf(fmaxf(var, 0.f) + LN_EPS);
        if (!FINAL && lane == 0) mr[row] = (f32x2){mean, rstd};
#pragma unroll
        for (int j = 0; j < 4; ++j) {
            const int c = j * 256 + lane * 4;
            const f32x4 y = *(const f32x4*)(Y + (size_t)row * DM + c), g = *(const f32x4*)(lg + c), b = *(const f32x4*)(lb + c);
            const f32x4 o = (y - mean) * rstd * g + b;
            if (FINAL) *(f32x4*)(Y + (size_t)row * DM + c) = o;
            else { u32x2 w; w.x = pk2(o[0], o[1]); w.y = pk2(o[2], o[3]); *(u32x2*)(xb + (size_t)row * DM + c) = w; }
        }
    }
}
__device__ __forceinline__ void phase_convgate(const bf16_t* P, const bf16_t* S, const float* cw, bf16_t* G) {
    const size_t n8 = (size_t)NTOK * DM / 8;
    for (size_t i = (size_t)blockIdx.x * NTHR + threadIdx.x; i < n8; i += (size_t)gridDim.x * NTHR) {
        const int row = (int)(i >> 7), c = (int)(i & 127) * 8; int s0, L; seq_of(row, s0, L);
        const bool hasl = row > s0, hasr = row < s0 + L - 1;
        const u32x4 pm = *(const u32x4*)(P + (size_t)row * DM + c), sv = *(const u32x4*)(S + (size_t)row * DM + c);
        u32x4 pl = (u32x4){0, 0, 0, 0}, pr = (u32x4){0, 0, 0, 0};
        if (hasl) pl = *(const u32x4*)(P + (size_t)(row - 1) * DM + c);
        if (hasr) pr = *(const u32x4*)(P + (size_t)(row + 1) * DM + c);
        float o[8];
#pragma unroll
        for (int j = 0; j < 4; ++j) {
            const unsigned l = pl[j], m = pm[j], r = pr[j], sw = sv[j];
            const int cc = c + 2 * j;
            o[2 * j] = __uint_as_float(sw << 16) * (cw[cc] * __uint_as_float(l << 16) + cw[1024 + cc] * __uint_as_float(m << 16) + cw[2048 + cc] * __uint_as_float(r << 16));
            o[2 * j + 1] = __uint_as_float(sw & 0xffff0000u) * (cw[cc + 1] * __uint_as_float(l & 0xffff0000u) + cw[1024 + cc + 1] * __uint_as_float(m & 0xffff0000u) + cw[2048 + cc + 1] * __uint_as_float(r & 0xffff0000u));
        }
        u32x4 w; w.x = pk2(o[0], o[1]); w.y = pk2(o[2], o[3]); w.z = pk2(o[4], o[5]); w.w = pk2(o[6], o[7]);
        *(u32x4*)(G + (size_t)row * DM + c) = w;
    }
}

typedef short s16x4 __attribute__((ext_vector_type(4)));
constexpr int GL_QT = 0, GL_KT = 16384, GL_VT = 32768, GL_PT = 49152, GL_B = 57344, GL_GD = 90112, GL_TOT = 94208, GL_EBL = 96256  , GL_SSW = 97280, GL_RSTD = 99328;
constexpr int NSEG = NTOK / 256;
__device__ __forceinline__ unsigned offb(unsigned row, unsigned ch) { return 256u * row + 16u * (ch ^ (((row & 3) << 2) | ((row >> 2) & 3))); }
__device__ __forceinline__ unsigned offp(unsigned row, unsigned ch) { return 128u * row + 16u * (ch ^ (row & 7)); }
__device__ __forceinline__ unsigned rr16(unsigned lane, unsigned rb, unsigned s) { return offb((lane & 15) + 16 * rb, 4 * s + (lane >> 4)); }
__device__ __forceinline__ unsigned tr16(unsigned lane, unsigned c, unsigned ks, unsigned t) {
    const unsigned g = lane >> 4, q = (lane & 15) >> 2, p = lane & 3;
    return offb(32 * ks + 8 * g + 4 * t + q, 2 * c + (p >> 1)) + 8 * (p & 1);
}
__device__ __forceinline__ bf16x8 tr_read8(unsigned a0, unsigned a1) {
    s16x4 r0, r1;
    asm volatile("ds_read_b64_tr_b16 %0, %2\n\tds_read_b64_tr_b16 %1, %3\n\ts_waitcnt lgkmcnt(0)" : "=&v"(r0), "=&v"(r1) : "v"(a0), "v"(a1) : "memory");
    return __builtin_shufflevector(r0, r1, 0, 1, 2, 3, 4, 5, 6, 7);
}
__device__ __forceinline__ void unpack8(const u32x4 w, float (&f)[8]) {
#pragma unroll
    for (int j = 0; j < 4; ++j) { f[2 * j] = __uint_as_float(w[j] << 16); f[2 * j + 1] = __uint_as_float(w[j] & 0xffff0000u); }
}
#define MFMA16(a, b, c) __builtin_amdgcn_mfma_f32_16x16x32_bf16((a), (b), (c), 0, 0, 0)

struct GlaPre { u32x4 gd[4]; u32x4 q[2], k[2], v[2]; };
template <int MODE>
__device__ __forceinline__ void gla_prefetch(const Args& a, GlaPre& pre, int tid, int tb, int h, int dir) {
    const bf16_t* U = (const bf16_t*)(a.ws + WS_U);
    const int lane = tid & 63, n = lane & 15, g = lane >> 4;
#pragma unroll
    for (int it = 0; it < 4; ++it) { const int row = 16 * it + n, tok = dir ? tb + 63 - row : tb + row; pre.gd[it] = *(const u32x4*)(U + (size_t)tok * UP + C_GD + dir * 16 + 8 * (g & 1)); }
#pragma unroll
    for (int i = 0; i < 2; ++i) {
        const int idx = tid + 512 * i, row = idx >> 4, ch = idx & 15, tok = dir ? tb + 63 - row : tb + row;
        const bf16_t* ur = U + (size_t)tok * UP + h * 128 + ch * 8;
        if (MODE == 0) { pre.v[i] = *(const u32x4*)(ur + C_VA); pre.k[i] = *(const u32x4*)(ur + C_KA); }
    }
}
__device__ __forceinline__ bf16x8 tr_read8(LAS unsigned char* lds, unsigned a0, unsigned a1) {
    const s16x4 r0 = __builtin_amdgcn_ds_read_tr16_b64_v4i16((LAS s16x4*)(lds + a0)), r1 = __builtin_amdgcn_ds_read_tr16_b64_v4i16((LAS s16x4*)(lds + a1));
    return __builtin_shufflevector(r0, r1, 0, 1, 2, 3, 4, 5, 6, 7);
}
template <int MODE>
__device__ __forceinline__ void gla_chunk(const Args& a, LAS unsigned char* lds, const int tb, const int h, const int dir, const bf16x8 wfrag, const float wbias,
                                          f32x4 (&Sacc)[8], float& lam, u32x4* stash, GlaPre& pre, const int ntb, const int nh, const int ndir, const int par) {
    const bf16_t* U = (const bf16_t*)(a.ws + WS_U);
    int tid = threadIdx.x; asm volatile("" : "+v"(tid));
    const int lane = tid & 63, w = __builtin_amdgcn_readfirstlane(tid >> 6), n = lane & 15, g = lane >> 4;
    const unsigned fn = ((n & 3) << 2) | ((n >> 2) & 3);
    const unsigned base_rr = 256u * n + 16u * (g ^ fn);
    const unsigned base_c = 256u * n + 16u * ((g >> 1) ^ fn) + 8u * (g & 1);
    const unsigned base_p = 128u * n + 16u * (g ^ (n & 7));
    const unsigned trb0 = tr16(lane, 0, 0, 0), trb1 = tr16(lane, 0, 0, 1);
    GlaPre cur = pre;
    gla_prefetch<MODE>(a, pre, tid, ntb, nh, ndir);
    int prow[2], pch[2], ptok[2];
#pragma unroll
    for (int i = 0; i < 2; ++i) { const int idx = tid + 512 * i; prow[i] = idx >> 4; pch[i] = idx & 15; ptok[i] = dir ? tb + 63 - prow[i] : tb + prow[i]; }
    if (MODE != 0) {
#pragma unroll
        for (int i = 0; i < 2; ++i) { const bf16_t* ur = U + (size_t)ptok[i] * UP + h * 128 + pch[i] * 8; cur.q[i] = *(const u32x4*)(ur + C_QA); cur.k[i] = *(const u32x4*)(ur + C_KA); cur.v[i] = *(const u32x4*)(ur + C_VA); }
    }
    u32x4 st0, st1, zraw[2];
    {
        LAS float* B = (LAS float*)(lds + GL_B);
        float carry = 0.f;
#pragma unroll
        for (int it = 0; it < 4; ++it) {
            f32x4 x = MFMA16(__builtin_bit_cast(bf16x8, cur.gd[it]), wfrag, ((f32x4){wbias, wbias, wbias, wbias}));
            float pfx[4]; float run = 0.f;
#pragma unroll
            for (int r = 0; r < 4; ++r) { const float xv = x[r]; const float ls = fminf(xv, 0.f) - __logf(1.0f + __expf(-fabsf(xv))); run += ls * (1.0f / 16.0f); pfx[r] = run; }
            const float t0 = __shfl(run, n), t1 = __shfl(run, n + 16), t2 = __shfl(run, n + 32), t3 = __shfl(run, n + 48);
            const float before = carry + (g > 0 ? t0 : 0.f) + (g > 1 ? t1 : 0.f) + (g > 2 ? t2 : 0.f);
#pragma unroll
            for (int r = 0; r < 4; ++r) B[(16 * it + 4 * g + r) * 128 + 16 * w + n] = before + pfx[r];
            carry += (t0 + t1) + (t2 + t3);
        }
        if (g == 0) ((LAS float*)(lds + GL_EBL + par * 512))[16 * w + n] = __expf(carry);
        lam += carry;
    }
    __syncthreads();
#pragma unroll
    for (int i = 0; i < 2; ++i) {
        const LAS f32x4* bp = (const LAS f32x4*)(lds + GL_B + (prow[i] * 128 + pch[i] * 8) * 4);
        const f32x4 b0 = bp[0], b1 = bp[1];
        float e[8], kf[8];
#pragma unroll
        for (int j = 0; j < 4; ++j) { e[j] = __expf(b0[j]); e[4 + j] = __expf(b1[j]); }
        unpack8(cur.k[i], kf);
        u32x4 kw;
#pragma unroll
        for (int j = 0; j < 4; ++j) kw[j] = pk2(kf[2 * j] * __builtin_amdgcn_rcpf(e[2 * j]), kf[2 * j + 1] * __builtin_amdgcn_rcpf(e[2 * j + 1]));
        *(LAS u32x4*)(lds + GL_KT + offb(prow[i], pch[i])) = kw;
        *(LAS u32x4*)(lds + GL_VT + offb(prow[i], pch[i])) = cur.v[i];
        if (MODE != 0) {
            float qf[8]; unpack8(cur.q[i], qf);
            u32x4 qw;
#pragma unroll
            for (int j = 0; j < 4; ++j) qw[j] = pk2(qf[2 * j] * e[2 * j], qf[2 * j + 1] * e[2 * j + 1]);
            *(LAS u32x4*)(lds + GL_QT + offb(prow[i], pch[i])) = qw;
        }
    }
    __syncthreads();
    f32x4 Oacc[4];
    if (MODE != 0) {
        const int it = w >> 1;
        bf16x8 qa[4];
#pragma unroll
        for (int s = 0; s < 4; ++s) qa[s] = *(const LAS bf16x8*)(lds + GL_QT + (base_rr ^ (64u * s)) + 4096u * it);
#pragma unroll
        for (int jj = 0; jj < 2; ++jj) {
            const int jt = 2 * (w & 1) + jj;
            f32x4 pacc = (f32x4){0.f, 0.f, 0.f, 0.f};
            if (jt <= it) {
#pragma unroll
                for (int s = 0; s < 4; ++s) { const bf16x8 kb = *(const LAS bf16x8*)(lds + GL_KT + (base_rr ^ (64u * s)) + 4096u * jt); pacc = MFMA16(qa[s], kb, pacc); }
            }
            const int j = 16 * jt + n;
#pragma unroll
            for (int r = 0; r < 4; ++r) {
                const int i = 16 * it + 4 * g + r;
                const bool keep = (MODE == 1) ? (j <= i) : (j < i);
                *(LAS bf16_t*)(lds + GL_PT + offp(i, j >> 3) + 2 * (j & 7)) = keep ? f2bf(pacc[r]) : (bf16_t)0;
            }
        }
        bf16x8 sb[4];
#pragma unroll
        for (int ks = 0; ks < 4; ++ks) {
            u32x4 pw; pw.x = pk2(Sacc[2 * ks][0], Sacc[2 * ks][1]); pw.y = pk2(Sacc[2 * ks][2], Sacc[2 * ks][3]); pw.z = pk2(Sacc[2 * ks + 1][0], Sacc[2 * ks + 1][1]); pw.w = pk2(Sacc[2 * ks + 1][2], Sacc[2 * ks + 1][3]);
            sb[ks] = __builtin_bit_cast(bf16x8, pw);
        }
#pragma unroll
        for (int i2 = 0; i2 < 4; ++i2) {
            Oacc[i2] = (f32x4){0.f, 0.f, 0.f, 0.f};
#pragma unroll
            for (int ks = 0; ks < 4; ++ks) {
                const unsigned alo = base_c ^ (64u * ks);
                const u32x2 lo = *(const LAS u32x2*)(lds + GL_QT + 4096 * i2 + alo);
                const u32x2 hi = *(const LAS u32x2*)(lds + GL_QT + 4096 * i2 + (alo ^ 32u));
                u32x4 aw; aw.x = lo.x; aw.y = lo.y; aw.z = hi.x; aw.w = hi.y;
                Oacc[i2] = MFMA16(__builtin_bit_cast(bf16x8, aw), sb[ks], Oacc[i2]);
            }
        }
        __syncthreads();
        if (MODE == 2) {
            st0 = stash[tid * 2]; st1 = stash[tid * 2 + 1];
#pragma unroll
            for (int i = 0; i < 2; ++i) zraw[i] = *(const u32x4*)(U + (size_t)ptok[i] * UP + C_ZA + h * 128 + pch[i] * 8);
        }
    }
    bf16x8 vf[2];
#pragma unroll
    for (int ks = 0; ks < 2; ++ks) vf[ks] = tr_read8(lds, GL_VT + 8192u * ks + (trb0 ^ (32u * w)), GL_VT + 8192u * ks + (trb1 ^ (32u * w)));
    if (MODE != 0) {
#pragma unroll
        for (int i2 = 0; i2 < 4; ++i2)
#pragma unroll
            for (int ks = 0; ks < 2; ++ks) {
                if (ks <= (i2 >> 1)) { const bf16x8 pa = *(const LAS bf16x8*)(lds + GL_PT + 2048 * i2 + (base_p ^ (64u * ks))); Oacc[i2] = MFMA16(pa, vf[ks], Oacc[i2]); }
            }
    }
#pragma unroll
    for (int kt = 0; kt < 8; ++kt) {
#pragma unroll
        for (int ks = 0; ks < 2; ++ks) { const bf16x8 ka = tr_read8(lds, GL_KT + 8192u * ks + (trb0 ^ (32u * kt)), GL_KT + 8192u * ks + (trb1 ^ (32u * kt))); Sacc[kt] = MFMA16(ka, vf[ks], Sacc[kt]); }
        const f32x4 eb = *(const LAS f32x4*)(lds + GL_EBL + par * 512 + (16 * kt + 4 * g) * 4);
        Sacc[kt] = Sacc[kt] * eb;
    }
    if (MODE == 1) {
        u32x4 s0, s1;
        s0.x = pk2(Oacc[3][3], Oacc[3][2]); s0.y = pk2(Oacc[3][1], Oacc[3][0]); s0.z = pk2(Oacc[2][3], Oacc[2][2]); s0.w = pk2(Oacc[2][1], Oacc[2][0]);
        s1.x = pk2(Oacc[1][3], Oacc[1][2]); s1.y = pk2(Oacc[1][1], Oacc[1][0]); s1.z = pk2(Oacc[0][3], Oacc[0][2]); s1.w = pk2(Oacc[0][1], Oacc[0][0]);
        const int tidm = tid ^ 48;
        stash[tidm * 2] = s0; stash[tidm * 2 + 1] = s1;
    }
    if (MODE == 2) {
        float fo[16]; { float t8[8]; unpack8(st0, t8);
#pragma unroll
            for (int j = 0; j < 8; ++j) fo[j] = t8[j]; unpack8(st1, t8);
#pragma unroll
            for (int j = 0; j < 8; ++j) fo[8 + j] = t8[j]; }
        LAS float* ssw = (LAS float*)(lds + GL_SSW);
#pragma unroll
        for (int i2 = 0; i2 < 4; ++i2)
#pragma unroll
            for (int r = 0; r < 4; ++r) {
                const float o = Oacc[i2][r] + fo[4 * i2 + r]; Oacc[i2][r] = o;
                float v = o * o; v += __shfl_xor(v, 1); v += __shfl_xor(v, 2); v += __shfl_xor(v, 4); v += __shfl_xor(v, 8);
                if (n == 0) ssw[w * 64 + 16 * i2 + 4 * g + r] = v;
            }
        __syncthreads();
        if (tid < 64) { float s = 0.f;
#pragma unroll
            for (int ww = 0; ww < 8; ++ww) s += ssw[ww * 64 + tid];
            ((LAS float*)(lds + GL_RSTD))[tid] = rsqrtf(s * (1.0f / 128.0f) + NORM_EPS); }
        __syncthreads();
        const float gn = a.ng[16 * w + n];
#pragma unroll
        for (int i2 = 0; i2 < 4; ++i2) {
            const f32x4 rs = *(const LAS f32x4*)(lds + GL_RSTD + (16 * i2 + 4 * g) * 4);
#pragma unroll
            for (int r = 0; r < 4; ++r) *(LAS bf16_t*)(lds + GL_QT + (16 * i2 + 4 * g + r) * 256 + (16 * w + n) * 2) = f2bf(Oacc[i2][r] * rs[r] * gn);
        }
        __syncthreads();
        bf16_t* ymix = (bf16_t*)((unsigned char*)a.out + 96 * MiB);
#pragma unroll
        for (int i = 0; i < 2; ++i) {
            const u32x4 ov = *(const LAS u32x4*)(lds + GL_QT + prow[i] * 256 + pch[i] * 16);
            float of[8], zf[8]; unpack8(ov, of); unpack8(zraw[i], zf);
            u32x4 yw;
#pragma unroll
            for (int j = 0; j < 4; ++j) yw[j] = pk2(of[2 * j] * silu(zf[2 * j]), of[2 * j + 1] * silu(zf[2 * j + 1]));
            *(u32x4*)(ymix + (size_t)ptok[i] * DM + h * 128 + pch[i] * 8) = yw;
        }
    }
}
__device__ __forceinline__ void gla_load_gate(const Args& a, int h, int dir, bf16x8& wfrag, float& wbias) {
    const float* wup = dir ? a.wub : a.wuf; const float* bias = dir ? a.bbw : a.bfw;
    const int lane = threadIdx.x & 63, w = threadIdx.x >> 6, n = lane & 15, g = lane >> 4, col = h * 128 + 16 * w + n;
    u32x4 pw;
#pragma unroll
    for (int j = 0; j < 4; ++j) {
        const float v0 = wup[(8 * (g & 1) + 2 * j) * 512 + col], v1 = wup[(8 * (g & 1) + 2 * j + 1) * 512 + col];
        const float h0 = bf2f(f2bf(v0)), h1 = bf2f(f2bf(v1));
        pw[j] = g < 2 ? pk2(v0, v1) : pk2(v0 - h0, v1 - h1);
    }
    wfrag = __builtin_bit_cast(bf16x8, pw);
    wbias = bias[col];
}
__device__ __forceinline__ void phase_gla_pass1(const Args& a, LAS unsigned char* lds) {
    const int tid = threadIdx.x, w = tid >> 6, lane = tid & 63;
    unsigned char* ST = a.ws + WS_ST;
    GlaPre pre; int par = 0;
    { const int item = blockIdx.x; if (item < NSEG * 8) { const int dir = item & 1; gla_prefetch<0>(a, pre, tid, (item >> 3) * 256 + (dir ? 3 : 0) * 64, (item >> 1) & 3, dir); } }
    for (int item = blockIdx.x; item < NSEG * 8; item += gridDim.x) {
        const int dir = item & 1, h = (item >> 1) & 3, seg = item >> 3;
        const int nitem = item + gridDim.x < NSEG * 8 ? item + gridDim.x : item;
        bf16x8 wfrag; float wbias; gla_load_gate(a, h, dir, wfrag, wbias);
        f32x4 Sacc[8];
#pragma unroll
        for (int kt = 0; kt < 8; ++kt) Sacc[kt] = (f32x4){0.f, 0.f, 0.f, 0.f};
        float lam = 0.f;
        for (int cc = 0; cc < 4; ++cc) {
            const int c = dir ? 3 - cc : cc;
            int ntb, nh, ndir;
            if (cc < 3) { ntb = seg * 256 + (dir ? c - 1 : c + 1) * 64; nh = h; ndir = dir; }
            else { ndir = nitem & 1; nh = (nitem >> 1) & 3; ntb = (nitem >> 3) * 256 + (ndir ? 3 : 0) * 64; }
            gla_chunk<0>(a, lds, seg * 256 + c * 64, h, dir, wfrag, wbias, Sacc, lam, nullptr, pre, ntb, nh, ndir, par); par ^= 1;
        }
        u32x2* dst = (u32x2*)(ST + (size_t)item * 32768) + (size_t)w * 8 * 64 + lane;
#pragma unroll
        for (int kt = 0; kt < 8; ++kt) { u32x2 v; v.x = pk2(Sacc[kt][0], Sacc[kt][1]); v.y = pk2(Sacc[kt][2], Sacc[kt][3]); dst[kt * 64] = v; }
        if (lane < 16) ((float*)(a.ws + WS_DEC))[(size_t)item * 128 + 16 * w + lane] = lam;
    }
    __syncthreads();
}
__device__ __forceinline__ void phase_gla_pass2(const Args& a) {
    unsigned char* ST = a.ws + WS_ST; const float* DEC = (const float*)(a.ws + WS_DEC);
    for (int gidx = blockIdx.x * NTHR + threadIdx.x; gidx < 48 * 4096; gidx += gridDim.x * NTHR) {
        const int chain = gidx >> 12, quad = gidx & 4095, dir = chain & 1, h = (chain >> 1) & 3, s = chain >> 3;
        const int nseg = s < 2 ? LP / 256 : LS / 256, seg0 = s < 2 ? s * (LP / 256) : 2 * (LP / 256) + (s - 2) * (LS / 256);
        const int kt = (quad >> 6) & 7, lane = quad & 63, dk0 = 16 * kt + 4 * (lane >> 4);
        f32x4 S = (f32x4){0.f, 0.f, 0.f, 0.f};
        for (int i0 = 0; i0 < nseg; i0 += 8) {
            u32x2 t[8]; f32x4 lm[8];
#pragma unroll
            for (int j = 0; j < 8; ++j) { const int seg = dir ? seg0 + nseg - 1 - (i0 + j) : seg0 + i0 + j; const size_t idx = (size_t)((seg * 4 + h) * 2 + dir);
                t[j] = ((const u32x2*)(ST + idx * 32768))[quad]; lm[j] = *(const f32x4*)(DEC + idx * 128 + dk0); }
#pragma unroll
            for (int j = 0; j < 8; ++j) { const int seg = dir ? seg0 + nseg - 1 - (i0 + j) : seg0 + i0 + j; const size_t idx = (size_t)((seg * 4 + h) * 2 + dir);
                u32x2 o; o.x = pk2(S[0], S[1]); o.y = pk2(S[2], S[3]); ((u32x2*)(ST + idx * 32768))[quad] = o;
                const f32x4 tv = (f32x4){__uint_as_float(t[j].x << 16), __uint_as_float(t[j].x & 0xffff0000u), __uint_as_float(t[j].y << 16), __uint_as_float(t[j].y & 0xffff0000u)};
                S = (f32x4){__expf(lm[j][0]), __expf(lm[j][1]), __expf(lm[j][2]), __expf(lm[j][3])} * S + tv; }
        }
    }
}
__device__ __forceinline__ void phase_gla_pass3(const Args& a, LAS unsigned char* lds) {
    const int tid = threadIdx.x, w = tid >> 6, lane = tid & 63;
    const unsigned char* ST = a.ws + WS_ST;
    GlaPre pre; int par = 0;
    if (blockIdx.x < NSEG * 4) gla_prefetch<1>(a, pre, tid, (blockIdx.x >> 2) * 256, blockIdx.x & 3, 0);
    for (int item = blockIdx.x; item < NSEG * 4; item += gridDim.x) {
        const int h = item & 3, seg = item >> 2;
        const int nitem = item + gridDim.x < NSEG * 4 ? item + gridDim.x : item;
        u32x4* stash = (u32x4*)a.out + (size_t)item * 4 * 1024;
#pragma unroll 1
        for (int dir = 0; dir < 2; ++dir) {
            bf16x8 wfrag; float wbias; gla_load_gate(a, h, dir, wfrag, wbias);
            f32x4 Sacc[8];
            const u32x2* src = (const u32x2*)(ST + (size_t)((seg * 4 + h) * 2 + dir) * 32768) + (size_t)w * 8 * 64 + lane;
#pragma unroll
            for (int kt = 0; kt < 8; ++kt) { const u32x2 v = src[kt * 64]; Sacc[kt] = (f32x4){__uint_as_float(v.x << 16), __uint_as_float(v.x & 0xffff0000u), __uint_as_float(v.y << 16), __uint_as_float(v.y & 0xffff0000u)}; }
            float lam = 0.f;
            if (dir == 0) {
                for (int c = 0; c < 4; ++c) { const int ntb = seg * 256 + (c < 3 ? c + 1 : 3) * 64, ndir = c < 3 ? 0 : 1;
                    gla_chunk<1>(a, lds, seg * 256 + c * 64, h, 0, wfrag, wbias, Sacc, lam, stash + c * 1024, pre, ntb, h, ndir, par); par ^= 1; }
            } else {
                for (int c = 3; c >= 0; --c) { const int ntb = c > 0 ? seg * 256 + (c - 1) * 64 : (nitem >> 2) * 256, nh = c > 0 ? h : (nitem & 3), ndir = c > 0 ? 1 : 0;
                    gla_chunk<2>(a, lds, seg * 256 + c * 64, h, 1, wfrag, wbias, Sacc, lam, stash + c * 1024, pre, ntb, nh, ndir, par); par ^= 1; }
            }
        }
    }
    __syncthreads();
}
typedef float f32x16 __attribute__((ext_vector_type(16)));
#define MFMA32(a, b, c) __builtin_amdgcn_mfma_f32_32x32x16_bf16((a), (b), (c), 0, 0, 0)
constexpr int SW_K = 0, SW_V = 49152, SW_TB = 98304, SW_TBN = 336, SW_TBH = 4 * SW_TBN * 4;
constexpr float SW_NEG = -1e30f;
__device__ __forceinline__ unsigned offk(unsigned row, unsigned c8) { return 128u * row + 16u * (c8 ^ ((row >> 1) & 7)); }
__device__ __forceinline__ unsigned offv(unsigned row, unsigned c8) { return 128u * row + 16u * (c8 ^ (((row >> 1) & 1) << 2)); }
__device__ __forceinline__ void phase_swa(const Args& a, LAS unsigned char* lds) {
    const bf16_t* U = (const bf16_t*)(a.ws + WS_U); bf16_t* ymix = (bf16_t*)((unsigned char*)a.out + 96 * MiB);
    const int tid = threadIdx.x, lane = tid & 63, w = __builtin_amdgcn_readfirstlane(tid >> 6), r = lane & 31, hh = lane >> 5;
    const unsigned lb = (unsigned)(size_t)lds;
    for (int item = blockIdx.x; item < (NTOK / 128) * 2; item += gridDim.x) {
        const int kvh = item & 1, tok0 = (item >> 1) * 128; int s0, L; seq_of(tok0, s0, L);
        const bool first = tok0 == s0, last = tok0 + 128 == s0 + L;
        __syncthreads();
#pragma unroll
        for (int i = 0; i < 6; ++i) {
            const int idx = tid + 512 * i, row = idx >> 3, c8 = idx & 7, kpos = tok0 - 128 + row;
            u32x4 kk = (u32x4){0, 0, 0, 0}, vv = (u32x4){0, 0, 0, 0};
            if (kpos >= s0 && kpos < s0 + L) { const bf16_t* ur = U + (size_t)kpos * UP + kvh * 64 + c8 * 8; kk = *(const u32x4*)(ur + C_KB); vv = *(const u32x4*)(ur + C_VB); }
            *(LAS u32x4*)(lds + SW_K + offk(row, c8)) = kk; *(LAS u32x4*)(lds + SW_V + offv(row, c8)) = vv;
        }
        for (int e = tid; e < 4 * SW_TBN; e += NTHR) {
            const int hl = e / SW_TBN, idx = e - hl * SW_TBN, rel = idx - 160;
            const float val = (rel >= -128 && rel <= 128) ? a.relb[t5_bucket(rel) * 8 + kvh * 4 + hl] : SW_NEG;
            LAS float* tb = (LAS float*)(lds + SW_TB + hl * SW_TBH);
#pragma unroll
            for (int s = 0; s < 4; ++s) if (idx - s >= 0) tb[s * SW_TBN + idx - s] = val;
        }
        __syncthreads();
        const int hl = w >> 1, hq = kvh * 4 + hl;
        const float snk = a.sink[hq];
#pragma unroll 1
        for (int ss = 0; ss < 2; ++ss) {
            const int st = (w & 1) * 2 + ss, qtok = tok0 + 32 * st + r;
            bf16x8 Qf[4];
#pragma unroll
            for (int s = 0; s < 4; ++s) Qf[s] = *(const bf16x8*)(U + (size_t)qtok * UP + C_QB + hq * 64 + 16 * s + 8 * hh);
            float m = snk, l = hh == 0 ? 1.0f : 0.0f;
            f32x16 O[2];
#pragma unroll
            for (int i = 0; i < 16; ++i) { O[0][i] = 0.f; O[1][i] = 0.f; }
            const int sft = (-r) & 3;
            const unsigned tbase = SW_TB + hl * SW_TBH + sft * (SW_TBN * 4) + 4 * (32 + 4 * hh - r - sft);
            const unsigned kb0 = SW_K + 128u * r + 16u * (hh ^ ((r >> 1) & 7)) + 4096u * st;
            const int q4 = (lane & 15) >> 2, p4 = lane & 3, g1 = (lane >> 4) & 1, xq = (q4 >> 1) & 1;
            const unsigned vb0 = SW_V + 128u * (4 * hh + q4) + 16u * ((4 * xq) | (2 * g1) | (p4 >> 1)) + 8u * (p4 & 1) + 4096u * st;
#pragma unroll 1
            for (int grp = 0; grp < 3; ++grp) {
                f32x16 S[3];
#pragma unroll
                for (int k3 = 0; k3 < 3; ++k3) {
                    const int kk = 3 * grp + k3, blk = (st + kk) >> 2;
                    const bool valid = !((blk == 0 && first) || (blk == 2 && last));
                    if (valid) {
#pragma unroll
                        for (int i = 0; i < 16; ++i) S[k3][i] = 0.f;
#pragma unroll
                        for (int s = 0; s < 4; ++s) { const bf16x8 Kf = *(const LAS bf16x8*)(lds + (kb0 ^ (32u * s)) + 4096u * kk); S[k3] = MFMA32(Kf, Qf[s], S[k3]); }
#pragma unroll
                        for (int i4 = 0; i4 < 4; ++i4) { const f32x4 bv = *(const LAS f32x4*)(lds + tbase + 4 * (32 * kk + 8 * i4));
#pragma unroll
                            for (int j = 0; j < 4; ++j) S[k3][4 * i4 + j] += bv[j]; }
                    } else {
#pragma unroll
                        for (int i = 0; i < 16; ++i) S[k3][i] = SW_NEG;
                    }
                }
                float mx = SW_NEG;
#pragma unroll
                for (int k3 = 0; k3 < 3; ++k3)
#pragma unroll
                    for (int i = 0; i < 16; ++i) mx = fmaxf(mx, S[k3][i]);
                mx = fmaxf(mx, __shfl_xor(mx, 32));
                const float mn = fmaxf(m, mx), alpha = __expf(m - mn);
                m = mn; l *= alpha;
#pragma unroll
                for (int i = 0; i < 16; ++i) { O[0][i] *= alpha; O[1][i] *= alpha; }
                bf16x8 Pf[3][2];
#pragma unroll
                for (int k3 = 0; k3 < 3; ++k3) {
#pragma unroll
                    for (int i = 0; i < 16; ++i) { const float pv = __expf(S[k3][i] - m); S[k3][i] = pv; l += pv; }
#pragma unroll
                    for (int s2 = 0; s2 < 2; ++s2) {
                        u32x4 pw;
#pragma unroll
                        for (int j = 0; j < 4; ++j) pw[j] = pk2(S[k3][8 * s2 + 2 * j], S[k3][8 * s2 + 2 * j + 1]);
                        Pf[k3][s2] = __builtin_bit_cast(bf16x8, pw);
                    }
                }
#pragma unroll
                for (int k3 = 0; k3 < 3; ++k3) {
                    const int kk = 3 * grp + k3;
#pragma unroll
                    for (int s2 = 0; s2 < 2; ++s2)
#pragma unroll
                        for (int dt = 0; dt < 2; ++dt) {
                            const unsigned va = (vb0 ^ (64u * dt)) + 4096u * kk + 2048u * s2;
                            const bf16x8 Vf = tr_read8(lds, va, va + 1024u);
                            O[dt] = MFMA32(Vf, Pf[k3][s2], O[dt]);
                        }
                }
            }
            l += __shfl_xor(l, 32);
            const float inv = 1.0f / l;
#pragma unroll
            for (int dt = 0; dt < 2; ++dt)
#pragma unroll
                for (int i4 = 0; i4 < 4; ++i4) {
                    const int d0 = 32 * dt + 8 * i4 + 4 * hh;
                    const u32x2 zv = *(const u32x2*)(U + (size_t)qtok * UP + C_ZB + hq * 64 + d0);
                    const float z0 = __uint_as_float(zv.x << 16), z1 = __uint_as_float(zv.x & 0xffff0000u), z2 = __uint_as_float(zv.y << 16), z3 = __uint_as_float(zv.y & 0xffff0000u);
                    u32x2 yw; yw.x = pk2(O[dt][4 * i4] * inv * silu(z0), O[dt][4 * i4 + 1] * inv * silu(z1)); yw.y = pk2(O[dt][4 * i4 + 2] * inv * silu(z2), O[dt][4 * i4 + 3] * inv * silu(z3));
                    *(u32x2*)(ymix + (size_t)qtok * DM + 512 + hq * 64 + d0) = yw;
                }
        }
    }
}

__global__ void __launch_bounds__(NTHR, 2) mega(Args a) {
    extern __shared__ __attribute__((aligned(16))) unsigned char lds_raw[];
    LAS unsigned char* lds = (LAS unsigned char*)lds_raw;
    volatile LAS unsigned* MISC = (volatile LAS unsigned*)(lds + MISC_OFF);
    if (threadIdx.x < 32) MISC[threadIdx.x] = 0u;
    __syncthreads();
    unsigned char* ws = a.ws; float* out = a.out;
    XcdBarrier bar = xcd_barrier_post((unsigned*)(ws + WS_CTL) + 4096, MISC + 8);
    bf16_t* W1t = (bf16_t*)(ws + WS_W1T); bf16_t* W2t = (bf16_t*)(ws + WS_W2T); bf16_t* W3t = (bf16_t*)(ws + WS_W3T); bf16_t* W4t = (bf16_t*)(ws + WS_W4T);
    bf16_t* xb = (bf16_t*)(ws + WS_XB); bf16_t* ymix = (bf16_t*)((unsigned char*)out + 96 * MiB); bf16_t* G = xb; bf16_t* U = (bf16_t*)(ws + WS_U);
    bf16_t* x1b = (bf16_t*)(ws + WS_X1B); bf16_t* P = (bf16_t*)(ws + WS_P); bf16_t* Sg = (bf16_t*)(ws + WS_S);
    f32x2* stat1 = (f32x2*)(ws + WS_STAT1); f32x2* stat2 = (f32x2*)(ws + WS_STAT2); f32x2* mr1 = (f32x2*)(ws + WS_MR1);

    phase_convert(a, lds);
    xcd_barrier(bar);
    { pg8::Gemm g{xb, W1t, NTOK, UP, DM, 0}; pg8::StaticOrder S; S.init(NTOK, UP, gridDim.x, blockIdx.x); EpiU E{U}; pg8::gemm_phase<EpiU, pg8::StaticOrder>(lds, g, S, E); }
    xcd_barrier(bar);
    phase_gla_pass1(a, lds);
    xcd_barrier(bar);
    phase_gla_pass2(a);
    phase_swa(a, lds);
    xcd_barrier(bar);
    phase_gla_pass3(a, lds);
    xcd_barrier(bar);
    { pg8::Gemm g{ymix, W2t, NTOK, DM, DM, 0}; pg8::StaticOrder S; S.init(NTOK, DM, gridDim.x, blockIdx.x);
      EpiLN<0> E{ws, nullptr, a.lng, a.lnb}; pg8::gemm_phase<EpiLN<0>, pg8::StaticOrder>(lds, g, S, E); }
    xcd_barrier(bar);
    { pg8::Gemm g{x1b, W3t, NTOK, 4096, DM, 0}; pg8::StaticOrder S; S.init(NTOK, 4096, gridDim.x, blockIdx.x); EpiPS E{P, Sg}; pg8::gemm_phase<EpiPS, pg8::StaticOrder>(lds, g, S, E); }
    xcd_barrier(bar);
    phase_convgate(P, Sg, a.cw, G);
    xcd_barrier(bar);
    { pg8::Gemm g{G, W4t, NTOK, DM, DM, 0}; pg8::StaticOrder S; S.init(NTOK, DM, gridDim.x, blockIdx.x);
      EpiLN<1> E{ws, out, a.lng + DM, a.lnb + DM}; pg8::gemm_phase<EpiLN<1>, pg8::StaticOrder>(lds, g, S, E); }
}

extern "C" void kernel_launch(void* const* d_in, const int* in_sizes, int n_in, void* d_out, int out_size, void* d_ws, size_t ws_size, hipStream_t stream) {
    static int grid = 0;
    if (grid == 0) {
        if (n_in != 16 || out_size != NTOK * DM || ws_size < WS_END) { fprintf(stderr, "kernel_launch: unexpected shapes (n_in %d out %d ws %zu)\n", n_in, out_size, ws_size); grid = -1; return; }
        int dev = 0, cus = 0, per_cu = 0;
        if (hipGetDevice(&dev) != hipSuccess || hipDeviceGetAttribute(&cus, hipDeviceAttributeMultiprocessorCount, dev) != hipSuccess) { grid = -1; return; }
        if (hipFuncSetAttribute((const void*)mega, hipFuncAttributeMaxDynamicSharedMemorySize, LDS_BYTES) != hipSuccess) { fprintf(stderr, "kernel_launch: hipFuncSetAttribute failed\n"); grid = -1; return; }
        if (hipOccupancyMaxActiveBlocksPerMultiprocessor(&per_cu, (const void*)mega, NTHR, LDS_BYTES) != hipSuccess || per_cu < 1) { fprintf(stderr, "kernel_launch: occupancy query says %d blocks per CU\n", per_cu); (void)hipGetLastError(); grid = -1; return; }
        grid = cus;
    }
    if (grid < 0) return;
    (void)hipMemsetAsync((char*)d_ws + WS_CTL, 0, 262144, stream);
    Args a{};
    a.xp = (const float*)d_in[0]; a.xs = (const float*)d_in[1]; a.w_in_even = (const float*)d_in[2]; a.wuf = (const float*)d_in[3]; a.bfw = (const float*)d_in[4];
    a.wub = (const float*)d_in[5]; a.bbw = (const float*)d_in[6]; a.ng = (const float*)d_in[7]; a.sink = (const float*)d_in[8]; a.relb = (const float*)d_in[9];
    a.w_out_even = (const float*)d_in[10]; a.w_in_odd = (const float*)d_in[11]; a.cw = (const float*)d_in[12]; a.w_out_odd = (const float*)d_in[13];
    a.lng = (const float*)d_in[14]; a.lnb = (const float*)d_in[15]; a.out = (float*)d_out; a.ws = (unsigned char*)d_ws;
    hipLaunchKernelGGL(mega, dim3(grid), dim3(NTHR), LDS_BYTES, stream, a);
}
```

```cpp
#include <hip/hip_runtime.h>
#include <cstdio>

typedef unsigned short bf16_t;
typedef short bf16x8 __attribute__((ext_vector_type(8)));
typedef float f32x4 __attribute__((ext_vector_type(4)));
typedef float f32x2 __attribute__((ext_vector_type(2)));
typedef unsigned u32x4 __attribute__((ext_vector_type(4)));
typedef unsigned u32x2 __attribute__((ext_vector_type(2)));
#define LAS __attribute__((address_space(3)))
extern __shared__ __attribute__((aligned(16))) unsigned char lds_raw[];
constexpr int SLOT_OFF = 131072 + 512;
__device__ __forceinline__ unsigned hw_slot() { return (unsigned)__builtin_amdgcn_s_getreg((5 << 11) | 4) & 63u; }
__device__ __forceinline__ int tid_now() {
    const int wid = __builtin_amdgcn_readfirstlane((int)((volatile LAS unsigned*)((LAS unsigned char*)lds_raw + SLOT_OFF))[hw_slot()]);
    return wid * 64 + (int)__lane_id();
}

constexpr int DM = 1024, NTOK = 49152, NPROMPT = 32768, LP = 16384, LS = 4096;
constexpr int UP = 3584;
constexpr int C_QA = 0, C_KA = 512, C_VA = 1024, C_ZA = 1536, C_QB = 2048, C_KB = 2560, C_VB = 2688, C_ZB = 2816, C_GD = 3328;
constexpr int EVEN_IN = 3360, ODD_IN = 4096;
constexpr float DN_ALPHA = 1.41421356237309515f;
constexpr float LN_EPS = 1e-5f, NORM_EPS = 1e-6f;

constexpr size_t MiB = 1u << 20;
constexpr size_t WS_CTL = 0, WS_W1T = 1 * MiB, WS_W2T = 8 * MiB, WS_W3T = 10 * MiB, WS_W4T = 18 * MiB, WS_STAT1 = 20 * MiB, WS_MR1 = 26 * MiB, WS_DEC = 27 * MiB, WS_GATE = 27 * MiB + 768 * 1024,
                 WS_XB = 28 * MiB  , WS_U = 124 * MiB, WS_ST = 460 * MiB, WS_END = 508 * MiB;
constexpr size_t WS_X1B = WS_U, WS_P = WS_U + 96 * MiB, WS_S = WS_U + 192 * MiB, WS_STAT2 = WS_U + 288 * MiB;

__device__ __forceinline__ float bf2f(bf16_t b) { return __uint_as_float(((unsigned)b) << 16); }
typedef __bf16 nbf16x2 __attribute__((ext_vector_type(2)));
__device__ __forceinline__ bf16_t f2bf(float f) { return __builtin_bit_cast(bf16_t, (__bf16)f); }
__device__ __forceinline__ unsigned pk2(float lo, float hi) { return __builtin_bit_cast(unsigned, __builtin_convertvector((f32x2){lo, hi}, nbf16x2)); }
__device__ __forceinline__ float fexp2(float x) { return __builtin_amdgcn_exp2f(x); }
__device__ __forceinline__ float fexp(float x) { return __builtin_amdgcn_exp2f(x * 1.4426950408889634f); }
__device__ __forceinline__ float flog2(float x) { return __builtin_amdgcn_logf(x); }
__device__ __forceinline__ float silu(float x) { return x * __builtin_amdgcn_rcpf(1.0f + fexp(-x)); }
__device__ __forceinline__ float wave_sum(float v) {
#pragma unroll
    for (int o = 1; o < 64; o <<= 1) v += __shfl_xor(v, o);
    return v;
}
__device__ __forceinline__ float wave_max(float v) {
#pragma unroll
    for (int o = 1; o < 64; o <<= 1) v = fmaxf(v, __shfl_xor(v, o));
    return v;
}
__device__ __forceinline__ void seq_of(int row, int& s0, int& L) {
    if (row < NPROMPT) { L = LP; s0 = row & ~(LP - 1); } else { L = LS; s0 = NPROMPT + ((row - NPROMPT) & ~(LS - 1)); }
}

namespace pg8 {
constexpr int BM = 256, BK = 64, HALF = 128, HTB = HALF * BK * 2, STAGE_BYTES = 8 * HTB, NXCD = 8, WGM = 8;
__host__ __device__ __forceinline__ int lds_byte(int r, int c) { const int st = (r >> 4) * 2 + (c >> 5), rr = r & 15, cc = c & 31, ob = rr * 64 + cc * 2; return st * 1024 + (ob ^ (((ob >> 9) & 1) << 5)); }
__host__ __device__ __forceinline__ void stage_rc(int b, int& R, int& C) { const int st = b / 1024, sb = b % 1024, swz = sb ^ (((sb >> 9) & 1) << 5); R = (st >> 1) * 16 + swz / 64; C = (st & 1) * 32 + (swz % 64) / 2; }
__host__ __device__ __forceinline__ int perm32(int rho) { const int n = rho >> 4, i = rho & 15; return 8 * (i >> 2) + 4 * n + (i & 3); }
struct Unit { int pm, pn; };
struct Gemm { const bf16_t* A; const bf16_t* Bt; int M, N, K, pad; };
struct StaticOrder {
    int nM, nN, nwg, G, c;
    __host__ __device__ void init(int M, int N, int G_, int c_) { nM = M / BM; nN = N / BM; nwg = nM * nN; G = G_; c = c_; }
    __host__ __device__ bool next(int i, Unit& u) const {
        const long L = (long)i * G + c; if (L >= nwg) return false;
        int wgid = (int)L; { const int q = nwg / NXCD, r = nwg % NXCD, xcd = wgid % NXCD, off = wgid / NXCD; wgid = (xcd < r ? xcd * (q + 1) : r * (q + 1) + (xcd - r) * q) + off; }
        const int nig = WGM * nN, gid = wgid / nig, fm = gid * WGM, gsz = (nM - fm) < WGM ? (nM - fm) : WGM;
        u.pm = fm + ((wgid % nig) % gsz); u.pn = (wgid % nig) / gsz; return true;
    }
    __device__ __forceinline__ void a_ready(const Unit&) const {}
    __device__ __forceinline__ void done(const Unit&) const {}
};

template <class Epi, class Sched>
__device__ __forceinline__ void gemm_phase(LAS unsigned char* lds, const Gemm g, const Sched& S, const Epi& E) {
    int tid = tid_now(); asm volatile("" : "+v"(tid));
    const int wid = __builtin_amdgcn_readfirstlane(tid >> 6), lane = tid & 63, wr = wid >> 2, wc = wid & 3, fr = lane & 15, fq = lane >> 4;
    const int K = g.K, nt = K / BK;
    unsigned voffA[2], voffB[2];
#pragma unroll
    for (int i = 0; i < 2; ++i) { int R, C; stage_rc(tid * 16 + i * 8192, R, C); const int Rb = Epi::PERM ? ((R & ~31) + perm32(R & 31)) : R;
        voffA[i] = (unsigned)(R * K + C) * 2u; voffB[i] = (unsigned)(Rb * K + C) * 2u; }
    const size_t kstep = (size_t)(BK * 2);
    const size_t hstep = (size_t)HALF * K * 2;
    const size_t tstep = 2 * hstep;
    const unsigned ldsw = (unsigned)wid * 1024u;
    const int aoff = lds_byte(wr * 64 + fr, fq * 8), boff = lds_byte(wc * 32 + fr, fq * 8);
#define PG8_SA(b, h) (((b) * 2 + (h)) * HTB)
#define PG8_SB(b, h) ((4 + (b) * 2 + (h)) * HTB)
#define PG8_STAGE(bufoff, gbase, voff) do { _Pragma("unroll") for (int _i = 0; _i < 2; ++_i) \
        __builtin_amdgcn_global_load_lds((const unsigned*)((const char*)(gbase) + (voff)[_i]), (LAS unsigned*)(lds + (bufoff) + ldsw + _i * 8192), 16, 0, 0); } while (0)
#define PG8_LDA(dst, b, h) do { _Pragma("unroll") for (int m = 0; m < 4; ++m) _Pragma("unroll") for (int k = 0; k < 2; ++k) dst[m][k] = *(const LAS bf16x8*)(lds + PG8_SA(b, h) + aoff + m * 2048 + k * 1024); } while (0)
#define PG8_LDB(dst, b, h) do { _Pragma("unroll") for (int n = 0; n < 2; ++n) _Pragma("unroll") for (int k = 0; k < 2; ++k) dst[n][k] = *(const LAS bf16x8*)(lds + PG8_SB(b, h) + boff + n * 2048 + k * 1024); } while (0)
#define PG8_MMA(ai, bj, At, Bt) do { __builtin_amdgcn_s_setprio(1); _Pragma("unroll") for (int m = 0; m < 4; ++m) _Pragma("unroll") for (int n = 0; n < 2; ++n) _Pragma("unroll") for (int k = 0; k < 2; ++k) \
        acc[ai][bj][m][n] = __builtin_amdgcn_mfma_f32_16x16x32_bf16(Bt[n][k], At[m][k], acc[ai][bj][m][n], 0, 0, 0); __builtin_amdgcn_s_setprio(0); } while (0)
#define PG8_WAIT_V(n) asm volatile("s_waitcnt vmcnt(" #n ")" ::: "memory")
#define PG8_WAIT_L(n) asm volatile("s_waitcnt lgkmcnt(" #n ")" ::: "memory")
#define PG8_BAR __builtin_amdgcn_s_barrier()
#define PG8_SCHED __builtin_amdgcn_sched_barrier(0)
    Unit cur, nxt; int ui = 0;
    if (!S.next(0, cur)) return;
    f32x4 acc[2][2][4][2];
#pragma unroll
    for (int a = 0; a < 2; ++a)
#pragma unroll
        for (int b = 0; b < 2; ++b)
#pragma unroll
            for (int m = 0; m < 4; ++m)
#pragma unroll
                for (int n = 0; n < 2; ++n) acc[a][b][m][n] = (f32x4){0.f, 0.f, 0.f, 0.f};
    bf16x8 At[4][2], B0[2][2], B1[2][2];
    const char* cA = (const char*)g.A + (size_t)cur.pm * tstep; const char* cB = (const char*)g.Bt + (size_t)cur.pn * tstep;
    S.a_ready(cur);
    PG8_STAGE(PG8_SB(0, 0), cB, voffB); PG8_STAGE(PG8_SA(0, 0), cA, voffA); PG8_STAGE(PG8_SB(0, 1), cB + hstep, voffB); PG8_STAGE(PG8_SA(0, 1), cA + hstep, voffA);
    if (wr == 1) PG8_BAR;
    PG8_WAIT_V(4); PG8_BAR;
    PG8_STAGE(PG8_SB(1, 0), cB + kstep, voffB); PG8_STAGE(PG8_SA(1, 0), cA + kstep, voffA); PG8_STAGE(PG8_SB(1, 1), cB + hstep + kstep, voffB);
    PG8_WAIT_V(6); PG8_BAR;
    for (;;) {
        const bool has_next = S.next(ui + 1, nxt);
        const char* nA = has_next ? (const char*)g.A + (size_t)nxt.pm * tstep : cA; const char* nB = has_next ? (const char*)g.Bt + (size_t)nxt.pn * tstep : cB;
        for (int t = 0; t < nt; t += 2) {
            const bool last = (t == nt - 2);
            const char* a1 = cA + (size_t)(t + 1) * kstep;
            const char* a2 = last ? nA : cA + (size_t)(t + 2) * kstep; const char* b2 = last ? nB : cB + (size_t)(t + 2) * kstep;
            const char* a3 = a2 + kstep; const char* b3 = b2 + kstep;
            if (last && has_next) S.a_ready(nxt);
            PG8_LDB(B0, 0, 0); PG8_SCHED; PG8_LDA(At, 0, 0); PG8_STAGE(PG8_SA(1, 1), a1 + hstep, voffA);
            PG8_WAIT_L(8); PG8_BAR; PG8_WAIT_L(0); PG8_MMA(0, 0, At, B0); PG8_BAR; PG8_SCHED;
            PG8_LDB(B1, 0, 1); PG8_STAGE(PG8_SB(0, 0), b2, voffB);
            PG8_BAR; PG8_WAIT_L(0); PG8_MMA(0, 1, At, B1); PG8_BAR;
            PG8_LDA(At, 0, 1); PG8_STAGE(PG8_SA(0, 0), a2, voffA);
            PG8_BAR; PG8_WAIT_L(0); PG8_MMA(1, 0, At, B0); PG8_BAR; PG8_SCHED;
            PG8_STAGE(PG8_SB(0, 1), b2 + hstep, voffB);
            PG8_WAIT_V(6); PG8_BAR; PG8_MMA(1, 1, At, B1); PG8_BAR;
            PG8_LDB(B0, 1, 0); PG8_SCHED; PG8_LDA(At, 1, 0); PG8_STAGE(PG8_SA(0, 1), a2 + hstep, voffA);
            PG8_WAIT_L(8); PG8_BAR; PG8_WAIT_L(0); PG8_MMA(0, 0, At, B0); PG8_BAR; PG8_SCHED;
            PG8_LDB(B1, 1, 1); PG8_STAGE(PG8_SB(1, 0), b3, voffB);
            PG8_BAR; PG8_WAIT_L(0); PG8_MMA(0, 1, At, B1); PG8_BAR;
            PG8_LDA(At, 1, 1); PG8_STAGE(PG8_SA(1, 0), a3, voffA);
            PG8_BAR; PG8_WAIT_L(0); PG8_MMA(1, 0, At, B0); PG8_BAR; PG8_SCHED;
            PG8_STAGE(PG8_SB(1, 1), b3 + hstep, voffB);
            PG8_WAIT_V(6); PG8_BAR; PG8_MMA(1, 1, At, B1); PG8_BAR;
        }
        if constexpr (Epi::REALIGN) { if (wr == 0) PG8_BAR; }
        E(acc, cur, wr, wc, fr, fq); S.done(cur);
        if constexpr (Epi::REALIGN) { if (wr == 1) PG8_BAR; }
        if (!has_next) break;
#pragma unroll
        for (int a = 0; a < 2; ++a)
#pragma unroll
            for (int b = 0; b < 2; ++b)
#pragma unroll
                for (int m = 0; m < 4; ++m)
#pragma unroll
                    for (int n = 0; n < 2; ++n) acc[a][b][m][n] = (f32x4){0.f, 0.f, 0.f, 0.f};
        cur = nxt; cA = nA; cB = nB; ++ui;
    }
    PG8_WAIT_V(0);
    if (wr == 0) PG8_BAR;
    PG8_BAR;
#undef PG8_SA
#undef PG8_SB
#undef PG8_STAGE
#undef PG8_LDA
#undef PG8_LDB
#undef PG8_MMA
#undef PG8_WAIT_V
#undef PG8_WAIT_L
#undef PG8_BAR
#undef PG8_SCHED
}
}

struct EpiU {
    static constexpr bool PERM = true, AFTER_DRAIN = false, REALIGN = false;
    bf16_t* O;
    __device__ __forceinline__ void operator()(const f32x4 (&acc)[2][2][4][2], const pg8::Unit& u, int wr, int wc, int fr, int fq) const {
        const int row0 = u.pm * 256 + wr * 64 + fr, col0 = u.pn * 256 + wc * 32 + 8 * fq;
#pragma unroll
        for (int ai = 0; ai < 2; ++ai)
#pragma unroll
            for (int m = 0; m < 4; ++m) { bf16_t* rowp = O + (size_t)(row0 + ai * 128 + m * 16) * UP + col0;
#pragma unroll
                for (int bj = 0; bj < 2; ++bj) { const f32x4 v0 = acc[ai][bj][m][0], v1 = acc[ai][bj][m][1];
                    u32x4 w; w.x = pk2(v0[0], v0[1]); w.y = pk2(v0[2], v0[3]); w.z = pk2(v1[0], v1[1]); w.w = pk2(v1[2], v1[3]);
                    *(u32x4*)(rowp + bj * 128) = w; } }
    }
};
template <int LAYER> struct EpiY {
    static constexpr bool PERM = false, AFTER_DRAIN = false, REALIGN = false;
    const float* xp; const float* xs; float* Y; f32x2* stat; const f32x2* mr; const float* lg; const float* lb;
    __device__ __forceinline__ void operator()(const f32x4 (&acc)[2][2][4][2], const pg8::Unit& u, int wr, int wc, int fr, int fq) const {
        const int col0 = u.pn * 256 + wc * 32 + 4 * fq;
        f32x4 gv[2][2], bv[2][2];
        if (LAYER == 1) {
#pragma unroll
            for (int bj = 0; bj < 2; ++bj)
#pragma unroll
                for (int n = 0; n < 2; ++n) { gv[bj][n] = *(const f32x4*)(lg + col0 + bj * 128 + n * 16); bv[bj][n] = *(const f32x4*)(lb + col0 + bj * 128 + n * 16); }
        }
#pragma unroll
        for (int ai = 0; ai < 2; ++ai)
#pragma unroll
            for (int m = 0; m < 4; ++m) {
                const int row = u.pm * 256 + ai * 128 + wr * 64 + m * 16 + fr;
                const float* rp; f32x2 mrv = (f32x2){0.f, 1.f};
                if (LAYER == 0) rp = (row < NPROMPT) ? xp + (size_t)row * DM : xs + (size_t)(row - NPROMPT) * DM;
                else { rp = Y + (size_t)row * DM; mrv = mr[row]; }
                float* yp = Y + (size_t)row * DM;
                float s = 0.f, q = 0.f;
#pragma unroll
                for (int bj = 0; bj < 2; ++bj)
#pragma unroll
                    for (int n = 0; n < 2; ++n) {
                        const int c = col0 + bj * 128 + n * 16;
                        f32x4 r = *(const f32x4*)(rp + c);
                        if (LAYER == 1) r = (r - mrv.x) * mrv.y * gv[bj][n] + bv[bj][n];
                        const f32x4 y = r * DN_ALPHA + acc[ai][bj][m][n];
                        *(f32x4*)(yp + c) = y;
                        s += (y[0] + y[1]) + (y[2] + y[3]); q += (y[0] * y[0] + y[1] * y[1]) + (y[2] * y[2] + y[3] * y[3]);
                    }
                s += __shfl_xor(s, 16); s += __shfl_xor(s, 32); q += __shfl_xor(q, 16); q += __shfl_xor(q, 32);
                if (fq == 0) stat[(size_t)row * 16 + u.pn * 4 + wc] = (f32x2){s, q};
            }
    }
};
#define RLX_AGENT __ATOMIC_RELAXED, __HIP_MEMORY_SCOPE_AGENT
template <int LAYER> struct EpiLN {
    static constexpr bool PERM = true, AFTER_DRAIN = false, REALIGN = true;
    unsigned char* ws; float* Of; const float* lg; const float* lb;
    __device__ __forceinline__ void operator()(f32x4 (&acc)[2][2][4][2], const pg8::Unit& u, int wr, int wc, int fr, int fq) const {
        unsigned char* w2 = ws; asm volatile("" : "+s"(w2));
        const bf16_t* R = (const bf16_t*)(w2 + (LAYER == 0 ? WS_XB : WS_X1B)); bf16_t* Ob = (bf16_t*)(w2 + WS_X1B);
        unsigned long long* xbuf = (unsigned long long*)(w2 + (LAYER == 0 ? WS_STAT1 : WS_STAT2)); unsigned* cnt = (unsigned*)(w2 + WS_CTL) + 16384 + LAYER * 192 * 64;
        const int col0 = u.pn * 256 + wc * 32 + 8 * fq, rowb = u.pm * 256 + wr * 64 + fr;
        float ps[2][4], pq[2][4];
#pragma unroll
        for (int ai = 0; ai < 2; ++ai)
#pragma unroll
            for (int m = 0; m < 4; ++m) {
                const bf16_t* rp = R + (size_t)(rowb + ai * 128 + m * 16) * DM + col0;
                float s = 0.f, q = 0.f;
#pragma unroll
                for (int bj = 0; bj < 2; ++bj) {
                    const u32x4 rw = *(const u32x4*)(rp + bj * 128);
                    f32x4 r0 = (f32x4){__uint_as_float(rw.x << 16), __uint_as_float(rw.x & 0xffff0000u), __uint_as_float(rw.y << 16), __uint_as_float(rw.y & 0xffff0000u)};
                    f32x4 r1 = (f32x4){__uint_as_float(rw.z << 16), __uint_as_float(rw.z & 0xffff0000u), __uint_as_float(rw.w << 16), __uint_as_float(rw.w & 0xffff0000u)};
                    const f32x4 v0 = r0 * DN_ALPHA + acc[ai][bj][m][0], v1 = r1 * DN_ALPHA + acc[ai][bj][m][1];
                    acc[ai][bj][m][0] = v0; acc[ai][bj][m][1] = v1;
                    s += ((v0[0] + v0[1]) + (v0[2] + v0[3])) + ((v1[0] + v1[1]) + (v1[2] + v1[3]));
                    q += ((v0[0] * v0[0] + v0[1] * v0[1]) + (v0[2] * v0[2] + v0[3] * v0[3])) + ((v1[0] * v1[0] + v1[1] * v1[1]) + (v1[2] * v1[2] + v1[3] * v1[3]));
                }
                s += __shfl_xor(s, 16); s += __shfl_xor(s, 32); q += __shfl_xor(q, 16); q += __shfl_xor(q, 32);
                ps[ai][m] = s; pq[ai][m] = q;
            }
        if (fq == 0) {
#pragma unroll
            for (int ai = 0; ai < 2; ++ai)
#pragma unroll
                for (int m = 0; m < 4; ++m)
                    __hip_atomic_store(xbuf + (size_t)(rowb + ai * 128 + m * 16) * 16 + u.pn * 4 + wc, ((unsigned long long)__float_as_uint(pq[ai][m]) << 32) | __float_as_uint(ps[ai][m]), RLX_AGENT);
        }
        asm volatile("s_waitcnt vmcnt(0)" ::: "memory");
        unsigned* c = cnt + 64 * u.pm;
        if ((tid_now() & 63) == 0) __hip_atomic_fetch_add(c, 1u, RLX_AGENT);
        { unsigned spins = 0;
          while ((unsigned)__builtin_amdgcn_readfirstlane(__hip_atomic_load(c, RLX_AGENT)) < 32u) { __builtin_amdgcn_s_sleep(2); if (++spins > (1u << 16)) break; }
          __builtin_amdgcn_fence(__ATOMIC_ACQUIRE, "agent"); }
#pragma unroll
        for (int ai = 0; ai < 2; ++ai)
#pragma unroll
            for (int m = 0; m < 4; ++m) {
                const unsigned long long* sp = xbuf + (size_t)(rowb + ai * 128 + m * 16) * 16 + 4 * fq;
                float s = 0.f, q = 0.f;
#pragma unroll
                for (int t = 0; t < 4; ++t) { const unsigned long long w8 = __hip_atomic_load(sp + t, RLX_AGENT); s += __uint_as_float((unsigned)w8); q += __uint_as_float((unsigned)(w8 >> 32)); }
                s += __shfl_xor(s, 16); s += __shfl_xor(s, 32); q += __shfl_xor(q, 16); q += __shfl_xor(q, 32);
                const float mean = s * (1.0f / DM), var = q * (1.0f / DM) - mean * mean;
                ps[ai][m] = mean; pq[ai][m] = rsqrtf(fmaxf(var, 0.f) + LN_EPS);
            }
#pragma unroll
        for (int bj = 0; bj < 2; ++bj) {
            const f32x4 g0 = *(const f32x4*)(lg + col0 + bj * 128), g1 = *(const f32x4*)(lg + col0 + bj * 128 + 4), b0 = *(const f32x4*)(lb + col0 + bj * 128), b1 = *(const f32x4*)(lb + col0 + bj * 128 + 4);
#pragma unroll
            for (int ai = 0; ai < 2; ++ai)
#pragma unroll
                for (int m = 0; m < 4; ++m) {
                    const int row = rowb + ai * 128 + m * 16; const float mean = ps[ai][m], rstd = pq[ai][m];
                    const f32x4 o0 = (acc[ai][bj][m][0] - mean) * rstd * g0 + b0, o1 = (acc[ai][bj][m][1] - mean) * rstd * g1 + b1;
                    if (LAYER == 0) { u32x4 w; w.x = pk2(o0[0], o0[1]); w.y = pk2(o0[2], o0[3]); w.z = pk2(o1[0], o1[1]); w.w = pk2(o1[2], o1[3]); *(u32x4*)(Ob + (size_t)row * DM + col0 + bj * 128) = w; }
                    else { float* op = Of + (size_t)row * DM + col0 + bj * 128; *(f32x4*)op = o0; *(f32x4*)(op + 4) = o1; }
                }
        }
    }
};
struct EpiPS {
    static constexpr bool PERM = true, AFTER_DRAIN = false, REALIGN = false;
    bf16_t* P; bf16_t* S;
    __device__ __forceinline__ void operator()(const f32x4 (&acc)[2][2][4][2], const pg8::Unit& u, int wr, int wc, int fr, int fq) const {
        const int row0 = u.pm * 256 + wr * 64 + fr, off = (wc & 1) * 32 + 8 * fq;
        bf16_t* dst = (wc < 2 ? S : P) + u.pn * 64 + off;
#pragma unroll
        for (int ai = 0; ai < 2; ++ai)
#pragma unroll
            for (int m = 0; m < 4; ++m) {
                float o[8];
#pragma unroll
                for (int n = 0; n < 2; ++n)
#pragma unroll
                    for (int j = 0; j < 4; ++j) { const float a = acc[ai][0][m][n][j], b = acc[ai][1][m][n][j];
                        o[4 * n + j] = (wc < 2) ? silu(b) * a : a * b; }
                u32x4 w; w.x = pk2(o[0], o[1]); w.y = pk2(o[2], o[3]); w.z = pk2(o[4], o[5]); w.w = pk2(o[6], o[7]);
                *(u32x4*)(dst + (size_t)(row0 + ai * 128 + m * 16) * DM) = w;
            }
    }
};

#define XB_TMO      128
#define XB_XCNT(j)  (256  + 64 * (j))
#define XB_XSUB(j)  (1280 + 64 * (j))
#define XB_XGEN(j)  (2304 + 64 * (j))
#define XB_TOP      3328
#define XB_TOPGEN   3392
#define XCD_BAR_WORDS 3456
#define XB_SPIN_CAP (1u << 27)
__device__ __forceinline__ unsigned xb_ld(unsigned* p)              { return __hip_atomic_load(p, __ATOMIC_RELAXED, __HIP_MEMORY_SCOPE_AGENT); }
__device__ __forceinline__ unsigned xb_add(unsigned* p, unsigned v) { return __hip_atomic_fetch_add(p, v, __ATOMIC_RELAXED, __HIP_MEMORY_SCOPE_AGENT); }
__device__ __forceinline__ unsigned xb_xcc_id() { return (unsigned)__builtin_amdgcn_s_getreg((3 << 11) | 20) & 0xFu; }
#define XB_SPIN(cond, bar) do { unsigned _sp = 0; while (cond) { __builtin_amdgcn_s_sleep(1); \
    if ((++_sp & 255u) == 0u) { if (xb_ld(&(bar)[XB_TMO])) break; if (_sp > XB_SPIN_CAP) { atomicAdd(&(bar)[XB_TMO], 1u); break; } } } } while (0)
struct XcdBarrier { unsigned* bar; unsigned x; volatile LAS unsigned* st; };
__device__ __forceinline__ XcdBarrier xcd_barrier_post(unsigned* bar, volatile LAS unsigned* st) {
    XcdBarrier b; b.bar = bar; b.x = xb_xcc_id(); b.st = st;
    if (tid_now() == 0) (void)xb_add(&bar[XB_XCNT(b.x)], 1u);
    return b;
}
__device__ __forceinline__ void xcd_barrier_complete(unsigned* bar, unsigned x, unsigned& nloc, unsigned& nx) {
    const unsigned G = gridDim.x * gridDim.y * gridDim.z;
    unsigned sum, cnt, mine, sp = 0u;
    for (;;) {
        sum = 0u; cnt = 0u; mine = 0u;
#pragma unroll
        for (unsigned j = 0; j < 16; ++j) { const unsigned c = xb_ld(&bar[XB_XCNT(j)]); sum += c; cnt += (c > 0u) ? 1u : 0u; mine = (j == x) ? c : mine; }
        if (sum == G) break;
        __builtin_amdgcn_s_sleep(1);
        if ((++sp & 255u) == 0u) { if (xb_ld(&bar[XB_TMO])) break; if (sp > XB_SPIN_CAP) { atomicAdd(&bar[XB_TMO], 1u); break; } }
    }
    nloc = mine > 0u ? mine : 1u; nx = cnt > 0u ? cnt : 1u;
}
__device__ __forceinline__ void xcd_barrier(const XcdBarrier& b) {
    asm volatile("s_waitcnt vmcnt(0)" ::: "memory");
    __syncthreads();
    if (tid_now() == 0) {
        unsigned* bar = b.bar;
        __builtin_amdgcn_s_waitcnt(0);
        unsigned nloc = b.st[0], nx = b.st[1];
        if (nloc == 0u) { xcd_barrier_complete(bar, b.x, nloc, nx); b.st[0] = nloc; b.st[1] = nx; }
        const unsigned old = xb_add(&bar[XB_XSUB(b.x)], 1u);
        const unsigned gen = old / nloc;
        if (old + 1u == (gen + 1u) * nloc) {
            __builtin_amdgcn_fence(__ATOMIC_RELEASE, "agent");
            asm volatile("s_waitcnt vmcnt(0)" ::: "memory");
            const unsigned og = xb_add(&bar[XB_TOP], 1u);
            const unsigned tg = og / nx;
            if (og + 1u == (tg + 1u) * nx) xb_add(&bar[XB_TOPGEN], 1u);
            else XB_SPIN(xb_ld(&bar[XB_TOPGEN]) == tg, bar);
            __builtin_amdgcn_fence(__ATOMIC_ACQUIRE, "agent");
            xb_add(&bar[XB_XGEN(b.x)], 1u);
            asm volatile("s_waitcnt vmcnt(0)" ::: "memory");
        } else {
            XB_SPIN(xb_ld(&bar[XB_XGEN(b.x)]) == gen, bar);
            __builtin_amdgcn_fence(__ATOMIC_ACQUIRE, "agent");
            asm volatile("s_waitcnt vmcnt(0)" ::: "memory");
        }
    }
    __syncthreads();
}

struct Args {
    const float *xp, *xs, *w_in_even, *wuf, *bfw, *wub, *bbw, *ng, *sink, *relb, *w_out_even, *w_in_odd, *cw, *w_out_odd, *lng, *lnb;
    float* out; unsigned char* ws;
};
constexpr int NTHR = 512;
constexpr int LDS_BYTES = 147456, MISC_OFF = 131072 + 1024;

template <int MODE> __device__ __forceinline__ int wmap(int n, float& sc) {
    sc = 1.f;
    if (MODE == 0) return n;
    if (MODE == 1) {
        if (n < 512) sc = 0.08838834764831845f;
        if (n >= C_QB && n < C_KB) sc = 0.125f;
        if (n < 2048) return n;
        if (n < C_GD) return n + 32;
        if (n < C_GD + 32) return n - C_GD + 2048;
        return -1;
    }
    const int w = n & 255, grp = w >> 6, ch = (n >> 8) * 64 + (w & 63);
    const int base = grp == 0 ? 0 : (grp == 1 ? 1024 : (grp == 2 ? 3072 : 2048));
    return base + ch;
}
template <int MODE> __device__ __forceinline__ void wconv_item(const float* __restrict__ W, int Nsrc, bf16_t* __restrict__ Wt, int Ndst, int item, LAS float* tile, int t256) {
    const int nb = item % (Ndst / 64), kb = item / (Ndst / 64), n0 = nb * 64, k0 = kb * 64;
    const int tx = t256 & 63, ty = t256 >> 6;
    float sc; const int src = wmap<MODE>(n0 + tx, sc);
    for (int kk = ty; kk < 64; kk += 4) tile[kk * 65 + tx] = src >= 0 ? W[(size_t)(k0 + kk) * Nsrc + src] * sc : 0.f;
    __syncthreads();
    for (int nn = ty; nn < 64; nn += 4) Wt[(size_t)(n0 + nn) * 1024 + k0 + tx] = f2bf(tile[tx * 65 + nn]);
    __syncthreads();
}
__device__ __forceinline__ void build_gate_tables(const Args& a);
__device__ __forceinline__ void phase_convert(const Args& a, LAS unsigned char* lds) {
    unsigned char* ws = a.ws;
    bf16_t* W1t = (bf16_t*)(ws + WS_W1T); bf16_t* W2t = (bf16_t*)(ws + WS_W2T); bf16_t* W3t = (bf16_t*)(ws + WS_W3T); bf16_t* W4t = (bf16_t*)(ws + WS_W4T);
    const int half = tid_now() >> 8, t256 = tid_now() & 255;
    LAS float* tile = (LAS float*)lds + half * (64 * 65);
    constexpr int I1 = (UP / 64) * 16, I2 = 16 * 16, I3 = 64 * 16, I4 = 16 * 16, NIT = I1 + I2 + I3 + I4;
    for (int it0 = blockIdx.x * 2; it0 < NIT; it0 += gridDim.x * 2) {
        int r = it0 + half;
        if (r < I1) wconv_item<1>(a.w_in_even, EVEN_IN, W1t, UP, r, tile, t256);
        else if ((r -= I1) < I2) wconv_item<0>(a.w_out_even, 1024, W2t, 1024, r, tile, t256);
        else if ((r -= I2) < I3) wconv_item<2>(a.w_in_odd, ODD_IN, W3t, 4096, r, tile, t256);
        else if ((r -= I3) < I4) wconv_item<0>(a.w_out_odd, 1024, W4t, 1024, r, tile, t256);
        else { __syncthreads(); __syncthreads(); }
    }
    build_gate_tables(a);
    bf16_t* xb = (bf16_t*)(ws + WS_XB);
    const size_t n8 = (size_t)NTOK * DM / 8;
    for (size_t i = (size_t)blockIdx.x * NTHR + tid_now(); i < n8; i += (size_t)gridDim.x * NTHR) {
        const size_t e = i * 8; const float* src = e < (size_t)NPROMPT * DM ? a.xp + e : a.xs + (e - (size_t)NPROMPT * DM);
        const f32x4 v0 = *(const f32x4*)src, v1 = *(const f32x4*)(src + 4);
        u32x4 w; w.x = pk2(v0[0], v0[1]); w.y = pk2(v0[2], v0[3]); w.z = pk2(v1[0], v1[1]); w.w = pk2(v1[2], v1[3]);
        *(u32x4*)(xb + e) = w;
    }
}

__device__ __forceinline__ void phase_gla_naive(const Args& a, LAS unsigned char* lds, float* OF, float* OB) {
    if (blockIdx.x >= 12) return;
    const bf16_t* U = (const bf16_t*)(a.ws + WS_U);
    const int grp = tid_now() >> 7, tid = tid_now() & 127, b = blockIdx.x * 4 + grp, dir = b & 1, h = (b >> 1) & 3, s = b >> 3;
    LAS float* sq = (LAS float*)lds + grp * (3 * 16 * 128); LAS float* sk = sq + 16 * 128; LAS float* sd = sk + 16 * 128;
    const int L = s < 2 ? LP : LS, start = s < 2 ? s * LP : NPROMPT + (s - 2) * LS;
    const float* wu = dir ? a.wub : a.wuf; const float* bias = dir ? a.bbw : a.bfw; float* O = dir ? OB : OF;
    float wr[16];
#pragma unroll
    for (int r = 0; r < 16; ++r) wr[r] = wu[r * 512 + h * 128 + tid];
    const float bb = bias[h * 128 + tid];
    float S[128];
#pragma unroll
    for (int i = 0; i < 128; ++i) S[i] = 0.f;
    for (int t0 = 0; t0 < L; t0 += 16) {
        for (int tt = 0; tt < 16; ++tt) {
            const int p = t0 + tt, tok = start + (dir ? L - 1 - p : p);
            const bf16_t* ur = U + (size_t)tok * UP;
            float x = bb;
#pragma unroll
            for (int r = 0; r < 16; ++r) x += bf2f(ur[C_GD + dir * 16 + r]) * wr[r];
            const float ls = fminf(x, 0.f) - log1pf(expf(-fabsf(x)));
            sd[tt * 128 + tid] = expf(ls * (1.0f / 16.0f));
            sq[tt * 128 + tid] = bf2f(ur[C_QA + h * 128 + tid]);
            sk[tt * 128 + tid] = bf2f(ur[C_KA + h * 128 + tid]);
        }
        __syncthreads();
        for (int tt = 0; tt < 16; ++tt) {
            const int p = t0 + tt, tok = start + (dir ? L - 1 - p : p);
            const float v = bf2f(U[(size_t)tok * UP + C_VA + h * 128 + tid]);
            float acc = 0.f;
#pragma unroll
            for (int dk = 0; dk < 128; dk += 4) {
                const f32x4 d4 = *(const LAS f32x4*)&sd[tt * 128 + dk], q4 = *(const LAS f32x4*)&sq[tt * 128 + dk], k4 = *(const LAS f32x4*)&sk[tt * 128 + dk];
#pragma unroll
                for (int j = 0; j < 4; ++j) {
                    const float sdec = S[dk + j] * d4[j];
                    const float sn = sdec + k4[j] * v;
                    acc += q4[j] * (dir ? sdec : sn);
                    S[dk + j] = sn;
                }
            }
            O[(size_t)tok * 512 + h * 128 + tid] = acc;
        }
        __syncthreads();
    }
}
__device__ __forceinline__ void phase_gla_combine(const Args& a, const float* OF, const float* OB) {
    const bf16_t* U = (const bf16_t*)(a.ws + WS_U); bf16_t* ymix = (bf16_t*)((unsigned char*)a.out + 96 * MiB);
    const int lane = tid_now() & 63;
    for (int w = blockIdx.x * 8 + (tid_now() >> 6); w < NTOK * 4; w += gridDim.x * 8) {
        const int tok = w >> 2, h = w & 3;
        const size_t o = (size_t)tok * 512 + h * 128 + lane * 2;
        const float a0 = OF[o] + OB[o], a1 = OF[o + 1] + OB[o + 1];
        const float ss = wave_sum(a0 * a0 + a1 * a1);
        const float rstd = rsqrtf(ss * (1.0f / 128.0f) + NORM_EPS);
        const bf16_t* z = U + (size_t)tok * UP + C_ZA + h * 128 + lane * 2;
        const float y0 = a0 * rstd * a.ng[lane * 2] * silu(bf2f(z[0])), y1 = a1 * rstd * a.ng[lane * 2 + 1] * silu(bf2f(z[1]));
        *(unsigned*)(ymix + (size_t)tok * DM + h * 128 + lane * 2) = pk2(y0, y1);
    }
}
__device__ __forceinline__ int t5_bucket(int rel) {
    const int n = rel < 0 ? -rel : rel;
    int b = n < 8 ? n : (n < 12 ? 8 : (n < 16 ? 9 : (n < 23 ? 10 : (n < 32 ? 11 : (n < 46 ? 12 : (n < 64 ? 13 : (n < 91 ? 14 : 15)))))));
    return b + (rel > 0 ? 16 : 0);
}
__device__ __forceinline__ void phase_swa_naive(const Args& a, LAS unsigned char* lds) {
    const bf16_t* U = (const bf16_t*)(a.ws + WS_U); bf16_t* ymix = (bf16_t*)((unsigned char*)a.out + 96 * MiB);
    const int wv = tid_now() >> 6, lane = tid_now() & 63;
    LAS float* sq = (LAS float*)(lds + 65536) + wv * 64; LAS float* sp = (LAS float*)(lds + 65536 + 2048) + wv * 320;
    for (int w = blockIdx.x * 8 + wv; w < NTOK * 8; w += gridDim.x * 8) {
        const int tok = w >> 3, hq = w & 7, kv = hq >> 2;
        int s0, L; seq_of(tok, s0, L); const int i = tok - s0;
        sq[lane] = bf2f(U[(size_t)tok * UP + C_QB + hq * 64 + lane]);
        const float snk = a.sink[hq];
        float sc[5]; float mx = snk;
#pragma unroll
        for (int c = 0; c < 5; ++c) {
            const int jj = c * 64 + lane, j = i - 128 + jj; const bool valid = jj <= 256 && j >= 0 && j < L;
            float d = -INFINITY;
            if (valid) {
                const bf16_t* kr = U + (size_t)(s0 + j) * UP + C_KB + kv * 64; d = 0.f;
#pragma unroll
                for (int e = 0; e < 64; e += 8) { const u32x4 kk = *(const u32x4*)(kr + e);
                    d += sq[e] * __uint_as_float(kk.x << 16) + sq[e + 1] * __uint_as_float(kk.x & 0xffff0000u) + sq[e + 2] * __uint_as_float(kk.y << 16) + sq[e + 3] * __uint_as_float(kk.y & 0xffff0000u)
                       + sq[e + 4] * __uint_as_float(kk.z << 16) + sq[e + 5] * __uint_as_float(kk.z & 0xffff0000u) + sq[e + 6] * __uint_as_float(kk.w << 16) + sq[e + 7] * __uint_as_float(kk.w & 0xffff0000u); }
                d += a.relb[t5_bucket(j - i) * 8 + hq];
            }
            sc[c] = d; mx = fmaxf(mx, d);
        }
        mx = wave_max(mx);
        float den = 0.f;
#pragma unroll
        for (int c = 0; c < 5; ++c) { sc[c] = sc[c] == -INFINITY ? 0.f : __expf(sc[c] - mx); den += sc[c]; }
        den = wave_sum(den) + __expf(snk - mx);
        const float inv = 1.0f / den;
#pragma unroll
        for (int c = 0; c < 5; ++c) sp[c * 64 + lane] = sc[c] * inv;
        float o = 0.f;
        for (int jj = 0; jj <= 256; ++jj) { const int j = i - 128 + jj; if (j >= 0 && j < L) o += sp[jj] * bf2f(U[(size_t)(s0 + j) * UP + C_VB + kv * 64 + lane]); }
        const float z = bf2f(U[(size_t)tok * UP + C_ZB + hq * 64 + lane]);
        ymix[(size_t)tok * DM + 512 + hq * 64 + lane] = f2bf(o * silu(z));
    }
}
template <int FINAL>
__device__ __forceinline__ void phase_ln(float* Y, const f32x2* stat, f32x2* mr, const float* lg, const float* lb, bf16_t* xb) {
    const int lane = tid_now() & 63;
    for (int row = blockIdx.x * 8 + (tid_now() >> 6); row < NTOK; row += gridDim.x * 8) {
        f32x2 p = lane < 16 ? stat[(size_t)row * 16 + lane] : (f32x2){0.f, 0.f};
        const float s = wave_sum(p.x), q = wave_sum(p.y);
        const float mean = s * (1.0f / DM), var = q * (1.0f / DM) - mean * mean, rstd = rsqrtf(fmaxf(var, 0.f) + LN_EPS);
        if (!FINAL && lane == 0) mr[row] = (f32x2){mean, rstd};
#pragma unroll
        for (int j = 0; j < 4; ++j) {
            const int c = j * 256 + lane * 4;
            const f32x4 y = *(const f32x4*)(Y + (size_t)row * DM + c), g = *(const f32x4*)(lg + c), b = *(const f32x4*)(lb + c);
            const f32x4 o = (y - mean) * rstd * g + b;
            if (FINAL) *(f32x4*)(Y + (size_t)row * DM + c) = o;
            else { u32x2 w; w.x = pk2(o[0], o[1]); w.y = pk2(o[2], o[3]); *(u32x2*)(xb + (size_t)row * DM + c) = w; }
        }
    }
}
__device__ __forceinline__ void phase_convgate(const bf16_t* P, const bf16_t* S, const float* cw, bf16_t* G) {
    const size_t n8 = (size_t)NTOK * DM / 8;
    for (size_t i = (size_t)blockIdx.x * NTHR + tid_now(); i < n8; i += (size_t)gridDim.x * NTHR) {
        const int row = (int)(i >> 7), c = (int)(i & 127) * 8; int s0, L; seq_of(row, s0, L);
        const bool hasl = row > s0, hasr = row < s0 + L - 1;
        const u32x4 pm = *(const u32x4*)(P + (size_t)row * DM + c), sv = *(const u32x4*)(S + (size_t)row * DM + c);
        u32x4 pl = (u32x4){0, 0, 0, 0}, pr = (u32x4){0, 0, 0, 0};
        if (hasl) pl = *(const u32x4*)(P + (size_t)(row - 1) * DM + c);
        if (hasr) pr = *(const u32x4*)(P + (size_t)(row + 1) * DM + c);
        float o[8];
#pragma unroll
        for (int j = 0; j < 4; ++j) {
            const unsigned l = pl[j], m = pm[j], r = pr[j], sw = sv[j];
            const int cc = c + 2 * j;
            o[2 * j] = __uint_as_float(sw << 16) * (cw[cc] * __uint_as_float(l << 16) + cw[1024 + cc] * __uint_as_float(m << 16) + cw[2048 + cc] * __uint_as_float(r << 16));
            o[2 * j + 1] = __uint_as_float(sw & 0xffff0000u) * (cw[cc + 1] * __uint_as_float(l & 0xffff0000u) + cw[1024 + cc + 1] * __uint_as_float(m & 0xffff0000u) + cw[2048 + cc + 1] * __uint_as_float(r & 0xffff0000u));
        }
        u32x4 w; w.x = pk2(o[0], o[1]); w.y = pk2(o[2], o[3]); w.z = pk2(o[4], o[5]); w.w = pk2(o[6], o[7]);
        *(u32x4*)(G + (size_t)row * DM + c) = w;
    }
}

typedef short s16x4 __attribute__((ext_vector_type(4)));
constexpr int GL_QT = 0, GL_KT = 16384, GL_VT = 32768, GL_PT = 49152, GL_B = 57344, GL_GD = 90112, GL_TOT = 94208, GL_EBL = 96256  , GL_SSW = 97280, GL_RSTD = 99328;
constexpr int NSEG = NTOK / 256;
__device__ __forceinline__ unsigned offb(unsigned row, unsigned ch) { return 256u * row + 16u * (ch ^ (((row & 3) << 2) | ((row >> 2) & 3))); }
__device__ __forceinline__ unsigned offp(unsigned row, unsigned ch) { return 128u * row + 16u * (ch ^ (row & 7)); }
__device__ __forceinline__ unsigned rr16(unsigned lane, unsigned rb, unsigned s) { return offb((lane & 15) + 16 * rb, 4 * s + (lane >> 4)); }
__device__ __forceinline__ unsigned tr16(unsigned lane, unsigned c, unsigned ks, unsigned t) {
    const unsigned g = lane >> 4, q = (lane & 15) >> 2, p = lane & 3;
    return offb(32 * ks + 8 * g + 4 * t + q, 2 * c + (p >> 1)) + 8 * (p & 1);
}
__device__ __forceinline__ bf16x8 tr_read8(unsigned a0, unsigned a1) {
    s16x4 r0, r1;
    asm volatile("ds_read_b64_tr_b16 %0, %2\n\tds_read_b64_tr_b16 %1, %3\n\ts_waitcnt lgkmcnt(0)" : "=&v"(r0), "=&v"(r1) : "v"(a0), "v"(a1) : "memory");
    return __builtin_shufflevector(r0, r1, 0, 1, 2, 3, 4, 5, 6, 7);
}
__device__ __forceinline__ void unpack8(const u32x4 w, float (&f)[8]) {
#pragma unroll
    for (int j = 0; j < 4; ++j) { f[2 * j] = __uint_as_float(w[j] << 16); f[2 * j + 1] = __uint_as_float(w[j] & 0xffff0000u); }
}
#define MFMA16(a, b, c) __builtin_amdgcn_mfma_f32_16x16x32_bf16((a), (b), (c), 0, 0, 0)

struct GlaPre { u32x4 gd[4]; u32x4 q[2], k[2], v[2]; u32x4 wf; f32x4 wb; };
template <int MODE>
__device__ __forceinline__ void gla_prefetch(const Args& a, GlaPre& pre, int tid, int tb, int h, int dir, int stidx) {
    const bf16_t* U = (const bf16_t*)(a.ws + WS_U);
    const int lane = tid & 63, n = lane & 15, g = lane >> 4, w = tid >> 6;
#pragma unroll
    for (int it = 0; it < 4; ++it) { const int row = 16 * it + n, tok = dir ? tb + 63 - row : tb + row; pre.gd[it] = *(const u32x4*)(U + (size_t)tok * UP + C_GD + dir * 16 + 8 * (g & 1)); }
#pragma unroll
    for (int i = 0; i < 2; ++i) {
        const int idx = tid + 512 * i, row = idx >> 4, ch = idx & 15, tok = dir ? tb + 63 - row : tb + row;
        const bf16_t* ur = U + (size_t)tok * UP + h * 128 + ch * 8;
        pre.v[i] = *(const u32x4*)(ur + C_VA); pre.k[i] = *(const u32x4*)(ur + C_KA);
        if (MODE != 0) pre.q[i] = *(const u32x4*)(ur + C_QA);
    }
    pre.wf = ((const u32x4*)(a.ws + WS_GATE))[(dir * 4 + h) * 512 + tid];
    pre.wb = *(const f32x4*)((const float*)(a.ws + WS_GATE + 65536) + (dir * 4 + h) * 128 + 16 * w + 4 * g);
}
__device__ __forceinline__ bf16x8 tr_read8(LAS unsigned char* lds, unsigned a0, unsigned a1) {
    const s16x4 r0 = __builtin_amdgcn_ds_read_tr16_b64_v4i16((LAS s16x4*)(lds + a0)), r1 = __builtin_amdgcn_ds_read_tr16_b64_v4i16((LAS s16x4*)(lds + a1));
    return __builtin_shufflevector(r0, r1, 0, 1, 2, 3, 4, 5, 6, 7);
}
template <int CTRL> __device__ __forceinline__ float dpp_f(float x) { return __int_as_float(__builtin_amdgcn_update_dpp(0, __float_as_int(x), CTRL, 0xf, 0xf, true)); }
constexpr int GL_BP = 132;
template <int MODE>
__device__ __forceinline__ void gla_chunk(const Args& a, LAS unsigned char* lds, const int tb, const int h, const int dir,
                                          f32x4 (&Sacc)[8], f32x4& lam, u32x4* stash, GlaPre& pre, const int ntb, const int nh, const int ndir, const bool first, const int par) {
    const bf16_t* U = (const bf16_t*)(a.ws + WS_U);
    int tid = tid_now(); asm volatile("" : "+v"(tid));
    const int lane = tid & 63, w = __builtin_amdgcn_readfirstlane(tid >> 6), n = lane & 15, g = lane >> 4;
    const unsigned fn = ((n & 3) << 2) | ((n >> 2) & 3);
    const unsigned base_rr = 256u * n + 16u * (g ^ fn);
    const unsigned base_c = 256u * n + 16u * ((g >> 1) ^ fn) + 8u * (g & 1);
    const unsigned base_p = 128u * n + 16u * (g ^ (n & 7));
    const unsigned trb0 = tr16(lane, 0, 0, 0), trb1 = tr16(lane, 0, 0, 1);
    GlaPre& cur = pre;
    const bf16x8 wfrag = __builtin_bit_cast(bf16x8, cur.wf); const f32x4 wbias = cur.wb;
    int prow[2], pch[2], ptok[2];
#pragma unroll
    for (int i = 0; i < 2; ++i) { const int idx = tid + 512 * i; prow[i] = idx >> 4; pch[i] = idx & 15; ptok[i] = dir ? tb + 63 - prow[i] : tb + prow[i]; }
    u32x4 st0, st1, zraw[2];
    {
        LAS float* B = (LAS float*)(lds + GL_B);
        f32x4 carry = (f32x4){0.f, 0.f, 0.f, 0.f};
#pragma unroll
        for (int tt = 0; tt < 4; ++tt) {
            const f32x4 x = MFMA16(wfrag, __builtin_bit_cast(bf16x8, cur.gd[tt]), wbias);
            f32x4 pv, tv;
#pragma unroll
            for (int r = 0; r < 4; ++r) {
                const float xv = x[r]; const float v = (fminf(xv, 0.f) - 0.6931471805599453f * flog2(1.0f + fexp(-fabsf(xv)))) * (1.0f / 16.0f);
                float ps = v; ps += dpp_f<0x111>(ps); ps += dpp_f<0x112>(ps); ps += dpp_f<0x114>(ps); ps += dpp_f<0x118>(ps);
                float ts = v; ts += dpp_f<0x128>(ts); ts += dpp_f<0x124>(ts); ts += dpp_f<0x122>(ts); ts += dpp_f<0x121>(ts);
                pv[r] = ps; tv[r] = ts;
            }
            *(LAS f32x4*)(B + (16 * tt + n) * GL_BP + 16 * w + 4 * g) = carry + pv;
            carry += tv;
        }
        if (n == 0) *(LAS f32x4*)(lds + GL_EBL + par * 512 + (16 * w + 4 * g) * 4) = (f32x4){fexp(carry[0]), fexp(carry[1]), fexp(carry[2]), fexp(carry[3])};
        lam += carry;
    }
    __syncthreads();
#pragma unroll
    for (int i = 0; i < 2; ++i) {
        const LAS f32x4* bp = (const LAS f32x4*)(lds + GL_B + (prow[i] * GL_BP + pch[i] * 8) * 4);
        const f32x4 b0 = bp[0], b1 = bp[1];
        float e[8], kf[8];
#pragma unroll
        for (int j = 0; j < 4; ++j) { e[j] = fexp(b0[j]); e[4 + j] = fexp(b1[j]); }
        unpack8(cur.k[i], kf);
        u32x4 kw;
#pragma unroll
        for (int j = 0; j < 4; ++j) kw[j] = pk2(kf[2 * j] * __builtin_amdgcn_rcpf(e[2 * j]), kf[2 * j + 1] * __builtin_amdgcn_rcpf(e[2 * j + 1]));
        *(LAS u32x4*)(lds + GL_KT + offb(prow[i], pch[i])) = kw;
        *(LAS u32x4*)(lds + GL_VT + offb(prow[i], pch[i])) = cur.v[i];
        if (MODE != 0) {
            float qf[8]; unpack8(cur.q[i], qf);
            u32x4 qw;
#pragma unroll
            for (int j = 0; j < 4; ++j) qw[j] = pk2(qf[2 * j] * e[2 * j], qf[2 * j + 1] * e[2 * j + 1]);
            *(LAS u32x4*)(lds + GL_QT + offb(prow[i], pch[i])) = qw;
        }
    }
    __syncthreads();
    gla_prefetch<MODE>(a, pre, tid, ntb, nh, ndir, -1);
    f32x4 Oacc[4];
    if (MODE != 0) {
        const int it = w >> 1;
#pragma unroll
        for (int jj = 0; jj < 2; ++jj) {
            const int jt = 2 * (w & 1) + jj;
            f32x4 pacc = (f32x4){0.f, 0.f, 0.f, 0.f};
            if (jt <= it) {
#pragma unroll
                for (int s = 0; s < 4; ++s) {
                    const bf16x8 qa = *(const LAS bf16x8*)(lds + GL_QT + (base_rr ^ (64u * s)) + 4096u * it);
                    const bf16x8 kb = *(const LAS bf16x8*)(lds + GL_KT + (base_rr ^ (64u * s)) + 4096u * jt); pacc = MFMA16(qa, kb, pacc); }
            }
            const int j = 16 * jt + n;
#pragma unroll
            for (int r = 0; r < 4; ++r) {
                const int i = 16 * it + 4 * g + r;
                const bool keep = (MODE == 1) ? (j <= i) : (j < i);
                *(LAS bf16_t*)(lds + GL_PT + offp(i, j >> 3) + 2 * (j & 7)) = keep ? f2bf(pacc[r]) : (bf16_t)0;
            }
            __builtin_amdgcn_sched_barrier(0);
        }
        if (first) {
#pragma unroll
            for (int kt = 0; kt < 8; ++kt) { const unsigned r0 = __float_as_uint(Sacc[kt][0]), r1 = __float_as_uint(Sacc[kt][1]);
                Sacc[kt] = (f32x4){__uint_as_float(r0 << 16), __uint_as_float(r0 & 0xffff0000u), __uint_as_float(r1 << 16), __uint_as_float(r1 & 0xffff0000u)}; }
        }
#pragma unroll
        for (int i2 = 0; i2 < 4; ++i2) Oacc[i2] = (f32x4){0.f, 0.f, 0.f, 0.f};
#pragma unroll
        for (int ks = 0; ks < 4; ++ks) {
            u32x4 pw; pw.x = pk2(Sacc[2 * ks][0], Sacc[2 * ks][1]); pw.y = pk2(Sacc[2 * ks][2], Sacc[2 * ks][3]); pw.z = pk2(Sacc[2 * ks + 1][0], Sacc[2 * ks + 1][1]); pw.w = pk2(Sacc[2 * ks + 1][2], Sacc[2 * ks + 1][3]);
            const bf16x8 sb = __builtin_bit_cast(bf16x8, pw);
            const unsigned alo = base_c ^ (64u * ks);
#pragma unroll
            for (int i2 = 0; i2 < 4; ++i2) {
                const u32x2 lo = *(const LAS u32x2*)(lds + GL_QT + 4096 * i2 + alo);
                const u32x2 hi = *(const LAS u32x2*)(lds + GL_QT + 4096 * i2 + (alo ^ 32u));
                u32x4 aw; aw.x = lo.x; aw.y = lo.y; aw.z = hi.x; aw.w = hi.y;
                Oacc[i2] = MFMA16(__builtin_bit_cast(bf16x8, aw), sb, Oacc[i2]);
            }
            __builtin_amdgcn_sched_barrier(0);
        }
        __syncthreads();
        if (MODE == 2) {
            st0 = stash[tid * 2]; st1 = stash[tid * 2 + 1];
#pragma unroll
            for (int i = 0; i < 2; ++i) zraw[i] = *(const u32x4*)(U + (size_t)ptok[i] * UP + C_ZA + h * 128 + pch[i] * 8);
        }
    }
    bf16x8 vf[2];
#pragma unroll
    for (int ks = 0; ks < 2; ++ks) vf[ks] = tr_read8(lds, GL_VT + 8192u * ks + (trb0 ^ (32u * w)), GL_VT + 8192u * ks + (trb1 ^ (32u * w)));
    if (MODE != 0) {
#pragma unroll
        for (int i2 = 0; i2 < 4; ++i2)
#pragma unroll
            for (int ks = 0; ks < 2; ++ks) {
                if (ks <= (i2 >> 1)) { const bf16x8 pa = *(const LAS bf16x8*)(lds + GL_PT + 2048 * i2 + (base_p ^ (64u * ks))); Oacc[i2] = MFMA16(pa, vf[ks], Oacc[i2]); }
            }
    }
#pragma unroll
    for (int kt = 0; kt < 8; ++kt) {
#pragma unroll
        for (int ks = 0; ks < 2; ++ks) { const bf16x8 ka = tr_read8(lds, GL_KT + 8192u * ks + (trb0 ^ (32u * kt)), GL_KT + 8192u * ks + (trb1 ^ (32u * kt))); Sacc[kt] = MFMA16(ka, vf[ks], Sacc[kt]); }
        const f32x4 eb = *(const LAS f32x4*)(lds + GL_EBL + par * 512 + (16 * kt + 4 * g) * 4);
        Sacc[kt] = Sacc[kt] * eb;
        if (kt & 1) __builtin_amdgcn_sched_barrier(0);
    }
    if (MODE == 1) {
        u32x4 s0, s1;
        s0.x = pk2(Oacc[3][3], Oacc[3][2]); s0.y = pk2(Oacc[3][1], Oacc[3][0]); s0.z = pk2(Oacc[2][3], Oacc[2][2]); s0.w = pk2(Oacc[2][1], Oacc[2][0]);
        s1.x = pk2(Oacc[1][3], Oacc[1][2]); s1.y = pk2(Oacc[1][1], Oacc[1][0]); s1.z = pk2(Oacc[0][3], Oacc[0][2]); s1.w = pk2(Oacc[0][1], Oacc[0][0]);
        const int tidm = tid ^ 48;
        stash[tidm * 2] = s0; stash[tidm * 2 + 1] = s1;
    }
    if (MODE == 2) {
        float fo[16]; { float t8[8]; unpack8(st0, t8);
#pragma unroll
            for (int j = 0; j < 8; ++j) fo[j] = t8[j]; unpack8(st1, t8);
#pragma unroll
            for (int j = 0; j < 8; ++j) fo[8 + j] = t8[j]; }
        LAS float* ssw = (LAS float*)(lds + GL_SSW);
#pragma unroll
        for (int i2 = 0; i2 < 4; ++i2)
#pragma unroll
            for (int r = 0; r < 4; ++r) {
                const float o = Oacc[i2][r] + fo[4 * i2 + r]; Oacc[i2][r] = o;
                float v = o * o; v += dpp_f<0x128>(v); v += dpp_f<0x124>(v); v += dpp_f<0x122>(v); v += dpp_f<0x121>(v);
                if (n == 0) ssw[w * 64 + 16 * i2 + 4 * g + r] = v;
            }
        __syncthreads();
        if (tid < 64) { float s = 0.f;
#pragma unroll
            for (int ww = 0; ww < 8; ++ww) s += ssw[ww * 64 + tid];
            ((LAS float*)(lds + GL_RSTD))[tid] = rsqrtf(s * (1.0f / 128.0f) + NORM_EPS); }
        __syncthreads();
        const float gn = a.ng[16 * w + n];
#pragma unroll
        for (int i2 = 0; i2 < 4; ++i2) {
            const f32x4 rs = *(const LAS f32x4*)(lds + GL_RSTD + (16 * i2 + 4 * g) * 4);
#pragma unroll
            for (int r = 0; r < 4; ++r) *(LAS bf16_t*)(lds + GL_QT + (16 * i2 + 4 * g + r) * 256 + (16 * w + n) * 2) = f2bf(Oacc[i2][r] * rs[r] * gn);
        }
        __syncthreads();
        bf16_t* ymix = (bf16_t*)((unsigned char*)a.out + 96 * MiB);
#pragma unroll
        for (int i = 0; i < 2; ++i) {
            const u32x4 ov = *(const LAS u32x4*)(lds + GL_QT + prow[i] * 256 + pch[i] * 16);
            float of[8], zf[8]; unpack8(ov, of); unpack8(zraw[i], zf);
            u32x4 yw;
#pragma unroll
            for (int j = 0; j < 4; ++j) yw[j] = pk2(of[2 * j] * silu(zf[2 * j]), of[2 * j + 1] * silu(zf[2 * j + 1]));
            *(u32x4*)(ymix + (size_t)ptok[i] * DM + h * 128 + pch[i] * 8) = yw;
        }
    }
}
__device__ __forceinline__ void build_gate_tables(const Args& a) {
    for (int e = blockIdx.x * NTHR + tid_now(); e < 8 * 512; e += gridDim.x * NTHR) {
        const int dh = e >> 9, tid = e & 511, dir = dh >> 2, h = dh & 3, lane = tid & 63, w = tid >> 6, n = lane & 15, g = lane >> 4, col = h * 128 + 16 * w + n;
        const float* wup = dir ? a.wub : a.wuf; const float* bias = dir ? a.bbw : a.bfw;
        u32x4 pw;
#pragma unroll
        for (int j = 0; j < 4; ++j) {
            const float v0 = wup[(8 * (g & 1) + 2 * j) * 512 + col], v1 = wup[(8 * (g & 1) + 2 * j + 1) * 512 + col];
            const float h0 = bf2f(f2bf(v0)), h1 = bf2f(f2bf(v1));
            pw[j] = g < 2 ? pk2(v0, v1) : pk2(v0 - h0, v1 - h1);
        }
        ((u32x4*)(a.ws + WS_GATE))[e] = pw;
        if (g == 0) ((float*)(a.ws + WS_GATE + 65536))[dh * 128 + 16 * w + n] = bias[col];
    }
}
__device__ __forceinline__ void phase_gla_pass1(const Args& a, LAS unsigned char* lds) {
    const int tid = tid_now(), w = tid >> 6, lane = tid & 63;
    unsigned char* ST = a.ws + WS_ST;
    GlaPre pre; int par = 0;
    { const int item = blockIdx.x; if (item < NSEG * 8) { const int dir = item & 1; gla_prefetch<0>(a, pre, tid, (item >> 3) * 256 + (dir ? 3 : 0) * 64, (item >> 1) & 3, dir, -1); } }
    for (int item = blockIdx.x; item < NSEG * 8; item += gridDim.x) {
        const int dir = item & 1, h = (item >> 1) & 3, seg = item >> 3;
        const int nitem = item + gridDim.x < NSEG * 8 ? item + gridDim.x : item;
        f32x4 Sacc[8];
#pragma unroll
        for (int kt = 0; kt < 8; ++kt) Sacc[kt] = (f32x4){0.f, 0.f, 0.f, 0.f};
        f32x4 lam = (f32x4){0.f, 0.f, 0.f, 0.f};
        for (int cc = 0; cc < 4; ++cc) {
            const int c = dir ? 3 - cc : cc;
            int ntb, nh, ndir;
            if (cc < 3) { ntb = seg * 256 + (dir ? c - 1 : c + 1) * 64; nh = h; ndir = dir; }
            else { ndir = nitem & 1; nh = (nitem >> 1) & 3; ntb = (nitem >> 3) * 256 + (ndir ? 3 : 0) * 64; }
            gla_chunk<0>(a, lds, seg * 256 + c * 64, h, dir, Sacc, lam, nullptr, pre, ntb, nh, ndir, false, par); par ^= 1;
        }
        u32x2* dst = (u32x2*)(ST + (size_t)item * 32768) + (size_t)w * 8 * 64 + lane;
#pragma unroll
        for (int kt = 0; kt < 8; ++kt) { u32x2 v; v.x = pk2(Sacc[kt][0], Sacc[kt][1]); v.y = pk2(Sacc[kt][2], Sacc[kt][3]); dst[kt * 64] = v; }
        if ((lane & 15) == 0) *(f32x4*)((float*)(a.ws + WS_DEC) + (size_t)item * 128 + 16 * w + 4 * (lane >> 4)) = lam;
    }
    __syncthreads();
}
__device__ __forceinline__ void phase_gla_pass2(const Args& a) {
    unsigned char* ST = a.ws + WS_ST; const float* DEC = (const float*)(a.ws + WS_DEC);
    for (int gidx = blockIdx.x * NTHR + tid_now(); gidx < 48 * 4096; gidx += gridDim.x * NTHR) {
        const int chain = gidx >> 12, quad = gidx & 4095, dir = chain & 1, h = (chain >> 1) & 3, s = chain >> 3;
        const int nseg = s < 2 ? LP / 256 : LS / 256, seg0 = s < 2 ? s * (LP / 256) : 2 * (LP / 256) + (s - 2) * (LS / 256);
        const int kt = (quad >> 6) & 7, lane = quad & 63, dk0 = 16 * kt + 4 * (lane >> 4);
        f32x4 S = (f32x4){0.f, 0.f, 0.f, 0.f};
        for (int i0 = 0; i0 < nseg; i0 += 8) {
            u32x2 t[8]; f32x4 lm[8];
#pragma unroll
            for (int j = 0; j < 8; ++j) { const int seg = dir ? seg0 + nseg - 1 - (i0 + j) : seg0 + i0 + j; const size_t idx = (size_t)((seg * 4 + h) * 2 + dir);
                t[j] = ((const u32x2*)(ST + idx * 32768))[quad]; lm[j] = *(const f32x4*)(DEC + idx * 128 + dk0); }
#pragma unroll
            for (int j = 0; j < 8; ++j) { const int seg = dir ? seg0 + nseg - 1 - (i0 + j) : seg0 + i0 + j; const size_t idx = (size_t)((seg * 4 + h) * 2 + dir);
                u32x2 o; o.x = pk2(S[0], S[1]); o.y = pk2(S[2], S[3]); ((u32x2*)(ST + idx * 32768))[quad] = o;
                const f32x4 tv = (f32x4){__uint_as_float(t[j].x << 16), __uint_as_float(t[j].x & 0xffff0000u), __uint_as_float(t[j].y << 16), __uint_as_float(t[j].y & 0xffff0000u)};
                S = (f32x4){fexp(lm[j][0]), fexp(lm[j][1]), fexp(lm[j][2]), fexp(lm[j][3])} * S + tv; }
        }
    }
}
__device__ __forceinline__ void phase_gla_pass3(const Args& a, LAS unsigned char* lds) {
    const int tid = tid_now(), w = tid >> 6, lane = tid & 63;
    GlaPre pre; int par = 0;
    if (blockIdx.x < NSEG * 4) gla_prefetch<1>(a, pre, tid, (blockIdx.x >> 2) * 256, blockIdx.x & 3, 0, -1);
    for (int item = blockIdx.x; item < NSEG * 4; item += gridDim.x) {
        const int h = item & 3, seg = item >> 2;
        const int nitem = item + gridDim.x < NSEG * 4 ? item + gridDim.x : item;
        u32x4* stash = (u32x4*)a.out + (size_t)item * 4 * 1024;
#pragma unroll 1
        for (int dir = 0; dir < 2; ++dir) {
            f32x4 Sacc[8];
            const u32x2* src = (const u32x2*)(a.ws + WS_ST + (size_t)((seg * 4 + h) * 2 + dir) * 32768) + (size_t)w * 8 * 64 + lane;
#pragma unroll
            for (int kt = 0; kt < 8; ++kt) { const u32x2 v = src[kt * 64]; Sacc[kt] = (f32x4){__uint_as_float(v.x), __uint_as_float(v.y), 0.f, 0.f}; }
            f32x4 lam = (f32x4){0.f, 0.f, 0.f, 0.f};
            if (dir == 0) {
                for (int c = 0; c < 4; ++c) { const int ntb = seg * 256 + (c < 3 ? c + 1 : 3) * 64, ndir = c < 3 ? 0 : 1;
                    gla_chunk<1>(a, lds, seg * 256 + c * 64, h, 0, Sacc, lam, stash + c * 1024, pre, ntb, h, ndir, c == 0, par); par ^= 1; }
            } else {
                for (int c = 3; c >= 0; --c) { const int ntb = c > 0 ? seg * 256 + (c - 1) * 64 : (nitem >> 2) * 256, nh = c > 0 ? h : (nitem & 3), ndir = c > 0 ? 1 : 0;
                    gla_chunk<2>(a, lds, seg * 256 + c * 64, h, 1, Sacc, lam, stash + c * 1024, pre, ntb, nh, ndir, c == 3, par); par ^= 1; }
            }
        }
    }
    __syncthreads();
}
typedef float f32x16 __attribute__((ext_vector_type(16)));
#define MFMA32(a, b, c) __builtin_amdgcn_mfma_f32_32x32x16_bf16((a), (b), (c), 0, 0, 0)
constexpr int SW_K = 0, SW_V = 49152, SW_TB = 98304, SW_TBN = 336, SW_TBH = 4 * SW_TBN * 4;
constexpr float SW_NEG = -1e30f;
__device__ __forceinline__ unsigned offk(unsigned row, unsigned c8) { return 128u * row + 16u * (c8 ^ ((row >> 1) & 7)); }
__device__ __forceinline__ unsigned offv(unsigned row, unsigned c8) { return 128u * row + 16u * (c8 ^ (((row >> 1) & 1) << 2)); }
__device__ __forceinline__ void phase_swa(const Args& a, LAS unsigned char* lds) {
    const bf16_t* U = (const bf16_t*)(a.ws + WS_U); bf16_t* ymix = (bf16_t*)((unsigned char*)a.out + 96 * MiB);
    const int tid = tid_now(), lane = tid & 63, w = __builtin_amdgcn_readfirstlane(tid >> 6), r = lane & 31, hh = lane >> 5;
    const unsigned lb = (unsigned)(size_t)lds;
    for (int item = blockIdx.x; item < (NTOK / 128) * 2; item += gridDim.x) {
        const int kvh = item & 1, tok0 = (item >> 1) * 128; int s0, L; seq_of(tok0, s0, L);
        const bool first = tok0 == s0, last = tok0 + 128 == s0 + L;
        __syncthreads();
#pragma unroll
        for (int i = 0; i < 6; ++i) {
            const int idx = tid + 512 * i, row = idx >> 3, c8 = idx & 7, kpos = tok0 - 128 + row;
            u32x4 kk = (u32x4){0, 0, 0, 0}, vv = (u32x4){0, 0, 0, 0};
            if (kpos >= s0 && kpos < s0 + L) { const bf16_t* ur = U + (size_t)kpos * UP + kvh * 64 + c8 * 8; kk = *(const u32x4*)(ur + C_KB); vv = *(const u32x4*)(ur + C_VB); }
            *(LAS u32x4*)(lds + SW_K + offk(row, c8)) = kk; *(LAS u32x4*)(lds + SW_V + offv(row, c8)) = vv;
        }
        for (int e = tid; e < 4 * SW_TBN; e += NTHR) {
            const int hl = e / SW_TBN, idx = e - hl * SW_TBN, rel = idx - 160;
            const float val = (rel >= -128 && rel <= 128) ? a.relb[t5_bucket(rel) * 8 + kvh * 4 + hl] : SW_NEG;
            LAS float* tb = (LAS float*)(lds + SW_TB + hl * SW_TBH);
#pragma unroll
            for (int s = 0; s < 4; ++s) if (idx - s >= 0) tb[s * SW_TBN + idx - s] = val;
        }
        __syncthreads();
        const int hl = w >> 1, hq = kvh * 4 + hl;
        const float snk = a.sink[hq];
#pragma unroll 1
        for (int ss = 0; ss < 2; ++ss) {
            const int st = (w & 1) * 2 + ss, qtok = tok0 + 32 * st + r;
            bf16x8 Qf[4];
#pragma unroll
            for (int s = 0; s < 4; ++s) Qf[s] = *(const bf16x8*)(U + (size_t)qtok * UP + C_QB + hq * 64 + 16 * s + 8 * hh);
            float m = snk, l = hh == 0 ? 1.0f : 0.0f;
            f32x16 O[2];
#pragma unroll
            for (int i = 0; i < 16; ++i) { O[0][i] = 0.f; O[1][i] = 0.f; }
            const int sft = (-r) & 3;
            const unsigned tbase = SW_TB + hl * SW_TBH + sft * (SW_TBN * 4) + 4 * (32 + 4 * hh - r - sft);
            const unsigned kb0 = SW_K + 128u * r + 16u * (hh ^ ((r >> 1) & 7)) + 4096u * st;
            const int q4 = (lane & 15) >> 2, p4 = lane & 3, g1 = (lane >> 4) & 1, xq = (q4 >> 1) & 1;
            const unsigned vb0 = SW_V + 128u * (4 * hh + q4) + 16u * ((4 * xq) | (2 * g1) | (p4 >> 1)) + 8u * (p4 & 1) + 4096u * st;
#pragma unroll 1
            for (int grp = 0; grp < 3; ++grp) {
                f32x16 S[3];
#pragma unroll
                for (int k3 = 0; k3 < 3; ++k3) {
                    const int kk = 3 * grp + k3, blk = (st + kk) >> 2;
                    const bool valid = !((blk == 0 && first) || (blk == 2 && last));
                    if (valid) {
#pragma unroll
                        for (int i = 0; i < 16; ++i) S[k3][i] = 0.f;
#pragma unroll
                        for (int s = 0; s < 4; ++s) { const bf16x8 Kf = *(const LAS bf16x8*)(lds + (kb0 ^ (32u * s)) + 4096u * kk); S[k3] = MFMA32(Kf, Qf[s], S[k3]); }
#pragma unroll
                        for (int i4 = 0; i4 < 4; ++i4) { const f32x4 bv = *(const LAS f32x4*)(lds + tbase + 4 * (32 * kk + 8 * i4));
#pragma unroll
                            for (int j = 0; j < 4; ++j) S[k3][4 * i4 + j] += bv[j]; }
                    } else {
#pragma unroll
                        for (int i = 0; i < 16; ++i) S[k3][i] = SW_NEG;
                    }
                }
                float mx = SW_NEG;
#pragma unroll
                for (int k3 = 0; k3 < 3; ++k3)
#pragma unroll
                    for (int i = 0; i < 16; ++i) mx = fmaxf(mx, S[k3][i]);
                mx = fmaxf(mx, __shfl_xor(mx, 32));
                const float mn = fmaxf(m, mx), alpha = fexp(m - mn);
                m = mn; l *= alpha;
#pragma unroll
                for (int i = 0; i < 16; ++i) { O[0][i] *= alpha; O[1][i] *= alpha; }
                bf16x8 Pf[3][2];
#pragma unroll
                for (int k3 = 0; k3 < 3; ++k3) {
#pragma unroll
                    for (int i = 0; i < 16; ++i) { const float pv = fexp(S[k3][i] - m); S[k3][i] = pv; l += pv; }
#pragma unroll
                    for (int s2 = 0; s2 < 2; ++s2) {
                        u32x4 pw;
#pragma unroll
                        for (int j = 0; j < 4; ++j) pw[j] = pk2(S[k3][8 * s2 + 2 * j], S[k3][8 * s2 + 2 * j + 1]);
                        Pf[k3][s2] = __builtin_bit_cast(bf16x8, pw);
                    }
                }
#pragma unroll
                for (int k3 = 0; k3 < 3; ++k3) {
                    const int kk = 3 * grp + k3;
#pragma unroll
                    for (int s2 = 0; s2 < 2; ++s2)
#pragma unroll
                        for (int dt = 0; dt < 2; ++dt) {
                            const unsigned va = (vb0 ^ (64u * dt)) + 4096u * kk + 2048u * s2;
                            const bf16x8 Vf = tr_read8(lds, va, va + 1024u);
                            O[dt] = MFMA32(Vf, Pf[k3][s2], O[dt]);
                        }
                }
            }
            l += __shfl_xor(l, 32);
            const float inv = __builtin_amdgcn_rcpf(l);
#pragma unroll
            for (int dt = 0; dt < 2; ++dt)
#pragma unroll
                for (int i4 = 0; i4 < 4; ++i4) {
                    const int d0 = 32 * dt + 8 * i4 + 4 * hh;
                    const u32x2 zv = *(const u32x2*)(U + (size_t)qtok * UP + C_ZB + hq * 64 + d0);
                    const float z0 = __uint_as_float(zv.x << 16), z1 = __uint_as_float(zv.x & 0xffff0000u), z2 = __uint_as_float(zv.y << 16), z3 = __uint_as_float(zv.y & 0xffff0000u);
                    u32x2 yw; yw.x = pk2(O[dt][4 * i4] * inv * silu(z0), O[dt][4 * i4 + 1] * inv * silu(z1)); yw.y = pk2(O[dt][4 * i4 + 2] * inv * silu(z2), O[dt][4 * i4 + 3] * inv * silu(z3));
                    *(u32x2*)(ymix + (size_t)qtok * DM + 512 + hq * 64 + d0) = yw;
                }
        }
    }
}

__global__ void __launch_bounds__(NTHR, 2) mega(Args a) {
    LAS unsigned char* lds = (LAS unsigned char*)lds_raw;
    volatile LAS unsigned* MISC = (volatile LAS unsigned*)(lds + MISC_OFF);
    if (threadIdx.x < 32) MISC[threadIdx.x] = 0u;
    if ((threadIdx.x & 63) == 0) ((volatile LAS unsigned*)(lds + SLOT_OFF))[hw_slot()] = threadIdx.x >> 6;
    __syncthreads();
    unsigned char* ws = a.ws; float* out = a.out;
    XcdBarrier bar = xcd_barrier_post((unsigned*)(ws + WS_CTL) + 4096, MISC + 8);
    bf16_t* W1t = (bf16_t*)(ws + WS_W1T); bf16_t* W2t = (bf16_t*)(ws + WS_W2T); bf16_t* W3t = (bf16_t*)(ws + WS_W3T); bf16_t* W4t = (bf16_t*)(ws + WS_W4T);
    bf16_t* xb = (bf16_t*)(ws + WS_XB); bf16_t* ymix = (bf16_t*)((unsigned char*)out + 96 * MiB); bf16_t* G = xb; bf16_t* U = (bf16_t*)(ws + WS_U);
    bf16_t* x1b = (bf16_t*)(ws + WS_X1B); bf16_t* P = (bf16_t*)(ws + WS_P); bf16_t* Sg = (bf16_t*)(ws + WS_S);
    f32x2* stat1 = (f32x2*)(ws + WS_STAT1); f32x2* stat2 = (f32x2*)(ws + WS_STAT2); f32x2* mr1 = (f32x2*)(ws + WS_MR1);

    phase_convert(a, lds);
    xcd_barrier(bar);
    { pg8::Gemm g{xb, W1t, NTOK, UP, DM, 0}; pg8::StaticOrder S; S.init(NTOK, UP, gridDim.x, blockIdx.x); EpiU E{U}; pg8::gemm_phase<EpiU, pg8::StaticOrder>(lds, g, S, E); }
    xcd_barrier(bar);
    phase_gla_pass1(a, lds);
    xcd_barrier(bar);
    phase_gla_pass2(a);
    phase_swa(a, lds);
    xcd_barrier(bar);
    phase_gla_pass3(a, lds);
    xcd_barrier(bar);
    { pg8::Gemm g{ymix, W2t, NTOK, DM, DM, 0}; pg8::StaticOrder S; S.init(NTOK, DM, gridDim.x, blockIdx.x);
      EpiLN<0> E{ws, nullptr, a.lng, a.lnb}; pg8::gemm_phase<EpiLN<0>, pg8::StaticOrder>(lds, g, S, E); }
    xcd_barrier(bar);
    { pg8::Gemm g{x1b, W3t, NTOK, 4096, DM, 0}; pg8::StaticOrder S; S.init(NTOK, 4096, gridDim.x, blockIdx.x); EpiPS E{P, Sg}; pg8::gemm_phase<EpiPS, pg8::StaticOrder>(lds, g, S, E); }
    xcd_barrier(bar);
    phase_convgate(P, Sg, a.cw, G);
    xcd_barrier(bar);
    { pg8::Gemm g{G, W4t, NTOK, DM, DM, 0}; pg8::StaticOrder S; S.init(NTOK, DM, gridDim.x, blockIdx.x);
      EpiLN<1> E{ws, out, a.lng + DM, a.lnb + DM}; pg8::gemm_phase<EpiLN<1>, pg8::StaticOrder>(lds, g, S, E); }
}

extern "C" void kernel_launch(void* const* d_in, const int* in_sizes, int n_in, void* d_out, int out_size, void* d_ws, size_t ws_size, hipStream_t stream) {
    static int grid = 0;
    if (grid == 0) {
        if (n_in != 16 || out_size != NTOK * DM || ws_size < WS_END) { fprintf(stderr, "kernel_launch: unexpected shapes (n_in %d out %d ws %zu)\n", n_in, out_size, ws_size); grid = -1; return; }
        int dev = 0, cus = 0, per_cu = 0;
        if (hipGetDevice(&dev) != hipSuccess || hipDeviceGetAttribute(&cus, hipDeviceAttributeMultiprocessorCount, dev) != hipSuccess) { grid = -1; return; }
        if (hipFuncSetAttribute((const void*)mega, hipFuncAttributeMaxDynamicSharedMemorySize, LDS_BYTES) != hipSuccess) { fprintf(stderr, "kernel_launch: hipFuncSetAttribute failed\n"); grid = -1; return; }
        if (hipOccupancyMaxActiveBlocksPerMultiprocessor(&per_cu, (const void*)mega, NTHR, LDS_BYTES) != hipSuccess || per_cu < 1) { fprintf(stderr, "kernel_launch: occupancy query says %d blocks per CU\n", per_cu); (void)hipGetLastError(); grid = -1; return; }
        grid = cus;
    }
    if (grid < 0) return;
    (void)hipMemsetAsync((char*)d_ws + WS_CTL, 0, 262144, stream);
    Args a{};
    a.xp = (const float*)d_in[0]; a.xs = (const float*)d_in[1]; a.w_in_even = (const float*)d_in[2]; a.wuf = (const float*)d_in[3]; a.bfw = (const float*)d_in[4];
    a.wub = (const float*)d_in[5]; a.bbw = (const float*)d_in[6]; a.ng = (const float*)d_in[7]; a.sink = (const float*)d_in[8]; a.relb = (const float*)d_in[9];
    a.w_out_even = (const float*)d_in[10]; a.w_in_odd = (const float*)d_in[11]; a.cw = (const float*)d_in[12]; a.w_out_odd = (const float*)d_in[13];
    a.lng = (const float*)d_in[14]; a.lnb = (const float*)d_in[15]; a.out = (float*)d_out; a.ws = (unsigned char*)d_ws;
    hipLaunchKernelGGL(mega, dim3(grid), dim3(NTHR), LDS_BYTES, stream, a);
}
```

```cpp
#include <hip/hip_runtime.h>
#include <cstdio>

typedef unsigned short bf16_t;
typedef short bf16x8 __attribute__((ext_vector_type(8)));
typedef float f32x4 __attribute__((ext_vector_type(4)));
typedef float f32x2 __attribute__((ext_vector_type(2)));
typedef unsigned u32x4 __attribute__((ext_vector_type(4)));
typedef unsigned u32x2 __attribute__((ext_vector_type(2)));
#define LAS __attribute__((address_space(3)))
extern __shared__ __attribute__((aligned(16))) unsigned char lds_raw[];
constexpr int SLOT_OFF = 131072 + 512;
__device__ __forceinline__ unsigned hw_slot() { return (unsigned)__builtin_amdgcn_s_getreg((5 << 11) | 4) & 63u; }
__device__ __forceinline__ int tid_now() {
    const int wid = __builtin_amdgcn_readfirstlane((int)((volatile LAS unsigned*)((LAS unsigned char*)lds_raw + SLOT_OFF))[hw_slot()]);
    return wid * 64 + (int)__lane_id();
}

constexpr int DM = 1024, NTOK = 49152, NPROMPT = 32768, LP = 16384, LS = 4096;
constexpr int UP = 3584;
constexpr int C_QA = 0, C_KA = 512, C_VA = 1024, C_ZA = 1536, C_QB = 2048, C_KB = 2560, C_VB = 2688, C_ZB = 2816, C_GD = 3328;
constexpr int EVEN_IN = 3360, ODD_IN = 4096;
constexpr float DN_ALPHA = 1.41421356237309515f;
constexpr float LN_EPS = 1e-5f, NORM_EPS = 1e-6f;

constexpr size_t MiB = 1u << 20;
constexpr size_t WS_CTL = 0, WS_W1T = 1 * MiB, WS_W2T = 8 * MiB, WS_W3T = 10 * MiB, WS_W4T = 18 * MiB, WS_STAT1 = 20 * MiB, WS_MR1 = 26 * MiB, WS_DEC = 27 * MiB, WS_GATE = 27 * MiB + 768 * 1024,
                 WS_XB = 28 * MiB  , WS_U = 124 * MiB, WS_ST = 460 * MiB, WS_END = 508 * MiB;
constexpr size_t WS_X1B = WS_U, WS_P = WS_U + 96 * MiB, WS_S = WS_U + 192 * MiB, WS_STAT2 = WS_U + 288 * MiB, WS_PB = WS_U + 296 * MiB, WS_SB = WS_U + 304 * MiB;

__device__ __forceinline__ float bf2f(bf16_t b) { return __uint_as_float(((unsigned)b) << 16); }
typedef __bf16 nbf16x2 __attribute__((ext_vector_type(2)));
__device__ __forceinline__ bf16_t f2bf(float f) { return __builtin_bit_cast(bf16_t, (__bf16)f); }
__device__ __forceinline__ unsigned pk2(float lo, float hi) { return __builtin_bit_cast(unsigned, __builtin_convertvector((f32x2){lo, hi}, nbf16x2)); }
__device__ __forceinline__ float fexp2(float x) { return __builtin_amdgcn_exp2f(x); }
__device__ __forceinline__ float fexp(float x) { return __builtin_amdgcn_exp2f(x * 1.4426950408889634f); }
__device__ __forceinline__ float flog2(float x) { return __builtin_amdgcn_logf(x); }
__device__ __forceinline__ float silu(float x) { return x * __builtin_amdgcn_rcpf(1.0f + fexp(-x)); }
__device__ __forceinline__ float wave_sum(float v) {
#pragma unroll
    for (int o = 1; o < 64; o <<= 1) v += __shfl_xor(v, o);
    return v;
}
__device__ __forceinline__ float wave_max(float v) {
#pragma unroll
    for (int o = 1; o < 64; o <<= 1) v = fmaxf(v, __shfl_xor(v, o));
    return v;
}
__device__ __forceinline__ void seq_of(int row, int& s0, int& L) {
    if (row < NPROMPT) { L = LP; s0 = row & ~(LP - 1); } else { L = LS; s0 = NPROMPT + ((row - NPROMPT) & ~(LS - 1)); }
}

namespace pg8 {
constexpr int BM = 256, BK = 64, HALF = 128, HTB = HALF * BK * 2, STAGE_BYTES = 8 * HTB, NXCD = 8, WGM = 8;
__host__ __device__ __forceinline__ int lds_byte(int r, int c) { const int st = (r >> 4) * 2 + (c >> 5), rr = r & 15, cc = c & 31, ob = rr * 64 + cc * 2; return st * 1024 + (ob ^ (((ob >> 9) & 1) << 5)); }
__host__ __device__ __forceinline__ void stage_rc(int b, int& R, int& C) { const int st = b / 1024, sb = b % 1024, swz = sb ^ (((sb >> 9) & 1) << 5); R = (st >> 1) * 16 + swz / 64; C = (st & 1) * 32 + (swz % 64) / 2; }
__host__ __device__ __forceinline__ int perm32(int rho) { const int n = rho >> 4, i = rho & 15; return 8 * (i >> 2) + 4 * n + (i & 3); }
struct Unit { int pm, pn; };
struct Gemm { const bf16_t* A; const bf16_t* Bt; int M, N, K, pad; };
struct StaticOrder {
    int nM, nN, nwg, G, c;
    __host__ __device__ void init(int M, int N, int G_, int c_) { nM = M / BM; nN = N / BM; nwg = nM * nN; G = G_; c = c_; }
    __host__ __device__ bool next(int i, Unit& u) const {
        const long L = (long)i * G + c; if (L >= nwg) return false;
        int wgid = (int)L; { const int q = nwg / NXCD, r = nwg % NXCD, xcd = wgid % NXCD, off = wgid / NXCD; wgid = (xcd < r ? xcd * (q + 1) : r * (q + 1) + (xcd - r) * q) + off; }
        const int nig = WGM * nN, gid = wgid / nig, fm = gid * WGM, gsz = (nM - fm) < WGM ? (nM - fm) : WGM;
        u.pm = fm + ((wgid % nig) % gsz); u.pn = (wgid % nig) / gsz; return true;
    }
    __device__ __forceinline__ void a_ready(const Unit&) const {}
    __device__ __forceinline__ void done(const Unit&) const {}
};

template <class Epi, class Sched>
__device__ __forceinline__ void gemm_phase(LAS unsigned char* lds, const Gemm g, const Sched& S, const Epi& E) {
    int tid = tid_now(); asm volatile("" : "+v"(tid));
    const int wid = __builtin_amdgcn_readfirstlane(tid >> 6), lane = tid & 63, wr = wid >> 2, wc = wid & 3, fr = lane & 15, fq = lane >> 4;
    const int K = g.K, nt = K / BK;
    unsigned voffA[2], voffB[2];
#pragma unroll
    for (int i = 0; i < 2; ++i) { int R, C; stage_rc(tid * 16 + i * 8192, R, C); const int Rb = Epi::PERM ? ((R & ~31) + perm32(R & 31)) : R;
        voffA[i] = (unsigned)(R * K + C) * 2u; voffB[i] = (unsigned)(Rb * K + C) * 2u; }
    const size_t kstep = (size_t)(BK * 2);
    const size_t hstep = (size_t)HALF * K * 2;
    const size_t tstep = 2 * hstep;
    const unsigned ldsw = (unsigned)wid * 1024u;
    const int aoff = lds_byte(wr * 64 + fr, fq * 8), boff = lds_byte(wc * 32 + fr, fq * 8);
#define PG8_SA(b, h) (((b) * 2 + (h)) * HTB)
#define PG8_SB(b, h) ((4 + (b) * 2 + (h)) * HTB)
#define PG8_STAGE(bufoff, gbase, voff) do { _Pragma("unroll") for (int _i = 0; _i < 2; ++_i) \
        __builtin_amdgcn_global_load_lds((const unsigned*)((const char*)(gbase) + (voff)[_i]), (LAS unsigned*)(lds + (bufoff) + ldsw + _i * 8192), 16, 0, 0); } while (0)
#define PG8_LDA(dst, b, h) do { _Pragma("unroll") for (int m = 0; m < 4; ++m) _Pragma("unroll") for (int k = 0; k < 2; ++k) dst[m][k] = *(const LAS bf16x8*)(lds + PG8_SA(b, h) + aoff + m * 2048 + k * 1024); } while (0)
#define PG8_LDB(dst, b, h) do { _Pragma("unroll") for (int n = 0; n < 2; ++n) _Pragma("unroll") for (int k = 0; k < 2; ++k) dst[n][k] = *(const LAS bf16x8*)(lds + PG8_SB(b, h) + boff + n * 2048 + k * 1024); } while (0)
#define PG8_MMA(ai, bj, At, Bt) do { __builtin_amdgcn_s_setprio(1); _Pragma("unroll") for (int m = 0; m < 4; ++m) _Pragma("unroll") for (int n = 0; n < 2; ++n) _Pragma("unroll") for (int k = 0; k < 2; ++k) \
        acc[ai][bj][m][n] = __builtin_amdgcn_mfma_f32_16x16x32_bf16(Bt[n][k], At[m][k], acc[ai][bj][m][n], 0, 0, 0); __builtin_amdgcn_s_setprio(0); } while (0)
#define PG8_WAIT_V(n) asm volatile("s_waitcnt vmcnt(" #n ")" ::: "memory")
#define PG8_WAIT_L(n) asm volatile("s_waitcnt lgkmcnt(" #n ")" ::: "memory")
#define PG8_BAR __builtin_amdgcn_s_barrier()
#define PG8_SCHED __builtin_amdgcn_sched_barrier(0)
    Unit cur, nxt; int ui = 0;
    if (!S.next(0, cur)) return;
    f32x4 acc[2][2][4][2];
#pragma unroll
    for (int a = 0; a < 2; ++a)
#pragma unroll
        for (int b = 0; b < 2; ++b)
#pragma unroll
            for (int m = 0; m < 4; ++m)
#pragma unroll
                for (int n = 0; n < 2; ++n) acc[a][b][m][n] = (f32x4){0.f, 0.f, 0.f, 0.f};
    bf16x8 At[4][2], B0[2][2], B1[2][2];
    const char* cA = (const char*)g.A + (size_t)cur.pm * tstep; const char* cB = (const char*)g.Bt + (size_t)cur.pn * tstep;
    S.a_ready(cur);
    PG8_STAGE(PG8_SB(0, 0), cB, voffB); PG8_STAGE(PG8_SA(0, 0), cA, voffA); PG8_STAGE(PG8_SB(0, 1), cB + hstep, voffB); PG8_STAGE(PG8_SA(0, 1), cA + hstep, voffA);
    if (wr == 1) PG8_BAR;
    PG8_WAIT_V(4); PG8_BAR;
    PG8_STAGE(PG8_SB(1, 0), cB + kstep, voffB); PG8_STAGE(PG8_SA(1, 0), cA + kstep, voffA); PG8_STAGE(PG8_SB(1, 1), cB + hstep + kstep, voffB);
    PG8_WAIT_V(6); PG8_BAR;
    for (;;) {
        const bool has_next = S.next(ui + 1, nxt);
        const char* nA = has_next ? (const char*)g.A + (size_t)nxt.pm * tstep : cA; const char* nB = has_next ? (const char*)g.Bt + (size_t)nxt.pn * tstep : cB;
        for (int t = 0; t < nt; t += 2) {
            const bool last = (t == nt - 2);
            const char* a1 = cA + (size_t)(t + 1) * kstep;
            const char* a2 = last ? nA : cA + (size_t)(t + 2) * kstep; const char* b2 = last ? nB : cB + (size_t)(t + 2) * kstep;
            const char* a3 = a2 + kstep; const char* b3 = b2 + kstep;
            if (last && has_next) S.a_ready(nxt);
            PG8_LDB(B0, 0, 0); PG8_SCHED; PG8_LDA(At, 0, 0); PG8_STAGE(PG8_SA(1, 1), a1 + hstep, voffA);
            PG8_WAIT_L(8); PG8_BAR; PG8_WAIT_L(0); PG8_MMA(0, 0, At, B0); PG8_BAR; PG8_SCHED;
            PG8_LDB(B1, 0, 1); PG8_STAGE(PG8_SB(0, 0), b2, voffB);
            PG8_BAR; PG8_WAIT_L(0); PG8_MMA(0, 1, At, B1); PG8_BAR;
            PG8_LDA(At, 0, 1); PG8_STAGE(PG8_SA(0, 0), a2, voffA);
            PG8_BAR; PG8_WAIT_L(0); PG8_MMA(1, 0, At, B0); PG8_BAR; PG8_SCHED;
            PG8_STAGE(PG8_SB(0, 1), b2 + hstep, voffB);
            PG8_WAIT_V(6); PG8_BAR; PG8_MMA(1, 1, At, B1); PG8_BAR;
            PG8_LDB(B0, 1, 0); PG8_SCHED; PG8_LDA(At, 1, 0); PG8_STAGE(PG8_SA(0, 1), a2 + hstep, voffA);
            PG8_WAIT_L(8); PG8_BAR; PG8_WAIT_L(0); PG8_MMA(0, 0, At, B0); PG8_BAR; PG8_SCHED;
            PG8_LDB(B1, 1, 1); PG8_STAGE(PG8_SB(1, 0), b3, voffB);
            PG8_BAR; PG8_WAIT_L(0); PG8_MMA(0, 1, At, B1); PG8_BAR;
            PG8_LDA(At, 1, 1); PG8_STAGE(PG8_SA(1, 0), a3, voffA);
            PG8_BAR; PG8_WAIT_L(0); PG8_MMA(1, 0, At, B0); PG8_BAR; PG8_SCHED;
            PG8_STAGE(PG8_SB(1, 1), b3 + hstep, voffB);
            PG8_WAIT_V(6); PG8_BAR; PG8_MMA(1, 1, At, B1); PG8_BAR;
        }
        if constexpr (Epi::REALIGN) { if (wr == 0) PG8_BAR; }
        E(acc, cur, wr, wc, fr, fq); S.done(cur);
        if constexpr (Epi::REALIGN) { if (wr == 1) PG8_BAR; }
        if (!has_next) break;
#pragma unroll
        for (int a = 0; a < 2; ++a)
#pragma unroll
            for (int b = 0; b < 2; ++b)
#pragma unroll
                for (int m = 0; m < 4; ++m)
#pragma unroll
                    for (int n = 0; n < 2; ++n) acc[a][b][m][n] = (f32x4){0.f, 0.f, 0.f, 0.f};
        cur = nxt; cA = nA; cB = nB; ++ui;
    }
    PG8_WAIT_V(0);
    if (wr == 0) PG8_BAR;
    PG8_BAR;
#undef PG8_SA
#undef PG8_SB
#undef PG8_STAGE
#undef PG8_LDA
#undef PG8_LDB
#undef PG8_MMA
#undef PG8_WAIT_V
#undef PG8_WAIT_L
#undef PG8_BAR
#undef PG8_SCHED
}
}

struct EpiU {
    static constexpr bool PERM = true, AFTER_DRAIN = false, REALIGN = false;
    bf16_t* O;
    __device__ __forceinline__ void operator()(const f32x4 (&acc)[2][2][4][2], const pg8::Unit& u, int wr, int wc, int fr, int fq) const {
        const int row0 = u.pm * 256 + wr * 64 + fr, col0 = u.pn * 256 + wc * 32 + 8 * fq;
#pragma unroll
        for (int ai = 0; ai < 2; ++ai)
#pragma unroll
            for (int m = 0; m < 4; ++m) { bf16_t* rowp = O + (size_t)(row0 + ai * 128 + m * 16) * UP + col0;
#pragma unroll
                for (int bj = 0; bj < 2; ++bj) { const f32x4 v0 = acc[ai][bj][m][0], v1 = acc[ai][bj][m][1];
                    u32x4 w; w.x = pk2(v0[0], v0[1]); w.y = pk2(v0[2], v0[3]); w.z = pk2(v1[0], v1[1]); w.w = pk2(v1[2], v1[3]);
                    *(u32x4*)(rowp + bj * 128) = w; } }
    }
};
template <int LAYER> struct EpiY {
    static constexpr bool PERM = false, AFTER_DRAIN = false, REALIGN = false;
    const float* xp; const float* xs; float* Y; f32x2* stat; const f32x2* mr; const float* lg; const float* lb;
    __device__ __forceinline__ void operator()(const f32x4 (&acc)[2][2][4][2], const pg8::Unit& u, int wr, int wc, int fr, int fq) const {
        const int col0 = u.pn * 256 + wc * 32 + 4 * fq;
        f32x4 gv[2][2], bv[2][2];
        if (LAYER == 1) {
#pragma unroll
            for (int bj = 0; bj < 2; ++bj)
#pragma unroll
                for (int n = 0; n < 2; ++n) { gv[bj][n] = *(const f32x4*)(lg + col0 + bj * 128 + n * 16); bv[bj][n] = *(const f32x4*)(lb + col0 + bj * 128 + n * 16); }
        }
#pragma unroll
        for (int ai = 0; ai < 2; ++ai)
#pragma unroll
            for (int m = 0; m < 4; ++m) {
                const int row = u.pm * 256 + ai * 128 + wr * 64 + m * 16 + fr;
                const float* rp; f32x2 mrv = (f32x2){0.f, 1.f};
                if (LAYER == 0) rp = (row < NPROMPT) ? xp + (size_t)row * DM : xs + (size_t)(row - NPROMPT) * DM;
                else { rp = Y + (size_t)row * DM; mrv = mr[row]; }
                float* yp = Y + (size_t)row * DM;
                float s = 0.f, q = 0.f;
#pragma unroll
                for (int bj = 0; bj < 2; ++bj)
#pragma unroll
                    for (int n = 0; n < 2; ++n) {
                        const int c = col0 + bj * 128 + n * 16;
                        f32x4 r = *(const f32x4*)(rp + c);
                        if (LAYER == 1) r = (r - mrv.x) * mrv.y * gv[bj][n] + bv[bj][n];
                        const f32x4 y = r * DN_ALPHA + acc[ai][bj][m][n];
                        *(f32x4*)(yp + c) = y;
                        s += (y[0] + y[1]) + (y[2] + y[3]); q += (y[0] * y[0] + y[1] * y[1]) + (y[2] * y[2] + y[3] * y[3]);
                    }
                s += __shfl_xor(s, 16); s += __shfl_xor(s, 32); q += __shfl_xor(q, 16); q += __shfl_xor(q, 32);
                if (fq == 0) stat[(size_t)row * 16 + u.pn * 4 + wc] = (f32x2){s, q};
            }
    }
};
#define RLX_AGENT __ATOMIC_RELAXED, __HIP_MEMORY_SCOPE_AGENT
template <int LAYER> struct EpiLN {
    static constexpr bool PERM = true, AFTER_DRAIN = false, REALIGN = true;
    unsigned char* ws; float* Of; const float* lg; const float* lb;
    __device__ __forceinline__ void operator()(f32x4 (&acc)[2][2][4][2], const pg8::Unit& u, int wr, int wc, int fr, int fq) const {
        unsigned char* w2 = ws; asm volatile("" : "+s"(w2));
        const bf16_t* R = (const bf16_t*)(w2 + (LAYER == 0 ? WS_XB : WS_X1B)); bf16_t* Ob = (bf16_t*)(w2 + WS_X1B);
        unsigned long long* xbuf = (unsigned long long*)(w2 + (LAYER == 0 ? WS_STAT1 : WS_STAT2)); unsigned* cnt = (unsigned*)(w2 + WS_CTL) + 16384 + LAYER * 192 * 64;
        const int col0 = u.pn * 256 + wc * 32 + 8 * fq, rowb = u.pm * 256 + wr * 64 + fr;
        float ps[2][4], pq[2][4];
#pragma unroll
        for (int ai = 0; ai < 2; ++ai)
#pragma unroll
            for (int m = 0; m < 4; ++m) {
                const bf16_t* rp = R + (size_t)(rowb + ai * 128 + m * 16) * DM + col0;
                float s = 0.f, q = 0.f;
#pragma unroll
                for (int bj = 0; bj < 2; ++bj) {
                    const u32x4 rw = *(const u32x4*)(rp + bj * 128);
                    f32x4 r0 = (f32x4){__uint_as_float(rw.x << 16), __uint_as_float(rw.x & 0xffff0000u), __uint_as_float(rw.y << 16), __uint_as_float(rw.y & 0xffff0000u)};
                    f32x4 r1 = (f32x4){__uint_as_float(rw.z << 16), __uint_as_float(rw.z & 0xffff0000u), __uint_as_float(rw.w << 16), __uint_as_float(rw.w & 0xffff0000u)};
                    const f32x4 v0 = r0 * DN_ALPHA + acc[ai][bj][m][0], v1 = r1 * DN_ALPHA + acc[ai][bj][m][1];
                    acc[ai][bj][m][0] = v0; acc[ai][bj][m][1] = v1;
                    s += ((v0[0] + v0[1]) + (v0[2] + v0[3])) + ((v1[0] + v1[1]) + (v1[2] + v1[3]));
                    q += ((v0[0] * v0[0] + v0[1] * v0[1]) + (v0[2] * v0[2] + v0[3] * v0[3])) + ((v1[0] * v1[0] + v1[1] * v1[1]) + (v1[2] * v1[2] + v1[3] * v1[3]));
                }
                s += __shfl_xor(s, 16); s += __shfl_xor(s, 32); q += __shfl_xor(q, 16); q += __shfl_xor(q, 32);
                ps[ai][m] = s; pq[ai][m] = q;
            }
        if (fq == 0) {
#pragma unroll
            for (int ai = 0; ai < 2; ++ai)
#pragma unroll
                for (int m = 0; m < 4; ++m)
                    __hip_atomic_store(xbuf + (size_t)(rowb + ai * 128 + m * 16) * 16 + u.pn * 4 + wc, ((unsigned long long)__float_as_uint(pq[ai][m]) << 32) | __float_as_uint(ps[ai][m]), RLX_AGENT);
        }
        asm volatile("s_waitcnt vmcnt(0)" ::: "memory");
        unsigned* c = cnt + 64 * u.pm;
        if ((tid_now() & 63) == 0) __hip_atomic_fetch_add(c, 1u, RLX_AGENT);
        { unsigned spins = 0;
          while ((unsigned)__builtin_amdgcn_readfirstlane(__hip_atomic_load(c, RLX_AGENT)) < 32u) { __builtin_amdgcn_s_sleep(2); if (++spins > (1u << 16)) break; }
          __builtin_amdgcn_fence(__ATOMIC_ACQUIRE, "agent"); }
#pragma unroll
        for (int ai = 0; ai < 2; ++ai)
#pragma unroll
            for (int m = 0; m < 4; ++m) {
                const unsigned long long* sp = xbuf + (size_t)(rowb + ai * 128 + m * 16) * 16 + 4 * fq;
                float s = 0.f, q = 0.f;
#pragma unroll
                for (int t = 0; t < 4; ++t) { const unsigned long long w8 = __hip_atomic_load(sp + t, RLX_AGENT); s += __uint_as_float((unsigned)w8); q += __uint_as_float((unsigned)(w8 >> 32)); }
                s += __shfl_xor(s, 16); s += __shfl_xor(s, 32); q += __shfl_xor(q, 16); q += __shfl_xor(q, 32);
                const float mean = s * (1.0f / DM), var = q * (1.0f / DM) - mean * mean;
                ps[ai][m] = mean; pq[ai][m] = rsqrtf(fmaxf(var, 0.f) + LN_EPS);
            }
#pragma unroll
        for (int bj = 0; bj < 2; ++bj) {
            const f32x4 g0 = *(const f32x4*)(lg + col0 + bj * 128), g1 = *(const f32x4*)(lg + col0 + bj * 128 + 4), b0 = *(const f32x4*)(lb + col0 + bj * 128), b1 = *(const f32x4*)(lb + col0 + bj * 128 + 4);
#pragma unroll
            for (int ai = 0; ai < 2; ++ai)
#pragma unroll
                for (int m = 0; m < 4; ++m) {
                    const int row = rowb + ai * 128 + m * 16; const float mean = ps[ai][m], rstd = pq[ai][m];
                    const f32x4 o0 = (acc[ai][bj][m][0] - mean) * rstd * g0 + b0, o1 = (acc[ai][bj][m][1] - mean) * rstd * g1 + b1;
                    if (LAYER == 0) { u32x4 w; w.x = pk2(o0[0], o0[1]); w.y = pk2(o0[2], o0[3]); w.z = pk2(o1[0], o1[1]); w.w = pk2(o1[2], o1[3]); *(u32x4*)(Ob + (size_t)row * DM + col0 + bj * 128) = w; }
                    else { float* op = Of + (size_t)row * DM + col0 + bj * 128; *(f32x4*)op = o0; *(f32x4*)(op + 4) = o1; }
                }
        }
    }
};
struct EpiPS {
    static constexpr bool PERM = true, AFTER_DRAIN = false, REALIGN = false;
    bf16_t* P; bf16_t* S;
    __device__ __forceinline__ void operator()(const f32x4 (&acc)[2][2][4][2], const pg8::Unit& u, int wr, int wc, int fr, int fq) const {
        const int row0 = u.pm * 256 + wr * 64 + fr, off = (wc & 1) * 32 + 8 * fq;
        bf16_t* dst = (wc < 2 ? S : P) + u.pn * 64 + off;
#pragma unroll
        for (int ai = 0; ai < 2; ++ai)
#pragma unroll
            for (int m = 0; m < 4; ++m) {
                float o[8];
#pragma unroll
                for (int n = 0; n < 2; ++n)
#pragma unroll
                    for (int j = 0; j < 4; ++j) { const float a = acc[ai][0][m][n][j], b = acc[ai][1][m][n][j];
                        o[4 * n + j] = (wc < 2) ? silu(b) * a : a * b; }
                u32x4 w; w.x = pk2(o[0], o[1]); w.y = pk2(o[2], o[3]); w.z = pk2(o[4], o[5]); w.w = pk2(o[6], o[7]);
                *(u32x4*)(dst + (size_t)(row0 + ai * 128 + m * 16) * DM) = w;
            }
    }
};

template <int CTRL> __device__ __forceinline__ float dpp_f(float x);
struct EpiG {
    static constexpr bool PERM = true, AFTER_DRAIN = false, REALIGN = false;
    unsigned char* ws; const float* cw;
    __device__ __forceinline__ void operator()(const f32x4 (&acc)[2][2][4][2], const pg8::Unit& u, int wr, int wc, int fr, int fq) const {
        unsigned char* w2 = ws; asm volatile("" : "+s"(w2));
        bf16_t* G = (bf16_t*)(w2 + WS_XB); float* Pb = (float*)(w2 + WS_PB); float* Sb = (float*)(w2 + WS_SB);
        const int ch0 = u.pn * 64 + 16 * wc + 4 * fq;
        const f32x4 c0 = *(const f32x4*)(cw + ch0), c1 = *(const f32x4*)(cw + 1024 + ch0), c2 = *(const f32x4*)(cw + 2048 + ch0);
#pragma unroll
        for (int ai = 0; ai < 2; ++ai) {
            f32x4 P[4], S[4];
#pragma unroll
            for (int m = 0; m < 4; ++m)
#pragma unroll
                for (int j = 0; j < 4; ++j) { P[m][j] = acc[ai][0][m][1][j] * acc[ai][1][m][1][j]; S[m][j] = silu(acc[ai][1][m][0][j]) * acc[ai][0][m][0][j]; }
            const int row0 = u.pm * 256 + ai * 128 + wr * 64 + fr;
#pragma unroll
            for (int m = 0; m < 4; ++m) {
                float o[4];
#pragma unroll
                for (int j = 0; j < 4; ++j) {
                    float pr = dpp_f<0x111>(P[m][j]);
                    if (m > 0) { const float t = dpp_f<0x121>(P[m - 1][j]); pr = fr == 0 ? t : pr; }
                    float nx = dpp_f<0x101>(P[m][j]);
                    if (m < 3) { const float t = dpp_f<0x12F>(P[m + 1][j]); nx = fr == 15 ? t : nx; }
                    o[j] = S[m][j] * (c0[j] * pr + c1[j] * P[m][j] + c2[j] * nx);
                }
                u32x2 w; w.x = pk2(o[0], o[1]); w.y = pk2(o[2], o[3]);
                *(u32x2*)(G + (size_t)(row0 + 16 * m) * DM + ch0) = w;
            }
            const int blk = u.pm * 4 + ai * 2 + wr;
            if (fr == 0) { *(f32x4*)(Pb + (size_t)(blk * 2) * 1024 + ch0) = P[0]; *(f32x4*)(Sb + (size_t)(blk * 2) * 1024 + ch0) = S[0]; }
            if (fr == 15) { *(f32x4*)(Pb + (size_t)(blk * 2 + 1) * 1024 + ch0) = P[3]; *(f32x4*)(Sb + (size_t)(blk * 2 + 1) * 1024 + ch0) = S[3]; }
        }
    }
};
#define XB_TMO      128
#define XB_XCNT(j)  (256  + 64 * (j))
#define XB_XSUB(j)  (1280 + 64 * (j))
#define XB_XGEN(j)  (2304 + 64 * (j))
#define XB_TOP      3328
#define XB_TOPGEN   3392
#define XCD_BAR_WORDS 3456
#define XB_SPIN_CAP (1u << 27)
__device__ __forceinline__ unsigned xb_ld(unsigned* p)              { return __hip_atomic_load(p, __ATOMIC_RELAXED, __HIP_MEMORY_SCOPE_AGENT); }
__device__ __forceinline__ unsigned xb_add(unsigned* p, unsigned v) { return __hip_atomic_fetch_add(p, v, __ATOMIC_RELAXED, __HIP_MEMORY_SCOPE_AGENT); }
__device__ __forceinline__ unsigned xb_xcc_id() { return (unsigned)__builtin_amdgcn_s_getreg((3 << 11) | 20) & 0xFu; }
#define XB_SPIN(cond, bar) do { unsigned _sp = 0; while (cond) { __builtin_amdgcn_s_sleep(1); \
    if ((++_sp & 255u) == 0u) { if (xb_ld(&(bar)[XB_TMO])) break; if (_sp > XB_SPIN_CAP) { atomicAdd(&(bar)[XB_TMO], 1u); break; } } } } while (0)
struct XcdBarrier { unsigned* bar; unsigned x; volatile LAS unsigned* st; };
__device__ __forceinline__ XcdBarrier xcd_barrier_post(unsigned* bar, volatile LAS unsigned* st) {
    XcdBarrier b; b.bar = bar; b.x = xb_xcc_id(); b.st = st;
    if (tid_now() == 0) (void)xb_add(&bar[XB_XCNT(b.x)], 1u);
    return b;
}
__device__ __forceinline__ void xcd_barrier_complete(unsigned* bar, unsigned x, unsigned& nloc, unsigned& nx) {
    const unsigned G = gridDim.x * gridDim.y * gridDim.z;
    unsigned sum, cnt, mine, sp = 0u;
    for (;;) {
        sum = 0u; cnt = 0u; mine = 0u;
#pragma unroll
        for (unsigned j = 0; j < 16; ++j) { const unsigned c = xb_ld(&bar[XB_XCNT(j)]); sum += c; cnt += (c > 0u) ? 1u : 0u; mine = (j == x) ? c : mine; }
        if (sum == G) break;
        __builtin_amdgcn_s_sleep(1);
        if ((++sp & 255u) == 0u) { if (xb_ld(&bar[XB_TMO])) break; if (sp > XB_SPIN_CAP) { atomicAdd(&bar[XB_TMO], 1u); break; } }
    }
    nloc = mine > 0u ? mine : 1u; nx = cnt > 0u ? cnt : 1u;
}
__device__ __forceinline__ void xcd_barrier(const XcdBarrier& b) {
    asm volatile("s_waitcnt vmcnt(0)" ::: "memory");
    __syncthreads();
    if (tid_now() == 0) {
        unsigned* bar = b.bar;
        __builtin_amdgcn_s_waitcnt(0);
        unsigned nloc = b.st[0], nx = b.st[1];
        if (nloc == 0u) { xcd_barrier_complete(bar, b.x, nloc, nx); b.st[0] = nloc; b.st[1] = nx; }
        const unsigned old = xb_add(&bar[XB_XSUB(b.x)], 1u);
        const unsigned gen = old / nloc;
        if (old + 1u == (gen + 1u) * nloc) {
            __builtin_amdgcn_fence(__ATOMIC_RELEASE, "agent");
            asm volatile("s_waitcnt vmcnt(0)" ::: "memory");
            const unsigned og = xb_add(&bar[XB_TOP], 1u);
            const unsigned tg = og / nx;
            if (og + 1u == (tg + 1u) * nx) xb_add(&bar[XB_TOPGEN], 1u);
            else XB_SPIN(xb_ld(&bar[XB_TOPGEN]) == tg, bar);
            __builtin_amdgcn_fence(__ATOMIC_ACQUIRE, "agent");
            xb_add(&bar[XB_XGEN(b.x)], 1u);
            asm volatile("s_waitcnt vmcnt(0)" ::: "memory");
        } else {
            XB_SPIN(xb_ld(&bar[XB_XGEN(b.x)]) == gen, bar);
            __builtin_amdgcn_fence(__ATOMIC_ACQUIRE, "agent");
            asm volatile("s_waitcnt vmcnt(0)" ::: "memory");
        }
    }
    __syncthreads();
}

struct Args {
    const float *xp, *xs, *w_in_even, *wuf, *bfw, *wub, *bbw, *ng, *sink, *relb, *w_out_even, *w_in_odd, *cw, *w_out_odd, *lng, *lnb;
    float* out; unsigned char* ws;
};
constexpr int NTHR = 512;
constexpr int LDS_BYTES = 147456, MISC_OFF = 131072 + 1024;

template <int MODE> __device__ __forceinline__ int wmap(int n, float& sc) {
    sc = 1.f;
    if (MODE == 0) return n;
    if (MODE == 1) {
        if (n < 512) sc = 0.08838834764831845f;
        if (n >= C_QB && n < C_KB) sc = 0.125f;
        if (n < 2048) return n;
        if (n < C_GD) return n + 32;
        if (n < C_GD + 32) return n - C_GD + 2048;
        return -1;
    }
    const int c = n & 255, bj = (c >> 7) & 1, wc = (c >> 5) & 3, fq = (c >> 3) & 3, nn = (c >> 2) & 1, j = c & 3, q = 2 * bj + nn, ch = (n >> 8) * 64 + 16 * wc + 4 * fq + j;
    const int base = q == 0 ? 0 : (q == 1 ? 1024 : (q == 2 ? 3072 : 2048));
    return base + ch;
}
template <int MODE> __device__ __forceinline__ void wconv_item(const float* __restrict__ W, int Nsrc, bf16_t* __restrict__ Wt, int Ndst, int item, LAS float* tile, int t256) {
    const int nb = item % (Ndst / 64), kb = item / (Ndst / 64), n0 = nb * 64, k0 = kb * 64;
    const int tx = t256 & 63, ty = t256 >> 6;
    float sc; const int src = wmap<MODE>(n0 + tx, sc);
    for (int kk = ty; kk < 64; kk += 4) tile[kk * 65 + tx] = src >= 0 ? W[(size_t)(k0 + kk) * Nsrc + src] * sc : 0.f;
    __syncthreads();
    for (int nn = ty; nn < 64; nn += 4) Wt[(size_t)(n0 + nn) * 1024 + k0 + tx] = f2bf(tile[tx * 65 + nn]);
    __syncthreads();
}
__device__ __forceinline__ void build_gate_tables(const Args& a);
__device__ __forceinline__ void phase_convert(const Args& a, LAS unsigned char* lds) {
    unsigned char* ws = a.ws;
    bf16_t* W1t = (bf16_t*)(ws + WS_W1T); bf16_t* W2t = (bf16_t*)(ws + WS_W2T); bf16_t* W3t = (bf16_t*)(ws + WS_W3T); bf16_t* W4t = (bf16_t*)(ws + WS_W4T);
    const int half = tid_now() >> 8, t256 = tid_now() & 255;
    LAS float* tile = (LAS float*)lds + half * (64 * 65);
    constexpr int I1 = (UP / 64) * 16, I2 = 16 * 16, I3 = 64 * 16, I4 = 16 * 16, NIT = I1 + I2 + I3 + I4;
    for (int it0 = blockIdx.x * 2; it0 < NIT; it0 += gridDim.x * 2) {
        int r = it0 + half;
        if (r < I1) wconv_item<1>(a.w_in_even, EVEN_IN, W1t, UP, r, tile, t256);
        else if ((r -= I1) < I2) wconv_item<0>(a.w_out_even, 1024, W2t, 1024, r, tile, t256);
        else if ((r -= I2) < I3) wconv_item<2>(a.w_in_odd, ODD_IN, W3t, 4096, r, tile, t256);
        else if ((r -= I3) < I4) wconv_item<0>(a.w_out_odd, 1024, W4t, 1024, r, tile, t256);
        else { __syncthreads(); __syncthreads(); }
    }
    build_gate_tables(a);
    bf16_t* xb = (bf16_t*)(ws + WS_XB);
    const size_t n8 = (size_t)NTOK * DM / 8;
    for (size_t i = (size_t)blockIdx.x * NTHR + tid_now(); i < n8; i += (size_t)gridDim.x * NTHR) {
        const size_t e = i * 8; const float* src = e < (size_t)NPROMPT * DM ? a.xp + e : a.xs + (e - (size_t)NPROMPT * DM);
        const f32x4 v0 = *(const f32x4*)src, v1 = *(const f32x4*)(src + 4);
        u32x4 w; w.x = pk2(v0[0], v0[1]); w.y = pk2(v0[2], v0[3]); w.z = pk2(v1[0], v1[1]); w.w = pk2(v1[2], v1[3]);
        *(u32x4*)(xb + e) = w;
    }
}

__device__ __forceinline__ void phase_gla_naive(const Args& a, LAS unsigned char* lds, float* OF, float* OB) {
    if (blockIdx.x >= 12) return;
    const bf16_t* U = (const bf16_t*)(a.ws + WS_U);
    const int grp = tid_now() >> 7, tid = tid_now() & 127, b = blockIdx.x * 4 + grp, dir = b & 1, h = (b >> 1) & 3, s = b >> 3;
    LAS float* sq = (LAS float*)lds + grp * (3 * 16 * 128); LAS float* sk = sq + 16 * 128; LAS float* sd = sk + 16 * 128;
    const int L = s < 2 ? LP : LS, start = s < 2 ? s * LP : NPROMPT + (s - 2) * LS;
    const float* wu = dir ? a.wub : a.wuf; const float* bias = dir ? a.bbw : a.bfw; float* O = dir ? OB : OF;
    float wr[16];
#pragma unroll
    for (int r = 0; r < 16; ++r) wr[r] = wu[r * 512 + h * 128 + tid];
    const float bb = bias[h * 128 + tid];
    float S[128];
#pragma unroll
    for (int i = 0; i < 128; ++i) S[i] = 0.f;
    for (int t0 = 0; t0 < L; t0 += 16) {
        for (int tt = 0; tt < 16; ++tt) {
            const int p = t0 + tt, tok = start + (dir ? L - 1 - p : p);
            const bf16_t* ur = U + (size_t)tok * UP;
            float x = bb;
#pragma unroll
            for (int r = 0; r < 16; ++r) x += bf2f(ur[C_GD + dir * 16 + r]) * wr[r];
            const float ls = fminf(x, 0.f) - log1pf(expf(-fabsf(x)));
            sd[tt * 128 + tid] = expf(ls * (1.0f / 16.0f));
            sq[tt * 128 + tid] = bf2f(ur[C_QA + h * 128 + tid]);
            sk[tt * 128 + tid] = bf2f(ur[C_KA + h * 128 + tid]);
        }
        __syncthreads();
        for (int tt = 0; tt < 16; ++tt) {
            const int p = t0 + tt, tok = start + (dir ? L - 1 - p : p);
            const float v = bf2f(U[(size_t)tok * UP + C_VA + h * 128 + tid]);
            float acc = 0.f;
#pragma unroll
            for (int dk = 0; dk < 128; dk += 4) {
                const f32x4 d4 = *(const LAS f32x4*)&sd[tt * 128 + dk], q4 = *(const LAS f32x4*)&sq[tt * 128 + dk], k4 = *(const LAS f32x4*)&sk[tt * 128 + dk];
#pragma unroll
                for (int j = 0; j < 4; ++j) {
                    const float sdec = S[dk + j] * d4[j];
                    const float sn = sdec + k4[j] * v;
                    acc += q4[j] * (dir ? sdec : sn);
                    S[dk + j] = sn;
                }
            }
            O[(size_t)tok * 512 + h * 128 + tid] = acc;
        }
        __syncthreads();
    }
}
__device__ __forceinline__ void phase_gla_combine(const Args& a, const float* OF, const float* OB) {
    const bf16_t* U = (const bf16_t*)(a.ws + WS_U); bf16_t* ymix = (bf16_t*)((unsigned char*)a.out + 96 * MiB);
    const int lane = tid_now() & 63;
    for (int w = blockIdx.x * 8 + (tid_now() >> 6); w < NTOK * 4; w += gridDim.x * 8) {
        const int tok = w >> 2, h = w & 3;
        const size_t o = (size_t)tok * 512 + h * 128 + lane * 2;
        const float a0 = OF[o] + OB[o], a1 = OF[o + 1] + OB[o + 1];
        const float ss = wave_sum(a0 * a0 + a1 * a1);
        const float rstd = rsqrtf(ss * (1.0f / 128.0f) + NORM_EPS);
        const bf16_t* z = U + (size_t)tok * UP + C_ZA + h * 128 + lane * 2;
        const float y0 = a0 * rstd * a.ng[lane * 2] * silu(bf2f(z[0])), y1 = a1 * rstd * a.ng[lane * 2 + 1] * silu(bf2f(z[1]));
        *(unsigned*)(ymix + (size_t)tok * DM + h * 128 + lane * 2) = pk2(y0, y1);
    }
}
__device__ __forceinline__ int t5_bucket(int rel) {
    const int n = rel < 0 ? -rel : rel;
    int b = n < 8 ? n : (n < 12 ? 8 : (n < 16 ? 9 : (n < 23 ? 10 : (n < 32 ? 11 : (n < 46 ? 12 : (n < 64 ? 13 : (n < 91 ? 14 : 15)))))));
    return b + (rel > 0 ? 16 : 0);
}
__device__ __forceinline__ void phase_swa_naive(const Args& a, LAS unsigned char* lds) {
    const bf16_t* U = (const bf16_t*)(a.ws + WS_U); bf16_t* ymix = (bf16_t*)((unsigned char*)a.out + 96 * MiB);
    const int wv = tid_now() >> 6, lane = tid_now() & 63;
    LAS float* sq = (LAS float*)(lds + 65536) + wv * 64; LAS float* sp = (LAS float*)(lds + 65536 + 2048) + wv * 320;
    for (int w = blockIdx.x * 8 + wv; w < NTOK * 8; w += gridDim.x * 8) {
        const int tok = w >> 3, hq = w & 7, kv = hq >> 2;
        int s0, L; seq_of(tok, s0, L); const int i = tok - s0;
        sq[lane] = bf2f(U[(size_t)tok * UP + C_QB + hq * 64 + lane]);
        const float snk = a.sink[hq];
        float sc[5]; float mx = snk;
#pragma unroll
        for (int c = 0; c < 5; ++c) {
            const int jj = c * 64 + lane, j = i - 128 + jj; const bool valid = jj <= 256 && j >= 0 && j < L;
            float d = -INFINITY;
            if (valid) {
                const bf16_t* kr = U + (size_t)(s0 + j) * UP + C_KB + kv * 64; d = 0.f;
#pragma unroll
                for (int e = 0; e < 64; e += 8) { const u32x4 kk = *(const u32x4*)(kr + e);
                    d += sq[e] * __uint_as_float(kk.x << 16) + sq[e + 1] * __uint_as_float(kk.x & 0xffff0000u) + sq[e + 2] * __uint_as_float(kk.y << 16) + sq[e + 3] * __uint_as_float(kk.y & 0xffff0000u)
                       + sq[e + 4] * __uint_as_float(kk.z << 16) + sq[e + 5] * __uint_as_float(kk.z & 0xffff0000u) + sq[e + 6] * __uint_as_float(kk.w << 16) + sq[e + 7] * __uint_as_float(kk.w & 0xffff0000u); }
                d += a.relb[t5_bucket(j - i) * 8 + hq];
            }
            sc[c] = d; mx = fmaxf(mx, d);
        }
        mx = wave_max(mx);
        float den = 0.f;
#pragma unroll
        for (int c = 0; c < 5; ++c) { sc[c] = sc[c] == -INFINITY ? 0.f : __expf(sc[c] - mx); den += sc[c]; }
        den = wave_sum(den) + __expf(snk - mx);
        const float inv = 1.0f / den;
#pragma unroll
        for (int c = 0; c < 5; ++c) sp[c * 64 + lane] = sc[c] * inv;
        float o = 0.f;
        for (int jj = 0; jj <= 256; ++jj) { const int j = i - 128 + jj; if (j >= 0 && j < L) o += sp[jj] * bf2f(U[(size_t)(s0 + j) * UP + C_VB + kv * 64 + lane]); }
        const float z = bf2f(U[(size_t)tok * UP + C_ZB + hq * 64 + lane]);
        ymix[(size_t)tok * DM + 512 + hq * 64 + lane] = f2bf(o * silu(z));
    }
}
template <int FINAL>
__device__ __forceinline__ void phase_ln(float* Y, const f32x2* stat, f32x2* mr, const float* lg, const float* lb, bf16_t* xb) {
    const int lane = tid_now() & 63;
    for (int row = blockIdx.x * 8 + (tid_now() >> 6); row < NTOK; row += gridDim.x * 8) {
        f32x2 p = lane < 16 ? stat[(size_t)row * 16 + lane] : (f32x2){0.f, 0.f};
        const float s = wave_sum(p.x), q = wave_sum(p.y);
        const float mean = s * (1.0f / DM), var = q * (1.0f / DM) - mean * mean, rstd = rsqrtf(fmaxf(var, 0.f) + LN_EPS);
        if (!FINAL && lane == 0) mr[row] = (f32x2){mean, rstd};
#pragma unroll
        for (int j = 0; j < 4; ++j) {
            const int c = j * 256 + lane * 4;
            const f32x4 y = *(const f32x4*)(Y + (size_t)row * DM + c), g = *(const f32x4*)(lg + c), b = *(const f32x4*)(lb + c);
            const f32x4 o = (y - mean) * rstd * g + b;
            if (FINAL) *(f32x4*)(Y + (size_t)row * DM + c) = o;
            else { u32x2 w; w.x = pk2(o[0], o[1]); w.y = pk2(o[2], o[3]); *(u32x2*)(xb + (size_t)row * DM + c) = w; }
        }
    }
}
__device__ __forceinline__ void phase_convgate(const bf16_t* P, const bf16_t* S, const float* cw, bf16_t* G) {
    const size_t n8 = (size_t)NTOK * DM / 8;
    for (size_t i = (size_t)blockIdx.x * NTHR + tid_now(); i < n8; i += (size_t)gridDim.x * NTHR) {
        const int row = (int)(i >> 7), c = (int)(i & 127) * 8; int s0, L; seq_of(row, s0, L);
        const bool hasl = row > s0, hasr = row < s0 + L - 1;
        const u32x4 pm = *(const u32x4*)(P + (size_t)row * DM + c), sv = *(const u32x4*)(S + (size_t)row * DM + c);
        u32x4 pl = (u32x4){0, 0, 0, 0}, pr = (u32x4){0, 0, 0, 0};
        if (hasl) pl = *(const u32x4*)(P + (size_t)(row - 1) * DM + c);
        if (hasr) pr = *(const u32x4*)(P + (size_t)(row + 1) * DM + c);
        float o[8];
#pragma unroll
        for (int j = 0; j < 4; ++j) {
            const unsigned l = pl[j], m = pm[j], r = pr[j], sw = sv[j];
            const int cc = c + 2 * j;
            o[2 * j] = __uint_as_float(sw << 16) * (cw[cc] * __uint_as_float(l << 16) + cw[1024 + cc] * __uint_as_float(m << 16) + cw[2048 + cc] * __uint_as_float(r << 16));
            o[2 * j + 1] = __uint_as_float(sw & 0xffff0000u) * (cw[cc + 1] * __uint_as_float(l & 0xffff0000u) + cw[1024 + cc + 1] * __uint_as_float(m & 0xffff0000u) + cw[2048 + cc + 1] * __uint_as_float(r & 0xffff0000u));
        }
        u32x4 w; w.x = pk2(o[0], o[1]); w.y = pk2(o[2], o[3]); w.z = pk2(o[4], o[5]); w.w = pk2(o[6], o[7]);
        *(u32x4*)(G + (size_t)row * DM + c) = w;
    }
}

typedef short s16x4 __attribute__((ext_vector_type(4)));
constexpr int GL_QT = 0, GL_KT = 16384, GL_VT = 32768, GL_PT = 49152, GL_B = 57344, GL_GD = 90112, GL_TOT = 94208, GL_EBL = 96256  , GL_SSW = 97280, GL_RSTD = 99328;
constexpr int NSEG = NTOK / 256;
__device__ __forceinline__ unsigned offb(unsigned row, unsigned ch) { return 256u * row + 16u * (ch ^ (((row & 3) << 2) | ((row >> 2) & 3))); }
__device__ __forceinline__ unsigned offp(unsigned row, unsigned ch) { return 128u * row + 16u * (ch ^ (row & 7)); }
__device__ __forceinline__ unsigned rr16(unsigned lane, unsigned rb, unsigned s) { return offb((lane & 15) + 16 * rb, 4 * s + (lane >> 4)); }
__device__ __forceinline__ unsigned tr16(unsigned lane, unsigned c, unsigned ks, unsigned t) {
    const unsigned g = lane >> 4, q = (lane & 15) >> 2, p = lane & 3;
    return offb(32 * ks + 8 * g + 4 * t + q, 2 * c + (p >> 1)) + 8 * (p & 1);
}
__device__ __forceinline__ bf16x8 tr_read8(unsigned a0, unsigned a1) {
    s16x4 r0, r1;
    asm volatile("ds_read_b64_tr_b16 %0, %2\n\tds_read_b64_tr_b16 %1, %3\n\ts_waitcnt lgkmcnt(0)" : "=&v"(r0), "=&v"(r1) : "v"(a0), "v"(a1) : "memory");
    return __builtin_shufflevector(r0, r1, 0, 1, 2, 3, 4, 5, 6, 7);
}
__device__ __forceinline__ void unpack8(const u32x4 w, float (&f)[8]) {
#pragma unroll
    for (int j = 0; j < 4; ++j) { f[2 * j] = __uint_as_float(w[j] << 16); f[2 * j + 1] = __uint_as_float(w[j] & 0xffff0000u); }
}
#define MFMA16(a, b, c) __builtin_amdgcn_mfma_f32_16x16x32_bf16((a), (b), (c), 0, 0, 0)

struct GlaPre { u32x4 gd[4]; u32x4 q[2], k[2], v[2]; u32x4 wf; f32x4 wb; };
template <int MODE>
__device__ __forceinline__ void gla_prefetch(const Args& a, GlaPre& pre, int tid, int tb, int h, int dir, int stidx) {
    const bf16_t* U = (const bf16_t*)(a.ws + WS_U);
    const int lane = tid & 63, n = lane & 15, g = lane >> 4, w = tid >> 6;
#pragma unroll
    for (int it = 0; it < 4; ++it) { const int row = 16 * it + n, tok = dir ? tb + 63 - row : tb + row; pre.gd[it] = *(const u32x4*)(U + (size_t)tok * UP + C_GD + dir * 16 + 8 * (g & 1)); }
#pragma unroll
    for (int i = 0; i < 2; ++i) {
        const int idx = tid + 512 * i, row = idx >> 4, ch = idx & 15, tok = dir ? tb + 63 - row : tb + row;
        const bf16_t* ur = U + (size_t)tok * UP + h * 128 + ch * 8;
        pre.v[i] = *(const u32x4*)(ur + C_VA); pre.k[i] = *(const u32x4*)(ur + C_KA);
        if (MODE != 0) pre.q[i] = *(const u32x4*)(ur + C_QA);
    }
    pre.wf = ((const u32x4*)(a.ws + WS_GATE))[(dir * 4 + h) * 512 + tid];
    pre.wb = *(const f32x4*)((const float*)(a.ws + WS_GATE + 65536) + (dir * 4 + h) * 128 + 16 * w + 4 * g);
}
__device__ __forceinline__ bf16x8 tr_read8(LAS unsigned char* lds, unsigned a0, unsigned a1) {
    const s16x4 r0 = __builtin_amdgcn_ds_read_tr16_b64_v4i16((LAS s16x4*)(lds + a0)), r1 = __builtin_amdgcn_ds_read_tr16_b64_v4i16((LAS s16x4*)(lds + a1));
    return __builtin_shufflevector(r0, r1, 0, 1, 2, 3, 4, 5, 6, 7);
}
template <int CTRL> __device__ __forceinline__ float dpp_f(float x) { return __int_as_float(__builtin_amdgcn_update_dpp(0, __float_as_int(x), CTRL, 0xf, 0xf, true)); }
constexpr int GL_BP = 132;
template <int MODE>
__device__ __forceinline__ void gla_chunk(const Args& a, LAS unsigned char* lds, const int tb, const int h, const int dir,
                                          f32x4 (&Sacc)[8], f32x4& lam, u32x4* stash, GlaPre& pre, const int ntb, const int nh, const int ndir, const bool first, const int par) {
    const bf16_t* U = (const bf16_t*)(a.ws + WS_U);
    int tid = tid_now(); asm volatile("" : "+v"(tid));
    const int lane = tid & 63, w = __builtin_amdgcn_readfirstlane(tid >> 6), n = lane & 15, g = lane >> 4;
    const unsigned fn = ((n & 3) << 2) | ((n >> 2) & 3);
    const unsigned base_rr = 256u * n + 16u * (g ^ fn);
    const unsigned base_c = 256u * n + 16u * ((g >> 1) ^ fn) + 8u * (g & 1);
    const unsigned base_p = 128u * n + 16u * (g ^ (n & 7));
    const unsigned trb0 = tr16(lane, 0, 0, 0), trb1 = tr16(lane, 0, 0, 1);
    GlaPre& cur = pre;
    const bf16x8 wfrag = __builtin_bit_cast(bf16x8, cur.wf); const f32x4 wbias = cur.wb;
    int prow[2], pch[2], ptok[2];
#pragma unroll
    for (int i = 0; i < 2; ++i) { const int idx = tid + 512 * i; prow[i] = idx >> 4; pch[i] = idx & 15; ptok[i] = dir ? tb + 63 - prow[i] : tb + prow[i]; }
    u32x4 st0, st1, zraw[2];
    {
        LAS float* B = (LAS float*)(lds + GL_B);
        f32x4 carry = (f32x4){0.f, 0.f, 0.f, 0.f};
#pragma unroll
        for (int tt = 0; tt < 4; ++tt) {
            const f32x4 x = MFMA16(wfrag, __builtin_bit_cast(bf16x8, cur.gd[tt]), wbias);
            f32x4 pv, tv;
#pragma unroll
            for (int r = 0; r < 4; ++r) {
                const float xv = x[r]; const float v = (fminf(xv, 0.f) - 0.6931471805599453f * flog2(1.0f + fexp(-fabsf(xv)))) * (1.0f / 16.0f);
                float ps = v; ps += dpp_f<0x111>(ps); ps += dpp_f<0x112>(ps); ps += dpp_f<0x114>(ps); ps += dpp_f<0x118>(ps);
                float ts = v; ts += dpp_f<0x128>(ts); ts += dpp_f<0x124>(ts); ts += dpp_f<0x122>(ts); ts += dpp_f<0x121>(ts);
                pv[r] = ps; tv[r] = ts;
            }
            *(LAS f32x4*)(B + (16 * tt + n) * GL_BP + 16 * w + 4 * g) = carry + pv;
            carry += tv;
        }
        if (n == 0) *(LAS f32x4*)(lds + GL_EBL + par * 512 + (16 * w + 4 * g) * 4) = (f32x4){fexp(carry[0]), fexp(carry[1]), fexp(carry[2]), fexp(carry[3])};
        lam += carry;
    }
    __syncthreads();
#pragma unroll
    for (int i = 0; i < 2; ++i) {
        const LAS f32x4* bp = (const LAS f32x4*)(lds + GL_B + (prow[i] * GL_BP + pch[i] * 8) * 4);
        const f32x4 b0 = bp[0], b1 = bp[1];
        float e[8], kf[8];
#pragma unroll
        for (int j = 0; j < 4; ++j) { e[j] = fexp(b0[j]); e[4 + j] = fexp(b1[j]); }
        unpack8(cur.k[i], kf);
        u32x4 kw;
#pragma unroll
        for (int j = 0; j < 4; ++j) kw[j] = pk2(kf[2 * j] * __builtin_amdgcn_rcpf(e[2 * j]), kf[2 * j + 1] * __builtin_amdgcn_rcpf(e[2 * j + 1]));
        *(LAS u32x4*)(lds + GL_KT + offb(prow[i], pch[i])) = kw;
        *(LAS u32x4*)(lds + GL_VT + offb(prow[i], pch[i])) = cur.v[i];
        if (MODE != 0) {
            float qf[8]; unpack8(cur.q[i], qf);
            u32x4 qw;
#pragma unroll
            for (int j = 0; j < 4; ++j) qw[j] = pk2(qf[2 * j] * e[2 * j], qf[2 * j + 1] * e[2 * j + 1]);
            *(LAS u32x4*)(lds + GL_QT + offb(prow[i], pch[i])) = qw;
        }
    }
    __syncthreads();
    gla_prefetch<MODE>(a, pre, tid, ntb, nh, ndir, -1);
    f32x4 Oacc[4];
    if (MODE != 0) {
        const int it = w >> 1;
#pragma unroll
        for (int jj = 0; jj < 2; ++jj) {
            const int jt = 2 * (w & 1) + jj;
            f32x4 pacc = (f32x4){0.f, 0.f, 0.f, 0.f};
            if (jt <= it) {
#pragma unroll
                for (int s = 0; s < 4; ++s) {
                    const bf16x8 qa = *(const LAS bf16x8*)(lds + GL_QT + (base_rr ^ (64u * s)) + 4096u * it);
                    const bf16x8 kb = *(const LAS bf16x8*)(lds + GL_KT + (base_rr ^ (64u * s)) + 4096u * jt); pacc = MFMA16(qa, kb, pacc); }
            }
            const int j = 16 * jt + n;
#pragma unroll
            for (int r = 0; r < 4; ++r) {
                const int i = 16 * it + 4 * g + r;
                const bool keep = (MODE == 1) ? (j <= i) : (j < i);
                *(LAS bf16_t*)(lds + GL_PT + offp(i, j >> 3) + 2 * (j & 7)) = keep ? f2bf(pacc[r]) : (bf16_t)0;
            }
            __builtin_amdgcn_sched_barrier(0);
        }
        if (first) {
#pragma unroll
            for (int kt = 0; kt < 8; ++kt) { const unsigned r0 = __float_as_uint(Sacc[kt][0]), r1 = __float_as_uint(Sacc[kt][1]);
                Sacc[kt] = (f32x4){__uint_as_float(r0 << 16), __uint_as_float(r0 & 0xffff0000u), __uint_as_float(r1 << 16), __uint_as_float(r1 & 0xffff0000u)}; }
        }
#pragma unroll
        for (int i2 = 0; i2 < 4; ++i2) Oacc[i2] = (f32x4){0.f, 0.f, 0.f, 0.f};
#pragma unroll
        for (int ks = 0; ks < 4; ++ks) {
            u32x4 pw; pw.x = pk2(Sacc[2 * ks][0], Sacc[2 * ks][1]); pw.y = pk2(Sacc[2 * ks][2], Sacc[2 * ks][3]); pw.z = pk2(Sacc[2 * ks + 1][0], Sacc[2 * ks + 1][1]); pw.w = pk2(Sacc[2 * ks + 1][2], Sacc[2 * ks + 1][3]);
            const bf16x8 sb = __builtin_bit_cast(bf16x8, pw);
            const unsigned alo = base_c ^ (64u * ks);
#pragma unroll
            for (int i2 = 0; i2 < 4; ++i2) {
                const u32x2 lo = *(const LAS u32x2*)(lds + GL_QT + 4096 * i2 + alo);
                const u32x2 hi = *(const LAS u32x2*)(lds + GL_QT + 4096 * i2 + (alo ^ 32u));
                u32x4 aw; aw.x = lo.x; aw.y = lo.y; aw.z = hi.x; aw.w = hi.y;
                Oacc[i2] = MFMA16(__builtin_bit_cast(bf16x8, aw), sb, Oacc[i2]);
            }
            __builtin_amdgcn_sched_barrier(0);
        }
        __syncthreads();
        if (MODE == 2) {
            st0 = stash[tid * 2]; st1 = stash[tid * 2 + 1];
#pragma unroll
            for (int i = 0; i < 2; ++i) zraw[i] = *(const u32x4*)(U + (size_t)ptok[i] * UP + C_ZA + h * 128 + pch[i] * 8);
        }
    }
    bf16x8 vf[2];
#pragma unroll
    for (int ks = 0; ks < 2; ++ks) vf[ks] = tr_read8(lds, GL_VT + 8192u * ks + (trb0 ^ (32u * w)), GL_VT + 8192u * ks + (trb1 ^ (32u * w)));
    if (MODE != 0) {
#pragma unroll
        for (int i2 = 0; i2 < 4; ++i2)
#pragma unroll
            for (int ks = 0; ks < 2; ++ks) {
                if (ks <= (i2 >> 1)) { const bf16x8 pa = *(const LAS bf16x8*)(lds + GL_PT + 2048 * i2 + (base_p ^ (64u * ks))); Oacc[i2] = MFMA16(pa, vf[ks], Oacc[i2]); }
            }
    }
#pragma unroll
    for (int kt = 0; kt < 8; ++kt) {
#pragma unroll
        for (int ks = 0; ks < 2; ++ks) { const bf16x8 ka = tr_read8(lds, GL_KT + 8192u * ks + (trb0 ^ (32u * kt)), GL_KT + 8192u * ks + (trb1 ^ (32u * kt))); Sacc[kt] = MFMA16(ka, vf[ks], Sacc[kt]); }
        const f32x4 eb = *(const LAS f32x4*)(lds + GL_EBL + par * 512 + (16 * kt + 4 * g) * 4);
        Sacc[kt] = Sacc[kt] * eb;
        if (kt & 1) __builtin_amdgcn_sched_barrier(0);
    }
    if (MODE == 1) {
        u32x4 s0, s1;
        s0.x = pk2(Oacc[3][3], Oacc[3][2]); s0.y = pk2(Oacc[3][1], Oacc[3][0]); s0.z = pk2(Oacc[2][3], Oacc[2][2]); s0.w = pk2(Oacc[2][1], Oacc[2][0]);
        s1.x = pk2(Oacc[1][3], Oacc[1][2]); s1.y = pk2(Oacc[1][1], Oacc[1][0]); s1.z = pk2(Oacc[0][3], Oacc[0][2]); s1.w = pk2(Oacc[0][1], Oacc[0][0]);
        const int tidm = tid ^ 48;
        stash[tidm * 2] = s0; stash[tidm * 2 + 1] = s1;
    }
    if (MODE == 2) {
        float fo[16]; { float t8[8]; unpack8(st0, t8);
#pragma unroll
            for (int j = 0; j < 8; ++j) fo[j] = t8[j]; unpack8(st1, t8);
#pragma unroll
            for (int j = 0; j < 8; ++j) fo[8 + j] = t8[j]; }
        LAS float* ssw = (LAS float*)(lds + GL_SSW);
#pragma unroll
        for (int i2 = 0; i2 < 4; ++i2)
#pragma unroll
            for (int r = 0; r < 4; ++r) {
                const float o = Oacc[i2][r] + fo[4 * i2 + r]; Oacc[i2][r] = o;
                float v = o * o; v += dpp_f<0x128>(v); v += dpp_f<0x124>(v); v += dpp_f<0x122>(v); v += dpp_f<0x121>(v);
                if (n == 0) ssw[w * 64 + 16 * i2 + 4 * g + r] = v;
            }
        __syncthreads();
        if (tid < 64) { float s = 0.f;
#pragma unroll
            for (int ww = 0; ww < 8; ++ww) s += ssw[ww * 64 + tid];
            ((LAS float*)(lds + GL_RSTD))[tid] = rsqrtf(s * (1.0f / 128.0f) + NORM_EPS); }
        __syncthreads();
        const float gn = a.ng[16 * w + n];
#pragma unroll
        for (int i2 = 0; i2 < 4; ++i2) {
            const f32x4 rs = *(const LAS f32x4*)(lds + GL_RSTD + (16 * i2 + 4 * g) * 4);
#pragma unroll
            for (int r = 0; r < 4; ++r) *(LAS bf16_t*)(lds + GL_QT + (16 * i2 + 4 * g + r) * 256 + (16 * w + n) * 2) = f2bf(Oacc[i2][r] * rs[r] * gn);
        }
        __syncthreads();
        bf16_t* ymix = (bf16_t*)((unsigned char*)a.out + 96 * MiB);
#pragma unroll
        for (int i = 0; i < 2; ++i) {
            const u32x4 ov = *(const LAS u32x4*)(lds + GL_QT + prow[i] * 256 + pch[i] * 16);
            float of[8], zf[8]; unpack8(ov, of); unpack8(zraw[i], zf);
            u32x4 yw;
#pragma unroll
            for (int j = 0; j < 4; ++j) yw[j] = pk2(of[2 * j] * silu(zf[2 * j]), of[2 * j + 1] * silu(zf[2 * j + 1]));
            *(u32x4*)(ymix + (size_t)ptok[i] * DM + h * 128 + pch[i] * 8) = yw;
        }
    }
}
__device__ __forceinline__ void build_gate_tables(const Args& a) {
    for (int e = blockIdx.x * NTHR + tid_now(); e < 8 * 512; e += gridDim.x * NTHR) {
        const int dh = e >> 9, tid = e & 511, dir = dh >> 2, h = dh & 3, lane = tid & 63, w = tid >> 6, n = lane & 15, g = lane >> 4, col = h * 128 + 16 * w + n;
        const float* wup = dir ? a.wub : a.wuf; const float* bias = dir ? a.bbw : a.bfw;
        u32x4 pw;
#pragma unroll
        for (int j = 0; j < 4; ++j) {
            const float v0 = wup[(8 * (g & 1) + 2 * j) * 512 + col], v1 = wup[(8 * (g & 1) + 2 * j + 1) * 512 + col];
            const float h0 = bf2f(f2bf(v0)), h1 = bf2f(f2bf(v1));
            pw[j] = g < 2 ? pk2(v0, v1) : pk2(v0 - h0, v1 - h1);
        }
        ((u32x4*)(a.ws + WS_GATE))[e] = pw;
        if (g == 0) ((float*)(a.ws + WS_GATE + 65536))[dh * 128 + 16 * w + n] = bias[col];
    }
}
__device__ __forceinline__ void phase_gla_pass1(const Args& a, LAS unsigned char* lds) {
    const int tid = tid_now(), w = tid >> 6, lane = tid & 63;
    unsigned char* ST = a.ws + WS_ST;
    GlaPre pre; int par = 0;
    { const int item = blockIdx.x; if (item < NSEG * 8) { const int dir = item & 1; gla_prefetch<0>(a, pre, tid, (item >> 3) * 256 + (dir ? 3 : 0) * 64, (item >> 1) & 3, dir, -1); } }
    for (int item = blockIdx.x; item < NSEG * 8; item += gridDim.x) {
        const int dir = item & 1, h = (item >> 1) & 3, seg = item >> 3;
        const int nitem = item + gridDim.x < NSEG * 8 ? item + gridDim.x : item;
        f32x4 Sacc[8];
#pragma unroll
        for (int kt = 0; kt < 8; ++kt) Sacc[kt] = (f32x4){0.f, 0.f, 0.f, 0.f};
        f32x4 lam = (f32x4){0.f, 0.f, 0.f, 0.f};
        for (int cc = 0; cc < 4; ++cc) {
            const int c = dir ? 3 - cc : cc;
            int ntb, nh, ndir;
            if (cc < 3) { ntb = seg * 256 + (dir ? c - 1 : c + 1) * 64; nh = h; ndir = dir; }
            else { ndir = nitem & 1; nh = (nitem >> 1) & 3; ntb = (nitem >> 3) * 256 + (ndir ? 3 : 0) * 64; }
            gla_chunk<0>(a, lds, seg * 256 + c * 64, h, dir, Sacc, lam, nullptr, pre, ntb, nh, ndir, false, par); par ^= 1;
        }
        u32x2* dst = (u32x2*)(ST + (size_t)item * 32768) + (size_t)w * 8 * 64 + lane;
#pragma unroll
        for (int kt = 0; kt < 8; ++kt) { u32x2 v; v.x = pk2(Sacc[kt][0], Sacc[kt][1]); v.y = pk2(Sacc[kt][2], Sacc[kt][3]); dst[kt * 64] = v; }
        if ((lane & 15) == 0) *(f32x4*)((float*)(a.ws + WS_DEC) + (size_t)item * 128 + 16 * w + 4 * (lane >> 4)) = lam;
    }
    __syncthreads();
}
__device__ __forceinline__ void phase_gla_pass2(const Args& a) {
    unsigned char* ST = a.ws + WS_ST; const float* DEC = (const float*)(a.ws + WS_DEC);
    for (int gidx = blockIdx.x * NTHR + tid_now(); gidx < 48 * 4096; gidx += gridDim.x * NTHR) {
        const int chain = gidx >> 12, quad = gidx & 4095, dir = chain & 1, h = (chain >> 1) & 3, s = chain >> 3;
        const int nseg = s < 2 ? LP / 256 : LS / 256, seg0 = s < 2 ? s * (LP / 256) : 2 * (LP / 256) + (s - 2) * (LS / 256);
        const int kt = (quad >> 6) & 7, lane = quad & 63, dk0 = 16 * kt + 4 * (lane >> 4);
        f32x4 S = (f32x4){0.f, 0.f, 0.f, 0.f};
        for (int i0 = 0; i0 < nseg; i0 += 8) {
            u32x2 t[8]; f32x4 lm[8];
#pragma unroll
            for (int j = 0; j < 8; ++j) { const int seg = dir ? seg0 + nseg - 1 - (i0 + j) : seg0 + i0 + j; const size_t idx = (size_t)((seg * 4 + h) * 2 + dir);
                t[j] = ((const u32x2*)(ST + idx * 32768))[quad]; lm[j] = *(const f32x4*)(DEC + idx * 128 + dk0); }
#pragma unroll
            for (int j = 0; j < 8; ++j) { const int seg = dir ? seg0 + nseg - 1 - (i0 + j) : seg0 + i0 + j; const size_t idx = (size_t)((seg * 4 + h) * 2 + dir);
                u32x2 o; o.x = pk2(S[0], S[1]); o.y = pk2(S[2], S[3]); ((u32x2*)(ST + idx * 32768))[quad] = o;
                const f32x4 tv = (f32x4){__uint_as_float(t[j].x << 16), __uint_as_float(t[j].x & 0xffff0000u), __uint_as_float(t[j].y << 16), __uint_as_float(t[j].y & 0xffff0000u)};
                S = (f32x4){fexp(lm[j][0]), fexp(lm[j][1]), fexp(lm[j][2]), fexp(lm[j][3])} * S + tv; }
        }
    }
}
__device__ __forceinline__ void phase_gla_pass3(const Args& a, LAS unsigned char* lds) {
    const int tid = tid_now(), w = tid >> 6, lane = tid & 63;
    GlaPre pre; int par = 0;
    if (blockIdx.x < NSEG * 4) gla_prefetch<1>(a, pre, tid, (blockIdx.x >> 2) * 256, blockIdx.x & 3, 0, -1);
    for (int item = blockIdx.x; item < NSEG * 4; item += gridDim.x) {
        const int h = item & 3, seg = item >> 2;
        const int nitem = item + gridDim.x < NSEG * 4 ? item + gridDim.x : item;
        u32x4* stash = (u32x4*)a.out + (size_t)item * 4 * 1024;
#pragma unroll 1
        for (int dir = 0; dir < 2; ++dir) {
            f32x4 Sacc[8];
            const u32x2* src = (const u32x2*)(a.ws + WS_ST + (size_t)((seg * 4 + h) * 2 + dir) * 32768) + (size_t)w * 8 * 64 + lane;
#pragma unroll
            for (int kt = 0; kt < 8; ++kt) { const u32x2 v = src[kt * 64]; Sacc[kt] = (f32x4){__uint_as_float(v.x), __uint_as_float(v.y), 0.f, 0.f}; }
            f32x4 lam = (f32x4){0.f, 0.f, 0.f, 0.f};
            if (dir == 0) {
                for (int c = 0; c < 4; ++c) { const int ntb = seg * 256 + (c < 3 ? c + 1 : 3) * 64, ndir = c < 3 ? 0 : 1;
                    gla_chunk<1>(a, lds, seg * 256 + c * 64, h, 0, Sacc, lam, stash + c * 1024, pre, ntb, h, ndir, c == 0, par); par ^= 1; }
            } else {
                for (int c = 3; c >= 0; --c) { const int ntb = c > 0 ? seg * 256 + (c - 1) * 64 : (nitem >> 2) * 256, nh = c > 0 ? h : (nitem & 3), ndir = c > 0 ? 1 : 0;
                    gla_chunk<2>(a, lds, seg * 256 + c * 64, h, 1, Sacc, lam, stash + c * 1024, pre, ntb, nh, ndir, c == 3, par); par ^= 1; }
            }
        }
    }
    __syncthreads();
}
typedef float f32x16 __attribute__((ext_vector_type(16)));
#define MFMA32(a, b, c) __builtin_amdgcn_mfma_f32_32x32x16_bf16((a), (b), (c), 0, 0, 0)
constexpr int SW_K = 0, SW_V = 49152, SW_TB = 98304, SW_TBN = 336, SW_TBH = 4 * SW_TBN * 4;
constexpr float SW_NEG = -1e30f;
__device__ __forceinline__ unsigned offk(unsigned row, unsigned c8) { return 128u * row + 16u * (c8 ^ ((row >> 1) & 7)); }
__device__ __forceinline__ unsigned offv(unsigned row, unsigned c8) { return 128u * row + 16u * (c8 ^ (((row >> 1) & 1) << 2)); }
__device__ __forceinline__ void phase_swa(const Args& a, LAS unsigned char* lds) {
    const bf16_t* U = (const bf16_t*)(a.ws + WS_U); bf16_t* ymix = (bf16_t*)((unsigned char*)a.out + 96 * MiB);
    const int tid = tid_now(), lane = tid & 63, w = __builtin_amdgcn_readfirstlane(tid >> 6), r = lane & 31, hh = lane >> 5;
    const unsigned lb = (unsigned)(size_t)lds;
    for (int item = blockIdx.x; item < (NTOK / 128) * 2; item += gridDim.x) {
        const int kvh = item & 1, tok0 = (item >> 1) * 128; int s0, L; seq_of(tok0, s0, L);
        const bool first = tok0 == s0, last = tok0 + 128 == s0 + L;
        __syncthreads();
#pragma unroll
        for (int i = 0; i < 6; ++i) {
            const int idx = tid + 512 * i, row = idx >> 3, c8 = idx & 7, kpos = tok0 - 128 + row;
            u32x4 kk = (u32x4){0, 0, 0, 0}, vv = (u32x4){0, 0, 0, 0};
            if (kpos >= s0 && kpos < s0 + L) { const bf16_t* ur = U + (size_t)kpos * UP + kvh * 64 + c8 * 8; kk = *(const u32x4*)(ur + C_KB); vv = *(const u32x4*)(ur + C_VB); }
            *(LAS u32x4*)(lds + SW_K + offk(row, c8)) = kk; *(LAS u32x4*)(lds + SW_V + offv(row, c8)) = vv;
        }
        for (int e = tid; e < 4 * SW_TBN; e += NTHR) {
            const int hl = e / SW_TBN, idx = e - hl * SW_TBN, rel = idx - 160;
            const float val = (rel >= -128 && rel <= 128) ? a.relb[t5_bucket(rel) * 8 + kvh * 4 + hl] : SW_NEG;
            LAS float* tb = (LAS float*)(lds + SW_TB + hl * SW_TBH);
#pragma unroll
            for (int s = 0; s < 4; ++s) if (idx - s >= 0) tb[s * SW_TBN + idx - s] = val;
        }
        __syncthreads();
        const int hl = w >> 1, hq = kvh * 4 + hl;
        const float snk = a.sink[hq];
#pragma unroll 1
        for (int ss = 0; ss < 2; ++ss) {
            const int st = (w & 1) * 2 + ss, qtok = tok0 + 32 * st + r;
            bf16x8 Qf[4];
#pragma unroll
            for (int s = 0; s < 4; ++s) Qf[s] = *(const bf16x8*)(U + (size_t)qtok * UP + C_QB + hq * 64 + 16 * s + 8 * hh);
            float m = snk, l = hh == 0 ? 1.0f : 0.0f;
            f32x16 O[2];
#pragma unroll
            for (int i = 0; i < 16; ++i) { O[0][i] = 0.f; O[1][i] = 0.f; }
            const int sft = (-r) & 3;
            const unsigned tbase = SW_TB + hl * SW_TBH + sft * (SW_TBN * 4) + 4 * (32 + 4 * hh - r - sft);
            const unsigned kb0 = SW_K + 128u * r + 16u * (hh ^ ((r >> 1) & 7)) + 4096u * st;
            const int q4 = (lane & 15) >> 2, p4 = lane & 3, g1 = (lane >> 4) & 1, xq = (q4 >> 1) & 1;
            const unsigned vb0 = SW_V + 128u * (4 * hh + q4) + 16u * ((4 * xq) | (2 * g1) | (p4 >> 1)) + 8u * (p4 & 1) + 4096u * st;
#pragma unroll 1
            for (int grp = 0; grp < 3; ++grp) {
                f32x16 S[3];
#pragma unroll
                for (int k3 = 0; k3 < 3; ++k3) {
                    const int kk = 3 * grp + k3, blk = (st + kk) >> 2;
                    const bool valid = !((blk == 0 && first) || (blk == 2 && last));
                    if (valid) {
#pragma unroll
                        for (int i = 0; i < 16; ++i) S[k3][i] = 0.f;
#pragma unroll
                        for (int s = 0; s < 4; ++s) { const bf16x8 Kf = *(const LAS bf16x8*)(lds + (kb0 ^ (32u * s)) + 4096u * kk); S[k3] = MFMA32(Kf, Qf[s], S[k3]); }
#pragma unroll
                        for (int i4 = 0; i4 < 4; ++i4) { const f32x4 bv = *(const LAS f32x4*)(lds + tbase + 4 * (32 * kk + 8 * i4));
#pragma unroll
                            for (int j = 0; j < 4; ++j) S[k3][4 * i4 + j] += bv[j]; }
                    } else {
#pragma unroll
                        for (int i = 0; i < 16; ++i) S[k3][i] = SW_NEG;
                    }
                }
                float mx = SW_NEG;
#pragma unroll
                for (int k3 = 0; k3 < 3; ++k3)
#pragma unroll
                    for (int i = 0; i < 16; ++i) mx = fmaxf(mx, S[k3][i]);
                mx = fmaxf(mx, __shfl_xor(mx, 32));
                const float mn = fmaxf(m, mx), alpha = fexp(m - mn);
                m = mn; l *= alpha;
#pragma unroll
                for (int i = 0; i < 16; ++i) { O[0][i] *= alpha; O[1][i] *= alpha; }
                bf16x8 Pf[3][2];
#pragma unroll
                for (int k3 = 0; k3 < 3; ++k3) {
#pragma unroll
                    for (int i = 0; i < 16; ++i) { const float pv = fexp(S[k3][i] - m); S[k3][i] = pv; l += pv; }
#pragma unroll
                    for (int s2 = 0; s2 < 2; ++s2) {
                        u32x4 pw;
#pragma unroll
                        for (int j = 0; j < 4; ++j) pw[j] = pk2(S[k3][8 * s2 + 2 * j], S[k3][8 * s2 + 2 * j + 1]);
                        Pf[k3][s2] = __builtin_bit_cast(bf16x8, pw);
                    }
                }
#pragma unroll
                for (int k3 = 0; k3 < 3; ++k3) {
                    const int kk = 3 * grp + k3;
#pragma unroll
                    for (int s2 = 0; s2 < 2; ++s2)
#pragma unroll
                        for (int dt = 0; dt < 2; ++dt) {
                            const unsigned va = (vb0 ^ (64u * dt)) + 4096u * kk + 2048u * s2;
                            const bf16x8 Vf = tr_read8(lds, va, va + 1024u);
                            O[dt] = MFMA32(Vf, Pf[k3][s2], O[dt]);
                        }
                }
            }
            l += __shfl_xor(l, 32);
            const float inv = __builtin_amdgcn_rcpf(l);
#pragma unroll
            for (int dt = 0; dt < 2; ++dt)
#pragma unroll
                for (int i4 = 0; i4 < 4; ++i4) {
                    const int d0 = 32 * dt + 8 * i4 + 4 * hh;
                    const u32x2 zv = *(const u32x2*)(U + (size_t)qtok * UP + C_ZB + hq * 64 + d0);
                    const float z0 = __uint_as_float(zv.x << 16), z1 = __uint_as_float(zv.x & 0xffff0000u), z2 = __uint_as_float(zv.y << 16), z3 = __uint_as_float(zv.y & 0xffff0000u);
                    u32x2 yw; yw.x = pk2(O[dt][4 * i4] * inv * silu(z0), O[dt][4 * i4 + 1] * inv * silu(z1)); yw.y = pk2(O[dt][4 * i4 + 2] * inv * silu(z2), O[dt][4 * i4 + 3] * inv * silu(z3));
                    *(u32x2*)(ymix + (size_t)qtok * DM + 512 + hq * 64 + d0) = yw;
                }
        }
    }
}

__device__ __forceinline__ void phase_convfix(const Args& a) {
    bf16_t* G = (bf16_t*)(a.ws + WS_XB); const float* Pb = (const float*)(a.ws + WS_PB); const float* Sb = (const float*)(a.ws + WS_SB);
    for (int idx = blockIdx.x * NTHR + tid_now(); idx < (NTOK / 64 - 1) * 256; idx += gridDim.x * NTHR) {
        const int k = idx / 256 + 1, c = (idx & 255) * 4, row = 64 * k; int s0, L; seq_of(row, s0, L);
        if (row == s0) continue;
        const f32x4 pl = *(const f32x4*)(Pb + (size_t)((k - 1) * 2 + 1) * 1024 + c), sl = *(const f32x4*)(Sb + (size_t)((k - 1) * 2 + 1) * 1024 + c);
        const f32x4 pf = *(const f32x4*)(Pb + (size_t)(k * 2) * 1024 + c), sf = *(const f32x4*)(Sb + (size_t)(k * 2) * 1024 + c);
        const f32x4 c0 = *(const f32x4*)(a.cw + c), c2 = *(const f32x4*)(a.cw + 2048 + c);
        u32x2* gl = (u32x2*)(G + (size_t)(row - 1) * DM + c); u32x2* gf = (u32x2*)(G + (size_t)row * DM + c);
        const u32x2 a0 = *gl, a1 = *gf;
        const f32x4 dl = sl * c2 * pf, df = sf * c0 * pl;
        u32x2 o0, o1;
        o0.x = pk2(__uint_as_float(a0.x << 16) + dl[0], __uint_as_float(a0.x & 0xffff0000u) + dl[1]); o0.y = pk2(__uint_as_float(a0.y << 16) + dl[2], __uint_as_float(a0.y & 0xffff0000u) + dl[3]);
        o1.x = pk2(__uint_as_float(a1.x << 16) + df[0], __uint_as_float(a1.x & 0xffff0000u) + df[1]); o1.y = pk2(__uint_as_float(a1.y << 16) + df[2], __uint_as_float(a1.y & 0xffff0000u) + df[3]);
        *gl = o0; *gf = o1;
    }
}
__global__ void __launch_bounds__(NTHR, 2) mega(Args a) {
    LAS unsigned char* lds = (LAS unsigned char*)lds_raw;
    volatile LAS unsigned* MISC = (volatile LAS unsigned*)(lds + MISC_OFF);
    if (threadIdx.x < 32) MISC[threadIdx.x] = 0u;
    if ((threadIdx.x & 63) == 0) ((volatile LAS unsigned*)(lds + SLOT_OFF))[hw_slot()] = threadIdx.x >> 6;
    __syncthreads();
    unsigned char* ws = a.ws; float* out = a.out;
    XcdBarrier bar = xcd_barrier_post((unsigned*)(ws + WS_CTL) + 4096, MISC + 8);
    bf16_t* W1t = (bf16_t*)(ws + WS_W1T); bf16_t* W2t = (bf16_t*)(ws + WS_W2T); bf16_t* W3t = (bf16_t*)(ws + WS_W3T); bf16_t* W4t = (bf16_t*)(ws + WS_W4T);
    bf16_t* xb = (bf16_t*)(ws + WS_XB); bf16_t* ymix = (bf16_t*)((unsigned char*)out + 96 * MiB); bf16_t* G = xb; bf16_t* U = (bf16_t*)(ws + WS_U);
    bf16_t* x1b = (bf16_t*)(ws + WS_X1B); bf16_t* P = (bf16_t*)(ws + WS_P); bf16_t* Sg = (bf16_t*)(ws + WS_S);
    f32x2* stat1 = (f32x2*)(ws + WS_STAT1); f32x2* stat2 = (f32x2*)(ws + WS_STAT2); f32x2* mr1 = (f32x2*)(ws + WS_MR1);

    phase_convert(a, lds);
    xcd_barrier(bar);
    { pg8::Gemm g{xb, W1t, NTOK, UP, DM, 0}; pg8::StaticOrder S; S.init(NTOK, UP, gridDim.x, blockIdx.x); EpiU E{U}; pg8::gemm_phase<EpiU, pg8::StaticOrder>(lds, g, S, E); }
    xcd_barrier(bar);
    phase_gla_pass1(a, lds);
    xcd_barrier(bar);
    phase_gla_pass2(a);
    phase_swa(a, lds);
    xcd_barrier(bar);
    phase_gla_pass3(a, lds);
    xcd_barrier(bar);
    { pg8::Gemm g{ymix, W2t, NTOK, DM, DM, 0}; pg8::StaticOrder S; S.init(NTOK, DM, gridDim.x, blockIdx.x);
      EpiLN<0> E{ws, nullptr, a.lng, a.lnb}; pg8::gemm_phase<EpiLN<0>, pg8::StaticOrder>(lds, g, S, E); }
    xcd_barrier(bar);
    { pg8::Gemm g{x1b, W3t, NTOK, 4096, DM, 0}; pg8::StaticOrder S; S.init(NTOK, 4096, gridDim.x, blockIdx.x); EpiG E{ws, a.cw}; pg8::gemm_phase<EpiG, pg8::StaticOrder>(lds, g, S, E); }
    xcd_barrier(bar);
    phase_convfix(a);
    xcd_barrier(bar);
    { pg8::Gemm g{G, W4t, NTOK, DM, DM, 0}; pg8::StaticOrder S; S.init(NTOK, DM, gridDim.x, blockIdx.x);
      EpiLN<1> E{ws, out, a.lng + DM, a.lnb + DM}; pg8::gemm_phase<EpiLN<1>, pg8::StaticOrder>(lds, g, S, E); }
}

extern "C" void kernel_launch(void* const* d_in, const int* in_sizes, int n_in, void* d_out, int out_size, void* d_ws, size_t ws_size, hipStream_t stream) {
    static int grid = 0;
    if (grid == 0) {
        if (n_in != 16 || out_size != NTOK * DM || ws_size < WS_END) { fprintf(stderr, "kernel_launch: unexpected shapes (n_in %d out %d ws %zu)\n", n_in, out_size, ws_size); grid = -1; return; }
        int dev = 0, cus = 0, per_cu = 0;
        if (hipGetDevice(&dev) != hipSuccess || hipDeviceGetAttribute(&cus, hipDeviceAttributeMultiprocessorCount, dev) != hipSuccess) { grid = -1; return; }
        if (hipFuncSetAttribute((const void*)mega, hipFuncAttributeMaxDynamicSharedMemorySize, LDS_BYTES) != hipSuccess) { fprintf(stderr, "kernel_launch: hipFuncSetAttribute failed\n"); grid = -1; return; }
        if (hipOccupancyMaxActiveBlocksPerMultiprocessor(&per_cu, (const void*)mega, NTHR, LDS_BYTES) != hipSuccess || per_cu < 1) { fprintf(stderr, "kernel_launch: occupancy query says %d blocks per CU\n", per_cu); (void)hipGetLastError(); grid = -1; return; }
        grid = cus;
    }
    if (grid < 0) return;
    (void)hipMemsetAsync((char*)d_ws + WS_CTL, 0, 262144, stream);
    Args a{};
    a.xp = (const float*)d_in[0]; a.xs = (const float*)d_in[1]; a.w_in_even = (const float*)d_in[2]; a.wuf = (const float*)d_in[3]; a.bfw = (const float*)d_in[4];
    a.wub = (const float*)d_in[5]; a.bbw = (const float*)d_in[6]; a.ng = (const float*)d_in[7]; a.sink = (const float*)d_in[8]; a.relb = (const float*)d_in[9];
    a.w_out_even = (const float*)d_in[10]; a.w_in_odd = (const float*)d_in[11]; a.cw = (const float*)d_in[12]; a.w_out_odd = (const float*)d_in[13];
    a.lng = (const float*)d_in[14]; a.lnb = (const float*)d_in[15]; a.out = (float*)d_out; a.ws = (unsigned char*)d_ws;
    hipLaunchKernelGGL(mega, dim3(grid), dim3(NTHR), LDS_BYTES, stream, a);
}
```

```cpp
#include <hip/hip_runtime.h>
#include <cstdio>

typedef unsigned short bf16_t;
typedef short bf16x8 __attribute__((ext_vector_type(8)));
typedef float f32x4 __attribute__((ext_vector_type(4)));
typedef float f32x2 __attribute__((ext_vector_type(2)));
typedef unsigned u32x4 __attribute__((ext_vector_type(4)));
typedef unsigned u32x2 __attribute__((ext_vector_type(2)));
#define LAS __attribute__((address_space(3)))
#define MFMA16(a, b, c) __builtin_amdgcn_mfma_f32_16x16x32_bf16((a), (b), (c), 0, 0, 0)
extern __shared__ __attribute__((aligned(16))) unsigned char lds_raw[];
constexpr int SLOT_OFF = 131072 + 512;
__device__ __forceinline__ unsigned hw_slot() { return (unsigned)__builtin_amdgcn_s_getreg((5 << 11) | 4) & 63u; }
__device__ __forceinline__ int tid_now() {
    const int wid = __builtin_amdgcn_readfirstlane((int)((volatile LAS unsigned*)((LAS unsigned char*)lds_raw + SLOT_OFF))[hw_slot()]);
    return wid * 64 + (int)__lane_id();
}

constexpr int DM = 1024, NTOK = 49152, NPROMPT = 32768, LP = 16384, LS = 4096;
constexpr int UP = 3584;
constexpr int C_QA = 0, C_KA = 512, C_VA = 1024, C_ZA = 1536, C_QB = 2048, C_KB = 2560, C_VB = 2688, C_ZB = 2816, C_GD = 3328;
constexpr int EVEN_IN = 3360, ODD_IN = 4096;
constexpr float DN_ALPHA = 1.41421356237309515f;
constexpr float LN_EPS = 1e-5f, NORM_EPS = 1e-6f;

constexpr size_t MiB = 1u << 20;
constexpr size_t WS_CTL = 0, WS_W1T = 1 * MiB, WS_W2T = 8 * MiB, WS_W3T = 10 * MiB, WS_W4T = 18 * MiB, WS_STAT1 = 20 * MiB, WS_MR1 = 26 * MiB, WS_DEC = 27 * MiB, WS_GATE = 27 * MiB + 768 * 1024,
                 WS_XB = 28 * MiB  , WS_U = 124 * MiB, WS_ST = 460 * MiB, WS_END = 508 * MiB;
constexpr size_t WS_X1B = WS_U, WS_P = WS_U + 96 * MiB, WS_S = WS_U + 192 * MiB, WS_STAT2 = WS_U + 288 * MiB, WS_PB = WS_U + 296 * MiB, WS_SB = WS_U + 304 * MiB;

__device__ __forceinline__ float bf2f(bf16_t b) { return __uint_as_float(((unsigned)b) << 16); }
typedef __bf16 nbf16x2 __attribute__((ext_vector_type(2)));
__device__ __forceinline__ bf16_t f2bf(float f) { return __builtin_bit_cast(bf16_t, (__bf16)f); }
__device__ __forceinline__ unsigned pk2(float lo, float hi) { return __builtin_bit_cast(unsigned, __builtin_convertvector((f32x2){lo, hi}, nbf16x2)); }
__device__ __forceinline__ float fexp2(float x) { return __builtin_amdgcn_exp2f(x); }
__device__ __forceinline__ float fexp(float x) { return __builtin_amdgcn_exp2f(x * 1.4426950408889634f); }
__device__ __forceinline__ float flog2(float x) { return __builtin_amdgcn_logf(x); }
__device__ __forceinline__ float silu(float x) { return x * __builtin_amdgcn_rcpf(1.0f + fexp(-x)); }
__device__ __forceinline__ float wave_sum(float v) {
#pragma unroll
    for (int o = 1; o < 64; o <<= 1) v += __shfl_xor(v, o);
    return v;
}
__device__ __forceinline__ float wave_max(float v) {
#pragma unroll
    for (int o = 1; o < 64; o <<= 1) v = fmaxf(v, __shfl_xor(v, o));
    return v;
}
__device__ __forceinline__ void seq_of(int row, int& s0, int& L) {
    if (row < NPROMPT) { L = LP; s0 = row & ~(LP - 1); } else { L = LS; s0 = NPROMPT + ((row - NPROMPT) & ~(LS - 1)); }
}

namespace pg8 {
constexpr int BM = 256, BK = 64, HALF = 128, HTB = HALF * BK * 2, STAGE_BYTES = 8 * HTB, NXCD = 8, WGM = 8;
__host__ __device__ __forceinline__ int lds_byte(int r, int c) { const int st = (r >> 4) * 2 + (c >> 5), rr = r & 15, cc = c & 31, ob = rr * 64 + cc * 2; return st * 1024 + (ob ^ (((ob >> 9) & 1) << 5)); }
__host__ __device__ __forceinline__ void stage_rc(int b, int& R, int& C) { const int st = b / 1024, sb = b % 1024, swz = sb ^ (((sb >> 9) & 1) << 5); R = (st >> 1) * 16 + swz / 64; C = (st & 1) * 32 + (swz % 64) / 2; }
__host__ __device__ __forceinline__ int perm32(int rho) { const int n = rho >> 4, i = rho & 15; return 8 * (i >> 2) + 4 * n + (i & 3); }
struct Unit { int pm, pn; };
struct Gemm { const bf16_t* A; const bf16_t* Bt; int M, N, K, pad; };
struct StaticOrder {
    int nM, nN, nwg, G, c;
    __host__ __device__ void init(int M, int N, int G_, int c_) { nM = M / BM; nN = N / BM; nwg = nM * nN; G = G_; c = c_; }
    __host__ __device__ bool next(int i, Unit& u) const {
        const long L = (long)i * G + c; if (L >= nwg) return false;
        int wgid = (int)L; { const int q = nwg / NXCD, r = nwg % NXCD, xcd = wgid % NXCD, off = wgid / NXCD; wgid = (xcd < r ? xcd * (q + 1) : r * (q + 1) + (xcd - r) * q) + off; }
        const int nig = WGM * nN, gid = wgid / nig, fm = gid * WGM, gsz = (nM - fm) < WGM ? (nM - fm) : WGM;
        u.pm = fm + ((wgid % nig) % gsz); u.pn = (wgid % nig) / gsz; return true;
    }
    __device__ __forceinline__ void a_ready(const Unit&) const {}
    __device__ __forceinline__ void done(const Unit&) const {}
};

template <class Epi, class Sched>
__device__ __forceinline__ void gemm_phase(LAS unsigned char* lds, const Gemm g, const Sched& S, const Epi& E) {
    int tid = tid_now(); asm volatile("" : "+v"(tid));
    const int wid = __builtin_amdgcn_readfirstlane(tid >> 6), lane = tid & 63, wr = wid >> 2, wc = wid & 3, fr = lane & 15, fq = lane >> 4;
    const int K = g.K, nt = K / BK;
    unsigned voffA[2], voffB[2];
#pragma unroll
    for (int i = 0; i < 2; ++i) { int R, C; stage_rc(tid * 16 + i * 8192, R, C); const int Rb = Epi::PERM ? ((R & ~31) + perm32(R & 31)) : R;
        voffA[i] = (unsigned)(R * K + C) * 2u; voffB[i] = (unsigned)(Rb * K + C) * 2u; }
    const size_t kstep = (size_t)(BK * 2);
    const size_t hstep = (size_t)HALF * K * 2;
    const size_t tstep = 2 * hstep;
    const unsigned ldsw = (unsigned)wid * 1024u;
    const int aoff = lds_byte(wr * 64 + fr, fq * 8), boff = lds_byte(wc * 32 + fr, fq * 8);
#define PG8_SA(b, h) (((b) * 2 + (h)) * HTB)
#define PG8_SB(b, h) ((4 + (b) * 2 + (h)) * HTB)
#define PG8_STAGE(bufoff, gbase, voff) do { _Pragma("unroll") for (int _i = 0; _i < 2; ++_i) \
        __builtin_amdgcn_global_load_lds((const unsigned*)((const char*)(gbase) + (voff)[_i]), (LAS unsigned*)(lds + (bufoff) + ldsw + _i * 8192), 16, 0, 0); } while (0)
#define PG8_LDA(dst, b, h) do { _Pragma("unroll") for (int m = 0; m < 4; ++m) _Pragma("unroll") for (int k = 0; k < 2; ++k) dst[m][k] = *(const LAS bf16x8*)(lds + PG8_SA(b, h) + aoff + m * 2048 + k * 1024); } while (0)
#define PG8_LDB(dst, b, h) do { _Pragma("unroll") for (int n = 0; n < 2; ++n) _Pragma("unroll") for (int k = 0; k < 2; ++k) dst[n][k] = *(const LAS bf16x8*)(lds + PG8_SB(b, h) + boff + n * 2048 + k * 1024); } while (0)
#define PG8_MMA(ai, bj, At, Bt) do { __builtin_amdgcn_s_setprio(1); _Pragma("unroll") for (int m = 0; m < 4; ++m) _Pragma("unroll") for (int n = 0; n < 2; ++n) _Pragma("unroll") for (int k = 0; k < 2; ++k) \
        acc[ai][bj][m][n] = __builtin_amdgcn_mfma_f32_16x16x32_bf16(Bt[n][k], At[m][k], acc[ai][bj][m][n], 0, 0, 0); __builtin_amdgcn_s_setprio(0); } while (0)
#define PG8_WAIT_V(n) asm volatile("s_waitcnt vmcnt(" #n ")" ::: "memory")
#define PG8_WAIT_L(n) asm volatile("s_waitcnt lgkmcnt(" #n ")" ::: "memory")
#define PG8_BAR __builtin_amdgcn_s_barrier()
#define PG8_SCHED __builtin_amdgcn_sched_barrier(0)
    Unit cur, nxt; int ui = 0;
    if (!S.next(0, cur)) return;
    f32x4 acc[2][2][4][2];
#pragma unroll
    for (int a = 0; a < 2; ++a)
#pragma unroll
        for (int b = 0; b < 2; ++b)
#pragma unroll
            for (int m = 0; m < 4; ++m)
#pragma unroll
                for (int n = 0; n < 2; ++n) acc[a][b][m][n] = (f32x4){0.f, 0.f, 0.f, 0.f};
    bf16x8 At[4][2], B0[2][2], B1[2][2];
    const char* cA = (const char*)g.A + (size_t)cur.pm * tstep; const char* cB = (const char*)g.Bt + (size_t)cur.pn * tstep;
    S.a_ready(cur);
    PG8_STAGE(PG8_SB(0, 0), cB, voffB); PG8_STAGE(PG8_SA(0, 0), cA, voffA); PG8_STAGE(PG8_SB(0, 1), cB + hstep, voffB); PG8_STAGE(PG8_SA(0, 1), cA + hstep, voffA);
    if (wr == 1) PG8_BAR;
    PG8_WAIT_V(4); PG8_BAR;
    PG8_STAGE(PG8_SB(1, 0), cB + kstep, voffB); PG8_STAGE(PG8_SA(1, 0), cA + kstep, voffA); PG8_STAGE(PG8_SB(1, 1), cB + hstep + kstep, voffB);
    PG8_WAIT_V(6); PG8_BAR;
    for (;;) {
        const bool has_next = S.next(ui + 1, nxt);
        const char* nA = has_next ? (const char*)g.A + (size_t)nxt.pm * tstep : cA; const char* nB = has_next ? (const char*)g.Bt + (size_t)nxt.pn * tstep : cB;
        for (int t = 0; t < nt; t += 2) {
            const bool last = (t == nt - 2);
            const char* a1 = cA + (size_t)(t + 1) * kstep;
            const char* a2 = last ? nA : cA + (size_t)(t + 2) * kstep; const char* b2 = last ? nB : cB + (size_t)(t + 2) * kstep;
            const char* a3 = a2 + kstep; const char* b3 = b2 + kstep;
            if (last && has_next) S.a_ready(nxt);
            PG8_LDB(B0, 0, 0); PG8_SCHED; PG8_LDA(At, 0, 0); PG8_STAGE(PG8_SA(1, 1), a1 + hstep, voffA);
            PG8_WAIT_L(8); PG8_BAR; PG8_WAIT_L(0); PG8_MMA(0, 0, At, B0); PG8_BAR; PG8_SCHED;
            PG8_LDB(B1, 0, 1); PG8_STAGE(PG8_SB(0, 0), b2, voffB);
            PG8_BAR; PG8_WAIT_L(0); PG8_MMA(0, 1, At, B1); PG8_BAR;
            PG8_LDA(At, 0, 1); PG8_STAGE(PG8_SA(0, 0), a2, voffA);
            PG8_BAR; PG8_WAIT_L(0); PG8_MMA(1, 0, At, B0); PG8_BAR; PG8_SCHED;
            PG8_STAGE(PG8_SB(0, 1), b2 + hstep, voffB);
            PG8_WAIT_V(6); PG8_BAR; PG8_MMA(1, 1, At, B1); PG8_BAR;
            PG8_LDB(B0, 1, 0); PG8_SCHED; PG8_LDA(At, 1, 0); PG8_STAGE(PG8_SA(0, 1), a2 + hstep, voffA);
            PG8_WAIT_L(8); PG8_BAR; PG8_WAIT_L(0); PG8_MMA(0, 0, At, B0); PG8_BAR; PG8_SCHED;
            PG8_LDB(B1, 1, 1); PG8_STAGE(PG8_SB(1, 0), b3, voffB);
            PG8_BAR; PG8_WAIT_L(0); PG8_MMA(0, 1, At, B1); PG8_BAR;
            PG8_LDA(At, 1, 1); PG8_STAGE(PG8_SA(1, 0), a3, voffA);
            PG8_BAR; PG8_WAIT_L(0); PG8_MMA(1, 0, At, B0); PG8_BAR; PG8_SCHED;
            PG8_STAGE(PG8_SB(1, 1), b3 + hstep, voffB);
            PG8_WAIT_V(6); PG8_BAR; PG8_MMA(1, 1, At, B1); PG8_BAR;
        }
        if constexpr (Epi::REALIGN) { if (wr == 0) PG8_BAR; }
        E(acc, cur, wr, wc, fr, fq); S.done(cur);
        if constexpr (Epi::REALIGN) { if (wr == 1) PG8_BAR; }
        if (!has_next) break;
#pragma unroll
        for (int a = 0; a < 2; ++a)
#pragma unroll
            for (int b = 0; b < 2; ++b)
#pragma unroll
                for (int m = 0; m < 4; ++m)
#pragma unroll
                    for (int n = 0; n < 2; ++n) acc[a][b][m][n] = (f32x4){0.f, 0.f, 0.f, 0.f};
        cur = nxt; cA = nA; cB = nB; ++ui;
    }
    PG8_WAIT_V(0);
    if (wr == 0) PG8_BAR;
    PG8_BAR;
#undef PG8_SA
#undef PG8_SB
#undef PG8_STAGE
#undef PG8_LDA
#undef PG8_LDB
#undef PG8_MMA
#undef PG8_WAIT_V
#undef PG8_WAIT_L
#undef PG8_BAR
#undef PG8_SCHED
}
}

struct EpiU {
    static constexpr bool PERM = true, AFTER_DRAIN = false, REALIGN = false;
    bf16_t* O;
    __device__ __forceinline__ void operator()(const f32x4 (&acc)[2][2][4][2], const pg8::Unit& u, int wr, int wc, int fr, int fq) const {
        const int row0 = u.pm * 256 + wr * 64 + fr, col0 = u.pn * 256 + wc * 32 + 8 * fq;
#pragma unroll
        for (int ai = 0; ai < 2; ++ai)
#pragma unroll
            for (int m = 0; m < 4; ++m) { bf16_t* rowp = O + (size_t)(row0 + ai * 128 + m * 16) * UP + col0;
#pragma unroll
                for (int bj = 0; bj < 2; ++bj) { const f32x4 v0 = acc[ai][bj][m][0], v1 = acc[ai][bj][m][1];
                    u32x4 w; w.x = pk2(v0[0], v0[1]); w.y = pk2(v0[2], v0[3]); w.z = pk2(v1[0], v1[1]); w.w = pk2(v1[2], v1[3]);
                    *(u32x4*)(rowp + bj * 128) = w; } }
    }
};
template <int LAYER> struct EpiY {
    static constexpr bool PERM = false, AFTER_DRAIN = false, REALIGN = false;
    const float* xp; const float* xs; float* Y; f32x2* stat; const f32x2* mr; const float* lg; const float* lb;
    __device__ __forceinline__ void operator()(const f32x4 (&acc)[2][2][4][2], const pg8::Unit& u, int wr, int wc, int fr, int fq) const {
        const int col0 = u.pn * 256 + wc * 32 + 4 * fq;
        f32x4 gv[2][2], bv[2][2];
        if (LAYER == 1) {
#pragma unroll
            for (int bj = 0; bj < 2; ++bj)
#pragma unroll
                for (int n = 0; n < 2; ++n) { gv[bj][n] = *(const f32x4*)(lg + col0 + bj * 128 + n * 16); bv[bj][n] = *(const f32x4*)(lb + col0 + bj * 128 + n * 16); }
        }
#pragma unroll
        for (int ai = 0; ai < 2; ++ai)
#pragma unroll
            for (int m = 0; m < 4; ++m) {
                const int row = u.pm * 256 + ai * 128 + wr * 64 + m * 16 + fr;
                const float* rp; f32x2 mrv = (f32x2){0.f, 1.f};
                if (LAYER == 0) rp = (row < NPROMPT) ? xp + (size_t)row * DM : xs + (size_t)(row - NPROMPT) * DM;
                else { rp = Y + (size_t)row * DM; mrv = mr[row]; }
                float* yp = Y + (size_t)row * DM;
                float s = 0.f, q = 0.f;
#pragma unroll
                for (int bj = 0; bj < 2; ++bj)
#pragma unroll
                    for (int n = 0; n < 2; ++n) {
                        const int c = col0 + bj * 128 + n * 16;
                        f32x4 r = *(const f32x4*)(rp + c);
                        if (LAYER == 1) r = (r - mrv.x) * mrv.y * gv[bj][n] + bv[bj][n];
                        const f32x4 y = r * DN_ALPHA + acc[ai][bj][m][n];
                        *(f32x4*)(yp + c) = y;
                        s += (y[0] + y[1]) + (y[2] + y[3]); q += (y[0] * y[0] + y[1] * y[1]) + (y[2] * y[2] + y[3] * y[3]);
                    }
                s += __shfl_xor(s, 16); s += __shfl_xor(s, 32); q += __shfl_xor(q, 16); q += __shfl_xor(q, 32);
                if (fq == 0) stat[(size_t)row * 16 + u.pn * 4 + wc] = (f32x2){s, q};
            }
    }
};
#define RLX_AGENT __ATOMIC_RELAXED, __HIP_MEMORY_SCOPE_AGENT
template <int LAYER> struct EpiLN {
    static constexpr bool PERM = true, AFTER_DRAIN = false, REALIGN = true;
    unsigned char* ws; float* Of; const float* lg; const float* lb;
    __device__ __forceinline__ void operator()(f32x4 (&acc)[2][2][4][2], const pg8::Unit& u, int wr, int wc, int fr, int fq) const {
        unsigned char* w2 = ws; asm volatile("" : "+s"(w2));
        const bf16_t* R = (const bf16_t*)(w2 + (LAYER == 0 ? WS_XB : WS_X1B)); bf16_t* Ob = (bf16_t*)(w2 + WS_X1B);
        unsigned long long* xbuf = (unsigned long long*)(w2 + (LAYER == 0 ? WS_STAT1 : WS_STAT2)); unsigned* cnt = (unsigned*)(w2 + WS_CTL) + 16384 + LAYER * 192 * 64;
        const int col0 = u.pn * 256 + wc * 32 + 8 * fq, rowb = u.pm * 256 + wr * 64 + fr;
        float ps[2][4], pq[2][4];
#pragma unroll
        for (int ai = 0; ai < 2; ++ai)
#pragma unroll
            for (int m = 0; m < 4; ++m) {
                const bf16_t* rp = R + (size_t)(rowb + ai * 128 + m * 16) * DM + col0;
                float s = 0.f, q = 0.f;
#pragma unroll
                for (int bj = 0; bj < 2; ++bj) {
                    const u32x4 rw = *(const u32x4*)(rp + bj * 128);
                    f32x4 r0 = (f32x4){__uint_as_float(rw.x << 16), __uint_as_float(rw.x & 0xffff0000u), __uint_as_float(rw.y << 16), __uint_as_float(rw.y & 0xffff0000u)};
                    f32x4 r1 = (f32x4){__uint_as_float(rw.z << 16), __uint_as_float(rw.z & 0xffff0000u), __uint_as_float(rw.w << 16), __uint_as_float(rw.w & 0xffff0000u)};
                    const f32x4 v0 = r0 * DN_ALPHA + acc[ai][bj][m][0], v1 = r1 * DN_ALPHA + acc[ai][bj][m][1];
                    acc[ai][bj][m][0] = v0; acc[ai][bj][m][1] = v1;
                    s += ((v0[0] + v0[1]) + (v0[2] + v0[3])) + ((v1[0] + v1[1]) + (v1[2] + v1[3]));
                    q += ((v0[0] * v0[0] + v0[1] * v0[1]) + (v0[2] * v0[2] + v0[3] * v0[3])) + ((v1[0] * v1[0] + v1[1] * v1[1]) + (v1[2] * v1[2] + v1[3] * v1[3]));
                }
                s += __shfl_xor(s, 16); s += __shfl_xor(s, 32); q += __shfl_xor(q, 16); q += __shfl_xor(q, 32);
                ps[ai][m] = s; pq[ai][m] = q;
            }
        if (fq == 0) {
#pragma unroll
            for (int ai = 0; ai < 2; ++ai)
#pragma unroll
                for (int m = 0; m < 4; ++m)
                    __hip_atomic_store(xbuf + (size_t)(rowb + ai * 128 + m * 16) * 16 + u.pn * 4 + wc, ((unsigned long long)__float_as_uint(pq[ai][m]) << 32) | __float_as_uint(ps[ai][m]), RLX_AGENT);
        }
        asm volatile("s_waitcnt vmcnt(0)" ::: "memory");
        unsigned* c = cnt + 64 * u.pm;
        if ((tid_now() & 63) == 0) __hip_atomic_fetch_add(c, 1u, RLX_AGENT);
        { unsigned spins = 0;
          while ((unsigned)__builtin_amdgcn_readfirstlane(__hip_atomic_load(c, RLX_AGENT)) < 32u) { __builtin_amdgcn_s_sleep(2); if (++spins > (1u << 16)) break; }
          __builtin_amdgcn_fence(__ATOMIC_ACQUIRE, "agent"); }
#pragma unroll
        for (int ai = 0; ai < 2; ++ai)
#pragma unroll
            for (int m = 0; m < 4; ++m) {
                const unsigned long long* sp = xbuf + (size_t)(rowb + ai * 128 + m * 16) * 16 + 4 * fq;
                float s = 0.f, q = 0.f;
#pragma unroll
                for (int t = 0; t < 4; ++t) { const unsigned long long w8 = __hip_atomic_load(sp + t, RLX_AGENT); s += __uint_as_float((unsigned)w8); q += __uint_as_float((unsigned)(w8 >> 32)); }
                s += __shfl_xor(s, 16); s += __shfl_xor(s, 32); q += __shfl_xor(q, 16); q += __shfl_xor(q, 32);
                const float mean = s * (1.0f / DM), var = q * (1.0f / DM) - mean * mean;
                ps[ai][m] = mean; pq[ai][m] = rsqrtf(fmaxf(var, 0.f) + LN_EPS);
            }
#pragma unroll
        for (int bj = 0; bj < 2; ++bj) {
            const f32x4 g0 = *(const f32x4*)(lg + col0 + bj * 128), g1 = *(const f32x4*)(lg + col0 + bj * 128 + 4), b0 = *(const f32x4*)(lb + col0 + bj * 128), b1 = *(const f32x4*)(lb + col0 + bj * 128 + 4);
#pragma unroll
            for (int ai = 0; ai < 2; ++ai)
#pragma unroll
                for (int m = 0; m < 4; ++m) {
                    const int row = rowb + ai * 128 + m * 16; const float mean = ps[ai][m], rstd = pq[ai][m];
                    const f32x4 o0 = (acc[ai][bj][m][0] - mean) * rstd * g0 + b0, o1 = (acc[ai][bj][m][1] - mean) * rstd * g1 + b1;
                    if (LAYER == 0) { u32x4 w; w.x = pk2(o0[0], o0[1]); w.y = pk2(o0[2], o0[3]); w.z = pk2(o1[0], o1[1]); w.w = pk2(o1[2], o1[3]); *(u32x4*)(Ob + (size_t)row * DM + col0 + bj * 128) = w; }
                    else { float* op = Of + (size_t)row * DM + col0 + bj * 128; *(f32x4*)op = o0; *(f32x4*)(op + 4) = o1; }
                }
        }
    }
};
struct EpiPS {
    static constexpr bool PERM = true, AFTER_DRAIN = false, REALIGN = false;
    bf16_t* P; bf16_t* S;
    __device__ __forceinline__ void operator()(const f32x4 (&acc)[2][2][4][2], const pg8::Unit& u, int wr, int wc, int fr, int fq) const {
        const int row0 = u.pm * 256 + wr * 64 + fr, off = (wc & 1) * 32 + 8 * fq;
        bf16_t* dst = (wc < 2 ? S : P) + u.pn * 64 + off;
#pragma unroll
        for (int ai = 0; ai < 2; ++ai)
#pragma unroll
            for (int m = 0; m < 4; ++m) {
                float o[8];
#pragma unroll
                for (int n = 0; n < 2; ++n)
#pragma unroll
                    for (int j = 0; j < 4; ++j) { const float a = acc[ai][0][m][n][j], b = acc[ai][1][m][n][j];
                        o[4 * n + j] = (wc < 2) ? silu(b) * a : a * b; }
                u32x4 w; w.x = pk2(o[0], o[1]); w.y = pk2(o[2], o[3]); w.z = pk2(o[4], o[5]); w.w = pk2(o[6], o[7]);
                *(u32x4*)(dst + (size_t)(row0 + ai * 128 + m * 16) * DM) = w;
            }
    }
};

template <int CTRL> __device__ __forceinline__ float dpp_f(float x);
struct EpiG {
    static constexpr bool PERM = true, AFTER_DRAIN = false, REALIGN = false;
    unsigned char* ws; const float* cw;
    __device__ __forceinline__ void operator()(const f32x4 (&acc)[2][2][4][2], const pg8::Unit& u, int wr, int wc, int fr, int fq) const {
        unsigned char* w2 = ws; asm volatile("" : "+s"(w2));
        bf16_t* G = (bf16_t*)(w2 + WS_XB); float* Pb = (float*)(w2 + WS_PB); float* Sb = (float*)(w2 + WS_SB);
        const int ch0 = u.pn * 64 + 16 * wc + 4 * fq;
        const f32x4 c0 = *(const f32x4*)(cw + ch0), c1 = *(const f32x4*)(cw + 1024 + ch0), c2 = *(const f32x4*)(cw + 2048 + ch0);
#pragma unroll
        for (int ai = 0; ai < 2; ++ai) {
            f32x4 P[4], S[4];
#pragma unroll
            for (int m = 0; m < 4; ++m)
#pragma unroll
                for (int j = 0; j < 4; ++j) { P[m][j] = acc[ai][0][m][1][j] * acc[ai][1][m][1][j]; S[m][j] = silu(acc[ai][1][m][0][j]) * acc[ai][0][m][0][j]; }
            const int row0 = u.pm * 256 + ai * 128 + wr * 64 + fr;
#pragma unroll
            for (int m = 0; m < 4; ++m) {
                float o[4];
#pragma unroll
                for (int j = 0; j < 4; ++j) {
                    float pr = dpp_f<0x111>(P[m][j]);
                    if (m > 0) { const float t = dpp_f<0x121>(P[m - 1][j]); pr = fr == 0 ? t : pr; }
                    float nx = dpp_f<0x101>(P[m][j]);
                    if (m < 3) { const float t = dpp_f<0x12F>(P[m + 1][j]); nx = fr == 15 ? t : nx; }
                    o[j] = S[m][j] * (c0[j] * pr + c1[j] * P[m][j] + c2[j] * nx);
                }
                u32x2 w; w.x = pk2(o[0], o[1]); w.y = pk2(o[2], o[3]);
                *(u32x2*)(G + (size_t)(row0 + 16 * m) * DM + ch0) = w;
            }
            const int blk = u.pm * 4 + ai * 2 + wr;
            if (fr == 0) { *(f32x4*)(Pb + (size_t)(blk * 2) * 1024 + ch0) = P[0]; *(f32x4*)(Sb + (size_t)(blk * 2) * 1024 + ch0) = S[0]; }
            if (fr == 15) { *(f32x4*)(Pb + (size_t)(blk * 2 + 1) * 1024 + ch0) = P[3]; *(f32x4*)(Sb + (size_t)(blk * 2 + 1) * 1024 + ch0) = S[3]; }
        }
    }
};
#define XB_TMO      128
#define XB_XCNT(j)  (256  + 64 * (j))
#define XB_XSUB(j)  (1280 + 64 * (j))
#define XB_XGEN(j)  (2304 + 64 * (j))
#define XB_TOP      3328
#define XB_TOPGEN   3392
#define XCD_BAR_WORDS 3456
#define XB_SPIN_CAP (1u << 27)
__device__ __forceinline__ unsigned xb_ld(unsigned* p)              { return __hip_atomic_load(p, __ATOMIC_RELAXED, __HIP_MEMORY_SCOPE_AGENT); }
__device__ __forceinline__ unsigned xb_add(unsigned* p, unsigned v) { return __hip_atomic_fetch_add(p, v, __ATOMIC_RELAXED, __HIP_MEMORY_SCOPE_AGENT); }
__device__ __forceinline__ unsigned xb_xcc_id() { return (unsigned)__builtin_amdgcn_s_getreg((3 << 11) | 20) & 0xFu; }
#define XB_SPIN(cond, bar) do { unsigned _sp = 0; while (cond) { __builtin_amdgcn_s_sleep(1); \
    if ((++_sp & 255u) == 0u) { if (xb_ld(&(bar)[XB_TMO])) break; if (_sp > XB_SPIN_CAP) { atomicAdd(&(bar)[XB_TMO], 1u); break; } } } } while (0)
struct XcdBarrier { unsigned* bar; unsigned x; volatile LAS unsigned* st; };
__device__ __forceinline__ XcdBarrier xcd_barrier_post(unsigned* bar, volatile LAS unsigned* st) {
    XcdBarrier b; b.bar = bar; b.x = xb_xcc_id(); b.st = st;
    if (tid_now() == 0) (void)xb_add(&bar[XB_XCNT(b.x)], 1u);
    return b;
}
__device__ __forceinline__ void xcd_barrier_complete(unsigned* bar, unsigned x, unsigned& nloc, unsigned& nx) {
    const unsigned G = gridDim.x * gridDim.y * gridDim.z;
    unsigned sum, cnt, mine, sp = 0u;
    for (;;) {
        sum = 0u; cnt = 0u; mine = 0u;
#pragma unroll
        for (unsigned j = 0; j < 16; ++j) { const unsigned c = xb_ld(&bar[XB_XCNT(j)]); sum += c; cnt += (c > 0u) ? 1u : 0u; mine = (j == x) ? c : mine; }
        if (sum == G) break;
        __builtin_amdgcn_s_sleep(1);
        if ((++sp & 255u) == 0u) { if (xb_ld(&bar[XB_TMO])) break; if (sp > XB_SPIN_CAP) { atomicAdd(&bar[XB_TMO], 1u); break; } }
    }
    nloc = mine > 0u ? mine : 1u; nx = cnt > 0u ? cnt : 1u;
}
__device__ __forceinline__ void xcd_barrier(const XcdBarrier& b) {
    asm volatile("s_waitcnt vmcnt(0)" ::: "memory");
    __syncthreads();
    if (tid_now() == 0) {
        unsigned* bar = b.bar;
        __builtin_amdgcn_s_waitcnt(0);
        unsigned nloc = b.st[0], nx = b.st[1];
        if (nloc == 0u) { xcd_barrier_complete(bar, b.x, nloc, nx); b.st[0] = nloc; b.st[1] = nx; }
        const unsigned old = xb_add(&bar[XB_XSUB(b.x)], 1u);
        const unsigned gen = old / nloc;
        if (old + 1u == (gen + 1u) * nloc) {
            __builtin_amdgcn_fence(__ATOMIC_RELEASE, "agent");
            asm volatile("s_waitcnt vmcnt(0)" ::: "memory");
            const unsigned og = xb_add(&bar[XB_TOP], 1u);
            const unsigned tg = og / nx;
            if (og + 1u == (tg + 1u) * nx) xb_add(&bar[XB_TOPGEN], 1u);
            else XB_SPIN(xb_ld(&bar[XB_TOPGEN]) == tg, bar);
            __builtin_amdgcn_fence(__ATOMIC_ACQUIRE, "agent");
            xb_add(&bar[XB_XGEN(b.x)], 1u);
            asm volatile("s_waitcnt vmcnt(0)" ::: "memory");
        } else {
            XB_SPIN(xb_ld(&bar[XB_XGEN(b.x)]) == gen, bar);
            __builtin_amdgcn_fence(__ATOMIC_ACQUIRE, "agent");
            asm volatile("s_waitcnt vmcnt(0)" ::: "memory");
        }
    }
    __syncthreads();
}

struct Args {
    const float *xp, *xs, *w_in_even, *wuf, *bfw, *wub, *bbw, *ng, *sink, *relb, *w_out_even, *w_in_odd, *cw, *w_out_odd, *lng, *lnb;
    float* out; unsigned char* ws;
};
constexpr int NTHR = 512;
constexpr int LDS_BYTES = 147456, MISC_OFF = 131072 + 1024;

template <int MODE> __device__ __forceinline__ int wmap(int n, float& sc) {
    sc = 1.f;
    if (MODE == 0) return n;
    if (MODE == 1) {
        if (n < 512) sc = 0.08838834764831845f;
        if (n >= C_QB && n < C_KB) sc = 0.125f;
        if (n < 2048) return n;
        if (n < C_GD) return n + 32;
        if (n < C_GD + 32) return n - C_GD + 2048;
        return -1;
    }
    const int c = n & 255, bj = (c >> 7) & 1, wc = (c >> 5) & 3, fq = (c >> 3) & 3, nn = (c >> 2) & 1, j = c & 3, q = 2 * bj + nn, ch = (n >> 8) * 64 + 16 * wc + 4 * fq + j;
    const int base = q == 0 ? 0 : (q == 1 ? 1024 : (q == 2 ? 3072 : 2048));
    return base + ch;
}
template <int MODE> __device__ __forceinline__ void wconv_item(const float* __restrict__ W, int Nsrc, bf16_t* __restrict__ Wt, int Ndst, int item, LAS float* tile, int t256) {
    const int nb = item % (Ndst / 64), kb = item / (Ndst / 64), n0 = nb * 64, k0 = kb * 64;
    const int tx = t256 & 63, ty = t256 >> 6;
    float sc; const int src = wmap<MODE>(n0 + tx, sc);
    for (int kk = ty; kk < 64; kk += 4) tile[kk * 65 + tx] = src >= 0 ? W[(size_t)(k0 + kk) * Nsrc + src] * sc : 0.f;
    __syncthreads();
    for (int nn = ty; nn < 64; nn += 4) Wt[(size_t)(n0 + nn) * 1024 + k0 + tx] = f2bf(tile[tx * 65 + nn]);
    __syncthreads();
}
__device__ __forceinline__ void build_gate_tables(const Args& a);
__device__ __forceinline__ void phase_convert(const Args& a, LAS unsigned char* lds) {
    unsigned char* ws = a.ws;
    bf16_t* W1t = (bf16_t*)(ws + WS_W1T); bf16_t* W2t = (bf16_t*)(ws + WS_W2T); bf16_t* W3t = (bf16_t*)(ws + WS_W3T); bf16_t* W4t = (bf16_t*)(ws + WS_W4T);
    const int half = tid_now() >> 8, t256 = tid_now() & 255;
    LAS float* tile = (LAS float*)lds + half * (64 * 65);
    constexpr int I1 = (C_GD / 64) * 16, I2 = 16 * 16, I3 = 64 * 16, I4 = 16 * 16, NIT = I1 + I2 + I3 + I4;
    for (int it0 = blockIdx.x * 2; it0 < NIT; it0 += gridDim.x * 2) {
        int r = it0 + half;
        if (r < I1) wconv_item<1>(a.w_in_even, EVEN_IN, W1t, C_GD, r, tile, t256);
        else if ((r -= I1) < I2) wconv_item<0>(a.w_out_even, 1024, W2t, 1024, r, tile, t256);
        else if ((r -= I2) < I3) wconv_item<2>(a.w_in_odd, ODD_IN, W3t, 4096, r, tile, t256);
        else if ((r -= I3) < I4) wconv_item<0>(a.w_out_odd, 1024, W4t, 1024, r, tile, t256);
        else { __syncthreads(); __syncthreads(); }
    }
    build_gate_tables(a);
    __syncthreads();
    {
        constexpr int WP = 1032;
        LAS bf16_t* wg = (LAS bf16_t*)lds; LAS float* comb = (LAS float*)(lds + 32 * WP * 2);
        const int tid = tid_now(), lane = tid & 63, w = tid >> 6, n = lane & 15, g = lane >> 4, kh = w >> 2, rb = w & 3;
        for (int e = tid; e < 32 * 1024; e += NTHR) { const int k = e >> 5, c = e & 31; wg[c * WP + k] = f2bf(a.w_in_even[(size_t)k * EVEN_IN + 2048 + c]); }
        __syncthreads();
        bf16_t* xb = (bf16_t*)(ws + WS_XB); bf16_t* U = (bf16_t*)(ws + WS_U);
#define P0_LOAD(V, SRC, K4) do { _Pragma("unroll") for (int q = 0; q < 4; ++q) { V[q][0] = *(const f32x4*)((SRC) + (4 * (K4) + q) * 32); V[q][1] = *(const f32x4*)((SRC) + (4 * (K4) + q) * 32 + 4); } } while (0)
#define P0_COMP(V, K4) do { _Pragma("unroll") for (int q = 0; q < 4; ++q) { \
            u32x4 pw; pw.x = pk2(V[q][0][0], V[q][0][1]); pw.y = pk2(V[q][0][2], V[q][0][3]); pw.z = pk2(V[q][1][0], V[q][1][1]); pw.w = pk2(V[q][1][2], V[q][1][3]); \
            *(u32x4*)(dst + (4 * (K4) + q) * 32) = pw; \
            const int kk = kh * 512 + (4 * (K4) + q) * 32 + 8 * g; \
            const bf16x8 b0 = *(const LAS bf16x8*)(wg + n * WP + kk), b1 = *(const LAS bf16x8*)(wg + (16 + n) * WP + kk); \
            acc0 = MFMA16(__builtin_bit_cast(bf16x8, pw), b0, acc0); acc1 = MFMA16(__builtin_bit_cast(bf16x8, pw), b1, acc1); } } while (0)
        auto rowsrc = [&](int it) { const int row = it * 64 + rb * 16 + n; return (row < NPROMPT ? a.xp + (size_t)row * DM : a.xs + (size_t)(row - NPROMPT) * DM) + kh * 512 + 8 * g; };
        f32x4 va[4][2], vb[4][2];
        if (blockIdx.x < NTOK / 64) { const float* s0 = rowsrc(blockIdx.x); P0_LOAD(va, s0, 0); }
        for (int it = blockIdx.x; it < NTOK / 64; it += gridDim.x) {
            const int row = it * 64 + rb * 16 + n;
            const float* src = rowsrc(it);
            const int nit = it + gridDim.x < NTOK / 64 ? it + gridDim.x : it;
            const float* nsrc = rowsrc(nit);
            bf16_t* dst = xb + (size_t)row * DM + kh * 512 + 8 * g;
            f32x4 acc0 = (f32x4){0.f, 0.f, 0.f, 0.f}, acc1 = acc0;
            P0_LOAD(vb, src, 1); P0_COMP(va, 0);
            P0_LOAD(va, src, 2); P0_COMP(vb, 1);
            P0_LOAD(vb, src, 3); P0_COMP(va, 2);
            P0_LOAD(va, nsrc, 0); P0_COMP(vb, 3);
            if (kh == 1) { LAS f32x4* cp = (LAS f32x4*)(comb + (rb * 64 + lane) * 8); cp[0] = acc0; cp[1] = acc1; }
            __syncthreads();
            if (kh == 0) {
                const LAS f32x4* cp = (const LAS f32x4*)(comb + (rb * 64 + lane) * 8); acc0 += cp[0]; acc1 += cp[1];
#pragma unroll
                for (int r = 0; r < 4; ++r) { bf16_t* up = U + (size_t)(it * 64 + rb * 16 + 4 * g + r) * UP + C_GD; up[n] = f2bf(acc0[r]); up[16 + n] = f2bf(acc1[r]); }
            }
            __syncthreads();
        }
#undef P0_LOAD
#undef P0_COMP
    }
}

__device__ __forceinline__ void phase_gla_naive(const Args& a, LAS unsigned char* lds, float* OF, float* OB) {
    if (blockIdx.x >= 12) return;
    const bf16_t* U = (const bf16_t*)(a.ws + WS_U);
    const int grp = tid_now() >> 7, tid = tid_now() & 127, b = blockIdx.x * 4 + grp, dir = b & 1, h = (b >> 1) & 3, s = b >> 3;
    LAS float* sq = (LAS float*)lds + grp * (3 * 16 * 128); LAS float* sk = sq + 16 * 128; LAS float* sd = sk + 16 * 128;
    const int L = s < 2 ? LP : LS, start = s < 2 ? s * LP : NPROMPT + (s - 2) * LS;
    const float* wu = dir ? a.wub : a.wuf; const float* bias = dir ? a.bbw : a.bfw; float* O = dir ? OB : OF;
    float wr[16];
#pragma unroll
    for (int r = 0; r < 16; ++r) wr[r] = wu[r * 512 + h * 128 + tid];
    const float bb = bias[h * 128 + tid];
    float S[128];
#pragma unroll
    for (int i = 0; i < 128; ++i) S[i] = 0.f;
    for (int t0 = 0; t0 < L; t0 += 16) {
        for (int tt = 0; tt < 16; ++tt) {
            const int p = t0 + tt, tok = start + (dir ? L - 1 - p : p);
            const bf16_t* ur = U + (size_t)tok * UP;
            float x = bb;
#pragma unroll
            for (int r = 0; r < 16; ++r) x += bf2f(ur[C_GD + dir * 16 + r]) * wr[r];
            const float ls = fminf(x, 0.f) - log1pf(expf(-fabsf(x)));
            sd[tt * 128 + tid] = expf(ls * (1.0f / 16.0f));
            sq[tt * 128 + tid] = bf2f(ur[C_QA + h * 128 + tid]);
            sk[tt * 128 + tid] = bf2f(ur[C_KA + h * 128 + tid]);
        }
        __syncthreads();
        for (int tt = 0; tt < 16; ++tt) {
            const int p = t0 + tt, tok = start + (dir ? L - 1 - p : p);
            const float v = bf2f(U[(size_t)tok * UP + C_VA + h * 128 + tid]);
            float acc = 0.f;
#pragma unroll
            for (int dk = 0; dk < 128; dk += 4) {
                const f32x4 d4 = *(const LAS f32x4*)&sd[tt * 128 + dk], q4 = *(const LAS f32x4*)&sq[tt * 128 + dk], k4 = *(const LAS f32x4*)&sk[tt * 128 + dk];
#pragma unroll
                for (int j = 0; j < 4; ++j) {
                    const float sdec = S[dk + j] * d4[j];
                    const float sn = sdec + k4[j] * v;
                    acc += q4[j] * (dir ? sdec : sn);
                    S[dk + j] = sn;
                }
            }
            O[(size_t)tok * 512 + h * 128 + tid] = acc;
        }
        __syncthreads();
    }
}
__device__ __forceinline__ void phase_gla_combine(const Args& a, const float* OF, const float* OB) {
    const bf16_t* U = (const bf16_t*)(a.ws + WS_U); bf16_t* ymix = (bf16_t*)((unsigned char*)a.out + 96 * MiB);
    const int lane = tid_now() & 63;
    for (int w = blockIdx.x * 8 + (tid_now() >> 6); w < NTOK * 4; w += gridDim.x * 8) {
        const int tok = w >> 2, h = w & 3;
        const size_t o = (size_t)tok * 512 + h * 128 + lane * 2;
        const float a0 = OF[o] + OB[o], a1 = OF[o + 1] + OB[o + 1];
        const float ss = wave_sum(a0 * a0 + a1 * a1);
        const float rstd = rsqrtf(ss * (1.0f / 128.0f) + NORM_EPS);
        const bf16_t* z = U + (size_t)tok * UP + C_ZA + h * 128 + lane * 2;
        const float y0 = a0 * rstd * a.ng[lane * 2] * silu(bf2f(z[0])), y1 = a1 * rstd * a.ng[lane * 2 + 1] * silu(bf2f(z[1]));
        *(unsigned*)(ymix + (size_t)tok * DM + h * 128 + lane * 2) = pk2(y0, y1);
    }
}
__device__ __forceinline__ int t5_bucket(int rel) {
    const int n = rel < 0 ? -rel : rel;
    int b = n < 8 ? n : (n < 12 ? 8 : (n < 16 ? 9 : (n < 23 ? 10 : (n < 32 ? 11 : (n < 46 ? 12 : (n < 64 ? 13 : (n < 91 ? 14 : 15)))))));
    return b + (rel > 0 ? 16 : 0);
}
__device__ __forceinline__ void phase_swa_naive(const Args& a, LAS unsigned char* lds) {
    const bf16_t* U = (const bf16_t*)(a.ws + WS_U); bf16_t* ymix = (bf16_t*)((unsigned char*)a.out + 96 * MiB);
    const int wv = tid_now() >> 6, lane = tid_now() & 63;
    LAS float* sq = (LAS float*)(lds + 65536) + wv * 64; LAS float* sp = (LAS float*)(lds + 65536 + 2048) + wv * 320;
    for (int w = blockIdx.x * 8 + wv; w < NTOK * 8; w += gridDim.x * 8) {
        const int tok = w >> 3, hq = w & 7, kv = hq >> 2;
        int s0, L; seq_of(tok, s0, L); const int i = tok - s0;
        sq[lane] = bf2f(U[(size_t)tok * UP + C_QB + hq * 64 + lane]);
        const float snk = a.sink[hq];
        float sc[5]; float mx = snk;
#pragma unroll
        for (int c = 0; c < 5; ++c) {
            const int jj = c * 64 + lane, j = i - 128 + jj; const bool valid = jj <= 256 && j >= 0 && j < L;
            float d = -INFINITY;
            if (valid) {
                const bf16_t* kr = U + (size_t)(s0 + j) * UP + C_KB + kv * 64; d = 0.f;
#pragma unroll
                for (int e = 0; e < 64; e += 8) { const u32x4 kk = *(const u32x4*)(kr + e);
                    d += sq[e] * __uint_as_float(kk.x << 16) + sq[e + 1] * __uint_as_float(kk.x & 0xffff0000u) + sq[e + 2] * __uint_as_float(kk.y << 16) + sq[e + 3] * __uint_as_float(kk.y & 0xffff0000u)
                       + sq[e + 4] * __uint_as_float(kk.z << 16) + sq[e + 5] * __uint_as_float(kk.z & 0xffff0000u) + sq[e + 6] * __uint_as_float(kk.w << 16) + sq[e + 7] * __uint_as_float(kk.w & 0xffff0000u); }
                d += a.relb[t5_bucket(j - i) * 8 + hq];
            }
            sc[c] = d; mx = fmaxf(mx, d);
        }
        mx = wave_max(mx);
        float den = 0.f;
#pragma unroll
        for (int c = 0; c < 5; ++c) { sc[c] = sc[c] == -INFINITY ? 0.f : __expf(sc[c] - mx); den += sc[c]; }
        den = wave_sum(den) + __expf(snk - mx);
        const float inv = 1.0f / den;
#pragma unroll
        for (int c = 0; c < 5; ++c) sp[c * 64 + lane] = sc[c] * inv;
        float o = 0.f;
        for (int jj = 0; jj <= 256; ++jj) { const int j = i - 128 + jj; if (j >= 0 && j < L) o += sp[jj] * bf2f(U[(size_t)(s0 + j) * UP + C_VB + kv * 64 + lane]); }
        const float z = bf2f(U[(size_t)tok * UP + C_ZB + hq * 64 + lane]);
        ymix[(size_t)tok * DM + 512 + hq * 64 + lane] = f2bf(o * silu(z));
    }
}
template <int FINAL>
__device__ __forceinline__ void phase_ln(float* Y, const f32x2* stat, f32x2* mr, const float* lg, const float* lb, bf16_t* xb) {
    const int lane = tid_now() & 63;
    for (int row = blockIdx.x * 8 + (tid_now() >> 6); row < NTOK; row += gridDim.x * 8) {
        f32x2 p = lane < 16 ? stat[(size_t)row * 16 + lane] : (f32x2){0.f, 0.f};
        const float s = wave_sum(p.x), q = wave_sum(p.y);
        const float mean = s * (1.0f / DM), var = q * (1.0f / DM) - mean * mean, rstd = rsqrtf(fmaxf(var, 0.f) + LN_EPS);
        if (!FINAL && lane == 0) mr[row] = (f32x2){mean, rstd};
#pragma unroll
        for (int j = 0; j < 4; ++j) {
            const int c = j * 256 + lane * 4;
            const f32x4 y = *(const f32x4*)(Y + (size_t)row * DM + c), g = *(const f32x4*)(lg + c), b = *(const f32x4*)(lb + c);
            const f32x4 o = (y - mean) * rstd * g + b;
            if (FINAL) *(f32x4*)(Y + (size_t)row * DM + c) = o;
            else { u32x2 w; w.x = pk2(o[0], o[1]); w.y = pk2(o[2], o[3]); *(u32x2*)(xb + (size_t)row * DM + c) = w; }
        }
    }
}
__device__ __forceinline__ void phase_convgate(const bf16_t* P, const bf16_t* S, const float* cw, bf16_t* G) {
    const size_t n8 = (size_t)NTOK * DM / 8;
    for (size_t i = (size_t)blockIdx.x * NTHR + tid_now(); i < n8; i += (size_t)gridDim.x * NTHR) {
        const int row = (int)(i >> 7), c = (int)(i & 127) * 8; int s0, L; seq_of(row, s0, L);
        const bool hasl = row > s0, hasr = row < s0 + L - 1;
        const u32x4 pm = *(const u32x4*)(P + (size_t)row * DM + c), sv = *(const u32x4*)(S + (size_t)row * DM + c);
        u32x4 pl = (u32x4){0, 0, 0, 0}, pr = (u32x4){0, 0, 0, 0};
        if (hasl) pl = *(const u32x4*)(P + (size_t)(row - 1) * DM + c);
        if (hasr) pr = *(const u32x4*)(P + (size_t)(row + 1) * DM + c);
        float o[8];
#pragma unroll
        for (int j = 0; j < 4; ++j) {
            const unsigned l = pl[j], m = pm[j], r = pr[j], sw = sv[j];
            const int cc = c + 2 * j;
            o[2 * j] = __uint_as_float(sw << 16) * (cw[cc] * __uint_as_float(l << 16) + cw[1024 + cc] * __uint_as_float(m << 16) + cw[2048 + cc] * __uint_as_float(r << 16));
            o[2 * j + 1] = __uint_as_float(sw & 0xffff0000u) * (cw[cc + 1] * __uint_as_float(l & 0xffff0000u) + cw[1024 + cc + 1] * __uint_as_float(m & 0xffff0000u) + cw[2048 + cc + 1] * __uint_as_float(r & 0xffff0000u));
        }
        u32x4 w; w.x = pk2(o[0], o[1]); w.y = pk2(o[2], o[3]); w.z = pk2(o[4], o[5]); w.w = pk2(o[6], o[7]);
        *(u32x4*)(G + (size_t)row * DM + c) = w;
    }
}

typedef short s16x4 __attribute__((ext_vector_type(4)));
constexpr int GL_QT = 0, GL_KT = 16384, GL_VT = 32768, GL_PT = 49152, GL_B = 57344, GL_GD = 90112, GL_TOT = 94208, GL_EBL = 96256  , GL_SSW = 97280, GL_RSTD = 99328;
constexpr int NSEG = NTOK / 256;
__device__ __forceinline__ unsigned offb(unsigned row, unsigned ch) { return 256u * row + 16u * (ch ^ (((row & 3) << 2) | ((row >> 2) & 3))); }
__device__ __forceinline__ unsigned offp(unsigned row, unsigned ch) { return 128u * row + 16u * (ch ^ (row & 7)); }
__device__ __forceinline__ unsigned rr16(unsigned lane, unsigned rb, unsigned s) { return offb((lane & 15) + 16 * rb, 4 * s + (lane >> 4)); }
__device__ __forceinline__ unsigned tr16(unsigned lane, unsigned c, unsigned ks, unsigned t) {
    const unsigned g = lane >> 4, q = (lane & 15) >> 2, p = lane & 3;
    return offb(32 * ks + 8 * g + 4 * t + q, 2 * c + (p >> 1)) + 8 * (p & 1);
}
__device__ __forceinline__ bf16x8 tr_read8(unsigned a0, unsigned a1) {
    s16x4 r0, r1;
    asm volatile("ds_read_b64_tr_b16 %0, %2\n\tds_read_b64_tr_b16 %1, %3\n\ts_waitcnt lgkmcnt(0)" : "=&v"(r0), "=&v"(r1) : "v"(a0), "v"(a1) : "memory");
    return __builtin_shufflevector(r0, r1, 0, 1, 2, 3, 4, 5, 6, 7);
}
__device__ __forceinline__ void unpack8(const u32x4 w, float (&f)[8]) {
#pragma unroll
    for (int j = 0; j < 4; ++j) { f[2 * j] = __uint_as_float(w[j] << 16); f[2 * j + 1] = __uint_as_float(w[j] & 0xffff0000u); }
}

struct GlaPre { u32x4 gd[4]; u32x4 q[2], k[2], v[2]; u32x4 wf; f32x4 wb; };
template <int MODE>
__device__ __forceinline__ void gla_prefetch(const Args& a, GlaPre& pre, int tid, int tb, int h, int dir, int stidx) {
    const bf16_t* U = (const bf16_t*)(a.ws + WS_U);
    const int lane = tid & 63, n = lane & 15, g = lane >> 4, w = tid >> 6;
#pragma unroll
    for (int it = 0; it < 4; ++it) { const int row = 16 * it + n, tok = dir ? tb + 63 - row : tb + row; pre.gd[it] = *(const u32x4*)(U + (size_t)tok * UP + C_GD + dir * 16 + 8 * (g & 1)); }
#pragma unroll
    for (int i = 0; i < 2; ++i) {
        const int idx = tid + 512 * i, row = idx >> 4, ch = idx & 15, tok = dir ? tb + 63 - row : tb + row;
        const bf16_t* ur = U + (size_t)tok * UP + h * 128 + ch * 8;
        pre.v[i] = *(const u32x4*)(ur + C_VA); pre.k[i] = *(const u32x4*)(ur + C_KA);
        if (MODE != 0) pre.q[i] = *(const u32x4*)(ur + C_QA);
    }
    pre.wf = ((const u32x4*)(a.ws + WS_GATE))[(dir * 4 + h) * 512 + tid];
    pre.wb = *(const f32x4*)((const float*)(a.ws + WS_GATE + 65536) + (dir * 4 + h) * 128 + 16 * w + 4 * g);
}
__device__ __forceinline__ bf16x8 tr_read8(LAS unsigned char* lds, unsigned a0, unsigned a1) {
    const s16x4 r0 = __builtin_amdgcn_ds_read_tr16_b64_v4i16((LAS s16x4*)(lds + a0)), r1 = __builtin_amdgcn_ds_read_tr16_b64_v4i16((LAS s16x4*)(lds + a1));
    return __builtin_shufflevector(r0, r1, 0, 1, 2, 3, 4, 5, 6, 7);
}
template <int CTRL> __device__ __forceinline__ float dpp_f(float x) { return __int_as_float(__builtin_amdgcn_update_dpp(0, __float_as_int(x), CTRL, 0xf, 0xf, true)); }
constexpr int GL_BP = 132;
template <int MODE>
__device__ __forceinline__ void gla_chunk(const Args& a, LAS unsigned char* lds, const int tb, const int h, const int dir,
                                          f32x4 (&Sacc)[8], f32x4& lam, u32x4* stash, GlaPre& pre, const int ntb, const int nh, const int ndir, const bool first, const int par) {
    const bf16_t* U = (const bf16_t*)(a.ws + WS_U);
    int tid = tid_now(); asm volatile("" : "+v"(tid));
    const int lane = tid & 63, w = __builtin_amdgcn_readfirstlane(tid >> 6), n = lane & 15, g = lane >> 4;
    const unsigned fn = ((n & 3) << 2) | ((n >> 2) & 3);
    const unsigned base_rr = 256u * n + 16u * (g ^ fn);
    const unsigned base_c = 256u * n + 16u * ((g >> 1) ^ fn) + 8u * (g & 1);
    const unsigned base_p = 128u * n + 16u * (g ^ (n & 7));
    const unsigned trb0 = tr16(lane, 0, 0, 0), trb1 = tr16(lane, 0, 0, 1);
    GlaPre& cur = pre;
    const bf16x8 wfrag = __builtin_bit_cast(bf16x8, cur.wf); const f32x4 wbias = cur.wb;
    int prow[2], pch[2], ptok[2];
#pragma unroll
    for (int i = 0; i < 2; ++i) { const int idx = tid + 512 * i; prow[i] = idx >> 4; pch[i] = idx & 15; ptok[i] = dir ? tb + 63 - prow[i] : tb + prow[i]; }
    u32x4 st0, st1, zraw[2];
    {
        LAS float* B = (LAS float*)(lds + GL_B);
        f32x4 carry = (f32x4){0.f, 0.f, 0.f, 0.f};
#pragma unroll
        for (int tt = 0; tt < 4; ++tt) {
            const f32x4 x = MFMA16(wfrag, __builtin_bit_cast(bf16x8, cur.gd[tt]), wbias);
            f32x4 pv, tv;
#pragma unroll
            for (int r = 0; r < 4; ++r) {
                const float xv = x[r]; const float v = (fminf(xv, 0.f) - 0.6931471805599453f * flog2(1.0f + fexp(-fabsf(xv)))) * (1.0f / 16.0f);
                float ps = v; ps += dpp_f<0x111>(ps); ps += dpp_f<0x112>(ps); ps += dpp_f<0x114>(ps); ps += dpp_f<0x118>(ps);
                float ts = v; ts += dpp_f<0x128>(ts); ts += dpp_f<0x124>(ts); ts += dpp_f<0x122>(ts); ts += dpp_f<0x121>(ts);
                pv[r] = ps; tv[r] = ts;
            }
            *(LAS f32x4*)(B + (16 * tt + n) * GL_BP + 16 * w + 4 * g) = carry + pv;
            carry += tv;
        }
        if (n == 0) *(LAS f32x4*)(lds + GL_EBL + par * 512 + (16 * w + 4 * g) * 4) = (f32x4){fexp(carry[0]), fexp(carry[1]), fexp(carry[2]), fexp(carry[3])};
        lam += carry;
    }
    __syncthreads();
#pragma unroll
    for (int i = 0; i < 2; ++i) {
        const LAS f32x4* bp = (const LAS f32x4*)(lds + GL_B + (prow[i] * GL_BP + pch[i] * 8) * 4);
        const f32x4 b0 = bp[0], b1 = bp[1];
        float e[8], kf[8];
#pragma unroll
        for (int j = 0; j < 4; ++j) { e[j] = fexp(b0[j]); e[4 + j] = fexp(b1[j]); }
        unpack8(cur.k[i], kf);
        u32x4 kw;
#pragma unroll
        for (int j = 0; j < 4; ++j) kw[j] = pk2(kf[2 * j] * __builtin_amdgcn_rcpf(e[2 * j]), kf[2 * j + 1] * __builtin_amdgcn_rcpf(e[2 * j + 1]));
        *(LAS u32x4*)(lds + GL_KT + offb(prow[i], pch[i])) = kw;
        *(LAS u32x4*)(lds + GL_VT + offb(prow[i], pch[i])) = cur.v[i];
        if (MODE != 0) {
            float qf[8]; unpack8(cur.q[i], qf);
            u32x4 qw;
#pragma unroll
            for (int j = 0; j < 4; ++j) qw[j] = pk2(qf[2 * j] * e[2 * j], qf[2 * j + 1] * e[2 * j + 1]);
            *(LAS u32x4*)(lds + GL_QT + offb(prow[i], pch[i])) = qw;
        }
    }
    __syncthreads();
    gla_prefetch<MODE>(a, pre, tid, ntb, nh, ndir, -1);
    f32x4 Oacc[4];
    if (MODE != 0) {
        const int it = w >> 1;
#pragma unroll
        for (int jj = 0; jj < 2; ++jj) {
            const int jt = 2 * (w & 1) + jj;
            f32x4 pacc = (f32x4){0.f, 0.f, 0.f, 0.f};
            if (jt <= it) {
#pragma unroll
                for (int s = 0; s < 4; ++s) {
                    const bf16x8 qa = *(const LAS bf16x8*)(lds + GL_QT + (base_rr ^ (64u * s)) + 4096u * it);
                    const bf16x8 kb = *(const LAS bf16x8*)(lds + GL_KT + (base_rr ^ (64u * s)) + 4096u * jt); pacc = MFMA16(qa, kb, pacc); }
            }
            const int j = 16 * jt + n;
#pragma unroll
            for (int r = 0; r < 4; ++r) {
                const int i = 16 * it + 4 * g + r;
                const bool keep = (MODE == 1) ? (j <= i) : (j < i);
                *(LAS bf16_t*)(lds + GL_PT + offp(i, j >> 3) + 2 * (j & 7)) = keep ? f2bf(pacc[r]) : (bf16_t)0;
            }
            __builtin_amdgcn_sched_barrier(0);
        }
        if (first) {
#pragma unroll
            for (int kt = 0; kt < 8; ++kt) { const unsigned r0 = __float_as_uint(Sacc[kt][0]), r1 = __float_as_uint(Sacc[kt][1]);
                Sacc[kt] = (f32x4){__uint_as_float(r0 << 16), __uint_as_float(r0 & 0xffff0000u), __uint_as_float(r1 << 16), __uint_as_float(r1 & 0xffff0000u)}; }
        }
#pragma unroll
        for (int i2 = 0; i2 < 4; ++i2) Oacc[i2] = (f32x4){0.f, 0.f, 0.f, 0.f};
#pragma unroll
        for (int ks = 0; ks < 4; ++ks) {
            u32x4 pw; pw.x = pk2(Sacc[2 * ks][0], Sacc[2 * ks][1]); pw.y = pk2(Sacc[2 * ks][2], Sacc[2 * ks][3]); pw.z = pk2(Sacc[2 * ks + 1][0], Sacc[2 * ks + 1][1]); pw.w = pk2(Sacc[2 * ks + 1][2], Sacc[2 * ks + 1][3]);
            const bf16x8 sb = __builtin_bit_cast(bf16x8, pw);
            const unsigned alo = base_c ^ (64u * ks);
#pragma unroll
            for (int i2 = 0; i2 < 4; ++i2) {
                const u32x2 lo = *(const LAS u32x2*)(lds + GL_QT + 4096 * i2 + alo);
                const u32x2 hi = *(const LAS u32x2*)(lds + GL_QT + 4096 * i2 + (alo ^ 32u));
                u32x4 aw; aw.x = lo.x; aw.y = lo.y; aw.z = hi.x; aw.w = hi.y;
                Oacc[i2] = MFMA16(__builtin_bit_cast(bf16x8, aw), sb, Oacc[i2]);
            }
            __builtin_amdgcn_sched_barrier(0);
        }
        __syncthreads();
        if (MODE == 2) {
            st0 = stash[tid * 2]; st1 = stash[tid * 2 + 1];
#pragma unroll
            for (int i = 0; i < 2; ++i) zraw[i] = *(const u32x4*)(U + (size_t)ptok[i] * UP + C_ZA + h * 128 + pch[i] * 8);
        }
    }
    bf16x8 vf[2];
#pragma unroll
    for (int ks = 0; ks < 2; ++ks) vf[ks] = tr_read8(lds, GL_VT + 8192u * ks + (trb0 ^ (32u * w)), GL_VT + 8192u * ks + (trb1 ^ (32u * w)));
    if (MODE != 0) {
#pragma unroll
        for (int i2 = 0; i2 < 4; ++i2)
#pragma unroll
            for (int ks = 0; ks < 2; ++ks) {
                if (ks <= (i2 >> 1)) { const bf16x8 pa = *(const LAS bf16x8*)(lds + GL_PT + 2048 * i2 + (base_p ^ (64u * ks))); Oacc[i2] = MFMA16(pa, vf[ks], Oacc[i2]); }
            }
    }
#pragma unroll
    for (int kt = 0; kt < 8; ++kt) {
#pragma unroll
        for (int ks = 0; ks < 2; ++ks) { const bf16x8 ka = tr_read8(lds, GL_KT + 8192u * ks + (trb0 ^ (32u * kt)), GL_KT + 8192u * ks + (trb1 ^ (32u * kt))); Sacc[kt] = MFMA16(ka, vf[ks], Sacc[kt]); }
        const f32x4 eb = *(const LAS f32x4*)(lds + GL_EBL + par * 512 + (16 * kt + 4 * g) * 4);
        Sacc[kt] = Sacc[kt] * eb;
        if (kt & 1) __builtin_amdgcn_sched_barrier(0);
    }
    if (MODE == 1) {
        u32x4 s0, s1;
        s0.x = pk2(Oacc[3][3], Oacc[3][2]); s0.y = pk2(Oacc[3][1], Oacc[3][0]); s0.z = pk2(Oacc[2][3], Oacc[2][2]); s0.w = pk2(Oacc[2][1], Oacc[2][0]);
        s1.x = pk2(Oacc[1][3], Oacc[1][2]); s1.y = pk2(Oacc[1][1], Oacc[1][0]); s1.z = pk2(Oacc[0][3], Oacc[0][2]); s1.w = pk2(Oacc[0][1], Oacc[0][0]);
        const int tidm = tid ^ 48;
        stash[tidm * 2] = s0; stash[tidm * 2 + 1] = s1;
    }
    if (MODE == 2) {
        float fo[16]; { float t8[8]; unpack8(st0, t8);
#pragma unroll
            for (int j = 0; j < 8; ++j) fo[j] = t8[j]; unpack8(st1, t8);
#pragma unroll
            for (int j = 0; j < 8; ++j) fo[8 + j] = t8[j]; }
        LAS float* ssw = (LAS float*)(lds + GL_SSW);
#pragma unroll
        for (int i2 = 0; i2 < 4; ++i2)
#pragma unroll
            for (int r = 0; r < 4; ++r) {
                const float o = Oacc[i2][r] + fo[4 * i2 + r]; Oacc[i2][r] = o;
                float v = o * o; v += dpp_f<0x128>(v); v += dpp_f<0x124>(v); v += dpp_f<0x122>(v); v += dpp_f<0x121>(v);
                if (n == 0) ssw[w * 64 + 16 * i2 + 4 * g + r] = v;
            }
        __syncthreads();
        if (tid < 64) { float s = 0.f;
#pragma unroll
            for (int ww = 0; ww < 8; ++ww) s += ssw[ww * 64 + tid];
            ((LAS float*)(lds + GL_RSTD))[tid] = rsqrtf(s * (1.0f / 128.0f) + NORM_EPS); }
        __syncthreads();
        const float gn = a.ng[16 * w + n];
#pragma unroll
        for (int i2 = 0; i2 < 4; ++i2) {
            const f32x4 rs = *(const LAS f32x4*)(lds + GL_RSTD + (16 * i2 + 4 * g) * 4);
#pragma unroll
            for (int r = 0; r < 4; ++r) *(LAS bf16_t*)(lds + GL_QT + (16 * i2 + 4 * g + r) * 256 + (16 * w + n) * 2) = f2bf(Oacc[i2][r] * rs[r] * gn);
        }
        __syncthreads();
        bf16_t* ymix = (bf16_t*)((unsigned char*)a.out + 96 * MiB);
#pragma unroll
        for (int i = 0; i < 2; ++i) {
            const u32x4 ov = *(const LAS u32x4*)(lds + GL_QT + prow[i] * 256 + pch[i] * 16);
            float of[8], zf[8]; unpack8(ov, of); unpack8(zraw[i], zf);
            u32x4 yw;
#pragma unroll
            for (int j = 0; j < 4; ++j) yw[j] = pk2(of[2 * j] * silu(zf[2 * j]), of[2 * j + 1] * silu(zf[2 * j + 1]));
            *(u32x4*)(ymix + (size_t)ptok[i] * DM + h * 128 + pch[i] * 8) = yw;
        }
    }
}
__device__ __forceinline__ void build_gate_tables(const Args& a) {
    for (int e = blockIdx.x * NTHR + tid_now(); e < 8 * 512; e += gridDim.x * NTHR) {
        const int dh = e >> 9, tid = e & 511, dir = dh >> 2, h = dh & 3, lane = tid & 63, w = tid >> 6, n = lane & 15, g = lane >> 4, col = h * 128 + 16 * w + n;
        const float* wup = dir ? a.wub : a.wuf; const float* bias = dir ? a.bbw : a.bfw;
        u32x4 pw;
#pragma unroll
        for (int j = 0; j < 4; ++j) {
            const float v0 = wup[(8 * (g & 1) + 2 * j) * 512 + col], v1 = wup[(8 * (g & 1) + 2 * j + 1) * 512 + col];
            const float h0 = bf2f(f2bf(v0)), h1 = bf2f(f2bf(v1));
            pw[j] = g < 2 ? pk2(v0, v1) : pk2(v0 - h0, v1 - h1);
        }
        ((u32x4*)(a.ws + WS_GATE))[e] = pw;
        if (g == 0) ((float*)(a.ws + WS_GATE + 65536))[dh * 128 + 16 * w + n] = bias[col];
    }
}
__device__ __forceinline__ void phase_gla_pass1(const Args& a, LAS unsigned char* lds) {
    const int tid = tid_now(), w = tid >> 6, lane = tid & 63;
    unsigned char* ST = a.ws + WS_ST;
    GlaPre pre; int par = 0;
    { const int item = blockIdx.x; if (item < NSEG * 8) { const int dir = item & 1; gla_prefetch<0>(a, pre, tid, (item >> 3) * 256 + (dir ? 3 : 0) * 64, (item >> 1) & 3, dir, -1); } }
    for (int item = blockIdx.x; item < NSEG * 8; item += gridDim.x) {
        const int dir = item & 1, h = (item >> 1) & 3, seg = item >> 3;
        const int nitem = item + gridDim.x < NSEG * 8 ? item + gridDim.x : item;
        f32x4 Sacc[8];
#pragma unroll
        for (int kt = 0; kt < 8; ++kt) Sacc[kt] = (f32x4){0.f, 0.f, 0.f, 0.f};
        f32x4 lam = (f32x4){0.f, 0.f, 0.f, 0.f};
        for (int cc = 0; cc < 4; ++cc) {
            const int c = dir ? 3 - cc : cc;
            int ntb, nh, ndir;
            if (cc < 3) { ntb = seg * 256 + (dir ? c - 1 : c + 1) * 64; nh = h; ndir = dir; }
            else { ndir = nitem & 1; nh = (nitem >> 1) & 3; ntb = (nitem >> 3) * 256 + (ndir ? 3 : 0) * 64; }
            gla_chunk<0>(a, lds, seg * 256 + c * 64, h, dir, Sacc, lam, nullptr, pre, ntb, nh, ndir, false, par); par ^= 1;
        }
        u32x2* dst = (u32x2*)(ST + (size_t)item * 32768) + (size_t)w * 8 * 64 + lane;
#pragma unroll
        for (int kt = 0; kt < 8; ++kt) { u32x2 v; v.x = pk2(Sacc[kt][0], Sacc[kt][1]); v.y = pk2(Sacc[kt][2], Sacc[kt][3]); dst[kt * 64] = v; }
        if ((lane & 15) == 0) *(f32x4*)((float*)(a.ws + WS_DEC) + (size_t)item * 128 + 16 * w + 4 * (lane >> 4)) = lam;
    }
    __syncthreads();
}
__device__ __forceinline__ void phase_gla_pass2(const Args& a) {
    unsigned char* ST = a.ws + WS_ST; const float* DEC = (const float*)(a.ws + WS_DEC);
    for (int gidx = blockIdx.x * NTHR + tid_now(); gidx < 48 * 4096; gidx += gridDim.x * NTHR) {
        const int chain = gidx >> 12, quad = gidx & 4095, dir = chain & 1, h = (chain >> 1) & 3, s = chain >> 3;
        const int nseg = s < 2 ? LP / 256 : LS / 256, seg0 = s < 2 ? s * (LP / 256) : 2 * (LP / 256) + (s - 2) * (LS / 256);
        const int kt = (quad >> 6) & 7, lane = quad & 63, dk0 = 16 * kt + 4 * (lane >> 4);
        f32x4 S = (f32x4){0.f, 0.f, 0.f, 0.f};
        for (int i0 = 0; i0 < nseg; i0 += 8) {
            u32x2 t[8]; f32x4 lm[8];
#pragma unroll
            for (int j = 0; j < 8; ++j) { const int seg = dir ? seg0 + nseg - 1 - (i0 + j) : seg0 + i0 + j; const size_t idx = (size_t)((seg * 4 + h) * 2 + dir);
                t[j] = ((const u32x2*)(ST + idx * 32768))[quad]; lm[j] = *(const f32x4*)(DEC + idx * 128 + dk0); }
#pragma unroll
            for (int j = 0; j < 8; ++j) { const int seg = dir ? seg0 + nseg - 1 - (i0 + j) : seg0 + i0 + j; const size_t idx = (size_t)((seg * 4 + h) * 2 + dir);
                u32x2 o; o.x = pk2(S[0], S[1]); o.y = pk2(S[2], S[3]); ((u32x2*)(ST + idx * 32768))[quad] = o;
                const f32x4 tv = (f32x4){__uint_as_float(t[j].x << 16), __uint_as_float(t[j].x & 0xffff0000u), __uint_as_float(t[j].y << 16), __uint_as_float(t[j].y & 0xffff0000u)};
                S = (f32x4){fexp(lm[j][0]), fexp(lm[j][1]), fexp(lm[j][2]), fexp(lm[j][3])} * S + tv; }
        }
    }
}
__device__ __forceinline__ void phase_gla_pass3(const Args& a, LAS unsigned char* lds) {
    const int tid = tid_now(), w = tid >> 6, lane = tid & 63;
    GlaPre pre; int par = 0;
    if (blockIdx.x < NSEG * 4) gla_prefetch<1>(a, pre, tid, (blockIdx.x >> 2) * 256, blockIdx.x & 3, 0, -1);
    for (int item = blockIdx.x; item < NSEG * 4; item += gridDim.x) {
        const int h = item & 3, seg = item >> 2;
        const int nitem = item + gridDim.x < NSEG * 4 ? item + gridDim.x : item;
        u32x4* stash = (u32x4*)a.out + (size_t)item * 4 * 1024;
#pragma unroll 1
        for (int dir = 0; dir < 2; ++dir) {
            f32x4 Sacc[8];
            const u32x2* src = (const u32x2*)(a.ws + WS_ST + (size_t)((seg * 4 + h) * 2 + dir) * 32768) + (size_t)w * 8 * 64 + lane;
#pragma unroll
            for (int kt = 0; kt < 8; ++kt) { const u32x2 v = src[kt * 64]; Sacc[kt] = (f32x4){__uint_as_float(v.x), __uint_as_float(v.y), 0.f, 0.f}; }
            f32x4 lam = (f32x4){0.f, 0.f, 0.f, 0.f};
            if (dir == 0) {
                for (int c = 0; c < 4; ++c) { const int ntb = seg * 256 + (c < 3 ? c + 1 : 3) * 64, ndir = c < 3 ? 0 : 1;
                    gla_chunk<1>(a, lds, seg * 256 + c * 64, h, 0, Sacc, lam, stash + c * 1024, pre, ntb, h, ndir, c == 0, par); par ^= 1; }
            } else {
                for (int c = 3; c >= 0; --c) { const int ntb = c > 0 ? seg * 256 + (c - 1) * 64 : (nitem >> 2) * 256, nh = c > 0 ? h : (nitem & 3), ndir = c > 0 ? 1 : 0;
                    gla_chunk<2>(a, lds, seg * 256 + c * 64, h, 1, Sacc, lam, stash + c * 1024, pre, ntb, nh, ndir, c == 3, par); par ^= 1; }
            }
        }
    }
    __syncthreads();
}
typedef float f32x16 __attribute__((ext_vector_type(16)));
#define MFMA32(a, b, c) __builtin_amdgcn_mfma_f32_32x32x16_bf16((a), (b), (c), 0, 0, 0)
constexpr int SW_K = 0, SW_V = 49152, SW_TB = 98304, SW_TBN = 336, SW_TBH = 4 * SW_TBN * 4;
constexpr float SW_NEG = -1e30f;
__device__ __forceinline__ unsigned offk(unsigned row, unsigned c8) { return 128u * row + 16u * (c8 ^ ((row >> 1) & 7)); }
__device__ __forceinline__ unsigned offv(unsigned row, unsigned c8) { return 128u * row + 16u * (c8 ^ (((row >> 1) & 1) << 2)); }
__device__ __forceinline__ void phase_swa(const Args& a, LAS unsigned char* lds) {
    const bf16_t* U = (const bf16_t*)(a.ws + WS_U); bf16_t* ymix = (bf16_t*)((unsigned char*)a.out + 96 * MiB);
    const int tid = tid_now(), lane = tid & 63, w = __builtin_amdgcn_readfirstlane(tid >> 6), r = lane & 31, hh = lane >> 5;
    const unsigned lb = (unsigned)(size_t)lds;
    for (int item = blockIdx.x; item < (NTOK / 128) * 2; item += gridDim.x) {
        const int kvh = item & 1, tok0 = (item >> 1) * 128; int s0, L; seq_of(tok0, s0, L);
        const bool first = tok0 == s0, last = tok0 + 128 == s0 + L;
        __syncthreads();
#pragma unroll
        for (int i = 0; i < 6; ++i) {
            const int idx = tid + 512 * i, row = idx >> 3, c8 = idx & 7, kpos = tok0 - 128 + row;
            u32x4 kk = (u32x4){0, 0, 0, 0}, vv = (u32x4){0, 0, 0, 0};
            if (kpos >= s0 && kpos < s0 + L) { const bf16_t* ur = U + (size_t)kpos * UP + kvh * 64 + c8 * 8; kk = *(const u32x4*)(ur + C_KB); vv = *(const u32x4*)(ur + C_VB); }
            *(LAS u32x4*)(lds + SW_K + offk(row, c8)) = kk; *(LAS u32x4*)(lds + SW_V + offv(row, c8)) = vv;
        }
        for (int e = tid; e < 4 * SW_TBN; e += NTHR) {
            const int hl = e / SW_TBN, idx = e - hl * SW_TBN, rel = idx - 160;
            const float val = (rel >= -128 && rel <= 128) ? a.relb[t5_bucket(rel) * 8 + kvh * 4 + hl] : SW_NEG;
            LAS float* tb = (LAS float*)(lds + SW_TB + hl * SW_TBH);
#pragma unroll
            for (int s = 0; s < 4; ++s) if (idx - s >= 0) tb[s * SW_TBN + idx - s] = val;
        }
        __syncthreads();
        const int hl = w >> 1, hq = kvh * 4 + hl;
        const float snk = a.sink[hq];
#pragma unroll 1
        for (int ss = 0; ss < 2; ++ss) {
            const int st = (w & 1) * 2 + ss, qtok = tok0 + 32 * st + r;
            bf16x8 Qf[4];
#pragma unroll
            for (int s = 0; s < 4; ++s) Qf[s] = *(const bf16x8*)(U + (size_t)qtok * UP + C_QB + hq * 64 + 16 * s + 8 * hh);
            float m = snk, l = hh == 0 ? 1.0f : 0.0f;
            f32x16 O[2];
#pragma unroll
            for (int i = 0; i < 16; ++i) { O[0][i] = 0.f; O[1][i] = 0.f; }
            const int sft = (-r) & 3;
            const unsigned tbase = SW_TB + hl * SW_TBH + sft * (SW_TBN * 4) + 4 * (32 + 4 * hh - r - sft);
            const unsigned kb0 = SW_K + 128u * r + 16u * (hh ^ ((r >> 1) & 7)) + 4096u * st;
            const int q4 = (lane & 15) >> 2, p4 = lane & 3, g1 = (lane >> 4) & 1, xq = (q4 >> 1) & 1;
            const unsigned vb0 = SW_V + 128u * (4 * hh + q4) + 16u * ((4 * xq) | (2 * g1) | (p4 >> 1)) + 8u * (p4 & 1) + 4096u * st;
#pragma unroll 1
            for (int grp = 0; grp < 3; ++grp) {
                f32x16 S[3];
#pragma unroll
                for (int k3 = 0; k3 < 3; ++k3) {
                    const int kk = 3 * grp + k3, blk = (st + kk) >> 2;
                    const bool valid = !((blk == 0 && first) || (blk == 2 && last));
                    if (valid) {
#pragma unroll
                        for (int i = 0; i < 16; ++i) S[k3][i] = 0.f;
#pragma unroll
                        for (int s = 0; s < 4; ++s) { const bf16x8 Kf = *(const LAS bf16x8*)(lds + (kb0 ^ (32u * s)) + 4096u * kk); S[k3] = MFMA32(Kf, Qf[s], S[k3]); }
#pragma unroll
                        for (int i4 = 0; i4 < 4; ++i4) { const f32x4 bv = *(const LAS f32x4*)(lds + tbase + 4 * (32 * kk + 8 * i4));
#pragma unroll
                            for (int j = 0; j < 4; ++j) S[k3][4 * i4 + j] += bv[j]; }
                    } else {
#pragma unroll
                        for (int i = 0; i < 16; ++i) S[k3][i] = SW_NEG;
                    }
                }
                float mx = SW_NEG;
#pragma unroll
                for (int k3 = 0; k3 < 3; ++k3)
#pragma unroll
                    for (int i = 0; i < 16; ++i) mx = fmaxf(mx, S[k3][i]);
                mx = fmaxf(mx, __shfl_xor(mx, 32));
                const float mn = fmaxf(m, mx), alpha = fexp(m - mn);
                m = mn; l *= alpha;
#pragma unroll
                for (int i = 0; i < 16; ++i) { O[0][i] *= alpha; O[1][i] *= alpha; }
                bf16x8 Pf[3][2];
#pragma unroll
                for (int k3 = 0; k3 < 3; ++k3) {
#pragma unroll
                    for (int i = 0; i < 16; ++i) { const float pv = fexp(S[k3][i] - m); S[k3][i] = pv; l += pv; }
#pragma unroll
                    for (int s2 = 0; s2 < 2; ++s2) {
                        u32x4 pw;
#pragma unroll
                        for (int j = 0; j < 4; ++j) pw[j] = pk2(S[k3][8 * s2 + 2 * j], S[k3][8 * s2 + 2 * j + 1]);
                        Pf[k3][s2] = __builtin_bit_cast(bf16x8, pw);
                    }
                }
#pragma unroll
                for (int k3 = 0; k3 < 3; ++k3) {
                    const int kk = 3 * grp + k3;
#pragma unroll
                    for (int s2 = 0; s2 < 2; ++s2)
#pragma unroll
                        for (int dt = 0; dt < 2; ++dt) {
                            const unsigned va = (vb0 ^ (64u * dt)) + 4096u * kk + 2048u * s2;
                            const bf16x8 Vf = tr_read8(lds, va, va + 1024u);
                            O[dt] = MFMA32(Vf, Pf[k3][s2], O[dt]);
                        }
                }
            }
            l += __shfl_xor(l, 32);
            const float inv = __builtin_amdgcn_rcpf(l);
#pragma unroll
            for (int dt = 0; dt < 2; ++dt)
#pragma unroll
                for (int i4 = 0; i4 < 4; ++i4) {
                    const int d0 = 32 * dt + 8 * i4 + 4 * hh;
                    const u32x2 zv = *(const u32x2*)(U + (size_t)qtok * UP + C_ZB + hq * 64 + d0);
                    const float z0 = __uint_as_float(zv.x << 16), z1 = __uint_as_float(zv.x & 0xffff0000u), z2 = __uint_as_float(zv.y << 16), z3 = __uint_as_float(zv.y & 0xffff0000u);
                    u32x2 yw; yw.x = pk2(O[dt][4 * i4] * inv * silu(z0), O[dt][4 * i4 + 1] * inv * silu(z1)); yw.y = pk2(O[dt][4 * i4 + 2] * inv * silu(z2), O[dt][4 * i4 + 3] * inv * silu(z3));
                    *(u32x2*)(ymix + (size_t)qtok * DM + 512 + hq * 64 + d0) = yw;
                }
        }
    }
}

__device__ __forceinline__ void phase_convfix(const Args& a) {
    bf16_t* G = (bf16_t*)(a.ws + WS_XB); const float* Pb = (const float*)(a.ws + WS_PB); const float* Sb = (const float*)(a.ws + WS_SB);
    for (int idx = blockIdx.x * NTHR + tid_now(); idx < (NTOK / 64 - 1) * 256; idx += gridDim.x * NTHR) {
        const int k = idx / 256 + 1, c = (idx & 255) * 4, row = 64 * k; int s0, L; seq_of(row, s0, L);
        if (row == s0) continue;
        const f32x4 pl = *(const f32x4*)(Pb + (size_t)((k - 1) * 2 + 1) * 1024 + c), sl = *(const f32x4*)(Sb + (size_t)((k - 1) * 2 + 1) * 1024 + c);
        const f32x4 pf = *(const f32x4*)(Pb + (size_t)(k * 2) * 1024 + c), sf = *(const f32x4*)(Sb + (size_t)(k * 2) * 1024 + c);
        const f32x4 c0 = *(const f32x4*)(a.cw + c), c2 = *(const f32x4*)(a.cw + 2048 + c);
        u32x2* gl = (u32x2*)(G + (size_t)(row - 1) * DM + c); u32x2* gf = (u32x2*)(G + (size_t)row * DM + c);
        const u32x2 a0 = *gl, a1 = *gf;
        const f32x4 dl = sl * c2 * pf, df = sf * c0 * pl;
        u32x2 o0, o1;
        o0.x = pk2(__uint_as_float(a0.x << 16) + dl[0], __uint_as_float(a0.x & 0xffff0000u) + dl[1]); o0.y = pk2(__uint_as_float(a0.y << 16) + dl[2], __uint_as_float(a0.y & 0xffff0000u) + dl[3]);
        o1.x = pk2(__uint_as_float(a1.x << 16) + df[0], __uint_as_float(a1.x & 0xffff0000u) + df[1]); o1.y = pk2(__uint_as_float(a1.y << 16) + df[2], __uint_as_float(a1.y & 0xffff0000u) + df[3]);
        *gl = o0; *gf = o1;
    }
}
__global__ void __launch_bounds__(NTHR, 2) mega(Args a) {
    LAS unsigned char* lds = (LAS unsigned char*)lds_raw;
    volatile LAS unsigned* MISC = (volatile LAS unsigned*)(lds + MISC_OFF);
    if (threadIdx.x < 32) MISC[threadIdx.x] = 0u;
    if ((threadIdx.x & 63) == 0) ((volatile LAS unsigned*)(lds + SLOT_OFF))[hw_slot()] = threadIdx.x >> 6;
    __syncthreads();
    unsigned char* ws = a.ws; float* out = a.out;
    XcdBarrier bar = xcd_barrier_post((unsigned*)(ws + WS_CTL) + 4096, MISC + 8);
    bf16_t* W1t = (bf16_t*)(ws + WS_W1T); bf16_t* W2t = (bf16_t*)(ws + WS_W2T); bf16_t* W3t = (bf16_t*)(ws + WS_W3T); bf16_t* W4t = (bf16_t*)(ws + WS_W4T);
    bf16_t* xb = (bf16_t*)(ws + WS_XB); bf16_t* ymix = (bf16_t*)((unsigned char*)out + 96 * MiB); bf16_t* G = xb; bf16_t* U = (bf16_t*)(ws + WS_U);
    bf16_t* x1b = (bf16_t*)(ws + WS_X1B); bf16_t* P = (bf16_t*)(ws + WS_P); bf16_t* Sg = (bf16_t*)(ws + WS_S);
    f32x2* stat1 = (f32x2*)(ws + WS_STAT1); f32x2* stat2 = (f32x2*)(ws + WS_STAT2); f32x2* mr1 = (f32x2*)(ws + WS_MR1);

    phase_convert(a, lds);
    xcd_barrier(bar);
    { pg8::Gemm g{xb, W1t, NTOK, C_GD, DM, 0}; pg8::StaticOrder S; S.init(NTOK, C_GD, gridDim.x, blockIdx.x); EpiU E{U}; pg8::gemm_phase<EpiU, pg8::StaticOrder>(lds, g, S, E); }
    xcd_barrier(bar);
    phase_gla_pass1(a, lds);
    xcd_barrier(bar);
    phase_gla_pass2(a);
    phase_swa(a, lds);
    xcd_barrier(bar);
    phase_gla_pass3(a, lds);
    xcd_barrier(bar);
    { pg8::Gemm g{ymix, W2t, NTOK, DM, DM, 0}; pg8::StaticOrder S; S.init(NTOK, DM, gridDim.x, blockIdx.x);
      EpiLN<0> E{ws, nullptr, a.lng, a.lnb}; pg8::gemm_phase<EpiLN<0>, pg8::StaticOrder>(lds, g, S, E); }
    xcd_barrier(bar);
    { pg8::Gemm g{x1b, W3t, NTOK, 4096, DM, 0}; pg8::StaticOrder S; S.init(NTOK, 4096, gridDim.x, blockIdx.x); EpiG E{ws, a.cw}; pg8::gemm_phase<EpiG, pg8::StaticOrder>(lds, g, S, E); }
    xcd_barrier(bar);
    phase_convfix(a);
    xcd_barrier(bar);
    { pg8::Gemm g{G, W4t, NTOK, DM, DM, 0}; pg8::StaticOrder S; S.init(NTOK, DM, gridDim.x, blockIdx.x);
      EpiLN<1> E{ws, out, a.lng + DM, a.lnb + DM}; pg8::gemm_phase<EpiLN<1>, pg8::StaticOrder>(lds, g, S, E); }
}

extern "C" void kernel_launch(void* const* d_in, const int* in_sizes, int n_in, void* d_out, int out_size, void* d_ws, size_t ws_size, hipStream_t stream) {
    static int grid = 0;
    if (grid == 0) {
        if (n_in != 16 || out_size != NTOK * DM || ws_size < WS_END) { fprintf(stderr, "kernel_launch: unexpected shapes (n_in %d out %d ws %zu)\n", n_in, out_size, ws_size); grid = -1; return; }
        int dev = 0, cus = 0, per_cu = 0;
        if (hipGetDevice(&dev) != hipSuccess || hipDeviceGetAttribute(&cus, hipDeviceAttributeMultiprocessorCount, dev) != hipSuccess) { grid = -1; return; }
        if (hipFuncSetAttribute((const void*)mega, hipFuncAttributeMaxDynamicSharedMemorySize, LDS_BYTES) != hipSuccess) { fprintf(stderr, "kernel_launch: hipFuncSetAttribute failed\n"); grid = -1; return; }
        if (hipOccupancyMaxActiveBlocksPerMultiprocessor(&per_cu, (const void*)mega, NTHR, LDS_BYTES) != hipSuccess || per_cu < 1) { fprintf(stderr, "kernel_launch: occupancy query says %d blocks per CU\n", per_cu); (void)hipGetLastError(); grid = -1; return; }
        grid = cus;
    }
    if (grid < 0) return;
    (void)hipMemsetAsync((char*)d_ws + WS_CTL, 0, 262144, stream);
    Args a{};
    a.xp = (const float*)d_in[0]; a.xs = (const float*)d_in[1]; a.w_in_even = (const float*)d_in[2]; a.wuf = (const float*)d_in[3]; a.bfw = (const float*)d_in[4];
    a.wub = (const float*)d_in[5]; a.bbw = (const float*)d_in[6]; a.ng = (const float*)d_in[7]; a.sink = (const float*)d_in[8]; a.relb = (const float*)d_in[9];
    a.w_out_even = (const float*)d_in[10]; a.w_in_odd = (const float*)d_in[11]; a.cw = (const float*)d_in[12]; a.w_out_odd = (const float*)d_in[13];
    a.lng = (const float*)d_in[14]; a.lnb = (const float*)d_in[15]; a.out = (float*)d_out; a.ws = (unsigned char*)d_ws;
    hipLaunchKernelGGL(mega, dim3(grid), dim3(NTHR), LDS_BYTES, stream, a);
}
```

```cpp
#include <hip/hip_runtime.h>
#include <cstdio>

typedef unsigned short bf16_t;
typedef short bf16x8 __attribute__((ext_vector_type(8)));
typedef float f32x4 __attribute__((ext_vector_type(4)));
typedef float f32x2 __attribute__((ext_vector_type(2)));
typedef unsigned u32x4 __attribute__((ext_vector_type(4)));
typedef unsigned u32x2 __attribute__((ext_vector_type(2)));
#define LAS __attribute__((address_space(3)))
#define MFMA16(a, b, c) __builtin_amdgcn_mfma_f32_16x16x32_bf16((a), (b), (c), 0, 0, 0)
extern __shared__ __attribute__((aligned(16))) unsigned char lds_raw[];
constexpr int SLOT_OFF = 163840 - 1024;
__device__ __forceinline__ unsigned hw_slot() { return (unsigned)__builtin_amdgcn_s_getreg((5 << 11) | 4) & 63u; }
__device__ __forceinline__ int tid_now() {
    const int wid = __builtin_amdgcn_readfirstlane((int)((volatile LAS unsigned*)((LAS unsigned char*)lds_raw + SLOT_OFF))[hw_slot()]);
    return wid * 64 + (int)__lane_id();
}

constexpr int DM = 1024, NTOK = 49152, NPROMPT = 32768, LP = 16384, LS = 4096;
constexpr int UP = 3584;
constexpr int C_QA = 0, C_KA = 512, C_VA = 1024, C_ZA = 1536, C_QB = 2048, C_KB = 2560, C_VB = 2688, C_ZB = 2816, C_GD = 3328;
constexpr int EVEN_IN = 3360, ODD_IN = 4096;
constexpr float DN_ALPHA = 1.41421356237309515f;
constexpr float LN_EPS = 1e-5f, NORM_EPS = 1e-6f;

constexpr size_t MiB = 1u << 20;
constexpr size_t WS_CTL = 0, WS_W1T = 1 * MiB, WS_W2T = 8 * MiB, WS_W3T = 10 * MiB, WS_W4T = 18 * MiB, WS_STAT1 = 20 * MiB, WS_MR1 = 26 * MiB, WS_DEC = 27 * MiB, WS_GATE = 27 * MiB + 768 * 1024,
                 WS_XB = 28 * MiB  , WS_U = 124 * MiB, WS_ST = 460 * MiB, WS_END = 508 * MiB;
constexpr size_t WS_X1B = WS_U, WS_P = WS_U + 96 * MiB, WS_S = WS_U + 192 * MiB, WS_STAT2 = WS_U + 288 * MiB, WS_PB = WS_U + 296 * MiB, WS_SB = WS_U + 304 * MiB;

__device__ __forceinline__ float bf2f(bf16_t b) { return __uint_as_float(((unsigned)b) << 16); }
typedef __bf16 nbf16x2 __attribute__((ext_vector_type(2)));
__device__ __forceinline__ bf16_t f2bf(float f) { return __builtin_bit_cast(bf16_t, (__bf16)f); }
__device__ __forceinline__ unsigned pk2(float lo, float hi) { return __builtin_bit_cast(unsigned, __builtin_convertvector((f32x2){lo, hi}, nbf16x2)); }
__device__ __forceinline__ float fexp2(float x) { return __builtin_amdgcn_exp2f(x); }
__device__ __forceinline__ float fexp(float x) { return __builtin_amdgcn_exp2f(x * 1.4426950408889634f); }
__device__ __forceinline__ float flog2(float x) { return __builtin_amdgcn_logf(x); }
__device__ __forceinline__ float silu(float x) { return x * __builtin_amdgcn_rcpf(1.0f + fexp(-x)); }
__device__ __forceinline__ float wave_sum(float v) {
#pragma unroll
    for (int o = 1; o < 64; o <<= 1) v += __shfl_xor(v, o);
    return v;
}
__device__ __forceinline__ float wave_max(float v) {
#pragma unroll
    for (int o = 1; o < 64; o <<= 1) v = fmaxf(v, __shfl_xor(v, o));
    return v;
}
__device__ __forceinline__ void seq_of(int row, int& s0, int& L) {
    if (row < NPROMPT) { L = LP; s0 = row & ~(LP - 1); } else { L = LS; s0 = NPROMPT + ((row - NPROMPT) & ~(LS - 1)); }
}

namespace pg8 {
constexpr int BM = 256, BK = 64, HALF = 128, HTB = HALF * BK * 2, STAGE_BYTES = 8 * HTB, NXCD = 8, WGM = 8;
__host__ __device__ __forceinline__ int lds_byte(int r, int c) { const int st = (r >> 4) * 2 + (c >> 5), rr = r & 15, cc = c & 31, ob = rr * 64 + cc * 2; return st * 1024 + (ob ^ (((ob >> 9) & 1) << 5)); }
__host__ __device__ __forceinline__ void stage_rc(int b, int& R, int& C) { const int st = b / 1024, sb = b % 1024, swz = sb ^ (((sb >> 9) & 1) << 5); R = (st >> 1) * 16 + swz / 64; C = (st & 1) * 32 + (swz % 64) / 2; }
__host__ __device__ __forceinline__ int perm32(int rho) { const int n = rho >> 4, i = rho & 15; return 8 * (i >> 2) + 4 * n + (i & 3); }
struct Unit { int pm, pn; };
struct Gemm { const bf16_t* A; const bf16_t* Bt; int M, N, K, pad; };
struct StaticOrder {
    int nM, nN, nwg, G, c;
    __host__ __device__ void init(int M, int N, int G_, int c_) { nM = M / BM; nN = N / BM; nwg = nM * nN; G = G_; c = c_; }
    __host__ __device__ bool next(int i, Unit& u) const {
        const long L = (long)i * G + c; if (L >= nwg) return false;
        int wgid = (int)L; { const int q = nwg / NXCD, r = nwg % NXCD, xcd = wgid % NXCD, off = wgid / NXCD; wgid = (xcd < r ? xcd * (q + 1) : r * (q + 1) + (xcd - r) * q) + off; }
        const int nig = WGM * nN, gid = wgid / nig, fm = gid * WGM, gsz = (nM - fm) < WGM ? (nM - fm) : WGM;
        u.pm = fm + ((wgid % nig) % gsz); u.pn = (wgid % nig) / gsz; return true;
    }
    __device__ __forceinline__ void a_ready(const Unit&) const {}
    __device__ __forceinline__ void done(const Unit&) const {}
};

template <class Epi, class Sched>
__device__ __forceinline__ void gemm_phase(LAS unsigned char* lds, const Gemm g, const Sched& S, const Epi& E) {
    int tid = tid_now(); asm volatile("" : "+v"(tid));
    const int wid = __builtin_amdgcn_readfirstlane(tid >> 6), lane = tid & 63, wr = wid >> 2, wc = wid & 3, fr = lane & 15, fq = lane >> 4;
    const int K = g.K, nt = K / BK;
    unsigned voffA[2], voffB[2];
#pragma unroll
    for (int i = 0; i < 2; ++i) { int R, C; stage_rc(tid * 16 + i * 8192, R, C); const int Rb = Epi::PERM ? ((R & ~31) + perm32(R & 31)) : R;
        voffA[i] = (unsigned)(R * K + C) * 2u; voffB[i] = (unsigned)(Rb * K + C) * 2u; }
    const size_t kstep = (size_t)(BK * 2);
    const size_t hstep = (size_t)HALF * K * 2;
    const size_t tstep = 2 * hstep;
    const unsigned ldsw = (unsigned)wid * 1024u;
    const int aoff = lds_byte(wr * 64 + fr, fq * 8), boff = lds_byte(wc * 32 + fr, fq * 8);
#define PG8_SA(b, h) (((b) * 2 + (h)) * HTB)
#define PG8_SB(b, h) ((4 + (b) * 2 + (h)) * HTB)
#define PG8_STAGE(bufoff, gbase, voff) do { _Pragma("unroll") for (int _i = 0; _i < 2; ++_i) \
        __builtin_amdgcn_global_load_lds((const unsigned*)((const char*)(gbase) + (voff)[_i]), (LAS unsigned*)(lds + (bufoff) + ldsw + _i * 8192), 16, 0, 0); } while (0)
#define PG8_LDA(dst, b, h) do { _Pragma("unroll") for (int m = 0; m < 4; ++m) _Pragma("unroll") for (int k = 0; k < 2; ++k) dst[m][k] = *(const LAS bf16x8*)(lds + PG8_SA(b, h) + aoff + m * 2048 + k * 1024); } while (0)
#define PG8_LDB(dst, b, h) do { _Pragma("unroll") for (int n = 0; n < 2; ++n) _Pragma("unroll") for (int k = 0; k < 2; ++k) dst[n][k] = *(const LAS bf16x8*)(lds + PG8_SB(b, h) + boff + n * 2048 + k * 1024); } while (0)
#define PG8_MMA(ai, bj, At, Bt) do { __builtin_amdgcn_s_setprio(1); _Pragma("unroll") for (int m = 0; m < 4; ++m) _Pragma("unroll") for (int n = 0; n < 2; ++n) _Pragma("unroll") for (int k = 0; k < 2; ++k) \
        acc[ai][bj][m][n] = __builtin_amdgcn_mfma_f32_16x16x32_bf16(Bt[n][k], At[m][k], acc[ai][bj][m][n], 0, 0, 0); __builtin_amdgcn_s_setprio(0); } while (0)
#define PG8_WAIT_V(n) asm volatile("s_waitcnt vmcnt(" #n ")" ::: "memory")
#define PG8_WAIT_L(n) asm volatile("s_waitcnt lgkmcnt(" #n ")" ::: "memory")
#define PG8_BAR __builtin_amdgcn_s_barrier()
#define PG8_SCHED __builtin_amdgcn_sched_barrier(0)
    Unit cur, nxt; int ui = 0;
    if (!S.next(0, cur)) return;
    f32x4 acc[2][2][4][2];
#pragma unroll
    for (int a = 0; a < 2; ++a)
#pragma unroll
        for (int b = 0; b < 2; ++b)
#pragma unroll
            for (int m = 0; m < 4; ++m)
#pragma unroll
                for (int n = 0; n < 2; ++n) acc[a][b][m][n] = (f32x4){0.f, 0.f, 0.f, 0.f};
    bf16x8 At[4][2], B0[2][2], B1[2][2];
    const char* cA = (const char*)g.A + (size_t)cur.pm * tstep; const char* cB = (const char*)g.Bt + (size_t)cur.pn * tstep;
    S.a_ready(cur);
    PG8_STAGE(PG8_SB(0, 0), cB, voffB); PG8_STAGE(PG8_SA(0, 0), cA, voffA); PG8_STAGE(PG8_SB(0, 1), cB + hstep, voffB); PG8_STAGE(PG8_SA(0, 1), cA + hstep, voffA);
    if (wr == 1) PG8_BAR;
    PG8_WAIT_V(4); PG8_BAR;
    PG8_STAGE(PG8_SB(1, 0), cB + kstep, voffB); PG8_STAGE(PG8_SA(1, 0), cA + kstep, voffA); PG8_STAGE(PG8_SB(1, 1), cB + hstep + kstep, voffB);
    PG8_WAIT_V(6); PG8_BAR;
    for (;;) {
        const bool has_next = S.next(ui + 1, nxt);
        const char* nA = has_next ? (const char*)g.A + (size_t)nxt.pm * tstep : cA; const char* nB = has_next ? (const char*)g.Bt + (size_t)nxt.pn * tstep : cB;
        for (int t = 0; t < nt; t += 2) {
            const bool last = (t == nt - 2);
            const char* a1 = cA + (size_t)(t + 1) * kstep;
            const char* a2 = last ? nA : cA + (size_t)(t + 2) * kstep; const char* b2 = last ? nB : cB + (size_t)(t + 2) * kstep;
            const char* a3 = a2 + kstep; const char* b3 = b2 + kstep;
            if (last && has_next) S.a_ready(nxt);
            PG8_LDB(B0, 0, 0); PG8_SCHED; PG8_LDA(At, 0, 0); PG8_STAGE(PG8_SA(1, 1), a1 + hstep, voffA);
            PG8_WAIT_L(8); PG8_BAR; PG8_WAIT_L(0); PG8_MMA(0, 0, At, B0); PG8_BAR; PG8_SCHED;
            PG8_LDB(B1, 0, 1); PG8_STAGE(PG8_SB(0, 0), b2, voffB);
            PG8_BAR; PG8_WAIT_L(0); PG8_MMA(0, 1, At, B1); PG8_BAR;
            PG8_LDA(At, 0, 1); PG8_STAGE(PG8_SA(0, 0), a2, voffA);
            PG8_BAR; PG8_WAIT_L(0); PG8_MMA(1, 0, At, B0); PG8_BAR; PG8_SCHED;
            PG8_STAGE(PG8_SB(0, 1), b2 + hstep, voffB);
            PG8_WAIT_V(6); PG8_BAR; PG8_MMA(1, 1, At, B1); PG8_BAR;
            PG8_LDB(B0, 1, 0); PG8_SCHED; PG8_LDA(At, 1, 0); PG8_STAGE(PG8_SA(0, 1), a2 + hstep, voffA);
            PG8_WAIT_L(8); PG8_BAR; PG8_WAIT_L(0); PG8_MMA(0, 0, At, B0); PG8_BAR; PG8_SCHED;
            PG8_LDB(B1, 1, 1); PG8_STAGE(PG8_SB(1, 0), b3, voffB);
            PG8_BAR; PG8_WAIT_L(0); PG8_MMA(0, 1, At, B1); PG8_BAR;
            PG8_LDA(At, 1, 1); PG8_STAGE(PG8_SA(1, 0), a3, voffA);
            PG8_BAR; PG8_WAIT_L(0); PG8_MMA(1, 0, At, B0); PG8_BAR; PG8_SCHED;
            PG8_STAGE(PG8_SB(1, 1), b3 + hstep, voffB);
            PG8_WAIT_V(6); PG8_BAR; PG8_MMA(1, 1, At, B1); PG8_BAR;
        }
        if constexpr (Epi::REALIGN) { if (wr == 0) PG8_BAR; }
        E(acc, cur, wr, wc, fr, fq); S.done(cur);
        if constexpr (Epi::REALIGN) { if (wr == 1) PG8_BAR; }
        if (!has_next) break;
#pragma unroll
        for (int a = 0; a < 2; ++a)
#pragma unroll
            for (int b = 0; b < 2; ++b)
#pragma unroll
                for (int m = 0; m < 4; ++m)
#pragma unroll
                    for (int n = 0; n < 2; ++n) acc[a][b][m][n] = (f32x4){0.f, 0.f, 0.f, 0.f};
        cur = nxt; cA = nA; cB = nB; ++ui;
    }
    PG8_WAIT_V(0);
    if (wr == 0) PG8_BAR;
    PG8_BAR;
#undef PG8_SA
#undef PG8_SB
#undef PG8_STAGE
#undef PG8_LDA
#undef PG8_LDB
#undef PG8_MMA
#undef PG8_WAIT_V
#undef PG8_WAIT_L
#undef PG8_BAR
#undef PG8_SCHED
}
}

struct EpiU {
    static constexpr bool PERM = true, AFTER_DRAIN = false, REALIGN = false;
    bf16_t* O;
    __device__ __forceinline__ void operator()(const f32x4 (&acc)[2][2][4][2], const pg8::Unit& u, int wr, int wc, int fr, int fq) const {
        const int row0 = u.pm * 256 + wr * 64 + fr, col0 = u.pn * 256 + wc * 32 + 8 * fq;
#pragma unroll
        for (int ai = 0; ai < 2; ++ai)
#pragma unroll
            for (int m = 0; m < 4; ++m) { bf16_t* rowp = O + (size_t)(row0 + ai * 128 + m * 16) * UP + col0;
#pragma unroll
                for (int bj = 0; bj < 2; ++bj) { const f32x4 v0 = acc[ai][bj][m][0], v1 = acc[ai][bj][m][1];
                    u32x4 w; w.x = pk2(v0[0], v0[1]); w.y = pk2(v0[2], v0[3]); w.z = pk2(v1[0], v1[1]); w.w = pk2(v1[2], v1[3]);
                    *(u32x4*)(rowp + bj * 128) = w; } }
    }
};
template <int LAYER> struct EpiY {
    static constexpr bool PERM = false, AFTER_DRAIN = false, REALIGN = false;
    const float* xp; const float* xs; float* Y; f32x2* stat; const f32x2* mr; const float* lg; const float* lb;
    __device__ __forceinline__ void operator()(const f32x4 (&acc)[2][2][4][2], const pg8::Unit& u, int wr, int wc, int fr, int fq) const {
        const int col0 = u.pn * 256 + wc * 32 + 4 * fq;
        f32x4 gv[2][2], bv[2][2];
        if (LAYER == 1) {
#pragma unroll
            for (int bj = 0; bj < 2; ++bj)
#pragma unroll
                for (int n = 0; n < 2; ++n) { gv[bj][n] = *(const f32x4*)(lg + col0 + bj * 128 + n * 16); bv[bj][n] = *(const f32x4*)(lb + col0 + bj * 128 + n * 16); }
        }
#pragma unroll
        for (int ai = 0; ai < 2; ++ai)
#pragma unroll
            for (int m = 0; m < 4; ++m) {
                const int row = u.pm * 256 + ai * 128 + wr * 64 + m * 16 + fr;
                const float* rp; f32x2 mrv = (f32x2){0.f, 1.f};
                if (LAYER == 0) rp = (row < NPROMPT) ? xp + (size_t)row * DM : xs + (size_t)(row - NPROMPT) * DM;
                else { rp = Y + (size_t)row * DM; mrv = mr[row]; }
                float* yp = Y + (size_t)row * DM;
                float s = 0.f, q = 0.f;
#pragma unroll
                for (int bj = 0; bj < 2; ++bj)
#pragma unroll
                    for (int n = 0; n < 2; ++n) {
                        const int c = col0 + bj * 128 + n * 16;
                        f32x4 r = *(const f32x4*)(rp + c);
                        if (LAYER == 1) r = (r - mrv.x) * mrv.y * gv[bj][n] + bv[bj][n];
                        const f32x4 y = r * DN_ALPHA + acc[ai][bj][m][n];
                        *(f32x4*)(yp + c) = y;
                        s += (y[0] + y[1]) + (y[2] + y[3]); q += (y[0] * y[0] + y[1] * y[1]) + (y[2] * y[2] + y[3] * y[3]);
                    }
                s += __shfl_xor(s, 16); s += __shfl_xor(s, 32); q += __shfl_xor(q, 16); q += __shfl_xor(q, 32);
                if (fq == 0) stat[(size_t)row * 16 + u.pn * 4 + wc] = (f32x2){s, q};
            }
    }
};
#define RLX_AGENT __ATOMIC_RELAXED, __HIP_MEMORY_SCOPE_AGENT
template <int LAYER> struct EpiLN {
    static constexpr bool PERM = true, AFTER_DRAIN = false, REALIGN = true;
    unsigned char* ws; float* Of; const float* lg; const float* lb;
    __device__ __forceinline__ void operator()(f32x4 (&acc)[2][2][4][2], const pg8::Unit& u, int wr, int wc, int fr, int fq) const {
        unsigned char* w2 = ws; asm volatile("" : "+s"(w2));
        const bf16_t* R = (const bf16_t*)(w2 + (LAYER == 0 ? WS_XB : WS_X1B)); bf16_t* Ob = (bf16_t*)(w2 + WS_X1B);
        unsigned long long* xbuf = (unsigned long long*)(w2 + (LAYER == 0 ? WS_STAT1 : WS_STAT2)); unsigned* cnt = (unsigned*)(w2 + WS_CTL) + 16384 + LAYER * 192 * 64;
        const int col0 = u.pn * 256 + wc * 32 + 8 * fq, rowb = u.pm * 256 + wr * 64 + fr;
        float ps[2][4], pq[2][4];
#pragma unroll
        for (int ai = 0; ai < 2; ++ai)
#pragma unroll
            for (int m = 0; m < 4; ++m) {
                const bf16_t* rp = R + (size_t)(rowb + ai * 128 + m * 16) * DM + col0;
                float s = 0.f, q = 0.f;
#pragma unroll
                for (int bj = 0; bj < 2; ++bj) {
                    const u32x4 rw = *(const u32x4*)(rp + bj * 128);
                    f32x4 r0 = (f32x4){__uint_as_float(rw.x << 16), __uint_as_float(rw.x & 0xffff0000u), __uint_as_float(rw.y << 16), __uint_as_float(rw.y & 0xffff0000u)};
                    f32x4 r1 = (f32x4){__uint_as_float(rw.z << 16), __uint_as_float(rw.z & 0xffff0000u), __uint_as_float(rw.w << 16), __uint_as_float(rw.w & 0xffff0000u)};
                    const f32x4 v0 = r0 * DN_ALPHA + acc[ai][bj][m][0], v1 = r1 * DN_ALPHA + acc[ai][bj][m][1];
                    acc[ai][bj][m][0] = v0; acc[ai][bj][m][1] = v1;
                    s += ((v0[0] + v0[1]) + (v0[2] + v0[3])) + ((v1[0] + v1[1]) + (v1[2] + v1[3]));
                    q += ((v0[0] * v0[0] + v0[1] * v0[1]) + (v0[2] * v0[2] + v0[3] * v0[3])) + ((v1[0] * v1[0] + v1[1] * v1[1]) + (v1[2] * v1[2] + v1[3] * v1[3]));
                }
                s += __shfl_xor(s, 16); s += __shfl_xor(s, 32); q += __shfl_xor(q, 16); q += __shfl_xor(q, 32);
                ps[ai][m] = s; pq[ai][m] = q;
            }
        if (fq == 0) {
#pragma unroll
            for (int ai = 0; ai < 2; ++ai)
#pragma unroll
                for (int m = 0; m < 4; ++m)
                    __hip_atomic_store(xbuf + (size_t)(rowb + ai * 128 + m * 16) * 16 + u.pn * 4 + wc, ((unsigned long long)__float_as_uint(pq[ai][m]) << 32) | __float_as_uint(ps[ai][m]), RLX_AGENT);
        }
        asm volatile("s_waitcnt vmcnt(0)" ::: "memory");
        unsigned* c = cnt + 64 * u.pm;
        if ((tid_now() & 63) == 0) __hip_atomic_fetch_add(c, 1u, RLX_AGENT);
        { unsigned spins = 0;
          while ((unsigned)__builtin_amdgcn_readfirstlane(__hip_atomic_load(c, RLX_AGENT)) < 32u) { __builtin_amdgcn_s_sleep(2); if (++spins > (1u << 16)) break; }
          __builtin_amdgcn_fence(__ATOMIC_ACQUIRE, "agent"); }
#pragma unroll
        for (int ai = 0; ai < 2; ++ai)
#pragma unroll
            for (int m = 0; m < 4; ++m) {
                const unsigned long long* sp = xbuf + (size_t)(rowb + ai * 128 + m * 16) * 16 + 4 * fq;
                float s = 0.f, q = 0.f;
#pragma unroll
                for (int t = 0; t < 4; ++t) { const unsigned long long w8 = __hip_atomic_load(sp + t, RLX_AGENT); s += __uint_as_float((unsigned)w8); q += __uint_as_float((unsigned)(w8 >> 32)); }
                s += __shfl_xor(s, 16); s += __shfl_xor(s, 32); q += __shfl_xor(q, 16); q += __shfl_xor(q, 32);
                const float mean = s * (1.0f / DM), var = q * (1.0f / DM) - mean * mean;
                ps[ai][m] = mean; pq[ai][m] = rsqrtf(fmaxf(var, 0.f) + LN_EPS);
            }
#pragma unroll
        for (int bj = 0; bj < 2; ++bj) {
            const f32x4 g0 = *(const f32x4*)(lg + col0 + bj * 128), g1 = *(const f32x4*)(lg + col0 + bj * 128 + 4), b0 = *(const f32x4*)(lb + col0 + bj * 128), b1 = *(const f32x4*)(lb + col0 + bj * 128 + 4);
#pragma unroll
            for (int ai = 0; ai < 2; ++ai)
#pragma unroll
                for (int m = 0; m < 4; ++m) {
                    const int row = rowb + ai * 128 + m * 16; const float mean = ps[ai][m], rstd = pq[ai][m];
                    const f32x4 o0 = (acc[ai][bj][m][0] - mean) * rstd * g0 + b0, o1 = (acc[ai][bj][m][1] - mean) * rstd * g1 + b1;
                    if (LAYER == 0) { u32x4 w; w.x = pk2(o0[0], o0[1]); w.y = pk2(o0[2], o0[3]); w.z = pk2(o1[0], o1[1]); w.w = pk2(o1[2], o1[3]); *(u32x4*)(Ob + (size_t)row * DM + col0 + bj * 128) = w; }
                    else { float* op = Of + (size_t)row * DM + col0 + bj * 128; *(f32x4*)op = o0; *(f32x4*)(op + 4) = o1; }
                }
        }
    }
};
struct EpiPS {
    static constexpr bool PERM = true, AFTER_DRAIN = false, REALIGN = false;
    bf16_t* P; bf16_t* S;
    __device__ __forceinline__ void operator()(const f32x4 (&acc)[2][2][4][2], const pg8::Unit& u, int wr, int wc, int fr, int fq) const {
        const int row0 = u.pm * 256 + wr * 64 + fr, off = (wc & 1) * 32 + 8 * fq;
        bf16_t* dst = (wc < 2 ? S : P) + u.pn * 64 + off;
#pragma unroll
        for (int ai = 0; ai < 2; ++ai)
#pragma unroll
            for (int m = 0; m < 4; ++m) {
                float o[8];
#pragma unroll
                for (int n = 0; n < 2; ++n)
#pragma unroll
                    for (int j = 0; j < 4; ++j) { const float a = acc[ai][0][m][n][j], b = acc[ai][1][m][n][j];
                        o[4 * n + j] = (wc < 2) ? silu(b) * a : a * b; }
                u32x4 w; w.x = pk2(o[0], o[1]); w.y = pk2(o[2], o[3]); w.z = pk2(o[4], o[5]); w.w = pk2(o[6], o[7]);
                *(u32x4*)(dst + (size_t)(row0 + ai * 128 + m * 16) * DM) = w;
            }
    }
};

template <int CTRL> __device__ __forceinline__ float dpp_f(float x);
struct EpiG {
    static constexpr bool PERM = true, AFTER_DRAIN = false, REALIGN = false;
    unsigned char* ws; const float* cw;
    __device__ __forceinline__ void operator()(const f32x4 (&acc)[2][2][4][2], const pg8::Unit& u, int wr, int wc, int fr, int fq) const {
        unsigned char* w2 = ws; asm volatile("" : "+s"(w2));
        bf16_t* G = (bf16_t*)(w2 + WS_XB); float* Pb = (float*)(w2 + WS_PB); float* Sb = (float*)(w2 + WS_SB);
        const int ch0 = u.pn * 64 + 16 * wc + 4 * fq;
        const f32x4 c0 = *(const f32x4*)(cw + ch0), c1 = *(const f32x4*)(cw + 1024 + ch0), c2 = *(const f32x4*)(cw + 2048 + ch0);
#pragma unroll
        for (int ai = 0; ai < 2; ++ai) {
            f32x4 P[4], S[4];
#pragma unroll
            for (int m = 0; m < 4; ++m)
#pragma unroll
                for (int j = 0; j < 4; ++j) { P[m][j] = acc[ai][0][m][1][j] * acc[ai][1][m][1][j]; S[m][j] = silu(acc[ai][1][m][0][j]) * acc[ai][0][m][0][j]; }
            const int row0 = u.pm * 256 + ai * 128 + wr * 64 + fr;
#pragma unroll
            for (int m = 0; m < 4; ++m) {
                float o[4];
#pragma unroll
                for (int j = 0; j < 4; ++j) {
                    float pr = dpp_f<0x111>(P[m][j]);
                    if (m > 0) { const float t = dpp_f<0x121>(P[m - 1][j]); pr = fr == 0 ? t : pr; }
                    float nx = dpp_f<0x101>(P[m][j]);
                    if (m < 3) { const float t = dpp_f<0x12F>(P[m + 1][j]); nx = fr == 15 ? t : nx; }
                    o[j] = S[m][j] * (c0[j] * pr + c1[j] * P[m][j] + c2[j] * nx);
                }
                u32x2 w; w.x = pk2(o[0], o[1]); w.y = pk2(o[2], o[3]);
                *(u32x2*)(G + (size_t)(row0 + 16 * m) * DM + ch0) = w;
            }
            const int blk = u.pm * 4 + ai * 2 + wr;
            if (fr == 0) { *(f32x4*)(Pb + (size_t)(blk * 2) * 1024 + ch0) = P[0]; *(f32x4*)(Sb + (size_t)(blk * 2) * 1024 + ch0) = S[0]; }
            if (fr == 15) { *(f32x4*)(Pb + (size_t)(blk * 2 + 1) * 1024 + ch0) = P[3]; *(f32x4*)(Sb + (size_t)(blk * 2 + 1) * 1024 + ch0) = S[3]; }
        }
    }
};
#define XB_TMO      128
#define XB_XCNT(j)  (256  + 64 * (j))
#define XB_XSUB(j)  (1280 + 64 * (j))
#define XB_XGEN(j)  (2304 + 64 * (j))
#define XB_TOP      3328
#define XB_TOPGEN   3392
#define XCD_BAR_WORDS 3456
#define XB_SPIN_CAP (1u << 27)
__device__ __forceinline__ unsigned xb_ld(unsigned* p)              { return __hip_atomic_load(p, __ATOMIC_RELAXED, __HIP_MEMORY_SCOPE_AGENT); }
__device__ __forceinline__ unsigned xb_add(unsigned* p, unsigned v) { return __hip_atomic_fetch_add(p, v, __ATOMIC_RELAXED, __HIP_MEMORY_SCOPE_AGENT); }
__device__ __forceinline__ unsigned xb_xcc_id() { return (unsigned)__builtin_amdgcn_s_getreg((3 << 11) | 20) & 0xFu; }
#define XB_SPIN(cond, bar) do { unsigned _sp = 0; while (cond) { __builtin_amdgcn_s_sleep(1); \
    if ((++_sp & 255u) == 0u) { if (xb_ld(&(bar)[XB_TMO])) break; if (_sp > XB_SPIN_CAP) { atomicAdd(&(bar)[XB_TMO], 1u); break; } } } } while (0)
struct XcdBarrier { unsigned* bar; unsigned x; volatile LAS unsigned* st; };
__device__ __forceinline__ XcdBarrier xcd_barrier_post(unsigned* bar, volatile LAS unsigned* st) {
    XcdBarrier b; b.bar = bar; b.x = xb_xcc_id(); b.st = st;
    if (tid_now() == 0) (void)xb_add(&bar[XB_XCNT(b.x)], 1u);
    return b;
}
__device__ __forceinline__ void xcd_barrier_complete(unsigned* bar, unsigned x, unsigned& nloc, unsigned& nx) {
    const unsigned G = gridDim.x * gridDim.y * gridDim.z;
    unsigned sum, cnt, mine, sp = 0u;
    for (;;) {
        sum = 0u; cnt = 0u; mine = 0u;
#pragma unroll
        for (unsigned j = 0; j < 16; ++j) { const unsigned c = xb_ld(&bar[XB_XCNT(j)]); sum += c; cnt += (c > 0u) ? 1u : 0u; mine = (j == x) ? c : mine; }
        if (sum == G) break;
        __builtin_amdgcn_s_sleep(1);
        if ((++sp & 255u) == 0u) { if (xb_ld(&bar[XB_TMO])) break; if (sp > XB_SPIN_CAP) { atomicAdd(&bar[XB_TMO], 1u); break; } }
    }
    nloc = mine > 0u ? mine : 1u; nx = cnt > 0u ? cnt : 1u;
}
__device__ __forceinline__ void xcd_barrier(const XcdBarrier& b) {
    asm volatile("s_waitcnt vmcnt(0)" ::: "memory");
    __syncthreads();
    if (tid_now() == 0) {
        unsigned* bar = b.bar;
        __builtin_amdgcn_s_waitcnt(0);
        unsigned nloc = b.st[0], nx = b.st[1];
        if (nloc == 0u) { xcd_barrier_complete(bar, b.x, nloc, nx); b.st[0] = nloc; b.st[1] = nx; }
        const unsigned old = xb_add(&bar[XB_XSUB(b.x)], 1u);
        const unsigned gen = old / nloc;
        if (old + 1u == (gen + 1u) * nloc) {
            __builtin_amdgcn_fence(__ATOMIC_RELEASE, "agent");
            asm volatile("s_waitcnt vmcnt(0)" ::: "memory");
            const unsigned og = xb_add(&bar[XB_TOP], 1u);
            const unsigned tg = og / nx;
            if (og + 1u == (tg + 1u) * nx) xb_add(&bar[XB_TOPGEN], 1u);
            else XB_SPIN(xb_ld(&bar[XB_TOPGEN]) == tg, bar);
            __builtin_amdgcn_fence(__ATOMIC_ACQUIRE, "agent");
            xb_add(&bar[XB_XGEN(b.x)], 1u);
            asm volatile("s_waitcnt vmcnt(0)" ::: "memory");
        } else {
            XB_SPIN(xb_ld(&bar[XB_XGEN(b.x)]) == gen, bar);
            __builtin_amdgcn_fence(__ATOMIC_ACQUIRE, "agent");
            asm volatile("s_waitcnt vmcnt(0)" ::: "memory");
        }
    }
    __syncthreads();
}

struct Args {
    const float *xp, *xs, *w_in_even, *wuf, *bfw, *wub, *bbw, *ng, *sink, *relb, *w_out_even, *w_in_odd, *cw, *w_out_odd, *lng, *lnb;
    float* out; unsigned char* ws;
};
constexpr int NTHR = 512;
constexpr int LDS_BYTES = 163840, MISC_OFF = 163840 - 512;

template <int MODE> __device__ __forceinline__ int wmap(int n, float& sc) {
    sc = 1.f;
    if (MODE == 0) return n;
    if (MODE == 1) {
        if (n < 512) sc = 0.08838834764831845f;
        if (n >= C_QB && n < C_KB) sc = 0.125f;
        if (n < 2048) return n;
        if (n < C_GD) return n + 32;
        if (n < C_GD + 32) return n - C_GD + 2048;
        return -1;
    }
    const int c = n & 255, bj = (c >> 7) & 1, wc = (c >> 5) & 3, fq = (c >> 3) & 3, nn = (c >> 2) & 1, j = c & 3, q = 2 * bj + nn, ch = (n >> 8) * 64 + 16 * wc + 4 * fq + j;
    const int base = q == 0 ? 0 : (q == 1 ? 1024 : (q == 2 ? 3072 : 2048));
    return base + ch;
}
template <int MODE> __device__ __forceinline__ void wconv_item(const float* __restrict__ W, int Nsrc, bf16_t* __restrict__ Wt, int Ndst, int item, LAS float* tile, int t256) {
    const int nb = item % (Ndst / 64), kb = item / (Ndst / 64), n0 = nb * 64, k0 = kb * 64;
    const int tx = t256 & 63, ty = t256 >> 6;
    float sc; const int src = wmap<MODE>(n0 + tx, sc);
    for (int kk = ty; kk < 64; kk += 4) tile[kk * 65 + tx] = src >= 0 ? W[(size_t)(k0 + kk) * Nsrc + src] * sc : 0.f;
    __syncthreads();
    for (int nn = ty; nn < 64; nn += 4) Wt[(size_t)(n0 + nn) * 1024 + k0 + tx] = f2bf(tile[tx * 65 + nn]);
    __syncthreads();
}
__device__ __forceinline__ void build_gate_tables(const Args& a);
__device__ __forceinline__ void phase_convert(const Args& a, LAS unsigned char* lds) {
    unsigned char* ws = a.ws;
    bf16_t* W1t = (bf16_t*)(ws + WS_W1T); bf16_t* W2t = (bf16_t*)(ws + WS_W2T); bf16_t* W3t = (bf16_t*)(ws + WS_W3T); bf16_t* W4t = (bf16_t*)(ws + WS_W4T);
    const int half = tid_now() >> 8, t256 = tid_now() & 255;
    LAS float* tile = (LAS float*)lds + half * (64 * 65);
    constexpr int I1 = (C_GD / 64) * 16, I2 = 16 * 16, I3 = 64 * 16, I4 = 16 * 16, NIT = I1 + I2 + I3 + I4;
    for (int it0 = blockIdx.x * 2; it0 < NIT; it0 += gridDim.x * 2) {
        int r = it0 + half;
        if (r < I1) wconv_item<1>(a.w_in_even, EVEN_IN, W1t, C_GD, r, tile, t256);
        else if ((r -= I1) < I2) wconv_item<0>(a.w_out_even, 1024, W2t, 1024, r, tile, t256);
        else if ((r -= I2) < I3) wconv_item<2>(a.w_in_odd, ODD_IN, W3t, 4096, r, tile, t256);
        else if ((r -= I3) < I4) wconv_item<0>(a.w_out_odd, 1024, W4t, 1024, r, tile, t256);
        else { __syncthreads(); __syncthreads(); }
    }
    build_gate_tables(a);
    __syncthreads();
    {
        constexpr int WP = 1032, TP = 264;
        LAS bf16_t* wg = (LAS bf16_t*)lds; LAS bf16_t* tile0 = (LAS bf16_t*)(lds + 32 * WP * 2);
        const int tid = tid_now(), lane = tid & 63, w = tid >> 6, n = lane & 15, g = lane >> 4, rb = w & 3, ct = w >> 2;
        for (int e = tid; e < 32 * 1024; e += NTHR) { const int k = e >> 5, c = e & 31; wg[c * WP + k] = f2bf(a.w_in_even[(size_t)k * EVEN_IN + 2048 + c]); }
        bf16_t* xb = (bf16_t*)(ws + WS_XB); bf16_t* U = (bf16_t*)(ws + WS_U);
        f32x4 v[4][2];
        auto slab_load = [&](int it, int sl) {
#pragma unroll
            for (int i = 0; i < 4; ++i) { const int idx = tid + 512 * i, row = it * 64 + (idx >> 5), col = sl * 256 + 8 * (idx & 31);
                const float* src = (row < NPROMPT ? a.xp + (size_t)row * DM : a.xs + (size_t)(row - NPROMPT) * DM) + col;
                v[i][0] = *(const f32x4*)src; v[i][1] = *(const f32x4*)(src + 4); } };
        const int ntrip = NTOK / 64;
        if ((int)blockIdx.x < ntrip) slab_load(blockIdx.x, 0);
        int par = 0;
        for (int it = blockIdx.x; it < ntrip; it += gridDim.x) {
            f32x4 acc = (f32x4){0.f, 0.f, 0.f, 0.f};
#pragma unroll 1
            for (int sl = 0; sl < 4; ++sl) {
                LAS bf16_t* tile = tile0 + par * (64 * TP);
#pragma unroll
                for (int i = 0; i < 4; ++i) { const int idx = tid + 512 * i, r64 = idx >> 5, c8 = idx & 31;
                    u32x4 pw; pw.x = pk2(v[i][0][0], v[i][0][1]); pw.y = pk2(v[i][0][2], v[i][0][3]); pw.z = pk2(v[i][1][0], v[i][1][1]); pw.w = pk2(v[i][1][2], v[i][1][3]);
                    *(u32x4*)(xb + (size_t)(it * 64 + r64) * DM + sl * 256 + 8 * c8) = pw;
                    *(LAS u32x4*)(tile + r64 * TP + 8 * c8) = pw; }
                { const int nsl = (sl + 1) & 3, nit = sl < 3 ? it : (it + (int)gridDim.x < ntrip ? it + (int)gridDim.x : it); slab_load(nit, nsl); }
                __syncthreads();
#pragma unroll
                for (int ks = 0; ks < 8; ++ks) {
                    const bf16x8 af = *(const LAS bf16x8*)(tile + (16 * rb + n) * TP + 32 * ks + 8 * g), bfr = *(const LAS bf16x8*)(wg + (16 * ct + n) * WP + sl * 256 + 32 * ks + 8 * g);
                    acc = MFMA16(af, bfr, acc);
                }
                par ^= 1;
            }
#pragma unroll
            for (int r = 0; r < 4; ++r) U[(size_t)(it * 64 + rb * 16 + 4 * g + r) * UP + C_GD + 16 * ct + n] = f2bf(acc[r]);
        }
        __syncthreads();
    }
}

__device__ __forceinline__ void phase_gla_naive(const Args& a, LAS unsigned char* lds, float* OF, float* OB) {
    if (blockIdx.x >= 12) return;
    const bf16_t* U = (const bf16_t*)(a.ws + WS_U);
    const int grp = tid_now() >> 7, tid = tid_now() & 127, b = blockIdx.x * 4 + grp, dir = b & 1, h = (b >> 1) & 3, s = b >> 3;
    LAS float* sq = (LAS float*)lds + grp * (3 * 16 * 128); LAS float* sk = sq + 16 * 128; LAS float* sd = sk + 16 * 128;
    const int L = s < 2 ? LP : LS, start = s < 2 ? s * LP : NPROMPT + (s - 2) * LS;
    const float* wu = dir ? a.wub : a.wuf; const float* bias = dir ? a.bbw : a.bfw; float* O = dir ? OB : OF;
    float wr[16];
#pragma unroll
    for (int r = 0; r < 16; ++r) wr[r] = wu[r * 512 + h * 128 + tid];
    const float bb = bias[h * 128 + tid];
    float S[128];
#pragma unroll
    for (int i = 0; i < 128; ++i) S[i] = 0.f;
    for (int t0 = 0; t0 < L; t0 += 16) {
        for (int tt = 0; tt < 16; ++tt) {
            const int p = t0 + tt, tok = start + (dir ? L - 1 - p : p);
            const bf16_t* ur = U + (size_t)tok * UP;
            float x = bb;
#pragma unroll
            for (int r = 0; r < 16; ++r) x += bf2f(ur[C_GD + dir * 16 + r]) * wr[r];
            const float ls = fminf(x, 0.f) - log1pf(expf(-fabsf(x)));
            sd[tt * 128 + tid] = expf(ls * (1.0f / 16.0f));
            sq[tt * 128 + tid] = bf2f(ur[C_QA + h * 128 + tid]);
            sk[tt * 128 + tid] = bf2f(ur[C_KA + h * 128 + tid]);
        }
        __syncthreads();
        for (int tt = 0; tt < 16; ++tt) {
            const int p = t0 + tt, tok = start + (dir ? L - 1 - p : p);
            const float v = bf2f(U[(size_t)tok * UP + C_VA + h * 128 + tid]);
            float acc = 0.f;
#pragma unroll
            for (int dk = 0; dk < 128; dk += 4) {
                const f32x4 d4 = *(const LAS f32x4*)&sd[tt * 128 + dk], q4 = *(const LAS f32x4*)&sq[tt * 128 + dk], k4 = *(const LAS f32x4*)&sk[tt * 128 + dk];
#pragma unroll
                for (int j = 0; j < 4; ++j) {
                    const float sdec = S[dk + j] * d4[j];
                    const float sn = sdec + k4[j] * v;
                    acc += q4[j] * (dir ? sdec : sn);
                    S[dk + j] = sn;
                }
            }
            O[(size_t)tok * 512 + h * 128 + tid] = acc;
        }
        __syncthreads();
    }
}
__device__ __forceinline__ void phase_gla_combine(const Args& a, const float* OF, const float* OB) {
    const bf16_t* U = (const bf16_t*)(a.ws + WS_U); bf16_t* ymix = (bf16_t*)((unsigned char*)a.out + 96 * MiB);
    const int lane = tid_now() & 63;
    for (int w = blockIdx.x * 8 + (tid_now() >> 6); w < NTOK * 4; w += gridDim.x * 8) {
        const int tok = w >> 2, h = w & 3;
        const size_t o = (size_t)tok * 512 + h * 128 + lane * 2;
        const float a0 = OF[o] + OB[o], a1 = OF[o + 1] + OB[o + 1];
        const float ss = wave_sum(a0 * a0 + a1 * a1);
        const float rstd = rsqrtf(ss * (1.0f / 128.0f) + NORM_EPS);
        const bf16_t* z = U + (size_t)tok * UP + C_ZA + h * 128 + lane * 2;
        const float y0 = a0 * rstd * a.ng[lane * 2] * silu(bf2f(z[0])), y1 = a1 * rstd * a.ng[lane * 2 + 1] * silu(bf2f(z[1]));
        *(unsigned*)(ymix + (size_t)tok * DM + h * 128 + lane * 2) = pk2(y0, y1);
    }
}
__device__ __forceinline__ int t5_bucket(int rel) {
    const int n = rel < 0 ? -rel : rel;
    int b = n < 8 ? n : (n < 12 ? 8 : (n < 16 ? 9 : (n < 23 ? 10 : (n < 32 ? 11 : (n < 46 ? 12 : (n < 64 ? 13 : (n < 91 ? 14 : 15)))))));
    return b + (rel > 0 ? 16 : 0);
}
__device__ __forceinline__ void phase_swa_naive(const Args& a, LAS unsigned char* lds) {
    const bf16_t* U = (const bf16_t*)(a.ws + WS_U); bf16_t* ymix = (bf16_t*)((unsigned char*)a.out + 96 * MiB);
    const int wv = tid_now() >> 6, lane = tid_now() & 63;
    LAS float* sq = (LAS float*)(lds + 65536) + wv * 64; LAS float* sp = (LAS float*)(lds + 65536 + 2048) + wv * 320;
    for (int w = blockIdx.x * 8 + wv; w < NTOK * 8; w += gridDim.x * 8) {
        const int tok = w >> 3, hq = w & 7, kv = hq >> 2;
        int s0, L; seq_of(tok, s0, L); const int i = tok - s0;
        sq[lane] = bf2f(U[(size_t)tok * UP + C_QB + hq * 64 + lane]);
        const float snk = a.sink[hq];
        float sc[5]; float mx = snk;
#pragma unroll
        for (int c = 0; c < 5; ++c) {
            const int jj = c * 64 + lane, j = i - 128 + jj; const bool valid = jj <= 256 && j >= 0 && j < L;
            float d = -INFINITY;
            if (valid) {
                const bf16_t* kr = U + (size_t)(s0 + j) * UP + C_KB + kv * 64; d = 0.f;
#pragma unroll
                for (int e = 0; e < 64; e += 8) { const u32x4 kk = *(const u32x4*)(kr + e);
                    d += sq[e] * __uint_as_float(kk.x << 16) + sq[e + 1] * __uint_as_float(kk.x & 0xffff0000u) + sq[e + 2] * __uint_as_float(kk.y << 16) + sq[e + 3] * __uint_as_float(kk.y & 0xffff0000u)
                       + sq[e + 4] * __uint_as_float(kk.z << 16) + sq[e + 5] * __uint_as_float(kk.z & 0xffff0000u) + sq[e + 6] * __uint_as_float(kk.w << 16) + sq[e + 7] * __uint_as_float(kk.w & 0xffff0000u); }
                d += a.relb[t5_bucket(j - i) * 8 + hq];
            }
            sc[c] = d; mx = fmaxf(mx, d);
        }
        mx = wave_max(mx);
        float den = 0.f;
#pragma unroll
        for (int c = 0; c < 5; ++c) { sc[c] = sc[c] == -INFINITY ? 0.f : __expf(sc[c] - mx); den += sc[c]; }
        den = wave_sum(den) + __expf(snk - mx);
        const float inv = 1.0f / den;
#pragma unroll
        for (int c = 0; c < 5; ++c) sp[c * 64 + lane] = sc[c] * inv;
        float o = 0.f;
        for (int jj = 0; jj <= 256; ++jj) { const int j = i - 128 + jj; if (j >= 0 && j < L) o += sp[jj] * bf2f(U[(size_t)(s0 + j) * UP + C_VB + kv * 64 + lane]); }
        const float z = bf2f(U[(size_t)tok * UP + C_ZB + hq * 64 + lane]);
        ymix[(size_t)tok * DM + 512 + hq * 64 + lane] = f2bf(o * silu(z));
    }
}
template <int FINAL>
__device__ __forceinline__ void phase_ln(float* Y, const f32x2* stat, f32x2* mr, const float* lg, const float* lb, bf16_t* xb) {
    const int lane = tid_now() & 63;
    for (int row = blockIdx.x * 8 + (tid_now() >> 6); row < NTOK; row += gridDim.x * 8) {
        f32x2 p = lane < 16 ? stat[(size_t)row * 16 + lane] : (f32x2){0.f, 0.f};
        const float s = wave_sum(p.x), q = wave_sum(p.y);
        const float mean = s * (1.0f / DM), var = q * (1.0f / DM) - mean * mean, rstd = rsqrtf(fmaxf(var, 0.f) + LN_EPS);
        if (!FINAL && lane == 0) mr[row] = (f32x2){mean, rstd};
#pragma unroll
        for (int j = 0; j < 4; ++j) {
            const int c = j * 256 + lane * 4;
            const f32x4 y = *(const f32x4*)(Y + (size_t)row * DM + c), g = *(const f32x4*)(lg + c), b = *(const f32x4*)(lb + c);
            const f32x4 o = (y - mean) * rstd * g + b;
            if (FINAL) *(f32x4*)(Y + (size_t)row * DM + c) = o;
            else { u32x2 w; w.x = pk2(o[0], o[1]); w.y = pk2(o[2], o[3]); *(u32x2*)(xb + (size_t)row * DM + c) = w; }
        }
    }
}
__device__ __forceinline__ void phase_convgate(const bf16_t* P, const bf16_t* S, const float* cw, bf16_t* G) {
    const size_t n8 = (size_t)NTOK * DM / 8;
    for (size_t i = (size_t)blockIdx.x * NTHR + tid_now(); i < n8; i += (size_t)gridDim.x * NTHR) {
        const int row = (int)(i >> 7), c = (int)(i & 127) * 8; int s0, L; seq_of(row, s0, L);
        const bool hasl = row > s0, hasr = row < s0 + L - 1;
        const u32x4 pm = *(const u32x4*)(P + (size_t)row * DM + c), sv = *(const u32x4*)(S + (size_t)row * DM + c);
        u32x4 pl = (u32x4){0, 0, 0, 0}, pr = (u32x4){0, 0, 0, 0};
        if (hasl) pl = *(const u32x4*)(P + (size_t)(row - 1) * DM + c);
        if (hasr) pr = *(const u32x4*)(P + (size_t)(row + 1) * DM + c);
        float o[8];
#pragma unroll
        for (int j = 0; j < 4; ++j) {
            const unsigned l = pl[j], m = pm[j], r = pr[j], sw = sv[j];
            const int cc = c + 2 * j;
            o[2 * j] = __uint_as_float(sw << 16) * (cw[cc] * __uint_as_float(l << 16) + cw[1024 + cc] * __uint_as_float(m << 16) + cw[2048 + cc] * __uint_as_float(r << 16));
            o[2 * j + 1] = __uint_as_float(sw & 0xffff0000u) * (cw[cc + 1] * __uint_as_float(l & 0xffff0000u) + cw[1024 + cc + 1] * __uint_as_float(m & 0xffff0000u) + cw[2048 + cc + 1] * __uint_as_float(r & 0xffff0000u));
        }
        u32x4 w; w.x = pk2(o[0], o[1]); w.y = pk2(o[2], o[3]); w.z = pk2(o[4], o[5]); w.w = pk2(o[6], o[7]);
        *(u32x4*)(G + (size_t)row * DM + c) = w;
    }
}

typedef short s16x4 __attribute__((ext_vector_type(4)));
constexpr int GL_QT = 0, GL_KT = 16384, GL_VT = 32768, GL_PT = 49152, GL_B = 57344, GL_GD = 90112, GL_TOT = 94208, GL_EBL = 96256  , GL_SSW = 97280, GL_RSTD = 99328;
constexpr int NSEG = NTOK / 256;
__device__ __forceinline__ unsigned offb(unsigned row, unsigned ch) { return 256u * row + 16u * (ch ^ (((row & 3) << 2) | ((row >> 2) & 3))); }
__device__ __forceinline__ unsigned offp(unsigned row, unsigned ch) { return 128u * row + 16u * (ch ^ (row & 7)); }
__device__ __forceinline__ unsigned rr16(unsigned lane, unsigned rb, unsigned s) { return offb((lane & 15) + 16 * rb, 4 * s + (lane >> 4)); }
__device__ __forceinline__ unsigned tr16(unsigned lane, unsigned c, unsigned ks, unsigned t) {
    const unsigned g = lane >> 4, q = (lane & 15) >> 2, p = lane & 3;
    return offb(32 * ks + 8 * g + 4 * t + q, 2 * c + (p >> 1)) + 8 * (p & 1);
}
__device__ __forceinline__ bf16x8 tr_read8(unsigned a0, unsigned a1) {
    s16x4 r0, r1;
    asm volatile("ds_read_b64_tr_b16 %0, %2\n\tds_read_b64_tr_b16 %1, %3\n\ts_waitcnt lgkmcnt(0)" : "=&v"(r0), "=&v"(r1) : "v"(a0), "v"(a1) : "memory");
    return __builtin_shufflevector(r0, r1, 0, 1, 2, 3, 4, 5, 6, 7);
}
__device__ __forceinline__ void unpack8(const u32x4 w, float (&f)[8]) {
#pragma unroll
    for (int j = 0; j < 4; ++j) { f[2 * j] = __uint_as_float(w[j] << 16); f[2 * j + 1] = __uint_as_float(w[j] & 0xffff0000u); }
}

struct GlaPre { u32x4 gd[4]; u32x4 q[2], k[2], v[2]; u32x4 wf; float wb; };
template <int MODE>
__device__ __forceinline__ void gla_prefetch(const Args& a, GlaPre& pre, int tid, int tb, int h, int dir, int stidx) {
    const bf16_t* U = (const bf16_t*)(a.ws + WS_U);
    const int lane = tid & 63, n = lane & 15, g = lane >> 4, w = tid >> 6;
#pragma unroll
    for (int it = 0; it < 4; ++it) { const int row = 16 * it + n, tok = dir ? tb + 63 - row : tb + row; pre.gd[it] = *(const u32x4*)(U + (size_t)tok * UP + C_GD + dir * 16 + 8 * (g & 1)); }
#pragma unroll
    for (int i = 0; i < 2; ++i) {
        const int idx = tid + 512 * i, row = idx >> 4, ch = idx & 15, tok = dir ? tb + 63 - row : tb + row;
        const bf16_t* ur = U + (size_t)tok * UP + h * 128 + ch * 8;
        pre.v[i] = *(const u32x4*)(ur + C_VA); pre.k[i] = *(const u32x4*)(ur + C_KA);
        if (MODE != 0) pre.q[i] = *(const u32x4*)(ur + C_QA);
    }
    pre.wf = ((const u32x4*)(a.ws + WS_GATE))[(dir * 4 + h) * 512 + tid];
    pre.wb = ((const float*)(a.ws + WS_GATE + 65536))[(dir * 4 + h) * 128 + 16 * w + n];
}
__device__ __forceinline__ bf16x8 tr_read8(LAS unsigned char* lds, unsigned a0, unsigned a1) {
    const s16x4 r0 = __builtin_amdgcn_ds_read_tr16_b64_v4i16((LAS s16x4*)(lds + a0)), r1 = __builtin_amdgcn_ds_read_tr16_b64_v4i16((LAS s16x4*)(lds + a1));
    return __builtin_shufflevector(r0, r1, 0, 1, 2, 3, 4, 5, 6, 7);
}
template <int CTRL> __device__ __forceinline__ float dpp_f(float x) { return __int_as_float(__builtin_amdgcn_update_dpp(0, __float_as_int(x), CTRL, 0xf, 0xf, true)); }
constexpr int GL_BP = 132;
template <int MODE>
__device__ __forceinline__ void gla_chunk(const Args& a, LAS unsigned char* lds, const int tb, const int h, const int dir,
                                          f32x4 (&Sacc)[8], float& lam, u32x4* stash, GlaPre& pre, const int ntb, const int nh, const int ndir, const bool first, const int par) {
    const bf16_t* U = (const bf16_t*)(a.ws + WS_U);
    int tid = tid_now(); asm volatile("" : "+v"(tid));
    const int lane = tid & 63, w = __builtin_amdgcn_readfirstlane(tid >> 6), n = lane & 15, g = lane >> 4;
    const unsigned fn = ((n & 3) << 2) | ((n >> 2) & 3);
    const unsigned base_rr = 256u * n + 16u * (g ^ fn);
    const unsigned base_c = 256u * n + 16u * ((g >> 1) ^ fn) + 8u * (g & 1);
    const unsigned base_p = 128u * n + 16u * (g ^ (n & 7));
    const unsigned trb0 = tr16(lane, 0, 0, 0), trb1 = tr16(lane, 0, 0, 1);
    GlaPre& cur = pre;
    const bf16x8 wfrag = __builtin_bit_cast(bf16x8, cur.wf); const float wbias = cur.wb;
    int prow[2], pch[2], ptok[2];
#pragma unroll
    for (int i = 0; i < 2; ++i) { const int idx = tid + 512 * i; prow[i] = idx >> 4; pch[i] = idx & 15; ptok[i] = dir ? tb + 63 - prow[i] : tb + prow[i]; }
    u32x4 st0, st1, zraw[2];
    {
        LAS float* B = (LAS float*)(lds + GL_B);
        bf16x8 vh[2], vl[2];
#pragma unroll
        for (int ks = 0; ks < 2; ++ks) {
            float vv[8];
#pragma unroll
            for (int half = 0; half < 2; ++half) {
                const f32x4 x = MFMA16(__builtin_bit_cast(bf16x8, cur.gd[2 * ks + half]), wfrag, ((f32x4){wbias, wbias, wbias, wbias}));
#pragma unroll
                for (int r = 0; r < 4; ++r) { const float xs = x[r] * 1.4426950408889634f; vv[4 * half + r] = (fminf(xs, 0.f) - flog2(1.0f + fexp2(-fabsf(xs)))) * (1.0f / 16.0f); }
            }
            u32x4 hw, lw;
#pragma unroll
            for (int q = 0; q < 4; ++q) { const unsigned hp = pk2(vv[2 * q], vv[2 * q + 1]); hw[q] = hp;
                lw[q] = pk2(vv[2 * q] - __uint_as_float(hp << 16), vv[2 * q + 1] - __uint_as_float(hp & 0xffff0000u)); }
            vh[ks] = __builtin_bit_cast(bf16x8, hw); vl[ks] = __builtin_bit_cast(bf16x8, lw);
        }
        u32x4 ta, tbm;
#pragma unroll
        for (int q = 0; q < 2; ++q) { const unsigned lo = (4 * g + 2 * q <= n) ? 0x3f80u : 0u, hi = (4 * g + 2 * q + 1 <= n) ? 0x3f800000u : 0u; ta[q] = lo | hi; ta[2 + q] = 0u; tbm[q] = 0x3f803f80u; tbm[2 + q] = lo | hi; }
        const bf16x8 TA = __builtin_bit_cast(bf16x8, ta), TB = __builtin_bit_cast(bf16x8, tbm), ONES = __builtin_bit_cast(bf16x8, ((u32x4){0x3f803f80u, 0x3f803f80u, 0x3f803f80u, 0x3f803f80u}));
        const f32x4 z4 = (f32x4){0.f, 0.f, 0.f, 0.f};
        f32x4 bt[4];
        bt[0] = MFMA16(TA, vl[0], MFMA16(TA, vh[0], z4));
        bt[1] = MFMA16(TB, vl[0], MFMA16(TB, vh[0], z4));
        const f32x4 s32 = MFMA16(ONES, vl[0], MFMA16(ONES, vh[0], z4));
        bt[2] = MFMA16(TA, vl[1], MFMA16(TA, vh[1], s32));
        bt[3] = MFMA16(TB, vl[1], MFMA16(TB, vh[1], s32));
#pragma unroll
        for (int it = 0; it < 4; ++it)
#pragma unroll
            for (int r = 0; r < 4; ++r) B[(16 * it + 4 * g + r) * GL_BP + 16 * w + n] = bt[it][r];
        if (g == 3) { ((LAS float*)(lds + GL_EBL + par * 512))[16 * w + n] = fexp2(bt[3][3]); lam += bt[3][3]; }
    }
    __syncthreads();
#pragma unroll
    for (int i = 0; i < 2; ++i) {
        const LAS f32x4* bp = (const LAS f32x4*)(lds + GL_B + (prow[i] * GL_BP + pch[i] * 8) * 4);
        const f32x4 b0 = bp[0], b1 = bp[1];
        float e[8], kf[8];
#pragma unroll
        for (int j = 0; j < 4; ++j) { e[j] = fexp2(b0[j]); e[4 + j] = fexp2(b1[j]); }
        unpack8(cur.k[i], kf);
        u32x4 kw;
#pragma unroll
        for (int j = 0; j < 4; ++j) kw[j] = pk2(kf[2 * j] * __builtin_amdgcn_rcpf(e[2 * j]), kf[2 * j + 1] * __builtin_amdgcn_rcpf(e[2 * j + 1]));
        *(LAS u32x4*)(lds + GL_KT + offb(prow[i], pch[i])) = kw;
        *(LAS u32x4*)(lds + GL_VT + offb(prow[i], pch[i])) = cur.v[i];
        if (MODE != 0) {
            float qf[8]; unpack8(cur.q[i], qf);
            u32x4 qw;
#pragma unroll
            for (int j = 0; j < 4; ++j) qw[j] = pk2(qf[2 * j] * e[2 * j], qf[2 * j + 1] * e[2 * j + 1]);
            *(LAS u32x4*)(lds + GL_QT + offb(prow[i], pch[i])) = qw;
        }
    }
    __syncthreads();
    gla_prefetch<MODE>(a, pre, tid, ntb, nh, ndir, -1);
    f32x4 Oacc[4];
    if (MODE != 0) {
        const int it = w >> 1;
#pragma unroll
        for (int jj = 0; jj < 2; ++jj) {
            const int jt = 2 * (w & 1) + jj;
            f32x4 pacc = (f32x4){0.f, 0.f, 0.f, 0.f};
            if (jt <= it) {
#pragma unroll
                for (int s = 0; s < 4; ++s) {
                    const bf16x8 qa = *(const LAS bf16x8*)(lds + GL_QT + (base_rr ^ (64u * s)) + 4096u * it);
                    const bf16x8 kb = *(const LAS bf16x8*)(lds + GL_KT + (base_rr ^ (64u * s)) + 4096u * jt); pacc = MFMA16(qa, kb, pacc); }
            }
            const int j = 16 * jt + n;
#pragma unroll
            for (int r = 0; r < 4; ++r) {
                const int i = 16 * it + 4 * g + r;
                const bool keep = (MODE == 1) ? (j <= i) : (j < i);
                *(LAS bf16_t*)(lds + GL_PT + offp(i, j >> 3) + 2 * (j & 7)) = keep ? f2bf(pacc[r]) : (bf16_t)0;
            }
            __builtin_amdgcn_sched_barrier(0);
        }
        if (first) {
#pragma unroll
            for (int kt = 0; kt < 8; ++kt) { const unsigned r0 = __float_as_uint(Sacc[kt][0]), r1 = __float_as_uint(Sacc[kt][1]);
                Sacc[kt] = (f32x4){__uint_as_float(r0 << 16), __uint_as_float(r0 & 0xffff0000u), __uint_as_float(r1 << 16), __uint_as_float(r1 & 0xffff0000u)}; }
        }
#pragma unroll
        for (int i2 = 0; i2 < 4; ++i2) Oacc[i2] = (f32x4){0.f, 0.f, 0.f, 0.f};
#pragma unroll
        for (int ks = 0; ks < 4; ++ks) {
            u32x4 pw; pw.x = pk2(Sacc[2 * ks][0], Sacc[2 * ks][1]); pw.y = pk2(Sacc[2 * ks][2], Sacc[2 * ks][3]); pw.z = pk2(Sacc[2 * ks + 1][0], Sacc[2 * ks + 1][1]); pw.w = pk2(Sacc[2 * ks + 1][2], Sacc[2 * ks + 1][3]);
            const bf16x8 sb = __builtin_bit_cast(bf16x8, pw);
            const unsigned alo = base_c ^ (64u * ks);
#pragma unroll
            for (int i2 = 0; i2 < 4; ++i2) {
                const u32x2 lo = *(const LAS u32x2*)(lds + GL_QT + 4096 * i2 + alo);
                const u32x2 hi = *(const LAS u32x2*)(lds + GL_QT + 4096 * i2 + (alo ^ 32u));
                u32x4 aw; aw.x = lo.x; aw.y = lo.y; aw.z = hi.x; aw.w = hi.y;
                Oacc[i2] = MFMA16(__builtin_bit_cast(bf16x8, aw), sb, Oacc[i2]);
            }
            __builtin_amdgcn_sched_barrier(0);
        }
        __syncthreads();
        if (MODE == 2) {
            st0 = stash[tid * 2]; st1 = stash[tid * 2 + 1];
#pragma unroll
            for (int i = 0; i < 2; ++i) zraw[i] = *(const u32x4*)(U + (size_t)ptok[i] * UP + C_ZA + h * 128 + pch[i] * 8);
        }
    }
    bf16x8 vf[2];
#pragma unroll
    for (int ks = 0; ks < 2; ++ks) vf[ks] = tr_read8(lds, GL_VT + 8192u * ks + (trb0 ^ (32u * w)), GL_VT + 8192u * ks + (trb1 ^ (32u * w)));
    if (MODE != 0) {
#pragma unroll
        for (int i2 = 0; i2 < 4; ++i2)
#pragma unroll
            for (int ks = 0; ks < 2; ++ks) {
                if (ks <= (i2 >> 1)) { const bf16x8 pa = *(const LAS bf16x8*)(lds + GL_PT + 2048 * i2 + (base_p ^ (64u * ks))); Oacc[i2] = MFMA16(pa, vf[ks], Oacc[i2]); }
            }
    }
#pragma unroll
    for (int kt = 0; kt < 8; ++kt) {
#pragma unroll
        for (int ks = 0; ks < 2; ++ks) { const bf16x8 ka = tr_read8(lds, GL_KT + 8192u * ks + (trb0 ^ (32u * kt)), GL_KT + 8192u * ks + (trb1 ^ (32u * kt))); Sacc[kt] = MFMA16(ka, vf[ks], Sacc[kt]); }
        const f32x4 eb = *(const LAS f32x4*)(lds + GL_EBL + par * 512 + (16 * kt + 4 * g) * 4);
        Sacc[kt] = Sacc[kt] * eb;
        if (kt & 1) __builtin_amdgcn_sched_barrier(0);
    }
    if (MODE == 1) {
        u32x4 s0, s1;
        s0.x = pk2(Oacc[3][3], Oacc[3][2]); s0.y = pk2(Oacc[3][1], Oacc[3][0]); s0.z = pk2(Oacc[2][3], Oacc[2][2]); s0.w = pk2(Oacc[2][1], Oacc[2][0]);
        s1.x = pk2(Oacc[1][3], Oacc[1][2]); s1.y = pk2(Oacc[1][1], Oacc[1][0]); s1.z = pk2(Oacc[0][3], Oacc[0][2]); s1.w = pk2(Oacc[0][1], Oacc[0][0]);
        const int tidm = tid ^ 48;
        stash[tidm * 2] = s0; stash[tidm * 2 + 1] = s1;
    }
    if (MODE == 2) {
        float fo[16]; { float t8[8]; unpack8(st0, t8);
#pragma unroll
            for (int j = 0; j < 8; ++j) fo[j] = t8[j]; unpack8(st1, t8);
#pragma unroll
            for (int j = 0; j < 8; ++j) fo[8 + j] = t8[j]; }
        LAS float* ssw = (LAS float*)(lds + GL_SSW);
#pragma unroll
        for (int i2 = 0; i2 < 4; ++i2)
#pragma unroll
            for (int r = 0; r < 4; ++r) {
                const float o = Oacc[i2][r] + fo[4 * i2 + r]; Oacc[i2][r] = o;
                float v = o * o; v += dpp_f<0x128>(v); v += dpp_f<0x124>(v); v += dpp_f<0x122>(v); v += dpp_f<0x121>(v);
                if (n == 0) ssw[w * 64 + 16 * i2 + 4 * g + r] = v;
            }
        __syncthreads();
        if (tid < 64) { float s = 0.f;
#pragma unroll
            for (int ww = 0; ww < 8; ++ww) s += ssw[ww * 64 + tid];
            ((LAS float*)(lds + GL_RSTD))[tid] = rsqrtf(s * (1.0f / 128.0f) + NORM_EPS); }
        __syncthreads();
        const float gn = a.ng[16 * w + n];
#pragma unroll
        for (int i2 = 0; i2 < 4; ++i2) {
            const f32x4 rs = *(const LAS f32x4*)(lds + GL_RSTD + (16 * i2 + 4 * g) * 4);
#pragma unroll
            for (int r = 0; r < 4; ++r) *(LAS bf16_t*)(lds + GL_QT + (16 * i2 + 4 * g + r) * 256 + (16 * w + n) * 2) = f2bf(Oacc[i2][r] * rs[r] * gn);
        }
        __syncthreads();
        bf16_t* ymix = (bf16_t*)((unsigned char*)a.out + 96 * MiB);
#pragma unroll
        for (int i = 0; i < 2; ++i) {
            const u32x4 ov = *(const LAS u32x4*)(lds + GL_QT + prow[i] * 256 + pch[i] * 16);
            float of[8], zf[8]; unpack8(ov, of); unpack8(zraw[i], zf);
            u32x4 yw;
#pragma unroll
            for (int j = 0; j < 4; ++j) yw[j] = pk2(of[2 * j] * silu(zf[2 * j]), of[2 * j + 1] * silu(zf[2 * j + 1]));
            *(u32x4*)(ymix + (size_t)ptok[i] * DM + h * 128 + pch[i] * 8) = yw;
        }
    }
}
__device__ __forceinline__ void build_gate_tables(const Args& a) {
    for (int e = blockIdx.x * NTHR + tid_now(); e < 8 * 512; e += gridDim.x * NTHR) {
        const int dh = e >> 9, tid = e & 511, dir = dh >> 2, h = dh & 3, lane = tid & 63, w = tid >> 6, n = lane & 15, g = lane >> 4, col = h * 128 + 16 * w + n;
        const float* wup = dir ? a.wub : a.wuf; const float* bias = dir ? a.bbw : a.bfw;
        u32x4 pw;
#pragma unroll
        for (int j = 0; j < 4; ++j) {
            const float v0 = wup[(8 * (g & 1) + 2 * j) * 512 + col], v1 = wup[(8 * (g & 1) + 2 * j + 1) * 512 + col];
            const float h0 = bf2f(f2bf(v0)), h1 = bf2f(f2bf(v1));
            pw[j] = g < 2 ? pk2(v0, v1) : pk2(v0 - h0, v1 - h1);
        }
        ((u32x4*)(a.ws + WS_GATE))[e] = pw;
        if (g == 0) ((float*)(a.ws + WS_GATE + 65536))[dh * 128 + 16 * w + n] = bias[col];
    }
}
__device__ __forceinline__ void phase_gla_pass1(const Args& a, LAS unsigned char* lds) {
    const int tid = tid_now(), w = tid >> 6, lane = tid & 63;
    unsigned char* ST = a.ws + WS_ST;
    const int nsteps = ((NSEG * 8 - (int)blockIdx.x + (int)gridDim.x - 1) / (int)gridDim.x) * 4;
    auto params = [&](int st, int& tb, int& h, int& dir) { if (st >= nsteps) st = nsteps - 1; const int item = blockIdx.x + (st >> 2) * gridDim.x, cc = st & 3; dir = item & 1; h = (item >> 1) & 3; tb = (item >> 3) * 256 + (dir ? 3 - cc : cc) * 64; };
    GlaPre preA, preB; int par = 0;
    if (nsteps > 0) { int tb, h, dir; params(0, tb, h, dir); gla_prefetch<0>(a, preA, tid, tb, h, dir, -1); params(1, tb, h, dir); gla_prefetch<0>(a, preB, tid, tb, h, dir, -1); }
    f32x4 Sacc[8]; float lam;
    for (int st = 0; st < nsteps; st += 2) {
        const int item = blockIdx.x + (st >> 2) * gridDim.x;
        if ((st & 3) == 0) {
#pragma unroll
            for (int kt = 0; kt < 8; ++kt) Sacc[kt] = (f32x4){0.f, 0.f, 0.f, 0.f};
            lam = 0.f;
        }
        { int tb, h, dir, ntb, nh, ndir; params(st, tb, h, dir); params(st + 2, ntb, nh, ndir); gla_chunk<0>(a, lds, tb, h, dir, Sacc, lam, nullptr, preA, ntb, nh, ndir, false, par); par ^= 1; }
        { int tb, h, dir, ntb, nh, ndir; params(st + 1, tb, h, dir); params(st + 3, ntb, nh, ndir); gla_chunk<0>(a, lds, tb, h, dir, Sacc, lam, nullptr, preB, ntb, nh, ndir, false, par); par ^= 1; }
        if ((st & 3) == 2) {
            u32x2* dst = (u32x2*)(ST + (size_t)item * 32768) + (size_t)w * 8 * 64 + lane;
#pragma unroll
            for (int kt = 0; kt < 8; ++kt) { u32x2 v; v.x = pk2(Sacc[kt][0], Sacc[kt][1]); v.y = pk2(Sacc[kt][2], Sacc[kt][3]); dst[kt * 64] = v; }
            if ((lane >> 4) == 3) ((float*)(a.ws + WS_DEC))[(size_t)item * 128 + 16 * w + (lane & 15)] = lam;
        }
    }
    __syncthreads();
}
__device__ __forceinline__ void phase_gla_pass2(const Args& a) {
    unsigned char* ST = a.ws + WS_ST; const float* DEC = (const float*)(a.ws + WS_DEC);
    for (int gidx = blockIdx.x * NTHR + tid_now(); gidx < 48 * 4096; gidx += gridDim.x * NTHR) {
        const int chain = gidx >> 12, quad = gidx & 4095, dir = chain & 1, h = (chain >> 1) & 3, s = chain >> 3;
        const int nseg = s < 2 ? LP / 256 : LS / 256, seg0 = s < 2 ? s * (LP / 256) : 2 * (LP / 256) + (s - 2) * (LS / 256);
        const int kt = (quad >> 6) & 7, lane = quad & 63, dk0 = 16 * kt + 4 * (lane >> 4);
        f32x4 S = (f32x4){0.f, 0.f, 0.f, 0.f};
        for (int i0 = 0; i0 < nseg; i0 += 8) {
            u32x2 t[8]; f32x4 lm[8];
#pragma unroll
            for (int j = 0; j < 8; ++j) { const int seg = dir ? seg0 + nseg - 1 - (i0 + j) : seg0 + i0 + j; const size_t idx = (size_t)((seg * 4 + h) * 2 + dir);
                t[j] = ((const u32x2*)(ST + idx * 32768))[quad]; lm[j] = *(const f32x4*)(DEC + idx * 128 + dk0); }
#pragma unroll
            for (int j = 0; j < 8; ++j) { const int seg = dir ? seg0 + nseg - 1 - (i0 + j) : seg0 + i0 + j; const size_t idx = (size_t)((seg * 4 + h) * 2 + dir);
                u32x2 o; o.x = pk2(S[0], S[1]); o.y = pk2(S[2], S[3]); ((u32x2*)(ST + idx * 32768))[quad] = o;
                const f32x4 tv = (f32x4){__uint_as_float(t[j].x << 16), __uint_as_float(t[j].x & 0xffff0000u), __uint_as_float(t[j].y << 16), __uint_as_float(t[j].y & 0xffff0000u)};
                S = (f32x4){fexp2(lm[j][0]), fexp2(lm[j][1]), fexp2(lm[j][2]), fexp2(lm[j][3])} * S + tv; }
        }
    }
}
__device__ __forceinline__ void phase_gla_pass3(const Args& a, LAS unsigned char* lds) {
    const int tid = tid_now(), w = tid >> 6, lane = tid & 63;
    GlaPre pre; int par = 0;
    if (blockIdx.x < NSEG * 4) gla_prefetch<1>(a, pre, tid, (blockIdx.x >> 2) * 256, blockIdx.x & 3, 0, -1);
    for (int item = blockIdx.x; item < NSEG * 4; item += gridDim.x) {
        const int h = item & 3, seg = item >> 2;
        const int nitem = item + gridDim.x < NSEG * 4 ? item + gridDim.x : item;
        u32x4* stash = (u32x4*)a.out + (size_t)item * 4 * 1024;
#pragma unroll 1
        for (int dir = 0; dir < 2; ++dir) {
            f32x4 Sacc[8];
            const u32x2* src = (const u32x2*)(a.ws + WS_ST + (size_t)((seg * 4 + h) * 2 + dir) * 32768) + (size_t)w * 8 * 64 + lane;
#pragma unroll
            for (int kt = 0; kt < 8; ++kt) { const u32x2 v = src[kt * 64]; Sacc[kt] = (f32x4){__uint_as_float(v.x), __uint_as_float(v.y), 0.f, 0.f}; }
            float lam = 0.f;
            if (dir == 0) {
                for (int c = 0; c < 4; ++c) { const int ntb = seg * 256 + (c < 3 ? c + 1 : 3) * 64, ndir = c < 3 ? 0 : 1;
                    gla_chunk<1>(a, lds, seg * 256 + c * 64, h, 0, Sacc, lam, stash + c * 1024, pre, ntb, h, ndir, c == 0, par); par ^= 1; }
            } else {
                for (int c = 3; c >= 0; --c) { const int ntb = c > 0 ? seg * 256 + (c - 1) * 64 : (nitem >> 2) * 256, nh = c > 0 ? h : (nitem & 3), ndir = c > 0 ? 1 : 0;
                    gla_chunk<2>(a, lds, seg * 256 + c * 64, h, 1, Sacc, lam, stash + c * 1024, pre, ntb, nh, ndir, c == 3, par); par ^= 1; }
            }
        }
    }
    __syncthreads();
}
typedef float f32x16 __attribute__((ext_vector_type(16)));
#define MFMA32(a, b, c) __builtin_amdgcn_mfma_f32_32x32x16_bf16((a), (b), (c), 0, 0, 0)
constexpr int SW_K = 0, SW_V = 65536, SW_TB = 131072, SW_TBN = 336, SW_TBH = 4 * SW_TBN * 4;
constexpr float SW_NEG = -1e30f;
__device__ __forceinline__ unsigned offk(unsigned row, unsigned c8) { return 128u * row + 16u * (c8 ^ ((row >> 1) & 7)); }
__device__ __forceinline__ unsigned offv(unsigned row, unsigned c8) { return 128u * row + 16u * (c8 ^ (((row >> 1) & 1) << 2)); }
__device__ __forceinline__ void swa_load_block(const bf16_t* U, int gb, int kvh, bool valid, int tid, u32x4 (&kk)[2], u32x4 (&vv)[2]) {
#pragma unroll
    for (int i = 0; i < 2; ++i) {
        const int idx = tid + 512 * i, r = idx >> 3, c8 = idx & 7;
        kk[i] = (u32x4){0, 0, 0, 0}; vv[i] = (u32x4){0, 0, 0, 0};
        if (valid) { const bf16_t* ur = U + (size_t)(gb * 128 + r) * UP + kvh * 64 + c8 * 8; kk[i] = *(const u32x4*)(ur + C_KB); vv[i] = *(const u32x4*)(ur + C_VB); }
    }
}
__device__ __forceinline__ void swa_store_block(LAS unsigned char* lds, int gb, int tid, const u32x4 (&kk)[2], const u32x4 (&vv)[2]) {
#pragma unroll
    for (int i = 0; i < 2; ++i) {
        const int idx = tid + 512 * i, r = 128 * (gb & 3) + (idx >> 3), c8 = idx & 7;
        *(LAS u32x4*)(lds + SW_K + offk(r, c8)) = kk[i]; *(LAS u32x4*)(lds + SW_V + offv(r, c8)) = vv[i];
    }
}
__device__ __forceinline__ bool swa_exists(int gb) { return gb >= 0 && gb < NTOK / 128; }
__device__ __forceinline__ void phase_swa(const Args& a, LAS unsigned char* lds) {
    const bf16_t* U = (const bf16_t*)(a.ws + WS_U); bf16_t* ymix = (bf16_t*)((unsigned char*)a.out + 96 * MiB);
    const int tid = tid_now(), lane = tid & 63, w = __builtin_amdgcn_readfirstlane(tid >> 6), r = lane & 31, hh = lane >> 5;
    for (int su = blockIdx.x; su < (NTOK / 128 / 3) * 2; su += gridDim.x) {
        const int kvh = su & 1, qb0 = 3 * (su >> 1);
        __syncthreads();
        for (int e = tid; e < 4 * SW_TBN; e += NTHR) {
            const int hl = e / SW_TBN, idx = e - hl * SW_TBN, rel = idx - 160;
            const float val = (rel >= -128 && rel <= 128) ? a.relb[t5_bucket(rel) * 8 + kvh * 4 + hl] : SW_NEG;
            LAS float* tb = (LAS float*)(lds + SW_TB + hl * SW_TBH);
#pragma unroll
            for (int s = 0; s < 4; ++s) if (idx - s >= 0) tb[s * SW_TBN + idx - s] = val;
        }
#pragma unroll 1
        for (int bb = -1; bb <= 1; ++bb) { u32x4 kk[2], vv[2]; swa_load_block(U, qb0 + bb, kvh, swa_exists(qb0 + bb), tid, kk, vv); swa_store_block(lds, qb0 + bb, tid, kk, vv); }
        __syncthreads();
        const int hl = w >> 1, hq = kvh * 4 + hl;
        const float snk = a.sink[hq];
#pragma unroll 1
        for (int qi = 0; qi < 3; ++qi) {
            const int qb = qb0 + qi, tok0 = qb * 128; int s0, L; seq_of(tok0, s0, L);
            const bool first = tok0 == s0, last = tok0 + 128 == s0 + L;
            u32x4 nk[2], nv[2];
            if (qi < 2) swa_load_block(U, qb + 2, kvh, swa_exists(qb + 2), tid, nk, nv);
#pragma unroll 1
            for (int ss = 0; ss < 2; ++ss) {
                const int st = (w & 1) * 2 + ss, qtok = tok0 + 32 * st + r;
                bf16x8 Qf[4];
#pragma unroll
                for (int s = 0; s < 4; ++s) Qf[s] = *(const bf16x8*)(U + (size_t)qtok * UP + C_QB + hq * 64 + 16 * s + 8 * hh);
                float m = snk, l = hh == 0 ? 1.0f : 0.0f;
                f32x16 O[2];
#pragma unroll
                for (int i = 0; i < 16; ++i) { O[0][i] = 0.f; O[1][i] = 0.f; }
                const int sft = (-r) & 3;
                const unsigned tbase = SW_TB + hl * SW_TBH + sft * (SW_TBN * 4) + 4 * (32 + 4 * hh - r - sft);
                const unsigned kb0 = SW_K + 128u * r + 16u * (hh ^ ((r >> 1) & 7));
                const int q4 = (lane & 15) >> 2, p4 = lane & 3, g1 = (lane >> 4) & 1, xq = (q4 >> 1) & 1;
                const unsigned vb0 = SW_V + 128u * (4 * hh + q4) + 16u * ((4 * xq) | (2 * g1) | (p4 >> 1)) + 8u * (p4 & 1);
#pragma unroll 1
                for (int grp = 0; grp < 3; ++grp) {
                    f32x16 S[3];
#pragma unroll
                    for (int k3 = 0; k3 < 3; ++k3) {
                        const int kk = 3 * grp + k3, kt = st + kk, blk = kt >> 2;
                        const bool valid = !((blk == 0 && first) || (blk == 2 && last));
                        const unsigned rowb = 128u * (128u * ((unsigned)(qb - 1 + blk) & 3u) + 32u * (kt & 3));
                        if (valid) {
#pragma unroll
                            for (int i = 0; i < 16; ++i) S[k3][i] = 0.f;
#pragma unroll
                            for (int s = 0; s < 4; ++s) { const bf16x8 Kf = *(const LAS bf16x8*)(lds + (kb0 ^ (32u * s)) + rowb); S[k3] = MFMA32(Kf, Qf[s], S[k3]); }
#pragma unroll
                            for (int i4 = 0; i4 < 4; ++i4) { const f32x4 bv = *(const LAS f32x4*)(lds + tbase + 4 * (32 * kk + 8 * i4));
#pragma unroll
                                for (int j = 0; j < 4; ++j) S[k3][4 * i4 + j] += bv[j]; }
                        } else {
#pragma unroll
                            for (int i = 0; i < 16; ++i) S[k3][i] = SW_NEG;
                        }
                    }
                    float mx = SW_NEG;
#pragma unroll
                    for (int k3 = 0; k3 < 3; ++k3)
#pragma unroll
                        for (int i = 0; i < 16; ++i) mx = fmaxf(mx, S[k3][i]);
                    mx = fmaxf(mx, __shfl_xor(mx, 32));
                    const float mn = fmaxf(m, mx), alpha = fexp(m - mn);
                    m = mn; l *= alpha;
#pragma unroll
                    for (int i = 0; i < 16; ++i) { O[0][i] *= alpha; O[1][i] *= alpha; }
                    bf16x8 Pf[3][2];
#pragma unroll
                    for (int k3 = 0; k3 < 3; ++k3) {
#pragma unroll
                        for (int i = 0; i < 16; ++i) { const float pv = fexp(S[k3][i] - m); S[k3][i] = pv; l += pv; }
#pragma unroll
                        for (int s2 = 0; s2 < 2; ++s2) {
                            u32x4 pw;
#pragma unroll
                            for (int j = 0; j < 4; ++j) pw[j] = pk2(S[k3][8 * s2 + 2 * j], S[k3][8 * s2 + 2 * j + 1]);
                            Pf[k3][s2] = __builtin_bit_cast(bf16x8, pw);
                        }
                    }
#pragma unroll
                    for (int k3 = 0; k3 < 3; ++k3) {
                        const int kt = st + 3 * grp + k3, blk = kt >> 2;
                        const unsigned rowb = 128u * (128u * ((unsigned)(qb - 1 + blk) & 3u) + 32u * (kt & 3));
#pragma unroll
                        for (int s2 = 0; s2 < 2; ++s2)
#pragma unroll
                            for (int dt = 0; dt < 2; ++dt) {
                                const unsigned va = (vb0 ^ (64u * dt)) + rowb + 2048u * s2;
                                const bf16x8 Vf = tr_read8(lds, va, va + 1024u);
                                O[dt] = MFMA32(Vf, Pf[k3][s2], O[dt]);
                            }
                    }
                }
                l += __shfl_xor(l, 32);
                const float inv = __builtin_amdgcn_rcpf(l);
#pragma unroll
                for (int dt = 0; dt < 2; ++dt)
#pragma unroll
                    for (int i4 = 0; i4 < 4; ++i4) {
                        const int d0 = 32 * dt + 8 * i4 + 4 * hh;
                        const u32x2 zv = *(const u32x2*)(U + (size_t)qtok * UP + C_ZB + hq * 64 + d0);
                        const float z0 = __uint_as_float(zv.x << 16), z1 = __uint_as_float(zv.x & 0xffff0000u), z2 = __uint_as_float(zv.y << 16), z3 = __uint_as_float(zv.y & 0xffff0000u);
                        u32x2 yw; yw.x = pk2(O[dt][4 * i4] * inv * silu(z0), O[dt][4 * i4 + 1] * inv * silu(z1)); yw.y = pk2(O[dt][4 * i4 + 2] * inv * silu(z2), O[dt][4 * i4 + 3] * inv * silu(z3));
                        *(u32x2*)(ymix + (size_t)qtok * DM + 512 + hq * 64 + d0) = yw;
                    }
            }
            if (qi < 2) swa_store_block(lds, qb + 2, tid, nk, nv);
            __syncthreads();
        }
    }
}
__device__ __forceinline__ void phase_convfix(const Args& a) {
    bf16_t* G = (bf16_t*)(a.ws + WS_XB); const float* Pb = (const float*)(a.ws + WS_PB); const float* Sb = (const float*)(a.ws + WS_SB);
    for (int idx = blockIdx.x * NTHR + tid_now(); idx < (NTOK / 64 - 1) * 256; idx += gridDim.x * NTHR) {
        const int k = idx / 256 + 1, c = (idx & 255) * 4, row = 64 * k; int s0, L; seq_of(row, s0, L);
        if (row == s0) continue;
        const f32x4 pl = *(const f32x4*)(Pb + (size_t)((k - 1) * 2 + 1) * 1024 + c), sl = *(const f32x4*)(Sb + (size_t)((k - 1) * 2 + 1) * 1024 + c);
        const f32x4 pf = *(const f32x4*)(Pb + (size_t)(k * 2) * 1024 + c), sf = *(const f32x4*)(Sb + (size_t)(k * 2) * 1024 + c);
        const f32x4 c0 = *(const f32x4*)(a.cw + c), c2 = *(const f32x4*)(a.cw + 2048 + c);
        u32x2* gl = (u32x2*)(G + (size_t)(row - 1) * DM + c); u32x2* gf = (u32x2*)(G + (size_t)row * DM + c);
        const u32x2 a0 = *gl, a1 = *gf;
        const f32x4 dl = sl * c2 * pf, df = sf * c0 * pl;
        u32x2 o0, o1;
        o0.x = pk2(__uint_as_float(a0.x << 16) + dl[0], __uint_as_float(a0.x & 0xffff0000u) + dl[1]); o0.y = pk2(__uint_as_float(a0.y << 16) + dl[2], __uint_as_float(a0.y & 0xffff0000u) + dl[3]);
        o1.x = pk2(__uint_as_float(a1.x << 16) + df[0], __uint_as_float(a1.x & 0xffff0000u) + df[1]); o1.y = pk2(__uint_as_float(a1.y << 16) + df[2], __uint_as_float(a1.y & 0xffff0000u) + df[3]);
        *gl = o0; *gf = o1;
    }
}
__global__ void __launch_bounds__(NTHR, 2) mega(Args a) {
    LAS unsigned char* lds = (LAS unsigned char*)lds_raw;
    volatile LAS unsigned* MISC = (volatile LAS unsigned*)(lds + MISC_OFF);
    if (threadIdx.x < 32) MISC[threadIdx.x] = 0u;
    if ((threadIdx.x & 63) == 0) ((volatile LAS unsigned*)(lds + SLOT_OFF))[hw_slot()] = threadIdx.x >> 6;
    __syncthreads();
    unsigned char* ws = a.ws; float* out = a.out;
    XcdBarrier bar = xcd_barrier_post((unsigned*)(ws + WS_CTL) + 4096, MISC + 8);
    bf16_t* W1t = (bf16_t*)(ws + WS_W1T); bf16_t* W2t = (bf16_t*)(ws + WS_W2T); bf16_t* W3t = (bf16_t*)(ws + WS_W3T); bf16_t* W4t = (bf16_t*)(ws + WS_W4T);
    bf16_t* xb = (bf16_t*)(ws + WS_XB); bf16_t* ymix = (bf16_t*)((unsigned char*)out + 96 * MiB); bf16_t* G = xb; bf16_t* U = (bf16_t*)(ws + WS_U);
    bf16_t* x1b = (bf16_t*)(ws + WS_X1B); bf16_t* P = (bf16_t*)(ws + WS_P); bf16_t* Sg = (bf16_t*)(ws + WS_S);
    f32x2* stat1 = (f32x2*)(ws + WS_STAT1); f32x2* stat2 = (f32x2*)(ws + WS_STAT2); f32x2* mr1 = (f32x2*)(ws + WS_MR1);

    phase_convert(a, lds);
    xcd_barrier(bar);
    { pg8::Gemm g{xb, W1t, NTOK, C_GD, DM, 0}; pg8::StaticOrder S; S.init(NTOK, C_GD, gridDim.x, blockIdx.x); EpiU E{U}; pg8::gemm_phase<EpiU, pg8::StaticOrder>(lds, g, S, E); }
    xcd_barrier(bar);
    phase_gla_pass1(a, lds);
    xcd_barrier(bar);
    phase_gla_pass2(a);
    phase_swa(a, lds);
    xcd_barrier(bar);
    phase_gla_pass3(a, lds);
    xcd_barrier(bar);
    { pg8::Gemm g{ymix, W2t, NTOK, DM, DM, 0}; pg8::StaticOrder S; S.init(NTOK, DM, gridDim.x, blockIdx.x);
      EpiLN<0> E{ws, nullptr, a.lng, a.lnb}; pg8::gemm_phase<EpiLN<0>, pg8::StaticOrder>(lds, g, S, E); }
    xcd_barrier(bar);
    { pg8::Gemm g{x1b, W3t, NTOK, 4096, DM, 0}; pg8::StaticOrder S; S.init(NTOK, 4096, gridDim.x, blockIdx.x); EpiG E{ws, a.cw}; pg8::gemm_phase<EpiG, pg8::StaticOrder>(lds, g, S, E); }
    xcd_barrier(bar);
    phase_convfix(a);
    xcd_barrier(bar);
    { pg8::Gemm g{G, W4t, NTOK, DM, DM, 0}; pg8::StaticOrder S; S.init(NTOK, DM, gridDim.x, blockIdx.x);
      EpiLN<1> E{ws, out, a.lng + DM, a.lnb + DM}; pg8::gemm_phase<EpiLN<1>, pg8::StaticOrder>(lds, g, S, E); }
}

extern "C" void kernel_launch(void* const* d_in, const int* in_sizes, int n_in, void* d_out, int out_size, void* d_ws, size_t ws_size, hipStream_t stream) {
    static int grid = 0;
    if (grid == 0) {
        if (n_in != 16 || out_size != NTOK * DM || ws_size < WS_END) { fprintf(stderr, "kernel_launch: unexpected shapes (n_in %d out %d ws %zu)\n", n_in, out_size, ws_size); grid = -1; return; }
        int dev = 0, cus = 0, per_cu = 0;
        if (hipGetDevice(&dev) != hipSuccess || hipDeviceGetAttribute(&cus, hipDeviceAttributeMultiprocessorCount, dev) != hipSuccess) { grid = -1; return; }
        if (hipFuncSetAttribute((const void*)mega, hipFuncAttributeMaxDynamicSharedMemorySize, LDS_BYTES) != hipSuccess) { fprintf(stderr, "kernel_launch: hipFuncSetAttribute failed\n"); grid = -1; return; }
        if (hipOccupancyMaxActiveBlocksPerMultiprocessor(&per_cu, (const void*)mega, NTHR, LDS_BYTES) != hipSuccess || per_cu < 1) { fprintf(stderr, "kernel_launch: occupancy query says %d blocks per CU\n", per_cu); (void)hipGetLastError(); grid = -1; return; }
        grid = cus;
    }
    if (grid < 0) return;
    (void)hipMemsetAsync((char*)d_ws + WS_CTL, 0, 262144, stream);
    Args a{};
    a.xp = (const float*)d_in[0]; a.xs = (const float*)d_in[1]; a.w_in_even = (const float*)d_in[2]; a.wuf = (const float*)d_in[3]; a.bfw = (const float*)d_in[4];
    a.wub = (const float*)d_in[5]; a.bbw = (const float*)d_in[6]; a.ng = (const float*)d_in[7]; a.sink = (const float*)d_in[8]; a.relb = (const float*)d_in[9];
    a.w_out_even = (const float*)d_in[10]; a.w_in_odd = (const float*)d_in[11]; a.cw = (const float*)d_in[12]; a.w_out_odd = (const float*)d_in[13];
    a.lng = (const float*)d_in[14]; a.lnb = (const float*)d_in[15]; a.out = (float*)d_out; a.ws = (unsigned char*)d_ws;
    hipLaunchKernelGGL(mega, dim3(grid), dim3(NTHR), LDS_BYTES, stream, a);
}
```

```cpp
#include <hip/hip_runtime.h>
#include <cstdio>

typedef unsigned short bf16_t;
typedef short bf16x8 __attribute__((ext_vector_type(8)));
typedef float f32x4 __attribute__((ext_vector_type(4)));
typedef float f32x2 __attribute__((ext_vector_type(2)));
typedef unsigned u32x4 __attribute__((ext_vector_type(4)));
typedef unsigned u32x2 __attribute__((ext_vector_type(2)));
#define LAS __attribute__((address_space(3)))
#define MFMA16(a, b, c) __builtin_amdgcn_mfma_f32_16x16x32_bf16((a), (b), (c), 0, 0, 0)
extern __shared__ __attribute__((aligned(16))) unsigned char lds_raw[];
constexpr int SLOT_OFF = 163840 - 1024;
__device__ __forceinline__ unsigned hw_slot() { return (unsigned)__builtin_amdgcn_s_getreg((5 << 11) | 4) & 63u; }
__device__ __forceinline__ int tid_now() {
    const int wid = __builtin_amdgcn_readfirstlane((int)((volatile LAS unsigned*)((LAS unsigned char*)lds_raw + SLOT_OFF))[hw_slot()]);
    return wid * 64 + (int)__lane_id();
}

constexpr int DM = 1024, NTOK = 49152, NPROMPT = 32768, LP = 16384, LS = 4096;
constexpr int UP = 3584;
constexpr int C_QA = 0, C_KA = 512, C_VA = 1024, C_ZA = 1536, C_QB = 2048, C_KB = 2560, C_VB = 2688, C_ZB = 2816, C_GD = 3328;
constexpr int EVEN_IN = 3360, ODD_IN = 4096;
constexpr float DN_ALPHA = 1.41421356237309515f;
constexpr float LN_EPS = 1e-5f, NORM_EPS = 1e-6f;

constexpr size_t MiB = 1u << 20;
constexpr size_t WS_CTL = 0, WS_W1T = 1 * MiB, WS_W2T = 8 * MiB, WS_W3T = 10 * MiB, WS_W4T = 18 * MiB, WS_STAT1 = 20 * MiB, WS_MR1 = 26 * MiB, WS_DEC = 27 * MiB, WS_GATE = 27 * MiB + 768 * 1024,
                 WS_XB = 28 * MiB  , WS_U = 124 * MiB, WS_ST = 460 * MiB, WS_END = 508 * MiB;
constexpr size_t WS_X1B = WS_U, WS_P = WS_U + 96 * MiB, WS_S = WS_U + 192 * MiB, WS_STAT2 = WS_U + 288 * MiB, WS_PB = WS_U + 296 * MiB, WS_SB = WS_U + 304 * MiB;

__device__ __forceinline__ float bf2f(bf16_t b) { return __uint_as_float(((unsigned)b) << 16); }
typedef __bf16 nbf16x2 __attribute__((ext_vector_type(2)));
__device__ __forceinline__ bf16_t f2bf(float f) { return __builtin_bit_cast(bf16_t, (__bf16)f); }
__device__ __forceinline__ unsigned pk2(float lo, float hi) { return __builtin_bit_cast(unsigned, __builtin_convertvector((f32x2){lo, hi}, nbf16x2)); }
__device__ __forceinline__ float fexp2(float x) { return __builtin_amdgcn_exp2f(x); }
__device__ __forceinline__ float fexp(float x) { return __builtin_amdgcn_exp2f(x * 1.4426950408889634f); }
__device__ __forceinline__ float flog2(float x) { return __builtin_amdgcn_logf(x); }
__device__ __forceinline__ float silu(float x) { return x * __builtin_amdgcn_rcpf(1.0f + fexp(-x)); }
__device__ __forceinline__ float wave_sum(float v) {
#pragma unroll
    for (int o = 1; o < 64; o <<= 1) v += __shfl_xor(v, o);
    return v;
}
__device__ __forceinline__ float wave_max(float v) {
#pragma unroll
    for (int o = 1; o < 64; o <<= 1) v = fmaxf(v, __shfl_xor(v, o));
    return v;
}
__device__ __forceinline__ void seq_of(int row, int& s0, int& L) {
    if (row < NPROMPT) { L = LP; s0 = row & ~(LP - 1); } else { L = LS; s0 = NPROMPT + ((row - NPROMPT) & ~(LS - 1)); }
}

namespace pg8 {
constexpr int BM = 256, BK = 64, HALF = 128, HTB = HALF * BK * 2, STAGE_BYTES = 8 * HTB, NXCD = 8, WGM = 8;
__host__ __device__ __forceinline__ int lds_byte(int r, int c) { const int st = (r >> 4) * 2 + (c >> 5), rr = r & 15, cc = c & 31, ob = rr * 64 + cc * 2; return st * 1024 + (ob ^ (((ob >> 9) & 1) << 5)); }
__host__ __device__ __forceinline__ void stage_rc(int b, int& R, int& C) { const int st = b / 1024, sb = b % 1024, swz = sb ^ (((sb >> 9) & 1) << 5); R = (st >> 1) * 16 + swz / 64; C = (st & 1) * 32 + (swz % 64) / 2; }
__host__ __device__ __forceinline__ int perm32(int rho) { const int n = rho >> 4, i = rho & 15; return 8 * (i >> 2) + 4 * n + (i & 3); }
struct Unit { int pm, pn; };
struct Gemm { const bf16_t* A; const bf16_t* Bt; int M, N, K, pad; };
struct StaticOrder {
    int nM, nN, nwg, G, c;
    __host__ __device__ void init(int M, int N, int G_, int c_) { nM = M / BM; nN = N / BM; nwg = nM * nN; G = G_; c = c_; }
    __host__ __device__ bool next(int i, Unit& u) const {
        const long L = (long)i * G + c; if (L >= nwg) return false;
        int wgid = (int)L; { const int q = nwg / NXCD, r = nwg % NXCD, xcd = wgid % NXCD, off = wgid / NXCD; wgid = (xcd < r ? xcd * (q + 1) : r * (q + 1) + (xcd - r) * q) + off; }
        const int nig = WGM * nN, gid = wgid / nig, fm = gid * WGM, gsz = (nM - fm) < WGM ? (nM - fm) : WGM;
        u.pm = fm + ((wgid % nig) % gsz); u.pn = (wgid % nig) / gsz; return true;
    }
    __device__ __forceinline__ void a_ready(const Unit&) const {}
    __device__ __forceinline__ void done(const Unit&) const {}
};

template <class Epi, class Sched>
__device__ __forceinline__ void gemm_phase(LAS unsigned char* lds, const Gemm g, const Sched& S, const Epi& E) {
    int tid = tid_now(); asm volatile("" : "+v"(tid));
    const int wid = __builtin_amdgcn_readfirstlane(tid >> 6), lane = tid & 63, wr = wid >> 2, wc = wid & 3, fr = lane & 15, fq = lane >> 4;
    const int K = g.K, nt = K / BK;
    unsigned voffA[2], voffB[2];
#pragma unroll
    for (int i = 0; i < 2; ++i) { int R, C; stage_rc(tid * 16 + i * 8192, R, C); const int Rb = Epi::PERM ? ((R & ~31) + perm32(R & 31)) : R;
        voffA[i] = (unsigned)(R * K + C) * 2u; voffB[i] = (unsigned)(Rb * K + C) * 2u; }
    const size_t kstep = (size_t)(BK * 2);
    const size_t hstep = (size_t)HALF * K * 2;
    const size_t tstep = 2 * hstep;
    const unsigned ldsw = (unsigned)wid * 1024u;
    const int aoff = lds_byte(wr * 64 + fr, fq * 8), boff = lds_byte(wc * 32 + fr, fq * 8);
#define PG8_SA(b, h) (((b) * 2 + (h)) * HTB)
#define PG8_SB(b, h) ((4 + (b) * 2 + (h)) * HTB)
#define PG8_STAGE(bufoff, gbase, voff) do { _Pragma("unroll") for (int _i = 0; _i < 2; ++_i) \
        __builtin_amdgcn_global_load_lds((const unsigned*)((const char*)(gbase) + (voff)[_i]), (LAS unsigned*)(lds + (bufoff) + ldsw + _i * 8192), 16, 0, 0); } while (0)
#define PG8_LDA(dst, b, h) do { _Pragma("unroll") for (int m = 0; m < 4; ++m) _Pragma("unroll") for (int k = 0; k < 2; ++k) dst[m][k] = *(const LAS bf16x8*)(lds + PG8_SA(b, h) + aoff + m * 2048 + k * 1024); } while (0)
#define PG8_LDB(dst, b, h) do { _Pragma("unroll") for (int n = 0; n < 2; ++n) _Pragma("unroll") for (int k = 0; k < 2; ++k) dst[n][k] = *(const LAS bf16x8*)(lds + PG8_SB(b, h) + boff + n * 2048 + k * 1024); } while (0)
#define PG8_MMA(ai, bj, At, Bt) do { __builtin_amdgcn_s_setprio(1); _Pragma("unroll") for (int m = 0; m < 4; ++m) _Pragma("unroll") for (int n = 0; n < 2; ++n) _Pragma("unroll") for (int k = 0; k < 2; ++k) \
        acc[ai][bj][m][n] = __builtin_amdgcn_mfma_f32_16x16x32_bf16(Bt[n][k], At[m][k], acc[ai][bj][m][n], 0, 0, 0); __builtin_amdgcn_s_setprio(0); } while (0)
#define PG8_WAIT_V(n) asm volatile("s_waitcnt vmcnt(" #n ")" ::: "memory")
#define PG8_WAIT_L(n) asm volatile("s_waitcnt lgkmcnt(" #n ")" ::: "memory")
#define PG8_BAR __builtin_amdgcn_s_barrier()
#define PG8_SCHED __builtin_amdgcn_sched_barrier(0)
    Unit cur, nxt; int ui = 0;
    if (!S.next(0, cur)) return;
    f32x4 acc[2][2][4][2];
#pragma unroll
    for (int a = 0; a < 2; ++a)
#pragma unroll
        for (int b = 0; b < 2; ++b)
#pragma unroll
            for (int m = 0; m < 4; ++m)
#pragma unroll
                for (int n = 0; n < 2; ++n) acc[a][b][m][n] = (f32x4){0.f, 0.f, 0.f, 0.f};
    bf16x8 At[4][2], B0[2][2], B1[2][2];
    const char* cA = (const char*)g.A + (size_t)cur.pm * tstep; const char* cB = (const char*)g.Bt + (size_t)cur.pn * tstep;
    S.a_ready(cur);
    PG8_STAGE(PG8_SB(0, 0), cB, voffB); PG8_STAGE(PG8_SA(0, 0), cA, voffA); PG8_STAGE(PG8_SB(0, 1), cB + hstep, voffB); PG8_STAGE(PG8_SA(0, 1), cA + hstep, voffA);
    if (wr == 1) PG8_BAR;
    PG8_WAIT_V(4); PG8_BAR;
    PG8_STAGE(PG8_SB(1, 0), cB + kstep, voffB); PG8_STAGE(PG8_SA(1, 0), cA + kstep, voffA); PG8_STAGE(PG8_SB(1, 1), cB + hstep + kstep, voffB);
    PG8_WAIT_V(6); PG8_BAR;
    for (;;) {
        const bool has_next = S.next(ui + 1, nxt);
        const char* nA = has_next ? (const char*)g.A + (size_t)nxt.pm * tstep : cA; const char* nB = has_next ? (const char*)g.Bt + (size_t)nxt.pn * tstep : cB;
        for (int t = 0; t < nt; t += 2) {
            const bool last = (t == nt - 2);
            const char* a1 = cA + (size_t)(t + 1) * kstep;
            const char* a2 = last ? nA : cA + (size_t)(t + 2) * kstep; const char* b2 = last ? nB : cB + (size_t)(t + 2) * kstep;
            const char* a3 = a2 + kstep; const char* b3 = b2 + kstep;
            if (last && has_next) S.a_ready(nxt);
            PG8_LDB(B0, 0, 0); PG8_SCHED; PG8_LDA(At, 0, 0); PG8_STAGE(PG8_SA(1, 1), a1 + hstep, voffA);
            PG8_WAIT_L(8); PG8_BAR; PG8_WAIT_L(0); PG8_MMA(0, 0, At, B0); PG8_BAR; PG8_SCHED;
            PG8_LDB(B1, 0, 1); PG8_STAGE(PG8_SB(0, 0), b2, voffB);
            PG8_BAR; PG8_WAIT_L(0); PG8_MMA(0, 1, At, B1); PG8_BAR;
            PG8_LDA(At, 0, 1); PG8_STAGE(PG8_SA(0, 0), a2, voffA);
            PG8_BAR; PG8_WAIT_L(0); PG8_MMA(1, 0, At, B0); PG8_BAR; PG8_SCHED;
            PG8_STAGE(PG8_SB(0, 1), b2 + hstep, voffB);
            PG8_WAIT_V(6); PG8_BAR; PG8_MMA(1, 1, At, B1); PG8_BAR;
            PG8_LDB(B0, 1, 0); PG8_SCHED; PG8_LDA(At, 1, 0); PG8_STAGE(PG8_SA(0, 1), a2 + hstep, voffA);
            PG8_WAIT_L(8); PG8_BAR; PG8_WAIT_L(0); PG8_MMA(0, 0, At, B0); PG8_BAR; PG8_SCHED;
            PG8_LDB(B1, 1, 1); PG8_STAGE(PG8_SB(1, 0), b3, voffB);
            PG8_BAR; PG8_WAIT_L(0); PG8_MMA(0, 1, At, B1); PG8_BAR;
            PG8_LDA(At, 1, 1); PG8_STAGE(PG8_SA(1, 0), a3, voffA);
            PG8_BAR; PG8_WAIT_L(0); PG8_MMA(1, 0, At, B0); PG8_BAR; PG8_SCHED;
            PG8_STAGE(PG8_SB(1, 1), b3 + hstep, voffB);
            PG8_WAIT_V(6); PG8_BAR; PG8_MMA(1, 1, At, B1); PG8_BAR;
        }
        if constexpr (Epi::REALIGN) { if (wr == 0) PG8_BAR; }
        E(acc, cur, wr, wc, fr, fq); S.done(cur);
        if constexpr (Epi::REALIGN) { if (wr == 1) PG8_BAR; }
        if (!has_next) break;
#pragma unroll
        for (int a = 0; a < 2; ++a)
#pragma unroll
            for (int b = 0; b < 2; ++b)
#pragma unroll
                for (int m = 0; m < 4; ++m)
#pragma unroll
                    for (int n = 0; n < 2; ++n) acc[a][b][m][n] = (f32x4){0.f, 0.f, 0.f, 0.f};
        cur = nxt; cA = nA; cB = nB; ++ui;
    }
    PG8_WAIT_V(0);
    if (wr == 0) PG8_BAR;
    PG8_BAR;
#undef PG8_SA
#undef PG8_SB
#undef PG8_STAGE
#undef PG8_LDA
#undef PG8_LDB
#undef PG8_MMA
#undef PG8_WAIT_V
#undef PG8_WAIT_L
#undef PG8_BAR
#undef PG8_SCHED
}
}

struct EpiU {
    static constexpr bool PERM = true, AFTER_DRAIN = false, REALIGN = false;
    bf16_t* O;
    __device__ __forceinline__ void operator()(const f32x4 (&acc)[2][2][4][2], const pg8::Unit& u, int wr, int wc, int fr, int fq) const {
        const int row0 = u.pm * 256 + wr * 64 + fr, col0 = u.pn * 256 + wc * 32 + 8 * fq;
#pragma unroll
        for (int ai = 0; ai < 2; ++ai)
#pragma unroll
            for (int m = 0; m < 4; ++m) { bf16_t* rowp = O + (size_t)(row0 + ai * 128 + m * 16) * UP + col0;
#pragma unroll
                for (int bj = 0; bj < 2; ++bj) { const f32x4 v0 = acc[ai][bj][m][0], v1 = acc[ai][bj][m][1];
                    u32x4 w; w.x = pk2(v0[0], v0[1]); w.y = pk2(v0[2], v0[3]); w.z = pk2(v1[0], v1[1]); w.w = pk2(v1[2], v1[3]);
                    *(u32x4*)(rowp + bj * 128) = w; } }
    }
};
template <int LAYER> struct EpiY {
    static constexpr bool PERM = false, AFTER_DRAIN = false, REALIGN = false;
    const float* xp; const float* xs; float* Y; f32x2* stat; const f32x2* mr; const float* lg; const float* lb;
    __device__ __forceinline__ void operator()(const f32x4 (&acc)[2][2][4][2], const pg8::Unit& u, int wr, int wc, int fr, int fq) const {
        const int col0 = u.pn * 256 + wc * 32 + 4 * fq;
        f32x4 gv[2][2], bv[2][2];
        if (LAYER == 1) {
#pragma unroll
            for (int bj = 0; bj < 2; ++bj)
#pragma unroll
                for (int n = 0; n < 2; ++n) { gv[bj][n] = *(const f32x4*)(lg + col0 + bj * 128 + n * 16); bv[bj][n] = *(const f32x4*)(lb + col0 + bj * 128 + n * 16); }
        }
#pragma unroll
        for (int ai = 0; ai < 2; ++ai)
#pragma unroll
            for (int m = 0; m < 4; ++m) {
                const int row = u.pm * 256 + ai * 128 + wr * 64 + m * 16 + fr;
                const float* rp; f32x2 mrv = (f32x2){0.f, 1.f};
                if (LAYER == 0) rp = (row < NPROMPT) ? xp + (size_t)row * DM : xs + (size_t)(row - NPROMPT) * DM;
                else { rp = Y + (size_t)row * DM; mrv = mr[row]; }
                float* yp = Y + (size_t)row * DM;
                float s = 0.f, q = 0.f;
#pragma unroll
                for (int bj = 0; bj < 2; ++bj)
#pragma unroll
                    for (int n = 0; n < 2; ++n) {
                        const int c = col0 + bj * 128 + n * 16;
                        f32x4 r = *(const f32x4*)(rp + c);
                        if (LAYER == 1) r = (r - mrv.x) * mrv.y * gv[bj][n] + bv[bj][n];
                        const f32x4 y = r * DN_ALPHA + acc[ai][bj][m][n];
                        *(f32x4*)(yp + c) = y;
                        s += (y[0] + y[1]) + (y[2] + y[3]); q += (y[0] * y[0] + y[1] * y[1]) + (y[2] * y[2] + y[3] * y[3]);
                    }
                s += __shfl_xor(s, 16); s += __shfl_xor(s, 32); q += __shfl_xor(q, 16); q += __shfl_xor(q, 32);
                if (fq == 0) stat[(size_t)row * 16 + u.pn * 4 + wc] = (f32x2){s, q};
            }
    }
};
#define RLX_AGENT __ATOMIC_RELAXED, __HIP_MEMORY_SCOPE_AGENT
template <int LAYER> struct EpiLN {
    static constexpr bool PERM = true, AFTER_DRAIN = false, REALIGN = true;
    unsigned char* ws; float* Of; const float* lg; const float* lb;
    __device__ __forceinline__ void operator()(f32x4 (&acc)[2][2][4][2], const pg8::Unit& u, int wr, int wc, int fr, int fq) const {
        unsigned char* w2 = ws; asm volatile("" : "+s"(w2));
        const bf16_t* R = (const bf16_t*)(w2 + (LAYER == 0 ? WS_XB : WS_X1B)); bf16_t* Ob = (bf16_t*)(w2 + WS_X1B);
        unsigned long long* xbuf = (unsigned long long*)(w2 + (LAYER == 0 ? WS_STAT1 : WS_STAT2)); unsigned* cnt = (unsigned*)(w2 + WS_CTL) + 16384 + LAYER * 192 * 64;
        const int col0 = u.pn * 256 + wc * 32 + 8 * fq, rowb = u.pm * 256 + wr * 64 + fr;
        float ps[2][4], pq[2][4];
#pragma unroll
        for (int ai = 0; ai < 2; ++ai)
#pragma unroll
            for (int m = 0; m < 4; ++m) {
                const bf16_t* rp = R + (size_t)(rowb + ai * 128 + m * 16) * DM + col0;
                float s = 0.f, q = 0.f;
#pragma unroll
                for (int bj = 0; bj < 2; ++bj) {
                    const u32x4 rw = *(const u32x4*)(rp + bj * 128);
                    f32x4 r0 = (f32x4){__uint_as_float(rw.x << 16), __uint_as_float(rw.x & 0xffff0000u), __uint_as_float(rw.y << 16), __uint_as_float(rw.y & 0xffff0000u)};
                    f32x4 r1 = (f32x4){__uint_as_float(rw.z << 16), __uint_as_float(rw.z & 0xffff0000u), __uint_as_float(rw.w << 16), __uint_as_float(rw.w & 0xffff0000u)};
                    const f32x4 v0 = r0 * DN_ALPHA + acc[ai][bj][m][0], v1 = r1 * DN_ALPHA + acc[ai][bj][m][1];
                    acc[ai][bj][m][0] = v0; acc[ai][bj][m][1] = v1;
                    s += ((v0[0] + v0[1]) + (v0[2] + v0[3])) + ((v1[0] + v1[1]) + (v1[2] + v1[3]));
                    q += ((v0[0] * v0[0] + v0[1] * v0[1]) + (v0[2] * v0[2] + v0[3] * v0[3])) + ((v1[0] * v1[0] + v1[1] * v1[1]) + (v1[2] * v1[2] + v1[3] * v1[3]));
                }
                s += __shfl_xor(s, 16); s += __shfl_xor(s, 32); q += __shfl_xor(q, 16); q += __shfl_xor(q, 32);
                ps[ai][m] = s; pq[ai][m] = q;
            }
        if (fq == 0) {
#pragma unroll
            for (int ai = 0; ai < 2; ++ai)
#pragma unroll
                for (int m = 0; m < 4; ++m)
                    __hip_atomic_store(xbuf + (size_t)(rowb + ai * 128 + m * 16) * 16 + u.pn * 4 + wc, ((unsigned long long)__float_as_uint(pq[ai][m]) << 32) | __float_as_uint(ps[ai][m]), RLX_AGENT);
        }
        asm volatile("s_waitcnt vmcnt(0)" ::: "memory");
        unsigned* c = cnt + 64 * u.pm;
        if ((tid_now() & 63) == 0) __hip_atomic_fetch_add(c, 1u, RLX_AGENT);
        { unsigned spins = 0;
          while ((unsigned)__builtin_amdgcn_readfirstlane(__hip_atomic_load(c, RLX_AGENT)) < 32u) { __builtin_amdgcn_s_sleep(2); if (++spins > (1u << 16)) break; }
          __builtin_amdgcn_fence(__ATOMIC_ACQUIRE, "agent"); }
#pragma unroll
        for (int ai = 0; ai < 2; ++ai)
#pragma unroll
            for (int m = 0; m < 4; ++m) {
                const unsigned long long* sp = xbuf + (size_t)(rowb + ai * 128 + m * 16) * 16 + 4 * fq;
                float s = 0.f, q = 0.f;
#pragma unroll
                for (int t = 0; t < 4; ++t) { const unsigned long long w8 = __hip_atomic_load(sp + t, RLX_AGENT); s += __uint_as_float((unsigned)w8); q += __uint_as_float((unsigned)(w8 >> 32)); }
                s += __shfl_xor(s, 16); s += __shfl_xor(s, 32); q += __shfl_xor(q, 16); q += __shfl_xor(q, 32);
                const float mean = s * (1.0f / DM), var = q * (1.0f / DM) - mean * mean;
                ps[ai][m] = mean; pq[ai][m] = rsqrtf(fmaxf(var, 0.f) + LN_EPS);
            }
#pragma unroll
        for (int bj = 0; bj < 2; ++bj) {
            const f32x4 g0 = *(const f32x4*)(lg + col0 + bj * 128), g1 = *(const f32x4*)(lg + col0 + bj * 128 + 4), b0 = *(const f32x4*)(lb + col0 + bj * 128), b1 = *(const f32x4*)(lb + col0 + bj * 128 + 4);
#pragma unroll
            for (int ai = 0; ai < 2; ++ai)
#pragma unroll
                for (int m = 0; m < 4; ++m) {
                    const int row = rowb + ai * 128 + m * 16; const float mean = ps[ai][m], rstd = pq[ai][m];
                    const f32x4 o0 = (acc[ai][bj][m][0] - mean) * rstd * g0 + b0, o1 = (acc[ai][bj][m][1] - mean) * rstd * g1 + b1;
                    if (LAYER == 0) { u32x4 w; w.x = pk2(o0[0], o0[1]); w.y = pk2(o0[2], o0[3]); w.z = pk2(o1[0], o1[1]); w.w = pk2(o1[2], o1[3]); *(u32x4*)(Ob + (size_t)row * DM + col0 + bj * 128) = w; }
                    else { float* op = Of + (size_t)row * DM + col0 + bj * 128; *(f32x4*)op = o0; *(f32x4*)(op + 4) = o1; }
                }
        }
    }
};
struct EpiPS {
    static constexpr bool PERM = true, AFTER_DRAIN = false, REALIGN = false;
    bf16_t* P; bf16_t* S;
    __device__ __forceinline__ void operator()(const f32x4 (&acc)[2][2][4][2], const pg8::Unit& u, int wr, int wc, int fr, int fq) const {
        const int row0 = u.pm * 256 + wr * 64 + fr, off = (wc & 1) * 32 + 8 * fq;
        bf16_t* dst = (wc < 2 ? S : P) + u.pn * 64 + off;
#pragma unroll
        for (int ai = 0; ai < 2; ++ai)
#pragma unroll
            for (int m = 0; m < 4; ++m) {
                float o[8];
#pragma unroll
                for (int n = 0; n < 2; ++n)
#pragma unroll
                    for (int j = 0; j < 4; ++j) { const float a = acc[ai][0][m][n][j], b = acc[ai][1][m][n][j];
                        o[4 * n + j] = (wc < 2) ? silu(b) * a : a * b; }
                u32x4 w; w.x = pk2(o[0], o[1]); w.y = pk2(o[2], o[3]); w.z = pk2(o[4], o[5]); w.w = pk2(o[6], o[7]);
                *(u32x4*)(dst + (size_t)(row0 + ai * 128 + m * 16) * DM) = w;
            }
    }
};

template <int CTRL> __device__ __forceinline__ float dpp_f(float x);
struct EpiG {
    static constexpr bool PERM = true, AFTER_DRAIN = false, REALIGN = false;
    unsigned char* ws; const float* cw;
    __device__ __forceinline__ void operator()(const f32x4 (&acc)[2][2][4][2], const pg8::Unit& u, int wr, int wc, int fr, int fq) const {
        unsigned char* w2 = ws; asm volatile("" : "+s"(w2));
        bf16_t* G = (bf16_t*)(w2 + WS_XB); float* Pb = (float*)(w2 + WS_PB); float* Sb = (float*)(w2 + WS_SB);
        const int ch0 = u.pn * 64 + 16 * wc + 4 * fq;
        const f32x4 c0 = *(const f32x4*)(cw + ch0), c1 = *(const f32x4*)(cw + 1024 + ch0), c2 = *(const f32x4*)(cw + 2048 + ch0);
#pragma unroll
        for (int ai = 0; ai < 2; ++ai) {
            f32x4 P[4], S[4];
#pragma unroll
            for (int m = 0; m < 4; ++m)
#pragma unroll
                for (int j = 0; j < 4; ++j) { P[m][j] = acc[ai][0][m][1][j] * acc[ai][1][m][1][j]; S[m][j] = silu(acc[ai][1][m][0][j]) * acc[ai][0][m][0][j]; }
            const int row0 = u.pm * 256 + ai * 128 + wr * 64 + fr;
#pragma unroll
            for (int m = 0; m < 4; ++m) {
                float o[4];
#pragma unroll
                for (int j = 0; j < 4; ++j) {
                    float pr = dpp_f<0x111>(P[m][j]);
                    if (m > 0) { const float t = dpp_f<0x121>(P[m - 1][j]); pr = fr == 0 ? t : pr; }
                    float nx = dpp_f<0x101>(P[m][j]);
                    if (m < 3) { const float t = dpp_f<0x12F>(P[m + 1][j]); nx = fr == 15 ? t : nx; }
                    o[j] = S[m][j] * (c0[j] * pr + c1[j] * P[m][j] + c2[j] * nx);
                }
                u32x2 w; w.x = pk2(o[0], o[1]); w.y = pk2(o[2], o[3]);
                *(u32x2*)(G + (size_t)(row0 + 16 * m) * DM + ch0) = w;
            }
            const int blk = u.pm * 4 + ai * 2 + wr;
            if (fr == 0) { *(f32x4*)(Pb + (size_t)(blk * 2) * 1024 + ch0) = P[0]; *(f32x4*)(Sb + (size_t)(blk * 2) * 1024 + ch0) = S[0]; }
            if (fr == 15) { *(f32x4*)(Pb + (size_t)(blk * 2 + 1) * 1024 + ch0) = P[3]; *(f32x4*)(Sb + (size_t)(blk * 2 + 1) * 1024 + ch0) = S[3]; }
        }
    }
};
#define XB_TMO      128
#define XB_XCNT(j)  (256  + 64 * (j))
#define XB_XSUB(j)  (1280 + 64 * (j))
#define XB_XGEN(j)  (2304 + 64 * (j))
#define XB_TOP      3328
#define XB_TOPGEN   3392
#define XCD_BAR_WORDS 3456
#define XB_SPIN_CAP (1u << 27)
__device__ __forceinline__ unsigned xb_ld(unsigned* p)              { return __hip_atomic_load(p, __ATOMIC_RELAXED, __HIP_MEMORY_SCOPE_AGENT); }
__device__ __forceinline__ unsigned xb_add(unsigned* p, unsigned v) { return __hip_atomic_fetch_add(p, v, __ATOMIC_RELAXED, __HIP_MEMORY_SCOPE_AGENT); }
__device__ __forceinline__ unsigned xb_xcc_id() { return (unsigned)__builtin_amdgcn_s_getreg((3 << 11) | 20) & 0xFu; }
#define XB_SPIN(cond, bar) do { unsigned _sp = 0; while (cond) { __builtin_amdgcn_s_sleep(1); \
    if ((++_sp & 255u) == 0u) { if (xb_ld(&(bar)[XB_TMO])) break; if (_sp > XB_SPIN_CAP) { atomicAdd(&(bar)[XB_TMO], 1u); break; } } } } while (0)
struct XcdBarrier { unsigned* bar; unsigned x; volatile LAS unsigned* st; };
__device__ __forceinline__ XcdBarrier xcd_barrier_post(unsigned* bar, volatile LAS unsigned* st) {
    XcdBarrier b; b.bar = bar; b.x = xb_xcc_id(); b.st = st;
    if (tid_now() == 0) (void)xb_add(&bar[XB_XCNT(b.x)], 1u);
    return b;
}
__device__ __forceinline__ void xcd_barrier_complete(unsigned* bar, unsigned x, unsigned& nloc, unsigned& nx) {
    const unsigned G = gridDim.x * gridDim.y * gridDim.z;
    unsigned sum, cnt, mine, sp = 0u;
    for (;;) {
        sum = 0u; cnt = 0u; mine = 0u;
#pragma unroll
        for (unsigned j = 0; j < 16; ++j) { const unsigned c = xb_ld(&bar[XB_XCNT(j)]); sum += c; cnt += (c > 0u) ? 1u : 0u; mine = (j == x) ? c : mine; }
        if (sum == G) break;
        __builtin_amdgcn_s_sleep(1);
        if ((++sp & 255u) == 0u) { if (xb_ld(&bar[XB_TMO])) break; if (sp > XB_SPIN_CAP) { atomicAdd(&bar[XB_TMO], 1u); break; } }
    }
    nloc = mine > 0u ? mine : 1u; nx = cnt > 0u ? cnt : 1u;
}
__device__ __forceinline__ void xcd_barrier(const XcdBarrier& b) {
    asm volatile("s_waitcnt vmcnt(0)" ::: "memory");
    __syncthreads();
    if (tid_now() == 0) {
        unsigned* bar = b.bar;
        __builtin_amdgcn_s_waitcnt(0);
        unsigned nloc = b.st[0], nx = b.st[1];
        if (nloc == 0u) { xcd_barrier_complete(bar, b.x, nloc, nx); b.st[0] = nloc; b.st[1] = nx; }
        const unsigned old = xb_add(&bar[XB_XSUB(b.x)], 1u);
        const unsigned gen = old / nloc;
        if (old + 1u == (gen + 1u) * nloc) {
            __builtin_amdgcn_fence(__ATOMIC_RELEASE, "agent");
            asm volatile("s_waitcnt vmcnt(0)" ::: "memory");
            const unsigned og = xb_add(&bar[XB_TOP], 1u);
            const unsigned tg = og / nx;
            if (og + 1u == (tg + 1u) * nx) xb_add(&bar[XB_TOPGEN], 1u);
            else XB_SPIN(xb_ld(&bar[XB_TOPGEN]) == tg, bar);
            __builtin_amdgcn_fence(__ATOMIC_ACQUIRE, "agent");
            xb_add(&bar[XB_XGEN(b.x)], 1u);
            asm volatile("s_waitcnt vmcnt(0)" ::: "memory");
        } else {
            XB_SPIN(xb_ld(&bar[XB_XGEN(b.x)]) == gen, bar);
            __builtin_amdgcn_fence(__ATOMIC_ACQUIRE, "agent");
            asm volatile("s_waitcnt vmcnt(0)" ::: "memory");
        }
    }
    __syncthreads();
}

struct Args {
    const float *xp, *xs, *w_in_even, *wuf, *bfw, *wub, *bbw, *ng, *sink, *relb, *w_out_even, *w_in_odd, *cw, *w_out_odd, *lng, *lnb;
    float* out; unsigned char* ws;
};
constexpr int NTHR = 512;
constexpr int LDS_BYTES = 163840, MISC_OFF = 163840 - 512;

template <int MODE> __device__ __forceinline__ int wmap(int n, float& sc) {
    sc = 1.f;
    if (MODE == 0) return n;
    if (MODE == 1) {
        if (n < 512) sc = 0.08838834764831845f;
        if (n >= C_QB && n < C_KB) sc = 0.125f;
        if (n < 2048) return n;
        if (n < C_GD) return n + 32;
        if (n < C_GD + 32) return n - C_GD + 2048;
        return -1;
    }
    const int c = n & 255, bj = (c >> 7) & 1, wc = (c >> 5) & 3, fq = (c >> 3) & 3, nn = (c >> 2) & 1, j = c & 3, q = 2 * bj + nn, ch = (n >> 8) * 64 + 16 * wc + 4 * fq + j;
    const int base = q == 0 ? 0 : (q == 1 ? 1024 : (q == 2 ? 3072 : 2048));
    return base + ch;
}
template <int MODE> __device__ __forceinline__ void wconv_item(const float* __restrict__ W, int Nsrc, bf16_t* __restrict__ Wt, int Ndst, int item, LAS float* tile, int t256) {
    const int nb = item % (Ndst / 64), kb = item / (Ndst / 64), n0 = nb * 64, k0 = kb * 64;
    const int tx = t256 & 63, ty = t256 >> 6;
    float sc; const int src = wmap<MODE>(n0 + tx, sc);
    for (int kk = ty; kk < 64; kk += 4) tile[kk * 65 + tx] = src >= 0 ? W[(size_t)(k0 + kk) * Nsrc + src] * sc : 0.f;
    __syncthreads();
    for (int nn = ty; nn < 64; nn += 4) Wt[(size_t)(n0 + nn) * 1024 + k0 + tx] = f2bf(tile[tx * 65 + nn]);
    __syncthreads();
}
__device__ __forceinline__ void build_gate_tables(const Args& a);
__device__ __forceinline__ void phase_convert(const Args& a, LAS unsigned char* lds) {
    unsigned char* ws = a.ws;
    bf16_t* W1t = (bf16_t*)(ws + WS_W1T); bf16_t* W2t = (bf16_t*)(ws + WS_W2T); bf16_t* W3t = (bf16_t*)(ws + WS_W3T); bf16_t* W4t = (bf16_t*)(ws + WS_W4T);
    const int half = tid_now() >> 8, t256 = tid_now() & 255;
    LAS float* tile = (LAS float*)lds + half * (64 * 65);
    constexpr int I1 = (C_GD / 64) * 16, I2 = 16 * 16, I3 = 64 * 16, I4 = 16 * 16, NIT = I1 + I2 + I3 + I4;
    for (int it0 = blockIdx.x * 2; it0 < NIT; it0 += gridDim.x * 2) {
        int r = it0 + half;
        if (r < I1) wconv_item<1>(a.w_in_even, EVEN_IN, W1t, C_GD, r, tile, t256);
        else if ((r -= I1) < I2) wconv_item<0>(a.w_out_even, 1024, W2t, 1024, r, tile, t256);
        else if ((r -= I2) < I3) wconv_item<2>(a.w_in_odd, ODD_IN, W3t, 4096, r, tile, t256);
        else if ((r -= I3) < I4) wconv_item<0>(a.w_out_odd, 1024, W4t, 1024, r, tile, t256);
        else { __syncthreads(); __syncthreads(); }
    }
    build_gate_tables(a);
    __syncthreads();
    {
        constexpr int WP = 1032, TP = 264;
        LAS bf16_t* wg = (LAS bf16_t*)lds; LAS bf16_t* tile0 = (LAS bf16_t*)(lds + 32 * WP * 2);
        const int tid = tid_now(), lane = tid & 63, w = tid >> 6, n = lane & 15, g = lane >> 4, rb = w & 3, ct = w >> 2;
        for (int e = tid; e < 32 * 1024; e += NTHR) { const int k = e >> 5, c = e & 31; wg[c * WP + k] = f2bf(a.w_in_even[(size_t)k * EVEN_IN + 2048 + c]); }
        bf16_t* xb = (bf16_t*)(ws + WS_XB); bf16_t* U = (bf16_t*)(ws + WS_U);
        f32x4 v[4][2];
        auto slab_load = [&](int it, int sl) {
#pragma unroll
            for (int i = 0; i < 4; ++i) { const int idx = tid + 512 * i, row = it * 64 + (idx >> 5), col = sl * 256 + 8 * (idx & 31);
                const float* src = (row < NPROMPT ? a.xp + (size_t)row * DM : a.xs + (size_t)(row - NPROMPT) * DM) + col;
                v[i][0] = *(const f32x4*)src; v[i][1] = *(const f32x4*)(src + 4); } };
        const int ntrip = NTOK / 64;
        if ((int)blockIdx.x < ntrip) slab_load(blockIdx.x, 0);
        int par = 0;
        for (int it = blockIdx.x; it < ntrip; it += gridDim.x) {
            f32x4 acc = (f32x4){0.f, 0.f, 0.f, 0.f};
#pragma unroll 1
            for (int sl = 0; sl < 4; ++sl) {
                LAS bf16_t* tile = tile0 + par * (64 * TP);
#pragma unroll
                for (int i = 0; i < 4; ++i) { const int idx = tid + 512 * i, r64 = idx >> 5, c8 = idx & 31;
                    u32x4 pw; pw.x = pk2(v[i][0][0], v[i][0][1]); pw.y = pk2(v[i][0][2], v[i][0][3]); pw.z = pk2(v[i][1][0], v[i][1][1]); pw.w = pk2(v[i][1][2], v[i][1][3]);
                    *(u32x4*)(xb + (size_t)(it * 64 + r64) * DM + sl * 256 + 8 * c8) = pw;
                    *(LAS u32x4*)(tile + r64 * TP + 8 * c8) = pw; }
                { const int nsl = (sl + 1) & 3, nit = sl < 3 ? it : (it + (int)gridDim.x < ntrip ? it + (int)gridDim.x : it); slab_load(nit, nsl); }
                __syncthreads();
#pragma unroll
                for (int ks = 0; ks < 8; ++ks) {
                    const bf16x8 af = *(const LAS bf16x8*)(tile + (16 * rb + n) * TP + 32 * ks + 8 * g), bfr = *(const LAS bf16x8*)(wg + (16 * ct + n) * WP + sl * 256 + 32 * ks + 8 * g);
                    acc = MFMA16(af, bfr, acc);
                }
                par ^= 1;
            }
#pragma unroll
            for (int r = 0; r < 4; ++r) U[(size_t)(it * 64 + rb * 16 + 4 * g + r) * UP + C_GD + 16 * ct + n] = f2bf(acc[r]);
        }
        __syncthreads();
    }
}

__device__ __forceinline__ void phase_gla_naive(const Args& a, LAS unsigned char* lds, float* OF, float* OB) {
    if (blockIdx.x >= 12) return;
    const bf16_t* U = (const bf16_t*)(a.ws + WS_U);
    const int grp = tid_now() >> 7, tid = tid_now() & 127, b = blockIdx.x * 4 + grp, dir = b & 1, h = (b >> 1) & 3, s = b >> 3;
    LAS float* sq = (LAS float*)lds + grp * (3 * 16 * 128); LAS float* sk = sq + 16 * 128; LAS float* sd = sk + 16 * 128;
    const int L = s < 2 ? LP : LS, start = s < 2 ? s * LP : NPROMPT + (s - 2) * LS;
    const float* wu = dir ? a.wub : a.wuf; const float* bias = dir ? a.bbw : a.bfw; float* O = dir ? OB : OF;
    float wr[16];
#pragma unroll
    for (int r = 0; r < 16; ++r) wr[r] = wu[r * 512 + h * 128 + tid];
    const float bb = bias[h * 128 + tid];
    float S[128];
#pragma unroll
    for (int i = 0; i < 128; ++i) S[i] = 0.f;
    for (int t0 = 0; t0 < L; t0 += 16) {
        for (int tt = 0; tt < 16; ++tt) {
            const int p = t0 + tt, tok = start + (dir ? L - 1 - p : p);
            const bf16_t* ur = U + (size_t)tok * UP;
            float x = bb;
#pragma unroll
            for (int r = 0; r < 16; ++r) x += bf2f(ur[C_GD + dir * 16 + r]) * wr[r];
            const float ls = fminf(x, 0.f) - log1pf(expf(-fabsf(x)));
            sd[tt * 128 + tid] = expf(ls * (1.0f / 16.0f));
            sq[tt * 128 + tid] = bf2f(ur[C_QA + h * 128 + tid]);
            sk[tt * 128 + tid] = bf2f(ur[C_KA + h * 128 + tid]);
        }
        __syncthreads();
        for (int tt = 0; tt < 16; ++tt) {
            const int p = t0 + tt, tok = start + (dir ? L - 1 - p : p);
            const float v = bf2f(U[(size_t)tok * UP + C_VA + h * 128 + tid]);
            float acc = 0.f;
#pragma unroll
            for (int dk = 0; dk < 128; dk += 4) {
                const f32x4 d4 = *(const LAS f32x4*)&sd[tt * 128 + dk], q4 = *(const LAS f32x4*)&sq[tt * 128 + dk], k4 = *(const LAS f32x4*)&sk[tt * 128 + dk];
#pragma unroll
                for (int j = 0; j < 4; ++j) {
                    const float sdec = S[dk + j] * d4[j];
                    const float sn = sdec + k4[j] * v;
                    acc += q4[j] * (dir ? sdec : sn);
                    S[dk + j] = sn;
                }
            }
            O[(size_t)tok * 512 + h * 128 + tid] = acc;
        }
        __syncthreads();
    }
}
__device__ __forceinline__ void phase_gla_combine(const Args& a, const float* OF, const float* OB) {
    const bf16_t* U = (const bf16_t*)(a.ws + WS_U); bf16_t* ymix = (bf16_t*)((unsigned char*)a.out + 96 * MiB);
    const int lane = tid_now() & 63;
    for (int w = blockIdx.x * 8 + (tid_now() >> 6); w < NTOK * 4; w += gridDim.x * 8) {
        const int tok = w >> 2, h = w & 3;
        const size_t o = (size_t)tok * 512 + h * 128 + lane * 2;
        const float a0 = OF[o] + OB[o], a1 = OF[o + 1] + OB[o + 1];
        const float ss = wave_sum(a0 * a0 + a1 * a1);
        const float rstd = rsqrtf(ss * (1.0f / 128.0f) + NORM_EPS);
        const bf16_t* z = U + (size_t)tok * UP + C_ZA + h * 128 + lane * 2;
        const float y0 = a0 * rstd * a.ng[lane * 2] * silu(bf2f(z[0])), y1 = a1 * rstd * a.ng[lane * 2 + 1] * silu(bf2f(z[1]));
        *(unsigned*)(ymix + (size_t)tok * DM + h * 128 + lane * 2) = pk2(y0, y1);
    }
}
__device__ __forceinline__ int t5_bucket(int rel) {
    const int n = rel < 0 ? -rel : rel;
    int b = n < 8 ? n : (n < 12 ? 8 : (n < 16 ? 9 : (n < 23 ? 10 : (n < 32 ? 11 : (n < 46 ? 12 : (n < 64 ? 13 : (n < 91 ? 14 : 15)))))));
    return b + (rel > 0 ? 16 : 0);
}
__device__ __forceinline__ void phase_swa_naive(const Args& a, LAS unsigned char* lds) {
    const bf16_t* U = (const bf16_t*)(a.ws + WS_U); bf16_t* ymix = (bf16_t*)((unsigned char*)a.out + 96 * MiB);
    const int wv = tid_now() >> 6, lane = tid_now() & 63;
    LAS float* sq = (LAS float*)(lds + 65536) + wv * 64; LAS float* sp = (LAS float*)(lds + 65536 + 2048) + wv * 320;
    for (int w = blockIdx.x * 8 + wv; w < NTOK * 8; w += gridDim.x * 8) {
        const int tok = w >> 3, hq = w & 7, kv = hq >> 2;
        int s0, L; seq_of(tok, s0, L); const int i = tok - s0;
        sq[lane] = bf2f(U[(size_t)tok * UP + C_QB + hq * 64 + lane]);
        const float snk = a.sink[hq];
        float sc[5]; float mx = snk;
#pragma unroll
        for (int c = 0; c < 5; ++c) {
            const int jj = c * 64 + lane, j = i - 128 + jj; const bool valid = jj <= 256 && j >= 0 && j < L;
            float d = -INFINITY;
            if (valid) {
                const bf16_t* kr = U + (size_t)(s0 + j) * UP + C_KB + kv * 64; d = 0.f;
#pragma unroll
                for (int e = 0; e < 64; e += 8) { const u32x4 kk = *(const u32x4*)(kr + e);
                    d += sq[e] * __uint_as_float(kk.x << 16) + sq[e + 1] * __uint_as_float(kk.x & 0xffff0000u) + sq[e + 2] * __uint_as_float(kk.y << 16) + sq[e + 3] * __uint_as_float(kk.y & 0xffff0000u)
                       + sq[e + 4] * __uint_as_float(kk.z << 16) + sq[e + 5] * __uint_as_float(kk.z & 0xffff0000u) + sq[e + 6] * __uint_as_float(kk.w << 16) + sq[e + 7] * __uint_as_float(kk.w & 0xffff0000u); }
                d += a.relb[t5_bucket(j - i) * 8 + hq];
            }
            sc[c] = d; mx = fmaxf(mx, d);
        }
        mx = wave_max(mx);
        float den = 0.f;
#pragma unroll
        for (int c = 0; c < 5; ++c) { sc[c] = sc[c] == -INFINITY ? 0.f : __expf(sc[c] - mx); den += sc[c]; }
        den = wave_sum(den) + __expf(snk - mx);
        const float inv = 1.0f / den;
#pragma unroll
        for (int c = 0; c < 5; ++c) sp[c * 64 + lane] = sc[c] * inv;
        float o = 0.f;
        for (int jj = 0; jj <= 256; ++jj) { const int j = i - 128 + jj; if (j >= 0 && j < L) o += sp[jj] * bf2f(U[(size_t)(s0 + j) * UP + C_VB + kv * 64 + lane]); }
        const float z = bf2f(U[(size_t)tok * UP + C_ZB + hq * 64 + lane]);
        ymix[(size_t)tok * DM + 512 + hq * 64 + lane] = f2bf(o * silu(z));
    }
}
template <int FINAL>
__device__ __forceinline__ void phase_ln(float* Y, const f32x2* stat, f32x2* mr, const float* lg, const float* lb, bf16_t* xb) {
    const int lane = tid_now() & 63;
    for (int row = blockIdx.x * 8 + (tid_now() >> 6); row < NTOK; row += gridDim.x * 8) {
        f32x2 p = lane < 16 ? stat[(size_t)row * 16 + lane] : (f32x2){0.f, 0.f};
        const float s = wave_sum(p.x), q = wave_sum(p.y);
        const float mean = s * (1.0f / DM), var = q * (1.0f / DM) - mean * mean, rstd = rsqrtf(fmaxf(var, 0.f) + LN_EPS);
        if (!FINAL && lane == 0) mr[row] = (f32x2){mean, rstd};
#pragma unroll
        for (int j = 0; j < 4; ++j) {
            const int c = j * 256 + lane * 4;
            const f32x4 y = *(const f32x4*)(Y + (size_t)row * DM + c), g = *(const f32x4*)(lg + c), b = *(const f32x4*)(lb + c);
            const f32x4 o = (y - mean) * rstd * g + b;
            if (FINAL) *(f32x4*)(Y + (size_t)row * DM + c) = o;
            else { u32x2 w; w.x = pk2(o[0], o[1]); w.y = pk2(o[2], o[3]); *(u32x2*)(xb + (size_t)row * DM + c) = w; }
        }
    }
}
__device__ __forceinline__ void phase_convgate(const bf16_t* P, const bf16_t* S, const float* cw, bf16_t* G) {
    const size_t n8 = (size_t)NTOK * DM / 8;
    for (size_t i = (size_t)blockIdx.x * NTHR + tid_now(); i < n8; i += (size_t)gridDim.x * NTHR) {
        const int row = (int)(i >> 7), c = (int)(i & 127) * 8; int s0, L; seq_of(row, s0, L);
        const bool hasl = row > s0, hasr = row < s0 + L - 1;
        const u32x4 pm = *(const u32x4*)(P + (size_t)row * DM + c), sv = *(const u32x4*)(S + (size_t)row * DM + c);
        u32x4 pl = (u32x4){0, 0, 0, 0}, pr = (u32x4){0, 0, 0, 0};
        if (hasl) pl = *(const u32x4*)(P + (size_t)(row - 1) * DM + c);
        if (hasr) pr = *(const u32x4*)(P + (size_t)(row + 1) * DM + c);
        float o[8];
#pragma unroll
        for (int j = 0; j < 4; ++j) {
            const unsigned l = pl[j], m = pm[j], r = pr[j], sw = sv[j];
            const int cc = c + 2 * j;
            o[2 * j] = __uint_as_float(sw << 16) * (cw[cc] * __uint_as_float(l << 16) + cw[1024 + cc] * __uint_as_float(m << 16) + cw[2048 + cc] * __uint_as_float(r << 16));
            o[2 * j + 1] = __uint_as_float(sw & 0xffff0000u) * (cw[cc + 1] * __uint_as_float(l & 0xffff0000u) + cw[1024 + cc + 1] * __uint_as_float(m & 0xffff0000u) + cw[2048 + cc + 1] * __uint_as_float(r & 0xffff0000u));
        }
        u32x4 w; w.x = pk2(o[0], o[1]); w.y = pk2(o[2], o[3]); w.z = pk2(o[4], o[5]); w.w = pk2(o[6], o[7]);
        *(u32x4*)(G + (size_t)row * DM + c) = w;
    }
}

typedef short s16x4 __attribute__((ext_vector_type(4)));
constexpr int GL_QT = 0, GL_KT = 16384, GL_VT = 32768, GL_PT = 49152, GL_B = 57344, GL_GD = 90112, GL_TOT = 94208, GL_EBL = 96256  , GL_SSW = 97280, GL_RSTD = 99328;
constexpr int NSEG = NTOK / 256;
__device__ __forceinline__ unsigned offb(unsigned row, unsigned ch) { return 256u * row + 16u * (ch ^ (((row & 3) << 2) | ((row >> 2) & 3))); }
__device__ __forceinline__ unsigned offp(unsigned row, unsigned ch) { return 128u * row + 16u * (ch ^ (row & 7)); }
__device__ __forceinline__ unsigned rr16(unsigned lane, unsigned rb, unsigned s) { return offb((lane & 15) + 16 * rb, 4 * s + (lane >> 4)); }
__device__ __forceinline__ unsigned tr16(unsigned lane, unsigned c, unsigned ks, unsigned t) {
    const unsigned g = lane >> 4, q = (lane & 15) >> 2, p = lane & 3;
    return offb(32 * ks + 8 * g + 4 * t + q, 2 * c + (p >> 1)) + 8 * (p & 1);
}
__device__ __forceinline__ bf16x8 tr_read8(unsigned a0, unsigned a1) {
    s16x4 r0, r1;
    asm volatile("ds_read_b64_tr_b16 %0, %2\n\tds_read_b64_tr_b16 %1, %3\n\ts_waitcnt lgkmcnt(0)" : "=&v"(r0), "=&v"(r1) : "v"(a0), "v"(a1) : "memory");
    return __builtin_shufflevector(r0, r1, 0, 1, 2, 3, 4, 5, 6, 7);
}
__device__ __forceinline__ void unpack8(const u32x4 w, float (&f)[8]) {
#pragma unroll
    for (int j = 0; j < 4; ++j) { f[2 * j] = __uint_as_float(w[j] << 16); f[2 * j + 1] = __uint_as_float(w[j] & 0xffff0000u); }
}

struct GlaPre { u32x4 gd[4]; u32x4 q[2], k[2], v[2]; u32x4 wf; float wb; };
template <int MODE>
__device__ __forceinline__ void gla_prefetch(const Args& a, GlaPre& pre, int tid, int tb, int h, int dir, int stidx) {
    const bf16_t* U = (const bf16_t*)(a.ws + WS_U);
    const int lane = tid & 63, n = lane & 15, g = lane >> 4, w = tid >> 6;
#pragma unroll
    for (int it = 0; it < 4; ++it) { const int row = 16 * it + n, tok = dir ? tb + 63 - row : tb + row; pre.gd[it] = *(const u32x4*)(U + (size_t)tok * UP + C_GD + dir * 16 + 8 * (g & 1)); }
#pragma unroll
    for (int i = 0; i < 2; ++i) {
        const int idx = tid + 512 * i, row = idx >> 4, ch = idx & 15, tok = dir ? tb + 63 - row : tb + row;
        const bf16_t* ur = U + (size_t)tok * UP + h * 128 + ch * 8;
        pre.v[i] = *(const u32x4*)(ur + C_VA); pre.k[i] = *(const u32x4*)(ur + C_KA);
        if (MODE != 0) pre.q[i] = *(const u32x4*)(ur + C_QA);
    }
    pre.wf = ((const u32x4*)(a.ws + WS_GATE))[(dir * 4 + h) * 512 + tid];
    pre.wb = ((const float*)(a.ws + WS_GATE + 65536))[(dir * 4 + h) * 128 + 16 * w + n];
}
__device__ __forceinline__ bf16x8 tr_read8(LAS unsigned char* lds, unsigned a0, unsigned a1) {
    const s16x4 r0 = __builtin_amdgcn_ds_read_tr16_b64_v4i16((LAS s16x4*)(lds + a0)), r1 = __builtin_amdgcn_ds_read_tr16_b64_v4i16((LAS s16x4*)(lds + a1));
    return __builtin_shufflevector(r0, r1, 0, 1, 2, 3, 4, 5, 6, 7);
}
template <int CTRL> __device__ __forceinline__ float dpp_f(float x) { return __int_as_float(__builtin_amdgcn_update_dpp(0, __float_as_int(x), CTRL, 0xf, 0xf, true)); }
constexpr int GL_BP = 132;
template <int MODE>
__device__ __forceinline__ void gla_chunk(const Args& a, LAS unsigned char* lds, const int tb, const int h, const int dir,
                                          f32x4 (&Sacc)[8], float& lam, u32x4* stash, GlaPre& pre, const int ntb, const int nh, const int ndir, const bool first, const int par) {
    const bf16_t* U = (const bf16_t*)(a.ws + WS_U);
    int tid = tid_now(); asm volatile("" : "+v"(tid));
    const int lane = tid & 63, w = __builtin_amdgcn_readfirstlane(tid >> 6), n = lane & 15, g = lane >> 4;
    const unsigned fn = ((n & 3) << 2) | ((n >> 2) & 3);
    const unsigned base_rr = 256u * n + 16u * (g ^ fn);
    const unsigned base_c = 256u * n + 16u * ((g >> 1) ^ fn) + 8u * (g & 1);
    const unsigned base_p = 128u * n + 16u * (g ^ (n & 7));
    const unsigned trb0 = tr16(lane, 0, 0, 0), trb1 = tr16(lane, 0, 0, 1);
    GlaPre& cur = pre;
    const bf16x8 wfrag = __builtin_bit_cast(bf16x8, cur.wf); const float wbias = cur.wb;
    int prow[2], pch[2], ptok[2];
#pragma unroll
    for (int i = 0; i < 2; ++i) { const int idx = tid + 512 * i; prow[i] = idx >> 4; pch[i] = idx & 15; ptok[i] = dir ? tb + 63 - prow[i] : tb + prow[i]; }
    u32x4 st0, st1, zraw[2];
    {
        LAS float* B = (LAS float*)(lds + GL_B);
        bf16x8 vh[2], vl[2];
#pragma unroll
        for (int ks = 0; ks < 2; ++ks) {
            float vv[8];
#pragma unroll
            for (int half = 0; half < 2; ++half) {
                const f32x4 x = MFMA16(__builtin_bit_cast(bf16x8, cur.gd[2 * ks + half]), wfrag, ((f32x4){wbias, wbias, wbias, wbias}));
#pragma unroll
                for (int r = 0; r < 4; ++r) { const float xs = x[r] * 1.4426950408889634f; vv[4 * half + r] = (fminf(xs, 0.f) - flog2(1.0f + fexp2(-fabsf(xs)))) * (1.0f / 16.0f); }
            }
            u32x4 hw, lw;
#pragma unroll
            for (int q = 0; q < 4; ++q) { const unsigned hp = pk2(vv[2 * q], vv[2 * q + 1]); hw[q] = hp;
                lw[q] = pk2(vv[2 * q] - __uint_as_float(hp << 16), vv[2 * q + 1] - __uint_as_float(hp & 0xffff0000u)); }
            vh[ks] = __builtin_bit_cast(bf16x8, hw); vl[ks] = __builtin_bit_cast(bf16x8, lw);
        }
        u32x4 ta, tbm;
#pragma unroll
        for (int q = 0; q < 2; ++q) { const unsigned lo = (4 * g + 2 * q <= n) ? 0x3f80u : 0u, hi = (4 * g + 2 * q + 1 <= n) ? 0x3f800000u : 0u; ta[q] = lo | hi; ta[2 + q] = 0u; tbm[q] = 0x3f803f80u; tbm[2 + q] = lo | hi; }
        const bf16x8 TA = __builtin_bit_cast(bf16x8, ta), TB = __builtin_bit_cast(bf16x8, tbm), ONES = __builtin_bit_cast(bf16x8, ((u32x4){0x3f803f80u, 0x3f803f80u, 0x3f803f80u, 0x3f803f80u}));
        const f32x4 z4 = (f32x4){0.f, 0.f, 0.f, 0.f};
        f32x4 bt[4];
        bt[0] = MFMA16(TA, vl[0], MFMA16(TA, vh[0], z4));
        bt[1] = MFMA16(TB, vl[0], MFMA16(TB, vh[0], z4));
        const f32x4 s32 = MFMA16(ONES, vl[0], MFMA16(ONES, vh[0], z4));
        bt[2] = MFMA16(TA, vl[1], MFMA16(TA, vh[1], s32));
        bt[3] = MFMA16(TB, vl[1], MFMA16(TB, vh[1], s32));
#pragma unroll
        for (int it = 0; it < 4; ++it)
#pragma unroll
            for (int r = 0; r < 4; ++r) B[(16 * it + 4 * g + r) * GL_BP + 16 * w + n] = bt[it][r];
        if (g == 3) { ((LAS float*)(lds + GL_EBL + par * 512))[16 * w + n] = fexp2(bt[3][3]); lam += bt[3][3]; }
    }
    __syncthreads();
#pragma unroll
    for (int i = 0; i < 2; ++i) {
        const LAS f32x4* bp = (const LAS f32x4*)(lds + GL_B + (prow[i] * GL_BP + pch[i] * 8) * 4);
        const f32x4 b0 = bp[0], b1 = bp[1];
        float e[8], kf[8];
#pragma unroll
        for (int j = 0; j < 4; ++j) { e[j] = fexp2(b0[j]); e[4 + j] = fexp2(b1[j]); }
        unpack8(cur.k[i], kf);
        u32x4 kw;
#pragma unroll
        for (int j = 0; j < 4; ++j) kw[j] = pk2(kf[2 * j] * __builtin_amdgcn_rcpf(e[2 * j]), kf[2 * j + 1] * __builtin_amdgcn_rcpf(e[2 * j + 1]));
        *(LAS u32x4*)(lds + GL_KT + offb(prow[i], pch[i])) = kw;
        *(LAS u32x4*)(lds + GL_VT + offb(prow[i], pch[i])) = cur.v[i];
        if (MODE != 0) {
            float qf[8]; unpack8(cur.q[i], qf);
            u32x4 qw;
#pragma unroll
            for (int j = 0; j < 4; ++j) qw[j] = pk2(qf[2 * j] * e[2 * j], qf[2 * j + 1] * e[2 * j + 1]);
            *(LAS u32x4*)(lds + GL_QT + offb(prow[i], pch[i])) = qw;
        }
    }
    __syncthreads();
    gla_prefetch<MODE>(a, pre, tid, ntb, nh, ndir, -1);
    f32x4 Oacc[4];
    if (MODE != 0) {
        const int it = w >> 1;
#pragma unroll
        for (int jj = 0; jj < 2; ++jj) {
            const int jt = 2 * (w & 1) + jj;
            f32x4 pacc = (f32x4){0.f, 0.f, 0.f, 0.f};
            if (jt <= it) {
#pragma unroll
                for (int s = 0; s < 4; ++s) {
                    const bf16x8 qa = *(const LAS bf16x8*)(lds + GL_QT + (base_rr ^ (64u * s)) + 4096u * it);
                    const bf16x8 kb = *(const LAS bf16x8*)(lds + GL_KT + (base_rr ^ (64u * s)) + 4096u * jt); pacc = MFMA16(qa, kb, pacc); }
            }
            const int j = 16 * jt + n;
#pragma unroll
            for (int r = 0; r < 4; ++r) {
                const int i = 16 * it + 4 * g + r;
                const bool keep = (MODE == 1) ? (j <= i) : (j < i);
                *(LAS bf16_t*)(lds + GL_PT + offp(i, j >> 3) + 2 * (j & 7)) = keep ? f2bf(pacc[r]) : (bf16_t)0;
            }
            __builtin_amdgcn_sched_barrier(0);
        }
        if (first) {
#pragma unroll
            for (int kt = 0; kt < 8; ++kt) { const unsigned r0 = __float_as_uint(Sacc[kt][0]), r1 = __float_as_uint(Sacc[kt][1]);
                Sacc[kt] = (f32x4){__uint_as_float(r0 << 16), __uint_as_float(r0 & 0xffff0000u), __uint_as_float(r1 << 16), __uint_as_float(r1 & 0xffff0000u)}; }
        }
#pragma unroll
        for (int i2 = 0; i2 < 4; ++i2) Oacc[i2] = (f32x4){0.f, 0.f, 0.f, 0.f};
#pragma unroll
        for (int ks = 0; ks < 4; ++ks) {
            u32x4 pw; pw.x = pk2(Sacc[2 * ks][0], Sacc[2 * ks][1]); pw.y = pk2(Sacc[2 * ks][2], Sacc[2 * ks][3]); pw.z = pk2(Sacc[2 * ks + 1][0], Sacc[2 * ks + 1][1]); pw.w = pk2(Sacc[2 * ks + 1][2], Sacc[2 * ks + 1][3]);
            const bf16x8 sb = __builtin_bit_cast(bf16x8, pw);
            const unsigned alo = base_c ^ (64u * ks);
#pragma unroll
            for (int i2 = 0; i2 < 4; ++i2) {
                const u32x2 lo = *(const LAS u32x2*)(lds + GL_QT + 4096 * i2 + alo);
                const u32x2 hi = *(const LAS u32x2*)(lds + GL_QT + 4096 * i2 + (alo ^ 32u));
                u32x4 aw; aw.x = lo.x; aw.y = lo.y; aw.z = hi.x; aw.w = hi.y;
                Oacc[i2] = MFMA16(__builtin_bit_cast(bf16x8, aw), sb, Oacc[i2]);
            }
            __builtin_amdgcn_sched_barrier(0);
        }
        __syncthreads();
        if (MODE == 2) {
            st0 = stash[tid * 2]; st1 = stash[tid * 2 + 1];
#pragma unroll
            for (int i = 0; i < 2; ++i) zraw[i] = *(const u32x4*)(U + (size_t)ptok[i] * UP + C_ZA + h * 128 + pch[i] * 8);
        }
    }
    bf16x8 vf[2];
#pragma unroll
    for (int ks = 0; ks < 2; ++ks) vf[ks] = tr_read8(lds, GL_VT + 8192u * ks + (trb0 ^ (32u * w)), GL_VT + 8192u * ks + (trb1 ^ (32u * w)));
    if (MODE != 0) {
#pragma unroll
        for (int i2 = 0; i2 < 4; ++i2)
#pragma unroll
            for (int ks = 0; ks < 2; ++ks) {
                if (ks <= (i2 >> 1)) { const bf16x8 pa = *(const LAS bf16x8*)(lds + GL_PT + 2048 * i2 + (base_p ^ (64u * ks))); Oacc[i2] = MFMA16(pa, vf[ks], Oacc[i2]); }
            }
    }
#pragma unroll
    for (int kt = 0; kt < 8; ++kt) {
#pragma unroll
        for (int ks = 0; ks < 2; ++ks) { const bf16x8 ka = tr_read8(lds, GL_KT + 8192u * ks + (trb0 ^ (32u * kt)), GL_KT + 8192u * ks + (trb1 ^ (32u * kt))); Sacc[kt] = MFMA16(ka, vf[ks], Sacc[kt]); }
        const f32x4 eb = *(const LAS f32x4*)(lds + GL_EBL + par * 512 + (16 * kt + 4 * g) * 4);
        Sacc[kt] = Sacc[kt] * eb;
        if (kt & 1) __builtin_amdgcn_sched_barrier(0);
    }
    if (MODE == 1) {
        u32x4 s0, s1;
        s0.x = pk2(Oacc[3][3], Oacc[3][2]); s0.y = pk2(Oacc[3][1], Oacc[3][0]); s0.z = pk2(Oacc[2][3], Oacc[2][2]); s0.w = pk2(Oacc[2][1], Oacc[2][0]);
        s1.x = pk2(Oacc[1][3], Oacc[1][2]); s1.y = pk2(Oacc[1][1], Oacc[1][0]); s1.z = pk2(Oacc[0][3], Oacc[0][2]); s1.w = pk2(Oacc[0][1], Oacc[0][0]);
        const int tidm = tid ^ 48;
        stash[tidm * 2] = s0; stash[tidm * 2 + 1] = s1;
    }
    if (MODE == 2) {
        float fo[16]; { float t8[8]; unpack8(st0, t8);
#pragma unroll
            for (int j = 0; j < 8; ++j) fo[j] = t8[j]; unpack8(st1, t8);
#pragma unroll
            for (int j = 0; j < 8; ++j) fo[8 + j] = t8[j]; }
        LAS float* ssw = (LAS float*)(lds + GL_SSW);
#pragma unroll
        for (int i2 = 0; i2 < 4; ++i2)
#pragma unroll
            for (int r = 0; r < 4; ++r) {
                const float o = Oacc[i2][r] + fo[4 * i2 + r]; Oacc[i2][r] = o;
                float v = o * o; v += dpp_f<0x128>(v); v += dpp_f<0x124>(v); v += dpp_f<0x122>(v); v += dpp_f<0x121>(v);
                if (n == 0) ssw[w * 64 + 16 * i2 + 4 * g + r] = v;
            }
        __syncthreads();
        if (tid < 64) { float s = 0.f;
#pragma unroll
            for (int ww = 0; ww < 8; ++ww) s += ssw[ww * 64 + tid];
            ((LAS float*)(lds + GL_RSTD))[tid] = rsqrtf(s * (1.0f / 128.0f) + NORM_EPS); }
        __syncthreads();
        const float gn = a.ng[16 * w + n];
#pragma unroll
        for (int i2 = 0; i2 < 4; ++i2) {
            const f32x4 rs = *(const LAS f32x4*)(lds + GL_RSTD + (16 * i2 + 4 * g) * 4);
#pragma unroll
            for (int r = 0; r < 4; ++r) *(LAS bf16_t*)(lds + GL_QT + (16 * i2 + 4 * g + r) * 256 + (16 * w + n) * 2) = f2bf(Oacc[i2][r] * rs[r] * gn);
        }
        __syncthreads();
        bf16_t* ymix = (bf16_t*)((unsigned char*)a.out + 96 * MiB);
#pragma unroll
        for (int i = 0; i < 2; ++i) {
            const u32x4 ov = *(const LAS u32x4*)(lds + GL_QT + prow[i] * 256 + pch[i] * 16);
            float of[8], zf[8]; unpack8(ov, of); unpack8(zraw[i], zf);
            u32x4 yw;
#pragma unroll
            for (int j = 0; j < 4; ++j) yw[j] = pk2(of[2 * j] * silu(zf[2 * j]), of[2 * j + 1] * silu(zf[2 * j + 1]));
            *(u32x4*)(ymix + (size_t)ptok[i] * DM + h * 128 + pch[i] * 8) = yw;
        }
    }
}
__device__ __forceinline__ void build_gate_tables(const Args& a) {
    for (int e = blockIdx.x * NTHR + tid_now(); e < 8 * 512; e += gridDim.x * NTHR) {
        const int dh = e >> 9, tid = e & 511, dir = dh >> 2, h = dh & 3, lane = tid & 63, w = tid >> 6, n = lane & 15, g = lane >> 4, col = h * 128 + 16 * w + n;
        const float* wup = dir ? a.wub : a.wuf; const float* bias = dir ? a.bbw : a.bfw;
        u32x4 pw;
#pragma unroll
        for (int j = 0; j < 4; ++j) {
            const float v0 = wup[(8 * (g & 1) + 2 * j) * 512 + col], v1 = wup[(8 * (g & 1) + 2 * j + 1) * 512 + col];
            const float h0 = bf2f(f2bf(v0)), h1 = bf2f(f2bf(v1));
            pw[j] = g < 2 ? pk2(v0, v1) : pk2(v0 - h0, v1 - h1);
        }
        ((u32x4*)(a.ws + WS_GATE))[e] = pw;
        if (g == 0) ((float*)(a.ws + WS_GATE + 65536))[dh * 128 + 16 * w + n] = bias[col];
    }
}
__device__ __forceinline__ void phase_gla_pass1(const Args& a, LAS unsigned char* lds) {
    const int tid = tid_now(), w = tid >> 6, lane = tid & 63;
    unsigned char* ST = a.ws + WS_ST;
    const int nsteps = ((NSEG * 8 - (int)blockIdx.x + (int)gridDim.x - 1) / (int)gridDim.x) * 4;
    auto params = [&](int st, int& tb, int& h, int& dir) { if (st >= nsteps) st = nsteps - 1; const int item = blockIdx.x + (st >> 2) * gridDim.x, cc = st & 3; dir = item & 1; h = (item >> 1) & 3; tb = (item >> 3) * 256 + (dir ? 3 - cc : cc) * 64; };
    GlaPre preA, preB; int par = 0;
    if (nsteps > 0) { int tb, h, dir; params(0, tb, h, dir); gla_prefetch<0>(a, preA, tid, tb, h, dir, -1); params(1, tb, h, dir); gla_prefetch<0>(a, preB, tid, tb, h, dir, -1); }
    f32x4 Sacc[8]; float lam;
    for (int st = 0; st < nsteps; st += 2) {
        const int item = blockIdx.x + (st >> 2) * gridDim.x;
        if ((st & 3) == 0) {
#pragma unroll
            for (int kt = 0; kt < 8; ++kt) Sacc[kt] = (f32x4){0.f, 0.f, 0.f, 0.f};
            lam = 0.f;
        }
        { int tb, h, dir, ntb, nh, ndir; params(st, tb, h, dir); params(st + 2, ntb, nh, ndir); gla_chunk<0>(a, lds, tb, h, dir, Sacc, lam, nullptr, preA, ntb, nh, ndir, false, par); par ^= 1; }
        { int tb, h, dir, ntb, nh, ndir; params(st + 1, tb, h, dir); params(st + 3, ntb, nh, ndir); gla_chunk<0>(a, lds, tb, h, dir, Sacc, lam, nullptr, preB, ntb, nh, ndir, false, par); par ^= 1; }
        if ((st & 3) == 2) {
            u32x2* dst = (u32x2*)(ST + (size_t)item * 32768) + (size_t)w * 8 * 64 + lane;
#pragma unroll
            for (int kt = 0; kt < 8; ++kt) { u32x2 v; v.x = pk2(Sacc[kt][0], Sacc[kt][1]); v.y = pk2(Sacc[kt][2], Sacc[kt][3]); dst[kt * 64] = v; }
            if ((lane >> 4) == 3) ((float*)(a.ws + WS_DEC))[(size_t)item * 128 + 16 * w + (lane & 15)] = lam;
        }
    }
    __syncthreads();
}
__device__ __forceinline__ void phase_gla_pass2(const Args& a) {
    unsigned char* ST = a.ws + WS_ST; const float* DEC = (const float*)(a.ws + WS_DEC);
    for (int gidx = blockIdx.x * NTHR + tid_now(); gidx < 48 * 4096; gidx += gridDim.x * NTHR) {
        const int chain = gidx >> 12, quad = gidx & 4095, dir = chain & 1, h = (chain >> 1) & 3, s = chain >> 3;
        const int nseg = s < 2 ? LP / 256 : LS / 256, seg0 = s < 2 ? s * (LP / 256) : 2 * (LP / 256) + (s - 2) * (LS / 256);
        const int kt = (quad >> 6) & 7, lane = quad & 63, dk0 = 16 * kt + 4 * (lane >> 4);
        f32x4 S = (f32x4){0.f, 0.f, 0.f, 0.f};
        for (int i0 = 0; i0 < nseg; i0 += 8) {
            u32x2 t[8]; f32x4 lm[8];
#pragma unroll
            for (int j = 0; j < 8; ++j) { const int seg = dir ? seg0 + nseg - 1 - (i0 + j) : seg0 + i0 + j; const size_t idx = (size_t)((seg * 4 + h) * 2 + dir);
                t[j] = ((const u32x2*)(ST + idx * 32768))[quad]; lm[j] = *(const f32x4*)(DEC + idx * 128 + dk0); }
#pragma unroll
            for (int j = 0; j < 8; ++j) { const int seg = dir ? seg0 + nseg - 1 - (i0 + j) : seg0 + i0 + j; const size_t idx = (size_t)((seg * 4 + h) * 2 + dir);
                u32x2 o; o.x = pk2(S[0], S[1]); o.y = pk2(S[2], S[3]); ((u32x2*)(ST + idx * 32768))[quad] = o;
                const f32x4 tv = (f32x4){__uint_as_float(t[j].x << 16), __uint_as_float(t[j].x & 0xffff0000u), __uint_as_float(t[j].y << 16), __uint_as_float(t[j].y & 0xffff0000u)};
                S = (f32x4){fexp2(lm[j][0]), fexp2(lm[j][1]), fexp2(lm[j][2]), fexp2(lm[j][3])} * S + tv; }
        }
    }
}
__device__ __forceinline__ void phase_gla_pass3(const Args& a, LAS unsigned char* lds) {
    const int tid = tid_now(), w = tid >> 6, lane = tid & 63;
    GlaPre pre; int par = 0;
    if (blockIdx.x < NSEG * 4) gla_prefetch<1>(a, pre, tid, (blockIdx.x >> 2) * 256, blockIdx.x & 3, 0, -1);
    for (int item = blockIdx.x; item < NSEG * 4; item += gridDim.x) {
        const int h = item & 3, seg = item >> 2;
        const int nitem = item + gridDim.x < NSEG * 4 ? item + gridDim.x : item;
        u32x4* stash = (u32x4*)a.out + (size_t)item * 4 * 1024;
#pragma unroll 1
        for (int dir = 0; dir < 2; ++dir) {
            f32x4 Sacc[8];
            const u32x2* src = (const u32x2*)(a.ws + WS_ST + (size_t)((seg * 4 + h) * 2 + dir) * 32768) + (size_t)w * 8 * 64 + lane;
#pragma unroll
            for (int kt = 0; kt < 8; ++kt) { const u32x2 v = src[kt * 64]; Sacc[kt] = (f32x4){__uint_as_float(v.x), __uint_as_float(v.y), 0.f, 0.f}; }
            float lam = 0.f;
            if (dir == 0) {
                for (int c = 0; c < 4; ++c) { const int ntb = seg * 256 + (c < 3 ? c + 1 : 3) * 64, ndir = c < 3 ? 0 : 1;
                    gla_chunk<1>(a, lds, seg * 256 + c * 64, h, 0, Sacc, lam, stash + c * 1024, pre, ntb, h, ndir, c == 0, par); par ^= 1; }
            } else {
                for (int c = 3; c >= 0; --c) { const int ntb = c > 0 ? seg * 256 + (c - 1) * 64 : (nitem >> 2) * 256, nh = c > 0 ? h : (nitem & 3), ndir = c > 0 ? 1 : 0;
                    gla_chunk<2>(a, lds, seg * 256 + c * 64, h, 1, Sacc, lam, stash + c * 1024, pre, ntb, nh, ndir, c == 3, par); par ^= 1; }
            }
        }
    }
    __syncthreads();
}
typedef float f32x16 __attribute__((ext_vector_type(16)));
#define MFMA32(a, b, c) __builtin_amdgcn_mfma_f32_32x32x16_bf16((a), (b), (c), 0, 0, 0)
constexpr int SW_K = 0, SW_V = 65536, SW_TB = 131072, SW_TBN = 336, SW_TBH = 4 * SW_TBN * 4;
constexpr float SW_NEG = -1e30f;
__device__ __forceinline__ unsigned offk(unsigned row, unsigned c8) { return 128u * row + 16u * (c8 ^ ((row >> 1) & 7)); }
__device__ __forceinline__ unsigned offv(unsigned row, unsigned c8) { return 128u * row + 16u * (c8 ^ (((row >> 1) & 1) << 2)); }
__device__ __forceinline__ void swa_load_block(const bf16_t* U, int gb, int kvh, bool valid, int tid, u32x4 (&kk)[2], u32x4 (&vv)[2]) {
#pragma unroll
    for (int i = 0; i < 2; ++i) {
        const int idx = tid + 512 * i, r = idx >> 3, c8 = idx & 7;
        kk[i] = (u32x4){0, 0, 0, 0}; vv[i] = (u32x4){0, 0, 0, 0};
        if (valid) { const bf16_t* ur = U + (size_t)(gb * 128 + r) * UP + kvh * 64 + c8 * 8; kk[i] = *(const u32x4*)(ur + C_KB); vv[i] = *(const u32x4*)(ur + C_VB); }
    }
}
__device__ __forceinline__ void swa_store_block(LAS unsigned char* lds, int gb, int tid, const u32x4 (&kk)[2], const u32x4 (&vv)[2]) {
#pragma unroll
    for (int i = 0; i < 2; ++i) {
        const int idx = tid + 512 * i, r = 128 * (gb & 3) + (idx >> 3), c8 = idx & 7;
        *(LAS u32x4*)(lds + SW_K + offk(r, c8)) = kk[i]; *(LAS u32x4*)(lds + SW_V + offv(r, c8)) = vv[i];
    }
}
__device__ __forceinline__ bool swa_exists(int gb) { return gb >= 0 && gb < NTOK / 128; }
__device__ __forceinline__ void phase_swa(const Args& a, LAS unsigned char* lds) {
    const bf16_t* U = (const bf16_t*)(a.ws + WS_U); bf16_t* ymix = (bf16_t*)((unsigned char*)a.out + 96 * MiB);
    const int tid = tid_now(), lane = tid & 63, w = __builtin_amdgcn_readfirstlane(tid >> 6), r = lane & 31, hh = lane >> 5;
    for (int su = blockIdx.x; su < (NTOK / 128 / 3) * 2; su += gridDim.x) {
        const int kvh = su & 1, qb0 = 3 * (su >> 1);
        __syncthreads();
        for (int e = tid; e < 4 * SW_TBN; e += NTHR) {
            const int hl = e / SW_TBN, idx = e - hl * SW_TBN, rel = idx - 160;
            const float val = (rel >= -128 && rel <= 128) ? a.relb[t5_bucket(rel) * 8 + kvh * 4 + hl] : SW_NEG;
            LAS float* tb = (LAS float*)(lds + SW_TB + hl * SW_TBH);
#pragma unroll
            for (int s = 0; s < 4; ++s) if (idx - s >= 0) tb[s * SW_TBN + idx - s] = val;
        }
#pragma unroll 1
        for (int bb = -1; bb <= 1; ++bb) { u32x4 kk[2], vv[2]; swa_load_block(U, qb0 + bb, kvh, swa_exists(qb0 + bb), tid, kk, vv); swa_store_block(lds, qb0 + bb, tid, kk, vv); }
        __syncthreads();
        const int hl = w >> 1, hq = kvh * 4 + hl;
        const float snk = a.sink[hq];
#pragma unroll 1
        for (int qi = 0; qi < 3; ++qi) {
            const int qb = qb0 + qi, tok0 = qb * 128; int s0, L; seq_of(tok0, s0, L);
            const bool first = tok0 == s0, last = tok0 + 128 == s0 + L;
            u32x4 nk[2], nv[2];
            if (qi < 2) swa_load_block(U, qb + 2, kvh, swa_exists(qb + 2), tid, nk, nv);
            bf16x8 Qn[4];
            { const int qt0 = tok0 + 32 * ((w & 1) * 2) + r;
#pragma unroll
              for (int s = 0; s < 4; ++s) Qn[s] = *(const bf16x8*)(U + (size_t)qt0 * UP + C_QB + hq * 64 + 16 * s + 8 * hh); }
#pragma unroll 1
            for (int ss = 0; ss < 2; ++ss) {
                const int st = (w & 1) * 2 + ss, qtok = tok0 + 32 * st + r;
                bf16x8 Qf[4];
#pragma unroll
                for (int s = 0; s < 4; ++s) Qf[s] = Qn[s];
                { const int qt1 = ss == 0 ? qtok + 32 : qtok;
#pragma unroll
                  for (int s = 0; s < 4; ++s) Qn[s] = *(const bf16x8*)(U + (size_t)qt1 * UP + C_QB + hq * 64 + 16 * s + 8 * hh); }
                u32x2 zv8[2][4];
#pragma unroll
                for (int dt = 0; dt < 2; ++dt)
#pragma unroll
                    for (int i4 = 0; i4 < 4; ++i4) zv8[dt][i4] = *(const u32x2*)(U + (size_t)qtok * UP + C_ZB + hq * 64 + 32 * dt + 8 * i4 + 4 * hh);
                float m = snk, l = hh == 0 ? 1.0f : 0.0f;
                f32x16 O[2];
#pragma unroll
                for (int i = 0; i < 16; ++i) { O[0][i] = 0.f; O[1][i] = 0.f; }
                const int sft = (-r) & 3;
                const unsigned tbase = SW_TB + hl * SW_TBH + sft * (SW_TBN * 4) + 4 * (32 + 4 * hh - r - sft);
                const unsigned kb0 = SW_K + 128u * r + 16u * (hh ^ ((r >> 1) & 7));
                const int q4 = (lane & 15) >> 2, p4 = lane & 3, g1 = (lane >> 4) & 1, xq = (q4 >> 1) & 1;
                const unsigned vb0 = SW_V + 128u * (4 * hh + q4) + 16u * ((4 * xq) | (2 * g1) | (p4 >> 1)) + 8u * (p4 & 1);
#pragma unroll 1
                for (int grp = 0; grp < 3; ++grp) {
                    f32x16 S[3];
#pragma unroll
                    for (int k3 = 0; k3 < 3; ++k3) {
                        const int kk = 3 * grp + k3, kt = st + kk, blk = kt >> 2;
                        const bool valid = !((blk == 0 && first) || (blk == 2 && last));
                        const unsigned rowb = 128u * (128u * ((unsigned)(qb - 1 + blk) & 3u) + 32u * (kt & 3));
                        if (valid) {
#pragma unroll
                            for (int i = 0; i < 16; ++i) S[k3][i] = 0.f;
#pragma unroll
                            for (int s = 0; s < 4; ++s) { const bf16x8 Kf = *(const LAS bf16x8*)(lds + (kb0 ^ (32u * s)) + rowb); S[k3] = MFMA32(Kf, Qf[s], S[k3]); }
#pragma unroll
                            for (int i4 = 0; i4 < 4; ++i4) { const f32x4 bv = *(const LAS f32x4*)(lds + tbase + 4 * (32 * kk + 8 * i4));
#pragma unroll
                                for (int j = 0; j < 4; ++j) S[k3][4 * i4 + j] += bv[j]; }
                        } else {
#pragma unroll
                            for (int i = 0; i < 16; ++i) S[k3][i] = SW_NEG;
                        }
                    }
                    float mx4[4] = {SW_NEG, SW_NEG, SW_NEG, SW_NEG};
#pragma unroll
                    for (int k3 = 0; k3 < 3; ++k3)
#pragma unroll
                        for (int i = 0; i < 16; ++i) mx4[i & 3] = fmaxf(mx4[i & 3], S[k3][i]);
                    float mx = fmaxf(fmaxf(mx4[0], mx4[1]), fmaxf(mx4[2], mx4[3]));
                    mx = fmaxf(mx, __shfl_xor(mx, 32));
                    const float mn = fmaxf(m, mx), alpha = fexp(m - mn);
                    m = mn; l *= alpha;
#pragma unroll
                    for (int i = 0; i < 16; ++i) { O[0][i] *= alpha; O[1][i] *= alpha; }
                    bf16x8 Pf[3][2];
                    float l4[4] = {0.f, 0.f, 0.f, 0.f};
#pragma unroll
                    for (int k3 = 0; k3 < 3; ++k3) {
#pragma unroll
                        for (int i = 0; i < 16; ++i) { const float pv = fexp(S[k3][i] - m); S[k3][i] = pv; l4[i & 3] += pv; }
#pragma unroll
                        for (int s2 = 0; s2 < 2; ++s2) {
                            u32x4 pw;
#pragma unroll
                            for (int j = 0; j < 4; ++j) pw[j] = pk2(S[k3][8 * s2 + 2 * j], S[k3][8 * s2 + 2 * j + 1]);
                            Pf[k3][s2] = __builtin_bit_cast(bf16x8, pw);
                        }
                    }
                    l += (l4[0] + l4[1]) + (l4[2] + l4[3]);
#pragma unroll
                    for (int k3 = 0; k3 < 3; ++k3) {
                        const int kt = st + 3 * grp + k3, blk = kt >> 2;
                        const unsigned rowb = 128u * (128u * ((unsigned)(qb - 1 + blk) & 3u) + 32u * (kt & 3));
#pragma unroll
                        for (int s2 = 0; s2 < 2; ++s2)
#pragma unroll
                            for (int dt = 0; dt < 2; ++dt) {
                                const unsigned va = (vb0 ^ (64u * dt)) + rowb + 2048u * s2;
                                const bf16x8 Vf = tr_read8(lds, va, va + 1024u);
                                O[dt] = MFMA32(Vf, Pf[k3][s2], O[dt]);
                            }
                    }
                }
                l += __shfl_xor(l, 32);
                const float inv = __builtin_amdgcn_rcpf(l);
#pragma unroll
                for (int dt = 0; dt < 2; ++dt)
#pragma unroll
                    for (int i4 = 0; i4 < 4; ++i4) {
                        const int d0 = 32 * dt + 8 * i4 + 4 * hh;
                        const u32x2 zv = zv8[dt][i4];
                        const float z0 = __uint_as_float(zv.x << 16), z1 = __uint_as_float(zv.x & 0xffff0000u), z2 = __uint_as_float(zv.y << 16), z3 = __uint_as_float(zv.y & 0xffff0000u);
                        u32x2 yw; yw.x = pk2(O[dt][4 * i4] * inv * silu(z0), O[dt][4 * i4 + 1] * inv * silu(z1)); yw.y = pk2(O[dt][4 * i4 + 2] * inv * silu(z2), O[dt][4 * i4 + 3] * inv * silu(z3));
                        *(u32x2*)(ymix + (size_t)qtok * DM + 512 + hq * 64 + d0) = yw;
                    }
            }
            if (qi < 2) swa_store_block(lds, qb + 2, tid, nk, nv);
            __syncthreads();
        }
    }
}
__device__ __forceinline__ void phase_convfix(const Args& a) {
    bf16_t* G = (bf16_t*)(a.ws + WS_XB); const float* Pb = (const float*)(a.ws + WS_PB); const float* Sb = (const float*)(a.ws + WS_SB);
    for (int idx = blockIdx.x * NTHR + tid_now(); idx < (NTOK / 64 - 1) * 256; idx += gridDim.x * NTHR) {
        const int k = idx / 256 + 1, c = (idx & 255) * 4, row = 64 * k; int s0, L; seq_of(row, s0, L);
        if (row == s0) continue;
        const f32x4 pl = *(const f32x4*)(Pb + (size_t)((k - 1) * 2 + 1) * 1024 + c), sl = *(const f32x4*)(Sb + (size_t)((k - 1) * 2 + 1) * 1024 + c);
        const f32x4 pf = *(const f32x4*)(Pb + (size_t)(k * 2) * 1024 + c), sf = *(const f32x4*)(Sb + (size_t)(k * 2) * 1024 + c);
        const f32x4 c0 = *(const f32x4*)(a.cw + c), c2 = *(const f32x4*)(a.cw + 2048 + c);
        u32x2* gl = (u32x2*)(G + (size_t)(row - 1) * DM + c); u32x2* gf = (u32x2*)(G + (size_t)row * DM + c);
        const u32x2 a0 = *gl, a1 = *gf;
        const f32x4 dl = sl * c2 * pf, df = sf * c0 * pl;
        u32x2 o0, o1;
        o0.x = pk2(__uint_as_float(a0.x << 16) + dl[0], __uint_as_float(a0.x & 0xffff0000u) + dl[1]); o0.y = pk2(__uint_as_float(a0.y << 16) + dl[2], __uint_as_float(a0.y & 0xffff0000u) + dl[3]);
        o1.x = pk2(__uint_as_float(a1.x << 16) + df[0], __uint_as_float(a1.x & 0xffff0000u) + df[1]); o1.y = pk2(__uint_as_float(a1.y << 16) + df[2], __uint_as_float(a1.y & 0xffff0000u) + df[3]);
        *gl = o0; *gf = o1;
    }
}
__global__ void __launch_bounds__(NTHR, 2) mega(Args a) {
    LAS unsigned char* lds = (LAS unsigned char*)lds_raw;
    volatile LAS unsigned* MISC = (volatile LAS unsigned*)(lds + MISC_OFF);
    if (threadIdx.x < 32) MISC[threadIdx.x] = 0u;
    if ((threadIdx.x & 63) == 0) ((volatile LAS unsigned*)(lds + SLOT_OFF))[hw_slot()] = threadIdx.x >> 6;
    __syncthreads();
    unsigned char* ws = a.ws; float* out = a.out;
    XcdBarrier bar = xcd_barrier_post((unsigned*)(ws + WS_CTL) + 4096, MISC + 8);
    bf16_t* W1t = (bf16_t*)(ws + WS_W1T); bf16_t* W2t = (bf16_t*)(ws + WS_W2T); bf16_t* W3t = (bf16_t*)(ws + WS_W3T); bf16_t* W4t = (bf16_t*)(ws + WS_W4T);
    bf16_t* xb = (bf16_t*)(ws + WS_XB); bf16_t* ymix = (bf16_t*)((unsigned char*)out + 96 * MiB); bf16_t* G = xb; bf16_t* U = (bf16_t*)(ws + WS_U);
    bf16_t* x1b = (bf16_t*)(ws + WS_X1B); bf16_t* P = (bf16_t*)(ws + WS_P); bf16_t* Sg = (bf16_t*)(ws + WS_S);
    f32x2* stat1 = (f32x2*)(ws + WS_STAT1); f32x2* stat2 = (f32x2*)(ws + WS_STAT2); f32x2* mr1 = (f32x2*)(ws + WS_MR1);

    phase_convert(a, lds);
    xcd_barrier(bar);
    { pg8::Gemm g{xb, W1t, NTOK, C_GD, DM, 0}; pg8::StaticOrder S; S.init(NTOK, C_GD, gridDim.x, blockIdx.x); EpiU E{U}; pg8::gemm_phase<EpiU, pg8::StaticOrder>(lds, g, S, E); }
    xcd_barrier(bar);
    phase_gla_pass1(a, lds);
    xcd_barrier(bar);
    phase_gla_pass2(a);
    phase_swa(a, lds);
    xcd_barrier(bar);
    phase_gla_pass3(a, lds);
    xcd_barrier(bar);
    { pg8::Gemm g{ymix, W2t, NTOK, DM, DM, 0}; pg8::StaticOrder S; S.init(NTOK, DM, gridDim.x, blockIdx.x);
      EpiLN<0> E{ws, nullptr, a.lng, a.lnb}; pg8::gemm_phase<EpiLN<0>, pg8::StaticOrder>(lds, g, S, E); }
    xcd_barrier(bar);
    { pg8::Gemm g{x1b, W3t, NTOK, 4096, DM, 0}; pg8::StaticOrder S; S.init(NTOK, 4096, gridDim.x, blockIdx.x); EpiG E{ws, a.cw}; pg8::gemm_phase<EpiG, pg8::StaticOrder>(lds, g, S, E); }
    xcd_barrier(bar);
    phase_convfix(a);
    xcd_barrier(bar);
    { pg8::Gemm g{G, W4t, NTOK, DM, DM, 0}; pg8::StaticOrder S; S.init(NTOK, DM, gridDim.x, blockIdx.x);
      EpiLN<1> E{ws, out, a.lng + DM, a.lnb + DM}; pg8::gemm_phase<EpiLN<1>, pg8::StaticOrder>(lds, g, S, E); }
}

extern "C" void kernel_launch(void* const* d_in, const int* in_sizes, int n_in, void* d_out, int out_size, void* d_ws, size_t ws_size, hipStream_t stream) {
    static int grid = 0;
    if (grid == 0) {
        if (n_in != 16 || out_size != NTOK * DM || ws_size < WS_END) { fprintf(stderr, "kernel_launch: unexpected shapes (n_in %d out %d ws %zu)\n", n_in, out_size, ws_size); grid = -1; return; }
        int dev = 0, cus = 0, per_cu = 0;
        if (hipGetDevice(&dev) != hipSuccess || hipDeviceGetAttribute(&cus, hipDeviceAttributeMultiprocessorCount, dev) != hipSuccess) { grid = -1; return; }
        if (hipFuncSetAttribute((const void*)mega, hipFuncAttributeMaxDynamicSharedMemorySize, LDS_BYTES) != hipSuccess) { fprintf(stderr, "kernel_launch: hipFuncSetAttribute failed\n"); grid = -1; return; }
        if (hipOccupancyMaxActiveBlocksPerMultiprocessor(&per_cu, (const void*)mega, NTHR, LDS_BYTES) != hipSuccess || per_cu < 1) { fprintf(stderr, "kernel_launch: occupancy query says %d blocks per CU\n", per_cu); (void)hipGetLastError(); grid = -1; return; }
        grid = cus;
    }
    if (grid < 0) return;
    (void)hipMemsetAsync((char*)d_ws + WS_CTL, 0, 262144, stream);
    Args a{};
    a.xp = (const float*)d_in[0]; a.xs = (const float*)d_in[1]; a.w_in_even = (const float*)d_in[2]; a.wuf = (const float*)d_in[3]; a.bfw = (const float*)d_in[4];
    a.wub = (const float*)d_in[5]; a.bbw = (const float*)d_in[6]; a.ng = (const float*)d_in[7]; a.sink = (const float*)d_in[8]; a.relb = (const float*)d_in[9];
    a.w_out_even = (const float*)d_in[10]; a.w_in_odd = (const float*)d_in[11]; a.cw = (const float*)d_in[12]; a.w_out_odd = (const float*)d_in[13];
    a.lng = (const float*)d_in[14]; a.lnb = (const float*)d_in[15]; a.out = (float*)d_out; a.ws = (unsigned char*)d_ws;
    hipLaunchKernelGGL(mega, dim3(grid), dim3(NTHR), LDS_BYTES, stream, a);
}
```

```cpp
#include <hip/hip_runtime.h>
#include <cstdio>

typedef unsigned short bf16_t;
typedef short bf16x8 __attribute__((ext_vector_type(8)));
typedef float f32x4 __attribute__((ext_vector_type(4)));
typedef float f32x2 __attribute__((ext_vector_type(2)));
typedef unsigned u32x4 __attribute__((ext_vector_type(4)));
typedef unsigned u32x2 __attribute__((ext_vector_type(2)));
#define LAS __attribute__((address_space(3)))
#define MFMA16(a, b, c) __builtin_amdgcn_mfma_f32_16x16x32_bf16((a), (b), (c), 0, 0, 0)
extern __shared__ __attribute__((aligned(16))) unsigned char lds_raw[];
constexpr int SLOT_OFF = 163840 - 1024;
__device__ __forceinline__ unsigned hw_slot() { return (unsigned)__builtin_amdgcn_s_getreg((5 << 11) | 4) & 63u; }
__device__ __forceinline__ int tid_now() {
    const int wid = __builtin_amdgcn_readfirstlane((int)((volatile LAS unsigned*)((LAS unsigned char*)lds_raw + SLOT_OFF))[hw_slot()]);
    return wid * 64 + (int)__lane_id();
}

constexpr int DM = 1024, NTOK = 49152, NPROMPT = 32768, LP = 16384, LS = 4096;
constexpr int UP = 3584;
constexpr int C_QA = 0, C_KA = 512, C_VA = 1024, C_ZA = 1536, C_QB = 2048, C_KB = 2560, C_VB = 2688, C_ZB = 2816, C_GD = 3328;
constexpr int EVEN_IN = 3360, ODD_IN = 4096;
constexpr float DN_ALPHA = 1.41421356237309515f;
constexpr float LN_EPS = 1e-5f, NORM_EPS = 1e-6f;

constexpr size_t MiB = 1u << 20;
constexpr size_t WS_CTL = 0, WS_W1T = 1 * MiB, WS_W2T = 8 * MiB, WS_W3T = 10 * MiB, WS_W4T = 18 * MiB, WS_STAT1 = 20 * MiB, WS_MR1 = 26 * MiB, WS_DEC = 27 * MiB, WS_GATE = 27 * MiB + 768 * 1024,
                 WS_XB = 28 * MiB  , WS_U = 124 * MiB, WS_ST = 460 * MiB, WS_END = 508 * MiB;
constexpr size_t WS_X1B = WS_U, WS_P = WS_U + 96 * MiB, WS_S = WS_U + 192 * MiB, WS_STAT2 = WS_U + 288 * MiB, WS_PB = WS_U + 296 * MiB, WS_SB = WS_U + 304 * MiB;

__device__ __forceinline__ float bf2f(bf16_t b) { return __uint_as_float(((unsigned)b) << 16); }
typedef __bf16 nbf16x2 __attribute__((ext_vector_type(2)));
__device__ __forceinline__ bf16_t f2bf(float f) { return __builtin_bit_cast(bf16_t, (__bf16)f); }
__device__ __forceinline__ unsigned pk2(float lo, float hi) { return __builtin_bit_cast(unsigned, __builtin_convertvector((f32x2){lo, hi}, nbf16x2)); }
__device__ __forceinline__ float fexp2(float x) { return __builtin_amdgcn_exp2f(x); }
__device__ __forceinline__ float fexp(float x) { return __builtin_amdgcn_exp2f(x * 1.4426950408889634f); }
__device__ __forceinline__ float flog2(float x) { return __builtin_amdgcn_logf(x); }
__device__ __forceinline__ float silu(float x) { return x * __builtin_amdgcn_rcpf(1.0f + fexp(-x)); }
__device__ __forceinline__ float wave_sum(float v) {
#pragma unroll
    for (int o = 1; o < 64; o <<= 1) v += __shfl_xor(v, o);
    return v;
}
__device__ __forceinline__ float wave_max(float v) {
#pragma unroll
    for (int o = 1; o < 64; o <<= 1) v = fmaxf(v, __shfl_xor(v, o));
    return v;
}
__device__ __forceinline__ void seq_of(int row, int& s0, int& L) {
    if (row < NPROMPT) { L = LP; s0 = row & ~(LP - 1); } else { L = LS; s0 = NPROMPT + ((row - NPROMPT) & ~(LS - 1)); }
}

namespace pg8 {
constexpr int BM = 256, BK = 64, HALF = 128, HTB = HALF * BK * 2, STAGE_BYTES = 8 * HTB, NXCD = 8, WGM = 8;
__host__ __device__ __forceinline__ int lds_byte(int r, int c) { const int st = (r >> 4) * 2 + (c >> 5), rr = r & 15, cc = c & 31, ob = rr * 64 + cc * 2; return st * 1024 + (ob ^ (((ob >> 9) & 1) << 5)); }
__host__ __device__ __forceinline__ void stage_rc(int b, int& R, int& C) { const int st = b / 1024, sb = b % 1024, swz = sb ^ (((sb >> 9) & 1) << 5); R = (st >> 1) * 16 + swz / 64; C = (st & 1) * 32 + (swz % 64) / 2; }
__host__ __device__ __forceinline__ int perm32(int rho) { const int n = rho >> 4, i = rho & 15; return 8 * (i >> 2) + 4 * n + (i & 3); }
struct Unit { int pm, pn; };
struct Gemm { const bf16_t* A; const bf16_t* Bt; int M, N, K, pad; };
struct StaticOrder {
    int nM, nN, nwg, G, c;
    __host__ __device__ void init(int M, int N, int G_, int c_) { nM = M / BM; nN = N / BM; nwg = nM * nN; G = G_; c = c_; }
    __host__ __device__ bool next(int i, Unit& u) const {
        const long L = (long)i * G + c; if (L >= nwg) return false;
        int wgid = (int)L; { const int q = nwg / NXCD, r = nwg % NXCD, xcd = wgid % NXCD, off = wgid / NXCD; wgid = (xcd < r ? xcd * (q + 1) : r * (q + 1) + (xcd - r) * q) + off; }
        const int nig = WGM * nN, gid = wgid / nig, fm = gid * WGM, gsz = (nM - fm) < WGM ? (nM - fm) : WGM;
        u.pm = fm + ((wgid % nig) % gsz); u.pn = (wgid % nig) / gsz; return true;
    }
    __device__ __forceinline__ void a_ready(const Unit&) const {}
    __device__ __forceinline__ void done(const Unit&) const {}
};

template <class Epi, class Sched>
__device__ __forceinline__ void gemm_phase(LAS unsigned char* lds, const Gemm g, const Sched& S, const Epi& E) {
    int tid = tid_now(); asm volatile("" : "+v"(tid));
    const int wid = __builtin_amdgcn_readfirstlane(tid >> 6), lane = tid & 63, wr = wid >> 2, wc = wid & 3, fr = lane & 15, fq = lane >> 4;
    const int K = g.K, nt = K / BK;
    unsigned voffA[2], voffB[2];
#pragma unroll
    for (int i = 0; i < 2; ++i) { int R, C; stage_rc(tid * 16 + i * 8192, R, C); const int Rb = Epi::PERM ? ((R & ~31) + perm32(R & 31)) : R;
        voffA[i] = (unsigned)(R * K + C) * 2u; voffB[i] = (unsigned)(Rb * K + C) * 2u; }
    const size_t kstep = (size_t)(BK * 2);
    const size_t hstep = (size_t)HALF * K * 2;
    const size_t tstep = 2 * hstep;
    const unsigned ldsw = (unsigned)wid * 1024u;
    const int aoff = lds_byte(wr * 64 + fr, fq * 8), boff = lds_byte(wc * 32 + fr, fq * 8);
#define PG8_SA(b, h) (((b) * 2 + (h)) * HTB)
#define PG8_SB(b, h) ((4 + (b) * 2 + (h)) * HTB)
#define PG8_STAGE(bufoff, gbase, voff) do { _Pragma("unroll") for (int _i = 0; _i < 2; ++_i) \
        __builtin_amdgcn_global_load_lds((const unsigned*)((const char*)(gbase) + (voff)[_i]), (LAS unsigned*)(lds + (bufoff) + ldsw + _i * 8192), 16, 0, 0); } while (0)
#define PG8_LDA(dst, b, h) do { _Pragma("unroll") for (int m = 0; m < 4; ++m) _Pragma("unroll") for (int k = 0; k < 2; ++k) dst[m][k] = *(const LAS bf16x8*)(lds + PG8_SA(b, h) + aoff + m * 2048 + k * 1024); } while (0)
#define PG8_LDB(dst, b, h) do { _Pragma("unroll") for (int n = 0; n < 2; ++n) _Pragma("unroll") for (int k = 0; k < 2; ++k) dst[n][k] = *(const LAS bf16x8*)(lds + PG8_SB(b, h) + boff + n * 2048 + k * 1024); } while (0)
#define PG8_MMA(ai, bj, At, Bt) do { __builtin_amdgcn_s_setprio(1); _Pragma("unroll") for (int m = 0; m < 4; ++m) _Pragma("unroll") for (int n = 0; n < 2; ++n) _Pragma("unroll") for (int k = 0; k < 2; ++k) \
        acc[ai][bj][m][n] = __builtin_amdgcn_mfma_f32_16x16x32_bf16(Bt[n][k], At[m][k], acc[ai][bj][m][n], 0, 0, 0); __builtin_amdgcn_s_setprio(0); } while (0)
#define PG8_WAIT_V(n) asm volatile("s_waitcnt vmcnt(" #n ")" ::: "memory")
#define PG8_WAIT_L(n) asm volatile("s_waitcnt lgkmcnt(" #n ")" ::: "memory")
#define PG8_BAR __builtin_amdgcn_s_barrier()
#define PG8_SCHED __builtin_amdgcn_sched_barrier(0)
    Unit cur, nxt; int ui = 0;
    if (!S.next(0, cur)) return;
    f32x4 acc[2][2][4][2];
#pragma unroll
    for (int a = 0; a < 2; ++a)
#pragma unroll
        for (int b = 0; b < 2; ++b)
#pragma unroll
            for (int m = 0; m < 4; ++m)
#pragma unroll
                for (int n = 0; n < 2; ++n) acc[a][b][m][n] = (f32x4){0.f, 0.f, 0.f, 0.f};
    bf16x8 At[4][2], B0[2][2], B1[2][2];
    const char* cA = (const char*)g.A + (size_t)cur.pm * tstep; const char* cB = (const char*)g.Bt + (size_t)cur.pn * tstep;
    S.a_ready(cur);
    PG8_STAGE(PG8_SB(0, 0), cB, voffB); PG8_STAGE(PG8_SA(0, 0), cA, voffA); PG8_STAGE(PG8_SB(0, 1), cB + hstep, voffB); PG8_STAGE(PG8_SA(0, 1), cA + hstep, voffA);
    if (wr == 1) PG8_BAR;
    PG8_WAIT_V(4); PG8_BAR;
    PG8_STAGE(PG8_SB(1, 0), cB + kstep, voffB); PG8_STAGE(PG8_SA(1, 0), cA + kstep, voffA); PG8_STAGE(PG8_SB(1, 1), cB + hstep + kstep, voffB);
    PG8_WAIT_V(6); PG8_BAR;
    for (;;) {
        const bool has_next = S.next(ui + 1, nxt);
        const char* nA = has_next ? (const char*)g.A + (size_t)nxt.pm * tstep : cA; const char* nB = has_next ? (const char*)g.Bt + (size_t)nxt.pn * tstep : cB;
        for (int t = 0; t < nt; t += 2) {
            const bool last = (t == nt - 2);
            const char* a1 = cA + (size_t)(t + 1) * kstep;
            const char* a2 = last ? nA : cA + (size_t)(t + 2) * kstep; const char* b2 = last ? nB : cB + (size_t)(t + 2) * kstep;
            const char* a3 = a2 + kstep; const char* b3 = b2 + kstep;
            if (last && has_next) S.a_ready(nxt);
            PG8_LDB(B0, 0, 0); PG8_SCHED; PG8_LDA(At, 0, 0); PG8_STAGE(PG8_SA(1, 1), a1 + hstep, voffA);
            PG8_WAIT_L(8); PG8_BAR; PG8_WAIT_L(0); PG8_MMA(0, 0, At, B0); PG8_BAR; PG8_SCHED;
            PG8_LDB(B1, 0, 1); PG8_STAGE(PG8_SB(0, 0), b2, voffB);
            PG8_BAR; PG8_WAIT_L(0); PG8_MMA(0, 1, At, B1); PG8_BAR;
            PG8_LDA(At, 0, 1); PG8_STAGE(PG8_SA(0, 0), a2, voffA);
            PG8_BAR; PG8_WAIT_L(0); PG8_MMA(1, 0, At, B0); PG8_BAR; PG8_SCHED;
            PG8_STAGE(PG8_SB(0, 1), b2 + hstep, voffB);
            PG8_WAIT_V(6); PG8_BAR; PG8_MMA(1, 1, At, B1); PG8_BAR;
            PG8_LDB(B0, 1, 0); PG8_SCHED; PG8_LDA(At, 1, 0); PG8_STAGE(PG8_SA(0, 1), a2 + hstep, voffA);
            PG8_WAIT_L(8); PG8_BAR; PG8_WAIT_L(0); PG8_MMA(0, 0, At, B0); PG8_BAR; PG8_SCHED;
            PG8_LDB(B1, 1, 1); PG8_STAGE(PG8_SB(1, 0), b3, voffB);
            PG8_BAR; PG8_WAIT_L(0); PG8_MMA(0, 1, At, B1); PG8_BAR;
            PG8_LDA(At, 1, 1); PG8_STAGE(PG8_SA(1, 0), a3, voffA);
            PG8_BAR; PG8_WAIT_L(0); PG8_MMA(1, 0, At, B0); PG8_BAR; PG8_SCHED;
            PG8_STAGE(PG8_SB(1, 1), b3 + hstep, voffB);
            PG8_WAIT_V(6); PG8_BAR; PG8_MMA(1, 1, At, B1); PG8_BAR;
        }
        if constexpr (Epi::REALIGN) { if (wr == 0) PG8_BAR; }
        E(acc, cur, wr, wc, fr, fq); S.done(cur);
        if constexpr (Epi::REALIGN) { if (wr == 1) PG8_BAR; }
        if (!has_next) break;
#pragma unroll
        for (int a = 0; a < 2; ++a)
#pragma unroll
            for (int b = 0; b < 2; ++b)
#pragma unroll
                for (int m = 0; m < 4; ++m)
#pragma unroll
                    for (int n = 0; n < 2; ++n) acc[a][b][m][n] = (f32x4){0.f, 0.f, 0.f, 0.f};
        cur = nxt; cA = nA; cB = nB; ++ui;
    }
    PG8_WAIT_V(0);
    if (wr == 0) PG8_BAR;
    PG8_BAR;
#undef PG8_SA
#undef PG8_SB
#undef PG8_STAGE
#undef PG8_LDA
#undef PG8_LDB
#undef PG8_MMA
#undef PG8_WAIT_V
#undef PG8_WAIT_L
#undef PG8_BAR
#undef PG8_SCHED
}
}

struct EpiU {
    static constexpr bool PERM = true, AFTER_DRAIN = false, REALIGN = false;
    bf16_t* O;
    __device__ __forceinline__ void operator()(const f32x4 (&acc)[2][2][4][2], const pg8::Unit& u, int wr, int wc, int fr, int fq) const {
        const int row0 = u.pm * 256 + wr * 64 + fr, col0 = u.pn * 256 + wc * 32 + 8 * fq;
#pragma unroll
        for (int ai = 0; ai < 2; ++ai)
#pragma unroll
            for (int m = 0; m < 4; ++m) { bf16_t* rowp = O + (size_t)(row0 + ai * 128 + m * 16) * UP + col0;
#pragma unroll
                for (int bj = 0; bj < 2; ++bj) { const f32x4 v0 = acc[ai][bj][m][0], v1 = acc[ai][bj][m][1];
                    u32x4 w; w.x = pk2(v0[0], v0[1]); w.y = pk2(v0[2], v0[3]); w.z = pk2(v1[0], v1[1]); w.w = pk2(v1[2], v1[3]);
                    *(u32x4*)(rowp + bj * 128) = w; } }
    }
};
template <int LAYER> struct EpiY {
    static constexpr bool PERM = false, AFTER_DRAIN = false, REALIGN = false;
    const float* xp; const float* xs; float* Y; f32x2* stat; const f32x2* mr; const float* lg; const float* lb;
    __device__ __forceinline__ void operator()(const f32x4 (&acc)[2][2][4][2], const pg8::Unit& u, int wr, int wc, int fr, int fq) const {
        const int col0 = u.pn * 256 + wc * 32 + 4 * fq;
        f32x4 gv[2][2], bv[2][2];
        if (LAYER == 1) {
#pragma unroll
            for (int bj = 0; bj < 2; ++bj)
#pragma unroll
                for (int n = 0; n < 2; ++n) { gv[bj][n] = *(const f32x4*)(lg + col0 + bj * 128 + n * 16); bv[bj][n] = *(const f32x4*)(lb + col0 + bj * 128 + n * 16); }
        }
#pragma unroll
        for (int ai = 0; ai < 2; ++ai)
#pragma unroll
            for (int m = 0; m < 4; ++m) {
                const int row = u.pm * 256 + ai * 128 + wr * 64 + m * 16 + fr;
                const float* rp; f32x2 mrv = (f32x2){0.f, 1.f};
                if (LAYER == 0) rp = (row < NPROMPT) ? xp + (size_t)row * DM : xs + (size_t)(row - NPROMPT) * DM;
                else { rp = Y + (size_t)row * DM; mrv = mr[row]; }
                float* yp = Y + (size_t)row * DM;
                float s = 0.f, q = 0.f;
#pragma unroll
                for (int bj = 0; bj < 2; ++bj)
#pragma unroll
                    for (int n = 0; n < 2; ++n) {
                        const int c = col0 + bj * 128 + n * 16;
                        f32x4 r = *(const f32x4*)(rp + c);
                        if (LAYER == 1) r = (r - mrv.x) * mrv.y * gv[bj][n] + bv[bj][n];
                        const f32x4 y = r * DN_ALPHA + acc[ai][bj][m][n];
                        *(f32x4*)(yp + c) = y;
                        s += (y[0] + y[1]) + (y[2] + y[3]); q += (y[0] * y[0] + y[1] * y[1]) + (y[2] * y[2] + y[3] * y[3]);
                    }
                s += __shfl_xor(s, 16); s += __shfl_xor(s, 32); q += __shfl_xor(q, 16); q += __shfl_xor(q, 32);
                if (fq == 0) stat[(size_t)row * 16 + u.pn * 4 + wc] = (f32x2){s, q};
            }
    }
};
#define RLX_AGENT __ATOMIC_RELAXED, __HIP_MEMORY_SCOPE_AGENT
template <int LAYER> struct EpiLN {
    static constexpr bool PERM = true, AFTER_DRAIN = false, REALIGN = true;
    unsigned char* ws; float* Of; const float* lg; const float* lb;
    __device__ __forceinline__ void operator()(f32x4 (&acc)[2][2][4][2], const pg8::Unit& u, int wr, int wc, int fr, int fq) const {
        unsigned char* w2 = ws; asm volatile("" : "+s"(w2));
        const bf16_t* R = (const bf16_t*)(w2 + (LAYER == 0 ? WS_XB : WS_X1B)); bf16_t* Ob = (bf16_t*)(w2 + WS_X1B);
        unsigned long long* xbuf = (unsigned long long*)(w2 + (LAYER == 0 ? WS_STAT1 : WS_STAT2)); unsigned* cnt = (unsigned*)(w2 + WS_CTL) + 16384 + LAYER * 192 * 64;
        const int col0 = u.pn * 256 + wc * 32 + 8 * fq, rowb = u.pm * 256 + wr * 64 + fr;
        float ps[2][4], pq[2][4];
#pragma unroll
        for (int ai = 0; ai < 2; ++ai)
#pragma unroll
            for (int m = 0; m < 4; ++m) {
                const bf16_t* rp = R + (size_t)(rowb + ai * 128 + m * 16) * DM + col0;
                float s = 0.f, q = 0.f;
#pragma unroll
                for (int bj = 0; bj < 2; ++bj) {
                    const u32x4 rw = *(const u32x4*)(rp + bj * 128);
                    f32x4 r0 = (f32x4){__uint_as_float(rw.x << 16), __uint_as_float(rw.x & 0xffff0000u), __uint_as_float(rw.y << 16), __uint_as_float(rw.y & 0xffff0000u)};
                    f32x4 r1 = (f32x4){__uint_as_float(rw.z << 16), __uint_as_float(rw.z & 0xffff0000u), __uint_as_float(rw.w << 16), __uint_as_float(rw.w & 0xffff0000u)};
                    const f32x4 v0 = r0 * DN_ALPHA + acc[ai][bj][m][0], v1 = r1 * DN_ALPHA + acc[ai][bj][m][1];
                    acc[ai][bj][m][0] = v0; acc[ai][bj][m][1] = v1;
                    s += ((v0[0] + v0[1]) + (v0[2] + v0[3])) + ((v1[0] + v1[1]) + (v1[2] + v1[3]));
                    q += ((v0[0] * v0[0] + v0[1] * v0[1]) + (v0[2] * v0[2] + v0[3] * v0[3])) + ((v1[0] * v1[0] + v1[1] * v1[1]) + (v1[2] * v1[2] + v1[3] * v1[3]));
                }
                s += __shfl_xor(s, 16); s += __shfl_xor(s, 32); q += __shfl_xor(q, 16); q += __shfl_xor(q, 32);
                ps[ai][m] = s; pq[ai][m] = q;
            }
        if (fq == 0) {
#pragma unroll
            for (int ai = 0; ai < 2; ++ai)
#pragma unroll
                for (int m = 0; m < 4; ++m)
                    __hip_atomic_store(xbuf + (size_t)(rowb + ai * 128 + m * 16) * 16 + u.pn * 4 + wc, ((unsigned long long)__float_as_uint(pq[ai][m]) << 32) | __float_as_uint(ps[ai][m]), RLX_AGENT);
        }
        asm volatile("s_waitcnt vmcnt(0)" ::: "memory");
        unsigned* c = cnt + 64 * u.pm;
        if ((tid_now() & 63) == 0) __hip_atomic_fetch_add(c, 1u, RLX_AGENT);
        { unsigned spins = 0;
          while ((unsigned)__builtin_amdgcn_readfirstlane(__hip_atomic_load(c, RLX_AGENT)) < 32u) { __builtin_amdgcn_s_sleep(2); if (++spins > (1u << 16)) break; }
          __builtin_amdgcn_fence(__ATOMIC_ACQUIRE, "agent"); }
#pragma unroll
        for (int ai = 0; ai < 2; ++ai)
#pragma unroll
            for (int m = 0; m < 4; ++m) {
                const unsigned long long* sp = xbuf + (size_t)(rowb + ai * 128 + m * 16) * 16 + 4 * fq;
                float s = 0.f, q = 0.f;
#pragma unroll
                for (int t = 0; t < 4; ++t) { const unsigned long long w8 = __hip_atomic_load(sp + t, RLX_AGENT); s += __uint_as_float((unsigned)w8); q += __uint_as_float((unsigned)(w8 >> 32)); }
                s += __shfl_xor(s, 16); s += __shfl_xor(s, 32); q += __shfl_xor(q, 16); q += __shfl_xor(q, 32);
                const float mean = s * (1.0f / DM), var = q * (1.0f / DM) - mean * mean;
                ps[ai][m] = mean; pq[ai][m] = rsqrtf(fmaxf(var, 0.f) + LN_EPS);
            }
#pragma unroll
        for (int bj = 0; bj < 2; ++bj) {
            const f32x4 g0 = *(const f32x4*)(lg + col0 + bj * 128), g1 = *(const f32x4*)(lg + col0 + bj * 128 + 4), b0 = *(const f32x4*)(lb + col0 + bj * 128), b1 = *(const f32x4*)(lb + col0 + bj * 128 + 4);
#pragma unroll
            for (int ai = 0; ai < 2; ++ai)
#pragma unroll
                for (int m = 0; m < 4; ++m) {
                    const int row = rowb + ai * 128 + m * 16; const float mean = ps[ai][m], rstd = pq[ai][m];
                    const f32x4 o0 = (acc[ai][bj][m][0] - mean) * rstd * g0 + b0, o1 = (acc[ai][bj][m][1] - mean) * rstd * g1 + b1;
                    if (LAYER == 0) { u32x4 w; w.x = pk2(o0[0], o0[1]); w.y = pk2(o0[2], o0[3]); w.z = pk2(o1[0], o1[1]); w.w = pk2(o1[2], o1[3]); *(u32x4*)(Ob + (size_t)row * DM + col0 + bj * 128) = w; }
                    else { float* op = Of + (size_t)row * DM + col0 + bj * 128; __builtin_nontemporal_store(o0, (f32x4*)op); __builtin_nontemporal_store(o1, (f32x4*)(op + 4)); }
                }
        }
    }
};
struct EpiPS {
    static constexpr bool PERM = true, AFTER_DRAIN = false, REALIGN = false;
    bf16_t* P; bf16_t* S;
    __device__ __forceinline__ void operator()(const f32x4 (&acc)[2][2][4][2], const pg8::Unit& u, int wr, int wc, int fr, int fq) const {
        const int row0 = u.pm * 256 + wr * 64 + fr, off = (wc & 1) * 32 + 8 * fq;
        bf16_t* dst = (wc < 2 ? S : P) + u.pn * 64 + off;
#pragma unroll
        for (int ai = 0; ai < 2; ++ai)
#pragma unroll
            for (int m = 0; m < 4; ++m) {
                float o[8];
#pragma unroll
                for (int n = 0; n < 2; ++n)
#pragma unroll
                    for (int j = 0; j < 4; ++j) { const float a = acc[ai][0][m][n][j], b = acc[ai][1][m][n][j];
                        o[4 * n + j] = (wc < 2) ? silu(b) * a : a * b; }
                u32x4 w; w.x = pk2(o[0], o[1]); w.y = pk2(o[2], o[3]); w.z = pk2(o[4], o[5]); w.w = pk2(o[6], o[7]);
                *(u32x4*)(dst + (size_t)(row0 + ai * 128 + m * 16) * DM) = w;
            }
    }
};

template <int CTRL> __device__ __forceinline__ float dpp_f(float x);
struct EpiG {
    static constexpr bool PERM = true, AFTER_DRAIN = false, REALIGN = false;
    unsigned char* ws; const float* cw;
    __device__ __forceinline__ void operator()(const f32x4 (&acc)[2][2][4][2], const pg8::Unit& u, int wr, int wc, int fr, int fq) const {
        unsigned char* w2 = ws; asm volatile("" : "+s"(w2));
        bf16_t* G = (bf16_t*)(w2 + WS_XB); float* Pb = (float*)(w2 + WS_PB); float* Sb = (float*)(w2 + WS_SB);
        const int ch0 = u.pn * 64 + 16 * wc + 4 * fq;
        const f32x4 c0 = *(const f32x4*)(cw + ch0), c1 = *(const f32x4*)(cw + 1024 + ch0), c2 = *(const f32x4*)(cw + 2048 + ch0);
#pragma unroll
        for (int ai = 0; ai < 2; ++ai) {
            f32x4 P[4], S[4];
#pragma unroll
            for (int m = 0; m < 4; ++m)
#pragma unroll
                for (int j = 0; j < 4; ++j) { P[m][j] = acc[ai][0][m][1][j] * acc[ai][1][m][1][j]; S[m][j] = silu(acc[ai][1][m][0][j]) * acc[ai][0][m][0][j]; }
            const int row0 = u.pm * 256 + ai * 128 + wr * 64 + fr;
#pragma unroll
            for (int m = 0; m < 4; ++m) {
                float o[4];
#pragma unroll
                for (int j = 0; j < 4; ++j) {
                    float pr = dpp_f<0x111>(P[m][j]);
                    if (m > 0) { const float t = dpp_f<0x121>(P[m - 1][j]); pr = fr == 0 ? t : pr; }
                    float nx = dpp_f<0x101>(P[m][j]);
                    if (m < 3) { const float t = dpp_f<0x12F>(P[m + 1][j]); nx = fr == 15 ? t : nx; }
                    o[j] = S[m][j] * (c0[j] * pr + c1[j] * P[m][j] + c2[j] * nx);
                }
                u32x2 w; w.x = pk2(o[0], o[1]); w.y = pk2(o[2], o[3]);
                *(u32x2*)(G + (size_t)(row0 + 16 * m) * DM + ch0) = w;
            }
            const int blk = u.pm * 4 + ai * 2 + wr;
            if (fr == 0) { *(f32x4*)(Pb + (size_t)(blk * 2) * 1024 + ch0) = P[0]; *(f32x4*)(Sb + (size_t)(blk * 2) * 1024 + ch0) = S[0]; }
            if (fr == 15) { *(f32x4*)(Pb + (size_t)(blk * 2 + 1) * 1024 + ch0) = P[3]; *(f32x4*)(Sb + (size_t)(blk * 2 + 1) * 1024 + ch0) = S[3]; }
        }
    }
};
#define XB_TMO      128
#define XB_XCNT(j)  (256  + 64 * (j))
#define XB_XSUB(j)  (1280 + 64 * (j))
#define XB_XGEN(j)  (2304 + 64 * (j))
#define XB_TOP      3328
#define XB_TOPGEN   3392
#define XCD_BAR_WORDS 3456
#define XB_SPIN_CAP (1u << 27)
__device__ __forceinline__ unsigned xb_ld(unsigned* p)              { return __hip_atomic_load(p, __ATOMIC_RELAXED, __HIP_MEMORY_SCOPE_AGENT); }
__device__ __forceinline__ unsigned xb_add(unsigned* p, unsigned v) { return __hip_atomic_fetch_add(p, v, __ATOMIC_RELAXED, __HIP_MEMORY_SCOPE_AGENT); }
__device__ __forceinline__ unsigned xb_xcc_id() { return (unsigned)__builtin_amdgcn_s_getreg((3 << 11) | 20) & 0xFu; }
#define XB_SPIN(cond, bar) do { unsigned _sp = 0; while (cond) { __builtin_amdgcn_s_sleep(1); \
    if ((++_sp & 255u) == 0u) { if (xb_ld(&(bar)[XB_TMO])) break; if (_sp > XB_SPIN_CAP) { atomicAdd(&(bar)[XB_TMO], 1u); break; } } } } while (0)
struct XcdBarrier { unsigned* bar; unsigned x; volatile LAS unsigned* st; };
__device__ __forceinline__ XcdBarrier xcd_barrier_post(unsigned* bar, volatile LAS unsigned* st) {
    XcdBarrier b; b.bar = bar; b.x = xb_xcc_id(); b.st = st;
    if (tid_now() == 0) (void)xb_add(&bar[XB_XCNT(b.x)], 1u);
    return b;
}
__device__ __forceinline__ void xcd_barrier_complete(unsigned* bar, unsigned x, unsigned& nloc, unsigned& nx) {
    const unsigned G = gridDim.x * gridDim.y * gridDim.z;
    unsigned sum, cnt, mine, sp = 0u;
    for (;;) {
        sum = 0u; cnt = 0u; mine = 0u;
#pragma unroll
        for (unsigned j = 0; j < 16; ++j) { const unsigned c = xb_ld(&bar[XB_XCNT(j)]); sum += c; cnt += (c > 0u) ? 1u : 0u; mine = (j == x) ? c : mine; }
        if (sum == G) break;
        __builtin_amdgcn_s_sleep(1);
        if ((++sp & 255u) == 0u) { if (xb_ld(&bar[XB_TMO])) break; if (sp > XB_SPIN_CAP) { atomicAdd(&bar[XB_TMO], 1u); break; } }
    }
    nloc = mine > 0u ? mine : 1u; nx = cnt > 0u ? cnt : 1u;
}
__device__ __forceinline__ void xcd_barrier(const XcdBarrier& b) {
    asm volatile("s_waitcnt vmcnt(0)" ::: "memory");
    __syncthreads();
    if (tid_now() == 0) {
        unsigned* bar = b.bar;
        __builtin_amdgcn_s_waitcnt(0);
        unsigned nloc = b.st[0], nx = b.st[1];
        if (nloc == 0u) { xcd_barrier_complete(bar, b.x, nloc, nx); b.st[0] = nloc; b.st[1] = nx; }
        const unsigned old = xb_add(&bar[XB_XSUB(b.x)], 1u);
        const unsigned gen = old / nloc;
        if (old + 1u == (gen + 1u) * nloc) {
            __builtin_amdgcn_fence(__ATOMIC_RELEASE, "agent");
            asm volatile("s_waitcnt vmcnt(0)" ::: "memory");
            const unsigned og = xb_add(&bar[XB_TOP], 1u);
            const unsigned tg = og / nx;
            if (og + 1u == (tg + 1u) * nx) xb_add(&bar[XB_TOPGEN], 1u);
            else XB_SPIN(xb_ld(&bar[XB_TOPGEN]) == tg, bar);
            __builtin_amdgcn_fence(__ATOMIC_ACQUIRE, "agent");
            xb_add(&bar[XB_XGEN(b.x)], 1u);
            asm volatile("s_waitcnt vmcnt(0)" ::: "memory");
        } else {
            XB_SPIN(xb_ld(&bar[XB_XGEN(b.x)]) == gen, bar);
            __builtin_amdgcn_fence(__ATOMIC_ACQUIRE, "agent");
            asm volatile("s_waitcnt vmcnt(0)" ::: "memory");
        }
    }
    __syncthreads();
}

struct Args {
    const float *xp, *xs, *w_in_even, *wuf, *bfw, *wub, *bbw, *ng, *sink, *relb, *w_out_even, *w_in_odd, *cw, *w_out_odd, *lng, *lnb;
    float* out; unsigned char* ws;
};
constexpr int NTHR = 512;
constexpr int LDS_BYTES = 163840, MISC_OFF = 163840 - 512;

template <int MODE> __device__ __forceinline__ int wmap(int n, float& sc) {
    sc = 1.f;
    if (MODE == 0) return n;
    if (MODE == 1) {
        if (n < 512) sc = 0.08838834764831845f;
        if (n >= C_QB && n < C_KB) sc = 0.125f;
        if (n < 2048) return n;
        if (n < C_GD) return n + 32;
        if (n < C_GD + 32) return n - C_GD + 2048;
        return -1;
    }
    const int c = n & 255, bj = (c >> 7) & 1, wc = (c >> 5) & 3, fq = (c >> 3) & 3, nn = (c >> 2) & 1, j = c & 3, q = 2 * bj + nn, ch = (n >> 8) * 64 + 16 * wc + 4 * fq + j;
    const int base = q == 0 ? 0 : (q == 1 ? 1024 : (q == 2 ? 3072 : 2048));
    return base + ch;
}
template <int MODE> __device__ __forceinline__ void wconv_item(const float* __restrict__ W, int Nsrc, bf16_t* __restrict__ Wt, int Ndst, int item, LAS float* tile, int t256) {
    const int nb = item % (Ndst / 64), kb = item / (Ndst / 64), n0 = nb * 64, k0 = kb * 64;
    const int tx = t256 & 63, ty = t256 >> 6;
    float sc; const int src = wmap<MODE>(n0 + tx, sc);
    for (int kk = ty; kk < 64; kk += 4) tile[kk * 65 + tx] = src >= 0 ? W[(size_t)(k0 + kk) * Nsrc + src] * sc : 0.f;
    __syncthreads();
    for (int nn = ty; nn < 64; nn += 4) Wt[(size_t)(n0 + nn) * 1024 + k0 + tx] = f2bf(tile[tx * 65 + nn]);
    __syncthreads();
}
__device__ __forceinline__ void build_gate_tables(const Args& a);
__device__ __forceinline__ void phase_convert(const Args& a, LAS unsigned char* lds) {
    unsigned char* ws = a.ws;
    bf16_t* W1t = (bf16_t*)(ws + WS_W1T); bf16_t* W2t = (bf16_t*)(ws + WS_W2T); bf16_t* W3t = (bf16_t*)(ws + WS_W3T); bf16_t* W4t = (bf16_t*)(ws + WS_W4T);
    const int half = tid_now() >> 8, t256 = tid_now() & 255;
    LAS float* tile = (LAS float*)lds + half * (64 * 65);
    constexpr int I1 = (C_GD / 64) * 16, I2 = 16 * 16, I3 = 64 * 16, I4 = 16 * 16, NIT = I1 + I2 + I3 + I4;
    for (int it0 = blockIdx.x * 2; it0 < NIT; it0 += gridDim.x * 2) {
        int r = it0 + half;
        if (r < I1) wconv_item<1>(a.w_in_even, EVEN_IN, W1t, C_GD, r, tile, t256);
        else if ((r -= I1) < I2) wconv_item<0>(a.w_out_even, 1024, W2t, 1024, r, tile, t256);
        else if ((r -= I2) < I3) wconv_item<2>(a.w_in_odd, ODD_IN, W3t, 4096, r, tile, t256);
        else if ((r -= I3) < I4) wconv_item<0>(a.w_out_odd, 1024, W4t, 1024, r, tile, t256);
        else { __syncthreads(); __syncthreads(); }
    }
    build_gate_tables(a);
    __syncthreads();
    {
        constexpr int WP = 1032, TP = 264;
        LAS bf16_t* wg = (LAS bf16_t*)lds; LAS bf16_t* tile0 = (LAS bf16_t*)(lds + 32 * WP * 2);
        const int tid = tid_now(), lane = tid & 63, w = tid >> 6, n = lane & 15, g = lane >> 4, rb = w & 3, ct = w >> 2;
        for (int e = tid; e < 32 * 1024; e += NTHR) { const int k = e >> 5, c = e & 31; wg[c * WP + k] = f2bf(a.w_in_even[(size_t)k * EVEN_IN + 2048 + c]); }
        bf16_t* xb = (bf16_t*)(ws + WS_XB); bf16_t* U = (bf16_t*)(ws + WS_U);
        f32x4 v[4][2];
        auto slab_load = [&](int it, int sl) {
#pragma unroll
            for (int i = 0; i < 4; ++i) { const int idx = tid + 512 * i, row = it * 64 + (idx >> 5), col = sl * 256 + 8 * (idx & 31);
                const float* src = (row < NPROMPT ? a.xp + (size_t)row * DM : a.xs + (size_t)(row - NPROMPT) * DM) + col;
                v[i][0] = __builtin_nontemporal_load((const f32x4*)src); v[i][1] = __builtin_nontemporal_load((const f32x4*)(src + 4)); } };
        const int ntrip = NTOK / 64;
        if ((int)blockIdx.x < ntrip) slab_load(blockIdx.x, 0);
        int par = 0;
        for (int it = blockIdx.x; it < ntrip; it += gridDim.x) {
            f32x4 acc = (f32x4){0.f, 0.f, 0.f, 0.f};
#pragma unroll 1
            for (int sl = 0; sl < 4; ++sl) {
                LAS bf16_t* tile = tile0 + par * (64 * TP);
#pragma unroll
                for (int i = 0; i < 4; ++i) { const int idx = tid + 512 * i, r64 = idx >> 5, c8 = idx & 31;
                    u32x4 pw; pw.x = pk2(v[i][0][0], v[i][0][1]); pw.y = pk2(v[i][0][2], v[i][0][3]); pw.z = pk2(v[i][1][0], v[i][1][1]); pw.w = pk2(v[i][1][2], v[i][1][3]);
                    *(u32x4*)(xb + (size_t)(it * 64 + r64) * DM + sl * 256 + 8 * c8) = pw;
                    *(LAS u32x4*)(tile + r64 * TP + 8 * c8) = pw; }
                { const int nsl = (sl + 1) & 3, nit = sl < 3 ? it : (it + (int)gridDim.x < ntrip ? it + (int)gridDim.x : it); slab_load(nit, nsl); }
                __syncthreads();
#pragma unroll
                for (int ks = 0; ks < 8; ++ks) {
                    const bf16x8 af = *(const LAS bf16x8*)(tile + (16 * rb + n) * TP + 32 * ks + 8 * g), bfr = *(const LAS bf16x8*)(wg + (16 * ct + n) * WP + sl * 256 + 32 * ks + 8 * g);
                    acc = MFMA16(af, bfr, acc);
                }
                par ^= 1;
            }
#pragma unroll
            for (int r = 0; r < 4; ++r) U[(size_t)(it * 64 + rb * 16 + 4 * g + r) * UP + C_GD + 16 * ct + n] = f2bf(acc[r]);
        }
        __syncthreads();
    }
}

__device__ __forceinline__ void phase_gla_naive(const Args& a, LAS unsigned char* lds, float* OF, float* OB) {
    if (blockIdx.x >= 12) return;
    const bf16_t* U = (const bf16_t*)(a.ws + WS_U);
    const int grp = tid_now() >> 7, tid = tid_now() & 127, b = blockIdx.x * 4 + grp, dir = b & 1, h = (b >> 1) & 3, s = b >> 3;
    LAS float* sq = (LAS float*)lds + grp * (3 * 16 * 128); LAS float* sk = sq + 16 * 128; LAS float* sd = sk + 16 * 128;
    const int L = s < 2 ? LP : LS, start = s < 2 ? s * LP : NPROMPT + (s - 2) * LS;
    const float* wu = dir ? a.wub : a.wuf; const float* bias = dir ? a.bbw : a.bfw; float* O = dir ? OB : OF;
    float wr[16];
#pragma unroll
    for (int r = 0; r < 16; ++r) wr[r] = wu[r * 512 + h * 128 + tid];
    const float bb = bias[h * 128 + tid];
    float S[128];
#pragma unroll
    for (int i = 0; i < 128; ++i) S[i] = 0.f;
    for (int t0 = 0; t0 < L; t0 += 16) {
        for (int tt = 0; tt < 16; ++tt) {
            const int p = t0 + tt, tok = start + (dir ? L - 1 - p : p);
            const bf16_t* ur = U + (size_t)tok * UP;
            float x = bb;
#pragma unroll
            for (int r = 0; r < 16; ++r) x += bf2f(ur[C_GD + dir * 16 + r]) * wr[r];
            const float ls = fminf(x, 0.f) - log1pf(expf(-fabsf(x)));
            sd[tt * 128 + tid] = expf(ls * (1.0f / 16.0f));
            sq[tt * 128 + tid] = bf2f(ur[C_QA + h * 128 + tid]);
            sk[tt * 128 + tid] = bf2f(ur[C_KA + h * 128 + tid]);
        }
        __syncthreads();
        for (int tt = 0; tt < 16; ++tt) {
            const int p = t0 + tt, tok = start + (dir ? L - 1 - p : p);
            const float v = bf2f(U[(size_t)tok * UP + C_VA + h * 128 + tid]);
            float acc = 0.f;
#pragma unroll
            for (int dk = 0; dk < 128; dk += 4) {
                const f32x4 d4 = *(const LAS f32x4*)&sd[tt * 128 + dk], q4 = *(const LAS f32x4*)&sq[tt * 128 + dk], k4 = *(const LAS f32x4*)&sk[tt * 128 + dk];
#pragma unroll
                for (int j = 0; j < 4; ++j) {
                    const float sdec = S[dk + j] * d4[j];
                    const float sn = sdec + k4[j] * v;
                    acc += q4[j] * (dir ? sdec : sn);
                    S[dk + j] = sn;
                }
            }
            O[(size_t)tok * 512 + h * 128 + tid] = acc;
        }
        __syncthreads();
    }
}
__device__ __forceinline__ void phase_gla_combine(const Args& a, const float* OF, const float* OB) {
    const bf16_t* U = (const bf16_t*)(a.ws + WS_U); bf16_t* ymix = (bf16_t*)((unsigned char*)a.out + 96 * MiB);
    const int lane = tid_now() & 63;
    for (int w = blockIdx.x * 8 + (tid_now() >> 6); w < NTOK * 4; w += gridDim.x * 8) {
        const int tok = w >> 2, h = w & 3;
        const size_t o = (size_t)tok * 512 + h * 128 + lane * 2;
        const float a0 = OF[o] + OB[o], a1 = OF[o + 1] + OB[o + 1];
        const float ss = wave_sum(a0 * a0 + a1 * a1);
        const float rstd = rsqrtf(ss * (1.0f / 128.0f) + NORM_EPS);
        const bf16_t* z = U + (size_t)tok * UP + C_ZA + h * 128 + lane * 2;
        const float y0 = a0 * rstd * a.ng[lane * 2] * silu(bf2f(z[0])), y1 = a1 * rstd * a.ng[lane * 2 + 1] * silu(bf2f(z[1]));
        *(unsigned*)(ymix + (size_t)tok * DM + h * 128 + lane * 2) = pk2(y0, y1);
    }
}
__device__ __forceinline__ int t5_bucket(int rel) {
    const int n = rel < 0 ? -rel : rel;
    int b = n < 8 ? n : (n < 12 ? 8 : (n < 16 ? 9 : (n < 23 ? 10 : (n < 32 ? 11 : (n < 46 ? 12 : (n < 64 ? 13 : (n < 91 ? 14 : 15)))))));
    return b + (rel > 0 ? 16 : 0);
}
__device__ __forceinline__ void phase_swa_naive(const Args& a, LAS unsigned char* lds) {
    const bf16_t* U = (const bf16_t*)(a.ws + WS_U); bf16_t* ymix = (bf16_t*)((unsigned char*)a.out + 96 * MiB);
    const int wv = tid_now() >> 6, lane = tid_now() & 63;
    LAS float* sq = (LAS float*)(lds + 65536) + wv * 64; LAS float* sp = (LAS float*)(lds + 65536 + 2048) + wv * 320;
    for (int w = blockIdx.x * 8 + wv; w < NTOK * 8; w += gridDim.x * 8) {
        const int tok = w >> 3, hq = w & 7, kv = hq >> 2;
        int s0, L; seq_of(tok, s0, L); const int i = tok - s0;
        sq[lane] = bf2f(U[(size_t)tok * UP + C_QB + hq * 64 + lane]);
        const float snk = a.sink[hq];
        float sc[5]; float mx = snk;
#pragma unroll
        for (int c = 0; c < 5; ++c) {
            const int jj = c * 64 + lane, j = i - 128 + jj; const bool valid = jj <= 256 && j >= 0 && j < L;
            float d = -INFINITY;
            if (valid) {
                const bf16_t* kr = U + (size_t)(s0 + j) * UP + C_KB + kv * 64; d = 0.f;
#pragma unroll
                for (int e = 0; e < 64; e += 8) { const u32x4 kk = *(const u32x4*)(kr + e);
                    d += sq[e] * __uint_as_float(kk.x << 16) + sq[e + 1] * __uint_as_float(kk.x & 0xffff0000u) + sq[e + 2] * __uint_as_float(kk.y << 16) + sq[e + 3] * __uint_as_float(kk.y & 0xffff0000u)
                       + sq[e + 4] * __uint_as_float(kk.z << 16) + sq[e + 5] * __uint_as_float(kk.z & 0xffff0000u) + sq[e + 6] * __uint_as_float(kk.w << 16) + sq[e + 7] * __uint_as_float(kk.w & 0xffff0000u); }
                d += a.relb[t5_bucket(j - i) * 8 + hq];
            }
            sc[c] = d; mx = fmaxf(mx, d);
        }
        mx = wave_max(mx);
        float den = 0.f;
#pragma unroll
        for (int c = 0; c < 5; ++c) { sc[c] = sc[c] == -INFINITY ? 0.f : __expf(sc[c] - mx); den += sc[c]; }
        den = wave_sum(den) + __expf(snk - mx);
        const float inv = 1.0f / den;
#pragma unroll
        for (int c = 0; c < 5; ++c) sp[c * 64 + lane] = sc[c] * inv;
        float o = 0.f;
        for (int jj = 0; jj <= 256; ++jj) { const int j = i - 128 + jj; if (j >= 0 && j < L) o += sp[jj] * bf2f(U[(size_t)(s0 + j) * UP + C_VB + kv * 64 + lane]); }
        const float z = bf2f(U[(size_t)tok * UP + C_ZB + hq * 64 + lane]);
        ymix[(size_t)tok * DM + 512 + hq * 64 + lane] = f2bf(o * silu(z));
    }
}
template <int FINAL>
__device__ __forceinline__ void phase_ln(float* Y, const f32x2* stat, f32x2* mr, const float* lg, const float* lb, bf16_t* xb) {
    const int lane = tid_now() & 63;
    for (int row = blockIdx.x * 8 + (tid_now() >> 6); row < NTOK; row += gridDim.x * 8) {
        f32x2 p = lane < 16 ? stat[(size_t)row * 16 + lane] : (f32x2){0.f, 0.f};
        const float s = wave_sum(p.x), q = wave_sum(p.y);
        const float mean = s * (1.0f / DM), var = q * (1.0f / DM) - mean * mean, rstd = rsqrtf(fmaxf(var, 0.f) + LN_EPS);
        if (!FINAL && lane == 0) mr[row] = (f32x2){mean, rstd};
#pragma unroll
        for (int j = 0; j < 4; ++j) {
            const int c = j * 256 + lane * 4;
            const f32x4 y = *(const f32x4*)(Y + (size_t)row * DM + c), g = *(const f32x4*)(lg + c), b = *(const f32x4*)(lb + c);
            const f32x4 o = (y - mean) * rstd * g + b;
            if (FINAL) *(f32x4*)(Y + (size_t)row * DM + c) = o;
            else { u32x2 w; w.x = pk2(o[0], o[1]); w.y = pk2(o[2], o[3]); *(u32x2*)(xb + (size_t)row * DM + c) = w; }
        }
    }
}
__device__ __forceinline__ void phase_convgate(const bf16_t* P, const bf16_t* S, const float* cw, bf16_t* G) {
    const size_t n8 = (size_t)NTOK * DM / 8;
    for (size_t i = (size_t)blockIdx.x * NTHR + tid_now(); i < n8; i += (size_t)gridDim.x * NTHR) {
        const int row = (int)(i >> 7), c = (int)(i & 127) * 8; int s0, L; seq_of(row, s0, L);
        const bool hasl = row > s0, hasr = row < s0 + L - 1;
        const u32x4 pm = *(const u32x4*)(P + (size_t)row * DM + c), sv = *(const u32x4*)(S + (size_t)row * DM + c);
        u32x4 pl = (u32x4){0, 0, 0, 0}, pr = (u32x4){0, 0, 0, 0};
        if (hasl) pl = *(const u32x4*)(P + (size_t)(row - 1) * DM + c);
        if (hasr) pr = *(const u32x4*)(P + (size_t)(row + 1) * DM + c);
        float o[8];
#pragma unroll
        for (int j = 0; j < 4; ++j) {
            const unsigned l = pl[j], m = pm[j], r = pr[j], sw = sv[j];
            const int cc = c + 2 * j;
            o[2 * j] = __uint_as_float(sw << 16) * (cw[cc] * __uint_as_float(l << 16) + cw[1024 + cc] * __uint_as_float(m << 16) + cw[2048 + cc] * __uint_as_float(r << 16));
            o[2 * j + 1] = __uint_as_float(sw & 0xffff0000u) * (cw[cc + 1] * __uint_as_float(l & 0xffff0000u) + cw[1024 + cc + 1] * __uint_as_float(m & 0xffff0000u) + cw[2048 + cc + 1] * __uint_as_float(r & 0xffff0000u));
        }
        u32x4 w; w.x = pk2(o[0], o[1]); w.y = pk2(o[2], o[3]); w.z = pk2(o[4], o[5]); w.w = pk2(o[6], o[7]);
        *(u32x4*)(G + (size_t)row * DM + c) = w;
    }
}

typedef short s16x4 __attribute__((ext_vector_type(4)));
constexpr int GL_QT = 0, GL_KT = 16384, GL_VT = 32768, GL_PT = 49152, GL_B = 57344, GL_GD = 90112, GL_TOT = 94208, GL_EBL = 96256  , GL_SSW = 97280, GL_RSTD = 99328;
constexpr int NSEG = NTOK / 256;
__device__ __forceinline__ unsigned offb(unsigned row, unsigned ch) { return 256u * row + 16u * (ch ^ (((row & 3) << 2) | ((row >> 2) & 3))); }
__device__ __forceinline__ unsigned offp(unsigned row, unsigned ch) { return 128u * row + 16u * (ch ^ (row & 7)); }
__device__ __forceinline__ unsigned rr16(unsigned lane, unsigned rb, unsigned s) { return offb((lane & 15) + 16 * rb, 4 * s + (lane >> 4)); }
__device__ __forceinline__ unsigned tr16(unsigned lane, unsigned c, unsigned ks, unsigned t) {
    const unsigned g = lane >> 4, q = (lane & 15) >> 2, p = lane & 3;
    return offb(32 * ks + 8 * g + 4 * t + q, 2 * c + (p >> 1)) + 8 * (p & 1);
}
__device__ __forceinline__ bf16x8 tr_read8(unsigned a0, unsigned a1) {
    s16x4 r0, r1;
    asm volatile("ds_read_b64_tr_b16 %0, %2\n\tds_read_b64_tr_b16 %1, %3\n\ts_waitcnt lgkmcnt(0)" : "=&v"(r0), "=&v"(r1) : "v"(a0), "v"(a1) : "memory");
    return __builtin_shufflevector(r0, r1, 0, 1, 2, 3, 4, 5, 6, 7);
}
__device__ __forceinline__ void unpack8(const u32x4 w, float (&f)[8]) {
#pragma unroll
    for (int j = 0; j < 4; ++j) { f[2 * j] = __uint_as_float(w[j] << 16); f[2 * j + 1] = __uint_as_float(w[j] & 0xffff0000u); }
}

struct GlaPre { u32x4 gd[4]; u32x4 q[2], k[2], v[2]; u32x4 wf; float wb; };
template <int MODE>
__device__ __forceinline__ void gla_prefetch(const Args& a, GlaPre& pre, int tid, int tb, int h, int dir, int stidx) {
    const bf16_t* U = (const bf16_t*)(a.ws + WS_U);
    const int lane = tid & 63, n = lane & 15, g = lane >> 4, w = tid >> 6;
#pragma unroll
    for (int it = 0; it < 4; ++it) { const int row = 16 * it + n, tok = dir ? tb + 63 - row : tb + row; pre.gd[it] = *(const u32x4*)(U + (size_t)tok * UP + C_GD + dir * 16 + 8 * (g & 1)); }
#pragma unroll
    for (int i = 0; i < 2; ++i) {
        const int idx = tid + 512 * i, row = idx >> 4, ch = idx & 15, tok = dir ? tb + 63 - row : tb + row;
        const bf16_t* ur = U + (size_t)tok * UP + h * 128 + ch * 8;
        pre.v[i] = *(const u32x4*)(ur + C_VA); pre.k[i] = *(const u32x4*)(ur + C_KA);
        if (MODE != 0) pre.q[i] = *(const u32x4*)(ur + C_QA);
    }
    pre.wf = ((const u32x4*)(a.ws + WS_GATE))[(dir * 4 + h) * 512 + tid];
    pre.wb = ((const float*)(a.ws + WS_GATE + 65536))[(dir * 4 + h) * 128 + 16 * w + n];
}
__device__ __forceinline__ bf16x8 tr_read8(LAS unsigned char* lds, unsigned a0, unsigned a1) {
    const s16x4 r0 = __builtin_amdgcn_ds_read_tr16_b64_v4i16((LAS s16x4*)(lds + a0)), r1 = __builtin_amdgcn_ds_read_tr16_b64_v4i16((LAS s16x4*)(lds + a1));
    return __builtin_shufflevector(r0, r1, 0, 1, 2, 3, 4, 5, 6, 7);
}
template <int CTRL> __device__ __forceinline__ float dpp_f(float x) { return __int_as_float(__builtin_amdgcn_update_dpp(0, __float_as_int(x), CTRL, 0xf, 0xf, true)); }
constexpr int GL_BP = 132;
template <int MODE>
__device__ __forceinline__ void gla_chunk(const Args& a, LAS unsigned char* lds, const int tb, const int h, const int dir,
                                          f32x4 (&Sacc)[8], float& lam, u32x4* stash, GlaPre& pre, const int ntb, const int nh, const int ndir, const bool first, const int par) {
    const bf16_t* U = (const bf16_t*)(a.ws + WS_U);
    int tid = tid_now(); asm volatile("" : "+v"(tid));
    const int lane = tid & 63, w = __builtin_amdgcn_readfirstlane(tid >> 6), n = lane & 15, g = lane >> 4;
    const unsigned fn = ((n & 3) << 2) | ((n >> 2) & 3);
    const unsigned base_rr = 256u * n + 16u * (g ^ fn);
    const unsigned base_c = 256u * n + 16u * ((g >> 1) ^ fn) + 8u * (g & 1);
    const unsigned base_p = 128u * n + 16u * (g ^ (n & 7));
    const unsigned trb0 = tr16(lane, 0, 0, 0), trb1 = tr16(lane, 0, 0, 1);
    GlaPre& cur = pre;
    const bf16x8 wfrag = __builtin_bit_cast(bf16x8, cur.wf); const float wbias = cur.wb;
    int prow[2], pch[2], ptok[2];
#pragma unroll
    for (int i = 0; i < 2; ++i) { const int idx = tid + 512 * i; prow[i] = idx >> 4; pch[i] = idx & 15; ptok[i] = dir ? tb + 63 - prow[i] : tb + prow[i]; }
    u32x4 st0, st1, zraw[2];
    {
        LAS float* B = (LAS float*)(lds + GL_B);
        bf16x8 vh[2], vl[2];
#pragma unroll
        for (int ks = 0; ks < 2; ++ks) {
            float vv[8];
#pragma unroll
            for (int half = 0; half < 2; ++half) {
                const f32x4 x = MFMA16(__builtin_bit_cast(bf16x8, cur.gd[2 * ks + half]), wfrag, ((f32x4){wbias, wbias, wbias, wbias}));
#pragma unroll
                for (int r = 0; r < 4; ++r) { const float xs = x[r] * 1.4426950408889634f; vv[4 * half + r] = (fminf(xs, 0.f) - flog2(1.0f + fexp2(-fabsf(xs)))) * (1.0f / 16.0f); }
            }
            u32x4 hw, lw;
#pragma unroll
            for (int q = 0; q < 4; ++q) { const unsigned hp = pk2(vv[2 * q], vv[2 * q + 1]); hw[q] = hp;
                lw[q] = pk2(vv[2 * q] - __uint_as_float(hp << 16), vv[2 * q + 1] - __uint_as_float(hp & 0xffff0000u)); }
            vh[ks] = __builtin_bit_cast(bf16x8, hw); vl[ks] = __builtin_bit_cast(bf16x8, lw);
        }
        u32x4 ta, tbm;
#pragma unroll
        for (int q = 0; q < 2; ++q) { const unsigned lo = (4 * g + 2 * q <= n) ? 0x3f80u : 0u, hi = (4 * g + 2 * q + 1 <= n) ? 0x3f800000u : 0u; ta[q] = lo | hi; ta[2 + q] = 0u; tbm[q] = 0x3f803f80u; tbm[2 + q] = lo | hi; }
        const bf16x8 TA = __builtin_bit_cast(bf16x8, ta), TB = __builtin_bit_cast(bf16x8, tbm), ONES = __builtin_bit_cast(bf16x8, ((u32x4){0x3f803f80u, 0x3f803f80u, 0x3f803f80u, 0x3f803f80u}));
        const f32x4 z4 = (f32x4){0.f, 0.f, 0.f, 0.f};
        f32x4 bt[4];
        bt[0] = MFMA16(TA, vl[0], MFMA16(TA, vh[0], z4));
        bt[1] = MFMA16(TB, vl[0], MFMA16(TB, vh[0], z4));
        const f32x4 s32 = MFMA16(ONES, vl[0], MFMA16(ONES, vh[0], z4));
        bt[2] = MFMA16(TA, vl[1], MFMA16(TA, vh[1], s32));
        bt[3] = MFMA16(TB, vl[1], MFMA16(TB, vh[1], s32));
#pragma unroll
        for (int it = 0; it < 4; ++it)
#pragma unroll
            for (int r = 0; r < 4; ++r) B[(16 * it + 4 * g + r) * GL_BP + 16 * w + n] = bt[it][r];
        if (g == 3) { ((LAS float*)(lds + GL_EBL + par * 512))[16 * w + n] = fexp2(bt[3][3]); lam += bt[3][3]; }
    }
    __syncthreads();
#pragma unroll
    for (int i = 0; i < 2; ++i) {
        const LAS f32x4* bp = (const LAS f32x4*)(lds + GL_B + (prow[i] * GL_BP + pch[i] * 8) * 4);
        const f32x4 b0 = bp[0], b1 = bp[1];
        float e[8], kf[8];
#pragma unroll
        for (int j = 0; j < 4; ++j) { e[j] = fexp2(b0[j]); e[4 + j] = fexp2(b1[j]); }
        unpack8(cur.k[i], kf);
        u32x4 kw;
#pragma unroll
        for (int j = 0; j < 4; ++j) kw[j] = pk2(kf[2 * j] * __builtin_amdgcn_rcpf(e[2 * j]), kf[2 * j + 1] * __builtin_amdgcn_rcpf(e[2 * j + 1]));
        *(LAS u32x4*)(lds + GL_KT + offb(prow[i], pch[i])) = kw;
        *(LAS u32x4*)(lds + GL_VT + offb(prow[i], pch[i])) = cur.v[i];
        if (MODE != 0) {
            float qf[8]; unpack8(cur.q[i], qf);
            u32x4 qw;
#pragma unroll
            for (int j = 0; j < 4; ++j) qw[j] = pk2(qf[2 * j] * e[2 * j], qf[2 * j + 1] * e[2 * j + 1]);
            *(LAS u32x4*)(lds + GL_QT + offb(prow[i], pch[i])) = qw;
        }
    }
    __syncthreads();
    gla_prefetch<MODE>(a, pre, tid, ntb, nh, ndir, -1);
    f32x4 Oacc[4];
    if (MODE != 0) {
        const int it = w >> 1;
#pragma unroll
        for (int jj = 0; jj < 2; ++jj) {
            const int jt = 2 * (w & 1) + jj;
            f32x4 pacc = (f32x4){0.f, 0.f, 0.f, 0.f};
            if (jt <= it) {
#pragma unroll
                for (int s = 0; s < 4; ++s) {
                    const bf16x8 qa = *(const LAS bf16x8*)(lds + GL_QT + (base_rr ^ (64u * s)) + 4096u * it);
                    const bf16x8 kb = *(const LAS bf16x8*)(lds + GL_KT + (base_rr ^ (64u * s)) + 4096u * jt); pacc = MFMA16(qa, kb, pacc); }
            }
            const int j = 16 * jt + n;
#pragma unroll
            for (int r = 0; r < 4; ++r) {
                const int i = 16 * it + 4 * g + r;
                const bool keep = (MODE == 1) ? (j <= i) : (j < i);
                *(LAS bf16_t*)(lds + GL_PT + offp(i, j >> 3) + 2 * (j & 7)) = keep ? f2bf(pacc[r]) : (bf16_t)0;
            }
            __builtin_amdgcn_sched_barrier(0);
        }
        if (first) {
#pragma unroll
            for (int kt = 0; kt < 8; ++kt) { const unsigned r0 = __float_as_uint(Sacc[kt][0]), r1 = __float_as_uint(Sacc[kt][1]);
                Sacc[kt] = (f32x4){__uint_as_float(r0 << 16), __uint_as_float(r0 & 0xffff0000u), __uint_as_float(r1 << 16), __uint_as_float(r1 & 0xffff0000u)}; }
        }
#pragma unroll
        for (int i2 = 0; i2 < 4; ++i2) Oacc[i2] = (f32x4){0.f, 0.f, 0.f, 0.f};
#pragma unroll
        for (int ks = 0; ks < 4; ++ks) {
            u32x4 pw; pw.x = pk2(Sacc[2 * ks][0], Sacc[2 * ks][1]); pw.y = pk2(Sacc[2 * ks][2], Sacc[2 * ks][3]); pw.z = pk2(Sacc[2 * ks + 1][0], Sacc[2 * ks + 1][1]); pw.w = pk2(Sacc[2 * ks + 1][2], Sacc[2 * ks + 1][3]);
            const bf16x8 sb = __builtin_bit_cast(bf16x8, pw);
            const unsigned alo = base_c ^ (64u * ks);
#pragma unroll
            for (int i2 = 0; i2 < 4; ++i2) {
                const u32x2 lo = *(const LAS u32x2*)(lds + GL_QT + 4096 * i2 + alo);
                const u32x2 hi = *(const LAS u32x2*)(lds + GL_QT + 4096 * i2 + (alo ^ 32u));
                u32x4 aw; aw.x = lo.x; aw.y = lo.y; aw.z = hi.x; aw.w = hi.y;
                Oacc[i2] = MFMA16(__builtin_bit_cast(bf16x8, aw), sb, Oacc[i2]);
            }
            __builtin_amdgcn_sched_barrier(0);
        }
        __syncthreads();
        if (MODE == 2) {
            st0 = stash[tid * 2]; st1 = stash[tid * 2 + 1];
#pragma unroll
            for (int i = 0; i < 2; ++i) zraw[i] = *(const u32x4*)(U + (size_t)ptok[i] * UP + C_ZA + h * 128 + pch[i] * 8);
        }
    }
    bf16x8 vf[2];
#pragma unroll
    for (int ks = 0; ks < 2; ++ks) vf[ks] = tr_read8(lds, GL_VT + 8192u * ks + (trb0 ^ (32u * w)), GL_VT + 8192u * ks + (trb1 ^ (32u * w)));
    if (MODE != 0) {
#pragma unroll
        for (int i2 = 0; i2 < 4; ++i2)
#pragma unroll
            for (int ks = 0; ks < 2; ++ks) {
                if (ks <= (i2 >> 1)) { const bf16x8 pa = *(const LAS bf16x8*)(lds + GL_PT + 2048 * i2 + (base_p ^ (64u * ks))); Oacc[i2] = MFMA16(pa, vf[ks], Oacc[i2]); }
            }
    }
#pragma unroll
    for (int kt = 0; kt < 8; ++kt) {
#pragma unroll
        for (int ks = 0; ks < 2; ++ks) { const bf16x8 ka = tr_read8(lds, GL_KT + 8192u * ks + (trb0 ^ (32u * kt)), GL_KT + 8192u * ks + (trb1 ^ (32u * kt))); Sacc[kt] = MFMA16(ka, vf[ks], Sacc[kt]); }
        const f32x4 eb = *(const LAS f32x4*)(lds + GL_EBL + par * 512 + (16 * kt + 4 * g) * 4);
        Sacc[kt] = Sacc[kt] * eb;
        if (kt & 1) __builtin_amdgcn_sched_barrier(0);
    }
    if (MODE == 1) {
        u32x4 s0, s1;
        s0.x = pk2(Oacc[3][3], Oacc[3][2]); s0.y = pk2(Oacc[3][1], Oacc[3][0]); s0.z = pk2(Oacc[2][3], Oacc[2][2]); s0.w = pk2(Oacc[2][1], Oacc[2][0]);
        s1.x = pk2(Oacc[1][3], Oacc[1][2]); s1.y = pk2(Oacc[1][1], Oacc[1][0]); s1.z = pk2(Oacc[0][3], Oacc[0][2]); s1.w = pk2(Oacc[0][1], Oacc[0][0]);
        const int tidm = tid ^ 48;
        stash[tidm * 2] = s0; stash[tidm * 2 + 1] = s1;
    }
    if (MODE == 2) {
        float fo[16]; { float t8[8]; unpack8(st0, t8);
#pragma unroll
            for (int j = 0; j < 8; ++j) fo[j] = t8[j]; unpack8(st1, t8);
#pragma unroll
            for (int j = 0; j < 8; ++j) fo[8 + j] = t8[j]; }
        LAS float* ssw = (LAS float*)(lds + GL_SSW);
#pragma unroll
        for (int i2 = 0; i2 < 4; ++i2)
#pragma unroll
            for (int r = 0; r < 4; ++r) {
                const float o = Oacc[i2][r] + fo[4 * i2 + r]; Oacc[i2][r] = o;
                float v = o * o; v += dpp_f<0x128>(v); v += dpp_f<0x124>(v); v += dpp_f<0x122>(v); v += dpp_f<0x121>(v);
                if (n == 0) ssw[w * 64 + 16 * i2 + 4 * g + r] = v;
            }
        __syncthreads();
        if (tid < 64) { float s = 0.f;
#pragma unroll
            for (int ww = 0; ww < 8; ++ww) s += ssw[ww * 64 + tid];
            ((LAS float*)(lds + GL_RSTD))[tid] = rsqrtf(s * (1.0f / 128.0f) + NORM_EPS); }
        __syncthreads();
        const float gn = a.ng[16 * w + n];
#pragma unroll
        for (int i2 = 0; i2 < 4; ++i2) {
            const f32x4 rs = *(const LAS f32x4*)(lds + GL_RSTD + (16 * i2 + 4 * g) * 4);
#pragma unroll
            for (int r = 0; r < 4; ++r) *(LAS bf16_t*)(lds + GL_QT + (16 * i2 + 4 * g + r) * 256 + (16 * w + n) * 2) = f2bf(Oacc[i2][r] * rs[r] * gn);
        }
        __syncthreads();
        bf16_t* ymix = (bf16_t*)((unsigned char*)a.out + 96 * MiB);
#pragma unroll
        for (int i = 0; i < 2; ++i) {
            const u32x4 ov = *(const LAS u32x4*)(lds + GL_QT + prow[i] * 256 + pch[i] * 16);
            float of[8], zf[8]; unpack8(ov, of); unpack8(zraw[i], zf);
            u32x4 yw;
#pragma unroll
            for (int j = 0; j < 4; ++j) yw[j] = pk2(of[2 * j] * silu(zf[2 * j]), of[2 * j + 1] * silu(zf[2 * j + 1]));
            *(u32x4*)(ymix + (size_t)ptok[i] * DM + h * 128 + pch[i] * 8) = yw;
        }
    }
}
__device__ __forceinline__ void build_gate_tables(const Args& a) {
    for (int e = blockIdx.x * NTHR + tid_now(); e < 8 * 512; e += gridDim.x * NTHR) {
        const int dh = e >> 9, tid = e & 511, dir = dh >> 2, h = dh & 3, lane = tid & 63, w = tid >> 6, n = lane & 15, g = lane >> 4, col = h * 128 + 16 * w + n;
        const float* wup = dir ? a.wub : a.wuf; const float* bias = dir ? a.bbw : a.bfw;
        u32x4 pw;
#pragma unroll
        for (int j = 0; j < 4; ++j) {
            const float v0 = wup[(8 * (g & 1) + 2 * j) * 512 + col], v1 = wup[(8 * (g & 1) + 2 * j + 1) * 512 + col];
            const float h0 = bf2f(f2bf(v0)), h1 = bf2f(f2bf(v1));
            pw[j] = g < 2 ? pk2(v0, v1) : pk2(v0 - h0, v1 - h1);
        }
        ((u32x4*)(a.ws + WS_GATE))[e] = pw;
        if (g == 0) ((float*)(a.ws + WS_GATE + 65536))[dh * 128 + 16 * w + n] = bias[col];
    }
}
__device__ __forceinline__ void phase_gla_pass1(const Args& a, LAS unsigned char* lds) {
    const int tid = tid_now(), w = tid >> 6, lane = tid & 63;
    unsigned char* ST = a.ws + WS_ST;
    const int nsteps = ((NSEG * 8 - (int)blockIdx.x + (int)gridDim.x - 1) / (int)gridDim.x) * 4;
    auto params = [&](int st, int& tb, int& h, int& dir) { if (st >= nsteps) st = nsteps - 1; const int item = blockIdx.x + (st >> 2) * gridDim.x, cc = st & 3; dir = item & 1; h = (item >> 1) & 3; tb = (item >> 3) * 256 + (dir ? 3 - cc : cc) * 64; };
    GlaPre preA, preB; int par = 0;
    if (nsteps > 0) { int tb, h, dir; params(0, tb, h, dir); gla_prefetch<0>(a, preA, tid, tb, h, dir, -1); params(1, tb, h, dir); gla_prefetch<0>(a, preB, tid, tb, h, dir, -1); }
    f32x4 Sacc[8]; float lam;
    for (int st = 0; st < nsteps; st += 2) {
        const int item = blockIdx.x + (st >> 2) * gridDim.x;
        if ((st & 3) == 0) {
#pragma unroll
            for (int kt = 0; kt < 8; ++kt) Sacc[kt] = (f32x4){0.f, 0.f, 0.f, 0.f};
            lam = 0.f;
        }
        { int tb, h, dir, ntb, nh, ndir; params(st, tb, h, dir); params(st + 2, ntb, nh, ndir); gla_chunk<0>(a, lds, tb, h, dir, Sacc, lam, nullptr, preA, ntb, nh, ndir, false, par); par ^= 1; }
        { int tb, h, dir, ntb, nh, ndir; params(st + 1, tb, h, dir); params(st + 3, ntb, nh, ndir); gla_chunk<0>(a, lds, tb, h, dir, Sacc, lam, nullptr, preB, ntb, nh, ndir, false, par); par ^= 1; }
        if ((st & 3) == 2) {
            u32x2* dst = (u32x2*)(ST + (size_t)item * 32768) + (size_t)w * 8 * 64 + lane;
#pragma unroll
            for (int kt = 0; kt < 8; ++kt) { u32x2 v; v.x = pk2(Sacc[kt][0], Sacc[kt][1]); v.y = pk2(Sacc[kt][2], Sacc[kt][3]); dst[kt * 64] = v; }
            if ((lane >> 4) == 3) ((float*)(a.ws + WS_DEC))[(size_t)item * 128 + 16 * w + (lane & 15)] = lam;
        }
    }
    __syncthreads();
}
__device__ __forceinline__ void phase_gla_pass2(const Args& a) {
    unsigned char* ST = a.ws + WS_ST; const float* DEC = (const float*)(a.ws + WS_DEC);
    for (int gidx = blockIdx.x * NTHR + tid_now(); gidx < 48 * 4096; gidx += gridDim.x * NTHR) {
        const int chain = gidx >> 12, quad = gidx & 4095, dir = chain & 1, h = (chain >> 1) & 3, s = chain >> 3;
        const int nseg = s < 2 ? LP / 256 : LS / 256, seg0 = s < 2 ? s * (LP / 256) : 2 * (LP / 256) + (s - 2) * (LS / 256);
        const int kt = (quad >> 6) & 7, lane = quad & 63, dk0 = 16 * kt + 4 * (lane >> 4);
        f32x4 S = (f32x4){0.f, 0.f, 0.f, 0.f};
        for (int i0 = 0; i0 < nseg; i0 += 8) {
            u32x2 t[8]; f32x4 lm[8];
#pragma unroll
            for (int j = 0; j < 8; ++j) { const int seg = dir ? seg0 + nseg - 1 - (i0 + j) : seg0 + i0 + j; const size_t idx = (size_t)((seg * 4 + h) * 2 + dir);
                t[j] = ((const u32x2*)(ST + idx * 32768))[quad]; lm[j] = *(const f32x4*)(DEC + idx * 128 + dk0); }
#pragma unroll
            for (int j = 0; j < 8; ++j) { const int seg = dir ? seg0 + nseg - 1 - (i0 + j) : seg0 + i0 + j; const size_t idx = (size_t)((seg * 4 + h) * 2 + dir);
                u32x2 o; o.x = pk2(S[0], S[1]); o.y = pk2(S[2], S[3]); ((u32x2*)(ST + idx * 32768))[quad] = o;
                const f32x4 tv = (f32x4){__uint_as_float(t[j].x << 16), __uint_as_float(t[j].x & 0xffff0000u), __uint_as_float(t[j].y << 16), __uint_as_float(t[j].y & 0xffff0000u)};
                S = (f32x4){fexp2(lm[j][0]), fexp2(lm[j][1]), fexp2(lm[j][2]), fexp2(lm[j][3])} * S + tv; }
        }
    }
}
__device__ __forceinline__ void phase_gla_pass3(const Args& a, LAS unsigned char* lds) {
    const int tid = tid_now(), w = tid >> 6, lane = tid & 63;
    GlaPre pre; int par = 0;
    if (blockIdx.x < NSEG * 4) gla_prefetch<1>(a, pre, tid, (blockIdx.x >> 2) * 256, blockIdx.x & 3, 0, -1);
    for (int item = blockIdx.x; item < NSEG * 4; item += gridDim.x) {
        const int h = item & 3, seg = item >> 2;
        const int nitem = item + gridDim.x < NSEG * 4 ? item + gridDim.x : item;
        u32x4* stash = (u32x4*)a.out + (size_t)item * 4 * 1024;
#pragma unroll 1
        for (int dir = 0; dir < 2; ++dir) {
            f32x4 Sacc[8];
            const u32x2* src = (const u32x2*)(a.ws + WS_ST + (size_t)((seg * 4 + h) * 2 + dir) * 32768) + (size_t)w * 8 * 64 + lane;
#pragma unroll
            for (int kt = 0; kt < 8; ++kt) { const u32x2 v = src[kt * 64]; Sacc[kt] = (f32x4){__uint_as_float(v.x), __uint_as_float(v.y), 0.f, 0.f}; }
            float lam = 0.f;
            if (dir == 0) {
                for (int c = 0; c < 4; ++c) { const int ntb = seg * 256 + (c < 3 ? c + 1 : 3) * 64, ndir = c < 3 ? 0 : 1;
                    gla_chunk<1>(a, lds, seg * 256 + c * 64, h, 0, Sacc, lam, stash + c * 1024, pre, ntb, h, ndir, c == 0, par); par ^= 1; }
            } else {
                for (int c = 3; c >= 0; --c) { const int ntb = c > 0 ? seg * 256 + (c - 1) * 64 : (nitem >> 2) * 256, nh = c > 0 ? h : (nitem & 3), ndir = c > 0 ? 1 : 0;
                    gla_chunk<2>(a, lds, seg * 256 + c * 64, h, 1, Sacc, lam, stash + c * 1024, pre, ntb, nh, ndir, c == 3, par); par ^= 1; }
            }
        }
    }
    __syncthreads();
}
typedef float f32x16 __attribute__((ext_vector_type(16)));
#define MFMA32(a, b, c) __builtin_amdgcn_mfma_f32_32x32x16_bf16((a), (b), (c), 0, 0, 0)
constexpr int SW_K = 0, SW_V = 65536, SW_TB = 131072, SW_TBN = 336, SW_TBH = 4 * SW_TBN * 4;
constexpr float SW_NEG = -1e30f;
__device__ __forceinline__ unsigned offk(unsigned row, unsigned c8) { return 128u * row + 16u * (c8 ^ ((row >> 1) & 7)); }
__device__ __forceinline__ unsigned offv(unsigned row, unsigned c8) { return 128u * row + 16u * (c8 ^ (((row >> 1) & 1) << 2)); }
__device__ __forceinline__ void swa_load_block(const bf16_t* U, int gb, int kvh, bool valid, int tid, u32x4 (&kk)[2], u32x4 (&vv)[2]) {
#pragma unroll
    for (int i = 0; i < 2; ++i) {
        const int idx = tid + 512 * i, r = idx >> 3, c8 = idx & 7;
        kk[i] = (u32x4){0, 0, 0, 0}; vv[i] = (u32x4){0, 0, 0, 0};
        if (valid) { const bf16_t* ur = U + (size_t)(gb * 128 + r) * UP + kvh * 64 + c8 * 8; kk[i] = *(const u32x4*)(ur + C_KB); vv[i] = *(const u32x4*)(ur + C_VB); }
    }
}
__device__ __forceinline__ void swa_store_block(LAS unsigned char* lds, int gb, int tid, const u32x4 (&kk)[2], const u32x4 (&vv)[2]) {
#pragma unroll
    for (int i = 0; i < 2; ++i) {
        const int idx = tid + 512 * i, r = 128 * (gb & 3) + (idx >> 3), c8 = idx & 7;
        *(LAS u32x4*)(lds + SW_K + offk(r, c8)) = kk[i]; *(LAS u32x4*)(lds + SW_V + offv(r, c8)) = vv[i];
    }
}
__device__ __forceinline__ bool swa_exists(int gb) { return gb >= 0 && gb < NTOK / 128; }
__device__ __forceinline__ void phase_swa(const Args& a, LAS unsigned char* lds) {
    const bf16_t* U = (const bf16_t*)(a.ws + WS_U); bf16_t* ymix = (bf16_t*)((unsigned char*)a.out + 96 * MiB);
    const int tid = tid_now(), lane = tid & 63, w = __builtin_amdgcn_readfirstlane(tid >> 6), r = lane & 31, hh = lane >> 5;
    for (int su = blockIdx.x; su < (NTOK / 128 / 3) * 2; su += gridDim.x) {
        const int kvh = su & 1, qb0 = 3 * (su >> 1);
        __syncthreads();
        for (int e = tid; e < 4 * SW_TBN; e += NTHR) {
            const int hl = e / SW_TBN, idx = e - hl * SW_TBN, rel = idx - 160;
            const float val = (rel >= -128 && rel <= 128) ? a.relb[t5_bucket(rel) * 8 + kvh * 4 + hl] : SW_NEG;
            LAS float* tb = (LAS float*)(lds + SW_TB + hl * SW_TBH);
#pragma unroll
            for (int s = 0; s < 4; ++s) if (idx - s >= 0) tb[s * SW_TBN + idx - s] = val;
        }
#pragma unroll 1
        for (int bb = -1; bb <= 1; ++bb) { u32x4 kk[2], vv[2]; swa_load_block(U, qb0 + bb, kvh, swa_exists(qb0 + bb), tid, kk, vv); swa_store_block(lds, qb0 + bb, tid, kk, vv); }
        __syncthreads();
        const int hl = w >> 1, hq = kvh * 4 + hl;
        const float snk = a.sink[hq];
#pragma unroll 1
        for (int qi = 0; qi < 3; ++qi) {
            const int qb = qb0 + qi, tok0 = qb * 128; int s0, L; seq_of(tok0, s0, L);
            const bool first = tok0 == s0, last = tok0 + 128 == s0 + L;
            u32x4 nk[2], nv[2];
            if (qi < 2) swa_load_block(U, qb + 2, kvh, swa_exists(qb + 2), tid, nk, nv);
            bf16x8 Qn[4];
            { const int qt0 = tok0 + 32 * ((w & 1) * 2) + r;
#pragma unroll
              for (int s = 0; s < 4; ++s) Qn[s] = *(const bf16x8*)(U + (size_t)qt0 * UP + C_QB + hq * 64 + 16 * s + 8 * hh); }
#pragma unroll 1
            for (int ss = 0; ss < 2; ++ss) {
                const int st = (w & 1) * 2 + ss, qtok = tok0 + 32 * st + r;
                bf16x8 Qf[4];
#pragma unroll
                for (int s = 0; s < 4; ++s) Qf[s] = Qn[s];
                { const int qt1 = ss == 0 ? qtok + 32 : qtok;
#pragma unroll
                  for (int s = 0; s < 4; ++s) Qn[s] = *(const bf16x8*)(U + (size_t)qt1 * UP + C_QB + hq * 64 + 16 * s + 8 * hh); }
                u32x2 zv8[2][4];
#pragma unroll
                for (int dt = 0; dt < 2; ++dt)
#pragma unroll
                    for (int i4 = 0; i4 < 4; ++i4) zv8[dt][i4] = *(const u32x2*)(U + (size_t)qtok * UP + C_ZB + hq * 64 + 32 * dt + 8 * i4 + 4 * hh);
                float m = snk, l = hh == 0 ? 1.0f : 0.0f;
                f32x16 O[2];
#pragma unroll
                for (int i = 0; i < 16; ++i) { O[0][i] = 0.f; O[1][i] = 0.f; }
                const int sft = (-r) & 3;
                const unsigned tbase = SW_TB + hl * SW_TBH + sft * (SW_TBN * 4) + 4 * (32 + 4 * hh - r - sft);
                const unsigned kb0 = SW_K + 128u * r + 16u * (hh ^ ((r >> 1) & 7));
                const int q4 = (lane & 15) >> 2, p4 = lane & 3, g1 = (lane >> 4) & 1, xq = (q4 >> 1) & 1;
                const unsigned vb0 = SW_V + 128u * (4 * hh + q4) + 16u * ((4 * xq) | (2 * g1) | (p4 >> 1)) + 8u * (p4 & 1);
#pragma unroll 1
                for (int grp = 0; grp < 3; ++grp) {
                    f32x16 S[3];
#pragma unroll
                    for (int k3 = 0; k3 < 3; ++k3) {
                        const int kk = 3 * grp + k3, kt = st + kk, blk = kt >> 2;
                        const bool valid = !((blk == 0 && first) || (blk == 2 && last));
                        const unsigned rowb = 128u * (128u * ((unsigned)(qb - 1 + blk) & 3u) + 32u * (kt & 3));
                        if (valid) {
#pragma unroll
                            for (int i = 0; i < 16; ++i) S[k3][i] = 0.f;
#pragma unroll
                            for (int s = 0; s < 4; ++s) { const bf16x8 Kf = *(const LAS bf16x8*)(lds + (kb0 ^ (32u * s)) + rowb); S[k3] = MFMA32(Kf, Qf[s], S[k3]); }
#pragma unroll
                            for (int i4 = 0; i4 < 4; ++i4) { const f32x4 bv = *(const LAS f32x4*)(lds + tbase + 4 * (32 * kk + 8 * i4));
#pragma unroll
                                for (int j = 0; j < 4; ++j) S[k3][4 * i4 + j] += bv[j]; }
                        } else {
#pragma unroll
                            for (int i = 0; i < 16; ++i) S[k3][i] = SW_NEG;
                        }
                    }
                    float mx4[4] = {SW_NEG, SW_NEG, SW_NEG, SW_NEG};
#pragma unroll
                    for (int k3 = 0; k3 < 3; ++k3)
#pragma unroll
                        for (int i = 0; i < 16; ++i) mx4[i & 3] = fmaxf(mx4[i & 3], S[k3][i]);
                    float mx = fmaxf(fmaxf(mx4[0], mx4[1]), fmaxf(mx4[2], mx4[3]));
                    mx = fmaxf(mx, __shfl_xor(mx, 32));
                    const float mn = fmaxf(m, mx), alpha = fexp(m - mn);
                    m = mn; l *= alpha;
#pragma unroll
                    for (int i = 0; i < 16; ++i) { O[0][i] *= alpha; O[1][i] *= alpha; }
                    bf16x8 Pf[3][2];
                    float l4[4] = {0.f, 0.f, 0.f, 0.f};
#pragma unroll
                    for (int k3 = 0; k3 < 3; ++k3) {
#pragma unroll
                        for (int i = 0; i < 16; ++i) { const float pv = fexp(S[k3][i] - m); S[k3][i] = pv; l4[i & 3] += pv; }
#pragma unroll
                        for (int s2 = 0; s2 < 2; ++s2) {
                            u32x4 pw;
#pragma unroll
                            for (int j = 0; j < 4; ++j) pw[j] = pk2(S[k3][8 * s2 + 2 * j], S[k3][8 * s2 + 2 * j + 1]);
                            Pf[k3][s2] = __builtin_bit_cast(bf16x8, pw);
                        }
                    }
                    l += (l4[0] + l4[1]) + (l4[2] + l4[3]);
#pragma unroll
                    for (int k3 = 0; k3 < 3; ++k3) {
                        const int kt = st + 3 * grp + k3, blk = kt >> 2;
                        const unsigned rowb = 128u * (128u * ((unsigned)(qb - 1 + blk) & 3u) + 32u * (kt & 3));
#pragma unroll
                        for (int s2 = 0; s2 < 2; ++s2)
#pragma unroll
                            for (int dt = 0; dt < 2; ++dt) {
                                const unsigned va = (vb0 ^ (64u * dt)) + rowb + 2048u * s2;
                                const bf16x8 Vf = tr_read8(lds, va, va + 1024u);
                                O[dt] = MFMA32(Vf, Pf[k3][s2], O[dt]);
                            }
                    }
                }
                l += __shfl_xor(l, 32);
                const float inv = __builtin_amdgcn_rcpf(l);
#pragma unroll
                for (int dt = 0; dt < 2; ++dt)
#pragma unroll
                    for (int i4 = 0; i4 < 4; ++i4) {
                        const int d0 = 32 * dt + 8 * i4 + 4 * hh;
                        const u32x2 zv = zv8[dt][i4];
                        const float z0 = __uint_as_float(zv.x << 16), z1 = __uint_as_float(zv.x & 0xffff0000u), z2 = __uint_as_float(zv.y << 16), z3 = __uint_as_float(zv.y & 0xffff0000u);
                        u32x2 yw; yw.x = pk2(O[dt][4 * i4] * inv * silu(z0), O[dt][4 * i4 + 1] * inv * silu(z1)); yw.y = pk2(O[dt][4 * i4 + 2] * inv * silu(z2), O[dt][4 * i4 + 3] * inv * silu(z3));
                        *(u32x2*)(ymix + (size_t)qtok * DM + 512 + hq * 64 + d0) = yw;
                    }
            }
            if (qi < 2) swa_store_block(lds, qb + 2, tid, nk, nv);
            __syncthreads();
        }
    }
}
__device__ __forceinline__ void phase_convfix(const Args& a) {
    bf16_t* G = (bf16_t*)(a.ws + WS_XB); const float* Pb = (const float*)(a.ws + WS_PB); const float* Sb = (const float*)(a.ws + WS_SB);
    for (int idx = blockIdx.x * NTHR + tid_now(); idx < (NTOK / 64 - 1) * 256; idx += gridDim.x * NTHR) {
        const int k = idx / 256 + 1, c = (idx & 255) * 4, row = 64 * k; int s0, L; seq_of(row, s0, L);
        if (row == s0) continue;
        const f32x4 pl = *(const f32x4*)(Pb + (size_t)((k - 1) * 2 + 1) * 1024 + c), sl = *(const f32x4*)(Sb + (size_t)((k - 1) * 2 + 1) * 1024 + c);
        const f32x4 pf = *(const f32x4*)(Pb + (size_t)(k * 2) * 1024 + c), sf = *(const f32x4*)(Sb + (size_t)(k * 2) * 1024 + c);
        const f32x4 c0 = *(const f32x4*)(a.cw + c), c2 = *(const f32x4*)(a.cw + 2048 + c);
        u32x2* gl = (u32x2*)(G + (size_t)(row - 1) * DM + c); u32x2* gf = (u32x2*)(G + (size_t)row * DM + c);
        const u32x2 a0 = *gl, a1 = *gf;
        const f32x4 dl = sl * c2 * pf, df = sf * c0 * pl;
        u32x2 o0, o1;
        o0.x = pk2(__uint_as_float(a0.x << 16) + dl[0], __uint_as_float(a0.x & 0xffff0000u) + dl[1]); o0.y = pk2(__uint_as_float(a0.y << 16) + dl[2], __uint_as_float(a0.y & 0xffff0000u) + dl[3]);
        o1.x = pk2(__uint_as_float(a1.x << 16) + df[0], __uint_as_float(a1.x & 0xffff0000u) + df[1]); o1.y = pk2(__uint_as_float(a1.y << 16) + df[2], __uint_as_float(a1.y & 0xffff0000u) + df[3]);
        *gl = o0; *gf = o1;
    }
}
__global__ void __launch_bounds__(NTHR, 2) mega(Args a) {
    LAS unsigned char* lds = (LAS unsigned char*)lds_raw;
    volatile LAS unsigned* MISC = (volatile LAS unsigned*)(lds + MISC_OFF);
    if (threadIdx.x < 32) MISC[threadIdx.x] = 0u;
    if ((threadIdx.x & 63) == 0) ((volatile LAS unsigned*)(lds + SLOT_OFF))[hw_slot()] = threadIdx.x >> 6;
    __syncthreads();
    unsigned char* ws = a.ws; float* out = a.out;
    XcdBarrier bar = xcd_barrier_post((unsigned*)(ws + WS_CTL) + 4096, MISC + 8);
    bf16_t* W1t = (bf16_t*)(ws + WS_W1T); bf16_t* W2t = (bf16_t*)(ws + WS_W2T); bf16_t* W3t = (bf16_t*)(ws + WS_W3T); bf16_t* W4t = (bf16_t*)(ws + WS_W4T);
    bf16_t* xb = (bf16_t*)(ws + WS_XB); bf16_t* ymix = (bf16_t*)((unsigned char*)out + 96 * MiB); bf16_t* G = xb; bf16_t* U = (bf16_t*)(ws + WS_U);
    bf16_t* x1b = (bf16_t*)(ws + WS_X1B); bf16_t* P = (bf16_t*)(ws + WS_P); bf16_t* Sg = (bf16_t*)(ws + WS_S);
    f32x2* stat1 = (f32x2*)(ws + WS_STAT1); f32x2* stat2 = (f32x2*)(ws + WS_STAT2); f32x2* mr1 = (f32x2*)(ws + WS_MR1);

    phase_convert(a, lds);
    xcd_barrier(bar);
    { pg8::Gemm g{xb, W1t, NTOK, C_GD, DM, 0}; pg8::StaticOrder S; S.init(NTOK, C_GD, gridDim.x, blockIdx.x); EpiU E{U}; pg8::gemm_phase<EpiU, pg8::StaticOrder>(lds, g, S, E); }
    xcd_barrier(bar);
    phase_gla_pass1(a, lds);
    xcd_barrier(bar);
    phase_gla_pass2(a);
    phase_swa(a, lds);
    xcd_barrier(bar);
    phase_gla_pass3(a, lds);
    xcd_barrier(bar);
    { pg8::Gemm g{ymix, W2t, NTOK, DM, DM, 0}; pg8::StaticOrder S; S.init(NTOK, DM, gridDim.x, blockIdx.x);
      EpiLN<0> E{ws, nullptr, a.lng, a.lnb}; pg8::gemm_phase<EpiLN<0>, pg8::StaticOrder>(lds, g, S, E); }
    xcd_barrier(bar);
    { pg8::Gemm g{x1b, W3t, NTOK, 4096, DM, 0}; pg8::StaticOrder S; S.init(NTOK, 4096, gridDim.x, blockIdx.x); EpiG E{ws, a.cw}; pg8::gemm_phase<EpiG, pg8::StaticOrder>(lds, g, S, E); }
    xcd_barrier(bar);
    phase_convfix(a);
    xcd_barrier(bar);
    { pg8::Gemm g{G, W4t, NTOK, DM, DM, 0}; pg8::StaticOrder S; S.init(NTOK, DM, gridDim.x, blockIdx.x);
      EpiLN<1> E{ws, out, a.lng + DM, a.lnb + DM}; pg8::gemm_phase<EpiLN<1>, pg8::StaticOrder>(lds, g, S, E); }
}

extern "C" void kernel_launch(void* const* d_in, const int* in_sizes, int n_in, void* d_out, int out_size, void* d_ws, size_t ws_size, hipStream_t stream) {
    static int grid = 0;
    if (grid == 0) {
        if (n_in != 16 || out_size != NTOK * DM || ws_size < WS_END) { fprintf(stderr, "kernel_launch: unexpected shapes (n_in %d out %d ws %zu)\n", n_in, out_size, ws_size); grid = -1; return; }
        int dev = 0, cus = 0, per_cu = 0;
        if (hipGetDevice(&dev) != hipSuccess || hipDeviceGetAttribute(&cus, hipDeviceAttributeMultiprocessorCount, dev) != hipSuccess) { grid = -1; return; }
        if (hipFuncSetAttribute((const void*)mega, hipFuncAttributeMaxDynamicSharedMemorySize, LDS_BYTES) != hipSuccess) { fprintf(stderr, "kernel_launch: hipFuncSetAttribute failed\n"); grid = -1; return; }
        if (hipOccupancyMaxActiveBlocksPerMultiprocessor(&per_cu, (const void*)mega, NTHR, LDS_BYTES) != hipSuccess || per_cu < 1) { fprintf(stderr, "kernel_launch: occupancy query says %d blocks per CU\n", per_cu); (void)hipGetLastError(); grid = -1; return; }
        grid = cus;
    }
    if (grid < 0) return;
    (void)hipMemsetAsync((char*)d_ws + WS_CTL, 0, 262144, stream);
    Args a{};
    a.xp = (const float*)d_in[0]; a.xs = (const float*)d_in[1]; a.w_in_even = (const float*)d_in[2]; a.wuf = (const float*)d_in[3]; a.bfw = (const float*)d_in[4];
    a.wub = (const float*)d_in[5]; a.bbw = (const float*)d_in[6]; a.ng = (const float*)d_in[7]; a.sink = (const float*)d_in[8]; a.relb = (const float*)d_in[9];
    a.w_out_even = (const float*)d_in[10]; a.w_in_odd = (const float*)d_in[11]; a.cw = (const float*)d_in[12]; a.w_out_odd = (const float*)d_in[13];
    a.lng = (const float*)d_in[14]; a.lnb = (const float*)d_in[15]; a.out = (float*)d_out; a.ws = (unsigned char*)d_ws;
    hipLaunchKernelGGL(mega, dim3(grid), dim3(NTHR), LDS_BYTES, stream, a);
}
```

```cpp
#include <hip/hip_runtime.h>
#include <cstdio>

typedef unsigned short bf16_t;
typedef short bf16x8 __attribute__((ext_vector_type(8)));
typedef float f32x4 __attribute__((ext_vector_type(4)));
typedef float f32x2 __attribute__((ext_vector_type(2)));
typedef unsigned u32x4 __attribute__((ext_vector_type(4)));
typedef unsigned u32x2 __attribute__((ext_vector_type(2)));
#define LAS __attribute__((address_space(3)))
#define MFMA16(a, b, c) __builtin_amdgcn_mfma_f32_16x16x32_bf16((a), (b), (c), 0, 0, 0)
extern __shared__ __attribute__((aligned(16))) unsigned char lds_raw[];
constexpr int SLOT_OFF = 163840 - 1024;
__device__ __forceinline__ unsigned hw_slot() { return (unsigned)__builtin_amdgcn_s_getreg((5 << 11) | 4) & 63u; }
__device__ __forceinline__ int tid_now() {
    const int wid = __builtin_amdgcn_readfirstlane((int)((volatile LAS unsigned*)((LAS unsigned char*)lds_raw + SLOT_OFF))[hw_slot()]);
    return wid * 64 + (int)__lane_id();
}

constexpr int DM = 1024, NTOK = 49152, NPROMPT = 32768, LP = 16384, LS = 4096;
constexpr int UP = 3584;
constexpr int C_QA = 0, C_KA = 512, C_VA = 1024, C_ZA = 1536, C_QB = 2048, C_KB = 2560, C_VB = 2688, C_ZB = 2816, C_GD = 3328;
constexpr int EVEN_IN = 3360, ODD_IN = 4096;
constexpr float DN_ALPHA = 1.41421356237309515f;
constexpr float LN_EPS = 1e-5f, NORM_EPS = 1e-6f;

constexpr size_t MiB = 1u << 20;
constexpr size_t WS_CTL = 0, WS_W1T = 1 * MiB, WS_W2T = 8 * MiB, WS_W3T = 10 * MiB, WS_W4T = 18 * MiB, WS_STAT1 = 20 * MiB, WS_MR1 = 26 * MiB, WS_DEC = 27 * MiB, WS_GATE = 27 * MiB + 768 * 1024,
                 WS_XB = 28 * MiB  , WS_U = 124 * MiB, WS_ST = 460 * MiB, WS_END = 508 * MiB;
constexpr size_t WS_X1B = WS_U, WS_P = WS_U + 96 * MiB, WS_S = WS_U + 192 * MiB, WS_STAT2 = WS_U + 288 * MiB, WS_PB = WS_U + 296 * MiB, WS_SB = WS_U + 304 * MiB;

__device__ __forceinline__ float bf2f(bf16_t b) { return __uint_as_float(((unsigned)b) << 16); }
typedef __bf16 nbf16x2 __attribute__((ext_vector_type(2)));
__device__ __forceinline__ bf16_t f2bf(float f) { return __builtin_bit_cast(bf16_t, (__bf16)f); }
__device__ __forceinline__ unsigned pk2(float lo, float hi) { return __builtin_bit_cast(unsigned, __builtin_convertvector((f32x2){lo, hi}, nbf16x2)); }
__device__ __forceinline__ float fexp2(float x) { return __builtin_amdgcn_exp2f(x); }
__device__ __forceinline__ float fexp(float x) { return __builtin_amdgcn_exp2f(x * 1.4426950408889634f); }
__device__ __forceinline__ float flog2(float x) { return __builtin_amdgcn_logf(x); }
__device__ __forceinline__ float silu(float x) { return x * __builtin_amdgcn_rcpf(1.0f + fexp(-x)); }
__device__ __forceinline__ float wave_sum(float v) {
#pragma unroll
    for (int o = 1; o < 64; o <<= 1) v += __shfl_xor(v, o);
    return v;
}
__device__ __forceinline__ float wave_max(float v) {
#pragma unroll
    for (int o = 1; o < 64; o <<= 1) v = fmaxf(v, __shfl_xor(v, o));
    return v;
}
__device__ __forceinline__ void seq_of(int row, int& s0, int& L) {
    if (row < NPROMPT) { L = LP; s0 = row & ~(LP - 1); } else { L = LS; s0 = NPROMPT + ((row - NPROMPT) & ~(LS - 1)); }
}

namespace pg8 {
constexpr int BM = 256, BK = 64, HALF = 128, HTB = HALF * BK * 2, STAGE_BYTES = 8 * HTB, NXCD = 8, WGM = 8;
__host__ __device__ __forceinline__ int lds_byte(int r, int c) { const int st = (r >> 4) * 2 + (c >> 5), rr = r & 15, cc = c & 31, ob = rr * 64 + cc * 2; return st * 1024 + (ob ^ (((ob >> 9) & 1) << 5)); }
__host__ __device__ __forceinline__ void stage_rc(int b, int& R, int& C) { const int st = b / 1024, sb = b % 1024, swz = sb ^ (((sb >> 9) & 1) << 5); R = (st >> 1) * 16 + swz / 64; C = (st & 1) * 32 + (swz % 64) / 2; }
__host__ __device__ __forceinline__ int perm32(int rho) { const int n = rho >> 4, i = rho & 15; return 8 * (i >> 2) + 4 * n + (i & 3); }
struct Unit { int pm, pn; };
struct Gemm { const bf16_t* A; const bf16_t* Bt; int M, N, K, pad; };
struct StaticOrder {
    int nM, nN, nwg, G, c;
    __host__ __device__ void init(int M, int N, int G_, int c_) { nM = M / BM; nN = N / BM; nwg = nM * nN; G = G_; c = c_; }
    __host__ __device__ bool next(int i, Unit& u) const {
        const long L = (long)i * G + c; if (L >= nwg) return false;
        int wgid = (int)L; { const int q = nwg / NXCD, r = nwg % NXCD, xcd = wgid % NXCD, off = wgid / NXCD; wgid = (xcd < r ? xcd * (q + 1) : r * (q + 1) + (xcd - r) * q) + off; }
        const int nig = WGM * nN, gid = wgid / nig, fm = gid * WGM, gsz = (nM - fm) < WGM ? (nM - fm) : WGM;
        u.pm = fm + ((wgid % nig) % gsz); u.pn = (wgid % nig) / gsz; return true;
    }
    __device__ __forceinline__ void a_ready(const Unit&) const {}
    __device__ __forceinline__ void done(const Unit&) const {}
};

template <class Epi, class Sched>
__device__ __forceinline__ void gemm_phase(LAS unsigned char* lds, const Gemm g, const Sched& S, const Epi& E) {
    int tid = tid_now(); asm volatile("" : "+v"(tid));
    const int wid = __builtin_amdgcn_readfirstlane(tid >> 6), lane = tid & 63, wr = wid >> 2, wc = wid & 3, fr = lane & 15, fq = lane >> 4;
    const int K = g.K, nt = K / BK;
    unsigned voffA[2], voffB[2];
#pragma unroll
    for (int i = 0; i < 2; ++i) { int R, C; stage_rc(tid * 16 + i * 8192, R, C); const int Rb = Epi::PERM ? ((R & ~31) + perm32(R & 31)) : R;
        voffA[i] = (unsigned)(R * K + C) * 2u; voffB[i] = (unsigned)(Rb * K + C) * 2u; }
    const size_t kstep = (size_t)(BK * 2);
    const size_t hstep = (size_t)HALF * K * 2;
    const size_t tstep = 2 * hstep;
    const unsigned ldsw = (unsigned)wid * 1024u;
    const int aoff = lds_byte(wr * 64 + fr, fq * 8), boff = lds_byte(wc * 32 + fr, fq * 8);
#define PG8_SA(b, h) (((b) * 2 + (h)) * HTB)
#define PG8_SB(b, h) ((4 + (b) * 2 + (h)) * HTB)
#define PG8_STAGE(bufoff, gbase, voff) do { _Pragma("unroll") for (int _i = 0; _i < 2; ++_i) \
        __builtin_amdgcn_global_load_lds((const unsigned*)((const char*)(gbase) + (voff)[_i]), (LAS unsigned*)(lds + (bufoff) + ldsw + _i * 8192), 16, 0, 0); } while (0)
#define PG8_LDA(dst, b, h) do { _Pragma("unroll") for (int m = 0; m < 4; ++m) _Pragma("unroll") for (int k = 0; k < 2; ++k) dst[m][k] = *(const LAS bf16x8*)(lds + PG8_SA(b, h) + aoff + m * 2048 + k * 1024); } while (0)
#define PG8_LDB(dst, b, h) do { _Pragma("unroll") for (int n = 0; n < 2; ++n) _Pragma("unroll") for (int k = 0; k < 2; ++k) dst[n][k] = *(const LAS bf16x8*)(lds + PG8_SB(b, h) + boff + n * 2048 + k * 1024); } while (0)
#define PG8_MMA(ai, bj, At, Bt) do { __builtin_amdgcn_s_setprio(1); _Pragma("unroll") for (int m = 0; m < 4; ++m) _Pragma("unroll") for (int n = 0; n < 2; ++n) _Pragma("unroll") for (int k = 0; k < 2; ++k) \
        acc[ai][bj][m][n] = __builtin_amdgcn_mfma_f32_16x16x32_bf16(Bt[n][k], At[m][k], acc[ai][bj][m][n], 0, 0, 0); __builtin_amdgcn_s_setprio(0); } while (0)
#define PG8_WAIT_V(n) asm volatile("s_waitcnt vmcnt(" #n ")" ::: "memory")
#define PG8_WAIT_L(n) asm volatile("s_waitcnt lgkmcnt(" #n ")" ::: "memory")
#define PG8_BAR __builtin_amdgcn_s_barrier()
#define PG8_SCHED __builtin_amdgcn_sched_barrier(0)
    Unit cur, nxt; int ui = 0;
    if (!S.next(0, cur)) return;
    f32x4 acc[2][2][4][2];
#pragma unroll
    for (int a = 0; a < 2; ++a)
#pragma unroll
        for (int b = 0; b < 2; ++b)
#pragma unroll
            for (int m = 0; m < 4; ++m)
#pragma unroll
                for (int n = 0; n < 2; ++n) acc[a][b][m][n] = (f32x4){0.f, 0.f, 0.f, 0.f};
    bf16x8 At[4][2], B0[2][2], B1[2][2];
    const char* cA = (const char*)g.A + (size_t)cur.pm * tstep; const char* cB = (const char*)g.Bt + (size_t)cur.pn * tstep;
    S.a_ready(cur);
    PG8_STAGE(PG8_SB(0, 0), cB, voffB); PG8_STAGE(PG8_SA(0, 0), cA, voffA); PG8_STAGE(PG8_SB(0, 1), cB + hstep, voffB); PG8_STAGE(PG8_SA(0, 1), cA + hstep, voffA);
    if (wr == 1) PG8_BAR;
    PG8_WAIT_V(4); PG8_BAR;
    PG8_STAGE(PG8_SB(1, 0), cB + kstep, voffB); PG8_STAGE(PG8_SA(1, 0), cA + kstep, voffA); PG8_STAGE(PG8_SB(1, 1), cB + hstep + kstep, voffB);
    PG8_WAIT_V(6); PG8_BAR;
    for (;;) {
        const bool has_next = S.next(ui + 1, nxt);
        const char* nA = has_next ? (const char*)g.A + (size_t)nxt.pm * tstep : cA; const char* nB = has_next ? (const char*)g.Bt + (size_t)nxt.pn * tstep : cB;
        for (int t = 0; t < nt; t += 2) {
            const bool last = (t == nt - 2);
            const char* a1 = cA + (size_t)(t + 1) * kstep;
            const char* a2 = last ? nA : cA + (size_t)(t + 2) * kstep; const char* b2 = last ? nB : cB + (size_t)(t + 2) * kstep;
            const char* a3 = a2 + kstep; const char* b3 = b2 + kstep;
            if (last && has_next) S.a_ready(nxt);
            PG8_LDB(B0, 0, 0); PG8_SCHED; PG8_LDA(At, 0, 0); PG8_STAGE(PG8_SA(1, 1), a1 + hstep, voffA);
            PG8_WAIT_L(8); PG8_BAR; PG8_WAIT_L(0); PG8_MMA(0, 0, At, B0); PG8_BAR; PG8_SCHED;
            PG8_LDB(B1, 0, 1); PG8_STAGE(PG8_SB(0, 0), b2, voffB);
            PG8_BAR; PG8_WAIT_L(0); PG8_MMA(0, 1, At, B1); PG8_BAR;
            PG8_LDA(At, 0, 1); PG8_STAGE(PG8_SA(0, 0), a2, voffA);
            PG8_BAR; PG8_WAIT_L(0); PG8_MMA(1, 0, At, B0); PG8_BAR; PG8_SCHED;
            PG8_STAGE(PG8_SB(0, 1), b2 + hstep, voffB);
            PG8_WAIT_V(6); PG8_BAR; PG8_MMA(1, 1, At, B1); PG8_BAR;
            PG8_LDB(B0, 1, 0); PG8_SCHED; PG8_LDA(At, 1, 0); PG8_STAGE(PG8_SA(0, 1), a2 + hstep, voffA);
            PG8_WAIT_L(8); PG8_BAR; PG8_WAIT_L(0); PG8_MMA(0, 0, At, B0); PG8_BAR; PG8_SCHED;
            PG8_LDB(B1, 1, 1); PG8_STAGE(PG8_SB(1, 0), b3, voffB);
            PG8_BAR; PG8_WAIT_L(0); PG8_MMA(0, 1, At, B1); PG8_BAR;
            PG8_LDA(At, 1, 1); PG8_STAGE(PG8_SA(1, 0), a3, voffA);
            PG8_BAR; PG8_WAIT_L(0); PG8_MMA(1, 0, At, B0); PG8_BAR; PG8_SCHED;
            PG8_STAGE(PG8_SB(1, 1), b3 + hstep, voffB);
            PG8_WAIT_V(6); PG8_BAR; PG8_MMA(1, 1, At, B1); PG8_BAR;
        }
        if constexpr (Epi::REALIGN) { if (wr == 0) PG8_BAR; }
        E(acc, cur, wr, wc, fr, fq); S.done(cur);
        if constexpr (Epi::REALIGN) { if (wr == 1) PG8_BAR; }
        if (!has_next) break;
#pragma unroll
        for (int a = 0; a < 2; ++a)
#pragma unroll
            for (int b = 0; b < 2; ++b)
#pragma unroll
                for (int m = 0; m < 4; ++m)
#pragma unroll
                    for (int n = 0; n < 2; ++n) acc[a][b][m][n] = (f32x4){0.f, 0.f, 0.f, 0.f};
        cur = nxt; cA = nA; cB = nB; ++ui;
    }
    PG8_WAIT_V(0);
    if (wr == 0) PG8_BAR;
    PG8_BAR;
#undef PG8_SA
#undef PG8_SB
#undef PG8_STAGE
#undef PG8_LDA
#undef PG8_LDB
#undef PG8_MMA
#undef PG8_WAIT_V
#undef PG8_WAIT_L
#undef PG8_BAR
#undef PG8_SCHED
}
}

struct EpiU {
    static constexpr bool PERM = true, AFTER_DRAIN = false, REALIGN = false;
    bf16_t* O;
    __device__ __forceinline__ void operator()(const f32x4 (&acc)[2][2][4][2], const pg8::Unit& u, int wr, int wc, int fr, int fq) const {
        const int row0 = u.pm * 256 + wr * 64 + fr, col0 = u.pn * 256 + wc * 32 + 8 * fq;
#pragma unroll
        for (int ai = 0; ai < 2; ++ai)
#pragma unroll
            for (int m = 0; m < 4; ++m) { bf16_t* rowp = O + (size_t)(row0 + ai * 128 + m * 16) * UP + col0;
#pragma unroll
                for (int bj = 0; bj < 2; ++bj) { const f32x4 v0 = acc[ai][bj][m][0], v1 = acc[ai][bj][m][1];
                    u32x4 w; w.x = pk2(v0[0], v0[1]); w.y = pk2(v0[2], v0[3]); w.z = pk2(v1[0], v1[1]); w.w = pk2(v1[2], v1[3]);
                    *(u32x4*)(rowp + bj * 128) = w; } }
    }
};
template <int LAYER> struct EpiY {
    static constexpr bool PERM = false, AFTER_DRAIN = false, REALIGN = false;
    const float* xp; const float* xs; float* Y; f32x2* stat; const f32x2* mr; const float* lg; const float* lb;
    __device__ __forceinline__ void operator()(const f32x4 (&acc)[2][2][4][2], const pg8::Unit& u, int wr, int wc, int fr, int fq) const {
        const int col0 = u.pn * 256 + wc * 32 + 4 * fq;
        f32x4 gv[2][2], bv[2][2];
        if (LAYER == 1) {
#pragma unroll
            for (int bj = 0; bj < 2; ++bj)
#pragma unroll
                for (int n = 0; n < 2; ++n) { gv[bj][n] = *(const f32x4*)(lg + col0 + bj * 128 + n * 16); bv[bj][n] = *(const f32x4*)(lb + col0 + bj * 128 + n * 16); }
        }
#pragma unroll
        for (int ai = 0; ai < 2; ++ai)
#pragma unroll
            for (int m = 0; m < 4; ++m) {
                const int row = u.pm * 256 + ai * 128 + wr * 64 + m * 16 + fr;
                const float* rp; f32x2 mrv = (f32x2){0.f, 1.f};
                if (LAYER == 0) rp = (row < NPROMPT) ? xp + (size_t)row * DM : xs + (size_t)(row - NPROMPT) * DM;
                else { rp = Y + (size_t)row * DM; mrv = mr[row]; }
                float* yp = Y + (size_t)row * DM;
                float s = 0.f, q = 0.f;
#pragma unroll
                for (int bj = 0; bj < 2; ++bj)
#pragma unroll
                    for (int n = 0; n < 2; ++n) {
                        const int c = col0 + bj * 128 + n * 16;
                        f32x4 r = *(const f32x4*)(rp + c);
                        if (LAYER == 1) r = (r - mrv.x) * mrv.y * gv[bj][n] + bv[bj][n];
                        const f32x4 y = r * DN_ALPHA + acc[ai][bj][m][n];
                        *(f32x4*)(yp + c) = y;
                        s += (y[0] + y[1]) + (y[2] + y[3]); q += (y[0] * y[0] + y[1] * y[1]) + (y[2] * y[2] + y[3] * y[3]);
                    }
                s += __shfl_xor(s, 16); s += __shfl_xor(s, 32); q += __shfl_xor(q, 16); q += __shfl_xor(q, 32);
                if (fq == 0) stat[(size_t)row * 16 + u.pn * 4 + wc] = (f32x2){s, q};
            }
    }
};
#define RLX_AGENT __ATOMIC_RELAXED, __HIP_MEMORY_SCOPE_AGENT
template <int LAYER> struct EpiLN {
    static constexpr bool PERM = true, AFTER_DRAIN = false, REALIGN = true;
    unsigned char* ws; float* Of; const float* lg; const float* lb;
    __device__ __forceinline__ void operator()(f32x4 (&acc)[2][2][4][2], const pg8::Unit& u, int wr, int wc, int fr, int fq) const {
        unsigned char* w2 = ws; asm volatile("" : "+s"(w2));
        const bf16_t* R = (const bf16_t*)(w2 + (LAYER == 0 ? WS_XB : WS_X1B)); bf16_t* Ob = (bf16_t*)(w2 + WS_X1B);
        unsigned long long* xbuf = (unsigned long long*)(w2 + WS_STAT1 + (LAYER == 0 ? 0 : 3 * MiB));
        unsigned* cnt = (unsigned*)(w2 + WS_CTL) + 16384 + LAYER * 192 * 64;
        const int col0 = u.pn * 256 + wc * 32 + 8 * fq, rowb = u.pm * 256 + wr * 64 + fr;
        LAS f32x2* part = (LAS f32x2*)((LAS unsigned char*)lds_raw + 131072);
        float ps[2][4], pq[2][4];
#pragma unroll
        for (int ai = 0; ai < 2; ++ai)
#pragma unroll
            for (int m = 0; m < 4; ++m) {
                const bf16_t* rp = R + (size_t)(rowb + ai * 128 + m * 16) * DM + col0;
                float s = 0.f, q = 0.f;
#pragma unroll
                for (int bj = 0; bj < 2; ++bj) {
                    const u32x4 rw = *(const u32x4*)(rp + bj * 128);
                    f32x4 r0 = (f32x4){__uint_as_float(rw.x << 16), __uint_as_float(rw.x & 0xffff0000u), __uint_as_float(rw.y << 16), __uint_as_float(rw.y & 0xffff0000u)};
                    f32x4 r1 = (f32x4){__uint_as_float(rw.z << 16), __uint_as_float(rw.z & 0xffff0000u), __uint_as_float(rw.w << 16), __uint_as_float(rw.w & 0xffff0000u)};
                    const f32x4 v0 = r0 * DN_ALPHA + acc[ai][bj][m][0], v1 = r1 * DN_ALPHA + acc[ai][bj][m][1];
                    acc[ai][bj][m][0] = v0; acc[ai][bj][m][1] = v1;
                    s += ((v0[0] + v0[1]) + (v0[2] + v0[3])) + ((v1[0] + v1[1]) + (v1[2] + v1[3]));
                    q += ((v0[0] * v0[0] + v0[1] * v0[1]) + (v0[2] * v0[2] + v0[3] * v0[3])) + ((v1[0] * v1[0] + v1[1] * v1[1]) + (v1[2] * v1[2] + v1[3] * v1[3]));
                }
                s += __shfl_xor(s, 16); s += __shfl_xor(s, 32); q += __shfl_xor(q, 16); q += __shfl_xor(q, 32);
                if (fq == 0) part[(ai * 128 + wr * 64 + m * 16 + fr) * 4 + wc] = (f32x2){s, q};
            }
        const int tid = (wr * 4 + wc) * 64 + fq * 16 + fr;
        asm volatile("s_waitcnt lgkmcnt(0)" ::: "memory"); __builtin_amdgcn_s_barrier(); asm volatile("" ::: "memory");
        if (tid < 256) {
            const LAS f32x4* pp = (const LAS f32x4*)(part + tid * 4); const f32x4 a01 = pp[0], a23 = pp[1];
            const float s = (a01[0] + a01[2]) + (a23[0] + a23[2]), q = (a01[1] + a01[3]) + (a23[1] + a23[3]);
            __hip_atomic_store(xbuf + (size_t)(u.pm * 256 + tid) * 4 + u.pn, ((unsigned long long)__float_as_uint(q) << 32) | __float_as_uint(s), RLX_AGENT);
        }
        asm volatile("s_waitcnt vmcnt(0)" ::: "memory"); __builtin_amdgcn_s_barrier(); asm volatile("" ::: "memory");
        unsigned* c = cnt + 64 * u.pm;
        if (tid == 0) __hip_atomic_fetch_add(c, 1u, RLX_AGENT);
        if (tid < 64) { unsigned spins = 0;
          while ((unsigned)__builtin_amdgcn_readfirstlane(__hip_atomic_load(c, RLX_AGENT)) < 4u) { __builtin_amdgcn_s_sleep(1); if (++spins > (1u << 16)) break; }
          __builtin_amdgcn_fence(__ATOMIC_ACQUIRE, "agent"); asm volatile("s_waitcnt vmcnt(0)" ::: "memory"); }
        __builtin_amdgcn_s_barrier(); asm volatile("" ::: "memory");
#pragma unroll
        for (int ai = 0; ai < 2; ++ai)
#pragma unroll
            for (int m = 0; m < 4; ++m) {
                const f32x4* sp = (const f32x4*)(xbuf + (size_t)(rowb + ai * 128 + m * 16) * 4);
                const f32x4 a01 = sp[0], a23 = sp[1];
                const float s = (a01[0] + a01[2]) + (a23[0] + a23[2]), q = (a01[1] + a01[3]) + (a23[1] + a23[3]);
                const float mean = s * (1.0f / DM), var = q * (1.0f / DM) - mean * mean;
                ps[ai][m] = mean; pq[ai][m] = rsqrtf(fmaxf(var, 0.f) + LN_EPS);
            }
#pragma unroll
        for (int bj = 0; bj < 2; ++bj) {
            const f32x4 g0 = *(const f32x4*)(lg + col0 + bj * 128), g1 = *(const f32x4*)(lg + col0 + bj * 128 + 4), b0 = *(const f32x4*)(lb + col0 + bj * 128), b1 = *(const f32x4*)(lb + col0 + bj * 128 + 4);
#pragma unroll
            for (int ai = 0; ai < 2; ++ai)
#pragma unroll
                for (int m = 0; m < 4; ++m) {
                    const int row = rowb + ai * 128 + m * 16; const float mean = ps[ai][m], rstd = pq[ai][m];
                    const f32x4 o0 = (acc[ai][bj][m][0] - mean) * rstd * g0 + b0, o1 = (acc[ai][bj][m][1] - mean) * rstd * g1 + b1;
                    if (LAYER == 0) { u32x4 w; w.x = pk2(o0[0], o0[1]); w.y = pk2(o0[2], o0[3]); w.z = pk2(o1[0], o1[1]); w.w = pk2(o1[2], o1[3]); *(u32x4*)(Ob + (size_t)row * DM + col0 + bj * 128) = w; }
                    else { float* op = Of + (size_t)row * DM + col0 + bj * 128; __builtin_nontemporal_store(o0, (f32x4*)op); __builtin_nontemporal_store(o1, (f32x4*)(op + 4)); }
                }
        }
    }
};
struct EpiPS {
    static constexpr bool PERM = true, AFTER_DRAIN = false, REALIGN = false;
    bf16_t* P; bf16_t* S;
    __device__ __forceinline__ void operator()(const f32x4 (&acc)[2][2][4][2], const pg8::Unit& u, int wr, int wc, int fr, int fq) const {
        const int row0 = u.pm * 256 + wr * 64 + fr, off = (wc & 1) * 32 + 8 * fq;
        bf16_t* dst = (wc < 2 ? S : P) + u.pn * 64 + off;
#pragma unroll
        for (int ai = 0; ai < 2; ++ai)
#pragma unroll
            for (int m = 0; m < 4; ++m) {
                float o[8];
#pragma unroll
                for (int n = 0; n < 2; ++n)
#pragma unroll
                    for (int j = 0; j < 4; ++j) { const float a = acc[ai][0][m][n][j], b = acc[ai][1][m][n][j];
                        o[4 * n + j] = (wc < 2) ? silu(b) * a : a * b; }
                u32x4 w; w.x = pk2(o[0], o[1]); w.y = pk2(o[2], o[3]); w.z = pk2(o[4], o[5]); w.w = pk2(o[6], o[7]);
                *(u32x4*)(dst + (size_t)(row0 + ai * 128 + m * 16) * DM) = w;
            }
    }
};

template <int CTRL> __device__ __forceinline__ float dpp_f(float x);
struct EpiG {
    static constexpr bool PERM = true, AFTER_DRAIN = false, REALIGN = false;
    unsigned char* ws; const float* cw;
    __device__ __forceinline__ void operator()(const f32x4 (&acc)[2][2][4][2], const pg8::Unit& u, int wr, int wc, int fr, int fq) const {
        unsigned char* w2 = ws; asm volatile("" : "+s"(w2));
        bf16_t* G = (bf16_t*)(w2 + WS_XB); float* Pb = (float*)(w2 + WS_PB); float* Sb = (float*)(w2 + WS_SB);
        const int ch0 = u.pn * 64 + 16 * wc + 4 * fq;
        const f32x4 c0 = *(const f32x4*)(cw + ch0), c1 = *(const f32x4*)(cw + 1024 + ch0), c2 = *(const f32x4*)(cw + 2048 + ch0);
#pragma unroll
        for (int ai = 0; ai < 2; ++ai) {
            f32x4 P[4], S[4];
#pragma unroll
            for (int m = 0; m < 4; ++m)
#pragma unroll
                for (int j = 0; j < 4; ++j) { P[m][j] = acc[ai][0][m][1][j] * acc[ai][1][m][1][j]; S[m][j] = silu(acc[ai][1][m][0][j]) * acc[ai][0][m][0][j]; }
            const int row0 = u.pm * 256 + ai * 128 + wr * 64 + fr;
#pragma unroll
            for (int m = 0; m < 4; ++m) {
                float o[4];
#pragma unroll
                for (int j = 0; j < 4; ++j) {
                    float pr = dpp_f<0x111>(P[m][j]);
                    if (m > 0) { const float t = dpp_f<0x121>(P[m - 1][j]); pr = fr == 0 ? t : pr; }
                    float nx = dpp_f<0x101>(P[m][j]);
                    if (m < 3) { const float t = dpp_f<0x12F>(P[m + 1][j]); nx = fr == 15 ? t : nx; }
                    o[j] = S[m][j] * (c0[j] * pr + c1[j] * P[m][j] + c2[j] * nx);
                }
                u32x2 w; w.x = pk2(o[0], o[1]); w.y = pk2(o[2], o[3]);
                *(u32x2*)(G + (size_t)(row0 + 16 * m) * DM + ch0) = w;
            }
            const int blk = u.pm * 4 + ai * 2 + wr;
            if (fr == 0) { *(f32x4*)(Pb + (size_t)(blk * 2) * 1024 + ch0) = P[0]; *(f32x4*)(Sb + (size_t)(blk * 2) * 1024 + ch0) = S[0]; }
            if (fr == 15) { *(f32x4*)(Pb + (size_t)(blk * 2 + 1) * 1024 + ch0) = P[3]; *(f32x4*)(Sb + (size_t)(blk * 2 + 1) * 1024 + ch0) = S[3]; }
        }
    }
};
#define XB_TMO      128
#define XB_XCNT(j)  (256  + 64 * (j))
#define XB_XSUB(j)  (1280 + 64 * (j))
#define XB_XGEN(j)  (2304 + 64 * (j))
#define XB_TOP      3328
#define XB_TOPGEN   3392
#define XCD_BAR_WORDS 3456
#define XB_SPIN_CAP (1u << 27)
__device__ __forceinline__ unsigned xb_ld(unsigned* p)              { return __hip_atomic_load(p, __ATOMIC_RELAXED, __HIP_MEMORY_SCOPE_AGENT); }
__device__ __forceinline__ unsigned xb_add(unsigned* p, unsigned v) { return __hip_atomic_fetch_add(p, v, __ATOMIC_RELAXED, __HIP_MEMORY_SCOPE_AGENT); }
__device__ __forceinline__ unsigned xb_xcc_id() { return (unsigned)__builtin_amdgcn_s_getreg((3 << 11) | 20) & 0xFu; }
#define XB_SPIN(cond, bar) do { unsigned _sp = 0; while (cond) { __builtin_amdgcn_s_sleep(1); \
    if ((++_sp & 255u) == 0u) { if (xb_ld(&(bar)[XB_TMO])) break; if (_sp > XB_SPIN_CAP) { atomicAdd(&(bar)[XB_TMO], 1u); break; } } } } while (0)
struct XcdBarrier { unsigned* bar; unsigned x; volatile LAS unsigned* st; };
__device__ __forceinline__ XcdBarrier xcd_barrier_post(unsigned* bar, volatile LAS unsigned* st) {
    XcdBarrier b; b.bar = bar; b.x = xb_xcc_id(); b.st = st;
    if (tid_now() == 0) (void)xb_add(&bar[XB_XCNT(b.x)], 1u);
    return b;
}
__device__ __forceinline__ void xcd_barrier_complete(unsigned* bar, unsigned x, unsigned& nloc, unsigned& nx) {
    const unsigned G = gridDim.x * gridDim.y * gridDim.z;
    unsigned sum, cnt, mine, sp = 0u;
    for (;;) {
        sum = 0u; cnt = 0u; mine = 0u;
#pragma unroll
        for (unsigned j = 0; j < 16; ++j) { const unsigned c = xb_ld(&bar[XB_XCNT(j)]); sum += c; cnt += (c > 0u) ? 1u : 0u; mine = (j == x) ? c : mine; }
        if (sum == G) break;
        __builtin_amdgcn_s_sleep(1);
        if ((++sp & 255u) == 0u) { if (xb_ld(&bar[XB_TMO])) break; if (sp > XB_SPIN_CAP) { atomicAdd(&bar[XB_TMO], 1u); break; } }
    }
    nloc = mine > 0u ? mine : 1u; nx = cnt > 0u ? cnt : 1u;
}
__device__ __forceinline__ void xcd_barrier(const XcdBarrier& b) {
    asm volatile("s_waitcnt vmcnt(0)" ::: "memory");
    __syncthreads();
    if (tid_now() == 0) {
        unsigned* bar = b.bar;
        __builtin_amdgcn_s_waitcnt(0);
        unsigned nloc = b.st[0], nx = b.st[1];
        if (nloc == 0u) { xcd_barrier_complete(bar, b.x, nloc, nx); b.st[0] = nloc; b.st[1] = nx; }
        const unsigned old = xb_add(&bar[XB_XSUB(b.x)], 1u);
        const unsigned gen = old / nloc;
        if (old + 1u == (gen + 1u) * nloc) {
            __builtin_amdgcn_fence(__ATOMIC_RELEASE, "agent");
            asm volatile("s_waitcnt vmcnt(0)" ::: "memory");
            const unsigned og = xb_add(&bar[XB_TOP], 1u);
            const unsigned tg = og / nx;
            if (og + 1u == (tg + 1u) * nx) xb_add(&bar[XB_TOPGEN], 1u);
            else XB_SPIN(xb_ld(&bar[XB_TOPGEN]) == tg, bar);
            __builtin_amdgcn_fence(__ATOMIC_ACQUIRE, "agent");
            xb_add(&bar[XB_XGEN(b.x)], 1u);
            asm volatile("s_waitcnt vmcnt(0)" ::: "memory");
        } else {
            XB_SPIN(xb_ld(&bar[XB_XGEN(b.x)]) == gen, bar);
            __builtin_amdgcn_fence(__ATOMIC_ACQUIRE, "agent");
            asm volatile("s_waitcnt vmcnt(0)" ::: "memory");
        }
    }
    __syncthreads();
}

struct Args {
    const float *xp, *xs, *w_in_even, *wuf, *bfw, *wub, *bbw, *ng, *sink, *relb, *w_out_even, *w_in_odd, *cw, *w_out_odd, *lng, *lnb;
    float* out; unsigned char* ws;
};
constexpr int NTHR = 512;
constexpr int LDS_BYTES = 163840, MISC_OFF = 163840 - 512;

template <int MODE> __device__ __forceinline__ int wmap(int n, float& sc) {
    sc = 1.f;
    if (MODE == 0) return n;
    if (MODE == 1) {
        if (n < 512) sc = 0.08838834764831845f;
        if (n >= C_QB && n < C_KB) sc = 0.125f;
        if (n < 2048) return n;
        if (n < C_GD) return n + 32;
        if (n < C_GD + 32) return n - C_GD + 2048;
        return -1;
    }
    const int c = n & 255, bj = (c >> 7) & 1, wc = (c >> 5) & 3, fq = (c >> 3) & 3, nn = (c >> 2) & 1, j = c & 3, q = 2 * bj + nn, ch = (n >> 8) * 64 + 16 * wc + 4 * fq + j;
    const int base = q == 0 ? 0 : (q == 1 ? 1024 : (q == 2 ? 3072 : 2048));
    return base + ch;
}
template <int MODE> __device__ __forceinline__ void wconv_item(const float* __restrict__ W, int Nsrc, bf16_t* __restrict__ Wt, int Ndst, int item, LAS float* tile, int t256) {
    const int nb = item % (Ndst / 64), kb = item / (Ndst / 64), n0 = nb * 64, k0 = kb * 64;
    const int tx = t256 & 63, ty = t256 >> 6;
    float sc; const int src = wmap<MODE>(n0 + tx, sc);
    for (int kk = ty; kk < 64; kk += 4) tile[kk * 65 + tx] = src >= 0 ? W[(size_t)(k0 + kk) * Nsrc + src] * sc : 0.f;
    __syncthreads();
    for (int nn = ty; nn < 64; nn += 4) Wt[(size_t)(n0 + nn) * 1024 + k0 + tx] = f2bf(tile[tx * 65 + nn]);
    __syncthreads();
}
__device__ __forceinline__ void build_gate_tables(const Args& a);
__device__ __forceinline__ void phase_convert(const Args& a, LAS unsigned char* lds) {
    unsigned char* ws = a.ws;
    bf16_t* W1t = (bf16_t*)(ws + WS_W1T); bf16_t* W2t = (bf16_t*)(ws + WS_W2T); bf16_t* W3t = (bf16_t*)(ws + WS_W3T); bf16_t* W4t = (bf16_t*)(ws + WS_W4T);
    const int half = tid_now() >> 8, t256 = tid_now() & 255;
    LAS float* tile = (LAS float*)lds + half * (64 * 65);
    constexpr int I1 = (C_GD / 64) * 16, I2 = 16 * 16, I3 = 64 * 16, I4 = 16 * 16, NIT = I1 + I2 + I3 + I4;
    for (int it0 = blockIdx.x * 2; it0 < NIT; it0 += gridDim.x * 2) {
        int r = it0 + half;
        if (r < I1) wconv_item<1>(a.w_in_even, EVEN_IN, W1t, C_GD, r, tile, t256);
        else if ((r -= I1) < I2) wconv_item<0>(a.w_out_even, 1024, W2t, 1024, r, tile, t256);
        else if ((r -= I2) < I3) wconv_item<2>(a.w_in_odd, ODD_IN, W3t, 4096, r, tile, t256);
        else if ((r -= I3) < I4) wconv_item<0>(a.w_out_odd, 1024, W4t, 1024, r, tile, t256);
        else { __syncthreads(); __syncthreads(); }
    }
    build_gate_tables(a);
    __syncthreads();
    {
        constexpr int WP = 1032, TP = 264;
        LAS bf16_t* wg = (LAS bf16_t*)lds; LAS bf16_t* tile0 = (LAS bf16_t*)(lds + 32 * WP * 2);
        const int tid = tid_now(), lane = tid & 63, w = tid >> 6, n = lane & 15, g = lane >> 4, rb = w & 3, ct = w >> 2;
        for (int e = tid; e < 32 * 1024; e += NTHR) { const int k = e >> 5, c = e & 31; wg[c * WP + k] = f2bf(a.w_in_even[(size_t)k * EVEN_IN + 2048 + c]); }
        bf16_t* xb = (bf16_t*)(ws + WS_XB); bf16_t* U = (bf16_t*)(ws + WS_U);
        f32x4 v[4][2];
        auto slab_load = [&](int it, int sl) {
#pragma unroll
            for (int i = 0; i < 4; ++i) { const int idx = tid + 512 * i, row = it * 64 + (idx >> 5), col = sl * 256 + 8 * (idx & 31);
                const float* src = (row < NPROMPT ? a.xp + (size_t)row * DM : a.xs + (size_t)(row - NPROMPT) * DM) + col;
                v[i][0] = __builtin_nontemporal_load((const f32x4*)src); v[i][1] = __builtin_nontemporal_load((const f32x4*)(src + 4)); } };
        const int ntrip = NTOK / 64;
        if ((int)blockIdx.x < ntrip) slab_load(blockIdx.x, 0);
        int par = 0;
        for (int it = blockIdx.x; it < ntrip; it += gridDim.x) {
            f32x4 acc = (f32x4){0.f, 0.f, 0.f, 0.f};
#pragma unroll 1
            for (int sl = 0; sl < 4; ++sl) {
                LAS bf16_t* tile = tile0 + par * (64 * TP);
#pragma unroll
                for (int i = 0; i < 4; ++i) { const int idx = tid + 512 * i, r64 = idx >> 5, c8 = idx & 31;
                    u32x4 pw; pw.x = pk2(v[i][0][0], v[i][0][1]); pw.y = pk2(v[i][0][2], v[i][0][3]); pw.z = pk2(v[i][1][0], v[i][1][1]); pw.w = pk2(v[i][1][2], v[i][1][3]);
                    *(u32x4*)(xb + (size_t)(it * 64 + r64) * DM + sl * 256 + 8 * c8) = pw;
                    *(LAS u32x4*)(tile + r64 * TP + 8 * c8) = pw; }
                { const int nsl = (sl + 1) & 3, nit = sl < 3 ? it : (it + (int)gridDim.x < ntrip ? it + (int)gridDim.x : it); slab_load(nit, nsl); }
                __syncthreads();
#pragma unroll
                for (int ks = 0; ks < 8; ++ks) {
                    const bf16x8 af = *(const LAS bf16x8*)(tile + (16 * rb + n) * TP + 32 * ks + 8 * g), bfr = *(const LAS bf16x8*)(wg + (16 * ct + n) * WP + sl * 256 + 32 * ks + 8 * g);
                    acc = MFMA16(af, bfr, acc);
                }
                par ^= 1;
            }
#pragma unroll
            for (int r = 0; r < 4; ++r) U[(size_t)(it * 64 + rb * 16 + 4 * g + r) * UP + C_GD + 16 * ct + n] = f2bf(acc[r]);
        }
        __syncthreads();
    }
}

__device__ __forceinline__ void phase_gla_naive(const Args& a, LAS unsigned char* lds, float* OF, float* OB) {
    if (blockIdx.x >= 12) return;
    const bf16_t* U = (const bf16_t*)(a.ws + WS_U);
    const int grp = tid_now() >> 7, tid = tid_now() & 127, b = blockIdx.x * 4 + grp, dir = b & 1, h = (b >> 1) & 3, s = b >> 3;
    LAS float* sq = (LAS float*)lds + grp * (3 * 16 * 128); LAS float* sk = sq + 16 * 128; LAS float* sd = sk + 16 * 128;
    const int L = s < 2 ? LP : LS, start = s < 2 ? s * LP : NPROMPT + (s - 2) * LS;
    const float* wu = dir ? a.wub : a.wuf; const float* bias = dir ? a.bbw : a.bfw; float* O = dir ? OB : OF;
    float wr[16];
#pragma unroll
    for (int r = 0; r < 16; ++r) wr[r] = wu[r * 512 + h * 128 + tid];
    const float bb = bias[h * 128 + tid];
    float S[128];
#pragma unroll
    for (int i = 0; i < 128; ++i) S[i] = 0.f;
    for (int t0 = 0; t0 < L; t0 += 16) {
        for (int tt = 0; tt < 16; ++tt) {
            const int p = t0 + tt, tok = start + (dir ? L - 1 - p : p);
            const bf16_t* ur = U + (size_t)tok * UP;
            float x = bb;
#pragma unroll
            for (int r = 0; r < 16; ++r) x += bf2f(ur[C_GD + dir * 16 + r]) * wr[r];
            const float ls = fminf(x, 0.f) - log1pf(expf(-fabsf(x)));
            sd[tt * 128 + tid] = expf(ls * (1.0f / 16.0f));
            sq[tt * 128 + tid] = bf2f(ur[C_QA + h * 128 + tid]);
            sk[tt * 128 + tid] = bf2f(ur[C_KA + h * 128 + tid]);
        }
        __syncthreads();
        for (int tt = 0; tt < 16; ++tt) {
            const int p = t0 + tt, tok = start + (dir ? L - 1 - p : p);
            const float v = bf2f(U[(size_t)tok * UP + C_VA + h * 128 + tid]);
            float acc = 0.f;
#pragma unroll
            for (int dk = 0; dk < 128; dk += 4) {
                const f32x4 d4 = *(const LAS f32x4*)&sd[tt * 128 + dk], q4 = *(const LAS f32x4*)&sq[tt * 128 + dk], k4 = *(const LAS f32x4*)&sk[tt * 128 + dk];
#pragma unroll
                for (int j = 0; j < 4; ++j) {
                    const float sdec = S[dk + j] * d4[j];
                    const float sn = sdec + k4[j] * v;
                    acc += q4[j] * (dir ? sdec : sn);
                    S[dk + j] = sn;
                }
            }
            O[(size_t)tok * 512 + h * 128 + tid] = acc;
        }
        __syncthreads();
    }
}
__device__ __forceinline__ void phase_gla_combine(const Args& a, const float* OF, const float* OB) {
    const bf16_t* U = (const bf16_t*)(a.ws + WS_U); bf16_t* ymix = (bf16_t*)((unsigned char*)a.out + 96 * MiB);
    const int lane = tid_now() & 63;
    for (int w = blockIdx.x * 8 + (tid_now() >> 6); w < NTOK * 4; w += gridDim.x * 8) {
        const int tok = w >> 2, h = w & 3;
        const size_t o = (size_t)tok * 512 + h * 128 + lane * 2;
        const float a0 = OF[o] + OB[o], a1 = OF[o + 1] + OB[o + 1];
        const float ss = wave_sum(a0 * a0 + a1 * a1);
        const float rstd = rsqrtf(ss * (1.0f / 128.0f) + NORM_EPS);
        const bf16_t* z = U + (size_t)tok * UP + C_ZA + h * 128 + lane * 2;
        const float y0 = a0 * rstd * a.ng[lane * 2] * silu(bf2f(z[0])), y1 = a1 * rstd * a.ng[lane * 2 + 1] * silu(bf2f(z[1]));
        *(unsigned*)(ymix + (size_t)tok * DM + h * 128 + lane * 2) = pk2(y0, y1);
    }
}
__device__ __forceinline__ int t5_bucket(int rel) {
    const int n = rel < 0 ? -rel : rel;
    int b = n < 8 ? n : (n < 12 ? 8 : (n < 16 ? 9 : (n < 23 ? 10 : (n < 32 ? 11 : (n < 46 ? 12 : (n < 64 ? 13 : (n < 91 ? 14 : 15)))))));
    return b + (rel > 0 ? 16 : 0);
}
__device__ __forceinline__ void phase_swa_naive(const Args& a, LAS unsigned char* lds) {
    const bf16_t* U = (const bf16_t*)(a.ws + WS_U); bf16_t* ymix = (bf16_t*)((unsigned char*)a.out + 96 * MiB);
    const int wv = tid_now() >> 6, lane = tid_now() & 63;
    LAS float* sq = (LAS float*)(lds + 65536) + wv * 64; LAS float* sp = (LAS float*)(lds + 65536 + 2048) + wv * 320;
    for (int w = blockIdx.x * 8 + wv; w < NTOK * 8; w += gridDim.x * 8) {
        const int tok = w >> 3, hq = w & 7, kv = hq >> 2;
        int s0, L; seq_of(tok, s0, L); const int i = tok - s0;
        sq[lane] = bf2f(U[(size_t)tok * UP + C_QB + hq * 64 + lane]);
        const float snk = a.sink[hq];
        float sc[5]; float mx = snk;
#pragma unroll
        for (int c = 0; c < 5; ++c) {
            const int jj = c * 64 + lane, j = i - 128 + jj; const bool valid = jj <= 256 && j >= 0 && j < L;
            float d = -INFINITY;
            if (valid) {
                const bf16_t* kr = U + (size_t)(s0 + j) * UP + C_KB + kv * 64; d = 0.f;
#pragma unroll
                for (int e = 0; e < 64; e += 8) { const u32x4 kk = *(const u32x4*)(kr + e);
                    d += sq[e] * __uint_as_float(kk.x << 16) + sq[e + 1] * __uint_as_float(kk.x & 0xffff0000u) + sq[e + 2] * __uint_as_float(kk.y << 16) + sq[e + 3] * __uint_as_float(kk.y & 0xffff0000u)
                       + sq[e + 4] * __uint_as_float(kk.z << 16) + sq[e + 5] * __uint_as_float(kk.z & 0xffff0000u) + sq[e + 6] * __uint_as_float(kk.w << 16) + sq[e + 7] * __uint_as_float(kk.w & 0xffff0000u); }
                d += a.relb[t5_bucket(j - i) * 8 + hq];
            }
            sc[c] = d; mx = fmaxf(mx, d);
        }
        mx = wave_max(mx);
        float den = 0.f;
#pragma unroll
        for (int c = 0; c < 5; ++c) { sc[c] = sc[c] == -INFINITY ? 0.f : __expf(sc[c] - mx); den += sc[c]; }
        den = wave_sum(den) + __expf(snk - mx);
        const float inv = 1.0f / den;
#pragma unroll
        for (int c = 0; c < 5; ++c) sp[c * 64 + lane] = sc[c] * inv;
        float o = 0.f;
        for (int jj = 0; jj <= 256; ++jj) { const int j = i - 128 + jj; if (j >= 0 && j < L) o += sp[jj] * bf2f(U[(size_t)(s0 + j) * UP + C_VB + kv * 64 + lane]); }
        const float z = bf2f(U[(size_t)tok * UP + C_ZB + hq * 64 + lane]);
        ymix[(size_t)tok * DM + 512 + hq * 64 + lane] = f2bf(o * silu(z));
    }
}
template <int FINAL>
__device__ __forceinline__ void phase_ln(float* Y, const f32x2* stat, f32x2* mr, const float* lg, const float* lb, bf16_t* xb) {
    const int lane = tid_now() & 63;
    for (int row = blockIdx.x * 8 + (tid_now() >> 6); row < NTOK; row += gridDim.x * 8) {
        f32x2 p = lane < 16 ? stat[(size_t)row * 16 + lane] : (f32x2){0.f, 0.f};
        const float s = wave_sum(p.x), q = wave_sum(p.y);
        const float mean = s * (1.0f / DM), var = q * (1.0f / DM) - mean * mean, rstd = rsqrtf(fmaxf(var, 0.f) + LN_EPS);
        if (!FINAL && lane == 0) mr[row] = (f32x2){mean, rstd};
#pragma unroll
        for (int j = 0; j < 4; ++j) {
            const int c = j * 256 + lane * 4;
            const f32x4 y = *(const f32x4*)(Y + (size_t)row * DM + c), g = *(const f32x4*)(lg + c), b = *(const f32x4*)(lb + c);
            const f32x4 o = (y - mean) * rstd * g + b;
            if (FINAL) *(f32x4*)(Y + (size_t)row * DM + c) = o;
            else { u32x2 w; w.x = pk2(o[0], o[1]); w.y = pk2(o[2], o[3]); *(u32x2*)(xb + (size_t)row * DM + c) = w; }
        }
    }
}
__device__ __forceinline__ void phase_convgate(const bf16_t* P, const bf16_t* S, const float* cw, bf16_t* G) {
    const size_t n8 = (size_t)NTOK * DM / 8;
    for (size_t i = (size_t)blockIdx.x * NTHR + tid_now(); i < n8; i += (size_t)gridDim.x * NTHR) {
        const int row = (int)(i >> 7), c = (int)(i & 127) * 8; int s0, L; seq_of(row, s0, L);
        const bool hasl = row > s0, hasr = row < s0 + L - 1;
        const u32x4 pm = *(const u32x4*)(P + (size_t)row * DM + c), sv = *(const u32x4*)(S + (size_t)row * DM + c);
        u32x4 pl = (u32x4){0, 0, 0, 0}, pr = (u32x4){0, 0, 0, 0};
        if (hasl) pl = *(const u32x4*)(P + (size_t)(row - 1) * DM + c);
        if (hasr) pr = *(const u32x4*)(P + (size_t)(row + 1) * DM + c);
        float o[8];
#pragma unroll
        for (int j = 0; j < 4; ++j) {
            const unsigned l = pl[j], m = pm[j], r = pr[j], sw = sv[j];
            const int cc = c + 2 * j;
            o[2 * j] = __uint_as_float(sw << 16) * (cw[cc] * __uint_as_float(l << 16) + cw[1024 + cc] * __uint_as_float(m << 16) + cw[2048 + cc] * __uint_as_float(r << 16));
            o[2 * j + 1] = __uint_as_float(sw & 0xffff0000u) * (cw[cc + 1] * __uint_as_float(l & 0xffff0000u) + cw[1024 + cc + 1] * __uint_as_float(m & 0xffff0000u) + cw[2048 + cc + 1] * __uint_as_float(r & 0xffff0000u));
        }
        u32x4 w; w.x = pk2(o[0], o[1]); w.y = pk2(o[2], o[3]); w.z = pk2(o[4], o[5]); w.w = pk2(o[6], o[7]);
        *(u32x4*)(G + (size_t)row * DM + c) = w;
    }
}

typedef short s16x4 __attribute__((ext_vector_type(4)));
constexpr int GL_QT = 0, GL_KT = 16384, GL_VT = 32768, GL_PT = 49152, GL_B = 57344, GL_GD = 90112, GL_TOT = 94208, GL_EBL = 96256  , GL_SSW = 97280, GL_RSTD = 99328;
constexpr int NSEG = NTOK / 256;
__device__ __forceinline__ unsigned offb(unsigned row, unsigned ch) { return 256u * row + 16u * (ch ^ (((row & 3) << 2) | ((row >> 2) & 3))); }
__device__ __forceinline__ unsigned offp(unsigned row, unsigned ch) { return 128u * row + 16u * (ch ^ (row & 7)); }
__device__ __forceinline__ unsigned rr16(unsigned lane, unsigned rb, unsigned s) { return offb((lane & 15) + 16 * rb, 4 * s + (lane >> 4)); }
__device__ __forceinline__ unsigned tr16(unsigned lane, unsigned c, unsigned ks, unsigned t) {
    const unsigned g = lane >> 4, q = (lane & 15) >> 2, p = lane & 3;
    return offb(32 * ks + 8 * g + 4 * t + q, 2 * c + (p >> 1)) + 8 * (p & 1);
}
__device__ __forceinline__ bf16x8 tr_read8(unsigned a0, unsigned a1) {
    s16x4 r0, r1;
    asm volatile("ds_read_b64_tr_b16 %0, %2\n\tds_read_b64_tr_b16 %1, %3\n\ts_waitcnt lgkmcnt(0)" : "=&v"(r0), "=&v"(r1) : "v"(a0), "v"(a1) : "memory");
    return __builtin_shufflevector(r0, r1, 0, 1, 2, 3, 4, 5, 6, 7);
}
__device__ __forceinline__ void unpack8(const u32x4 w, float (&f)[8]) {
#pragma unroll
    for (int j = 0; j < 4; ++j) { f[2 * j] = __uint_as_float(w[j] << 16); f[2 * j + 1] = __uint_as_float(w[j] & 0xffff0000u); }
}

struct GlaPre { u32x4 gd[4]; u32x4 q[2], k[2], v[2]; u32x4 wf; float wb; };
template <int MODE>
__device__ __forceinline__ void gla_prefetch(const Args& a, GlaPre& pre, int tid, int tb, int h, int dir, int stidx) {
    const bf16_t* U = (const bf16_t*)(a.ws + WS_U);
    const int lane = tid & 63, n = lane & 15, g = lane >> 4, w = tid >> 6;
#pragma unroll
    for (int it = 0; it < 4; ++it) { const int row = 16 * it + n, tok = dir ? tb + 63 - row : tb + row; pre.gd[it] = *(const u32x4*)(U + (size_t)tok * UP + C_GD + dir * 16 + 8 * (g & 1)); }
#pragma unroll
    for (int i = 0; i < 2; ++i) {
        const int idx = tid + 512 * i, row = idx >> 4, ch = idx & 15, tok = dir ? tb + 63 - row : tb + row;
        const bf16_t* ur = U + (size_t)tok * UP + h * 128 + ch * 8;
        pre.v[i] = *(const u32x4*)(ur + C_VA); pre.k[i] = *(const u32x4*)(ur + C_KA);
        if (MODE != 0) pre.q[i] = *(const u32x4*)(ur + C_QA);
    }
    pre.wf = ((const u32x4*)(a.ws + WS_GATE))[(dir * 4 + h) * 512 + tid];
    pre.wb = ((const float*)(a.ws + WS_GATE + 65536))[(dir * 4 + h) * 128 + 16 * w + n];
}
__device__ __forceinline__ bf16x8 tr_read8(LAS unsigned char* lds, unsigned a0, unsigned a1) {
    const s16x4 r0 = __builtin_amdgcn_ds_read_tr16_b64_v4i16((LAS s16x4*)(lds + a0)), r1 = __builtin_amdgcn_ds_read_tr16_b64_v4i16((LAS s16x4*)(lds + a1));
    return __builtin_shufflevector(r0, r1, 0, 1, 2, 3, 4, 5, 6, 7);
}
template <int CTRL> __device__ __forceinline__ float dpp_f(float x) { return __int_as_float(__builtin_amdgcn_update_dpp(0, __float_as_int(x), CTRL, 0xf, 0xf, true)); }
constexpr int GL_BP = 132;
template <int MODE>
__device__ __forceinline__ void gla_chunk(const Args& a, LAS unsigned char* lds, const int tb, const int h, const int dir,
                                          f32x4 (&Sacc)[8], float& lam, u32x4* stash, GlaPre& pre, const int ntb, const int nh, const int ndir, const bool first, const int par) {
    const bf16_t* U = (const bf16_t*)(a.ws + WS_U);
    int tid = tid_now(); asm volatile("" : "+v"(tid));
    const int lane = tid & 63, w = __builtin_amdgcn_readfirstlane(tid >> 6), n = lane & 15, g = lane >> 4;
    const unsigned fn = ((n & 3) << 2) | ((n >> 2) & 3);
    const unsigned base_rr = 256u * n + 16u * (g ^ fn);
    const unsigned base_c = 256u * n + 16u * ((g >> 1) ^ fn) + 8u * (g & 1);
    const unsigned base_p = 128u * n + 16u * (g ^ (n & 7));
    const unsigned trb0 = tr16(lane, 0, 0, 0), trb1 = tr16(lane, 0, 0, 1);
    GlaPre& cur = pre;
    const bf16x8 wfrag = __builtin_bit_cast(bf16x8, cur.wf); const float wbias = cur.wb;
    int prow[2], pch[2], ptok[2];
#pragma unroll
    for (int i = 0; i < 2; ++i) { const int idx = tid + 512 * i; prow[i] = idx >> 4; pch[i] = idx & 15; ptok[i] = dir ? tb + 63 - prow[i] : tb + prow[i]; }
    u32x4 st0, st1, zraw[2];
    {
        LAS float* B = (LAS float*)(lds + GL_B);
        bf16x8 vh[2], vl[2];
#pragma unroll
        for (int ks = 0; ks < 2; ++ks) {
            float vv[8];
#pragma unroll
            for (int half = 0; half < 2; ++half) {
                const f32x4 x = MFMA16(__builtin_bit_cast(bf16x8, cur.gd[2 * ks + half]), wfrag, ((f32x4){wbias, wbias, wbias, wbias}));
#pragma unroll
                for (int r = 0; r < 4; ++r) { const float xs = x[r] * 1.4426950408889634f; vv[4 * half + r] = (fminf(xs, 0.f) - flog2(1.0f + fexp2(-fabsf(xs)))) * (1.0f / 16.0f); }
            }
            u32x4 hw, lw;
#pragma unroll
            for (int q = 0; q < 4; ++q) { const unsigned hp = pk2(vv[2 * q], vv[2 * q + 1]); hw[q] = hp;
                lw[q] = pk2(vv[2 * q] - __uint_as_float(hp << 16), vv[2 * q + 1] - __uint_as_float(hp & 0xffff0000u)); }
            vh[ks] = __builtin_bit_cast(bf16x8, hw); vl[ks] = __builtin_bit_cast(bf16x8, lw);
        }
        u32x4 ta, tbm;
#pragma unroll
        for (int q = 0; q < 2; ++q) { const unsigned lo = (4 * g + 2 * q <= n) ? 0x3f80u : 0u, hi = (4 * g + 2 * q + 1 <= n) ? 0x3f800000u : 0u; ta[q] = lo | hi; ta[2 + q] = 0u; tbm[q] = 0x3f803f80u; tbm[2 + q] = lo | hi; }
        const bf16x8 TA = __builtin_bit_cast(bf16x8, ta), TB = __builtin_bit_cast(bf16x8, tbm), ONES = __builtin_bit_cast(bf16x8, ((u32x4){0x3f803f80u, 0x3f803f80u, 0x3f803f80u, 0x3f803f80u}));
        const f32x4 z4 = (f32x4){0.f, 0.f, 0.f, 0.f};
        f32x4 bt[4];
        bt[0] = MFMA16(TA, vl[0], MFMA16(TA, vh[0], z4));
        bt[1] = MFMA16(TB, vl[0], MFMA16(TB, vh[0], z4));
        const f32x4 s32 = MFMA16(ONES, vl[0], MFMA16(ONES, vh[0], z4));
        bt[2] = MFMA16(TA, vl[1], MFMA16(TA, vh[1], s32));
        bt[3] = MFMA16(TB, vl[1], MFMA16(TB, vh[1], s32));
#pragma unroll
        for (int it = 0; it < 4; ++it)
#pragma unroll
            for (int r = 0; r < 4; ++r) B[(16 * it + 4 * g + r) * GL_BP + 16 * w + n] = bt[it][r];
        if (g == 3) { ((LAS float*)(lds + GL_EBL + par * 512))[16 * w + n] = fexp2(bt[3][3]); lam += bt[3][3]; }
    }
    __syncthreads();
#pragma unroll
    for (int i = 0; i < 2; ++i) {
        const LAS f32x4* bp = (const LAS f32x4*)(lds + GL_B + (prow[i] * GL_BP + pch[i] * 8) * 4);
        const f32x4 b0 = bp[0], b1 = bp[1];
        float e[8], kf[8];
#pragma unroll
        for (int j = 0; j < 4; ++j) { e[j] = fexp2(b0[j]); e[4 + j] = fexp2(b1[j]); }
        unpack8(cur.k[i], kf);
        u32x4 kw;
#pragma unroll
        for (int j = 0; j < 4; ++j) kw[j] = pk2(kf[2 * j] * __builtin_amdgcn_rcpf(e[2 * j]), kf[2 * j + 1] * __builtin_amdgcn_rcpf(e[2 * j + 1]));
        *(LAS u32x4*)(lds + GL_KT + offb(prow[i], pch[i])) = kw;
        *(LAS u32x4*)(lds + GL_VT + offb(prow[i], pch[i])) = cur.v[i];
        if (MODE != 0) {
            float qf[8]; unpack8(cur.q[i], qf);
            u32x4 qw;
#pragma unroll
            for (int j = 0; j < 4; ++j) qw[j] = pk2(qf[2 * j] * e[2 * j], qf[2 * j + 1] * e[2 * j + 1]);
            *(LAS u32x4*)(lds + GL_QT + offb(prow[i], pch[i])) = qw;
        }
    }
    __syncthreads();
    gla_prefetch<MODE>(a, pre, tid, ntb, nh, ndir, -1);
    f32x4 Oacc[4];
    if (MODE != 0) {
        const int it = w >> 1;
#pragma unroll
        for (int jj = 0; jj < 2; ++jj) {
            const int jt = 2 * (w & 1) + jj;
            f32x4 pacc = (f32x4){0.f, 0.f, 0.f, 0.f};
            if (jt <= it) {
#pragma unroll
                for (int s = 0; s < 4; ++s) {
                    const bf16x8 qa = *(const LAS bf16x8*)(lds + GL_QT + (base_rr ^ (64u * s)) + 4096u * it);
                    const bf16x8 kb = *(const LAS bf16x8*)(lds + GL_KT + (base_rr ^ (64u * s)) + 4096u * jt); pacc = MFMA16(qa, kb, pacc); }
            }
            const int j = 16 * jt + n;
#pragma unroll
            for (int r = 0; r < 4; ++r) {
                const int i = 16 * it + 4 * g + r;
                const bool keep = (MODE == 1) ? (j <= i) : (j < i);
                *(LAS bf16_t*)(lds + GL_PT + offp(i, j >> 3) + 2 * (j & 7)) = keep ? f2bf(pacc[r]) : (bf16_t)0;
            }
            __builtin_amdgcn_sched_barrier(0);
        }
        if (first) {
#pragma unroll
            for (int kt = 0; kt < 8; ++kt) { const unsigned r0 = __float_as_uint(Sacc[kt][0]), r1 = __float_as_uint(Sacc[kt][1]);
                Sacc[kt] = (f32x4){__uint_as_float(r0 << 16), __uint_as_float(r0 & 0xffff0000u), __uint_as_float(r1 << 16), __uint_as_float(r1 & 0xffff0000u)}; }
        }
#pragma unroll
        for (int i2 = 0; i2 < 4; ++i2) Oacc[i2] = (f32x4){0.f, 0.f, 0.f, 0.f};
#pragma unroll
        for (int ks = 0; ks < 4; ++ks) {
            u32x4 pw; pw.x = pk2(Sacc[2 * ks][0], Sacc[2 * ks][1]); pw.y = pk2(Sacc[2 * ks][2], Sacc[2 * ks][3]); pw.z = pk2(Sacc[2 * ks + 1][0], Sacc[2 * ks + 1][1]); pw.w = pk2(Sacc[2 * ks + 1][2], Sacc[2 * ks + 1][3]);
            const bf16x8 sb = __builtin_bit_cast(bf16x8, pw);
            const unsigned alo = base_c ^ (64u * ks);
#pragma unroll
            for (int i2 = 0; i2 < 4; ++i2) {
                const u32x2 lo = *(const LAS u32x2*)(lds + GL_QT + 4096 * i2 + alo);
                const u32x2 hi = *(const LAS u32x2*)(lds + GL_QT + 4096 * i2 + (alo ^ 32u));
                u32x4 aw; aw.x = lo.x; aw.y = lo.y; aw.z = hi.x; aw.w = hi.y;
                Oacc[i2] = MFMA16(__builtin_bit_cast(bf16x8, aw), sb, Oacc[i2]);
            }
            __builtin_amdgcn_sched_barrier(0);
        }
        __syncthreads();
        if (MODE == 2) {
            st0 = stash[tid * 2]; st1 = stash[tid * 2 + 1];
#pragma unroll
            for (int i = 0; i < 2; ++i) zraw[i] = *(const u32x4*)(U + (size_t)ptok[i] * UP + C_ZA + h * 128 + pch[i] * 8);
        }
    }
    bf16x8 vf[2];
#pragma unroll
    for (int ks = 0; ks < 2; ++ks) vf[ks] = tr_read8(lds, GL_VT + 8192u * ks + (trb0 ^ (32u * w)), GL_VT + 8192u * ks + (trb1 ^ (32u * w)));
    if (MODE != 0) {
#pragma unroll
        for (int i2 = 0; i2 < 4; ++i2)
#pragma unroll
            for (int ks = 0; ks < 2; ++ks) {
                if (ks <= (i2 >> 1)) { const bf16x8 pa = *(const LAS bf16x8*)(lds + GL_PT + 2048 * i2 + (base_p ^ (64u * ks))); Oacc[i2] = MFMA16(pa, vf[ks], Oacc[i2]); }
            }
    }
#pragma unroll
    for (int kt = 0; kt < 8; ++kt) {
#pragma unroll
        for (int ks = 0; ks < 2; ++ks) { const bf16x8 ka = tr_read8(lds, GL_KT + 8192u * ks + (trb0 ^ (32u * kt)), GL_KT + 8192u * ks + (trb1 ^ (32u * kt))); Sacc[kt] = MFMA16(ka, vf[ks], Sacc[kt]); }
        const f32x4 eb = *(const LAS f32x4*)(lds + GL_EBL + par * 512 + (16 * kt + 4 * g) * 4);
        Sacc[kt] = Sacc[kt] * eb;
        if (kt & 1) __builtin_amdgcn_sched_barrier(0);
    }
    if (MODE == 1) {
        u32x4 s0, s1;
        s0.x = pk2(Oacc[3][3], Oacc[3][2]); s0.y = pk2(Oacc[3][1], Oacc[3][0]); s0.z = pk2(Oacc[2][3], Oacc[2][2]); s0.w = pk2(Oacc[2][1], Oacc[2][0]);
        s1.x = pk2(Oacc[1][3], Oacc[1][2]); s1.y = pk2(Oacc[1][1], Oacc[1][0]); s1.z = pk2(Oacc[0][3], Oacc[0][2]); s1.w = pk2(Oacc[0][1], Oacc[0][0]);
        const int tidm = tid ^ 48;
        stash[tidm * 2] = s0; stash[tidm * 2 + 1] = s1;
    }
    if (MODE == 2) {
        float fo[16]; { float t8[8]; unpack8(st0, t8);
#pragma unroll
            for (int j = 0; j < 8; ++j) fo[j] = t8[j]; unpack8(st1, t8);
#pragma unroll
            for (int j = 0; j < 8; ++j) fo[8 + j] = t8[j]; }
        LAS float* ssw = (LAS float*)(lds + GL_SSW);
#pragma unroll
        for (int i2 = 0; i2 < 4; ++i2)
#pragma unroll
            for (int r = 0; r < 4; ++r) {
                const float o = Oacc[i2][r] + fo[4 * i2 + r]; Oacc[i2][r] = o;
                float v = o * o; v += dpp_f<0x128>(v); v += dpp_f<0x124>(v); v += dpp_f<0x122>(v); v += dpp_f<0x121>(v);
                if (n == 0) ssw[w * 64 + 16 * i2 + 4 * g + r] = v;
            }
        __syncthreads();
        if (tid < 64) { float s = 0.f;
#pragma unroll
            for (int ww = 0; ww < 8; ++ww) s += ssw[ww * 64 + tid];
            ((LAS float*)(lds + GL_RSTD))[tid] = rsqrtf(s * (1.0f / 128.0f) + NORM_EPS); }
        __syncthreads();
        const float gn = a.ng[16 * w + n];
#pragma unroll
        for (int i2 = 0; i2 < 4; ++i2) {
            const f32x4 rs = *(const LAS f32x4*)(lds + GL_RSTD + (16 * i2 + 4 * g) * 4);
#pragma unroll
            for (int r = 0; r < 4; ++r) *(LAS bf16_t*)(lds + GL_QT + (16 * i2 + 4 * g + r) * 256 + (16 * w + n) * 2) = f2bf(Oacc[i2][r] * rs[r] * gn);
        }
        __syncthreads();
        bf16_t* ymix = (bf16_t*)((unsigned char*)a.out + 96 * MiB);
#pragma unroll
        for (int i = 0; i < 2; ++i) {
            const u32x4 ov = *(const LAS u32x4*)(lds + GL_QT + prow[i] * 256 + pch[i] * 16);
            float of[8], zf[8]; unpack8(ov, of); unpack8(zraw[i], zf);
            u32x4 yw;
#pragma unroll
            for (int j = 0; j < 4; ++j) yw[j] = pk2(of[2 * j] * silu(zf[2 * j]), of[2 * j + 1] * silu(zf[2 * j + 1]));
            *(u32x4*)(ymix + (size_t)ptok[i] * DM + h * 128 + pch[i] * 8) = yw;
        }
    }
}
__device__ __forceinline__ void build_gate_tables(const Args& a) {
    for (int e = blockIdx.x * NTHR + tid_now(); e < 8 * 512; e += gridDim.x * NTHR) {
        const int dh = e >> 9, tid = e & 511, dir = dh >> 2, h = dh & 3, lane = tid & 63, w = tid >> 6, n = lane & 15, g = lane >> 4, col = h * 128 + 16 * w + n;
        const float* wup = dir ? a.wub : a.wuf; const float* bias = dir ? a.bbw : a.bfw;
        u32x4 pw;
#pragma unroll
        for (int j = 0; j < 4; ++j) {
            const float v0 = wup[(8 * (g & 1) + 2 * j) * 512 + col], v1 = wup[(8 * (g & 1) + 2 * j + 1) * 512 + col];
            const float h0 = bf2f(f2bf(v0)), h1 = bf2f(f2bf(v1));
            pw[j] = g < 2 ? pk2(v0, v1) : pk2(v0 - h0, v1 - h1);
        }
        ((u32x4*)(a.ws + WS_GATE))[e] = pw;
        if (g == 0) ((float*)(a.ws + WS_GATE + 65536))[dh * 128 + 16 * w + n] = bias[col];
    }
}
__device__ __forceinline__ void phase_gla_pass1(const Args& a, LAS unsigned char* lds) {
    const int tid = tid_now(), w = tid >> 6, lane = tid & 63;
    unsigned char* ST = a.ws + WS_ST;
    const int nsteps = ((NSEG * 8 - (int)blockIdx.x + (int)gridDim.x - 1) / (int)gridDim.x) * 4;
    auto params = [&](int st, int& tb, int& h, int& dir) { if (st >= nsteps) st = nsteps - 1; const int item = blockIdx.x + (st >> 2) * gridDim.x, cc = st & 3; dir = item & 1; h = (item >> 1) & 3; tb = (item >> 3) * 256 + (dir ? 3 - cc : cc) * 64; };
    GlaPre preA, preB; int par = 0;
    if (nsteps > 0) { int tb, h, dir; params(0, tb, h, dir); gla_prefetch<0>(a, preA, tid, tb, h, dir, -1); params(1, tb, h, dir); gla_prefetch<0>(a, preB, tid, tb, h, dir, -1); }
    f32x4 Sacc[8]; float lam;
    for (int st = 0; st < nsteps; st += 2) {
        const int item = blockIdx.x + (st >> 2) * gridDim.x;
        if ((st & 3) == 0) {
#pragma unroll
            for (int kt = 0; kt < 8; ++kt) Sacc[kt] = (f32x4){0.f, 0.f, 0.f, 0.f};
            lam = 0.f;
        }
        { int tb, h, dir, ntb, nh, ndir; params(st, tb, h, dir); params(st + 2, ntb, nh, ndir); gla_chunk<0>(a, lds, tb, h, dir, Sacc, lam, nullptr, preA, ntb, nh, ndir, false, par); par ^= 1; }
        { int tb, h, dir, ntb, nh, ndir; params(st + 1, tb, h, dir); params(st + 3, ntb, nh, ndir); gla_chunk<0>(a, lds, tb, h, dir, Sacc, lam, nullptr, preB, ntb, nh, ndir, false, par); par ^= 1; }
        if ((st & 3) == 2) {
            u32x2* dst = (u32x2*)(ST + (size_t)item * 32768) + (size_t)w * 8 * 64 + lane;
#pragma unroll
            for (int kt = 0; kt < 8; ++kt) { u32x2 v; v.x = pk2(Sacc[kt][0], Sacc[kt][1]); v.y = pk2(Sacc[kt][2], Sacc[kt][3]); dst[kt * 64] = v; }
            if ((lane >> 4) == 3) ((float*)(a.ws + WS_DEC))[(size_t)item * 128 + 16 * w + (lane & 15)] = lam;
        }
    }
    __syncthreads();
}
__device__ __forceinline__ void phase_gla_pass2(const Args& a) {
    unsigned char* ST = a.ws + WS_ST; const float* DEC = (const float*)(a.ws + WS_DEC);
    for (int gidx = blockIdx.x * NTHR + tid_now(); gidx < 48 * 4096; gidx += gridDim.x * NTHR) {
        const int chain = gidx >> 12, quad = gidx & 4095, dir = chain & 1, h = (chain >> 1) & 3, s = chain >> 3;
        const int nseg = s < 2 ? LP / 256 : LS / 256, seg0 = s < 2 ? s * (LP / 256) : 2 * (LP / 256) + (s - 2) * (LS / 256);
        const int kt = (quad >> 6) & 7, lane = quad & 63, dk0 = 16 * kt + 4 * (lane >> 4);
        f32x4 S = (f32x4){0.f, 0.f, 0.f, 0.f};
        for (int i0 = 0; i0 < nseg; i0 += 8) {
            u32x2 t[8]; f32x4 lm[8];
#pragma unroll
            for (int j = 0; j < 8; ++j) { const int seg = dir ? seg0 + nseg - 1 - (i0 + j) : seg0 + i0 + j; const size_t idx = (size_t)((seg * 4 + h) * 2 + dir);
                t[j] = ((const u32x2*)(ST + idx * 32768))[quad]; lm[j] = *(const f32x4*)(DEC + idx * 128 + dk0); }
#pragma unroll
            for (int j = 0; j < 8; ++j) { const int seg = dir ? seg0 + nseg - 1 - (i0 + j) : seg0 + i0 + j; const size_t idx = (size_t)((seg * 4 + h) * 2 + dir);
                u32x2 o; o.x = pk2(S[0], S[1]); o.y = pk2(S[2], S[3]); ((u32x2*)(ST + idx * 32768))[quad] = o;
                const f32x4 tv = (f32x4){__uint_as_float(t[j].x << 16), __uint_as_float(t[j].x & 0xffff0000u), __uint_as_float(t[j].y << 16), __uint_as_float(t[j].y & 0xffff0000u)};
                S = (f32x4){fexp2(lm[j][0]), fexp2(lm[j][1]), fexp2(lm[j][2]), fexp2(lm[j][3])} * S + tv; }
        }
    }
}
__device__ __forceinline__ void phase_gla_pass3(const Args& a, LAS unsigned char* lds) {
    const int tid = tid_now(), w = tid >> 6, lane = tid & 63;
    GlaPre pre; int par = 0;
    if (blockIdx.x < NSEG * 4) gla_prefetch<1>(a, pre, tid, (blockIdx.x >> 2) * 256, blockIdx.x & 3, 0, -1);
    for (int item = blockIdx.x; item < NSEG * 4; item += gridDim.x) {
        const int h = item & 3, seg = item >> 2;
        const int nitem = item + gridDim.x < NSEG * 4 ? item + gridDim.x : item;
        u32x4* stash = (u32x4*)a.out + (size_t)item * 4 * 1024;
#pragma unroll 1
        for (int dir = 0; dir < 2; ++dir) {
            f32x4 Sacc[8];
            const u32x2* src = (const u32x2*)(a.ws + WS_ST + (size_t)((seg * 4 + h) * 2 + dir) * 32768) + (size_t)w * 8 * 64 + lane;
#pragma unroll
            for (int kt = 0; kt < 8; ++kt) { const u32x2 v = src[kt * 64]; Sacc[kt] = (f32x4){__uint_as_float(v.x), __uint_as_float(v.y), 0.f, 0.f}; }
            float lam = 0.f;
            if (dir == 0) {
                for (int c = 0; c < 4; ++c) { const int ntb = seg * 256 + (c < 3 ? c + 1 : 3) * 64, ndir = c < 3 ? 0 : 1;
                    gla_chunk<1>(a, lds, seg * 256 + c * 64, h, 0, Sacc, lam, stash + c * 1024, pre, ntb, h, ndir, c == 0, par); par ^= 1; }
            } else {
                for (int c = 3; c >= 0; --c) { const int ntb = c > 0 ? seg * 256 + (c - 1) * 64 : (nitem >> 2) * 256, nh = c > 0 ? h : (nitem & 3), ndir = c > 0 ? 1 : 0;
                    gla_chunk<2>(a, lds, seg * 256 + c * 64, h, 1, Sacc, lam, stash + c * 1024, pre, ntb, nh, ndir, c == 3, par); par ^= 1; }
            }
        }
    }
    __syncthreads();
}
typedef float f32x16 __attribute__((ext_vector_type(16)));
#define MFMA32(a, b, c) __builtin_amdgcn_mfma_f32_32x32x16_bf16((a), (b), (c), 0, 0, 0)
constexpr int SW_K = 0, SW_V = 65536, SW_TB = 131072, SW_TBN = 336, SW_TBH = 4 * SW_TBN * 4;
constexpr float SW_NEG = -1e30f;
__device__ __forceinline__ unsigned offk(unsigned row, unsigned c8) { return 128u * row + 16u * (c8 ^ ((row >> 1) & 7)); }
__device__ __forceinline__ unsigned offv(unsigned row, unsigned c8) { return 128u * row + 16u * (c8 ^ (((row >> 1) & 1) << 2)); }
__device__ __forceinline__ void swa_load_block(const bf16_t* U, int gb, int kvh, bool valid, int tid, u32x4 (&kk)[2], u32x4 (&vv)[2]) {
#pragma unroll
    for (int i = 0; i < 2; ++i) {
        const int idx = tid + 512 * i, r = idx >> 3, c8 = idx & 7;
        kk[i] = (u32x4){0, 0, 0, 0}; vv[i] = (u32x4){0, 0, 0, 0};
        if (valid) { const bf16_t* ur = U + (size_t)(gb * 128 + r) * UP + kvh * 64 + c8 * 8; kk[i] = __builtin_nontemporal_load((const u32x4*)(ur + C_KB)); vv[i] = __builtin_nontemporal_load((const u32x4*)(ur + C_VB)); }
    }
}
__device__ __forceinline__ void swa_store_block(LAS unsigned char* lds, int gb, int tid, const u32x4 (&kk)[2], const u32x4 (&vv)[2]) {
#pragma unroll
    for (int i = 0; i < 2; ++i) {
        const int idx = tid + 512 * i, r = 128 * (gb & 3) + (idx >> 3), c8 = idx & 7;
        *(LAS u32x4*)(lds + SW_K + offk(r, c8)) = kk[i]; *(LAS u32x4*)(lds + SW_V + offv(r, c8)) = vv[i];
    }
}
__device__ __forceinline__ bool swa_exists(int gb) { return gb >= 0 && gb < NTOK / 128; }
__device__ __forceinline__ void phase_swa(const Args& a, LAS unsigned char* lds) {
    const bf16_t* U = (const bf16_t*)(a.ws + WS_U); bf16_t* ymix = (bf16_t*)((unsigned char*)a.out + 96 * MiB);
    const int tid = tid_now(), lane = tid & 63, w = __builtin_amdgcn_readfirstlane(tid >> 6), r = lane & 31, hh = lane >> 5;
    for (int su = blockIdx.x; su < (NTOK / 128 / 3) * 2; su += gridDim.x) {
        const int kvh = su & 1, qb0 = 3 * (su >> 1);
        __syncthreads();
        for (int e = tid; e < 4 * SW_TBN; e += NTHR) {
            const int hl = e / SW_TBN, idx = e - hl * SW_TBN, rel = idx - 160;
            const float val = (rel >= -128 && rel <= 128) ? a.relb[t5_bucket(rel) * 8 + kvh * 4 + hl] : SW_NEG;
            LAS float* tb = (LAS float*)(lds + SW_TB + hl * SW_TBH);
#pragma unroll
            for (int s = 0; s < 4; ++s) if (idx - s >= 0) tb[s * SW_TBN + idx - s] = val;
        }
#pragma unroll 1
        for (int bb = -1; bb <= 1; ++bb) { u32x4 kk[2], vv[2]; swa_load_block(U, qb0 + bb, kvh, swa_exists(qb0 + bb), tid, kk, vv); swa_store_block(lds, qb0 + bb, tid, kk, vv); }
        __syncthreads();
        const int hl = w >> 1, hq = kvh * 4 + hl;
        const float snk = a.sink[hq];
#pragma unroll 1
        for (int qi = 0; qi < 3; ++qi) {
            const int qb = qb0 + qi, tok0 = qb * 128; int s0, L; seq_of(tok0, s0, L);
            const bool first = tok0 == s0, last = tok0 + 128 == s0 + L;
            u32x4 nk[2], nv[2];
            if (qi < 2) swa_load_block(U, qb + 2, kvh, swa_exists(qb + 2), tid, nk, nv);
            bf16x8 Qn[4];
            { const int qt0 = tok0 + 32 * ((w & 1) * 2) + r;
#pragma unroll
              for (int s = 0; s < 4; ++s) Qn[s] = *(const bf16x8*)(U + (size_t)qt0 * UP + C_QB + hq * 64 + 16 * s + 8 * hh); }
#pragma unroll 1
            for (int ss = 0; ss < 2; ++ss) {
                const int st = (w & 1) * 2 + ss, qtok = tok0 + 32 * st + r;
                bf16x8 Qf[4];
#pragma unroll
                for (int s = 0; s < 4; ++s) Qf[s] = Qn[s];
                { const int qt1 = ss == 0 ? qtok + 32 : qtok;
#pragma unroll
                  for (int s = 0; s < 4; ++s) Qn[s] = *(const bf16x8*)(U + (size_t)qt1 * UP + C_QB + hq * 64 + 16 * s + 8 * hh); }
                u32x2 zv8[2][4];
#pragma unroll
                for (int dt = 0; dt < 2; ++dt)
#pragma unroll
                    for (int i4 = 0; i4 < 4; ++i4) zv8[dt][i4] = *(const u32x2*)(U + (size_t)qtok * UP + C_ZB + hq * 64 + 32 * dt + 8 * i4 + 4 * hh);
                float m = snk, l = hh == 0 ? 1.0f : 0.0f;
                f32x16 O[2];
#pragma unroll
                for (int i = 0; i < 16; ++i) { O[0][i] = 0.f; O[1][i] = 0.f; }
                const int sft = (-r) & 3;
                const unsigned tbase = SW_TB + hl * SW_TBH + sft * (SW_TBN * 4) + 4 * (32 + 4 * hh - r - sft);
                const unsigned kb0 = SW_K + 128u * r + 16u * (hh ^ ((r >> 1) & 7));
                const int q4 = (lane & 15) >> 2, p4 = lane & 3, g1 = (lane >> 4) & 1, xq = (q4 >> 1) & 1;
                const unsigned vb0 = SW_V + 128u * (4 * hh + q4) + 16u * ((4 * xq) | (2 * g1) | (p4 >> 1)) + 8u * (p4 & 1);
#pragma unroll 1
                for (int grp = 0; grp < 3; ++grp) {
                    f32x16 S[3];
#pragma unroll
                    for (int k3 = 0; k3 < 3; ++k3) {
                        const int kk = 3 * grp + k3, kt = st + kk, blk = kt >> 2;
                        const bool valid = !((blk == 0 && first) || (blk == 2 && last));
                        const unsigned rowb = 128u * (128u * ((unsigned)(qb - 1 + blk) & 3u) + 32u * (kt & 3));
                        if (valid) {
#pragma unroll
                            for (int i = 0; i < 16; ++i) S[k3][i] = 0.f;
#pragma unroll
                            for (int s = 0; s < 4; ++s) { const bf16x8 Kf = *(const LAS bf16x8*)(lds + (kb0 ^ (32u * s)) + rowb); S[k3] = MFMA32(Kf, Qf[s], S[k3]); }
#pragma unroll
                            for (int i4 = 0; i4 < 4; ++i4) { const f32x4 bv = *(const LAS f32x4*)(lds + tbase + 4 * (32 * kk + 8 * i4));
#pragma unroll
                                for (int j = 0; j < 4; ++j) S[k3][4 * i4 + j] += bv[j]; }
                        } else {
#pragma unroll
                            for (int i = 0; i < 16; ++i) S[k3][i] = SW_NEG;
                        }
                    }
                    float mx4[4] = {SW_NEG, SW_NEG, SW_NEG, SW_NEG};
#pragma unroll
                    for (int k3 = 0; k3 < 3; ++k3)
#pragma unroll
                        for (int i = 0; i < 16; ++i) mx4[i & 3] = fmaxf(mx4[i & 3], S[k3][i]);
                    float mx = fmaxf(fmaxf(mx4[0], mx4[1]), fmaxf(mx4[2], mx4[3]));
                    mx = fmaxf(mx, __shfl_xor(mx, 32));
                    const float mn = fmaxf(m, mx), alpha = fexp(m - mn);
                    m = mn; l *= alpha;
#pragma unroll
                    for (int i = 0; i < 16; ++i) { O[0][i] *= alpha; O[1][i] *= alpha; }
                    bf16x8 Pf[3][2];
                    float l4[4] = {0.f, 0.f, 0.f, 0.f};
#pragma unroll
                    for (int k3 = 0; k3 < 3; ++k3) {
#pragma unroll
                        for (int i = 0; i < 16; ++i) { const float pv = fexp(S[k3][i] - m); S[k3][i] = pv; l4[i & 3] += pv; }
#pragma unroll
                        for (int s2 = 0; s2 < 2; ++s2) {
                            u32x4 pw;
#pragma unroll
                            for (int j = 0; j < 4; ++j) pw[j] = pk2(S[k3][8 * s2 + 2 * j], S[k3][8 * s2 + 2 * j + 1]);
                            Pf[k3][s2] = __builtin_bit_cast(bf16x8, pw);
                        }
                    }
                    l += (l4[0] + l4[1]) + (l4[2] + l4[3]);
#pragma unroll
                    for (int k3 = 0; k3 < 3; ++k3) {
                        const int kt = st + 3 * grp + k3, blk = kt >> 2;
                        const unsigned rowb = 128u * (128u * ((unsigned)(qb - 1 + blk) & 3u) + 32u * (kt & 3));
#pragma unroll
                        for (int s2 = 0; s2 < 2; ++s2)
#pragma unroll
                            for (int dt = 0; dt < 2; ++dt) {
                                const unsigned va = (vb0 ^ (64u * dt)) + rowb + 2048u * s2;
                                const bf16x8 Vf = tr_read8(lds, va, va + 1024u);
                                O[dt] = MFMA32(Vf, Pf[k3][s2], O[dt]);
                            }
                    }
                }
                l += __shfl_xor(l, 32);
                const float inv = __builtin_amdgcn_rcpf(l);
#pragma unroll
                for (int dt = 0; dt < 2; ++dt)
#pragma unroll
                    for (int i4 = 0; i4 < 4; ++i4) {
                        const int d0 = 32 * dt + 8 * i4 + 4 * hh;
                        const u32x2 zv = zv8[dt][i4];
                        const float z0 = __uint_as_float(zv.x << 16), z1 = __uint_as_float(zv.x & 0xffff0000u), z2 = __uint_as_float(zv.y << 16), z3 = __uint_as_float(zv.y & 0xffff0000u);
                        u32x2 yw; yw.x = pk2(O[dt][4 * i4] * inv * silu(z0), O[dt][4 * i4 + 1] * inv * silu(z1)); yw.y = pk2(O[dt][4 * i4 + 2] * inv * silu(z2), O[dt][4 * i4 + 3] * inv * silu(z3));
                        *(u32x2*)(ymix + (size_t)qtok * DM + 512 + hq * 64 + d0) = yw;
                    }
            }
            if (qi < 2) swa_store_block(lds, qb + 2, tid, nk, nv);
            __syncthreads();
        }
    }
}
__device__ __forceinline__ void phase_convfix(const Args& a) {
    bf16_t* G = (bf16_t*)(a.ws + WS_XB); const float* Pb = (const float*)(a.ws + WS_PB); const float* Sb = (const float*)(a.ws + WS_SB);
    for (int idx = blockIdx.x * NTHR + tid_now(); idx < (NTOK / 64 - 1) * 256; idx += gridDim.x * NTHR) {
        const int k = idx / 256 + 1, c = (idx & 255) * 4, row = 64 * k; int s0, L; seq_of(row, s0, L);
        if (row == s0) continue;
        const f32x4 pl = *(const f32x4*)(Pb + (size_t)((k - 1) * 2 + 1) * 1024 + c), sl = *(const f32x4*)(Sb + (size_t)((k - 1) * 2 + 1) * 1024 + c);
        const f32x4 pf = *(const f32x4*)(Pb + (size_t)(k * 2) * 1024 + c), sf = *(const f32x4*)(Sb + (size_t)(k * 2) * 1024 + c);
        const f32x4 c0 = *(const f32x4*)(a.cw + c), c2 = *(const f32x4*)(a.cw + 2048 + c);
        u32x2* gl = (u32x2*)(G + (size_t)(row - 1) * DM + c); u32x2* gf = (u32x2*)(G + (size_t)row * DM + c);
        const u32x2 a0 = *gl, a1 = *gf;
        const f32x4 dl = sl * c2 * pf, df = sf * c0 * pl;
        u32x2 o0, o1;
        o0.x = pk2(__uint_as_float(a0.x << 16) + dl[0], __uint_as_float(a0.x & 0xffff0000u) + dl[1]); o0.y = pk2(__uint_as_float(a0.y << 16) + dl[2], __uint_as_float(a0.y & 0xffff0000u) + dl[3]);
        o1.x = pk2(__uint_as_float(a1.x << 16) + df[0], __uint_as_float(a1.x & 0xffff0000u) + df[1]); o1.y = pk2(__uint_as_float(a1.y << 16) + df[2], __uint_as_float(a1.y & 0xffff0000u) + df[3]);
        *gl = o0; *gf = o1;
    }
}
__global__ void __launch_bounds__(NTHR, 2) mega(Args a) {
    LAS unsigned char* lds = (LAS unsigned char*)lds_raw;
    volatile LAS unsigned* MISC = (volatile LAS unsigned*)(lds + MISC_OFF);
    if (threadIdx.x < 32) MISC[threadIdx.x] = 0u;
    if ((threadIdx.x & 63) == 0) ((volatile LAS unsigned*)(lds + SLOT_OFF))[hw_slot()] = threadIdx.x >> 6;
    __syncthreads();
    unsigned char* ws = a.ws; float* out = a.out;
    XcdBarrier bar = xcd_barrier_post((unsigned*)(ws + WS_CTL) + 4096, MISC + 8);
    bf16_t* W1t = (bf16_t*)(ws + WS_W1T); bf16_t* W2t = (bf16_t*)(ws + WS_W2T); bf16_t* W3t = (bf16_t*)(ws + WS_W3T); bf16_t* W4t = (bf16_t*)(ws + WS_W4T);
    bf16_t* xb = (bf16_t*)(ws + WS_XB); bf16_t* ymix = (bf16_t*)((unsigned char*)out + 96 * MiB); bf16_t* G = xb; bf16_t* U = (bf16_t*)(ws + WS_U);
    bf16_t* x1b = (bf16_t*)(ws + WS_X1B); bf16_t* P = (bf16_t*)(ws + WS_P); bf16_t* Sg = (bf16_t*)(ws + WS_S);
    f32x2* stat1 = (f32x2*)(ws + WS_STAT1); f32x2* stat2 = (f32x2*)(ws + WS_STAT2); f32x2* mr1 = (f32x2*)(ws + WS_MR1);

    phase_convert(a, lds);
    xcd_barrier(bar);
    { pg8::Gemm g{xb, W1t, NTOK, C_GD, DM, 0}; pg8::StaticOrder S; S.init(NTOK, C_GD, gridDim.x, blockIdx.x); EpiU E{U}; pg8::gemm_phase<EpiU, pg8::StaticOrder>(lds, g, S, E); }
    xcd_barrier(bar);
    phase_gla_pass1(a, lds);
    xcd_barrier(bar);
    phase_gla_pass2(a);
    phase_swa(a, lds);
    xcd_barrier(bar);
    phase_gla_pass3(a, lds);
    xcd_barrier(bar);
    { pg8::Gemm g{ymix, W2t, NTOK, DM, DM, 0}; pg8::StaticOrder S; S.init(NTOK, DM, gridDim.x, blockIdx.x);
      EpiLN<0> E{ws, nullptr, a.lng, a.lnb}; pg8::gemm_phase<EpiLN<0>, pg8::StaticOrder>(lds, g, S, E); }
    xcd_barrier(bar);
    { pg8::Gemm g{x1b, W3t, NTOK, 4096, DM, 0}; pg8::StaticOrder S; S.init(NTOK, 4096, gridDim.x, blockIdx.x); EpiG E{ws, a.cw}; pg8::gemm_phase<EpiG, pg8::StaticOrder>(lds, g, S, E); }
    xcd_barrier(bar);
    phase_convfix(a);
    xcd_barrier(bar);
    { pg8::Gemm g{G, W4t, NTOK, DM, DM, 0}; pg8::StaticOrder S; S.init(NTOK, DM, gridDim.x, blockIdx.x);
      EpiLN<1> E{ws, out, a.lng + DM, a.lnb + DM}; pg8::gemm_phase<EpiLN<1>, pg8::StaticOrder>(lds, g, S, E); }
}

extern "C" void kernel_launch(void* const* d_in, const int* in_sizes, int n_in, void* d_out, int out_size, void* d_ws, size_t ws_size, hipStream_t stream) {
    static int grid = 0;
    if (grid == 0) {
        if (n_in != 16 || out_size != NTOK * DM || ws_size < WS_END) { fprintf(stderr, "kernel_launch: unexpected shapes (n_in %d out %d ws %zu)\n", n_in, out_size, ws_size); grid = -1; return; }
        int dev = 0, cus = 0, per_cu = 0;
        if (hipGetDevice(&dev) != hipSuccess || hipDeviceGetAttribute(&cus, hipDeviceAttributeMultiprocessorCount, dev) != hipSuccess) { grid = -1; return; }
        if (hipFuncSetAttribute((const void*)mega, hipFuncAttributeMaxDynamicSharedMemorySize, LDS_BYTES) != hipSuccess) { fprintf(stderr, "kernel_launch: hipFuncSetAttribute failed\n"); grid = -1; return; }
        if (hipOccupancyMaxActiveBlocksPerMultiprocessor(&per_cu, (const void*)mega, NTHR, LDS_BYTES) != hipSuccess || per_cu < 1) { fprintf(stderr, "kernel_launch: occupancy query says %d blocks per CU\n", per_cu); (void)hipGetLastError(); grid = -1; return; }
        grid = cus;
    }
    if (grid < 0) return;
    (void)hipMemsetAsync((char*)d_ws + WS_CTL, 0, 262144, stream);
    Args a{};
    a.xp = (const float*)d_in[0]; a.xs = (const float*)d_in[1]; a.w_in_even = (const float*)d_in[2]; a.wuf = (const float*)d_in[3]; a.bfw = (const float*)d_in[4];
    a.wub = (const float*)d_in[5]; a.bbw = (const float*)d_in[6]; a.ng = (const float*)d_in[7]; a.sink = (const float*)d_in[8]; a.relb = (const float*)d_in[9];
    a.w_out_even = (const float*)d_in[10]; a.w_in_odd = (const float*)d_in[11]; a.cw = (const float*)d_in[12]; a.w_out_odd = (const float*)d_in[13];
    a.lng = (const float*)d_in[14]; a.lnb = (const float*)d_in[15]; a.out = (float*)d_out; a.ws = (unsigned char*)d_ws;
    hipLaunchKernelGGL(mega, dim3(grid), dim3(NTHR), LDS_BYTES, stream, a);
}
```

```cpp
#include <hip/hip_runtime.h>
#include <cstdio>

typedef unsigned short bf16_t;
typedef short bf16x8 __attribute__((ext_vector_type(8)));
typedef float f32x4 __attribute__((ext_vector_type(4)));
typedef float f32x2 __attribute__((ext_vector_type(2)));
typedef unsigned u32x4 __attribute__((ext_vector_type(4)));
typedef unsigned u32x2 __attribute__((ext_vector_type(2)));
#define LAS __attribute__((address_space(3)))
#define MFMA16(a, b, c) __builtin_amdgcn_mfma_f32_16x16x32_bf16((a), (b), (c), 0, 0, 0)
extern __shared__ __attribute__((aligned(16))) unsigned char lds_raw[];
constexpr int SLOT_OFF = 163840 - 1024;
__device__ __forceinline__ unsigned hw_slot() { return (unsigned)__builtin_amdgcn_s_getreg((5 << 11) | 4) & 63u; }
__device__ __forceinline__ int tid_now() {
    const int wid = __builtin_amdgcn_readfirstlane((int)((volatile LAS unsigned*)((LAS unsigned char*)lds_raw + SLOT_OFF))[hw_slot()]);
    return wid * 64 + (int)__lane_id();
}

constexpr int DM = 1024, NTOK = 49152, NPROMPT = 32768, LP = 16384, LS = 4096;
constexpr int UP = 3584;
constexpr int C_QA = 0, C_KA = 512, C_VA = 1024, C_ZA = 1536, C_QB = 2048, C_KB = 2560, C_VB = 2688, C_ZB = 2816, C_GD = 3328;
constexpr int EVEN_IN = 3360, ODD_IN = 4096;
constexpr float DN_ALPHA = 1.41421356237309515f;
constexpr float LN_EPS = 1e-5f, NORM_EPS = 1e-6f;

constexpr size_t MiB = 1u << 20;
constexpr size_t WS_CTL = 0, WS_W1T = 1 * MiB, WS_W2T = 8 * MiB, WS_W3T = 10 * MiB, WS_W4T = 18 * MiB, WS_STAT1 = 20 * MiB, WS_MR1 = 26 * MiB, WS_DEC = 27 * MiB, WS_GATE = 27 * MiB + 768 * 1024,
                 WS_XB = 28 * MiB  , WS_U = 124 * MiB, WS_ST = 460 * MiB, WS_END = 508 * MiB;
constexpr size_t WS_X1B = WS_U, WS_P = WS_U + 96 * MiB, WS_S = WS_U + 192 * MiB, WS_STAT2 = WS_U + 288 * MiB, WS_PB = WS_U + 296 * MiB, WS_SB = WS_U + 304 * MiB;

__device__ __forceinline__ float bf2f(bf16_t b) { return __uint_as_float(((unsigned)b) << 16); }
typedef __bf16 nbf16x2 __attribute__((ext_vector_type(2)));
__device__ __forceinline__ bf16_t f2bf(float f) { return __builtin_bit_cast(bf16_t, (__bf16)f); }
__device__ __forceinline__ unsigned pk2(float lo, float hi) { return __builtin_bit_cast(unsigned, __builtin_convertvector((f32x2){lo, hi}, nbf16x2)); }
__device__ __forceinline__ float fexp2(float x) { return __builtin_amdgcn_exp2f(x); }
__device__ __forceinline__ float fexp(float x) { return __builtin_amdgcn_exp2f(x * 1.4426950408889634f); }
__device__ __forceinline__ float flog2(float x) { return __builtin_amdgcn_logf(x); }
__device__ __forceinline__ float silu(float x) { return x * __builtin_amdgcn_rcpf(1.0f + fexp(-x)); }
__device__ __forceinline__ float wave_sum(float v) {
#pragma unroll
    for (int o = 1; o < 64; o <<= 1) v += __shfl_xor(v, o);
    return v;
}
__device__ __forceinline__ float wave_max(float v) {
#pragma unroll
    for (int o = 1; o < 64; o <<= 1) v = fmaxf(v, __shfl_xor(v, o));
    return v;
}
__device__ __forceinline__ void seq_of(int row, int& s0, int& L) {
    if (row < NPROMPT) { L = LP; s0 = row & ~(LP - 1); } else { L = LS; s0 = NPROMPT + ((row - NPROMPT) & ~(LS - 1)); }
}

namespace pg8 {
constexpr int BM = 256, BK = 64, HALF = 128, HTB = HALF * BK * 2, STAGE_BYTES = 8 * HTB, NXCD = 8, WGM = 8;
__host__ __device__ __forceinline__ int lds_byte(int r, int c) { const int st = (r >> 4) * 2 + (c >> 5), rr = r & 15, cc = c & 31, ob = rr * 64 + cc * 2; return st * 1024 + (ob ^ (((ob >> 9) & 1) << 5)); }
__host__ __device__ __forceinline__ void stage_rc(int b, int& R, int& C) { const int st = b / 1024, sb = b % 1024, swz = sb ^ (((sb >> 9) & 1) << 5); R = (st >> 1) * 16 + swz / 64; C = (st & 1) * 32 + (swz % 64) / 2; }
__host__ __device__ __forceinline__ int perm32(int rho) { const int n = rho >> 4, i = rho & 15; return 8 * (i >> 2) + 4 * n + (i & 3); }
struct Unit { int pm, pn; };
struct Gemm { const bf16_t* A; const bf16_t* Bt; int M, N, K, pad; };
struct StaticOrder {
    int nM, nN, nwg, G, c;
    __host__ __device__ void init(int M, int N, int G_, int c_) { nM = M / BM; nN = N / BM; nwg = nM * nN; G = G_; c = c_; }
    __host__ __device__ bool next(int i, Unit& u) const {
        const long L = (long)i * G + c; if (L >= nwg) return false;
        int wgid = (int)L; { const int q = nwg / NXCD, r = nwg % NXCD, xcd = wgid % NXCD, off = wgid / NXCD; wgid = (xcd < r ? xcd * (q + 1) : r * (q + 1) + (xcd - r) * q) + off; }
        const int nig = WGM * nN, gid = wgid / nig, fm = gid * WGM, gsz = (nM - fm) < WGM ? (nM - fm) : WGM;
        u.pm = fm + ((wgid % nig) % gsz); u.pn = (wgid % nig) / gsz; return true;
    }
    __device__ __forceinline__ void a_ready(const Unit&) const {}
    __device__ __forceinline__ void done(const Unit&) const {}
};

template <class Epi, class Sched>
__device__ __forceinline__ void gemm_phase(LAS unsigned char* lds, const Gemm g, const Sched& S, const Epi& E) {
    int tid = tid_now(); asm volatile("" : "+v"(tid));
    const int wid = __builtin_amdgcn_readfirstlane(tid >> 6), lane = tid & 63, wr = wid >> 2, wc = wid & 3, fr = lane & 15, fq = lane >> 4;
    const int K = g.K, nt = K / BK;
    unsigned voffA[2], voffB[2];
#pragma unroll
    for (int i = 0; i < 2; ++i) { int R, C; stage_rc(tid * 16 + i * 8192, R, C); const int Rb = Epi::PERM ? ((R & ~31) + perm32(R & 31)) : R;
        voffA[i] = (unsigned)(R * K + C) * 2u; voffB[i] = (unsigned)(Rb * K + C) * 2u; }
    const size_t kstep = (size_t)(BK * 2);
    const size_t hstep = (size_t)HALF * K * 2;
    const size_t tstep = 2 * hstep;
    const unsigned ldsw = (unsigned)wid * 1024u;
    const int aoff = lds_byte(wr * 64 + fr, fq * 8), boff = lds_byte(wc * 32 + fr, fq * 8);
#define PG8_SA(b, h) (((b) * 2 + (h)) * HTB)
#define PG8_SB(b, h) ((4 + (b) * 2 + (h)) * HTB)
#define PG8_STAGE(bufoff, gbase, voff) do { _Pragma("unroll") for (int _i = 0; _i < 2; ++_i) \
        __builtin_amdgcn_global_load_lds((const unsigned*)((const char*)(gbase) + (voff)[_i]), (LAS unsigned*)(lds + (bufoff) + ldsw + _i * 8192), 16, 0, 0); } while (0)
#define PG8_LDA(dst, b, h) do { _Pragma("unroll") for (int m = 0; m < 4; ++m) _Pragma("unroll") for (int k = 0; k < 2; ++k) dst[m][k] = *(const LAS bf16x8*)(lds + PG8_SA(b, h) + aoff + m * 2048 + k * 1024); } while (0)
#define PG8_LDB(dst, b, h) do { _Pragma("unroll") for (int n = 0; n < 2; ++n) _Pragma("unroll") for (int k = 0; k < 2; ++k) dst[n][k] = *(const LAS bf16x8*)(lds + PG8_SB(b, h) + boff + n * 2048 + k * 1024); } while (0)
#define PG8_MMA(ai, bj, At, Bt) do { __builtin_amdgcn_s_setprio(1); _Pragma("unroll") for (int m = 0; m < 4; ++m) _Pragma("unroll") for (int n = 0; n < 2; ++n) _Pragma("unroll") for (int k = 0; k < 2; ++k) \
        acc[ai][bj][m][n] = __builtin_amdgcn_mfma_f32_16x16x32_bf16(Bt[n][k], At[m][k], acc[ai][bj][m][n], 0, 0, 0); __builtin_amdgcn_s_setprio(0); } while (0)
#define PG8_WAIT_V(n) asm volatile("s_waitcnt vmcnt(" #n ")" ::: "memory")
#define PG8_WAIT_L(n) asm volatile("s_waitcnt lgkmcnt(" #n ")" ::: "memory")
#define PG8_BAR __builtin_amdgcn_s_barrier()
#define PG8_SCHED __builtin_amdgcn_sched_barrier(0)
    Unit cur, nxt; int ui = 0;
    if (!S.next(0, cur)) return;
    f32x4 acc[2][2][4][2];
#pragma unroll
    for (int a = 0; a < 2; ++a)
#pragma unroll
        for (int b = 0; b < 2; ++b)
#pragma unroll
            for (int m = 0; m < 4; ++m)
#pragma unroll
                for (int n = 0; n < 2; ++n) acc[a][b][m][n] = (f32x4){0.f, 0.f, 0.f, 0.f};
    bf16x8 At[4][2], B0[2][2], B1[2][2];
    const char* cA = (const char*)g.A + (size_t)cur.pm * tstep; const char* cB = (const char*)g.Bt + (size_t)cur.pn * tstep;
    S.a_ready(cur);
    PG8_STAGE(PG8_SB(0, 0), cB, voffB); PG8_STAGE(PG8_SA(0, 0), cA, voffA); PG8_STAGE(PG8_SB(0, 1), cB + hstep, voffB); PG8_STAGE(PG8_SA(0, 1), cA + hstep, voffA);
    if (wr == 1) PG8_BAR;
    PG8_WAIT_V(4); PG8_BAR;
    PG8_STAGE(PG8_SB(1, 0), cB + kstep, voffB); PG8_STAGE(PG8_SA(1, 0), cA + kstep, voffA); PG8_STAGE(PG8_SB(1, 1), cB + hstep + kstep, voffB);
    PG8_WAIT_V(6); PG8_BAR;
    for (;;) {
        const bool has_next = S.next(ui + 1, nxt);
        const char* nA = has_next ? (const char*)g.A + (size_t)nxt.pm * tstep : cA; const char* nB = has_next ? (const char*)g.Bt + (size_t)nxt.pn * tstep : cB;
        for (int t = 0; t < nt; t += 2) {
            const bool last = (t == nt - 2);
            const char* a1 = cA + (size_t)(t + 1) * kstep;
            const char* a2 = last ? nA : cA + (size_t)(t + 2) * kstep; const char* b2 = last ? nB : cB + (size_t)(t + 2) * kstep;
            const char* a3 = a2 + kstep; const char* b3 = b2 + kstep;
            if (last && has_next) S.a_ready(nxt);
            PG8_LDB(B0, 0, 0); PG8_SCHED; PG8_LDA(At, 0, 0); PG8_STAGE(PG8_SA(1, 1), a1 + hstep, voffA);
            PG8_WAIT_L(8); PG8_BAR; PG8_WAIT_L(0); PG8_MMA(0, 0, At, B0); PG8_BAR; PG8_SCHED;
            PG8_LDB(B1, 0, 1); PG8_STAGE(PG8_SB(0, 0), b2, voffB);
            PG8_BAR; PG8_WAIT_L(0); PG8_MMA(0, 1, At, B1); PG8_BAR;
            PG8_LDA(At, 0, 1); PG8_STAGE(PG8_SA(0, 0), a2, voffA);
            PG8_BAR; PG8_WAIT_L(0); PG8_MMA(1, 0, At, B0); PG8_BAR; PG8_SCHED;
            PG8_STAGE(PG8_SB(0, 1), b2 + hstep, voffB);
            PG8_WAIT_V(6); PG8_BAR; PG8_MMA(1, 1, At, B1); PG8_BAR;
            PG8_LDB(B0, 1, 0); PG8_SCHED; PG8_LDA(At, 1, 0); PG8_STAGE(PG8_SA(0, 1), a2 + hstep, voffA);
            PG8_WAIT_L(8); PG8_BAR; PG8_WAIT_L(0); PG8_MMA(0, 0, At, B0); PG8_BAR; PG8_SCHED;
            PG8_LDB(B1, 1, 1); PG8_STAGE(PG8_SB(1, 0), b3, voffB);
            PG8_BAR; PG8_WAIT_L(0); PG8_MMA(0, 1, At, B1); PG8_BAR;
            PG8_LDA(At, 1, 1); PG8_STAGE(PG8_SA(1, 0), a3, voffA);
            PG8_BAR; PG8_WAIT_L(0); PG8_MMA(1, 0, At, B0); PG8_BAR; PG8_SCHED;
            PG8_STAGE(PG8_SB(1, 1), b3 + hstep, voffB);
            PG8_WAIT_V(6); PG8_BAR; PG8_MMA(1, 1, At, B1); PG8_BAR;
        }
        if constexpr (Epi::REALIGN) { if (wr == 0) PG8_BAR; }
        E(acc, cur, wr, wc, fr, fq); S.done(cur);
        if constexpr (Epi::REALIGN) { if (wr == 1) PG8_BAR; }
        if (!has_next) break;
#pragma unroll
        for (int a = 0; a < 2; ++a)
#pragma unroll
            for (int b = 0; b < 2; ++b)
#pragma unroll
                for (int m = 0; m < 4; ++m)
#pragma unroll
                    for (int n = 0; n < 2; ++n) acc[a][b][m][n] = (f32x4){0.f, 0.f, 0.f, 0.f};
        cur = nxt; cA = nA; cB = nB; ++ui;
    }
    PG8_WAIT_V(0);
    if (wr == 0) PG8_BAR;
    PG8_BAR;
#undef PG8_SA
#undef PG8_SB
#undef PG8_STAGE
#undef PG8_LDA
#undef PG8_LDB
#undef PG8_MMA
#undef PG8_WAIT_V
#undef PG8_WAIT_L
#undef PG8_BAR
#undef PG8_SCHED
}
}

struct EpiU {
    static constexpr bool PERM = true, AFTER_DRAIN = false, REALIGN = false;
    bf16_t* O;
    __device__ __forceinline__ void operator()(const f32x4 (&acc)[2][2][4][2], const pg8::Unit& u, int wr, int wc, int fr, int fq) const {
        const int row0 = u.pm * 256 + wr * 64 + fr, col0 = u.pn * 256 + wc * 32 + 8 * fq;
#pragma unroll
        for (int ai = 0; ai < 2; ++ai)
#pragma unroll
            for (int m = 0; m < 4; ++m) { bf16_t* rowp = O + (size_t)(row0 + ai * 128 + m * 16) * UP + col0;
#pragma unroll
                for (int bj = 0; bj < 2; ++bj) { const f32x4 v0 = acc[ai][bj][m][0], v1 = acc[ai][bj][m][1];
                    u32x4 w; w.x = pk2(v0[0], v0[1]); w.y = pk2(v0[2], v0[3]); w.z = pk2(v1[0], v1[1]); w.w = pk2(v1[2], v1[3]);
                    *(u32x4*)(rowp + bj * 128) = w; } }
    }
};
template <int LAYER> struct EpiY {
    static constexpr bool PERM = false, AFTER_DRAIN = false, REALIGN = false;
    const float* xp; const float* xs; float* Y; f32x2* stat; const f32x2* mr; const float* lg; const float* lb;
    __device__ __forceinline__ void operator()(const f32x4 (&acc)[2][2][4][2], const pg8::Unit& u, int wr, int wc, int fr, int fq) const {
        const int col0 = u.pn * 256 + wc * 32 + 4 * fq;
        f32x4 gv[2][2], bv[2][2];
        if (LAYER == 1) {
#pragma unroll
            for (int bj = 0; bj < 2; ++bj)
#pragma unroll
                for (int n = 0; n < 2; ++n) { gv[bj][n] = *(const f32x4*)(lg + col0 + bj * 128 + n * 16); bv[bj][n] = *(const f32x4*)(lb + col0 + bj * 128 + n * 16); }
        }
#pragma unroll
        for (int ai = 0; ai < 2; ++ai)
#pragma unroll
            for (int m = 0; m < 4; ++m) {
                const int row = u.pm * 256 + ai * 128 + wr * 64 + m * 16 + fr;
                const float* rp; f32x2 mrv = (f32x2){0.f, 1.f};
                if (LAYER == 0) rp = (row < NPROMPT) ? xp + (size_t)row * DM : xs + (size_t)(row - NPROMPT) * DM;
                else { rp = Y + (size_t)row * DM; mrv = mr[row]; }
                float* yp = Y + (size_t)row * DM;
                float s = 0.f, q = 0.f;
#pragma unroll
                for (int bj = 0; bj < 2; ++bj)
#pragma unroll
                    for (int n = 0; n < 2; ++n) {
                        const int c = col0 + bj * 128 + n * 16;
                        f32x4 r = *(const f32x4*)(rp + c);
                        if (LAYER == 1) r = (r - mrv.x) * mrv.y * gv[bj][n] + bv[bj][n];
                        const f32x4 y = r * DN_ALPHA + acc[ai][bj][m][n];
                        *(f32x4*)(yp + c) = y;
                        s += (y[0] + y[1]) + (y[2] + y[3]); q += (y[0] * y[0] + y[1] * y[1]) + (y[2] * y[2] + y[3] * y[3]);
                    }
                s += __shfl_xor(s, 16); s += __shfl_xor(s, 32); q += __shfl_xor(q, 16); q += __shfl_xor(q, 32);
                if (fq == 0) stat[(size_t)row * 16 + u.pn * 4 + wc] = (f32x2){s, q};
            }
    }
};
#define RLX_AGENT __ATOMIC_RELAXED, __HIP_MEMORY_SCOPE_AGENT
template <int LAYER> struct EpiLN {
    static constexpr bool PERM = true, AFTER_DRAIN = false, REALIGN = true;
    unsigned char* ws; float* Of; const float* lg; const float* lb;
    __device__ __forceinline__ void operator()(f32x4 (&acc)[2][2][4][2], const pg8::Unit& u, int wr, int wc, int fr, int fq) const {
        unsigned char* w2 = ws; asm volatile("" : "+s"(w2));
        const bf16_t* R = (const bf16_t*)(w2 + (LAYER == 0 ? WS_XB : WS_X1B)); bf16_t* Ob = (bf16_t*)(w2 + WS_X1B);
        unsigned long long* xbuf = (unsigned long long*)(w2 + WS_STAT1 + (LAYER == 0 ? 0 : 3 * MiB));
        unsigned* cnt = (unsigned*)(w2 + WS_CTL) + 16384 + LAYER * 192 * 64;
        const int col0 = u.pn * 256 + wc * 32 + 8 * fq, rowb = u.pm * 256 + wr * 64 + fr;
        LAS f32x2* part = (LAS f32x2*)((LAS unsigned char*)lds_raw + 131072);
        float ps[2][4], pq[2][4];
#pragma unroll
        for (int ai = 0; ai < 2; ++ai) {
            u32x4 rwa[4][2];
#pragma unroll
            for (int m = 0; m < 4; ++m)
#pragma unroll
                for (int bj = 0; bj < 2; ++bj) rwa[m][bj] = *(const u32x4*)(R + (size_t)(rowb + ai * 128 + m * 16) * DM + col0 + bj * 128);
#pragma unroll
            for (int m = 0; m < 4; ++m) {
                float s = 0.f, q = 0.f;
#pragma unroll
                for (int bj = 0; bj < 2; ++bj) {
                    const u32x4 rw = rwa[m][bj];
                    f32x4 r0 = (f32x4){__uint_as_float(rw.x << 16), __uint_as_float(rw.x & 0xffff0000u), __uint_as_float(rw.y << 16), __uint_as_float(rw.y & 0xffff0000u)};
                    f32x4 r1 = (f32x4){__uint_as_float(rw.z << 16), __uint_as_float(rw.z & 0xffff0000u), __uint_as_float(rw.w << 16), __uint_as_float(rw.w & 0xffff0000u)};
                    const f32x4 v0 = r0 * DN_ALPHA + acc[ai][bj][m][0], v1 = r1 * DN_ALPHA + acc[ai][bj][m][1];
                    acc[ai][bj][m][0] = v0; acc[ai][bj][m][1] = v1;
                    s += ((v0[0] + v0[1]) + (v0[2] + v0[3])) + ((v1[0] + v1[1]) + (v1[2] + v1[3]));
                    q += ((v0[0] * v0[0] + v0[1] * v0[1]) + (v0[2] * v0[2] + v0[3] * v0[3])) + ((v1[0] * v1[0] + v1[1] * v1[1]) + (v1[2] * v1[2] + v1[3] * v1[3]));
                }
                s += __shfl_xor(s, 16); s += __shfl_xor(s, 32); q += __shfl_xor(q, 16); q += __shfl_xor(q, 32);
                if (fq == 0) part[(ai * 128 + wr * 64 + m * 16 + fr) * 4 + wc] = (f32x2){s, q};
            }
        }
        const int tid = (wr * 4 + wc) * 64 + fq * 16 + fr;
        asm volatile("s_waitcnt lgkmcnt(0)" ::: "memory"); __builtin_amdgcn_s_barrier(); asm volatile("" ::: "memory");
        if (tid < 256) {
            const LAS f32x4* pp = (const LAS f32x4*)(part + tid * 4); const f32x4 a01 = pp[0], a23 = pp[1];
            const float s = (a01[0] + a01[2]) + (a23[0] + a23[2]), q = (a01[1] + a01[3]) + (a23[1] + a23[3]);
            __hip_atomic_store(xbuf + (size_t)(u.pm * 256 + tid) * 4 + u.pn, ((unsigned long long)__float_as_uint(q) << 32) | __float_as_uint(s), RLX_AGENT);
        }
        asm volatile("s_waitcnt vmcnt(0)" ::: "memory"); __builtin_amdgcn_s_barrier(); asm volatile("" ::: "memory");
        unsigned* c = cnt + 64 * u.pm;
        if (tid == 0) __hip_atomic_fetch_add(c, 1u, RLX_AGENT);
        if (tid < 64) { unsigned spins = 0;
          while ((unsigned)__builtin_amdgcn_readfirstlane(__hip_atomic_load(c, RLX_AGENT)) < 4u) { __builtin_amdgcn_s_sleep(1); if (++spins > (1u << 16)) break; }
          __builtin_amdgcn_fence(__ATOMIC_ACQUIRE, "agent"); asm volatile("s_waitcnt vmcnt(0)" ::: "memory"); }
        __builtin_amdgcn_s_barrier(); asm volatile("" ::: "memory");
#pragma unroll
        for (int ai = 0; ai < 2; ++ai)
#pragma unroll
            for (int m = 0; m < 4; ++m) {
                const f32x4* sp = (const f32x4*)(xbuf + (size_t)(rowb + ai * 128 + m * 16) * 4);
                const f32x4 a01 = sp[0], a23 = sp[1];
                const float s = (a01[0] + a01[2]) + (a23[0] + a23[2]), q = (a01[1] + a01[3]) + (a23[1] + a23[3]);
                const float mean = s * (1.0f / DM), var = q * (1.0f / DM) - mean * mean;
                ps[ai][m] = mean; pq[ai][m] = rsqrtf(fmaxf(var, 0.f) + LN_EPS);
            }
#pragma unroll
        for (int bj = 0; bj < 2; ++bj) {
            const f32x4 g0 = *(const f32x4*)(lg + col0 + bj * 128), g1 = *(const f32x4*)(lg + col0 + bj * 128 + 4), b0 = *(const f32x4*)(lb + col0 + bj * 128), b1 = *(const f32x4*)(lb + col0 + bj * 128 + 4);
#pragma unroll
            for (int ai = 0; ai < 2; ++ai)
#pragma unroll
                for (int m = 0; m < 4; ++m) {
                    const int row = rowb + ai * 128 + m * 16; const float mean = ps[ai][m], rstd = pq[ai][m];
                    const f32x4 o0 = (acc[ai][bj][m][0] - mean) * rstd * g0 + b0, o1 = (acc[ai][bj][m][1] - mean) * rstd * g1 + b1;
                    if (LAYER == 0) { u32x4 w; w.x = pk2(o0[0], o0[1]); w.y = pk2(o0[2], o0[3]); w.z = pk2(o1[0], o1[1]); w.w = pk2(o1[2], o1[3]); *(u32x4*)(Ob + (size_t)row * DM + col0 + bj * 128) = w; }
                    else { float* op = Of + (size_t)row * DM + col0 + bj * 128; __builtin_nontemporal_store(o0, (f32x4*)op); __builtin_nontemporal_store(o1, (f32x4*)(op + 4)); }
                }
        }
    }
};
struct EpiPS {
    static constexpr bool PERM = true, AFTER_DRAIN = false, REALIGN = false;
    bf16_t* P; bf16_t* S;
    __device__ __forceinline__ void operator()(const f32x4 (&acc)[2][2][4][2], const pg8::Unit& u, int wr, int wc, int fr, int fq) const {
        const int row0 = u.pm * 256 + wr * 64 + fr, off = (wc & 1) * 32 + 8 * fq;
        bf16_t* dst = (wc < 2 ? S : P) + u.pn * 64 + off;
#pragma unroll
        for (int ai = 0; ai < 2; ++ai)
#pragma unroll
            for (int m = 0; m < 4; ++m) {
                float o[8];
#pragma unroll
                for (int n = 0; n < 2; ++n)
#pragma unroll
                    for (int j = 0; j < 4; ++j) { const float a = acc[ai][0][m][n][j], b = acc[ai][1][m][n][j];
                        o[4 * n + j] = (wc < 2) ? silu(b) * a : a * b; }
                u32x4 w; w.x = pk2(o[0], o[1]); w.y = pk2(o[2], o[3]); w.z = pk2(o[4], o[5]); w.w = pk2(o[6], o[7]);
                *(u32x4*)(dst + (size_t)(row0 + ai * 128 + m * 16) * DM) = w;
            }
    }
};

template <int CTRL> __device__ __forceinline__ float dpp_f(float x);
struct EpiG {
    static constexpr bool PERM = true, AFTER_DRAIN = false, REALIGN = false;
    unsigned char* ws; const float* cw;
    __device__ __forceinline__ void operator()(const f32x4 (&acc)[2][2][4][2], const pg8::Unit& u, int wr, int wc, int fr, int fq) const {
        unsigned char* w2 = ws; asm volatile("" : "+s"(w2));
        bf16_t* G = (bf16_t*)(w2 + WS_XB); float* Pb = (float*)(w2 + WS_PB); float* Sb = (float*)(w2 + WS_SB);
        const int ch0 = u.pn * 64 + 16 * wc + 4 * fq;
        const f32x4 c0 = *(const f32x4*)(cw + ch0), c1 = *(const f32x4*)(cw + 1024 + ch0), c2 = *(const f32x4*)(cw + 2048 + ch0);
#pragma unroll
        for (int ai = 0; ai < 2; ++ai) {
            f32x4 P[4], S[4];
#pragma unroll
            for (int m = 0; m < 4; ++m)
#pragma unroll
                for (int j = 0; j < 4; ++j) { P[m][j] = acc[ai][0][m][1][j] * acc[ai][1][m][1][j]; S[m][j] = silu(acc[ai][1][m][0][j]) * acc[ai][0][m][0][j]; }
            const int row0 = u.pm * 256 + ai * 128 + wr * 64 + fr;
#pragma unroll
            for (int m = 0; m < 4; ++m) {
                float o[4];
#pragma unroll
                for (int j = 0; j < 4; ++j) {
                    float pr = dpp_f<0x111>(P[m][j]);
                    if (m > 0) { const float t = dpp_f<0x121>(P[m - 1][j]); pr = fr == 0 ? t : pr; }
                    float nx = dpp_f<0x101>(P[m][j]);
                    if (m < 3) { const float t = dpp_f<0x12F>(P[m + 1][j]); nx = fr == 15 ? t : nx; }
                    o[j] = S[m][j] * (c0[j] * pr + c1[j] * P[m][j] + c2[j] * nx);
                }
                u32x2 w; w.x = pk2(o[0], o[1]); w.y = pk2(o[2], o[3]);
                *(u32x2*)(G + (size_t)(row0 + 16 * m) * DM + ch0) = w;
            }
            const int blk = u.pm * 4 + ai * 2 + wr;
            if (fr == 0) { *(f32x4*)(Pb + (size_t)(blk * 2) * 1024 + ch0) = P[0]; *(f32x4*)(Sb + (size_t)(blk * 2) * 1024 + ch0) = S[0]; }
            if (fr == 15) { *(f32x4*)(Pb + (size_t)(blk * 2 + 1) * 1024 + ch0) = P[3]; *(f32x4*)(Sb + (size_t)(blk * 2 + 1) * 1024 + ch0) = S[3]; }
        }
    }
};
#define XB_TMO      128
#define XB_XCNT(j)  (256  + 64 * (j))
#define XB_XSUB(j)  (1280 + 64 * (j))
#define XB_XGEN(j)  (2304 + 64 * (j))
#define XB_TOP      3328
#define XB_TOPGEN   3392
#define XCD_BAR_WORDS 3456
#define XB_SPIN_CAP (1u << 27)
__device__ __forceinline__ unsigned xb_ld(unsigned* p)              { return __hip_atomic_load(p, __ATOMIC_RELAXED, __HIP_MEMORY_SCOPE_AGENT); }
__device__ __forceinline__ unsigned xb_add(unsigned* p, unsigned v) { return __hip_atomic_fetch_add(p, v, __ATOMIC_RELAXED, __HIP_MEMORY_SCOPE_AGENT); }
__device__ __forceinline__ unsigned xb_xcc_id() { return (unsigned)__builtin_amdgcn_s_getreg((3 << 11) | 20) & 0xFu; }
#define XB_SPIN(cond, bar) do { unsigned _sp = 0; while (cond) { __builtin_amdgcn_s_sleep(1); \
    if ((++_sp & 255u) == 0u) { if (xb_ld(&(bar)[XB_TMO])) break; if (_sp > XB_SPIN_CAP) { atomicAdd(&(bar)[XB_TMO], 1u); break; } } } } while (0)
struct XcdBarrier { unsigned* bar; unsigned x; volatile LAS unsigned* st; };
__device__ __forceinline__ XcdBarrier xcd_barrier_post(unsigned* bar, volatile LAS unsigned* st) {
    XcdBarrier b; b.bar = bar; b.x = xb_xcc_id(); b.st = st;
    if (tid_now() == 0) (void)xb_add(&bar[XB_XCNT(b.x)], 1u);
    return b;
}
__device__ __forceinline__ void xcd_barrier_complete(unsigned* bar, unsigned x, unsigned& nloc, unsigned& nx) {
    const unsigned G = gridDim.x * gridDim.y * gridDim.z;
    unsigned sum, cnt, mine, sp = 0u;
    for (;;) {
        sum = 0u; cnt = 0u; mine = 0u;
#pragma unroll
        for (unsigned j = 0; j < 16; ++j) { const unsigned c = xb_ld(&bar[XB_XCNT(j)]); sum += c; cnt += (c > 0u) ? 1u : 0u; mine = (j == x) ? c : mine; }
        if (sum == G) break;
        __builtin_amdgcn_s_sleep(1);
        if ((++sp & 255u) == 0u) { if (xb_ld(&bar[XB_TMO])) break; if (sp > XB_SPIN_CAP) { atomicAdd(&bar[XB_TMO], 1u); break; } }
    }
    nloc = mine > 0u ? mine : 1u; nx = cnt > 0u ? cnt : 1u;
}
__device__ __forceinline__ void xcd_barrier(const XcdBarrier& b) {
    asm volatile("s_waitcnt vmcnt(0)" ::: "memory");
    __syncthreads();
    if (tid_now() == 0) {
        unsigned* bar = b.bar;
        __builtin_amdgcn_s_waitcnt(0);
        unsigned nloc = b.st[0], nx = b.st[1];
        if (nloc == 0u) { xcd_barrier_complete(bar, b.x, nloc, nx); b.st[0] = nloc; b.st[1] = nx; }
        const unsigned old = xb_add(&bar[XB_XSUB(b.x)], 1u);
        const unsigned gen = old / nloc;
        if (old + 1u == (gen + 1u) * nloc) {
            __builtin_amdgcn_fence(__ATOMIC_RELEASE, "agent");
            asm volatile("s_waitcnt vmcnt(0)" ::: "memory");
            const unsigned og = xb_add(&bar[XB_TOP], 1u);
            const unsigned tg = og / nx;
            if (og + 1u == (tg + 1u) * nx) xb_add(&bar[XB_TOPGEN], 1u);
            else XB_SPIN(xb_ld(&bar[XB_TOPGEN]) == tg, bar);
            __builtin_amdgcn_fence(__ATOMIC_ACQUIRE, "agent");
            xb_add(&bar[XB_XGEN(b.x)], 1u);
            asm volatile("s_waitcnt vmcnt(0)" ::: "memory");
        } else {
            XB_SPIN(xb_ld(&bar[XB_XGEN(b.x)]) == gen, bar);
            __builtin_amdgcn_fence(__ATOMIC_ACQUIRE, "agent");
            asm volatile("s_waitcnt vmcnt(0)" ::: "memory");
        }
    }
    __syncthreads();
}

struct Args {
    const float *xp, *xs, *w_in_even, *wuf, *bfw, *wub, *bbw, *ng, *sink, *relb, *w_out_even, *w_in_odd, *cw, *w_out_odd, *lng, *lnb;
    float* out; unsigned char* ws;
};
constexpr int NTHR = 512;
constexpr int LDS_BYTES = 163840, MISC_OFF = 163840 - 512;

template <int MODE> __device__ __forceinline__ int wmap(int n, float& sc) {
    sc = 1.f;
    if (MODE == 0) return n;
    if (MODE == 1) {
        if (n < 512) sc = 0.08838834764831845f;
        if (n >= C_QB && n < C_KB) sc = 0.125f;
        if (n < 2048) return n;
        if (n < C_GD) return n + 32;
        if (n < C_GD + 32) return n - C_GD + 2048;
        return -1;
    }
    const int c = n & 255, bj = (c >> 7) & 1, wc = (c >> 5) & 3, fq = (c >> 3) & 3, nn = (c >> 2) & 1, j = c & 3, q = 2 * bj + nn, ch = (n >> 8) * 64 + 16 * wc + 4 * fq + j;
    const int base = q == 0 ? 0 : (q == 1 ? 1024 : (q == 2 ? 3072 : 2048));
    return base + ch;
}
template <int MODE> __device__ __forceinline__ void wconv_item(const float* __restrict__ W, int Nsrc, bf16_t* __restrict__ Wt, int Ndst, int item, LAS float* tile, int t256) {
    const int nb = item % (Ndst / 64), kb = item / (Ndst / 64), n0 = nb * 64, k0 = kb * 64;
    const int tx = t256 & 63, ty = t256 >> 6;
    float sc; const int src = wmap<MODE>(n0 + tx, sc);
    for (int kk = ty; kk < 64; kk += 4) tile[kk * 65 + tx] = src >= 0 ? W[(size_t)(k0 + kk) * Nsrc + src] * sc : 0.f;
    __syncthreads();
    for (int nn = ty; nn < 64; nn += 4) Wt[(size_t)(n0 + nn) * 1024 + k0 + tx] = f2bf(tile[tx * 65 + nn]);
    __syncthreads();
}
template <int MODE> __device__ __forceinline__ void p0_w_item(const float* __restrict__ W, int Nsrc, bf16_t* __restrict__ Wt, int Ndst, int item, LAS float* scr, int lane) {
    const int nblk = Ndst / 32, kb = item / nblk, nb = item - kb * nblk, k0 = 64 * kb, n0 = 32 * nb;
    float sc; const int src = wmap<MODE>(n0 + (lane & 31), sc);
#pragma unroll 8
    for (int i = 0; i < 32; ++i) { const int kk = 2 * i + (lane >> 5); scr[kk * 33 + (lane & 31)] = src >= 0 ? W[(size_t)(k0 + kk) * Nsrc + src] * sc : 0.f; }
    asm volatile("s_waitcnt lgkmcnt(0)" ::: "memory");
    const int c = lane & 7;
#pragma unroll
    for (int jj = 0; jj < 4; ++jj) { const int n = (lane >> 3) + 8 * jj; const LAS float* sp = scr + (8 * c) * 33 + n;
        u32x4 o; o.x = pk2(sp[0 * 33], sp[1 * 33]); o.y = pk2(sp[2 * 33], sp[3 * 33]); o.z = pk2(sp[4 * 33], sp[5 * 33]); o.w = pk2(sp[6 * 33], sp[7 * 33]);
        *(u32x4*)(Wt + (size_t)(n0 + n) * 1024 + k0 + 8 * c) = o; }
    asm volatile("s_waitcnt lgkmcnt(0)" ::: "memory");
}
__device__ __forceinline__ void build_gate_tables(const Args& a);
__device__ __forceinline__ void phase_convert(const Args& a, LAS unsigned char* lds) {
    unsigned char* ws = a.ws;
    bf16_t* W1t = (bf16_t*)(ws + WS_W1T); bf16_t* W2t = (bf16_t*)(ws + WS_W2T); bf16_t* W3t = (bf16_t*)(ws + WS_W3T); bf16_t* W4t = (bf16_t*)(ws + WS_W4T);
    {
        const int tidw = tid_now(), lanew = tidw & 63, ww = tidw >> 6;
        LAS float* scr = (LAS float*)(lds + ww * 8448);
        constexpr int I1 = 16 * (C_GD / 32), I2 = 16 * 32, I3 = 16 * 128, I4 = 16 * 32, NW = I1 + I2 + I3 + I4;
        for (int wi = blockIdx.x * 8 + ww; wi < NW; wi += gridDim.x * 8) {
            int r = wi;
            if (r < I1) p0_w_item<1>(a.w_in_even, EVEN_IN, W1t, C_GD, r, scr, lanew);
            else if ((r -= I1) < I2) p0_w_item<0>(a.w_out_even, 1024, W2t, 1024, r, scr, lanew);
            else if ((r -= I2) < I3) p0_w_item<2>(a.w_in_odd, ODD_IN, W3t, 4096, r, scr, lanew);
            else p0_w_item<0>(a.w_out_odd, 1024, W4t, 1024, r - I3, scr, lanew);
        }
    }
    build_gate_tables(a);
    __syncthreads();
    {
        constexpr int WP = 1032, TP = 264;
        LAS bf16_t* wg = (LAS bf16_t*)lds; LAS bf16_t* tile0 = (LAS bf16_t*)(lds + 32 * WP * 2);
        const int tid = tid_now(), lane = tid & 63, w = tid >> 6, n = lane & 15, g = lane >> 4, rb = w & 3, ct = w >> 2;
        for (int e = tid; e < 32 * 1024; e += NTHR) { const int k = e >> 5, c = e & 31; wg[c * WP + k] = f2bf(a.w_in_even[(size_t)k * EVEN_IN + 2048 + c]); }
        bf16_t* xb = (bf16_t*)(ws + WS_XB); bf16_t* U = (bf16_t*)(ws + WS_U);
        f32x4 v[4][2];
        auto slab_load = [&](int it, int sl) {
#pragma unroll
            for (int i = 0; i < 4; ++i) { const int idx = tid + 512 * i, row = it * 64 + (idx >> 5), col = sl * 256 + 8 * (idx & 31);
                const float* src = (row < NPROMPT ? a.xp + (size_t)row * DM : a.xs + (size_t)(row - NPROMPT) * DM) + col;
                v[i][0] = __builtin_nontemporal_load((const f32x4*)src); v[i][1] = __builtin_nontemporal_load((const f32x4*)(src + 4)); } };
        const int ntrip = NTOK / 64;
        if ((int)blockIdx.x < ntrip) slab_load(blockIdx.x, 0);
        int par = 0;
        for (int it = blockIdx.x; it < ntrip; it += gridDim.x) {
            f32x4 acc = (f32x4){0.f, 0.f, 0.f, 0.f};
#pragma unroll 1
            for (int sl = 0; sl < 4; ++sl) {
                LAS bf16_t* tile = tile0 + par * (64 * TP);
#pragma unroll
                for (int i = 0; i < 4; ++i) { const int idx = tid + 512 * i, r64 = idx >> 5, c8 = idx & 31;
                    u32x4 pw; pw.x = pk2(v[i][0][0], v[i][0][1]); pw.y = pk2(v[i][0][2], v[i][0][3]); pw.z = pk2(v[i][1][0], v[i][1][1]); pw.w = pk2(v[i][1][2], v[i][1][3]);
                    *(u32x4*)(xb + (size_t)(it * 64 + r64) * DM + sl * 256 + 8 * c8) = pw;
                    *(LAS u32x4*)(tile + r64 * TP + 8 * c8) = pw; }
                { const int nsl = (sl + 1) & 3, nit = sl < 3 ? it : (it + (int)gridDim.x < ntrip ? it + (int)gridDim.x : it); slab_load(nit, nsl); }
                __syncthreads();
#pragma unroll
                for (int ks = 0; ks < 8; ++ks) {
                    const bf16x8 af = *(const LAS bf16x8*)(tile + (16 * rb + n) * TP + 32 * ks + 8 * g), bfr = *(const LAS bf16x8*)(wg + (16 * ct + n) * WP + sl * 256 + 32 * ks + 8 * g);
                    acc = MFMA16(af, bfr, acc);
                }
                par ^= 1;
            }
#pragma unroll
            for (int r = 0; r < 4; ++r) U[(size_t)(it * 64 + rb * 16 + 4 * g + r) * UP + C_GD + 16 * ct + n] = f2bf(acc[r]);
        }
        __syncthreads();
    }
}

__device__ __forceinline__ void phase_gla_naive(const Args& a, LAS unsigned char* lds, float* OF, float* OB) {
    if (blockIdx.x >= 12) return;
    const bf16_t* U = (const bf16_t*)(a.ws + WS_U);
    const int grp = tid_now() >> 7, tid = tid_now() & 127, b = blockIdx.x * 4 + grp, dir = b & 1, h = (b >> 1) & 3, s = b >> 3;
    LAS float* sq = (LAS float*)lds + grp * (3 * 16 * 128); LAS float* sk = sq + 16 * 128; LAS float* sd = sk + 16 * 128;
    const int L = s < 2 ? LP : LS, start = s < 2 ? s * LP : NPROMPT + (s - 2) * LS;
    const float* wu = dir ? a.wub : a.wuf; const float* bias = dir ? a.bbw : a.bfw; float* O = dir ? OB : OF;
    float wr[16];
#pragma unroll
    for (int r = 0; r < 16; ++r) wr[r] = wu[r * 512 + h * 128 + tid];
    const float bb = bias[h * 128 + tid];
    float S[128];
#pragma unroll
    for (int i = 0; i < 128; ++i) S[i] = 0.f;
    for (int t0 = 0; t0 < L; t0 += 16) {
        for (int tt = 0; tt < 16; ++tt) {
            const int p = t0 + tt, tok = start + (dir ? L - 1 - p : p);
            const bf16_t* ur = U + (size_t)tok * UP;
            float x = bb;
#pragma unroll
            for (int r = 0; r < 16; ++r) x += bf2f(ur[C_GD + dir * 16 + r]) * wr[r];
            const float ls = fminf(x, 0.f) - log1pf(expf(-fabsf(x)));
            sd[tt * 128 + tid] = expf(ls * (1.0f / 16.0f));
            sq[tt * 128 + tid] = bf2f(ur[C_QA + h * 128 + tid]);
            sk[tt * 128 + tid] = bf2f(ur[C_KA + h * 128 + tid]);
        }
        __syncthreads();
        for (int tt = 0; tt < 16; ++tt) {
            const int p = t0 + tt, tok = start + (dir ? L - 1 - p : p);
            const float v = bf2f(U[(size_t)tok * UP + C_VA + h * 128 + tid]);
            float acc = 0.f;
#pragma unroll
            for (int dk = 0; dk < 128; dk += 4) {
                const f32x4 d4 = *(const LAS f32x4*)&sd[tt * 128 + dk], q4 = *(const LAS f32x4*)&sq[tt * 128 + dk], k4 = *(const LAS f32x4*)&sk[tt * 128 + dk];
#pragma unroll
                for (int j = 0; j < 4; ++j) {
                    const float sdec = S[dk + j] * d4[j];
                    const float sn = sdec + k4[j] * v;
                    acc += q4[j] * (dir ? sdec : sn);
                    S[dk + j] = sn;
                }
            }
            O[(size_t)tok * 512 + h * 128 + tid] = acc;
        }
        __syncthreads();
    }
}
__device__ __forceinline__ void phase_gla_combine(const Args& a, const float* OF, const float* OB) {
    const bf16_t* U = (const bf16_t*)(a.ws + WS_U); bf16_t* ymix = (bf16_t*)((unsigned char*)a.out + 96 * MiB);
    const int lane = tid_now() & 63;
    for (int w = blockIdx.x * 8 + (tid_now() >> 6); w < NTOK * 4; w += gridDim.x * 8) {
        const int tok = w >> 2, h = w & 3;
        const size_t o = (size_t)tok * 512 + h * 128 + lane * 2;
        const float a0 = OF[o] + OB[o], a1 = OF[o + 1] + OB[o + 1];
        const float ss = wave_sum(a0 * a0 + a1 * a1);
        const float rstd = rsqrtf(ss * (1.0f / 128.0f) + NORM_EPS);
        const bf16_t* z = U + (size_t)tok * UP + C_ZA + h * 128 + lane * 2;
        const float y0 = a0 * rstd * a.ng[lane * 2] * silu(bf2f(z[0])), y1 = a1 * rstd * a.ng[lane * 2 + 1] * silu(bf2f(z[1]));
        *(unsigned*)(ymix + (size_t)tok * DM + h * 128 + lane * 2) = pk2(y0, y1);
    }
}
__device__ __forceinline__ int t5_bucket(int rel) {
    const int n = rel < 0 ? -rel : rel;
    int b = n < 8 ? n : (n < 12 ? 8 : (n < 16 ? 9 : (n < 23 ? 10 : (n < 32 ? 11 : (n < 46 ? 12 : (n < 64 ? 13 : (n < 91 ? 14 : 15)))))));
    return b + (rel > 0 ? 16 : 0);
}
__device__ __forceinline__ void phase_swa_naive(const Args& a, LAS unsigned char* lds) {
    const bf16_t* U = (const bf16_t*)(a.ws + WS_U); bf16_t* ymix = (bf16_t*)((unsigned char*)a.out + 96 * MiB);
    const int wv = tid_now() >> 6, lane = tid_now() & 63;
    LAS float* sq = (LAS float*)(lds + 65536) + wv * 64; LAS float* sp = (LAS float*)(lds + 65536 + 2048) + wv * 320;
    for (int w = blockIdx.x * 8 + wv; w < NTOK * 8; w += gridDim.x * 8) {
        const int tok = w >> 3, hq = w & 7, kv = hq >> 2;
        int s0, L; seq_of(tok, s0, L); const int i = tok - s0;
        sq[lane] = bf2f(U[(size_t)tok * UP + C_QB + hq * 64 + lane]);
        const float snk = a.sink[hq];
        float sc[5]; float mx = snk;
#pragma unroll
        for (int c = 0; c < 5; ++c) {
            const int jj = c * 64 + lane, j = i - 128 + jj; const bool valid = jj <= 256 && j >= 0 && j < L;
            float d = -INFINITY;
            if (valid) {
                const bf16_t* kr = U + (size_t)(s0 + j) * UP + C_KB + kv * 64; d = 0.f;
#pragma unroll
                for (int e = 0; e < 64; e += 8) { const u32x4 kk = *(const u32x4*)(kr + e);
                    d += sq[e] * __uint_as_float(kk.x << 16) + sq[e + 1] * __uint_as_float(kk.x & 0xffff0000u) + sq[e + 2] * __uint_as_float(kk.y << 16) + sq[e + 3] * __uint_as_float(kk.y & 0xffff0000u)
                       + sq[e + 4] * __uint_as_float(kk.z << 16) + sq[e + 5] * __uint_as_float(kk.z & 0xffff0000u) + sq[e + 6] * __uint_as_float(kk.w << 16) + sq[e + 7] * __uint_as_float(kk.w & 0xffff0000u); }
                d += a.relb[t5_bucket(j - i) * 8 + hq];
            }
            sc[c] = d; mx = fmaxf(mx, d);
        }
        mx = wave_max(mx);
        float den = 0.f;
#pragma unroll
        for (int c = 0; c < 5; ++c) { sc[c] = sc[c] == -INFINITY ? 0.f : __expf(sc[c] - mx); den += sc[c]; }
        den = wave_sum(den) + __expf(snk - mx);
        const float inv = 1.0f / den;
#pragma unroll
        for (int c = 0; c < 5; ++c) sp[c * 64 + lane] = sc[c] * inv;
        float o = 0.f;
        for (int jj = 0; jj <= 256; ++jj) { const int j = i - 128 + jj; if (j >= 0 && j < L) o += sp[jj] * bf2f(U[(size_t)(s0 + j) * UP + C_VB + kv * 64 + lane]); }
        const float z = bf2f(U[(size_t)tok * UP + C_ZB + hq * 64 + lane]);
        ymix[(size_t)tok * DM + 512 + hq * 64 + lane] = f2bf(o * silu(z));
    }
}
template <int FINAL>
__device__ __forceinline__ void phase_ln(float* Y, const f32x2* stat, f32x2* mr, const float* lg, const float* lb, bf16_t* xb) {
    const int lane = tid_now() & 63;
    for (int row = blockIdx.x * 8 + (tid_now() >> 6); row < NTOK; row += gridDim.x * 8) {
        f32x2 p = lane < 16 ? stat[(size_t)row * 16 + lane] : (f32x2){0.f, 0.f};
        const float s = wave_sum(p.x), q = wave_sum(p.y);
        const float mean = s * (1.0f / DM), var = q * (1.0f / DM) - mean * mean, rstd = rsqrtf(fmaxf(var, 0.f) + LN_EPS);
        if (!FINAL && lane == 0) mr[row] = (f32x2){mean, rstd};
#pragma unroll
        for (int j = 0; j < 4; ++j) {
            const int c = j * 256 + lane * 4;
            const f32x4 y = *(const f32x4*)(Y + (size_t)row * DM + c), g = *(const f32x4*)(lg + c), b = *(const f32x4*)(lb + c);
            const f32x4 o = (y - mean) * rstd * g + b;
            if (FINAL) *(f32x4*)(Y + (size_t)row * DM + c) = o;
            else { u32x2 w; w.x = pk2(o[0], o[1]); w.y = pk2(o[2], o[3]); *(u32x2*)(xb + (size_t)row * DM + c) = w; }
        }
    }
}
__device__ __forceinline__ void phase_convgate(const bf16_t* P, const bf16_t* S, const float* cw, bf16_t* G) {
    const size_t n8 = (size_t)NTOK * DM / 8;
    for (size_t i = (size_t)blockIdx.x * NTHR + tid_now(); i < n8; i += (size_t)gridDim.x * NTHR) {
        const int row = (int)(i >> 7), c = (int)(i & 127) * 8; int s0, L; seq_of(row, s0, L);
        const bool hasl = row > s0, hasr = row < s0 + L - 1;
        const u32x4 pm = *(const u32x4*)(P + (size_t)row * DM + c), sv = *(const u32x4*)(S + (size_t)row * DM + c);
        u32x4 pl = (u32x4){0, 0, 0, 0}, pr = (u32x4){0, 0, 0, 0};
        if (hasl) pl = *(const u32x4*)(P + (size_t)(row - 1) * DM + c);
        if (hasr) pr = *(const u32x4*)(P + (size_t)(row + 1) * DM + c);
        float o[8];
#pragma unroll
        for (int j = 0; j < 4; ++j) {
            const unsigned l = pl[j], m = pm[j], r = pr[j], sw = sv[j];
            const int cc = c + 2 * j;
            o[2 * j] = __uint_as_float(sw << 16) * (cw[cc] * __uint_as_float(l << 16) + cw[1024 + cc] * __uint_as_float(m << 16) + cw[2048 + cc] * __uint_as_float(r << 16));
            o[2 * j + 1] = __uint_as_float(sw & 0xffff0000u) * (cw[cc + 1] * __uint_as_float(l & 0xffff0000u) + cw[1024 + cc + 1] * __uint_as_float(m & 0xffff0000u) + cw[2048 + cc + 1] * __uint_as_float(r & 0xffff0000u));
        }
        u32x4 w; w.x = pk2(o[0], o[1]); w.y = pk2(o[2], o[3]); w.z = pk2(o[4], o[5]); w.w = pk2(o[6], o[7]);
        *(u32x4*)(G + (size_t)row * DM + c) = w;
    }
}

typedef short s16x4 __attribute__((ext_vector_type(4)));
constexpr int GL_QT = 0, GL_KT = 16384, GL_VT = 32768, GL_PT = 49152, GL_B = 57344, GL_GD = 90112, GL_TOT = 94208, GL_EBL = 96256  , GL_SSW = 97280, GL_RSTD = 99328;
constexpr int NSEG = NTOK / 256;
__device__ __forceinline__ unsigned offb(unsigned row, unsigned ch) { return 256u * row + 16u * (ch ^ (((row & 3) << 2) | ((row >> 2) & 3))); }
__device__ __forceinline__ unsigned offp(unsigned row, unsigned ch) { return 128u * row + 16u * (ch ^ (row & 7)); }
__device__ __forceinline__ unsigned rr16(unsigned lane, unsigned rb, unsigned s) { return offb((lane & 15) + 16 * rb, 4 * s + (lane >> 4)); }
__device__ __forceinline__ unsigned tr16(unsigned lane, unsigned c, unsigned ks, unsigned t) {
    const unsigned g = lane >> 4, q = (lane & 15) >> 2, p = lane & 3;
    return offb(32 * ks + 8 * g + 4 * t + q, 2 * c + (p >> 1)) + 8 * (p & 1);
}
__device__ __forceinline__ bf16x8 tr_read8(unsigned a0, unsigned a1) {
    s16x4 r0, r1;
    asm volatile("ds_read_b64_tr_b16 %0, %2\n\tds_read_b64_tr_b16 %1, %3\n\ts_waitcnt lgkmcnt(0)" : "=&v"(r0), "=&v"(r1) : "v"(a0), "v"(a1) : "memory");
    return __builtin_shufflevector(r0, r1, 0, 1, 2, 3, 4, 5, 6, 7);
}
__device__ __forceinline__ void unpack8(const u32x4 w, float (&f)[8]) {
#pragma unroll
    for (int j = 0; j < 4; ++j) { f[2 * j] = __uint_as_float(w[j] << 16); f[2 * j + 1] = __uint_as_float(w[j] & 0xffff0000u); }
}

struct GlaPre { u32x4 gd[4]; u32x4 q[2], k[2], v[2]; u32x4 wf; float wb; };
template <int MODE>
__device__ __forceinline__ void gla_prefetch(const Args& a, GlaPre& pre, int tid, int tb, int h, int dir, int stidx) {
    const bf16_t* U = (const bf16_t*)(a.ws + WS_U);
    const int lane = tid & 63, n = lane & 15, g = lane >> 4, w = tid >> 6;
#pragma unroll
    for (int it = 0; it < 4; ++it) { const int row = 16 * it + n, tok = dir ? tb + 63 - row : tb + row; pre.gd[it] = *(const u32x4*)(U + (size_t)tok * UP + C_GD + dir * 16 + 8 * (g & 1)); }
#pragma unroll
    for (int i = 0; i < 2; ++i) {
        const int idx = tid + 512 * i, row = idx >> 4, ch = idx & 15, tok = dir ? tb + 63 - row : tb + row;
        const bf16_t* ur = U + (size_t)tok * UP + h * 128 + ch * 8;
        pre.v[i] = *(const u32x4*)(ur + C_VA); pre.k[i] = *(const u32x4*)(ur + C_KA);
        if (MODE != 0) pre.q[i] = *(const u32x4*)(ur + C_QA);
    }
    pre.wf = ((const u32x4*)(a.ws + WS_GATE))[(dir * 4 + h) * 512 + tid];
    pre.wb = ((const float*)(a.ws + WS_GATE + 65536))[(dir * 4 + h) * 128 + 16 * w + n];
}
__device__ __forceinline__ bf16x8 tr_read8(LAS unsigned char* lds, unsigned a0, unsigned a1) {
    const s16x4 r0 = __builtin_amdgcn_ds_read_tr16_b64_v4i16((LAS s16x4*)(lds + a0)), r1 = __builtin_amdgcn_ds_read_tr16_b64_v4i16((LAS s16x4*)(lds + a1));
    return __builtin_shufflevector(r0, r1, 0, 1, 2, 3, 4, 5, 6, 7);
}
template <int CTRL> __device__ __forceinline__ float dpp_f(float x) { return __int_as_float(__builtin_amdgcn_update_dpp(0, __float_as_int(x), CTRL, 0xf, 0xf, true)); }
constexpr int GL_BP = 132;
__device__ __forceinline__ float gla_a1(LAS unsigned char* lds, const GlaPre& cur, const int w, const int n, const int g, const int par) {
    const bf16x8 wfrag = __builtin_bit_cast(bf16x8, cur.wf); const float wbias = cur.wb;
    float tot = 0.f;
    {
        LAS float* B = (LAS float*)(lds + GL_B);
        bf16x8 vh[2], vl[2];
#pragma unroll
        for (int ks = 0; ks < 2; ++ks) {
            float vv[8];
#pragma unroll
            for (int half = 0; half < 2; ++half) {
                const f32x4 x = MFMA16(__builtin_bit_cast(bf16x8, cur.gd[2 * ks + half]), wfrag, ((f32x4){wbias, wbias, wbias, wbias}));
#pragma unroll
                for (int r = 0; r < 4; ++r) { const float xs = x[r] * 1.4426950408889634f; vv[4 * half + r] = (fminf(xs, 0.f) - flog2(1.0f + fexp2(-fabsf(xs)))) * (1.0f / 16.0f); }
            }
            u32x4 hw, lw;
#pragma unroll
            for (int q = 0; q < 4; ++q) { const unsigned hp = pk2(vv[2 * q], vv[2 * q + 1]); hw[q] = hp;
                lw[q] = pk2(vv[2 * q] - __uint_as_float(hp << 16), vv[2 * q + 1] - __uint_as_float(hp & 0xffff0000u)); }
            vh[ks] = __builtin_bit_cast(bf16x8, hw); vl[ks] = __builtin_bit_cast(bf16x8, lw);
        }
        u32x4 ta, tbm;
#pragma unroll
        for (int q = 0; q < 2; ++q) { const unsigned lo = (4 * g + 2 * q <= n) ? 0x3f80u : 0u, hi = (4 * g + 2 * q + 1 <= n) ? 0x3f800000u : 0u; ta[q] = lo | hi; ta[2 + q] = 0u; tbm[q] = 0x3f803f80u; tbm[2 + q] = lo | hi; }
        const bf16x8 TA = __builtin_bit_cast(bf16x8, ta), TB = __builtin_bit_cast(bf16x8, tbm), ONES = __builtin_bit_cast(bf16x8, ((u32x4){0x3f803f80u, 0x3f803f80u, 0x3f803f80u, 0x3f803f80u}));
        const f32x4 z4 = (f32x4){0.f, 0.f, 0.f, 0.f};
        f32x4 bt[4];
        bt[0] = MFMA16(TA, vl[0], MFMA16(TA, vh[0], z4));
        bt[1] = MFMA16(TB, vl[0], MFMA16(TB, vh[0], z4));
        const f32x4 s32 = MFMA16(ONES, vl[0], MFMA16(ONES, vh[0], z4));
        bt[2] = MFMA16(TA, vl[1], MFMA16(TA, vh[1], s32));
        bt[3] = MFMA16(TB, vl[1], MFMA16(TB, vh[1], s32));
#pragma unroll
        for (int it = 0; it < 4; ++it)
#pragma unroll
            for (int r = 0; r < 4; ++r) B[(16 * it + 4 * g + r) * GL_BP + 16 * w + n] = bt[it][r];
        if (g == 3) { ((LAS float*)(lds + GL_EBL + par * 512))[16 * w + n] = fexp2(bt[3][3]); tot = bt[3][3]; }
    }
    return tot;
}
template <int MODE>
__device__ __forceinline__ void gla_chunk(const Args& a, LAS unsigned char* lds, const int tb, const int h, const int dir,
                                          f32x4 (&Sacc)[8], float& ntot, u32x4* stash, GlaPre& pre, const GlaPre& nxt, const int ntb, const int nh, const int ndir, const bool first, const int par) {
    const bf16_t* U = (const bf16_t*)(a.ws + WS_U);
    int tid = tid_now(); asm volatile("" : "+v"(tid));
    const int lane = tid & 63, w = __builtin_amdgcn_readfirstlane(tid >> 6), n = lane & 15, g = lane >> 4;
    const unsigned fn = ((n & 3) << 2) | ((n >> 2) & 3);
    const unsigned base_rr = 256u * n + 16u * (g ^ fn);
    const unsigned base_c = 256u * n + 16u * ((g >> 1) ^ fn) + 8u * (g & 1);
    const unsigned base_p = 128u * n + 16u * (g ^ (n & 7));
    const unsigned trb0 = tr16(lane, 0, 0, 0), trb1 = tr16(lane, 0, 0, 1);
    GlaPre& cur = pre;
    int prow[2], pch[2], ptok[2];
#pragma unroll
    for (int i = 0; i < 2; ++i) { const int idx = tid + 512 * i; prow[i] = idx >> 4; pch[i] = idx & 15; ptok[i] = dir ? tb + 63 - prow[i] : tb + prow[i]; }
    u32x4 st0, st1, zraw[2];
    __syncthreads();
#pragma unroll
    for (int i = 0; i < 2; ++i) {
        const LAS f32x4* bp = (const LAS f32x4*)(lds + GL_B + (prow[i] * GL_BP + pch[i] * 8) * 4);
        const f32x4 b0 = bp[0], b1 = bp[1];
        float e[8], kf[8];
#pragma unroll
        for (int j = 0; j < 4; ++j) { e[j] = fexp2(b0[j]); e[4 + j] = fexp2(b1[j]); }
        unpack8(cur.k[i], kf);
        u32x4 kw;
#pragma unroll
        for (int j = 0; j < 4; ++j) kw[j] = pk2(kf[2 * j] * __builtin_amdgcn_rcpf(e[2 * j]), kf[2 * j + 1] * __builtin_amdgcn_rcpf(e[2 * j + 1]));
        *(LAS u32x4*)(lds + GL_KT + offb(prow[i], pch[i])) = kw;
        *(LAS u32x4*)(lds + GL_VT + offb(prow[i], pch[i])) = cur.v[i];
        if (MODE != 0) {
            float qf[8]; unpack8(cur.q[i], qf);
            u32x4 qw;
#pragma unroll
            for (int j = 0; j < 4; ++j) qw[j] = pk2(qf[2 * j] * e[2 * j], qf[2 * j + 1] * e[2 * j + 1]);
            *(LAS u32x4*)(lds + GL_QT + offb(prow[i], pch[i])) = qw;
        }
    }
    __syncthreads();
    gla_prefetch<MODE>(a, pre, tid, ntb, nh, ndir, -1);
    f32x4 Oacc[4];
    if (MODE != 0) {
        const int it = w >> 1;
#pragma unroll
        for (int jj = 0; jj < 2; ++jj) {
            const int jt = 2 * (w & 1) + jj;
            f32x4 pacc = (f32x4){0.f, 0.f, 0.f, 0.f};
            if (jt <= it) {
#pragma unroll
                for (int s = 0; s < 4; ++s) {
                    const bf16x8 qa = *(const LAS bf16x8*)(lds + GL_QT + (base_rr ^ (64u * s)) + 4096u * it);
                    const bf16x8 kb = *(const LAS bf16x8*)(lds + GL_KT + (base_rr ^ (64u * s)) + 4096u * jt); pacc = MFMA16(qa, kb, pacc); }
            }
            const int j = 16 * jt + n;
#pragma unroll
            for (int r = 0; r < 4; ++r) {
                const int i = 16 * it + 4 * g + r;
                const bool keep = (MODE == 1) ? (j <= i) : (j < i);
                *(LAS bf16_t*)(lds + GL_PT + offp(i, j >> 3) + 2 * (j & 7)) = keep ? f2bf(pacc[r]) : (bf16_t)0;
            }

        }
        if (first) {
#pragma unroll
            for (int kt = 0; kt < 8; ++kt) { const unsigned r0 = __float_as_uint(Sacc[kt][0]), r1 = __float_as_uint(Sacc[kt][1]);
                Sacc[kt] = (f32x4){__uint_as_float(r0 << 16), __uint_as_float(r0 & 0xffff0000u), __uint_as_float(r1 << 16), __uint_as_float(r1 & 0xffff0000u)}; }
        }
#pragma unroll
        for (int i2 = 0; i2 < 4; ++i2) Oacc[i2] = (f32x4){0.f, 0.f, 0.f, 0.f};
#pragma unroll
        for (int ks = 0; ks < 4; ++ks) {
            u32x4 pw; pw.x = pk2(Sacc[2 * ks][0], Sacc[2 * ks][1]); pw.y = pk2(Sacc[2 * ks][2], Sacc[2 * ks][3]); pw.z = pk2(Sacc[2 * ks + 1][0], Sacc[2 * ks + 1][1]); pw.w = pk2(Sacc[2 * ks + 1][2], Sacc[2 * ks + 1][3]);
            const bf16x8 sb = __builtin_bit_cast(bf16x8, pw);
            const unsigned alo = base_c ^ (64u * ks);
#pragma unroll
            for (int i2 = 0; i2 < 4; ++i2) {
                const u32x2 lo = *(const LAS u32x2*)(lds + GL_QT + 4096 * i2 + alo);
                const u32x2 hi = *(const LAS u32x2*)(lds + GL_QT + 4096 * i2 + (alo ^ 32u));
                u32x4 aw; aw.x = lo.x; aw.y = lo.y; aw.z = hi.x; aw.w = hi.y;
                Oacc[i2] = MFMA16(__builtin_bit_cast(bf16x8, aw), sb, Oacc[i2]);
            }

        }
        __syncthreads();
        if (MODE == 2) {
            st0 = stash[tid * 2]; st1 = stash[tid * 2 + 1];
#pragma unroll
            for (int i = 0; i < 2; ++i) zraw[i] = *(const u32x4*)(U + (size_t)ptok[i] * UP + C_ZA + h * 128 + pch[i] * 8);
        }
    }
    bf16x8 vf[2];
#pragma unroll
    for (int ks = 0; ks < 2; ++ks) vf[ks] = tr_read8(lds, GL_VT + 8192u * ks + (trb0 ^ (32u * w)), GL_VT + 8192u * ks + (trb1 ^ (32u * w)));
    if (MODE != 0) {
#pragma unroll
        for (int i2 = 0; i2 < 4; ++i2)
#pragma unroll
            for (int ks = 0; ks < 2; ++ks) {
                if (ks <= (i2 >> 1)) { const bf16x8 pa = *(const LAS bf16x8*)(lds + GL_PT + 2048 * i2 + (base_p ^ (64u * ks))); Oacc[i2] = MFMA16(pa, vf[ks], Oacc[i2]); }
            }
    }
#pragma unroll
    for (int kt = 0; kt < 8; ++kt) {
#pragma unroll
        for (int ks = 0; ks < 2; ++ks) { const bf16x8 ka = tr_read8(lds, GL_KT + 8192u * ks + (trb0 ^ (32u * kt)), GL_KT + 8192u * ks + (trb1 ^ (32u * kt))); Sacc[kt] = MFMA16(ka, vf[ks], Sacc[kt]); }
        const f32x4 eb = *(const LAS f32x4*)(lds + GL_EBL + par * 512 + (16 * kt + 4 * g) * 4);
        Sacc[kt] = Sacc[kt] * eb;
        if (kt & 1) __builtin_amdgcn_sched_barrier(0);
    }
    ntot = gla_a1(lds, nxt, w, n, g, par ^ 1);
    if (MODE == 1) {
        u32x4 s0, s1;
        s0.x = pk2(Oacc[3][3], Oacc[3][2]); s0.y = pk2(Oacc[3][1], Oacc[3][0]); s0.z = pk2(Oacc[2][3], Oacc[2][2]); s0.w = pk2(Oacc[2][1], Oacc[2][0]);
        s1.x = pk2(Oacc[1][3], Oacc[1][2]); s1.y = pk2(Oacc[1][1], Oacc[1][0]); s1.z = pk2(Oacc[0][3], Oacc[0][2]); s1.w = pk2(Oacc[0][1], Oacc[0][0]);
        const int tidm = tid ^ 48;
        stash[tidm * 2] = s0; stash[tidm * 2 + 1] = s1;
    }
    if (MODE == 2) {
        float fo[16]; { float t8[8]; unpack8(st0, t8);
#pragma unroll
            for (int j = 0; j < 8; ++j) fo[j] = t8[j]; unpack8(st1, t8);
#pragma unroll
            for (int j = 0; j < 8; ++j) fo[8 + j] = t8[j]; }
        LAS float* ssw = (LAS float*)(lds + GL_SSW);
#pragma unroll
        for (int i2 = 0; i2 < 4; ++i2)
#pragma unroll
            for (int r = 0; r < 4; ++r) {
                const float o = Oacc[i2][r] + fo[4 * i2 + r]; Oacc[i2][r] = o;
                float v = o * o; v += dpp_f<0x128>(v); v += dpp_f<0x124>(v); v += dpp_f<0x122>(v); v += dpp_f<0x121>(v);
                if (n == 0) ssw[w * 64 + 16 * i2 + 4 * g + r] = v;
            }
        __syncthreads();
        if (tid < 64) { float s = 0.f;
#pragma unroll
            for (int ww = 0; ww < 8; ++ww) s += ssw[ww * 64 + tid];
            ((LAS float*)(lds + GL_RSTD))[tid] = rsqrtf(s * (1.0f / 128.0f) + NORM_EPS); }
        __syncthreads();
        const float gn = a.ng[16 * w + n];
#pragma unroll
        for (int i2 = 0; i2 < 4; ++i2) {
            const f32x4 rs = *(const LAS f32x4*)(lds + GL_RSTD + (16 * i2 + 4 * g) * 4);
#pragma unroll
            for (int r = 0; r < 4; ++r) *(LAS bf16_t*)(lds + GL_QT + (16 * i2 + 4 * g + r) * 256 + (16 * w + n) * 2) = f2bf(Oacc[i2][r] * rs[r] * gn);
        }
        __syncthreads();
        bf16_t* ymix = (bf16_t*)((unsigned char*)a.out + 96 * MiB);
#pragma unroll
        for (int i = 0; i < 2; ++i) {
            const u32x4 ov = *(const LAS u32x4*)(lds + GL_QT + prow[i] * 256 + pch[i] * 16);
            float of[8], zf[8]; unpack8(ov, of); unpack8(zraw[i], zf);
            u32x4 yw;
#pragma unroll
            for (int j = 0; j < 4; ++j) yw[j] = pk2(of[2 * j] * silu(zf[2 * j]), of[2 * j + 1] * silu(zf[2 * j + 1]));
            *(u32x4*)(ymix + (size_t)ptok[i] * DM + h * 128 + pch[i] * 8) = yw;
        }
    }
}
__device__ __forceinline__ void build_gate_tables(const Args& a) {
    for (int e = blockIdx.x * NTHR + tid_now(); e < 8 * 512; e += gridDim.x * NTHR) {
        const int dh = e >> 9, tid = e & 511, dir = dh >> 2, h = dh & 3, lane = tid & 63, w = tid >> 6, n = lane & 15, g = lane >> 4, col = h * 128 + 16 * w + n;
        const float* wup = dir ? a.wub : a.wuf; const float* bias = dir ? a.bbw : a.bfw;
        u32x4 pw;
#pragma unroll
        for (int j = 0; j < 4; ++j) {
            const float v0 = wup[(8 * (g & 1) + 2 * j) * 512 + col], v1 = wup[(8 * (g & 1) + 2 * j + 1) * 512 + col];
            const float h0 = bf2f(f2bf(v0)), h1 = bf2f(f2bf(v1));
            pw[j] = g < 2 ? pk2(v0, v1) : pk2(v0 - h0, v1 - h1);
        }
        ((u32x4*)(a.ws + WS_GATE))[e] = pw;
        if (g == 0) ((float*)(a.ws + WS_GATE + 65536))[dh * 128 + 16 * w + n] = bias[col];
    }
}
__device__ __forceinline__ void phase_gla_pass1(const Args& a, LAS unsigned char* lds) {
    const int tid = tid_now(), w = tid >> 6, lane = tid & 63;
    unsigned char* ST = a.ws + WS_ST;
    const int nsteps = ((NSEG * 8 - (int)blockIdx.x + (int)gridDim.x - 1) / (int)gridDim.x) * 4;
    auto params = [&](int st, int& tb, int& h, int& dir) { if (st >= nsteps) st = nsteps - 1; const int item = blockIdx.x + (st >> 2) * gridDim.x, cc = st & 3; dir = item & 1; h = (item >> 1) & 3; tb = (item >> 3) * 256 + (dir ? 3 - cc : cc) * 64; };
    GlaPre preA, preB; int par = 0;
    float ctot = 0.f;
    if (nsteps > 0) { int tb, h, dir; params(0, tb, h, dir); gla_prefetch<0>(a, preA, tid, tb, h, dir, -1); params(1, tb, h, dir); gla_prefetch<0>(a, preB, tid, tb, h, dir, -1);
        ctot = gla_a1(lds, preA, w, lane & 15, lane >> 4, 0); }
    f32x4 Sacc[8]; float lam;
    for (int st = 0; st < nsteps; st += 2) {
        const int item = blockIdx.x + (st >> 2) * gridDim.x;
        if ((st & 3) == 0) {
#pragma unroll
            for (int kt = 0; kt < 8; ++kt) Sacc[kt] = (f32x4){0.f, 0.f, 0.f, 0.f};
            lam = 0.f;
        }
        { int tb, h, dir, ntb, nh, ndir; params(st, tb, h, dir); params(st + 2, ntb, nh, ndir); lam += ctot; gla_chunk<0>(a, lds, tb, h, dir, Sacc, ctot, nullptr, preA, preB, ntb, nh, ndir, false, par); par ^= 1; }
        { int tb, h, dir, ntb, nh, ndir; params(st + 1, tb, h, dir); params(st + 3, ntb, nh, ndir); lam += ctot; gla_chunk<0>(a, lds, tb, h, dir, Sacc, ctot, nullptr, preB, preA, ntb, nh, ndir, false, par); par ^= 1; }
        if ((st & 3) == 2) {
            u32x2* dst = (u32x2*)(ST + (size_t)item * 32768) + (size_t)w * 8 * 64 + lane;
#pragma unroll
            for (int kt = 0; kt < 8; ++kt) { u32x2 v; v.x = pk2(Sacc[kt][0], Sacc[kt][1]); v.y = pk2(Sacc[kt][2], Sacc[kt][3]); dst[kt * 64] = v; }
            if ((lane >> 4) == 3) ((float*)(a.ws + WS_DEC))[(size_t)item * 128 + 16 * w + (lane & 15)] = lam;
        }
    }
    __syncthreads();
}
__device__ __forceinline__ void phase_gla_pass2(const Args& a) {
    unsigned char* ST = a.ws + WS_ST; const float* DEC = (const float*)(a.ws + WS_DEC);
    for (int gidx = blockIdx.x * NTHR + tid_now(); gidx < 48 * 4096; gidx += gridDim.x * NTHR) {
        const int chain = gidx >> 12, quad = gidx & 4095, dir = chain & 1, h = (chain >> 1) & 3, s = chain >> 3;
        const int nseg = s < 2 ? LP / 256 : LS / 256, seg0 = s < 2 ? s * (LP / 256) : 2 * (LP / 256) + (s - 2) * (LS / 256);
        const int kt = (quad >> 6) & 7, lane = quad & 63, dk0 = 16 * kt + 4 * (lane >> 4);
        f32x4 S = (f32x4){0.f, 0.f, 0.f, 0.f};
        for (int i0 = 0; i0 < nseg; i0 += 8) {
            u32x2 t[8]; f32x4 lm[8];
#pragma unroll
            for (int j = 0; j < 8; ++j) { const int seg = dir ? seg0 + nseg - 1 - (i0 + j) : seg0 + i0 + j; const size_t idx = (size_t)((seg * 4 + h) * 2 + dir);
                t[j] = ((const u32x2*)(ST + idx * 32768))[quad]; lm[j] = *(const f32x4*)(DEC + idx * 128 + dk0); }
#pragma unroll
            for (int j = 0; j < 8; ++j) { const int seg = dir ? seg0 + nseg - 1 - (i0 + j) : seg0 + i0 + j; const size_t idx = (size_t)((seg * 4 + h) * 2 + dir);
                u32x2 o; o.x = pk2(S[0], S[1]); o.y = pk2(S[2], S[3]); ((u32x2*)(ST + idx * 32768))[quad] = o;
                const f32x4 tv = (f32x4){__uint_as_float(t[j].x << 16), __uint_as_float(t[j].x & 0xffff0000u), __uint_as_float(t[j].y << 16), __uint_as_float(t[j].y & 0xffff0000u)};
                S = (f32x4){fexp2(lm[j][0]), fexp2(lm[j][1]), fexp2(lm[j][2]), fexp2(lm[j][3])} * S + tv; }
        }
    }
}
__device__ __forceinline__ void phase_gla_pass3(const Args& a, LAS unsigned char* lds) {
    const int tid = tid_now(), w = tid >> 6, lane = tid & 63;
    GlaPre pre; int par = 0; float ctot = 0.f;
    if (blockIdx.x < NSEG * 4) { gla_prefetch<1>(a, pre, tid, (blockIdx.x >> 2) * 256, blockIdx.x & 3, 0, -1); ctot = gla_a1(lds, pre, w, lane & 15, lane >> 4, 0); }
    for (int item = blockIdx.x; item < NSEG * 4; item += gridDim.x) {
        const int h = item & 3, seg = item >> 2;
        const int nitem = item + gridDim.x < NSEG * 4 ? item + gridDim.x : item;
        u32x4* stash = (u32x4*)a.out + (size_t)item * 4 * 1024;
#pragma unroll 1
        for (int dir = 0; dir < 2; ++dir) {
            f32x4 Sacc[8];
            const u32x2* src = (const u32x2*)(a.ws + WS_ST + (size_t)((seg * 4 + h) * 2 + dir) * 32768) + (size_t)w * 8 * 64 + lane;
#pragma unroll
            for (int kt = 0; kt < 8; ++kt) { const u32x2 v = src[kt * 64]; Sacc[kt] = (f32x4){__uint_as_float(v.x), __uint_as_float(v.y), 0.f, 0.f}; }
            if (dir == 0) {
                for (int c = 0; c < 4; ++c) { const int ntb = seg * 256 + (c < 3 ? c + 1 : 3) * 64, ndir = c < 3 ? 0 : 1;
                    gla_chunk<1>(a, lds, seg * 256 + c * 64, h, 0, Sacc, ctot, stash + c * 1024, pre, pre, ntb, h, ndir, c == 0, par); par ^= 1; }
            } else {
                for (int c = 3; c >= 0; --c) { const int ntb = c > 0 ? seg * 256 + (c - 1) * 64 : (nitem >> 2) * 256, nh = c > 0 ? h : (nitem & 3), ndir = c > 0 ? 1 : 0;
                    gla_chunk<2>(a, lds, seg * 256 + c * 64, h, 1, Sacc, ctot, stash + c * 1024, pre, pre, ntb, nh, ndir, c == 3, par); par ^= 1; }
            }
        }
    }
    __syncthreads();
}
typedef float f32x16 __attribute__((ext_vector_type(16)));
#define MFMA32(a, b, c) __builtin_amdgcn_mfma_f32_32x32x16_bf16((a), (b), (c), 0, 0, 0)
constexpr int SW_K = 0, SW_V = 65536, SW_TB = 131072, SW_TBN = 336, SW_TBH = 4 * SW_TBN * 4;
constexpr float SW_NEG = -1e30f;
__device__ __forceinline__ unsigned offk(unsigned row, unsigned c8) { return 128u * row + 16u * (c8 ^ ((row >> 1) & 7)); }
__device__ __forceinline__ unsigned offv(unsigned row, unsigned c8) { return 128u * row + 16u * (c8 ^ (((row >> 1) & 1) << 2)); }
__device__ __forceinline__ void swa_load_block(const bf16_t* U, int gb, int kvh, bool valid, int tid, u32x4 (&kk)[2], u32x4 (&vv)[2]) {
#pragma unroll
    for (int i = 0; i < 2; ++i) {
        const int idx = tid + 512 * i, r = idx >> 3, c8 = idx & 7;
        kk[i] = (u32x4){0, 0, 0, 0}; vv[i] = (u32x4){0, 0, 0, 0};
        if (valid) { const bf16_t* ur = U + (size_t)(gb * 128 + r) * UP + kvh * 64 + c8 * 8; kk[i] = __builtin_nontemporal_load((const u32x4*)(ur + C_KB)); vv[i] = __builtin_nontemporal_load((const u32x4*)(ur + C_VB)); }
    }
}
__device__ __forceinline__ void swa_store_block(LAS unsigned char* lds, int gb, int tid, const u32x4 (&kk)[2], const u32x4 (&vv)[2]) {
#pragma unroll
    for (int i = 0; i < 2; ++i) {
        const int idx = tid + 512 * i, r = 128 * (gb & 3) + (idx >> 3), c8 = idx & 7;
        *(LAS u32x4*)(lds + SW_K + offk(r, c8)) = kk[i]; *(LAS u32x4*)(lds + SW_V + offv(r, c8)) = vv[i];
    }
}
__device__ __forceinline__ bool swa_exists(int gb) { return gb >= 0 && gb < NTOK / 128; }
__device__ __forceinline__ void phase_swa(const Args& a, LAS unsigned char* lds) {
    const bf16_t* U = (const bf16_t*)(a.ws + WS_U); bf16_t* ymix = (bf16_t*)((unsigned char*)a.out + 96 * MiB);
    const int tid = tid_now(), lane = tid & 63, w = __builtin_amdgcn_readfirstlane(tid >> 6), r = lane & 31, hh = lane >> 5;
    for (int su = blockIdx.x; su < (NTOK / 128 / 3) * 2; su += gridDim.x) {
        const int kvh = su & 1, qb0 = 3 * (su >> 1);
        __syncthreads();
        for (int e = tid; e < 4 * SW_TBN; e += NTHR) {
            const int hl = e / SW_TBN, idx = e - hl * SW_TBN, rel = idx - 160;
            const float val = (rel >= -128 && rel <= 128) ? a.relb[t5_bucket(rel) * 8 + kvh * 4 + hl] : SW_NEG;
            LAS float* tb = (LAS float*)(lds + SW_TB + hl * SW_TBH);
#pragma unroll
            for (int s = 0; s < 4; ++s) if (idx - s >= 0) tb[s * SW_TBN + idx - s] = val;
        }
#pragma unroll 1
        for (int bb = -1; bb <= 1; ++bb) { u32x4 kk[2], vv[2]; swa_load_block(U, qb0 + bb, kvh, swa_exists(qb0 + bb), tid, kk, vv); swa_store_block(lds, qb0 + bb, tid, kk, vv); }
        __syncthreads();
        const int hl = w >> 1, hq = kvh * 4 + hl;
        const float snk = a.sink[hq];
#pragma unroll 1
        for (int qi = 0; qi < 3; ++qi) {
            const int qb = qb0 + qi, tok0 = qb * 128; int s0, L; seq_of(tok0, s0, L);
            const bool first = tok0 == s0, last = tok0 + 128 == s0 + L;
            u32x4 nk[2], nv[2];
            if (qi < 2) swa_load_block(U, qb + 2, kvh, swa_exists(qb + 2), tid, nk, nv);
            bf16x8 Qn[4];
            { const int qt0 = tok0 + 32 * ((w & 1) * 2) + r;
#pragma unroll
              for (int s = 0; s < 4; ++s) Qn[s] = *(const bf16x8*)(U + (size_t)qt0 * UP + C_QB + hq * 64 + 16 * s + 8 * hh); }
#pragma unroll 1
            for (int ss = 0; ss < 2; ++ss) {
                const int st = (w & 1) * 2 + ss, qtok = tok0 + 32 * st + r;
                bf16x8 Qf[4];
#pragma unroll
                for (int s = 0; s < 4; ++s) Qf[s] = Qn[s];
                { const int qt1 = ss == 0 ? qtok + 32 : qtok;
#pragma unroll
                  for (int s = 0; s < 4; ++s) Qn[s] = *(const bf16x8*)(U + (size_t)qt1 * UP + C_QB + hq * 64 + 16 * s + 8 * hh); }
                u32x2 zv8[2][4];
#pragma unroll
                for (int dt = 0; dt < 2; ++dt)
#pragma unroll
                    for (int i4 = 0; i4 < 4; ++i4) zv8[dt][i4] = *(const u32x2*)(U + (size_t)qtok * UP + C_ZB + hq * 64 + 32 * dt + 8 * i4 + 4 * hh);
                float m = snk, l = hh == 0 ? 1.0f : 0.0f;
                f32x16 O[2];
#pragma unroll
                for (int i = 0; i < 16; ++i) { O[0][i] = 0.f; O[1][i] = 0.f; }
                const int sft = (-r) & 3;
                const unsigned tbase = SW_TB + hl * SW_TBH + sft * (SW_TBN * 4) + 4 * (32 + 4 * hh - r - sft);
                const unsigned kb0 = SW_K + 128u * r + 16u * (hh ^ ((r >> 1) & 7));
                const int q4 = (lane & 15) >> 2, p4 = lane & 3, g1 = (lane >> 4) & 1, xq = (q4 >> 1) & 1;
                const unsigned vb0 = SW_V + 128u * (4 * hh + q4) + 16u * ((4 * xq) | (2 * g1) | (p4 >> 1)) + 8u * (p4 & 1);
#pragma unroll 1
                for (int grp = 0; grp < 3; ++grp) {
                    f32x16 S[3];
#pragma unroll
                    for (int k3 = 0; k3 < 3; ++k3) {
                        const int kk = 3 * grp + k3, kt = st + kk, blk = kt >> 2;
                        const bool valid = !((blk == 0 && first) || (blk == 2 && last));
                        const unsigned rowb = 128u * (128u * ((unsigned)(qb - 1 + blk) & 3u) + 32u * (kt & 3));
                        if (valid) {
#pragma unroll
                            for (int i = 0; i < 16; ++i) S[k3][i] = 0.f;
#pragma unroll
                            for (int s = 0; s < 4; ++s) { const bf16x8 Kf = *(const LAS bf16x8*)(lds + (kb0 ^ (32u * s)) + rowb); S[k3] = MFMA32(Kf, Qf[s], S[k3]); }
#pragma unroll
                            for (int i4 = 0; i4 < 4; ++i4) { const f32x4 bv = *(const LAS f32x4*)(lds + tbase + 4 * (32 * kk + 8 * i4));
#pragma unroll
                                for (int j = 0; j < 4; ++j) S[k3][4 * i4 + j] += bv[j]; }
                        } else {
#pragma unroll
                            for (int i = 0; i < 16; ++i) S[k3][i] = SW_NEG;
                        }
                    }
                    float mx4[4] = {SW_NEG, SW_NEG, SW_NEG, SW_NEG};
#pragma unroll
                    for (int k3 = 0; k3 < 3; ++k3)
#pragma unroll
                        for (int i = 0; i < 16; ++i) mx4[i & 3] = fmaxf(mx4[i & 3], S[k3][i]);
                    float mx = fmaxf(fmaxf(mx4[0], mx4[1]), fmaxf(mx4[2], mx4[3]));
                    mx = fmaxf(mx, __shfl_xor(mx, 32));
                    const float mn = fmaxf(m, mx), alpha = fexp(m - mn);
                    m = mn; l *= alpha;
#pragma unroll
                    for (int i = 0; i < 16; ++i) { O[0][i] *= alpha; O[1][i] *= alpha; }
                    bf16x8 Pf[3][2];
                    float l4[4] = {0.f, 0.f, 0.f, 0.f};
#pragma unroll
                    for (int k3 = 0; k3 < 3; ++k3) {
#pragma unroll
                        for (int i = 0; i < 16; ++i) { const float pv = fexp(S[k3][i] - m); S[k3][i] = pv; l4[i & 3] += pv; }
#pragma unroll
                        for (int s2 = 0; s2 < 2; ++s2) {
                            u32x4 pw;
#pragma unroll
                            for (int j = 0; j < 4; ++j) pw[j] = pk2(S[k3][8 * s2 + 2 * j], S[k3][8 * s2 + 2 * j + 1]);
                            Pf[k3][s2] = __builtin_bit_cast(bf16x8, pw);
                        }
                    }
                    l += (l4[0] + l4[1]) + (l4[2] + l4[3]);
#pragma unroll
                    for (int k3 = 0; k3 < 3; ++k3) {
                        const int kt = st + 3 * grp + k3, blk = kt >> 2;
                        const unsigned rowb = 128u * (128u * ((unsigned)(qb - 1 + blk) & 3u) + 32u * (kt & 3));
#pragma unroll
                        for (int s2 = 0; s2 < 2; ++s2)
#pragma unroll
                            for (int dt = 0; dt < 2; ++dt) {
                                const unsigned va = (vb0 ^ (64u * dt)) + rowb + 2048u * s2;
                                const bf16x8 Vf = tr_read8(lds, va, va + 1024u);
                                O[dt] = MFMA32(Vf, Pf[k3][s2], O[dt]);
                            }
                    }
                }
                l += __shfl_xor(l, 32);
                const float inv = __builtin_amdgcn_rcpf(l);
#pragma unroll
                for (int dt = 0; dt < 2; ++dt)
#pragma unroll
                    for (int i4 = 0; i4 < 4; ++i4) {
                        const int d0 = 32 * dt + 8 * i4 + 4 * hh;
                        const u32x2 zv = zv8[dt][i4];
                        const float z0 = __uint_as_float(zv.x << 16), z1 = __uint_as_float(zv.x & 0xffff0000u), z2 = __uint_as_float(zv.y << 16), z3 = __uint_as_float(zv.y & 0xffff0000u);
                        u32x2 yw; yw.x = pk2(O[dt][4 * i4] * inv * silu(z0), O[dt][4 * i4 + 1] * inv * silu(z1)); yw.y = pk2(O[dt][4 * i4 + 2] * inv * silu(z2), O[dt][4 * i4 + 3] * inv * silu(z3));
                        *(u32x2*)(ymix + (size_t)qtok * DM + 512 + hq * 64 + d0) = yw;
                    }
            }
            if (qi < 2) swa_store_block(lds, qb + 2, tid, nk, nv);
            __syncthreads();
        }
    }
}
__device__ __forceinline__ void phase_convfix(const Args& a) {
    bf16_t* G = (bf16_t*)(a.ws + WS_XB); const float* Pb = (const float*)(a.ws + WS_PB); const float* Sb = (const float*)(a.ws + WS_SB);
    for (int idx = blockIdx.x * NTHR + tid_now(); idx < (NTOK / 64 - 1) * 256; idx += gridDim.x * NTHR) {
        const int k = idx / 256 + 1, c = (idx & 255) * 4, row = 64 * k; int s0, L; seq_of(row, s0, L);
        if (row == s0) continue;
        const f32x4 pl = *(const f32x4*)(Pb + (size_t)((k - 1) * 2 + 1) * 1024 + c), sl = *(const f32x4*)(Sb + (size_t)((k - 1) * 2 + 1) * 1024 + c);
        const f32x4 pf = *(const f32x4*)(Pb + (size_t)(k * 2) * 1024 + c), sf = *(const f32x4*)(Sb + (size_t)(k * 2) * 1024 + c);
        const f32x4 c0 = *(const f32x4*)(a.cw + c), c2 = *(const f32x4*)(a.cw + 2048 + c);
        u32x2* gl = (u32x2*)(G + (size_t)(row - 1) * DM + c); u32x2* gf = (u32x2*)(G + (size_t)row * DM + c);
        const u32x2 a0 = *gl, a1 = *gf;
        const f32x4 dl = sl * c2 * pf, df = sf * c0 * pl;
        u32x2 o0, o1;
        o0.x = pk2(__uint_as_float(a0.x << 16) + dl[0], __uint_as_float(a0.x & 0xffff0000u) + dl[1]); o0.y = pk2(__uint_as_float(a0.y << 16) + dl[2], __uint_as_float(a0.y & 0xffff0000u) + dl[3]);
        o1.x = pk2(__uint_as_float(a1.x << 16) + df[0], __uint_as_float(a1.x & 0xffff0000u) + df[1]); o1.y = pk2(__uint_as_float(a1.y << 16) + df[2], __uint_as_float(a1.y & 0xffff0000u) + df[3]);
        *gl = o0; *gf = o1;
    }
}
__global__ void __launch_bounds__(NTHR, 2) mega(Args a) {
    LAS unsigned char* lds = (LAS unsigned char*)lds_raw;
    volatile LAS unsigned* MISC = (volatile LAS unsigned*)(lds + MISC_OFF);
    if (threadIdx.x < 32) MISC[threadIdx.x] = 0u;
    if ((threadIdx.x & 63) == 0) ((volatile LAS unsigned*)(lds + SLOT_OFF))[hw_slot()] = threadIdx.x >> 6;
    __syncthreads();
    unsigned char* ws = a.ws; float* out = a.out;
    XcdBarrier bar = xcd_barrier_post((unsigned*)(ws + WS_CTL) + 4096, MISC + 8);
    bf16_t* W1t = (bf16_t*)(ws + WS_W1T); bf16_t* W2t = (bf16_t*)(ws + WS_W2T); bf16_t* W3t = (bf16_t*)(ws + WS_W3T); bf16_t* W4t = (bf16_t*)(ws + WS_W4T);
    bf16_t* xb = (bf16_t*)(ws + WS_XB); bf16_t* ymix = (bf16_t*)((unsigned char*)out + 96 * MiB); bf16_t* G = xb; bf16_t* U = (bf16_t*)(ws + WS_U);
    bf16_t* x1b = (bf16_t*)(ws + WS_X1B); bf16_t* P = (bf16_t*)(ws + WS_P); bf16_t* Sg = (bf16_t*)(ws + WS_S);
    f32x2* stat1 = (f32x2*)(ws + WS_STAT1); f32x2* stat2 = (f32x2*)(ws + WS_STAT2); f32x2* mr1 = (f32x2*)(ws + WS_MR1);

    phase_convert(a, lds);
    xcd_barrier(bar);
    { pg8::Gemm g{xb, W1t, NTOK, C_GD, DM, 0}; pg8::StaticOrder S; S.init(NTOK, C_GD, gridDim.x, blockIdx.x); EpiU E{U}; pg8::gemm_phase<EpiU, pg8::StaticOrder>(lds, g, S, E); }
    xcd_barrier(bar);
    phase_gla_pass1(a, lds);
    xcd_barrier(bar);
    phase_gla_pass2(a);
    phase_swa(a, lds);
    xcd_barrier(bar);
    phase_gla_pass3(a, lds);
    xcd_barrier(bar);
    { pg8::Gemm g{ymix, W2t, NTOK, DM, DM, 0}; pg8::StaticOrder S; S.init(NTOK, DM, gridDim.x, blockIdx.x);
      EpiLN<0> E{ws, nullptr, a.lng, a.lnb}; pg8::gemm_phase<EpiLN<0>, pg8::StaticOrder>(lds, g, S, E); }
    xcd_barrier(bar);
    { pg8::Gemm g{x1b, W3t, NTOK, 4096, DM, 0}; pg8::StaticOrder S; S.init(NTOK, 4096, gridDim.x, blockIdx.x); EpiG E{ws, a.cw}; pg8::gemm_phase<EpiG, pg8::StaticOrder>(lds, g, S, E); }
    xcd_barrier(bar);
    phase_convfix(a);
    xcd_barrier(bar);
    { pg8::Gemm g{G, W4t, NTOK, DM, DM, 0}; pg8::StaticOrder S; S.init(NTOK, DM, gridDim.x, blockIdx.x);
      EpiLN<1> E{ws, out, a.lng + DM, a.lnb + DM}; pg8::gemm_phase<EpiLN<1>, pg8::StaticOrder>(lds, g, S, E); }
}

extern "C" void kernel_launch(void* const* d_in, const int* in_sizes, int n_in, void* d_out, int out_size, void* d_ws, size_t ws_size, hipStream_t stream) {
    static int grid = 0;
    if (grid == 0) {
        if (n_in != 16 || out_size != NTOK * DM || ws_size < WS_END) { fprintf(stderr, "kernel_launch: unexpected shapes (n_in %d out %d ws %zu)\n", n_in, out_size, ws_size); grid = -1; return; }
        int dev = 0, cus = 0, per_cu = 0;
        if (hipGetDevice(&dev) != hipSuccess || hipDeviceGetAttribute(&cus, hipDeviceAttributeMultiprocessorCount, dev) != hipSuccess) { grid = -1; return; }
        if (hipFuncSetAttribute((const void*)mega, hipFuncAttributeMaxDynamicSharedMemorySize, LDS_BYTES) != hipSuccess) { fprintf(stderr, "kernel_launch: hipFuncSetAttribute failed\n"); grid = -1; return; }
        if (hipOccupancyMaxActiveBlocksPerMultiprocessor(&per_cu, (const void*)mega, NTHR, LDS_BYTES) != hipSuccess || per_cu < 1) { fprintf(stderr, "kernel_launch: occupancy query says %d blocks per CU\n", per_cu); (void)hipGetLastError(); grid = -1; return; }
        grid = cus;
    }
    if (grid < 0) return;
    (void)hipMemsetAsync((char*)d_ws + WS_CTL, 0, 262144, stream);
    Args a{};
    a.xp = (const float*)d_in[0]; a.xs = (const float*)d_in[1]; a.w_in_even = (const float*)d_in[2]; a.wuf = (const float*)d_in[3]; a.bfw = (const float*)d_in[4];
    a.wub = (const float*)d_in[5]; a.bbw = (const float*)d_in[6]; a.ng = (const float*)d_in[7]; a.sink = (const float*)d_in[8]; a.relb = (const float*)d_in[9];
    a.w_out_even = (const float*)d_in[10]; a.w_in_odd = (const float*)d_in[11]; a.cw = (const float*)d_in[12]; a.w_out_odd = (const float*)d_in[13];
    a.lng = (const float*)d_in[14]; a.lnb = (const float*)d_in[15]; a.out = (float*)d_out; a.ws = (unsigned char*)d_ws;
    hipLaunchKernelGGL(mega, dim3(grid), dim3(NTHR), LDS_BYTES, stream, a);
}
```

```cpp
#include <hip/hip_runtime.h>
#include <cstdio>

typedef unsigned short bf16_t;
typedef short bf16x8 __attribute__((ext_vector_type(8)));
typedef float f32x4 __attribute__((ext_vector_type(4)));
typedef float f32x2 __attribute__((ext_vector_type(2)));
typedef unsigned u32x4 __attribute__((ext_vector_type(4)));
typedef unsigned u32x2 __attribute__((ext_vector_type(2)));
#define LAS __attribute__((address_space(3)))
#define MFMA16(a, b, c) __builtin_amdgcn_mfma_f32_16x16x32_bf16((a), (b), (c), 0, 0, 0)
extern __shared__ __attribute__((aligned(16))) unsigned char lds_raw[];
constexpr int SLOT_OFF = 163840 - 1024;
__device__ __forceinline__ unsigned hw_slot() { return (unsigned)__builtin_amdgcn_s_getreg((5 << 11) | 4) & 63u; }
__device__ __forceinline__ int tid_now() {
    const int wid = __builtin_amdgcn_readfirstlane((int)((volatile LAS unsigned*)((LAS unsigned char*)lds_raw + SLOT_OFF))[hw_slot()]);
    return wid * 64 + (int)__lane_id();
}

constexpr int DM = 1024, NTOK = 49152, NPROMPT = 32768, LP = 16384, LS = 4096;
constexpr int UP = 3584;
constexpr int C_QA = 0, C_KA = 512, C_VA = 1024, C_ZA = 1536, C_QB = 2048, C_KB = 2560, C_VB = 2688, C_ZB = 2816, C_GD = 3328;
constexpr int EVEN_IN = 3360, ODD_IN = 4096;
constexpr float DN_ALPHA = 1.41421356237309515f;
constexpr float LN_EPS = 1e-5f, NORM_EPS = 1e-6f;

constexpr size_t MiB = 1u << 20;
constexpr size_t WS_CTL = 0, WS_W1T = 1 * MiB, WS_W2T = 8 * MiB, WS_W3T = 10 * MiB, WS_W4T = 18 * MiB, WS_STAT1 = 20 * MiB, WS_MR1 = 26 * MiB, WS_DEC = 27 * MiB, WS_GATE = 27 * MiB + 768 * 1024,
                 WS_XB = 28 * MiB  , WS_U = 124 * MiB, WS_ST = 460 * MiB, WS_END = 508 * MiB;
constexpr size_t WS_X1B = WS_U, WS_P = WS_U + 96 * MiB, WS_S = WS_U + 192 * MiB, WS_STAT2 = WS_U + 288 * MiB, WS_PB = WS_U + 296 * MiB, WS_SB = WS_U + 304 * MiB;

__device__ __forceinline__ float bf2f(bf16_t b) { return __uint_as_float(((unsigned)b) << 16); }
typedef __bf16 nbf16x2 __attribute__((ext_vector_type(2)));
__device__ __forceinline__ bf16_t f2bf(float f) { return __builtin_bit_cast(bf16_t, (__bf16)f); }
__device__ __forceinline__ unsigned pk2(float lo, float hi) { return __builtin_bit_cast(unsigned, __builtin_convertvector((f32x2){lo, hi}, nbf16x2)); }
__device__ __forceinline__ float fexp2(float x) { return __builtin_amdgcn_exp2f(x); }
__device__ __forceinline__ float fexp(float x) { return __builtin_amdgcn_exp2f(x * 1.4426950408889634f); }
__device__ __forceinline__ float flog2(float x) { return __builtin_amdgcn_logf(x); }
__device__ __forceinline__ float silu(float x) { return x * __builtin_amdgcn_rcpf(1.0f + fexp(-x)); }
__device__ __forceinline__ float wave_sum(float v) {
#pragma unroll
    for (int o = 1; o < 64; o <<= 1) v += __shfl_xor(v, o);
    return v;
}
__device__ __forceinline__ float wave_max(float v) {
#pragma unroll
    for (int o = 1; o < 64; o <<= 1) v = fmaxf(v, __shfl_xor(v, o));
    return v;
}
__device__ __forceinline__ void seq_of(int row, int& s0, int& L) {
    if (row < NPROMPT) { L = LP; s0 = row & ~(LP - 1); } else { L = LS; s0 = NPROMPT + ((row - NPROMPT) & ~(LS - 1)); }
}

namespace pg8 {
constexpr int BM = 256, BK = 64, HALF = 128, HTB = HALF * BK * 2, STAGE_BYTES = 8 * HTB, NXCD = 8, WGM = 8;
__host__ __device__ __forceinline__ int lds_byte(int r, int c) { const int st = (r >> 4) * 2 + (c >> 5), rr = r & 15, cc = c & 31, ob = rr * 64 + cc * 2; return st * 1024 + (ob ^ (((ob >> 9) & 1) << 5)); }
__host__ __device__ __forceinline__ void stage_rc(int b, int& R, int& C) { const int st = b / 1024, sb = b % 1024, swz = sb ^ (((sb >> 9) & 1) << 5); R = (st >> 1) * 16 + swz / 64; C = (st & 1) * 32 + (swz % 64) / 2; }
__host__ __device__ __forceinline__ int perm32(int rho) { const int n = rho >> 4, i = rho & 15; return 8 * (i >> 2) + 4 * n + (i & 3); }
struct Unit { int pm, pn; };
struct Gemm { const bf16_t* A; const bf16_t* Bt; int M, N, K, pad; };
struct StaticOrder {
    int nM, nN, nwg, G, c;
    __host__ __device__ void init(int M, int N, int G_, int c_) { nM = M / BM; nN = N / BM; nwg = nM * nN; G = G_; c = c_; }
    __host__ __device__ bool next(int i, Unit& u) const {
        const long L = (long)i * G + c; if (L >= nwg) return false;
        int wgid = (int)L; { const int q = nwg / NXCD, r = nwg % NXCD, xcd = wgid % NXCD, off = wgid / NXCD; wgid = (xcd < r ? xcd * (q + 1) : r * (q + 1) + (xcd - r) * q) + off; }
        const int nig = WGM * nN, gid = wgid / nig, fm = gid * WGM, gsz = (nM - fm) < WGM ? (nM - fm) : WGM;
        u.pm = fm + ((wgid % nig) % gsz); u.pn = (wgid % nig) / gsz; return true;
    }
    __device__ __forceinline__ void a_ready(const Unit&) const {}
    __device__ __forceinline__ void done(const Unit&) const {}
};

template <class Epi, class Sched>
__device__ __forceinline__ void gemm_phase(LAS unsigned char* lds, const Gemm g, const Sched& S, const Epi& E) {
    int tid = tid_now(); asm volatile("" : "+v"(tid));
    const int wid = __builtin_amdgcn_readfirstlane(tid >> 6), lane = tid & 63, wr = wid >> 2, wc = wid & 3, fr = lane & 15, fq = lane >> 4;
    const int K = g.K, nt = K / BK;
    unsigned voffA[2], voffB[2];
#pragma unroll
    for (int i = 0; i < 2; ++i) { int R, C; stage_rc(tid * 16 + i * 8192, R, C); const int Rb = Epi::PERM ? ((R & ~31) + perm32(R & 31)) : R;
        voffA[i] = (unsigned)(R * K + C) * 2u; voffB[i] = (unsigned)(Rb * K + C) * 2u; }
    const size_t kstep = (size_t)(BK * 2);
    const size_t hstep = (size_t)HALF * K * 2;
    const size_t tstep = 2 * hstep;
    const unsigned ldsw = (unsigned)wid * 1024u;
    const int aoff = lds_byte(wr * 64 + fr, fq * 8), boff = lds_byte(wc * 32 + fr, fq * 8);
#define PG8_SA(b, h) (((b) * 2 + (h)) * HTB)
#define PG8_SB(b, h) ((4 + (b) * 2 + (h)) * HTB)
#define PG8_STAGE(bufoff, gbase, voff) do { _Pragma("unroll") for (int _i = 0; _i < 2; ++_i) \
        __builtin_amdgcn_global_load_lds((const unsigned*)((const char*)(gbase) + (voff)[_i]), (LAS unsigned*)(lds + (bufoff) + ldsw + _i * 8192), 16, 0, 0); } while (0)
#define PG8_LDA(dst, b, h) do { _Pragma("unroll") for (int m = 0; m < 4; ++m) _Pragma("unroll") for (int k = 0; k < 2; ++k) dst[m][k] = *(const LAS bf16x8*)(lds + PG8_SA(b, h) + aoff + m * 2048 + k * 1024); } while (0)
#define PG8_LDB(dst, b, h) do { _Pragma("unroll") for (int n = 0; n < 2; ++n) _Pragma("unroll") for (int k = 0; k < 2; ++k) dst[n][k] = *(const LAS bf16x8*)(lds + PG8_SB(b, h) + boff + n * 2048 + k * 1024); } while (0)
#define PG8_MMA(ai, bj, At, Bt) do { __builtin_amdgcn_s_setprio(1); _Pragma("unroll") for (int m = 0; m < 4; ++m) _Pragma("unroll") for (int n = 0; n < 2; ++n) _Pragma("unroll") for (int k = 0; k < 2; ++k) \
        acc[ai][bj][m][n] = __builtin_amdgcn_mfma_f32_16x16x32_bf16(Bt[n][k], At[m][k], acc[ai][bj][m][n], 0, 0, 0); __builtin_amdgcn_s_setprio(0); } while (0)
#define PG8_WAIT_V(n) asm volatile("s_waitcnt vmcnt(" #n ")" ::: "memory")
#define PG8_WAIT_L(n) asm volatile("s_waitcnt lgkmcnt(" #n ")" ::: "memory")
#define PG8_BAR __builtin_amdgcn_s_barrier()
#define PG8_SCHED __builtin_amdgcn_sched_barrier(0)
    Unit cur, nxt; int ui = 0;
    if (!S.next(0, cur)) return;
    f32x4 acc[2][2][4][2];
#pragma unroll
    for (int a = 0; a < 2; ++a)
#pragma unroll
        for (int b = 0; b < 2; ++b)
#pragma unroll
            for (int m = 0; m < 4; ++m)
#pragma unroll
                for (int n = 0; n < 2; ++n) acc[a][b][m][n] = (f32x4){0.f, 0.f, 0.f, 0.f};
    bf16x8 At[4][2], B0[2][2], B1[2][2];
    const char* cA = (const char*)g.A + (size_t)cur.pm * tstep; const char* cB = (const char*)g.Bt + (size_t)cur.pn * tstep;
    S.a_ready(cur);
    PG8_STAGE(PG8_SB(0, 0), cB, voffB); PG8_STAGE(PG8_SA(0, 0), cA, voffA); PG8_STAGE(PG8_SB(0, 1), cB + hstep, voffB); PG8_STAGE(PG8_SA(0, 1), cA + hstep, voffA);
    if (wr == 1) PG8_BAR;
    PG8_WAIT_V(4); PG8_BAR;
    PG8_STAGE(PG8_SB(1, 0), cB + kstep, voffB); PG8_STAGE(PG8_SA(1, 0), cA + kstep, voffA); PG8_STAGE(PG8_SB(1, 1), cB + hstep + kstep, voffB);
    PG8_WAIT_V(6); PG8_BAR;
    for (;;) {
        const bool has_next = S.next(ui + 1, nxt);
        const char* nA = has_next ? (const char*)g.A + (size_t)nxt.pm * tstep : cA; const char* nB = has_next ? (const char*)g.Bt + (size_t)nxt.pn * tstep : cB;
        for (int t = 0; t < nt; t += 2) {
            const bool last = (t == nt - 2);
            const char* a1 = cA + (size_t)(t + 1) * kstep;
            const char* a2 = last ? nA : cA + (size_t)(t + 2) * kstep; const char* b2 = last ? nB : cB + (size_t)(t + 2) * kstep;
            const char* a3 = a2 + kstep; const char* b3 = b2 + kstep;
            if (last && has_next) S.a_ready(nxt);
            PG8_LDB(B0, 0, 0); PG8_SCHED; PG8_LDA(At, 0, 0); PG8_STAGE(PG8_SA(1, 1), a1 + hstep, voffA);
            PG8_WAIT_L(8); PG8_BAR; PG8_WAIT_L(0); PG8_MMA(0, 0, At, B0); PG8_BAR; PG8_SCHED;
            PG8_LDB(B1, 0, 1); PG8_STAGE(PG8_SB(0, 0), b2, voffB);
            PG8_BAR; PG8_WAIT_L(0); PG8_MMA(0, 1, At, B1); PG8_BAR;
            PG8_LDA(At, 0, 1); PG8_STAGE(PG8_SA(0, 0), a2, voffA);
            PG8_BAR; PG8_WAIT_L(0); PG8_MMA(1, 0, At, B0); PG8_BAR; PG8_SCHED;
            PG8_STAGE(PG8_SB(0, 1), b2 + hstep, voffB);
            PG8_WAIT_V(6); PG8_BAR; PG8_MMA(1, 1, At, B1); PG8_BAR;
            PG8_LDB(B0, 1, 0); PG8_SCHED; PG8_LDA(At, 1, 0); PG8_STAGE(PG8_SA(0, 1), a2 + hstep, voffA);
            PG8_WAIT_L(8); PG8_BAR; PG8_WAIT_L(0); PG8_MMA(0, 0, At, B0); PG8_BAR; PG8_SCHED;
            PG8_LDB(B1, 1, 1); PG8_STAGE(PG8_SB(1, 0), b3, voffB);
            PG8_BAR; PG8_WAIT_L(0); PG8_MMA(0, 1, At, B1); PG8_BAR;
            PG8_LDA(At, 1, 1); PG8_STAGE(PG8_SA(1, 0), a3, voffA);
            PG8_BAR; PG8_WAIT_L(0); PG8_MMA(1, 0, At, B0); PG8_BAR; PG8_SCHED;
            PG8_STAGE(PG8_SB(1, 1), b3 + hstep, voffB);
            PG8_WAIT_V(6); PG8_BAR; PG8_MMA(1, 1, At, B1); PG8_BAR;
        }
        if constexpr (Epi::REALIGN) { if (wr == 0) PG8_BAR; }
        E(acc, cur, wr, wc, fr, fq); S.done(cur);
        if constexpr (Epi::REALIGN) { if (wr == 1) PG8_BAR; }
        if (!has_next) break;
#pragma unroll
        for (int a = 0; a < 2; ++a)
#pragma unroll
            for (int b = 0; b < 2; ++b)
#pragma unroll
                for (int m = 0; m < 4; ++m)
#pragma unroll
                    for (int n = 0; n < 2; ++n) acc[a][b][m][n] = (f32x4){0.f, 0.f, 0.f, 0.f};
        cur = nxt; cA = nA; cB = nB; ++ui;
    }
    PG8_WAIT_V(0);
    if (wr == 0) PG8_BAR;
    PG8_BAR;
#undef PG8_SA
#undef PG8_SB
#undef PG8_STAGE
#undef PG8_LDA
#undef PG8_LDB
#undef PG8_MMA
#undef PG8_WAIT_V
#undef PG8_WAIT_L
#undef PG8_BAR
#undef PG8_SCHED
}
}

struct EpiU {
    static constexpr bool PERM = true, AFTER_DRAIN = false, REALIGN = false;
    bf16_t* O;
    __device__ __forceinline__ void operator()(const f32x4 (&acc)[2][2][4][2], const pg8::Unit& u, int wr, int wc, int fr, int fq) const {
        const int row0 = u.pm * 256 + wr * 64 + fr, col0 = u.pn * 256 + wc * 32 + 8 * fq;
#pragma unroll
        for (int ai = 0; ai < 2; ++ai)
#pragma unroll
            for (int m = 0; m < 4; ++m) { bf16_t* rowp = O + (size_t)(row0 + ai * 128 + m * 16) * UP + col0;
#pragma unroll
                for (int bj = 0; bj < 2; ++bj) { const f32x4 v0 = acc[ai][bj][m][0], v1 = acc[ai][bj][m][1];
                    u32x4 w; w.x = pk2(v0[0], v0[1]); w.y = pk2(v0[2], v0[3]); w.z = pk2(v1[0], v1[1]); w.w = pk2(v1[2], v1[3]);
                    *(u32x4*)(rowp + bj * 128) = w; } }
    }
};
#define RLX_AGENT __ATOMIC_RELAXED, __HIP_MEMORY_SCOPE_AGENT
template <int LAYER> struct EpiLN {
    static constexpr bool PERM = true, AFTER_DRAIN = false, REALIGN = true;
    unsigned char* ws; float* Of; const float* lg; const float* lb;
    __device__ __forceinline__ void operator()(f32x4 (&acc)[2][2][4][2], const pg8::Unit& u, int wr, int wc, int fr, int fq) const {
        unsigned char* w2 = ws; asm volatile("" : "+s"(w2));
        const bf16_t* R = (const bf16_t*)(w2 + (LAYER == 0 ? WS_XB : WS_X1B)); bf16_t* Ob = (bf16_t*)(w2 + WS_X1B);
        unsigned long long* xbuf = (unsigned long long*)(w2 + WS_STAT1 + (LAYER == 0 ? 0 : 3 * MiB));
        unsigned* cnt = (unsigned*)(w2 + WS_CTL) + 16384 + LAYER * 192 * 64;
        const int col0 = u.pn * 256 + wc * 32 + 8 * fq, rowb = u.pm * 256 + wr * 64 + fr;
        LAS f32x2* part = (LAS f32x2*)((LAS unsigned char*)lds_raw + 131072);
        float ps[2][4], pq[2][4];
#pragma unroll
        for (int ai = 0; ai < 2; ++ai) {
            u32x4 rwa[4][2];
#pragma unroll
            for (int m = 0; m < 4; ++m)
#pragma unroll
                for (int bj = 0; bj < 2; ++bj) rwa[m][bj] = *(const u32x4*)(R + (size_t)(rowb + ai * 128 + m * 16) * DM + col0 + bj * 128);
#pragma unroll
            for (int m = 0; m < 4; ++m) {
                float s = 0.f, q = 0.f;
#pragma unroll
                for (int bj = 0; bj < 2; ++bj) {
                    const u32x4 rw = rwa[m][bj];
                    f32x4 r0 = (f32x4){__uint_as_float(rw.x << 16), __uint_as_float(rw.x & 0xffff0000u), __uint_as_float(rw.y << 16), __uint_as_float(rw.y & 0xffff0000u)};
                    f32x4 r1 = (f32x4){__uint_as_float(rw.z << 16), __uint_as_float(rw.z & 0xffff0000u), __uint_as_float(rw.w << 16), __uint_as_float(rw.w & 0xffff0000u)};
                    const f32x4 v0 = r0 * DN_ALPHA + acc[ai][bj][m][0], v1 = r1 * DN_ALPHA + acc[ai][bj][m][1];
                    acc[ai][bj][m][0] = v0; acc[ai][bj][m][1] = v1;
                    s += ((v0[0] + v0[1]) + (v0[2] + v0[3])) + ((v1[0] + v1[1]) + (v1[2] + v1[3]));
                    q += ((v0[0] * v0[0] + v0[1] * v0[1]) + (v0[2] * v0[2] + v0[3] * v0[3])) + ((v1[0] * v1[0] + v1[1] * v1[1]) + (v1[2] * v1[2] + v1[3] * v1[3]));
                }
                s += __shfl_xor(s, 16); s += __shfl_xor(s, 32); q += __shfl_xor(q, 16); q += __shfl_xor(q, 32);
                if (fq == 0) part[(ai * 128 + wr * 64 + m * 16 + fr) * 4 + wc] = (f32x2){s, q};
            }
        }
        const int tid = (wr * 4 + wc) * 64 + fq * 16 + fr;
        asm volatile("s_waitcnt lgkmcnt(0)" ::: "memory"); __builtin_amdgcn_s_barrier(); asm volatile("" ::: "memory");
        if (tid < 256) {
            const LAS f32x4* pp = (const LAS f32x4*)(part + tid * 4); const f32x4 a01 = pp[0], a23 = pp[1];
            const float s = (a01[0] + a01[2]) + (a23[0] + a23[2]), q = (a01[1] + a01[3]) + (a23[1] + a23[3]);
            __hip_atomic_store(xbuf + (size_t)(u.pm * 256 + tid) * 4 + u.pn, ((unsigned long long)__float_as_uint(q) << 32) | __float_as_uint(s), RLX_AGENT);
        }
        asm volatile("s_waitcnt vmcnt(0)" ::: "memory"); __builtin_amdgcn_s_barrier(); asm volatile("" ::: "memory");
        unsigned* c = cnt + 64 * u.pm;
        if (tid == 0) __hip_atomic_fetch_add(c, 1u, RLX_AGENT);
        if (tid < 64) { unsigned spins = 0;
          while ((unsigned)__builtin_amdgcn_readfirstlane(__hip_atomic_load(c, RLX_AGENT)) < 4u) { __builtin_amdgcn_s_sleep(1); if (++spins > (1u << 16)) break; }
          __builtin_amdgcn_fence(__ATOMIC_ACQUIRE, "agent"); asm volatile("s_waitcnt vmcnt(0)" ::: "memory"); }
        __builtin_amdgcn_s_barrier(); asm volatile("" ::: "memory");
#pragma unroll
        for (int ai = 0; ai < 2; ++ai)
#pragma unroll
            for (int m = 0; m < 4; ++m) {
                const f32x4* sp = (const f32x4*)(xbuf + (size_t)(rowb + ai * 128 + m * 16) * 4);
                const f32x4 a01 = sp[0], a23 = sp[1];
                const float s = (a01[0] + a01[2]) + (a23[0] + a23[2]), q = (a01[1] + a01[3]) + (a23[1] + a23[3]);
                const float mean = s * (1.0f / DM), var = q * (1.0f / DM) - mean * mean;
                ps[ai][m] = mean; pq[ai][m] = rsqrtf(fmaxf(var, 0.f) + LN_EPS);
            }
#pragma unroll
        for (int bj = 0; bj < 2; ++bj) {
            const f32x4 g0 = *(const f32x4*)(lg + col0 + bj * 128), g1 = *(const f32x4*)(lg + col0 + bj * 128 + 4), b0 = *(const f32x4*)(lb + col0 + bj * 128), b1 = *(const f32x4*)(lb + col0 + bj * 128 + 4);
#pragma unroll
            for (int ai = 0; ai < 2; ++ai)
#pragma unroll
                for (int m = 0; m < 4; ++m) {
                    const int row = rowb + ai * 128 + m * 16; const float mean = ps[ai][m], rstd = pq[ai][m];
                    const f32x4 o0 = (acc[ai][bj][m][0] - mean) * rstd * g0 + b0, o1 = (acc[ai][bj][m][1] - mean) * rstd * g1 + b1;
                    if (LAYER == 0) { u32x4 w; w.x = pk2(o0[0], o0[1]); w.y = pk2(o0[2], o0[3]); w.z = pk2(o1[0], o1[1]); w.w = pk2(o1[2], o1[3]); *(u32x4*)(Ob + (size_t)row * DM + col0 + bj * 128) = w; }
                    else { float* op = Of + (size_t)row * DM + col0 + bj * 128; __builtin_nontemporal_store(o0, (f32x4*)op); __builtin_nontemporal_store(o1, (f32x4*)(op + 4)); }
                }
        }
    }
};
template <int CTRL> __device__ __forceinline__ float dpp_f(float x);
struct EpiG {
    static constexpr bool PERM = true, AFTER_DRAIN = false, REALIGN = false;
    unsigned char* ws; const float* cw;
    __device__ __forceinline__ void operator()(const f32x4 (&acc)[2][2][4][2], const pg8::Unit& u, int wr, int wc, int fr, int fq) const {
        unsigned char* w2 = ws; asm volatile("" : "+s"(w2));
        bf16_t* G = (bf16_t*)(w2 + WS_XB); float* Pb = (float*)(w2 + WS_PB); float* Sb = (float*)(w2 + WS_SB);
        const int ch0 = u.pn * 64 + 16 * wc + 4 * fq;
        const f32x4 c0 = *(const f32x4*)(cw + ch0), c1 = *(const f32x4*)(cw + 1024 + ch0), c2 = *(const f32x4*)(cw + 2048 + ch0);
#pragma unroll
        for (int ai = 0; ai < 2; ++ai) {
            f32x4 P[4], S[4];
#pragma unroll
            for (int m = 0; m < 4; ++m)
#pragma unroll
                for (int j = 0; j < 4; ++j) { P[m][j] = acc[ai][0][m][1][j] * acc[ai][1][m][1][j]; S[m][j] = silu(acc[ai][1][m][0][j]) * acc[ai][0][m][0][j]; }
            const int row0 = u.pm * 256 + ai * 128 + wr * 64 + fr;
#pragma unroll
            for (int m = 0; m < 4; ++m) {
                float o[4];
#pragma unroll
                for (int j = 0; j < 4; ++j) {
                    float pr = dpp_f<0x111>(P[m][j]);
                    if (m > 0) { const float t = dpp_f<0x121>(P[m - 1][j]); pr = fr == 0 ? t : pr; }
                    float nx = dpp_f<0x101>(P[m][j]);
                    if (m < 3) { const float t = dpp_f<0x12F>(P[m + 1][j]); nx = fr == 15 ? t : nx; }
                    o[j] = S[m][j] * (c0[j] * pr + c1[j] * P[m][j] + c2[j] * nx);
                }
                u32x2 w; w.x = pk2(o[0], o[1]); w.y = pk2(o[2], o[3]);
                *(u32x2*)(G + (size_t)(row0 + 16 * m) * DM + ch0) = w;
            }
            const int blk = u.pm * 4 + ai * 2 + wr;
            if (fr == 0) { *(f32x4*)(Pb + (size_t)(blk * 2) * 1024 + ch0) = P[0]; *(f32x4*)(Sb + (size_t)(blk * 2) * 1024 + ch0) = S[0]; }
            if (fr == 15) { *(f32x4*)(Pb + (size_t)(blk * 2 + 1) * 1024 + ch0) = P[3]; *(f32x4*)(Sb + (size_t)(blk * 2 + 1) * 1024 + ch0) = S[3]; }
        }
    }
};
#define XB_TMO      128
#define XB_XCNT(j)  (256  + 64 * (j))
#define XB_XSUB(j)  (1280 + 64 * (j))
#define XB_XGEN(j)  (2304 + 64 * (j))
#define XB_TOP      3328
#define XB_TOPGEN   3392
#define XCD_BAR_WORDS 3456
#define XB_SPIN_CAP (1u << 27)
__device__ __forceinline__ unsigned xb_ld(unsigned* p)              { return __hip_atomic_load(p, __ATOMIC_RELAXED, __HIP_MEMORY_SCOPE_AGENT); }
__device__ __forceinline__ unsigned xb_add(unsigned* p, unsigned v) { return __hip_atomic_fetch_add(p, v, __ATOMIC_RELAXED, __HIP_MEMORY_SCOPE_AGENT); }
__device__ __forceinline__ unsigned xb_xcc_id() { return (unsigned)__builtin_amdgcn_s_getreg((3 << 11) | 20) & 0xFu; }
#define XB_SPIN(cond, bar) do { unsigned _sp = 0; while (cond) { __builtin_amdgcn_s_sleep(1); \
    if ((++_sp & 255u) == 0u) { if (xb_ld(&(bar)[XB_TMO])) break; if (_sp > XB_SPIN_CAP) { atomicAdd(&(bar)[XB_TMO], 1u); break; } } } } while (0)
struct XcdBarrier { unsigned* bar; unsigned x; volatile LAS unsigned* st; };
__device__ __forceinline__ XcdBarrier xcd_barrier_post(unsigned* bar, volatile LAS unsigned* st) {
    XcdBarrier b; b.bar = bar; b.x = xb_xcc_id(); b.st = st;
    if (tid_now() == 0) (void)xb_add(&bar[XB_XCNT(b.x)], 1u);
    return b;
}
__device__ __forceinline__ void xcd_barrier_complete(unsigned* bar, unsigned x, unsigned& nloc, unsigned& nx) {
    const unsigned G = gridDim.x * gridDim.y * gridDim.z;
    unsigned sum, cnt, mine, sp = 0u;
    for (;;) {
        sum = 0u; cnt = 0u; mine = 0u;
#pragma unroll
        for (unsigned j = 0; j < 16; ++j) { const unsigned c = xb_ld(&bar[XB_XCNT(j)]); sum += c; cnt += (c > 0u) ? 1u : 0u; mine = (j == x) ? c : mine; }
        if (sum == G) break;
        __builtin_amdgcn_s_sleep(1);
        if ((++sp & 255u) == 0u) { if (xb_ld(&bar[XB_TMO])) break; if (sp > XB_SPIN_CAP) { atomicAdd(&bar[XB_TMO], 1u); break; } }
    }
    nloc = mine > 0u ? mine : 1u; nx = cnt > 0u ? cnt : 1u;
}
__device__ __forceinline__ void xcd_barrier(const XcdBarrier& b) {
    asm volatile("s_waitcnt vmcnt(0)" ::: "memory");
    __syncthreads();
    if (tid_now() == 0) {
        unsigned* bar = b.bar;
        __builtin_amdgcn_s_waitcnt(0);
        unsigned nloc = b.st[0], nx = b.st[1];
        if (nloc == 0u) { xcd_barrier_complete(bar, b.x, nloc, nx); b.st[0] = nloc; b.st[1] = nx; }
        const unsigned old = xb_add(&bar[XB_XSUB(b.x)], 1u);
        const unsigned gen = old / nloc;
        if (old + 1u == (gen + 1u) * nloc) {
            __builtin_amdgcn_fence(__ATOMIC_RELEASE, "agent");
            asm volatile("s_waitcnt vmcnt(0)" ::: "memory");
            const unsigned og = xb_add(&bar[XB_TOP], 1u);
            const unsigned tg = og / nx;
            if (og + 1u == (tg + 1u) * nx) xb_add(&bar[XB_TOPGEN], 1u);
            else XB_SPIN(xb_ld(&bar[XB_TOPGEN]) == tg, bar);
            __builtin_amdgcn_fence(__ATOMIC_ACQUIRE, "agent");
            xb_add(&bar[XB_XGEN(b.x)], 1u);
            asm volatile("s_waitcnt vmcnt(0)" ::: "memory");
        } else {
            XB_SPIN(xb_ld(&bar[XB_XGEN(b.x)]) == gen, bar);
            __builtin_amdgcn_fence(__ATOMIC_ACQUIRE, "agent");
            asm volatile("s_waitcnt vmcnt(0)" ::: "memory");
        }
    }
    __syncthreads();
}

struct Args {
    const float *xp, *xs, *w_in_even, *wuf, *bfw, *wub, *bbw, *ng, *sink, *relb, *w_out_even, *w_in_odd, *cw, *w_out_odd, *lng, *lnb;
    float* out; unsigned char* ws;
};
constexpr int NTHR = 512;
constexpr int LDS_BYTES = 163840, MISC_OFF = 163840 - 512;

template <int MODE> __device__ __forceinline__ int wmap(int n, float& sc) {
    sc = 1.f;
    if (MODE == 0) return n;
    if (MODE == 1) {
        if (n < 512) sc = 0.08838834764831845f;
        if (n >= C_QB && n < C_KB) sc = 0.125f;
        if (n < 2048) return n;
        if (n < C_GD) return n + 32;
        if (n < C_GD + 32) return n - C_GD + 2048;
        return -1;
    }
    const int c = n & 255, bj = (c >> 7) & 1, wc = (c >> 5) & 3, fq = (c >> 3) & 3, nn = (c >> 2) & 1, j = c & 3, q = 2 * bj + nn, ch = (n >> 8) * 64 + 16 * wc + 4 * fq + j;
    const int base = q == 0 ? 0 : (q == 1 ? 1024 : (q == 2 ? 3072 : 2048));
    return base + ch;
}
template <int MODE> __device__ __forceinline__ void p0_w_item(const float* __restrict__ W, int Nsrc, bf16_t* __restrict__ Wt, int Ndst, int item, LAS float* scr, int lane) {
    const int nblk = Ndst / 32, kb = item / nblk, nb = item - kb * nblk, k0 = 64 * kb, n0 = 32 * nb;
    float sc; const int src = wmap<MODE>(n0 + (lane & 31), sc);
#pragma unroll 8
    for (int i = 0; i < 32; ++i) { const int kk = 2 * i + (lane >> 5); scr[kk * 33 + (lane & 31)] = src >= 0 ? W[(size_t)(k0 + kk) * Nsrc + src] * sc : 0.f; }
    asm volatile("s_waitcnt lgkmcnt(0)" ::: "memory");
    const int c = lane & 7;
#pragma unroll
    for (int jj = 0; jj < 4; ++jj) { const int n = (lane >> 3) + 8 * jj; const LAS float* sp = scr + (8 * c) * 33 + n;
        u32x4 o; o.x = pk2(sp[0 * 33], sp[1 * 33]); o.y = pk2(sp[2 * 33], sp[3 * 33]); o.z = pk2(sp[4 * 33], sp[5 * 33]); o.w = pk2(sp[6 * 33], sp[7 * 33]);
        *(u32x4*)(Wt + (size_t)(n0 + n) * 1024 + k0 + 8 * c) = o; }
    asm volatile("s_waitcnt lgkmcnt(0)" ::: "memory");
}
__device__ __forceinline__ void build_gate_tables(const Args& a);
__device__ __forceinline__ void phase_convert(const Args& a, LAS unsigned char* lds) {
    unsigned char* ws = a.ws;
    bf16_t* W1t = (bf16_t*)(ws + WS_W1T); bf16_t* W2t = (bf16_t*)(ws + WS_W2T); bf16_t* W3t = (bf16_t*)(ws + WS_W3T); bf16_t* W4t = (bf16_t*)(ws + WS_W4T);
    {
        const int tidw = tid_now(), lanew = tidw & 63, ww = tidw >> 6;
        LAS float* scr = (LAS float*)(lds + ww * 8448);
        constexpr int I1 = 16 * (C_GD / 32), I2 = 16 * 32, I3 = 16 * 128, I4 = 16 * 32, NW = I1 + I2 + I3 + I4;
        for (int wi = blockIdx.x * 8 + ww; wi < NW; wi += gridDim.x * 8) {
            int r = wi;
            if (r < I1) p0_w_item<1>(a.w_in_even, EVEN_IN, W1t, C_GD, r, scr, lanew);
            else if ((r -= I1) < I2) p0_w_item<0>(a.w_out_even, 1024, W2t, 1024, r, scr, lanew);
            else if ((r -= I2) < I3) p0_w_item<2>(a.w_in_odd, ODD_IN, W3t, 4096, r, scr, lanew);
            else p0_w_item<0>(a.w_out_odd, 1024, W4t, 1024, r - I3, scr, lanew);
        }
    }
    build_gate_tables(a);
    __syncthreads();
    {
        constexpr int WP = 1032, TP = 264;
        LAS bf16_t* wg = (LAS bf16_t*)lds; LAS bf16_t* tile0 = (LAS bf16_t*)(lds + 32 * WP * 2);
        const int tid = tid_now(), lane = tid & 63, w = tid >> 6, n = lane & 15, g = lane >> 4, rb = w & 3, ct = w >> 2;
        for (int e = tid; e < 32 * 1024; e += NTHR) { const int k = e >> 5, c = e & 31; wg[c * WP + k] = f2bf(a.w_in_even[(size_t)k * EVEN_IN + 2048 + c]); }
        bf16_t* xb = (bf16_t*)(ws + WS_XB); bf16_t* U = (bf16_t*)(ws + WS_U);
        f32x4 v[4][2];
        auto slab_load = [&](int it, int sl) {
#pragma unroll
            for (int i = 0; i < 4; ++i) { const int idx = tid + 512 * i, row = it * 64 + (idx >> 5), col = sl * 256 + 8 * (idx & 31);
                const float* src = (row < NPROMPT ? a.xp + (size_t)row * DM : a.xs + (size_t)(row - NPROMPT) * DM) + col;
                v[i][0] = __builtin_nontemporal_load((const f32x4*)src); v[i][1] = __builtin_nontemporal_load((const f32x4*)(src + 4)); } };
        const int ntrip = NTOK / 64;
        if ((int)blockIdx.x < ntrip) slab_load(blockIdx.x, 0);
        int par = 0;
        for (int it = blockIdx.x; it < ntrip; it += gridDim.x) {
            f32x4 acc = (f32x4){0.f, 0.f, 0.f, 0.f};
#pragma unroll 1
            for (int sl = 0; sl < 4; ++sl) {
                LAS bf16_t* tile = tile0 + par * (64 * TP);
#pragma unroll
                for (int i = 0; i < 4; ++i) { const int idx = tid + 512 * i, r64 = idx >> 5, c8 = idx & 31;
                    u32x4 pw; pw.x = pk2(v[i][0][0], v[i][0][1]); pw.y = pk2(v[i][0][2], v[i][0][3]); pw.z = pk2(v[i][1][0], v[i][1][1]); pw.w = pk2(v[i][1][2], v[i][1][3]);
                    *(u32x4*)(xb + (size_t)(it * 64 + r64) * DM + sl * 256 + 8 * c8) = pw;
                    *(LAS u32x4*)(tile + r64 * TP + 8 * c8) = pw; }
                { const int nsl = (sl + 1) & 3, nit = sl < 3 ? it : (it + (int)gridDim.x < ntrip ? it + (int)gridDim.x : it); slab_load(nit, nsl); }
                __syncthreads();
#pragma unroll
                for (int ks = 0; ks < 8; ++ks) {
                    const bf16x8 af = *(const LAS bf16x8*)(tile + (16 * rb + n) * TP + 32 * ks + 8 * g), bfr = *(const LAS bf16x8*)(wg + (16 * ct + n) * WP + sl * 256 + 32 * ks + 8 * g);
                    acc = MFMA16(af, bfr, acc);
                }
                par ^= 1;
            }
#pragma unroll
            for (int r = 0; r < 4; ++r) U[(size_t)(it * 64 + rb * 16 + 4 * g + r) * UP + C_GD + 16 * ct + n] = f2bf(acc[r]);
        }
        __syncthreads();
    }
}

__device__ __forceinline__ int t5_bucket(int rel) {
    const int n = rel < 0 ? -rel : rel;
    int b = n < 8 ? n : (n < 12 ? 8 : (n < 16 ? 9 : (n < 23 ? 10 : (n < 32 ? 11 : (n < 46 ? 12 : (n < 64 ? 13 : (n < 91 ? 14 : 15)))))));
    return b + (rel > 0 ? 16 : 0);
}
typedef short s16x4 __attribute__((ext_vector_type(4)));
constexpr int GL_QT = 0, GL_KT = 16384, GL_VT = 32768, GL_PT = 49152, GL_B = 57344, GL_GD = 90112, GL_TOT = 94208, GL_EBL = 96256  , GL_SSW = 97280, GL_RSTD = 99328;
constexpr int NSEG = NTOK / 256;
__device__ __forceinline__ unsigned offb(unsigned row, unsigned ch) { return 256u * row + 16u * (ch ^ (((row & 3) << 2) | ((row >> 2) & 3))); }
__device__ __forceinline__ unsigned offp(unsigned row, unsigned ch) { return 128u * row + 16u * (ch ^ (row & 7)); }
__device__ __forceinline__ unsigned rr16(unsigned lane, unsigned rb, unsigned s) { return offb((lane & 15) + 16 * rb, 4 * s + (lane >> 4)); }
__device__ __forceinline__ unsigned tr16(unsigned lane, unsigned c, unsigned ks, unsigned t) {
    const unsigned g = lane >> 4, q = (lane & 15) >> 2, p = lane & 3;
    return offb(32 * ks + 8 * g + 4 * t + q, 2 * c + (p >> 1)) + 8 * (p & 1);
}
__device__ __forceinline__ void unpack8(const u32x4 w, float (&f)[8]) {
#pragma unroll
    for (int j = 0; j < 4; ++j) { f[2 * j] = __uint_as_float(w[j] << 16); f[2 * j + 1] = __uint_as_float(w[j] & 0xffff0000u); }
}

struct GlaPre { u32x4 gd[4]; u32x4 q[2], k[2], v[2]; u32x4 wf; float wb; };
template <int MODE>
__device__ __forceinline__ void gla_prefetch(const Args& a, GlaPre& pre, int tid, int tb, int h, int dir, int stidx) {
    const bf16_t* U = (const bf16_t*)(a.ws + WS_U);
    const int lane = tid & 63, n = lane & 15, g = lane >> 4, w = tid >> 6;
#pragma unroll
    for (int it = 0; it < 4; ++it) { const int row = 16 * it + n, tok = dir ? tb + 63 - row : tb + row; pre.gd[it] = *(const u32x4*)(U + (size_t)tok * UP + C_GD + dir * 16 + 8 * (g & 1)); }
#pragma unroll
    for (int i = 0; i < 2; ++i) {
        const int idx = tid + 512 * i, row = idx >> 4, ch = idx & 15, tok = dir ? tb + 63 - row : tb + row;
        const bf16_t* ur = U + (size_t)tok * UP + h * 128 + ch * 8;
        pre.v[i] = *(const u32x4*)(ur + C_VA); pre.k[i] = *(const u32x4*)(ur + C_KA);
        if (MODE != 0) pre.q[i] = *(const u32x4*)(ur + C_QA);
    }
    pre.wf = ((const u32x4*)(a.ws + WS_GATE))[(dir * 4 + h) * 512 + tid];
    pre.wb = ((const float*)(a.ws + WS_GATE + 65536))[(dir * 4 + h) * 128 + 16 * w + n];
}
__device__ __forceinline__ bf16x8 tr_read8(LAS unsigned char* lds, unsigned a0, unsigned a1) {
    const s16x4 r0 = __builtin_amdgcn_ds_read_tr16_b64_v4i16((LAS s16x4*)(lds + a0)), r1 = __builtin_amdgcn_ds_read_tr16_b64_v4i16((LAS s16x4*)(lds + a1));
    return __builtin_shufflevector(r0, r1, 0, 1, 2, 3, 4, 5, 6, 7);
}
template <int CTRL> __device__ __forceinline__ float dpp_f(float x) { return __int_as_float(__builtin_amdgcn_update_dpp(0, __float_as_int(x), CTRL, 0xf, 0xf, true)); }
constexpr int GL_BP = 132;
__device__ __forceinline__ float gla_a1(LAS unsigned char* lds, const GlaPre& cur, const int w, const int n, const int g, const int par) {
    const bf16x8 wfrag = __builtin_bit_cast(bf16x8, cur.wf); const float wbias = cur.wb;
    float tot = 0.f;
    {
        LAS float* B = (LAS float*)(lds + GL_B);
        bf16x8 vh[2], vl[2];
#pragma unroll
        for (int ks = 0; ks < 2; ++ks) {
            float vv[8];
#pragma unroll
            for (int half = 0; half < 2; ++half) {
                const f32x4 x = MFMA16(__builtin_bit_cast(bf16x8, cur.gd[2 * ks + half]), wfrag, ((f32x4){wbias, wbias, wbias, wbias}));
#pragma unroll
                for (int r = 0; r < 4; ++r) { const float xs = x[r] * 1.4426950408889634f; vv[4 * half + r] = (fminf(xs, 0.f) - flog2(1.0f + fexp2(-fabsf(xs)))) * (1.0f / 16.0f); }
            }
            u32x4 hw, lw;
#pragma unroll
            for (int q = 0; q < 4; ++q) { const unsigned hp = pk2(vv[2 * q], vv[2 * q + 1]); hw[q] = hp;
                lw[q] = pk2(vv[2 * q] - __uint_as_float(hp << 16), vv[2 * q + 1] - __uint_as_float(hp & 0xffff0000u)); }
            vh[ks] = __builtin_bit_cast(bf16x8, hw); vl[ks] = __builtin_bit_cast(bf16x8, lw);
        }
        u32x4 ta, tbm;
#pragma unroll
        for (int q = 0; q < 2; ++q) { const unsigned lo = (4 * g + 2 * q <= n) ? 0x3f80u : 0u, hi = (4 * g + 2 * q + 1 <= n) ? 0x3f800000u : 0u; ta[q] = lo | hi; ta[2 + q] = 0u; tbm[q] = 0x3f803f80u; tbm[2 + q] = lo | hi; }
        const bf16x8 TA = __builtin_bit_cast(bf16x8, ta), TB = __builtin_bit_cast(bf16x8, tbm), ONES = __builtin_bit_cast(bf16x8, ((u32x4){0x3f803f80u, 0x3f803f80u, 0x3f803f80u, 0x3f803f80u}));
        const f32x4 z4 = (f32x4){0.f, 0.f, 0.f, 0.f};
        f32x4 bt[4];
        bt[0] = MFMA16(TA, vl[0], MFMA16(TA, vh[0], z4));
        bt[1] = MFMA16(TB, vl[0], MFMA16(TB, vh[0], z4));
        const f32x4 s32 = MFMA16(ONES, vl[0], MFMA16(ONES, vh[0], z4));
        bt[2] = MFMA16(TA, vl[1], MFMA16(TA, vh[1], s32));
        bt[3] = MFMA16(TB, vl[1], MFMA16(TB, vh[1], s32));
#pragma unroll
        for (int it = 0; it < 4; ++it)
#pragma unroll
            for (int r = 0; r < 4; ++r) B[(16 * it + 4 * g + r) * GL_BP + 16 * w + n] = bt[it][r];
        if (g == 3) { ((LAS float*)(lds + GL_EBL + par * 512))[16 * w + n] = fexp2(bt[3][3]); tot = bt[3][3]; }
    }
    return tot;
}
template <int MODE>
__device__ __forceinline__ void gla_chunk(const Args& a, LAS unsigned char* lds, const int tb, const int h, const int dir,
                                          f32x4 (&Sacc)[8], float& ntot, u32x4* stash, GlaPre& pre, const GlaPre& nxt, const int ntb, const int nh, const int ndir, const bool first, const int par) {
    const bf16_t* U = (const bf16_t*)(a.ws + WS_U);
    int tid = tid_now(); asm volatile("" : "+v"(tid));
    const int lane = tid & 63, w = __builtin_amdgcn_readfirstlane(tid >> 6), n = lane & 15, g = lane >> 4;
    const unsigned fn = ((n & 3) << 2) | ((n >> 2) & 3);
    const unsigned base_rr = 256u * n + 16u * (g ^ fn);
    const unsigned base_c = 256u * n + 16u * ((g >> 1) ^ fn) + 8u * (g & 1);
    const unsigned base_p = 128u * n + 16u * (g ^ (n & 7));
    const unsigned trb0 = tr16(lane, 0, 0, 0), trb1 = tr16(lane, 0, 0, 1);
    GlaPre& cur = pre;
    int prow[2], pch[2], ptok[2];
#pragma unroll
    for (int i = 0; i < 2; ++i) { const int idx = tid + 512 * i; prow[i] = idx >> 4; pch[i] = idx & 15; ptok[i] = dir ? tb + 63 - prow[i] : tb + prow[i]; }
    u32x4 st0, st1, zraw[2];
    __syncthreads();
#pragma unroll
    for (int i = 0; i < 2; ++i) {
        const LAS f32x4* bp = (const LAS f32x4*)(lds + GL_B + (prow[i] * GL_BP + pch[i] * 8) * 4);
        const f32x4 b0 = bp[0], b1 = bp[1];
        float e[8], kf[8];
#pragma unroll
        for (int j = 0; j < 4; ++j) { e[j] = fexp2(b0[j]); e[4 + j] = fexp2(b1[j]); }
        unpack8(cur.k[i], kf);
        u32x4 kw;
#pragma unroll
        for (int j = 0; j < 4; ++j) kw[j] = pk2(kf[2 * j] * __builtin_amdgcn_rcpf(e[2 * j]), kf[2 * j + 1] * __builtin_amdgcn_rcpf(e[2 * j + 1]));
        *(LAS u32x4*)(lds + GL_KT + offb(prow[i], pch[i])) = kw;
        *(LAS u32x4*)(lds + GL_VT + offb(prow[i], pch[i])) = cur.v[i];
        if (MODE != 0) {
            float qf[8]; unpack8(cur.q[i], qf);
            u32x4 qw;
#pragma unroll
            for (int j = 0; j < 4; ++j) qw[j] = pk2(qf[2 * j] * e[2 * j], qf[2 * j + 1] * e[2 * j + 1]);
            *(LAS u32x4*)(lds + GL_QT + offb(prow[i], pch[i])) = qw;
        }
    }
    __syncthreads();
    gla_prefetch<MODE>(a, pre, tid, ntb, nh, ndir, -1);
    f32x4 Oacc[4];
    if (MODE != 0) {
        const int it = w >> 1;
#pragma unroll
        for (int jj = 0; jj < 2; ++jj) {
            const int jt = 2 * (w & 1) + jj;
            f32x4 pacc = (f32x4){0.f, 0.f, 0.f, 0.f};
            if (jt <= it) {
#pragma unroll
                for (int s = 0; s < 4; ++s) {
                    const bf16x8 qa = *(const LAS bf16x8*)(lds + GL_QT + (base_rr ^ (64u * s)) + 4096u * it);
                    const bf16x8 kb = *(const LAS bf16x8*)(lds + GL_KT + (base_rr ^ (64u * s)) + 4096u * jt); pacc = MFMA16(qa, kb, pacc); }
            }
            const int j = 16 * jt + n;
#pragma unroll
            for (int r = 0; r < 4; ++r) {
                const int i = 16 * it + 4 * g + r;
                const bool keep = (MODE == 1) ? (j <= i) : (j < i);
                *(LAS bf16_t*)(lds + GL_PT + offp(i, j >> 3) + 2 * (j & 7)) = keep ? f2bf(pacc[r]) : (bf16_t)0;
            }

        }
        if (first) {
#pragma unroll
            for (int kt = 0; kt < 8; ++kt) { const unsigned r0 = __float_as_uint(Sacc[kt][0]), r1 = __float_as_uint(Sacc[kt][1]);
                Sacc[kt] = (f32x4){__uint_as_float(r0 << 16), __uint_as_float(r0 & 0xffff0000u), __uint_as_float(r1 << 16), __uint_as_float(r1 & 0xffff0000u)}; }
        }
#pragma unroll
        for (int i2 = 0; i2 < 4; ++i2) Oacc[i2] = (f32x4){0.f, 0.f, 0.f, 0.f};
#pragma unroll
        for (int ks = 0; ks < 4; ++ks) {
            u32x4 pw; pw.x = pk2(Sacc[2 * ks][0], Sacc[2 * ks][1]); pw.y = pk2(Sacc[2 * ks][2], Sacc[2 * ks][3]); pw.z = pk2(Sacc[2 * ks + 1][0], Sacc[2 * ks + 1][1]); pw.w = pk2(Sacc[2 * ks + 1][2], Sacc[2 * ks + 1][3]);
            const bf16x8 sb = __builtin_bit_cast(bf16x8, pw);
            const unsigned alo = base_c ^ (64u * ks);
#pragma unroll
            for (int i2 = 0; i2 < 4; ++i2) {
                const u32x2 lo = *(const LAS u32x2*)(lds + GL_QT + 4096 * i2 + alo);
                const u32x2 hi = *(const LAS u32x2*)(lds + GL_QT + 4096 * i2 + (alo ^ 32u));
                u32x4 aw; aw.x = lo.x; aw.y = lo.y; aw.z = hi.x; aw.w = hi.y;
                Oacc[i2] = MFMA16(__builtin_bit_cast(bf16x8, aw), sb, Oacc[i2]);
            }

        }
        __syncthreads();
        if (MODE == 2) {
            st0 = stash[tid * 2]; st1 = stash[tid * 2 + 1];
#pragma unroll
            for (int i = 0; i < 2; ++i) zraw[i] = *(const u32x4*)(U + (size_t)ptok[i] * UP + C_ZA + h * 128 + pch[i] * 8);
        }
    }
    bf16x8 vf[2];
#pragma unroll
    for (int ks = 0; ks < 2; ++ks) vf[ks] = tr_read8(lds, GL_VT + 8192u * ks + (trb0 ^ (32u * w)), GL_VT + 8192u * ks + (trb1 ^ (32u * w)));
    if (MODE != 0) {
#pragma unroll
        for (int i2 = 0; i2 < 4; ++i2)
#pragma unroll
            for (int ks = 0; ks < 2; ++ks) {
                if (ks <= (i2 >> 1)) { const bf16x8 pa = *(const LAS bf16x8*)(lds + GL_PT + 2048 * i2 + (base_p ^ (64u * ks))); Oacc[i2] = MFMA16(pa, vf[ks], Oacc[i2]); }
            }
    }
#pragma unroll
    for (int kt = 0; kt < 8; ++kt) {
#pragma unroll
        for (int ks = 0; ks < 2; ++ks) { const bf16x8 ka = tr_read8(lds, GL_KT + 8192u * ks + (trb0 ^ (32u * kt)), GL_KT + 8192u * ks + (trb1 ^ (32u * kt))); Sacc[kt] = MFMA16(ka, vf[ks], Sacc[kt]); }
        const f32x4 eb = *(const LAS f32x4*)(lds + GL_EBL + par * 512 + (16 * kt + 4 * g) * 4);
        Sacc[kt] = Sacc[kt] * eb;
        if (kt & 1) __builtin_amdgcn_sched_barrier(0);
    }
    ntot = gla_a1(lds, nxt, w, n, g, par ^ 1);
    if (MODE == 1) {
        u32x4 s0, s1;
        s0.x = pk2(Oacc[3][3], Oacc[3][2]); s0.y = pk2(Oacc[3][1], Oacc[3][0]); s0.z = pk2(Oacc[2][3], Oacc[2][2]); s0.w = pk2(Oacc[2][1], Oacc[2][0]);
        s1.x = pk2(Oacc[1][3], Oacc[1][2]); s1.y = pk2(Oacc[1][1], Oacc[1][0]); s1.z = pk2(Oacc[0][3], Oacc[0][2]); s1.w = pk2(Oacc[0][1], Oacc[0][0]);
        const int tidm = tid ^ 48;
        stash[tidm * 2] = s0; stash[tidm * 2 + 1] = s1;
    }
    if (MODE == 2) {
        float fo[16]; { float t8[8]; unpack8(st0, t8);
#pragma unroll
            for (int j = 0; j < 8; ++j) fo[j] = t8[j]; unpack8(st1, t8);
#pragma unroll
            for (int j = 0; j < 8; ++j) fo[8 + j] = t8[j]; }
        LAS float* ssw = (LAS float*)(lds + GL_SSW);
#pragma unroll
        for (int i2 = 0; i2 < 4; ++i2)
#pragma unroll
            for (int r = 0; r < 4; ++r) {
                const float o = Oacc[i2][r] + fo[4 * i2 + r]; Oacc[i2][r] = o;
                float v = o * o; v += dpp_f<0x128>(v); v += dpp_f<0x124>(v); v += dpp_f<0x122>(v); v += dpp_f<0x121>(v);
                if (n == 0) ssw[w * 64 + 16 * i2 + 4 * g + r] = v;
            }
        __syncthreads();
        if (tid < 64) { float s = 0.f;
#pragma unroll
            for (int ww = 0; ww < 8; ++ww) s += ssw[ww * 64 + tid];
            ((LAS float*)(lds + GL_RSTD))[tid] = rsqrtf(s * (1.0f / 128.0f) + NORM_EPS); }
        __syncthreads();
        const float gn = a.ng[16 * w + n];
#pragma unroll
        for (int i2 = 0; i2 < 4; ++i2) {
            const f32x4 rs = *(const LAS f32x4*)(lds + GL_RSTD + (16 * i2 + 4 * g) * 4);
#pragma unroll
            for (int r = 0; r < 4; ++r) *(LAS bf16_t*)(lds + GL_QT + (16 * i2 + 4 * g + r) * 256 + (16 * w + n) * 2) = f2bf(Oacc[i2][r] * rs[r] * gn);
        }
        __syncthreads();
        bf16_t* ymix = (bf16_t*)((unsigned char*)a.out + 96 * MiB);
#pragma unroll
        for (int i = 0; i < 2; ++i) {
            const u32x4 ov = *(const LAS u32x4*)(lds + GL_QT + prow[i] * 256 + pch[i] * 16);
            float of[8], zf[8]; unpack8(ov, of); unpack8(zraw[i], zf);
            u32x4 yw;
#pragma unroll
            for (int j = 0; j < 4; ++j) yw[j] = pk2(of[2 * j] * silu(zf[2 * j]), of[2 * j + 1] * silu(zf[2 * j + 1]));
            *(u32x4*)(ymix + (size_t)ptok[i] * DM + h * 128 + pch[i] * 8) = yw;
        }
    }
}
__device__ __forceinline__ void build_gate_tables(const Args& a) {
    for (int e = blockIdx.x * NTHR + tid_now(); e < 8 * 512; e += gridDim.x * NTHR) {
        const int dh = e >> 9, tid = e & 511, dir = dh >> 2, h = dh & 3, lane = tid & 63, w = tid >> 6, n = lane & 15, g = lane >> 4, col = h * 128 + 16 * w + n;
        const float* wup = dir ? a.wub : a.wuf; const float* bias = dir ? a.bbw : a.bfw;
        u32x4 pw;
#pragma unroll
        for (int j = 0; j < 4; ++j) {
            const float v0 = wup[(8 * (g & 1) + 2 * j) * 512 + col], v1 = wup[(8 * (g & 1) + 2 * j + 1) * 512 + col];
            const float h0 = bf2f(f2bf(v0)), h1 = bf2f(f2bf(v1));
            pw[j] = g < 2 ? pk2(v0, v1) : pk2(v0 - h0, v1 - h1);
        }
        ((u32x4*)(a.ws + WS_GATE))[e] = pw;
        if (g == 0) ((float*)(a.ws + WS_GATE + 65536))[dh * 128 + 16 * w + n] = bias[col];
    }
}
__device__ __forceinline__ void phase_gla_pass1(const Args& a, LAS unsigned char* lds) {
    const int tid = tid_now(), w = tid >> 6, lane = tid & 63;
    unsigned char* ST = a.ws + WS_ST;
    const int nsteps = ((NSEG * 8 - (int)blockIdx.x + (int)gridDim.x - 1) / (int)gridDim.x) * 4;
    auto params = [&](int st, int& tb, int& h, int& dir) { if (st >= nsteps) st = nsteps - 1; const int item = blockIdx.x + (st >> 2) * gridDim.x, cc = st & 3; dir = item & 1; h = (item >> 1) & 3; tb = (item >> 3) * 256 + (dir ? 3 - cc : cc) * 64; };
    GlaPre preA, preB; int par = 0;
    float ctot = 0.f;
    if (nsteps > 0) { int tb, h, dir; params(0, tb, h, dir); gla_prefetch<0>(a, preA, tid, tb, h, dir, -1); params(1, tb, h, dir); gla_prefetch<0>(a, preB, tid, tb, h, dir, -1);
        ctot = gla_a1(lds, preA, w, lane & 15, lane >> 4, 0); }
    f32x4 Sacc[8]; float lam;
    for (int st = 0; st < nsteps; st += 2) {
        const int item = blockIdx.x + (st >> 2) * gridDim.x;
        if ((st & 3) == 0) {
#pragma unroll
            for (int kt = 0; kt < 8; ++kt) Sacc[kt] = (f32x4){0.f, 0.f, 0.f, 0.f};
            lam = 0.f;
        }
        { int tb, h, dir, ntb, nh, ndir; params(st, tb, h, dir); params(st + 2, ntb, nh, ndir); lam += ctot; gla_chunk<0>(a, lds, tb, h, dir, Sacc, ctot, nullptr, preA, preB, ntb, nh, ndir, false, par); par ^= 1; }
        { int tb, h, dir, ntb, nh, ndir; params(st + 1, tb, h, dir); params(st + 3, ntb, nh, ndir); lam += ctot; gla_chunk<0>(a, lds, tb, h, dir, Sacc, ctot, nullptr, preB, preA, ntb, nh, ndir, false, par); par ^= 1; }
        if ((st & 3) == 2) {
            u32x2* dst = (u32x2*)(ST + (size_t)item * 32768) + (size_t)w * 8 * 64 + lane;
#pragma unroll
            for (int kt = 0; kt < 8; ++kt) { u32x2 v; v.x = pk2(Sacc[kt][0], Sacc[kt][1]); v.y = pk2(Sacc[kt][2], Sacc[kt][3]); dst[kt * 64] = v; }
            if ((lane >> 4) == 3) ((float*)(a.ws + WS_DEC))[(size_t)item * 128 + 16 * w + (lane & 15)] = lam;
        }
    }
    __syncthreads();
}
__device__ __forceinline__ void phase_gla_pass2(const Args& a) {
    unsigned char* ST = a.ws + WS_ST; const float* DEC = (const float*)(a.ws + WS_DEC);
    for (int gidx = blockIdx.x * NTHR + tid_now(); gidx < 48 * 4096; gidx += gridDim.x * NTHR) {
        const int chain = gidx >> 12, quad = gidx & 4095, dir = chain & 1, h = (chain >> 1) & 3, s = chain >> 3;
        const int nseg = s < 2 ? LP / 256 : LS / 256, seg0 = s < 2 ? s * (LP / 256) : 2 * (LP / 256) + (s - 2) * (LS / 256);
        const int kt = (quad >> 6) & 7, lane = quad & 63, dk0 = 16 * kt + 4 * (lane >> 4);
        f32x4 S = (f32x4){0.f, 0.f, 0.f, 0.f};
        for (int i0 = 0; i0 < nseg; i0 += 8) {
            u32x2 t[8]; f32x4 lm[8];
#pragma unroll
            for (int j = 0; j < 8; ++j) { const int seg = dir ? seg0 + nseg - 1 - (i0 + j) : seg0 + i0 + j; const size_t idx = (size_t)((seg * 4 + h) * 2 + dir);
                t[j] = ((const u32x2*)(ST + idx * 32768))[quad]; lm[j] = *(const f32x4*)(DEC + idx * 128 + dk0); }
#pragma unroll
            for (int j = 0; j < 8; ++j) { const int seg = dir ? seg0 + nseg - 1 - (i0 + j) : seg0 + i0 + j; const size_t idx = (size_t)((seg * 4 + h) * 2 + dir);
                u32x2 o; o.x = pk2(S[0], S[1]); o.y = pk2(S[2], S[3]); ((u32x2*)(ST + idx * 32768))[quad] = o;
                const f32x4 tv = (f32x4){__uint_as_float(t[j].x << 16), __uint_as_float(t[j].x & 0xffff0000u), __uint_as_float(t[j].y << 16), __uint_as_float(t[j].y & 0xffff0000u)};
                S = (f32x4){fexp2(lm[j][0]), fexp2(lm[j][1]), fexp2(lm[j][2]), fexp2(lm[j][3])} * S + tv; }
        }
    }
}
__device__ __forceinline__ void phase_gla_pass3(const Args& a, LAS unsigned char* lds) {
    const int tid = tid_now(), w = tid >> 6, lane = tid & 63;
    GlaPre pre; int par = 0; float ctot = 0.f;
    if (blockIdx.x < NSEG * 4) { gla_prefetch<1>(a, pre, tid, (blockIdx.x >> 2) * 256, blockIdx.x & 3, 0, -1); ctot = gla_a1(lds, pre, w, lane & 15, lane >> 4, 0); }
    for (int item = blockIdx.x; item < NSEG * 4; item += gridDim.x) {
        const int h = item & 3, seg = item >> 2;
        const int nitem = item + gridDim.x < NSEG * 4 ? item + gridDim.x : item;
        u32x4* stash = (u32x4*)a.out + (size_t)item * 4 * 1024;
#pragma unroll 1
        for (int dir = 0; dir < 2; ++dir) {
            f32x4 Sacc[8];
            const u32x2* src = (const u32x2*)(a.ws + WS_ST + (size_t)((seg * 4 + h) * 2 + dir) * 32768) + (size_t)w * 8 * 64 + lane;
#pragma unroll
            for (int kt = 0; kt < 8; ++kt) { const u32x2 v = src[kt * 64]; Sacc[kt] = (f32x4){__uint_as_float(v.x), __uint_as_float(v.y), 0.f, 0.f}; }
            if (dir == 0) {
                for (int c = 0; c < 4; ++c) { const int ntb = seg * 256 + (c < 3 ? c + 1 : 3) * 64, ndir = c < 3 ? 0 : 1;
                    gla_chunk<1>(a, lds, seg * 256 + c * 64, h, 0, Sacc, ctot, stash + c * 1024, pre, pre, ntb, h, ndir, c == 0, par); par ^= 1; }
            } else {
                for (int c = 3; c >= 0; --c) { const int ntb = c > 0 ? seg * 256 + (c - 1) * 64 : (nitem >> 2) * 256, nh = c > 0 ? h : (nitem & 3), ndir = c > 0 ? 1 : 0;
                    gla_chunk<2>(a, lds, seg * 256 + c * 64, h, 1, Sacc, ctot, stash + c * 1024, pre, pre, ntb, nh, ndir, c == 3, par); par ^= 1; }
            }
        }
    }
    __syncthreads();
}
typedef float f32x16 __attribute__((ext_vector_type(16)));
#define MFMA32(a, b, c) __builtin_amdgcn_mfma_f32_32x32x16_bf16((a), (b), (c), 0, 0, 0)
constexpr int SW_K = 0, SW_V = 65536, SW_TB = 131072, SW_TBN = 336, SW_TBH = 4 * SW_TBN * 4;
constexpr float SW_NEG = -1e30f;
__device__ __forceinline__ unsigned offk(unsigned row, unsigned c8) { return 128u * row + 16u * (c8 ^ ((row >> 1) & 7)); }
__device__ __forceinline__ unsigned offv(unsigned row, unsigned c8) { return 128u * row + 16u * (c8 ^ (((row >> 1) & 1) << 2)); }
__device__ __forceinline__ void swa_load_block(const bf16_t* U, int gb, int kvh, bool valid, int tid, u32x4 (&kk)[2], u32x4 (&vv)[2]) {
#pragma unroll
    for (int i = 0; i < 2; ++i) {
        const int idx = tid + 512 * i, r = idx >> 3, c8 = idx & 7;
        kk[i] = (u32x4){0, 0, 0, 0}; vv[i] = (u32x4){0, 0, 0, 0};
        if (valid) { const bf16_t* ur = U + (size_t)(gb * 128 + r) * UP + kvh * 64 + c8 * 8; kk[i] = __builtin_nontemporal_load((const u32x4*)(ur + C_KB)); vv[i] = __builtin_nontemporal_load((const u32x4*)(ur + C_VB)); }
    }
}
__device__ __forceinline__ void swa_store_block(LAS unsigned char* lds, int gb, int tid, const u32x4 (&kk)[2], const u32x4 (&vv)[2]) {
#pragma unroll
    for (int i = 0; i < 2; ++i) {
        const int idx = tid + 512 * i, r = 128 * (gb & 3) + (idx >> 3), c8 = idx & 7;
        *(LAS u32x4*)(lds + SW_K + offk(r, c8)) = kk[i]; *(LAS u32x4*)(lds + SW_V + offv(r, c8)) = vv[i];
    }
}
__device__ __forceinline__ bool swa_exists(int gb) { return gb >= 0 && gb < NTOK / 128; }
__device__ __forceinline__ void phase_swa(const Args& a, LAS unsigned char* lds) {
    const bf16_t* U = (const bf16_t*)(a.ws + WS_U); bf16_t* ymix = (bf16_t*)((unsigned char*)a.out + 96 * MiB);
    const int tid = tid_now(), lane = tid & 63, w = __builtin_amdgcn_readfirstlane(tid >> 6), r = lane & 31, hh = lane >> 5;
    for (int su = blockIdx.x; su < (NTOK / 128 / 3) * 2; su += gridDim.x) {
        const int kvh = su & 1, qb0 = 3 * (su >> 1);
        __syncthreads();
        for (int e = tid; e < 4 * SW_TBN; e += NTHR) {
            const int hl = e / SW_TBN, idx = e - hl * SW_TBN, rel = idx - 160;
            const float val = (rel >= -128 && rel <= 128) ? a.relb[t5_bucket(rel) * 8 + kvh * 4 + hl] : SW_NEG;
            LAS float* tb = (LAS float*)(lds + SW_TB + hl * SW_TBH);
#pragma unroll
            for (int s = 0; s < 4; ++s) if (idx - s >= 0) tb[s * SW_TBN + idx - s] = val;
        }
#pragma unroll 1
        for (int bb = -1; bb <= 1; ++bb) { u32x4 kk[2], vv[2]; swa_load_block(U, qb0 + bb, kvh, swa_exists(qb0 + bb), tid, kk, vv); swa_store_block(lds, qb0 + bb, tid, kk, vv); }
        __syncthreads();
        const int hl = w >> 1, hq = kvh * 4 + hl;
        const float snk = a.sink[hq];
#pragma unroll 1
        for (int qi = 0; qi < 3; ++qi) {
            const int qb = qb0 + qi, tok0 = qb * 128; int s0, L; seq_of(tok0, s0, L);
            const bool first = tok0 == s0, last = tok0 + 128 == s0 + L;
            u32x4 nk[2], nv[2];
            if (qi < 2) swa_load_block(U, qb + 2, kvh, swa_exists(qb + 2), tid, nk, nv);
            bf16x8 Qn[4];
            { const int qt0 = tok0 + 32 * ((w & 1) * 2) + r;
#pragma unroll
              for (int s = 0; s < 4; ++s) Qn[s] = *(const bf16x8*)(U + (size_t)qt0 * UP + C_QB + hq * 64 + 16 * s + 8 * hh); }
#pragma unroll 1
            for (int ss = 0; ss < 2; ++ss) {
                const int st = (w & 1) * 2 + ss, qtok = tok0 + 32 * st + r;
                bf16x8 Qf[4];
#pragma unroll
                for (int s = 0; s < 4; ++s) Qf[s] = Qn[s];
                { const int qt1 = ss == 0 ? qtok + 32 : qtok;
#pragma unroll
                  for (int s = 0; s < 4; ++s) Qn[s] = *(const bf16x8*)(U + (size_t)qt1 * UP + C_QB + hq * 64 + 16 * s + 8 * hh); }
                u32x2 zv8[2][4];
#pragma unroll
                for (int dt = 0; dt < 2; ++dt)
#pragma unroll
                    for (int i4 = 0; i4 < 4; ++i4) zv8[dt][i4] = *(const u32x2*)(U + (size_t)qtok * UP + C_ZB + hq * 64 + 32 * dt + 8 * i4 + 4 * hh);
                float m = snk, l = hh == 0 ? 1.0f : 0.0f;
                f32x16 O[2];
#pragma unroll
                for (int i = 0; i < 16; ++i) { O[0][i] = 0.f; O[1][i] = 0.f; }
                const int sft = (-r) & 3;
                const unsigned tbase = SW_TB + hl * SW_TBH + sft * (SW_TBN * 4) + 4 * (32 + 4 * hh - r - sft);
                const unsigned kb0 = SW_K + 128u * r + 16u * (hh ^ ((r >> 1) & 7));
                const int q4 = (lane & 15) >> 2, p4 = lane & 3, g1 = (lane >> 4) & 1, xq = (q4 >> 1) & 1;
                const unsigned vb0 = SW_V + 128u * (4 * hh + q4) + 16u * ((4 * xq) | (2 * g1) | (p4 >> 1)) + 8u * (p4 & 1);
#pragma unroll 1
                for (int grp = 0; grp < 3; ++grp) {
                    f32x16 S[3];
#pragma unroll
                    for (int k3 = 0; k3 < 3; ++k3) {
                        const int kk = 3 * grp + k3, kt = st + kk, blk = kt >> 2;
                        const bool valid = !((blk == 0 && first) || (blk == 2 && last));
                        const unsigned rowb = 128u * (128u * ((unsigned)(qb - 1 + blk) & 3u) + 32u * (kt & 3));
                        if (valid) {
#pragma unroll
                            for (int i = 0; i < 16; ++i) S[k3][i] = 0.f;
#pragma unroll
                            for (int s = 0; s < 4; ++s) { const bf16x8 Kf = *(const LAS bf16x8*)(lds + (kb0 ^ (32u * s)) + rowb); S[k3] = MFMA32(Kf, Qf[s], S[k3]); }
#pragma unroll
                            for (int i4 = 0; i4 < 4; ++i4) { const f32x4 bv = *(const LAS f32x4*)(lds + tbase + 4 * (32 * kk + 8 * i4));
#pragma unroll
                                for (int j = 0; j < 4; ++j) S[k3][4 * i4 + j] += bv[j]; }
                        } else {
#pragma unroll
                            for (int i = 0; i < 16; ++i) S[k3][i] = SW_NEG;
                        }
                    }
                    float mx4[4] = {SW_NEG, SW_NEG, SW_NEG, SW_NEG};
#pragma unroll
                    for (int k3 = 0; k3 < 3; ++k3)
#pragma unroll
                        for (int i = 0; i < 16; ++i) mx4[i & 3] = fmaxf(mx4[i & 3], S[k3][i]);
                    float mx = fmaxf(fmaxf(mx4[0], mx4[1]), fmaxf(mx4[2], mx4[3]));
                    mx = fmaxf(mx, __shfl_xor(mx, 32));
                    const float mn = fmaxf(m, mx), alpha = fexp(m - mn);
                    m = mn; l *= alpha;
#pragma unroll
                    for (int i = 0; i < 16; ++i) { O[0][i] *= alpha; O[1][i] *= alpha; }
                    bf16x8 Pf[3][2];
                    float l4[4] = {0.f, 0.f, 0.f, 0.f};
#pragma unroll
                    for (int k3 = 0; k3 < 3; ++k3) {
#pragma unroll
                        for (int i = 0; i < 16; ++i) { const float pv = fexp(S[k3][i] - m); S[k3][i] = pv; l4[i & 3] += pv; }
#pragma unroll
                        for (int s2 = 0; s2 < 2; ++s2) {
                            u32x4 pw;
#pragma unroll
                            for (int j = 0; j < 4; ++j) pw[j] = pk2(S[k3][8 * s2 + 2 * j], S[k3][8 * s2 + 2 * j + 1]);
                            Pf[k3][s2] = __builtin_bit_cast(bf16x8, pw);
                        }
                    }
                    l += (l4[0] + l4[1]) + (l4[2] + l4[3]);
#pragma unroll
                    for (int k3 = 0; k3 < 3; ++k3) {
                        const int kt = st + 3 * grp + k3, blk = kt >> 2;
                        const unsigned rowb = 128u * (128u * ((unsigned)(qb - 1 + blk) & 3u) + 32u * (kt & 3));
#pragma unroll
                        for (int s2 = 0; s2 < 2; ++s2)
#pragma unroll
                            for (int dt = 0; dt < 2; ++dt) {
                                const unsigned va = (vb0 ^ (64u * dt)) + rowb + 2048u * s2;
                                const bf16x8 Vf = tr_read8(lds, va, va + 1024u);
                                O[dt] = MFMA32(Vf, Pf[k3][s2], O[dt]);
                            }
                    }
                }
                l += __shfl_xor(l, 32);
                const float inv = __builtin_amdgcn_rcpf(l);
#pragma unroll
                for (int dt = 0; dt < 2; ++dt)
#pragma unroll
                    for (int i4 = 0; i4 < 4; ++i4) {
                        const int d0 = 32 * dt + 8 * i4 + 4 * hh;
                        const u32x2 zv = zv8[dt][i4];
                        const float z0 = __uint_as_float(zv.x << 16), z1 = __uint_as_float(zv.x & 0xffff0000u), z2 = __uint_as_float(zv.y << 16), z3 = __uint_as_float(zv.y & 0xffff0000u);
                        u32x2 yw; yw.x = pk2(O[dt][4 * i4] * inv * silu(z0), O[dt][4 * i4 + 1] * inv * silu(z1)); yw.y = pk2(O[dt][4 * i4 + 2] * inv * silu(z2), O[dt][4 * i4 + 3] * inv * silu(z3));
                        *(u32x2*)(ymix + (size_t)qtok * DM + 512 + hq * 64 + d0) = yw;
                    }
            }
            if (qi < 2) swa_store_block(lds, qb + 2, tid, nk, nv);
            __syncthreads();
        }
    }
}
__device__ __forceinline__ void phase_convfix(const Args& a) {
    bf16_t* G = (bf16_t*)(a.ws + WS_XB); const float* Pb = (const float*)(a.ws + WS_PB); const float* Sb = (const float*)(a.ws + WS_SB);
    for (int idx = blockIdx.x * NTHR + tid_now(); idx < (NTOK / 64 - 1) * 256; idx += gridDim.x * NTHR) {
        const int k = idx / 256 + 1, c = (idx & 255) * 4, row = 64 * k; int s0, L; seq_of(row, s0, L);
        if (row == s0) continue;
        const f32x4 pl = *(const f32x4*)(Pb + (size_t)((k - 1) * 2 + 1) * 1024 + c), sl = *(const f32x4*)(Sb + (size_t)((k - 1) * 2 + 1) * 1024 + c);
        const f32x4 pf = *(const f32x4*)(Pb + (size_t)(k * 2) * 1024 + c), sf = *(const f32x4*)(Sb + (size_t)(k * 2) * 1024 + c);
        const f32x4 c0 = *(const f32x4*)(a.cw + c), c2 = *(const f32x4*)(a.cw + 2048 + c);
        u32x2* gl = (u32x2*)(G + (size_t)(row - 1) * DM + c); u32x2* gf = (u32x2*)(G + (size_t)row * DM + c);
        const u32x2 a0 = *gl, a1 = *gf;
        const f32x4 dl = sl * c2 * pf, df = sf * c0 * pl;
        u32x2 o0, o1;
        o0.x = pk2(__uint_as_float(a0.x << 16) + dl[0], __uint_as_float(a0.x & 0xffff0000u) + dl[1]); o0.y = pk2(__uint_as_float(a0.y << 16) + dl[2], __uint_as_float(a0.y & 0xffff0000u) + dl[3]);
        o1.x = pk2(__uint_as_float(a1.x << 16) + df[0], __uint_as_float(a1.x & 0xffff0000u) + df[1]); o1.y = pk2(__uint_as_float(a1.y << 16) + df[2], __uint_as_float(a1.y & 0xffff0000u) + df[3]);
        *gl = o0; *gf = o1;
    }
}
__global__ void __launch_bounds__(NTHR, 2) mega(Args a) {
    LAS unsigned char* lds = (LAS unsigned char*)lds_raw;
    volatile LAS unsigned* MISC = (volatile LAS unsigned*)(lds + MISC_OFF);
    if (threadIdx.x < 32) MISC[threadIdx.x] = 0u;
    if ((threadIdx.x & 63) == 0) ((volatile LAS unsigned*)(lds + SLOT_OFF))[hw_slot()] = threadIdx.x >> 6;
    __syncthreads();
    unsigned char* ws = a.ws; float* out = a.out;
    XcdBarrier bar = xcd_barrier_post((unsigned*)(ws + WS_CTL) + 4096, MISC + 8);
    bf16_t* W1t = (bf16_t*)(ws + WS_W1T); bf16_t* W2t = (bf16_t*)(ws + WS_W2T); bf16_t* W3t = (bf16_t*)(ws + WS_W3T); bf16_t* W4t = (bf16_t*)(ws + WS_W4T);
    bf16_t* xb = (bf16_t*)(ws + WS_XB); bf16_t* ymix = (bf16_t*)((unsigned char*)out + 96 * MiB); bf16_t* G = xb; bf16_t* U = (bf16_t*)(ws + WS_U);
    bf16_t* x1b = (bf16_t*)(ws + WS_X1B); bf16_t* P = (bf16_t*)(ws + WS_P); bf16_t* Sg = (bf16_t*)(ws + WS_S);
    f32x2* stat1 = (f32x2*)(ws + WS_STAT1); f32x2* stat2 = (f32x2*)(ws + WS_STAT2); f32x2* mr1 = (f32x2*)(ws + WS_MR1);

    phase_convert(a, lds);
    xcd_barrier(bar);
    { pg8::Gemm g{xb, W1t, NTOK, C_GD, DM, 0}; pg8::StaticOrder S; S.init(NTOK, C_GD, gridDim.x, blockIdx.x); EpiU E{U}; pg8::gemm_phase<EpiU, pg8::StaticOrder>(lds, g, S, E); }
    xcd_barrier(bar);
    phase_gla_pass1(a, lds);
    xcd_barrier(bar);
    phase_gla_pass2(a);
    phase_swa(a, lds);
    xcd_barrier(bar);
    phase_gla_pass3(a, lds);
    xcd_barrier(bar);
    { pg8::Gemm g{ymix, W2t, NTOK, DM, DM, 0}; pg8::StaticOrder S; S.init(NTOK, DM, gridDim.x, blockIdx.x);
      EpiLN<0> E{ws, nullptr, a.lng, a.lnb}; pg8::gemm_phase<EpiLN<0>, pg8::StaticOrder>(lds, g, S, E); }
    xcd_barrier(bar);
    { pg8::Gemm g{x1b, W3t, NTOK, 4096, DM, 0}; pg8::StaticOrder S; S.init(NTOK, 4096, gridDim.x, blockIdx.x); EpiG E{ws, a.cw}; pg8::gemm_phase<EpiG, pg8::StaticOrder>(lds, g, S, E); }
    xcd_barrier(bar);
    phase_convfix(a);
    xcd_barrier(bar);
    { pg8::Gemm g{G, W4t, NTOK, DM, DM, 0}; pg8::StaticOrder S; S.init(NTOK, DM, gridDim.x, blockIdx.x);
      EpiLN<1> E{ws, out, a.lng + DM, a.lnb + DM}; pg8::gemm_phase<EpiLN<1>, pg8::StaticOrder>(lds, g, S, E); }
}

extern "C" void kernel_launch(void* const* d_in, const int* in_sizes, int n_in, void* d_out, int out_size, void* d_ws, size_t ws_size, hipStream_t stream) {
    static int grid = 0;
    if (grid == 0) {
        if (n_in != 16 || out_size != NTOK * DM || ws_size < WS_END) { fprintf(stderr, "kernel_launch: unexpected shapes (n_in %d out %d ws %zu)\n", n_in, out_size, ws_size); grid = -1; return; }
        int dev = 0, cus = 0, per_cu = 0;
        if (hipGetDevice(&dev) != hipSuccess || hipDeviceGetAttribute(&cus, hipDeviceAttributeMultiprocessorCount, dev) != hipSuccess) { grid = -1; return; }
        if (hipFuncSetAttribute((const void*)mega, hipFuncAttributeMaxDynamicSharedMemorySize, LDS_BYTES) != hipSuccess) { fprintf(stderr, "kernel_launch: hipFuncSetAttribute failed\n"); grid = -1; return; }
        if (hipOccupancyMaxActiveBlocksPerMultiprocessor(&per_cu, (const void*)mega, NTHR, LDS_BYTES) != hipSuccess || per_cu < 1) { fprintf(stderr, "kernel_launch: occupancy query says %d blocks per CU\n", per_cu); (void)hipGetLastError(); grid = -1; return; }
        grid = cus;
    }
    if (grid < 0) return;
    (void)hipMemsetAsync((char*)d_ws + WS_CTL, 0, 262144, stream);
    Args a{};
    a.xp = (const float*)d_in[0]; a.xs = (const float*)d_in[1]; a.w_in_even = (const float*)d_in[2]; a.wuf = (const float*)d_in[3]; a.bfw = (const float*)d_in[4];
    a.wub = (const float*)d_in[5]; a.bbw = (const float*)d_in[6]; a.ng = (const float*)d_in[7]; a.sink = (const float*)d_in[8]; a.relb = (const float*)d_in[9];
    a.w_out_even = (const float*)d_in[10]; a.w_in_odd = (const float*)d_in[11]; a.cw = (const float*)d_in[12]; a.w_out_odd = (const float*)d_in[13];
    a.lng = (const float*)d_in[14]; a.lnb = (const float*)d_in[15]; a.out = (float*)d_out; a.ws = (unsigned char*)d_ws;
    hipLaunchKernelGGL(mega, dim3(grid), dim3(NTHR), LDS_BYTES, stream, a);
}
```

```cpp
#include <hip/hip_runtime.h>
#include <cstdio>

typedef unsigned short bf16_t;
typedef short bf16x8 __attribute__((ext_vector_type(8)));
typedef float f32x4 __attribute__((ext_vector_type(4)));
typedef float f32x2 __attribute__((ext_vector_type(2)));
typedef unsigned u32x4 __attribute__((ext_vector_type(4)));
typedef unsigned u32x2 __attribute__((ext_vector_type(2)));
#define LAS __attribute__((address_space(3)))
#define MFMA16(a, b, c) __builtin_amdgcn_mfma_f32_16x16x32_bf16((a), (b), (c), 0, 0, 0)
extern __shared__ __attribute__((aligned(16))) unsigned char lds_raw[];
constexpr int SLOT_OFF = 163840 - 1024;
__device__ __forceinline__ unsigned hw_slot() { return (unsigned)__builtin_amdgcn_s_getreg((5 << 11) | 4) & 63u; }
__device__ __forceinline__ int tid_now() {
    const int wid = __builtin_amdgcn_readfirstlane((int)((volatile LAS unsigned*)((LAS unsigned char*)lds_raw + SLOT_OFF))[hw_slot()]);
    return wid * 64 + (int)__lane_id();
}

constexpr int DM = 1024, NTOK = 49152, NPROMPT = 32768, LP = 16384, LS = 4096;
constexpr int UP = 3584;
constexpr int C_QA = 0, C_KA = 512, C_VA = 1024, C_ZA = 1536, C_QB = 2048, C_KB = 2560, C_VB = 2688, C_ZB = 2816, C_GD = 3328;
constexpr int EVEN_IN = 3360, ODD_IN = 4096;
constexpr float DN_ALPHA = 1.41421356237309515f;
constexpr float LN_EPS = 1e-5f, NORM_EPS = 1e-6f;

constexpr size_t MiB = 1u << 20;
constexpr size_t WS_CTL = 0, WS_W1T = 1 * MiB, WS_W2T = 8 * MiB, WS_W3T = 10 * MiB, WS_W4T = 18 * MiB, WS_STAT1 = 20 * MiB, WS_MR1 = 26 * MiB, WS_DEC = 27 * MiB, WS_GATE = 27 * MiB + 768 * 1024,
                 WS_XB = 28 * MiB  , WS_U = 124 * MiB, WS_ST = 460 * MiB, WS_END = 508 * MiB;
constexpr size_t WS_X1B = WS_U, WS_P = WS_U + 96 * MiB, WS_S = WS_U + 192 * MiB, WS_STAT2 = WS_U + 288 * MiB, WS_PB = WS_U + 296 * MiB, WS_SB = WS_U + 304 * MiB;

__device__ __forceinline__ float bf2f(bf16_t b) { return __uint_as_float(((unsigned)b) << 16); }
typedef __bf16 nbf16x2 __attribute__((ext_vector_type(2)));
__device__ __forceinline__ bf16_t f2bf(float f) { return __builtin_bit_cast(bf16_t, (__bf16)f); }
__device__ __forceinline__ unsigned pk2(float lo, float hi) { return __builtin_bit_cast(unsigned, __builtin_convertvector((f32x2){lo, hi}, nbf16x2)); }
__device__ __forceinline__ float fexp2(float x) { return __builtin_amdgcn_exp2f(x); }
__device__ __forceinline__ float fexp(float x) { return __builtin_amdgcn_exp2f(x * 1.4426950408889634f); }
__device__ __forceinline__ float flog2(float x) { return __builtin_amdgcn_logf(x); }
__device__ __forceinline__ float silu(float x) { return x * __builtin_amdgcn_rcpf(1.0f + fexp(-x)); }
__device__ __forceinline__ float wave_sum(float v) {
#pragma unroll
    for (int o = 1; o < 64; o <<= 1) v += __shfl_xor(v, o);
    return v;
}
__device__ __forceinline__ float wave_max(float v) {
#pragma unroll
    for (int o = 1; o < 64; o <<= 1) v = fmaxf(v, __shfl_xor(v, o));
    return v;
}
__device__ __forceinline__ void seq_of(int row, int& s0, int& L) {
    if (row < NPROMPT) { L = LP; s0 = row & ~(LP - 1); } else { L = LS; s0 = NPROMPT + ((row - NPROMPT) & ~(LS - 1)); }
}

namespace pg8 {
constexpr int BM = 256, BK = 64, HALF = 128, HTB = HALF * BK * 2, STAGE_BYTES = 8 * HTB, NXCD = 8, WGM = 8;
__host__ __device__ __forceinline__ int lds_byte(int r, int c) { const int st = (r >> 4) * 2 + (c >> 5), rr = r & 15, cc = c & 31, ob = rr * 64 + cc * 2; return st * 1024 + (ob ^ (((ob >> 9) & 1) << 5)); }
__host__ __device__ __forceinline__ void stage_rc(int b, int& R, int& C) { const int st = b / 1024, sb = b % 1024, swz = sb ^ (((sb >> 9) & 1) << 5); R = (st >> 1) * 16 + swz / 64; C = (st & 1) * 32 + (swz % 64) / 2; }
__host__ __device__ __forceinline__ int perm32(int rho) { const int n = rho >> 4, i = rho & 15; return 8 * (i >> 2) + 4 * n + (i & 3); }
struct Unit { int pm, pn; };
struct Gemm { const bf16_t* A; const bf16_t* Bt; int M, N, K, pad; };
struct StaticOrder {
    int nM, nN, nwg, G, c;
    __host__ __device__ void init(int M, int N, int G_, int c_) { nM = M / BM; nN = N / BM; nwg = nM * nN; G = G_; c = c_; }
    __host__ __device__ bool next(int i, Unit& u) const {
        const long L = (long)i * G + c; if (L >= nwg) return false;
        int wgid = (int)L; { const int q = nwg / NXCD, r = nwg % NXCD, xcd = wgid % NXCD, off = wgid / NXCD; wgid = (xcd < r ? xcd * (q + 1) : r * (q + 1) + (xcd - r) * q) + off; }
        const int nig = WGM * nN, gid = wgid / nig, fm = gid * WGM, gsz = (nM - fm) < WGM ? (nM - fm) : WGM;
        u.pm = fm + ((wgid % nig) % gsz); u.pn = (wgid % nig) / gsz; return true;
    }
    __device__ __forceinline__ void a_ready(const Unit&) const {}
    __device__ __forceinline__ void done(const Unit&) const {}
};

template <class Epi, class Sched>
__device__ __forceinline__ void gemm_phase(LAS unsigned char* lds, const Gemm g, const Sched& S, const Epi& E) {
    int tid = tid_now(); asm volatile("" : "+v"(tid));
    const int wid = __builtin_amdgcn_readfirstlane(tid >> 6), lane = tid & 63, wr = wid >> 2, wc = wid & 3, fr = lane & 15, fq = lane >> 4;
    const int K = g.K, nt = K / BK;
    unsigned voffA[2], voffB[2];
#pragma unroll
    for (int i = 0; i < 2; ++i) { int R, C; stage_rc(tid * 16 + i * 8192, R, C); const int Rb = Epi::PERM ? ((R & ~31) + perm32(R & 31)) : R;
        voffA[i] = (unsigned)(R * K + C) * 2u; voffB[i] = (unsigned)(Rb * K + C) * 2u; }
    const size_t kstep = (size_t)(BK * 2);
    const size_t hstep = (size_t)HALF * K * 2;
    const size_t tstep = 2 * hstep;
    const unsigned ldsw = (unsigned)wid * 1024u;
    const int aoff = lds_byte(wr * 64 + fr, fq * 8), boff = lds_byte(wc * 32 + fr, fq * 8);
#define PG8_SA(b, h) (((b) * 2 + (h)) * HTB)
#define PG8_SB(b, h) ((4 + (b) * 2 + (h)) * HTB)
#define PG8_STAGE(bufoff, gbase, voff) do { _Pragma("unroll") for (int _i = 0; _i < 2; ++_i) \
        __builtin_amdgcn_global_load_lds((const unsigned*)((const char*)(gbase) + (voff)[_i]), (LAS unsigned*)(lds + (bufoff) + ldsw + _i * 8192), 16, 0, 0); } while (0)
#define PG8_LDA(dst, b, h) do { _Pragma("unroll") for (int m = 0; m < 4; ++m) _Pragma("unroll") for (int k = 0; k < 2; ++k) dst[m][k] = *(const LAS bf16x8*)(lds + PG8_SA(b, h) + aoff + m * 2048 + k * 1024); } while (0)
#define PG8_LDB(dst, b, h) do { _Pragma("unroll") for (int n = 0; n < 2; ++n) _Pragma("unroll") for (int k = 0; k < 2; ++k) dst[n][k] = *(const LAS bf16x8*)(lds + PG8_SB(b, h) + boff + n * 2048 + k * 1024); } while (0)
#define PG8_MMA(ai, bj, At, Bt) do { __builtin_amdgcn_s_setprio(1); _Pragma("unroll") for (int m = 0; m < 4; ++m) _Pragma("unroll") for (int n = 0; n < 2; ++n) _Pragma("unroll") for (int k = 0; k < 2; ++k) \
        acc[ai][bj][m][n] = __builtin_amdgcn_mfma_f32_16x16x32_bf16(Bt[n][k], At[m][k], acc[ai][bj][m][n], 0, 0, 0); __builtin_amdgcn_s_setprio(0); } while (0)
#define PG8_WAIT_V(n) asm volatile("s_waitcnt vmcnt(" #n ")" ::: "memory")
#define PG8_WAIT_L(n) asm volatile("s_waitcnt lgkmcnt(" #n ")" ::: "memory")
#define PG8_BAR __builtin_amdgcn_s_barrier()
#define PG8_SCHED __builtin_amdgcn_sched_barrier(0)
    Unit cur, nxt; int ui = 0;
    if (!S.next(0, cur)) return;
    f32x4 acc[2][2][4][2];
#pragma unroll
    for (int a = 0; a < 2; ++a)
#pragma unroll
        for (int b = 0; b < 2; ++b)
#pragma unroll
            for (int m = 0; m < 4; ++m)
#pragma unroll
                for (int n = 0; n < 2; ++n) acc[a][b][m][n] = (f32x4){0.f, 0.f, 0.f, 0.f};
    bf16x8 At[4][2], B0[2][2], B1[2][2];
    const char* cA = (const char*)g.A + (size_t)cur.pm * tstep; const char* cB = (const char*)g.Bt + (size_t)cur.pn * tstep;
    S.a_ready(cur);
    PG8_STAGE(PG8_SB(0, 0), cB, voffB); PG8_STAGE(PG8_SA(0, 0), cA, voffA); PG8_STAGE(PG8_SB(0, 1), cB + hstep, voffB); PG8_STAGE(PG8_SA(0, 1), cA + hstep, voffA);
    if (wr == 1) PG8_BAR;
    PG8_WAIT_V(4); PG8_BAR;
    PG8_STAGE(PG8_SB(1, 0), cB + kstep, voffB); PG8_STAGE(PG8_SA(1, 0), cA + kstep, voffA); PG8_STAGE(PG8_SB(1, 1), cB + hstep + kstep, voffB);
    PG8_WAIT_V(6); PG8_BAR;
    for (;;) {
        const bool has_next = S.next(ui + 1, nxt);
        const char* nA = has_next ? (const char*)g.A + (size_t)nxt.pm * tstep : cA; const char* nB = has_next ? (const char*)g.Bt + (size_t)nxt.pn * tstep : cB;
        for (int t = 0; t < nt; t += 2) {
            const bool last = (t == nt - 2);
            const char* a1 = cA + (size_t)(t + 1) * kstep;
            const char* a2 = last ? nA : cA + (size_t)(t + 2) * kstep; const char* b2 = last ? nB : cB + (size_t)(t + 2) * kstep;
            const char* a3 = a2 + kstep; const char* b3 = b2 + kstep;
            if (last && has_next) S.a_ready(nxt);
            PG8_LDB(B0, 0, 0); PG8_SCHED; PG8_LDA(At, 0, 0); PG8_STAGE(PG8_SA(1, 1), a1 + hstep, voffA);
            PG8_WAIT_L(8); PG8_BAR; PG8_WAIT_L(0); PG8_MMA(0, 0, At, B0); PG8_BAR; PG8_SCHED;
            PG8_LDB(B1, 0, 1); PG8_STAGE(PG8_SB(0, 0), b2, voffB);
            PG8_BAR; PG8_WAIT_L(0); PG8_MMA(0, 1, At, B1); PG8_BAR;
            PG8_LDA(At, 0, 1); PG8_STAGE(PG8_SA(0, 0), a2, voffA);
            PG8_BAR; PG8_WAIT_L(0); PG8_MMA(1, 0, At, B0); PG8_BAR; PG8_SCHED;
            PG8_STAGE(PG8_SB(0, 1), b2 + hstep, voffB);
            PG8_WAIT_V(6); PG8_BAR; PG8_MMA(1, 1, At, B1); PG8_BAR;
            PG8_LDB(B0, 1, 0); PG8_SCHED; PG8_LDA(At, 1, 0); PG8_STAGE(PG8_SA(0, 1), a2 + hstep, voffA);
            PG8_WAIT_L(8); PG8_BAR; PG8_WAIT_L(0); PG8_MMA(0, 0, At, B0); PG8_BAR; PG8_SCHED;
            PG8_LDB(B1, 1, 1); PG8_STAGE(PG8_SB(1, 0), b3, voffB);
            PG8_BAR; PG8_WAIT_L(0); PG8_MMA(0, 1, At, B1); PG8_BAR;
            PG8_LDA(At, 1, 1); PG8_STAGE(PG8_SA(1, 0), a3, voffA);
            PG8_BAR; PG8_WAIT_L(0); PG8_MMA(1, 0, At, B0); PG8_BAR; PG8_SCHED;
            PG8_STAGE(PG8_SB(1, 1), b3 + hstep, voffB);
            PG8_WAIT_V(6); PG8_BAR; PG8_MMA(1, 1, At, B1); PG8_BAR;
        }
        if constexpr (Epi::REALIGN) { if (wr == 0) PG8_BAR; }
        E(acc, cur, wr, wc, fr, fq); S.done(cur);
        if constexpr (Epi::REALIGN) { if (wr == 1) PG8_BAR; }
        if (!has_next) break;
#pragma unroll
        for (int a = 0; a < 2; ++a)
#pragma unroll
            for (int b = 0; b < 2; ++b)
#pragma unroll
                for (int m = 0; m < 4; ++m)
#pragma unroll
                    for (int n = 0; n < 2; ++n) acc[a][b][m][n] = (f32x4){0.f, 0.f, 0.f, 0.f};
        cur = nxt; cA = nA; cB = nB; ++ui;
    }
    PG8_WAIT_V(0);
    if (wr == 0) PG8_BAR;
    PG8_BAR;
#undef PG8_SA
#undef PG8_SB
#undef PG8_STAGE
#undef PG8_LDA
#undef PG8_LDB
#undef PG8_MMA
#undef PG8_WAIT_V
#undef PG8_WAIT_L
#undef PG8_BAR
#undef PG8_SCHED
}
}

struct EpiU {
    static constexpr bool PERM = true, AFTER_DRAIN = false, REALIGN = false;
    bf16_t* O;
    __device__ __forceinline__ void operator()(const f32x4 (&acc)[2][2][4][2], const pg8::Unit& u, int wr, int wc, int fr, int fq) const {
        const int row0 = u.pm * 256 + wr * 64 + fr, col0 = u.pn * 256 + wc * 32 + 8 * fq;
#pragma unroll
        for (int ai = 0; ai < 2; ++ai)
#pragma unroll
            for (int m = 0; m < 4; ++m) { bf16_t* rowp = O + (size_t)(row0 + ai * 128 + m * 16) * UP + col0;
#pragma unroll
                for (int bj = 0; bj < 2; ++bj) { const f32x4 v0 = acc[ai][bj][m][0], v1 = acc[ai][bj][m][1];
                    u32x4 w; w.x = pk2(v0[0], v0[1]); w.y = pk2(v0[2], v0[3]); w.z = pk2(v1[0], v1[1]); w.w = pk2(v1[2], v1[3]);
                    *(u32x4*)(rowp + bj * 128) = w; } }
    }
};
#define RLX_AGENT __ATOMIC_RELAXED, __HIP_MEMORY_SCOPE_AGENT
template <int LAYER> struct EpiLN {
    static constexpr bool PERM = true, AFTER_DRAIN = false, REALIGN = true;
    unsigned char* ws; float* Of; const float* lg; const float* lb;
    __device__ __forceinline__ void operator()(f32x4 (&acc)[2][2][4][2], const pg8::Unit& u, int wr, int wc, int fr, int fq) const {
        unsigned char* w2 = ws; asm volatile("" : "+s"(w2));
        const bf16_t* R = (const bf16_t*)(w2 + (LAYER == 0 ? WS_XB : WS_X1B)); bf16_t* Ob = (bf16_t*)(w2 + WS_X1B);
        unsigned long long* xbuf = (unsigned long long*)(w2 + WS_STAT1 + (LAYER == 0 ? 0 : 3 * MiB));
        unsigned* cnt = (unsigned*)(w2 + WS_CTL) + 16384 + LAYER * 192 * 64;
        const int col0 = u.pn * 256 + wc * 32 + 8 * fq, rowb = u.pm * 256 + wr * 64 + fr;
        LAS f32x2* part = (LAS f32x2*)((LAS unsigned char*)lds_raw + 131072);
        float ps[2][4], pq[2][4];
#pragma unroll
        for (int ai = 0; ai < 2; ++ai) {
            u32x4 rwa[4][2];
#pragma unroll
            for (int m = 0; m < 4; ++m)
#pragma unroll
                for (int bj = 0; bj < 2; ++bj) rwa[m][bj] = *(const u32x4*)(R + (size_t)(rowb + ai * 128 + m * 16) * DM + col0 + bj * 128);
#pragma unroll
            for (int m = 0; m < 4; ++m) {
                float s = 0.f, q = 0.f;
#pragma unroll
                for (int bj = 0; bj < 2; ++bj) {
                    const u32x4 rw = rwa[m][bj];
                    f32x4 r0 = (f32x4){__uint_as_float(rw.x << 16), __uint_as_float(rw.x & 0xffff0000u), __uint_as_float(rw.y << 16), __uint_as_float(rw.y & 0xffff0000u)};
                    f32x4 r1 = (f32x4){__uint_as_float(rw.z << 16), __uint_as_float(rw.z & 0xffff0000u), __uint_as_float(rw.w << 16), __uint_as_float(rw.w & 0xffff0000u)};
                    const f32x4 v0 = r0 * DN_ALPHA + acc[ai][bj][m][0], v1 = r1 * DN_ALPHA + acc[ai][bj][m][1];
                    acc[ai][bj][m][0] = v0; acc[ai][bj][m][1] = v1;
                    s += ((v0[0] + v0[1]) + (v0[2] + v0[3])) + ((v1[0] + v1[1]) + (v1[2] + v1[3]));
                    q += ((v0[0] * v0[0] + v0[1] * v0[1]) + (v0[2] * v0[2] + v0[3] * v0[3])) + ((v1[0] * v1[0] + v1[1] * v1[1]) + (v1[2] * v1[2] + v1[3] * v1[3]));
                }
                s += __shfl_xor(s, 16); s += __shfl_xor(s, 32); q += __shfl_xor(q, 16); q += __shfl_xor(q, 32);
                if (fq == 0) part[(ai * 128 + wr * 64 + m * 16 + fr) * 4 + wc] = (f32x2){s, q};
            }
        }
        const int tid = (wr * 4 + wc) * 64 + fq * 16 + fr;
        asm volatile("s_waitcnt lgkmcnt(0)" ::: "memory"); __builtin_amdgcn_s_barrier(); asm volatile("" ::: "memory");
        if (tid < 256) {
            const LAS f32x4* pp = (const LAS f32x4*)(part + tid * 4); const f32x4 a01 = pp[0], a23 = pp[1];
            const float s = (a01[0] + a01[2]) + (a23[0] + a23[2]), q = (a01[1] + a01[3]) + (a23[1] + a23[3]);
            __hip_atomic_store(xbuf + (size_t)(u.pm * 256 + tid) * 4 + u.pn, ((unsigned long long)__float_as_uint(q) << 32) | __float_as_uint(s), RLX_AGENT);
        }
        asm volatile("s_waitcnt vmcnt(0)" ::: "memory"); __builtin_amdgcn_s_barrier(); asm volatile("" ::: "memory");
        unsigned* c = cnt + 64 * u.pm;
        if (tid == 0) __hip_atomic_fetch_add(c, 1u, RLX_AGENT);
        if (tid < 64) { unsigned spins = 0;
          while ((unsigned)__builtin_amdgcn_readfirstlane(__hip_atomic_load(c, RLX_AGENT)) < 4u) { __builtin_amdgcn_s_sleep(1); if (++spins > (1u << 16)) break; }
          __builtin_amdgcn_fence(__ATOMIC_ACQUIRE, "agent"); asm volatile("s_waitcnt vmcnt(0)" ::: "memory"); }
        __builtin_amdgcn_s_barrier(); asm volatile("" ::: "memory");
#pragma unroll
        for (int ai = 0; ai < 2; ++ai)
#pragma unroll
            for (int m = 0; m < 4; ++m) {
                const f32x4* sp = (const f32x4*)(xbuf + (size_t)(rowb + ai * 128 + m * 16) * 4);
                const f32x4 a01 = sp[0], a23 = sp[1];
                const float s = (a01[0] + a01[2]) + (a23[0] + a23[2]), q = (a01[1] + a01[3]) + (a23[1] + a23[3]);
                const float mean = s * (1.0f / DM), var = q * (1.0f / DM) - mean * mean;
                ps[ai][m] = mean; pq[ai][m] = rsqrtf(fmaxf(var, 0.f) + LN_EPS);
            }
#pragma unroll
        for (int bj = 0; bj < 2; ++bj) {
            const f32x4 g0 = *(const f32x4*)(lg + col0 + bj * 128), g1 = *(const f32x4*)(lg + col0 + bj * 128 + 4), b0 = *(const f32x4*)(lb + col0 + bj * 128), b1 = *(const f32x4*)(lb + col0 + bj * 128 + 4);
#pragma unroll
            for (int ai = 0; ai < 2; ++ai)
#pragma unroll
                for (int m = 0; m < 4; ++m) {
                    const int row = rowb + ai * 128 + m * 16; const float mean = ps[ai][m], rstd = pq[ai][m];
                    const f32x4 o0 = (acc[ai][bj][m][0] - mean) * rstd * g0 + b0, o1 = (acc[ai][bj][m][1] - mean) * rstd * g1 + b1;
                    if (LAYER == 0) { u32x4 w; w.x = pk2(o0[0], o0[1]); w.y = pk2(o0[2], o0[3]); w.z = pk2(o1[0], o1[1]); w.w = pk2(o1[2], o1[3]); *(u32x4*)(Ob + (size_t)row * DM + col0 + bj * 128) = w; }
                    else { float* op = Of + (size_t)row * DM + col0 + bj * 128; __builtin_nontemporal_store(o0, (f32x4*)op); __builtin_nontemporal_store(o1, (f32x4*)(op + 4)); }
                }
        }
    }
};
template <int CTRL> __device__ __forceinline__ float dpp_f(float x);
template <int CTRL> __device__ __forceinline__ float dpp_fo(float old, float x) { return __int_as_float(__builtin_amdgcn_update_dpp(__float_as_int(old), __float_as_int(x), CTRL, 0xf, 0xf, false)); }
struct EpiG {
    static constexpr bool PERM = true, AFTER_DRAIN = false, REALIGN = false;
    unsigned char* ws; const float* cw;
    __device__ __forceinline__ void operator()(const f32x4 (&acc)[2][2][4][2], const pg8::Unit& u, int wr, int wc, int fr, int fq) const {
        unsigned char* w2 = ws; asm volatile("" : "+s"(w2));
        bf16_t* G = (bf16_t*)(w2 + WS_XB); float* Pb = (float*)(w2 + WS_PB); float* Sb = (float*)(w2 + WS_SB);
        const int ch0 = u.pn * 64 + 16 * wc + 4 * fq;
        const f32x4 c0 = *(const f32x4*)(cw + ch0), c1 = *(const f32x4*)(cw + 1024 + ch0), c2 = *(const f32x4*)(cw + 2048 + ch0);
#pragma unroll
        for (int ai = 0; ai < 2; ++ai) {
            f32x4 P[4], S[4];
#pragma unroll
            for (int m = 0; m < 4; ++m)
#pragma unroll
                for (int j = 0; j < 4; ++j) { P[m][j] = acc[ai][0][m][1][j] * acc[ai][1][m][1][j]; S[m][j] = silu(acc[ai][1][m][0][j]) * acc[ai][0][m][0][j]; }
            const int row0 = u.pm * 256 + ai * 128 + wr * 64 + fr;
#pragma unroll
            for (int m = 0; m < 4; ++m) {
                float o[4];
#pragma unroll
                for (int j = 0; j < 4; ++j) {
                    const float pr = m > 0 ? dpp_fo<0x111>(dpp_f<0x121>(P[m - 1][j]), P[m][j]) : dpp_f<0x111>(P[m][j]);
                    const float nx = m < 3 ? dpp_fo<0x101>(dpp_f<0x12F>(P[m + 1][j]), P[m][j]) : dpp_f<0x101>(P[m][j]);
                    o[j] = S[m][j] * (c0[j] * pr + c1[j] * P[m][j] + c2[j] * nx);
                }
                u32x2 w; w.x = pk2(o[0], o[1]); w.y = pk2(o[2], o[3]);
                *(u32x2*)(G + (size_t)(row0 + 16 * m) * DM + ch0) = w;
            }
            const int blk = u.pm * 4 + ai * 2 + wr;
            if (fr == 0) { *(f32x4*)(Pb + (size_t)(blk * 2) * 1024 + ch0) = P[0]; *(f32x4*)(Sb + (size_t)(blk * 2) * 1024 + ch0) = S[0]; }
            if (fr == 15) { *(f32x4*)(Pb + (size_t)(blk * 2 + 1) * 1024 + ch0) = P[3]; *(f32x4*)(Sb + (size_t)(blk * 2 + 1) * 1024 + ch0) = S[3]; }
        }
    }
};
#define XB_TMO      128
#define XB_XCNT(j)  (256  + 64 * (j))
#define XB_XSUB(j)  (1280 + 64 * (j))
#define XB_XGEN(j)  (2304 + 64 * (j))
#define XB_TOP      3328
#define XB_TOPGEN   3392
#define XCD_BAR_WORDS 3456
#define XB_SPIN_CAP (1u << 27)
__device__ __forceinline__ unsigned xb_ld(unsigned* p)              { return __hip_atomic_load(p, __ATOMIC_RELAXED, __HIP_MEMORY_SCOPE_AGENT); }
__device__ __forceinline__ unsigned xb_add(unsigned* p, unsigned v) { return __hip_atomic_fetch_add(p, v, __ATOMIC_RELAXED, __HIP_MEMORY_SCOPE_AGENT); }
__device__ __forceinline__ unsigned xb_xcc_id() { return (unsigned)__builtin_amdgcn_s_getreg((3 << 11) | 20) & 0xFu; }
#define XB_SPIN(cond, bar) do { unsigned _sp = 0; while (cond) { __builtin_amdgcn_s_sleep(1); \
    if ((++_sp & 255u) == 0u) { if (xb_ld(&(bar)[XB_TMO])) break; if (_sp > XB_SPIN_CAP) { atomicAdd(&(bar)[XB_TMO], 1u); break; } } } } while (0)
struct XcdBarrier { unsigned* bar; unsigned x; volatile LAS unsigned* st; };
__device__ __forceinline__ XcdBarrier xcd_barrier_post(unsigned* bar, volatile LAS unsigned* st) {
    XcdBarrier b; b.bar = bar; b.x = xb_xcc_id(); b.st = st;
    if (tid_now() == 0) (void)xb_add(&bar[XB_XCNT(b.x)], 1u);
    return b;
}
__device__ __forceinline__ void xcd_barrier_complete(unsigned* bar, unsigned x, unsigned& nloc, unsigned& nx) {
    const unsigned G = gridDim.x * gridDim.y * gridDim.z;
    unsigned sum, cnt, mine, sp = 0u;
    for (;;) {
        sum = 0u; cnt = 0u; mine = 0u;
#pragma unroll
        for (unsigned j = 0; j < 16; ++j) { const unsigned c = xb_ld(&bar[XB_XCNT(j)]); sum += c; cnt += (c > 0u) ? 1u : 0u; mine = (j == x) ? c : mine; }
        if (sum == G) break;
        __builtin_amdgcn_s_sleep(1);
        if ((++sp & 255u) == 0u) { if (xb_ld(&bar[XB_TMO])) break; if (sp > XB_SPIN_CAP) { atomicAdd(&bar[XB_TMO], 1u); break; } }
    }
    nloc = mine > 0u ? mine : 1u; nx = cnt > 0u ? cnt : 1u;
}
__device__ __forceinline__ void xcd_barrier(const XcdBarrier& b) {
    asm volatile("s_waitcnt vmcnt(0)" ::: "memory");
    __syncthreads();
    if (tid_now() == 0) {
        unsigned* bar = b.bar;
        __builtin_amdgcn_s_waitcnt(0);
        unsigned nloc = b.st[0], nx = b.st[1];
        if (nloc == 0u) { xcd_barrier_complete(bar, b.x, nloc, nx); b.st[0] = nloc; b.st[1] = nx; }
        const unsigned old = xb_add(&bar[XB_XSUB(b.x)], 1u);
        const unsigned gen = old / nloc;
        if (old + 1u == (gen + 1u) * nloc) {
            __builtin_amdgcn_fence(__ATOMIC_RELEASE, "agent");
            asm volatile("s_waitcnt vmcnt(0)" ::: "memory");
            const unsigned og = xb_add(&bar[XB_TOP], 1u);
            const unsigned tg = og / nx;
            if (og + 1u == (tg + 1u) * nx) xb_add(&bar[XB_TOPGEN], 1u);
            else XB_SPIN(xb_ld(&bar[XB_TOPGEN]) == tg, bar);
            __builtin_amdgcn_fence(__ATOMIC_ACQUIRE, "agent");
            xb_add(&bar[XB_XGEN(b.x)], 1u);
            asm volatile("s_waitcnt vmcnt(0)" ::: "memory");
        } else {
            XB_SPIN(xb_ld(&bar[XB_XGEN(b.x)]) == gen, bar);
            __builtin_amdgcn_fence(__ATOMIC_ACQUIRE, "agent");
            asm volatile("s_waitcnt vmcnt(0)" ::: "memory");
        }
    }
    __syncthreads();
}

struct Args {
    const float *xp, *xs, *w_in_even, *wuf, *bfw, *wub, *bbw, *ng, *sink, *relb, *w_out_even, *w_in_odd, *cw, *w_out_odd, *lng, *lnb;
    float* out; unsigned char* ws;
};
constexpr int NTHR = 512;
constexpr int LDS_BYTES = 163840, MISC_OFF = 163840 - 512;

template <int MODE> __device__ __forceinline__ int wmap(int n, float& sc) {
    sc = 1.f;
    if (MODE == 0) return n;
    if (MODE == 1) {
        if (n < 512) sc = 0.08838834764831845f;
        if (n >= C_QB && n < C_KB) sc = 0.125f;
        if (n < 2048) return n;
        if (n < C_GD) return n + 32;
        if (n < C_GD + 32) return n - C_GD + 2048;
        return -1;
    }
    const int c = n & 255, bj = (c >> 7) & 1, wc = (c >> 5) & 3, fq = (c >> 3) & 3, nn = (c >> 2) & 1, j = c & 3, q = 2 * bj + nn, ch = (n >> 8) * 64 + 16 * wc + 4 * fq + j;
    const int base = q == 0 ? 0 : (q == 1 ? 1024 : (q == 2 ? 3072 : 2048));
    return base + ch;
}
template <int MODE> __device__ __forceinline__ void p0_w_item(const float* __restrict__ W, int Nsrc, bf16_t* __restrict__ Wt, int Ndst, int item, LAS float* scr, int lane) {
    const int nblk = Ndst / 32, kb = item / nblk, nb = item - kb * nblk, k0 = 64 * kb, n0 = 32 * nb;
    float sc; const int src = wmap<MODE>(n0 + (lane & 31), sc);
#pragma unroll 8
    for (int i = 0; i < 32; ++i) { const int kk = 2 * i + (lane >> 5); scr[kk * 33 + (lane & 31)] = src >= 0 ? W[(size_t)(k0 + kk) * Nsrc + src] * sc : 0.f; }
    asm volatile("s_waitcnt lgkmcnt(0)" ::: "memory");
    const int c = lane & 7;
#pragma unroll
    for (int jj = 0; jj < 4; ++jj) { const int n = (lane >> 3) + 8 * jj; const LAS float* sp = scr + (8 * c) * 33 + n;
        u32x4 o; o.x = pk2(sp[0 * 33], sp[1 * 33]); o.y = pk2(sp[2 * 33], sp[3 * 33]); o.z = pk2(sp[4 * 33], sp[5 * 33]); o.w = pk2(sp[6 * 33], sp[7 * 33]);
        *(u32x4*)(Wt + (size_t)(n0 + n) * 1024 + k0 + 8 * c) = o; }
    asm volatile("s_waitcnt lgkmcnt(0)" ::: "memory");
}
__device__ __forceinline__ void build_gate_tables(const Args& a);
__device__ __forceinline__ void phase_convert(const Args& a, LAS unsigned char* lds) {
    unsigned char* ws = a.ws;
    bf16_t* W1t = (bf16_t*)(ws + WS_W1T); bf16_t* W2t = (bf16_t*)(ws + WS_W2T); bf16_t* W3t = (bf16_t*)(ws + WS_W3T); bf16_t* W4t = (bf16_t*)(ws + WS_W4T);
    {
        const int tidw = tid_now(), lanew = tidw & 63, ww = tidw >> 6;
        LAS float* scr = (LAS float*)(lds + ww * 8448);
        constexpr int I1 = 16 * (C_GD / 32), I2 = 16 * 32, I3 = 16 * 128, I4 = 16 * 32, NW = I1 + I2 + I3 + I4;
        for (int wi = blockIdx.x * 8 + ww; wi < NW; wi += gridDim.x * 8) {
            int r = wi;
            if (r < I1) p0_w_item<1>(a.w_in_even, EVEN_IN, W1t, C_GD, r, scr, lanew);
            else if ((r -= I1) < I2) p0_w_item<0>(a.w_out_even, 1024, W2t, 1024, r, scr, lanew);
            else if ((r -= I2) < I3) p0_w_item<2>(a.w_in_odd, ODD_IN, W3t, 4096, r, scr, lanew);
            else p0_w_item<0>(a.w_out_odd, 1024, W4t, 1024, r - I3, scr, lanew);
        }
    }
    build_gate_tables(a);
    __syncthreads();
    {
        constexpr int WP = 1032, TP = 264;
        LAS bf16_t* wg = (LAS bf16_t*)lds; LAS bf16_t* tile0 = (LAS bf16_t*)(lds + 32 * WP * 2);
        const int tid = tid_now(), lane = tid & 63, w = tid >> 6, n = lane & 15, g = lane >> 4, rb = w & 3, ct = w >> 2;
        for (int e = tid; e < 32 * 1024; e += NTHR) { const int k = e >> 5, c = e & 31; wg[c * WP + k] = f2bf(a.w_in_even[(size_t)k * EVEN_IN + 2048 + c]); }
        bf16_t* xb = (bf16_t*)(ws + WS_XB); bf16_t* U = (bf16_t*)(ws + WS_U);
        f32x4 v[4][2];
        auto slab_load = [&](int it, int sl) {
#pragma unroll
            for (int i = 0; i < 4; ++i) { const int idx = tid + 512 * i, row = it * 64 + (idx >> 5), col = sl * 256 + 8 * (idx & 31);
                const float* src = (row < NPROMPT ? a.xp + (size_t)row * DM : a.xs + (size_t)(row - NPROMPT) * DM) + col;
                v[i][0] = __builtin_nontemporal_load((const f32x4*)src); v[i][1] = __builtin_nontemporal_load((const f32x4*)(src + 4)); } };
        const int ntrip = NTOK / 64;
        if ((int)blockIdx.x < ntrip) slab_load(blockIdx.x, 0);
        int par = 0;
        for (int it = blockIdx.x; it < ntrip; it += gridDim.x) {
            f32x4 acc = (f32x4){0.f, 0.f, 0.f, 0.f};
#pragma unroll 1
            for (int sl = 0; sl < 4; ++sl) {
                LAS bf16_t* tile = tile0 + par * (64 * TP);
#pragma unroll
                for (int i = 0; i < 4; ++i) { const int idx = tid + 512 * i, r64 = idx >> 5, c8 = idx & 31;
                    u32x4 pw; pw.x = pk2(v[i][0][0], v[i][0][1]); pw.y = pk2(v[i][0][2], v[i][0][3]); pw.z = pk2(v[i][1][0], v[i][1][1]); pw.w = pk2(v[i][1][2], v[i][1][3]);
                    *(u32x4*)(xb + (size_t)(it * 64 + r64) * DM + sl * 256 + 8 * c8) = pw;
                    *(LAS u32x4*)(tile + r64 * TP + 8 * c8) = pw; }
                { const int nsl = (sl + 1) & 3, nit = sl < 3 ? it : (it + (int)gridDim.x < ntrip ? it + (int)gridDim.x : it); slab_load(nit, nsl); }
                __syncthreads();
#pragma unroll
                for (int ks = 0; ks < 8; ++ks) {
                    const bf16x8 af = *(const LAS bf16x8*)(tile + (16 * rb + n) * TP + 32 * ks + 8 * g), bfr = *(const LAS bf16x8*)(wg + (16 * ct + n) * WP + sl * 256 + 32 * ks + 8 * g);
                    acc = MFMA16(af, bfr, acc);
                }
                par ^= 1;
            }
#pragma unroll
            for (int r = 0; r < 4; ++r) U[(size_t)(it * 64 + rb * 16 + 4 * g + r) * UP + C_GD + 16 * ct + n] = f2bf(acc[r]);
        }
        __syncthreads();
    }
}

__device__ __forceinline__ int t5_bucket(int rel) {
    const int n = rel < 0 ? -rel : rel;
    int b = n < 8 ? n : (n < 12 ? 8 : (n < 16 ? 9 : (n < 23 ? 10 : (n < 32 ? 11 : (n < 46 ? 12 : (n < 64 ? 13 : (n < 91 ? 14 : 15)))))));
    return b + (rel > 0 ? 16 : 0);
}
typedef short s16x4 __attribute__((ext_vector_type(4)));
constexpr int GL_QT = 0, GL_KT = 16384, GL_VT = 32768, GL_PT = 49152, GL_B = 57344, GL_GD = 90112, GL_TOT = 94208, GL_EBL = 96256  , GL_SSW = 97280, GL_RSTD = 99328;
constexpr int NSEG = NTOK / 256;
__device__ __forceinline__ unsigned offb(unsigned row, unsigned ch) { return 256u * row + 16u * (ch ^ (((row & 3) << 2) | ((row >> 2) & 3))); }
__device__ __forceinline__ unsigned offp(unsigned row, unsigned ch) { return 128u * row + 16u * (ch ^ (row & 7)); }
__device__ __forceinline__ unsigned rr16(unsigned lane, unsigned rb, unsigned s) { return offb((lane & 15) + 16 * rb, 4 * s + (lane >> 4)); }
__device__ __forceinline__ unsigned tr16(unsigned lane, unsigned c, unsigned ks, unsigned t) {
    const unsigned g = lane >> 4, q = (lane & 15) >> 2, p = lane & 3;
    return offb(32 * ks + 8 * g + 4 * t + q, 2 * c + (p >> 1)) + 8 * (p & 1);
}
__device__ __forceinline__ void unpack8(const u32x4 w, float (&f)[8]) {
#pragma unroll
    for (int j = 0; j < 4; ++j) { f[2 * j] = __uint_as_float(w[j] << 16); f[2 * j + 1] = __uint_as_float(w[j] & 0xffff0000u); }
}

struct GlaPre { u32x4 gd[4]; u32x4 q[2], k[2], v[2]; u32x4 wf; float wb; };
template <int MODE>
__device__ __forceinline__ void gla_prefetch(const Args& a, GlaPre& pre, int tid, int tb, int h, int dir, int stidx) {
    const bf16_t* U = (const bf16_t*)(a.ws + WS_U);
    const int lane = tid & 63, n = lane & 15, g = lane >> 4, w = tid >> 6;
#pragma unroll
    for (int it = 0; it < 4; ++it) { const int row = 16 * it + n, tok = dir ? tb + 63 - row : tb + row; pre.gd[it] = *(const u32x4*)(U + (size_t)tok * UP + C_GD + dir * 16 + 8 * (g & 1)); }
#pragma unroll
    for (int i = 0; i < 2; ++i) {
        const int idx = tid + 512 * i, row = idx >> 4, ch = idx & 15, tok = dir ? tb + 63 - row : tb + row;
        const bf16_t* ur = U + (size_t)tok * UP + h * 128 + ch * 8;
        pre.v[i] = *(const u32x4*)(ur + C_VA); pre.k[i] = *(const u32x4*)(ur + C_KA);
        if (MODE != 0) pre.q[i] = *(const u32x4*)(ur + C_QA);
    }
    pre.wf = ((const u32x4*)(a.ws + WS_GATE))[(dir * 4 + h) * 512 + tid];
    pre.wb = ((const float*)(a.ws + WS_GATE + 65536))[(dir * 4 + h) * 128 + 16 * w + n];
}
__device__ __forceinline__ bf16x8 tr_read8(LAS unsigned char* lds, unsigned a0, unsigned a1) {
    const s16x4 r0 = __builtin_amdgcn_ds_read_tr16_b64_v4i16((LAS s16x4*)(lds + a0)), r1 = __builtin_amdgcn_ds_read_tr16_b64_v4i16((LAS s16x4*)(lds + a1));
    return __builtin_shufflevector(r0, r1, 0, 1, 2, 3, 4, 5, 6, 7);
}
template <int CTRL> __device__ __forceinline__ float dpp_f(float x) { return __int_as_float(__builtin_amdgcn_update_dpp(0, __float_as_int(x), CTRL, 0xf, 0xf, true)); }
constexpr int GL_BP = 132;
__device__ __forceinline__ float gla_a1(LAS unsigned char* lds, const GlaPre& cur, const int w, const int n, const int g, const int par, const int OFFB = GL_B, const int OFFE = GL_EBL) {
    const bf16x8 wfrag = __builtin_bit_cast(bf16x8, cur.wf); const float wbias = cur.wb;
    float tot = 0.f;
    {
        LAS float* B = (LAS float*)(lds + OFFB);
        bf16x8 vh[2], vl[2];
#pragma unroll
        for (int ks = 0; ks < 2; ++ks) {
            float vv[8];
#pragma unroll
            for (int half = 0; half < 2; ++half) {
                const f32x4 x = MFMA16(__builtin_bit_cast(bf16x8, cur.gd[2 * ks + half]), wfrag, ((f32x4){wbias, wbias, wbias, wbias}));
#pragma unroll
                for (int r = 0; r < 4; ++r) { const float xs = x[r] * 1.4426950408889634f; vv[4 * half + r] = (fminf(xs, 0.f) - flog2(1.0f + fexp2(-fabsf(xs)))) * (1.0f / 16.0f); }
            }
            u32x4 hw, lw;
#pragma unroll
            for (int q = 0; q < 4; ++q) { const unsigned hp = pk2(vv[2 * q], vv[2 * q + 1]); hw[q] = hp;
                lw[q] = pk2(vv[2 * q] - __uint_as_float(hp << 16), vv[2 * q + 1] - __uint_as_float(hp & 0xffff0000u)); }
            vh[ks] = __builtin_bit_cast(bf16x8, hw); vl[ks] = __builtin_bit_cast(bf16x8, lw);
        }
        u32x4 ta, tbm;
#pragma unroll
        for (int q = 0; q < 2; ++q) { const unsigned lo = (4 * g + 2 * q <= n) ? 0x3f80u : 0u, hi = (4 * g + 2 * q + 1 <= n) ? 0x3f800000u : 0u; ta[q] = lo | hi; ta[2 + q] = 0u; tbm[q] = 0x3f803f80u; tbm[2 + q] = lo | hi; }
        const bf16x8 TA = __builtin_bit_cast(bf16x8, ta), TB = __builtin_bit_cast(bf16x8, tbm), ONES = __builtin_bit_cast(bf16x8, ((u32x4){0x3f803f80u, 0x3f803f80u, 0x3f803f80u, 0x3f803f80u}));
        const f32x4 z4 = (f32x4){0.f, 0.f, 0.f, 0.f};
        f32x4 bt[4];
        bt[0] = MFMA16(TA, vl[0], MFMA16(TA, vh[0], z4));
        bt[1] = MFMA16(TB, vl[0], MFMA16(TB, vh[0], z4));
        const f32x4 s32 = MFMA16(ONES, vl[0], MFMA16(ONES, vh[0], z4));
        bt[2] = MFMA16(TA, vl[1], MFMA16(TA, vh[1], s32));
        bt[3] = MFMA16(TB, vl[1], MFMA16(TB, vh[1], s32));
#pragma unroll
        for (int it = 0; it < 4; ++it)
#pragma unroll
            for (int r = 0; r < 4; ++r) B[(16 * it + 4 * g + r) * GL_BP + 16 * w + n] = bt[it][r];
        if (g == 3) { ((LAS float*)(lds + OFFE + par * 512))[16 * w + n] = fexp2(bt[3][3]); tot = bt[3][3]; }
    }
    return tot;
}
template <int MODE>
__device__ __forceinline__ void gla_chunk(const Args& a, LAS unsigned char* lds, const int tb, const int h, const int dir,
                                          f32x4 (&Sacc)[8], float& ntot, u32x4* stash, GlaPre& pre, const GlaPre& nxt, const int ntb, const int nh, const int ndir, const bool first, const int par) {
    const bf16_t* U = (const bf16_t*)(a.ws + WS_U);
    int tid = tid_now(); asm volatile("" : "+v"(tid));
    const int lane = tid & 63, w = __builtin_amdgcn_readfirstlane(tid >> 6), n = lane & 15, g = lane >> 4;
    const unsigned fn = ((n & 3) << 2) | ((n >> 2) & 3);
    const unsigned base_rr = 256u * n + 16u * (g ^ fn);
    const unsigned base_c = 256u * n + 16u * ((g >> 1) ^ fn) + 8u * (g & 1);
    const unsigned base_p = 128u * n + 16u * (g ^ (n & 7));
    const unsigned trb0 = tr16(lane, 0, 0, 0), trb1 = tr16(lane, 0, 0, 1);
    GlaPre& cur = pre;
    int prow[2], pch[2], ptok[2];
#pragma unroll
    for (int i = 0; i < 2; ++i) { const int idx = tid + 512 * i; prow[i] = idx >> 4; pch[i] = idx & 15; ptok[i] = dir ? tb + 63 - prow[i] : tb + prow[i]; }
    u32x4 st0, st1, zraw[2];
    __syncthreads();
#pragma unroll
    for (int i = 0; i < 2; ++i) {
        const LAS f32x4* bp = (const LAS f32x4*)(lds + GL_B + (prow[i] * GL_BP + pch[i] * 8) * 4);
        const f32x4 b0 = bp[0], b1 = bp[1];
        float e[8], kf[8];
#pragma unroll
        for (int j = 0; j < 4; ++j) { e[j] = fexp2(b0[j]); e[4 + j] = fexp2(b1[j]); }
        unpack8(cur.k[i], kf);
        u32x4 kw;
#pragma unroll
        for (int j = 0; j < 4; ++j) kw[j] = pk2(kf[2 * j] * __builtin_amdgcn_rcpf(e[2 * j]), kf[2 * j + 1] * __builtin_amdgcn_rcpf(e[2 * j + 1]));
        *(LAS u32x4*)(lds + GL_KT + offb(prow[i], pch[i])) = kw;
        *(LAS u32x4*)(lds + GL_VT + offb(prow[i], pch[i])) = cur.v[i];
        if (MODE != 0) {
            float qf[8]; unpack8(cur.q[i], qf);
            u32x4 qw;
#pragma unroll
            for (int j = 0; j < 4; ++j) qw[j] = pk2(qf[2 * j] * e[2 * j], qf[2 * j + 1] * e[2 * j + 1]);
            *(LAS u32x4*)(lds + GL_QT + offb(prow[i], pch[i])) = qw;
        }
    }
    __syncthreads();
    gla_prefetch<MODE>(a, pre, tid, ntb, nh, ndir, -1);
    f32x4 Oacc[4];
    if (MODE != 0) {
        const int it = w >> 1;
#pragma unroll
        for (int jj = 0; jj < 2; ++jj) {
            const int jt = 2 * (w & 1) + jj;
            f32x4 pacc = (f32x4){0.f, 0.f, 0.f, 0.f};
            if (jt <= it) {
#pragma unroll
                for (int s = 0; s < 4; ++s) {
                    const bf16x8 qa = *(const LAS bf16x8*)(lds + GL_QT + (base_rr ^ (64u * s)) + 4096u * it);
                    const bf16x8 kb = *(const LAS bf16x8*)(lds + GL_KT + (base_rr ^ (64u * s)) + 4096u * jt); pacc = MFMA16(kb, qa, pacc); }
            }
            const int i = 16 * it + n, j0 = 16 * jt + 4 * g;
            float pv[4];
#pragma unroll
            for (int r = 0; r < 4; ++r) { const bool keep = (MODE == 1) ? (j0 + r <= i) : (j0 + r < i); pv[r] = keep ? pacc[r] : 0.f; }
            u32x2 pw; pw.x = pk2(pv[0], pv[1]); pw.y = pk2(pv[2], pv[3]);
            *(LAS u32x2*)(lds + GL_PT + offp(i, 2 * jt + (g >> 1)) + 8 * (g & 1)) = pw;

        }
        if (first) {
#pragma unroll
            for (int kt = 0; kt < 8; ++kt) { const unsigned r0 = __float_as_uint(Sacc[kt][0]), r1 = __float_as_uint(Sacc[kt][1]);
                Sacc[kt] = (f32x4){__uint_as_float(r0 << 16), __uint_as_float(r0 & 0xffff0000u), __uint_as_float(r1 << 16), __uint_as_float(r1 & 0xffff0000u)}; }
        }
#pragma unroll
        for (int i2 = 0; i2 < 4; ++i2) Oacc[i2] = (f32x4){0.f, 0.f, 0.f, 0.f};
#pragma unroll
        for (int ks = 0; ks < 4; ++ks) {
            u32x4 pw; pw.x = pk2(Sacc[2 * ks][0], Sacc[2 * ks][1]); pw.y = pk2(Sacc[2 * ks][2], Sacc[2 * ks][3]); pw.z = pk2(Sacc[2 * ks + 1][0], Sacc[2 * ks + 1][1]); pw.w = pk2(Sacc[2 * ks + 1][2], Sacc[2 * ks + 1][3]);
            const bf16x8 sb = __builtin_bit_cast(bf16x8, pw);
            const unsigned alo = base_c ^ (64u * ks);
#pragma unroll
            for (int i2 = 0; i2 < 4; ++i2) {
                const u32x2 lo = *(const LAS u32x2*)(lds + GL_QT + 4096 * i2 + alo);
                const u32x2 hi = *(const LAS u32x2*)(lds + GL_QT + 4096 * i2 + (alo ^ 32u));
                u32x4 aw; aw.x = lo.x; aw.y = lo.y; aw.z = hi.x; aw.w = hi.y;
                Oacc[i2] = MFMA16(__builtin_bit_cast(bf16x8, aw), sb, Oacc[i2]);
            }

        }
        __syncthreads();
        if (MODE == 2) {
            st0 = stash[tid * 2]; st1 = stash[tid * 2 + 1];
#pragma unroll
            for (int i = 0; i < 2; ++i) zraw[i] = *(const u32x4*)(U + (size_t)ptok[i] * UP + C_ZA + h * 128 + pch[i] * 8);
        }
    }
    bf16x8 vf[2];
#pragma unroll
    for (int ks = 0; ks < 2; ++ks) vf[ks] = tr_read8(lds, GL_VT + 8192u * ks + (trb0 ^ (32u * w)), GL_VT + 8192u * ks + (trb1 ^ (32u * w)));
    if (MODE != 0) {
#pragma unroll
        for (int i2 = 0; i2 < 4; ++i2)
#pragma unroll
            for (int ks = 0; ks < 2; ++ks) {
                if (ks <= (i2 >> 1)) { const bf16x8 pa = *(const LAS bf16x8*)(lds + GL_PT + 2048 * i2 + (base_p ^ (64u * ks))); Oacc[i2] = MFMA16(pa, vf[ks], Oacc[i2]); }
            }
    }
#pragma unroll
    for (int kt = 0; kt < 8; ++kt) {
#pragma unroll
        for (int ks = 0; ks < 2; ++ks) { const bf16x8 ka = tr_read8(lds, GL_KT + 8192u * ks + (trb0 ^ (32u * kt)), GL_KT + 8192u * ks + (trb1 ^ (32u * kt))); Sacc[kt] = MFMA16(ka, vf[ks], Sacc[kt]); }
        const f32x4 eb = *(const LAS f32x4*)(lds + GL_EBL + par * 512 + (16 * kt + 4 * g) * 4);
        Sacc[kt] = Sacc[kt] * eb;
        if (kt & 1) __builtin_amdgcn_sched_barrier(0);
    }
    ntot = gla_a1(lds, nxt, w, n, g, par ^ 1);
    if (MODE == 1) {
        u32x4 s0, s1;
        s0.x = pk2(Oacc[3][3], Oacc[3][2]); s0.y = pk2(Oacc[3][1], Oacc[3][0]); s0.z = pk2(Oacc[2][3], Oacc[2][2]); s0.w = pk2(Oacc[2][1], Oacc[2][0]);
        s1.x = pk2(Oacc[1][3], Oacc[1][2]); s1.y = pk2(Oacc[1][1], Oacc[1][0]); s1.z = pk2(Oacc[0][3], Oacc[0][2]); s1.w = pk2(Oacc[0][1], Oacc[0][0]);
        const int tidm = tid ^ 48;
        stash[tidm * 2] = s0; stash[tidm * 2 + 1] = s1;
    }
    if (MODE == 2) {
        float fo[16]; { float t8[8]; unpack8(st0, t8);
#pragma unroll
            for (int j = 0; j < 8; ++j) fo[j] = t8[j]; unpack8(st1, t8);
#pragma unroll
            for (int j = 0; j < 8; ++j) fo[8 + j] = t8[j]; }
        LAS float* ssw = (LAS float*)(lds + GL_SSW);
        const float gn = a.ng[16 * w + n];
#pragma unroll
        for (int i2 = 0; i2 < 4; ++i2)
#pragma unroll
            for (int r = 0; r < 4; ++r) {
                const float o = Oacc[i2][r] + fo[4 * i2 + r];
                float v = o * o; v += dpp_f<0x128>(v); v += dpp_f<0x124>(v); v += dpp_f<0x122>(v); v += dpp_f<0x121>(v);
                if (n == 0) ssw[(16 * i2 + 4 * g + r) * 8 + w] = v;
                *(LAS bf16_t*)(lds + GL_QT + (16 * i2 + 4 * g + r) * 256 + (16 * w + n) * 2) = f2bf(o * gn);
            }
        __syncthreads();
        bf16_t* ymix = (bf16_t*)((unsigned char*)a.out + 96 * MiB);
#pragma unroll
        for (int i = 0; i < 2; ++i) {
            const f32x4 p0 = *(const LAS f32x4*)(ssw + prow[i] * 8), p1 = *(const LAS f32x4*)(ssw + prow[i] * 8 + 4);
            const float rs = rsqrtf((((p0[0] + p0[1]) + (p0[2] + p0[3])) + ((p1[0] + p1[1]) + (p1[2] + p1[3]))) * (1.0f / 128.0f) + NORM_EPS);
            const u32x4 ov = *(const LAS u32x4*)(lds + GL_QT + prow[i] * 256 + pch[i] * 16);
            float of[8], zf[8]; unpack8(ov, of); unpack8(zraw[i], zf);
            u32x4 yw;
#pragma unroll
            for (int j = 0; j < 4; ++j) yw[j] = pk2(of[2 * j] * rs * silu(zf[2 * j]), of[2 * j + 1] * rs * silu(zf[2 * j + 1]));
            *(u32x4*)(ymix + (size_t)ptok[i] * DM + h * 128 + pch[i] * 8) = yw;
        }
    }
}
__device__ __forceinline__ void build_gate_tables(const Args& a) {
    for (int e = blockIdx.x * NTHR + tid_now(); e < 8 * 512; e += gridDim.x * NTHR) {
        const int dh = e >> 9, tid = e & 511, dir = dh >> 2, h = dh & 3, lane = tid & 63, w = tid >> 6, n = lane & 15, g = lane >> 4, col = h * 128 + 16 * w + n;
        const float* wup = dir ? a.wub : a.wuf; const float* bias = dir ? a.bbw : a.bfw;
        u32x4 pw;
#pragma unroll
        for (int j = 0; j < 4; ++j) {
            const float v0 = wup[(8 * (g & 1) + 2 * j) * 512 + col], v1 = wup[(8 * (g & 1) + 2 * j + 1) * 512 + col];
            const float h0 = bf2f(f2bf(v0)), h1 = bf2f(f2bf(v1));
            pw[j] = g < 2 ? pk2(v0, v1) : pk2(v0 - h0, v1 - h1);
        }
        ((u32x4*)(a.ws + WS_GATE))[e] = pw;
        if (g == 0) ((float*)(a.ws + WS_GATE + 65536))[dh * 128 + 16 * w + n] = bias[col];
    }
}
constexpr int Q1_KF = 0, Q1_KB = 32768, Q1_V = 65536, Q1_EBL = 98304;
struct Q1Pre { u32x4 gf[4], gb[4], wff, wfb; float wbf, wbb; u32x2 k[4]; u32x4 v[2]; };
__device__ __forceinline__ void q1_params(int st, int nst, int& tb, int& h, int& item) {
    if (st >= nst) st = nst - 1;
    item = blockIdx.x + (st >> 2) * gridDim.x; h = item & 3; tb = (item >> 2) * 256 + (st & 3) * 64;
}
__device__ __forceinline__ void q1_prefetch_gd(const Args& a, Q1Pre& pre, int tid, int tb, int h) {
    const bf16_t* U = (const bf16_t*)(a.ws + WS_U);
    const int lane = tid & 63, n = lane & 15, g = lane >> 4, w = tid >> 6;
#pragma unroll
    for (int it = 0; it < 4; ++it) { const bf16_t* ur = U + (size_t)(tb + 16 * it + n) * UP + C_GD + 8 * (g & 1); pre.gf[it] = *(const u32x4*)ur; pre.gb[it] = *(const u32x4*)(ur + 16); }
    pre.wff = ((const u32x4*)(a.ws + WS_GATE))[h * 512 + tid]; pre.wfb = ((const u32x4*)(a.ws + WS_GATE))[(4 + h) * 512 + tid];
    pre.wbf = ((const float*)(a.ws + WS_GATE + 65536))[h * 128 + 16 * w + n]; pre.wbb = ((const float*)(a.ws + WS_GATE + 65536))[(4 + h) * 128 + 16 * w + n];
}
__device__ __forceinline__ void q1_prefetch_k(const Args& a, Q1Pre& pre, int tid, int tb, int h) {
    const bf16_t* U = (const bf16_t*)(a.ws + WS_U);
    const int lane = tid & 63, n = lane & 15, g = lane >> 4, w = tid >> 6;
#pragma unroll
    for (int it = 0; it < 4; ++it) pre.k[it] = *(const u32x2*)(U + (size_t)(tb + 16 * it + n) * UP + C_KA + h * 128 + 16 * w + 4 * g);
}
__device__ __forceinline__ void q1_prefetch_v(const Args& a, Q1Pre& pre, int tid, int tb, int h) {
    const bf16_t* U = (const bf16_t*)(a.ws + WS_U);
#pragma unroll
    for (int i = 0; i < 2; ++i) { const int idx = tid + 512 * i, row = idx >> 4, ch = idx & 15; pre.v[i] = *(const u32x4*)(U + (size_t)(tb + row) * UP + C_VA + h * 128 + ch * 8); }
}
template <bool EXCL>
__device__ __forceinline__ void q1_gate(const u32x4 (&gd)[4], const u32x4 wf, const float wbias, const f32x4 init, const int n, const int g, f32x4 (&bt)[4], f32x4& s64) {
    const bf16x8 wfrag = __builtin_bit_cast(bf16x8, wf);
    bf16x8 vh[2], vl[2];
#pragma unroll
    for (int ks = 0; ks < 2; ++ks) {
        float vv[8];
#pragma unroll
        for (int half = 0; half < 2; ++half) {
            const f32x4 x = MFMA16(__builtin_bit_cast(bf16x8, gd[2 * ks + half]), wfrag, ((f32x4){wbias, wbias, wbias, wbias}));
#pragma unroll
            for (int r = 0; r < 4; ++r) { const float xs = x[r] * 1.4426950408889634f; vv[4 * half + r] = (fminf(xs, 0.f) - flog2(1.0f + fexp2(-fabsf(xs)))) * (1.0f / 16.0f); }
        }
        u32x4 hw, lw;
#pragma unroll
        for (int q = 0; q < 4; ++q) { const unsigned hp = pk2(vv[2 * q], vv[2 * q + 1]); hw[q] = hp;
            lw[q] = pk2(vv[2 * q] - __uint_as_float(hp << 16), vv[2 * q + 1] - __uint_as_float(hp & 0xffff0000u)); }
        vh[ks] = __builtin_bit_cast(bf16x8, hw); vl[ks] = __builtin_bit_cast(bf16x8, lw);
    }
    u32x4 ta, tbm;
#pragma unroll
    for (int q = 0; q < 2; ++q) {
        const bool c0 = EXCL ? (4 * g + 2 * q < n) : (4 * g + 2 * q <= n), c1 = EXCL ? (4 * g + 2 * q + 1 < n) : (4 * g + 2 * q + 1 <= n);
        const unsigned lo = c0 ? 0x3f80u : 0u, hi = c1 ? 0x3f800000u : 0u; ta[q] = lo | hi; ta[2 + q] = 0u; tbm[q] = 0x3f803f80u; tbm[2 + q] = lo | hi; }
    const bf16x8 TA = __builtin_bit_cast(bf16x8, ta), TB = __builtin_bit_cast(bf16x8, tbm), ONES = __builtin_bit_cast(bf16x8, ((u32x4){0x3f803f80u, 0x3f803f80u, 0x3f803f80u, 0x3f803f80u}));
    bt[0] = MFMA16(vl[0], TA, MFMA16(vh[0], TA, init));
    bt[1] = MFMA16(vl[0], TB, MFMA16(vh[0], TB, init));
    const f32x4 s32 = MFMA16(vl[0], ONES, MFMA16(vh[0], ONES, init));
    bt[2] = MFMA16(vl[1], TA, MFMA16(vh[1], TA, s32));
    bt[3] = MFMA16(vl[1], TB, MFMA16(vh[1], TB, s32));
    s64 = MFMA16(vl[1], ONES, MFMA16(vh[1], ONES, s32));
}
__device__ __forceinline__ void q1_stage_a(const Args& a, LAS unsigned char* lds, Q1Pre& pre, f32x4& lamf, f32x4& lamb, const int st, const int nst, const int tid) {
    const int lane = tid & 63, w = tid >> 6, n = lane & 15, g = lane >> 4, set = st & 1;
    int tb, h, item, ntb, nh, nitem; q1_params(st, nst, tb, h, item); q1_params(st + 1, nst, ntb, nh, nitem);
    const f32x4 z4 = (f32x4){0.f, 0.f, 0.f, 0.f};
    if ((st & 3) == 0) { lamf = z4; lamb = z4; }
    f32x4 btf[4], btb[4], s64f, s64b;
    q1_gate<false>(pre.gf, pre.wff, pre.wbf, z4, n, g, btf, s64f);
    q1_gate<true>(pre.gb, pre.wfb, pre.wbb, lamb, n, g, btb, s64b);
    q1_prefetch_gd(a, pre, tid, ntb, nh);
    lamf += s64f; lamb = s64b;
    if (n == 0) {
        *(LAS f32x4*)(lds + Q1_EBL + set * 512 + (16 * w + 4 * g) * 4) = (f32x4){fexp2(s64f[0]), fexp2(s64f[1]), fexp2(s64f[2]), fexp2(s64f[3])};
        if ((st & 3) == 3) { float* DEC = (float*)(a.ws + WS_DEC) + (size_t)item * 256 + 16 * w + 4 * g; *(f32x4*)DEC = lamf; *(f32x4*)(DEC + 128) = lamb; }
    }
    const unsigned fn = ((n & 3) << 2) | ((n >> 2) & 3), koff = 256u * n + 16u * ((unsigned)(2 * w + (g >> 1)) ^ fn) + 8u * (g & 1);
#pragma unroll
    for (int it = 0; it < 4; ++it) {
        const float k0 = __uint_as_float(pre.k[it].x << 16), k1 = __uint_as_float(pre.k[it].x & 0xffff0000u), k2 = __uint_as_float(pre.k[it].y << 16), k3 = __uint_as_float(pre.k[it].y & 0xffff0000u);
        u32x2 of, ob;
        of.x = pk2(k0 * fexp2(-btf[it][0]), k1 * fexp2(-btf[it][1])); of.y = pk2(k2 * fexp2(-btf[it][2]), k3 * fexp2(-btf[it][3]));
        ob.x = pk2(k0 * fexp2(btb[it][0]), k1 * fexp2(btb[it][1])); ob.y = pk2(k2 * fexp2(btb[it][2]), k3 * fexp2(btb[it][3]));
        *(LAS u32x2*)(lds + Q1_KF + set * 16384 + 4096 * it + koff) = of;
        *(LAS u32x2*)(lds + Q1_KB + set * 16384 + 4096 * it + koff) = ob;
    }
    q1_prefetch_k(a, pre, tid, ntb, nh);
#pragma unroll
    for (int i = 0; i < 2; ++i) { const int idx = tid + 512 * i; *(LAS u32x4*)(lds + Q1_V + set * 16384 + offb(idx >> 4, idx & 15)) = pre.v[i]; }
    q1_prefetch_v(a, pre, tid, ntb, nh);
}
__device__ __forceinline__ void phase_gla_pass1(const Args& a, LAS unsigned char* lds) {
    const int tid = tid_now(), w = tid >> 6, lane = tid & 63, g = lane >> 4;
    unsigned char* ST = a.ws + WS_ST;
    const int nst = ((NSEG * 4 - (int)blockIdx.x + (int)gridDim.x - 1) / (int)gridDim.x) * 4;
    const unsigned trb0 = tr16(lane, 0, 0, 0), trb1 = tr16(lane, 0, 0, 1);
    Q1Pre pre; f32x4 Sf[8], Sb[8], lamf = (f32x4){0.f, 0.f, 0.f, 0.f}, lamb = lamf;
    if (nst > 0) {
        int tb, h, item; q1_params(0, nst, tb, h, item);
        q1_prefetch_gd(a, pre, tid, tb, h); q1_prefetch_k(a, pre, tid, tb, h); q1_prefetch_v(a, pre, tid, tb, h);
        q1_stage_a(a, lds, pre, lamf, lamb, 0, nst, tid);
    }
#pragma unroll 1
    for (int st = 0; st < nst; ++st) {
        const int p = st & 1;
        if ((st & 3) == 0) {
#pragma unroll
            for (int kt = 0; kt < 8; ++kt) { Sf[kt] = (f32x4){0.f, 0.f, 0.f, 0.f}; Sb[kt] = (f32x4){0.f, 0.f, 0.f, 0.f}; }
        }
        __syncthreads();
        {
            bf16x8 vf[2];
#pragma unroll
            for (int ks = 0; ks < 2; ++ks) vf[ks] = tr_read8(lds, Q1_V + p * 16384 + 8192u * ks + (trb0 ^ (32u * w)), Q1_V + p * 16384 + 8192u * ks + (trb1 ^ (32u * w)));
#pragma unroll
            for (int kt = 0; kt < 8; ++kt) {
#pragma unroll
                for (int ks = 0; ks < 2; ++ks) {
                    const bf16x8 kf = tr_read8(lds, Q1_KF + p * 16384 + 8192u * ks + (trb0 ^ (32u * kt)), Q1_KF + p * 16384 + 8192u * ks + (trb1 ^ (32u * kt))); Sf[kt] = MFMA16(kf, vf[ks], Sf[kt]);
                    const bf16x8 kb = tr_read8(lds, Q1_KB + p * 16384 + 8192u * ks + (trb0 ^ (32u * kt)), Q1_KB + p * 16384 + 8192u * ks + (trb1 ^ (32u * kt))); Sb[kt] = MFMA16(kb, vf[ks], Sb[kt]);
                }
                const f32x4 eb = *(const LAS f32x4*)(lds + Q1_EBL + p * 512 + (16 * kt + 4 * g) * 4);
                Sf[kt] = Sf[kt] * eb;
            }
        }
        if ((st & 3) == 3) {
            const int item = blockIdx.x + (st >> 2) * gridDim.x;
            u32x2* dst = (u32x2*)(ST + (size_t)item * 65536) + (size_t)w * 8 * 64 + lane;
#pragma unroll
            for (int kt = 0; kt < 8; ++kt) { u32x2 v; v.x = pk2(Sf[kt][0], Sf[kt][1]); v.y = pk2(Sf[kt][2], Sf[kt][3]); dst[kt * 64] = v;
                u32x2 u; u.x = pk2(Sb[kt][0], Sb[kt][1]); u.y = pk2(Sb[kt][2], Sb[kt][3]); dst[4096 + kt * 64] = u; }
        }
        if (st + 1 < nst) q1_stage_a(a, lds, pre, lamf, lamb, st + 1, nst, tid);
    }
    __syncthreads();
}
__device__ __forceinline__ void phase_gla_pass2(const Args& a) {
    unsigned char* ST = a.ws + WS_ST; const float* DEC = (const float*)(a.ws + WS_DEC);
    for (int gidx = blockIdx.x * NTHR + tid_now(); gidx < 48 * 4096; gidx += gridDim.x * NTHR) {
        const int chain = gidx >> 12, quad = gidx & 4095, dir = chain & 1, h = (chain >> 1) & 3, s = chain >> 3;
        const int nseg = s < 2 ? LP / 256 : LS / 256, seg0 = s < 2 ? s * (LP / 256) : 2 * (LP / 256) + (s - 2) * (LS / 256);
        const int kt = (quad >> 6) & 7, lane = quad & 63, dk0 = 16 * kt + 4 * (lane >> 4);
        f32x4 S = (f32x4){0.f, 0.f, 0.f, 0.f};
        for (int i0 = 0; i0 < nseg; i0 += 8) {
            u32x2 t[8]; f32x4 lm[8];
#pragma unroll
            for (int j = 0; j < 8; ++j) { const int seg = dir ? seg0 + nseg - 1 - (i0 + j) : seg0 + i0 + j; const size_t idx = (size_t)((seg * 4 + h) * 2 + dir);
                t[j] = ((const u32x2*)(ST + idx * 32768))[quad]; lm[j] = *(const f32x4*)(DEC + idx * 128 + dk0); }
#pragma unroll
            for (int j = 0; j < 8; ++j) { const int seg = dir ? seg0 + nseg - 1 - (i0 + j) : seg0 + i0 + j; const size_t idx = (size_t)((seg * 4 + h) * 2 + dir);
                u32x2 o; o.x = pk2(S[0], S[1]); o.y = pk2(S[2], S[3]); ((u32x2*)(ST + idx * 32768))[quad] = o;
                const f32x4 tv = (f32x4){__uint_as_float(t[j].x << 16), __uint_as_float(t[j].x & 0xffff0000u), __uint_as_float(t[j].y << 16), __uint_as_float(t[j].y & 0xffff0000u)};
                S = (f32x4){fexp2(lm[j][0]), fexp2(lm[j][1]), fexp2(lm[j][2]), fexp2(lm[j][3])} * S + tv; }
        }
    }
}
__device__ __forceinline__ void phase_gla_pass3(const Args& a, LAS unsigned char* lds) {
    const int tid = tid_now(), w = tid >> 6, lane = tid & 63;
    GlaPre pre; int par = 0; float ctot = 0.f;
    if (blockIdx.x < NSEG * 4) { gla_prefetch<1>(a, pre, tid, (blockIdx.x >> 2) * 256, blockIdx.x & 3, 0, -1); ctot = gla_a1(lds, pre, w, lane & 15, lane >> 4, 0); }
    for (int item = blockIdx.x; item < NSEG * 4; item += gridDim.x) {
        const int h = item & 3, seg = item >> 2;
        const int nitem = item + gridDim.x < NSEG * 4 ? item + gridDim.x : item;
        u32x4* stash = (u32x4*)a.out + (size_t)item * 4 * 1024;
#pragma unroll 1
        for (int dir = 0; dir < 2; ++dir) {
            f32x4 Sacc[8];
            const u32x2* src = (const u32x2*)(a.ws + WS_ST + (size_t)((seg * 4 + h) * 2 + dir) * 32768) + (size_t)w * 8 * 64 + lane;
#pragma unroll
            for (int kt = 0; kt < 8; ++kt) { const u32x2 v = src[kt * 64]; Sacc[kt] = (f32x4){__uint_as_float(v.x), __uint_as_float(v.y), 0.f, 0.f}; }
            if (dir == 0) {
                for (int c = 0; c < 4; ++c) { const int ntb = seg * 256 + (c < 3 ? c + 1 : 3) * 64, ndir = c < 3 ? 0 : 1;
                    gla_chunk<1>(a, lds, seg * 256 + c * 64, h, 0, Sacc, ctot, stash + c * 1024, pre, pre, ntb, h, ndir, c == 0, par); par ^= 1; }
            } else {
                for (int c = 3; c >= 0; --c) { const int ntb = c > 0 ? seg * 256 + (c - 1) * 64 : (nitem >> 2) * 256, nh = c > 0 ? h : (nitem & 3), ndir = c > 0 ? 1 : 0;
                    gla_chunk<2>(a, lds, seg * 256 + c * 64, h, 1, Sacc, ctot, stash + c * 1024, pre, pre, ntb, nh, ndir, c == 3, par); par ^= 1; }
            }
        }
    }
    __syncthreads();
}
typedef float f32x16 __attribute__((ext_vector_type(16)));
#define MFMA32(a, b, c) __builtin_amdgcn_mfma_f32_32x32x16_bf16((a), (b), (c), 0, 0, 0)
constexpr int SW_K = 0, SW_V = 65536, SW_TB = 131072, SW_TBN = 336, SW_TBH = 4 * SW_TBN * 4;
constexpr float SW_NEG = -1e30f;
__device__ __forceinline__ unsigned offk(unsigned row, unsigned c8) { return 128u * row + 16u * (c8 ^ ((row >> 1) & 7)); }
__device__ __forceinline__ unsigned offv(unsigned row, unsigned c8) { return 128u * row + 16u * (c8 ^ (((row >> 1) & 1) << 2)); }
__device__ __forceinline__ void swa_load_block(const bf16_t* U, int gb, int kvh, bool valid, int tid, u32x4 (&kk)[2], u32x4 (&vv)[2]) {
#pragma unroll
    for (int i = 0; i < 2; ++i) {
        const int idx = tid + 512 * i, r = idx >> 3, c8 = idx & 7;
        kk[i] = (u32x4){0, 0, 0, 0}; vv[i] = (u32x4){0, 0, 0, 0};
        if (valid) { const bf16_t* ur = U + (size_t)(gb * 128 + r) * UP + kvh * 64 + c8 * 8; kk[i] = __builtin_nontemporal_load((const u32x4*)(ur + C_KB)); vv[i] = __builtin_nontemporal_load((const u32x4*)(ur + C_VB)); }
    }
}
__device__ __forceinline__ void swa_store_block(LAS unsigned char* lds, int gb, int tid, const u32x4 (&kk)[2], const u32x4 (&vv)[2]) {
#pragma unroll
    for (int i = 0; i < 2; ++i) {
        const int idx = tid + 512 * i, r = 128 * (gb & 3) + (idx >> 3), c8 = idx & 7;
        *(LAS u32x4*)(lds + SW_K + offk(r, c8)) = kk[i]; *(LAS u32x4*)(lds + SW_V + offv(r, c8)) = vv[i];
    }
}
__device__ __forceinline__ bool swa_exists(int gb) { return gb >= 0 && gb < NTOK / 128; }
__device__ __forceinline__ void phase_swa(const Args& a, LAS unsigned char* lds) {
    const bf16_t* U = (const bf16_t*)(a.ws + WS_U); bf16_t* ymix = (bf16_t*)((unsigned char*)a.out + 96 * MiB);
    const int tid = tid_now(), lane = tid & 63, w = __builtin_amdgcn_readfirstlane(tid >> 6), r = lane & 31, hh = lane >> 5;
    for (int su = blockIdx.x; su < (NTOK / 128 / 3) * 2; su += gridDim.x) {
        const int kvh = su & 1, qb0 = 3 * (su >> 1);
        __syncthreads();
        for (int e = tid; e < 4 * SW_TBN; e += NTHR) {
            const int hl = e / SW_TBN, idx = e - hl * SW_TBN, rel = idx - 160;
            const float val = (rel >= -128 && rel <= 128) ? a.relb[t5_bucket(rel) * 8 + kvh * 4 + hl] : SW_NEG;
            LAS float* tb = (LAS float*)(lds + SW_TB + hl * SW_TBH);
#pragma unroll
            for (int s = 0; s < 4; ++s) if (idx - s >= 0) tb[s * SW_TBN + idx - s] = val;
        }
#pragma unroll 1
        for (int bb = -1; bb <= 1; ++bb) { u32x4 kk[2], vv[2]; swa_load_block(U, qb0 + bb, kvh, swa_exists(qb0 + bb), tid, kk, vv); swa_store_block(lds, qb0 + bb, tid, kk, vv); }
        __syncthreads();
        const int hl = w >> 1, hq = kvh * 4 + hl;
        const float snk = a.sink[hq];
#pragma unroll 1
        for (int qi = 0; qi < 3; ++qi) {
            const int qb = qb0 + qi, tok0 = qb * 128; int s0, L; seq_of(tok0, s0, L);
            const bool first = tok0 == s0, last = tok0 + 128 == s0 + L;
            u32x4 nk[2], nv[2];
            if (qi < 2) swa_load_block(U, qb + 2, kvh, swa_exists(qb + 2), tid, nk, nv);
            bf16x8 Qn[4];
            { const int qt0 = tok0 + 32 * ((w & 1) * 2) + r;
#pragma unroll
              for (int s = 0; s < 4; ++s) Qn[s] = *(const bf16x8*)(U + (size_t)qt0 * UP + C_QB + hq * 64 + 16 * s + 8 * hh); }
#pragma unroll 1
            for (int ss = 0; ss < 2; ++ss) {
                const int st = (w & 1) * 2 + ss, qtok = tok0 + 32 * st + r;
                bf16x8 Qf[4];
#pragma unroll
                for (int s = 0; s < 4; ++s) Qf[s] = Qn[s];
                { const int qt1 = ss == 0 ? qtok + 32 : qtok;
#pragma unroll
                  for (int s = 0; s < 4; ++s) Qn[s] = *(const bf16x8*)(U + (size_t)qt1 * UP + C_QB + hq * 64 + 16 * s + 8 * hh); }
                u32x2 zv8[2][4];
#pragma unroll
                for (int dt = 0; dt < 2; ++dt)
#pragma unroll
                    for (int i4 = 0; i4 < 4; ++i4) zv8[dt][i4] = *(const u32x2*)(U + (size_t)qtok * UP + C_ZB + hq * 64 + 32 * dt + 8 * i4 + 4 * hh);
                float m = snk, l = hh == 0 ? 1.0f : 0.0f;
                f32x16 O[2];
#pragma unroll
                for (int i = 0; i < 16; ++i) { O[0][i] = 0.f; O[1][i] = 0.f; }
                const int sft = (-r) & 3;
                const unsigned tbase = SW_TB + hl * SW_TBH + sft * (SW_TBN * 4) + 4 * (32 + 4 * hh - r - sft);
                const unsigned kb0 = SW_K + 128u * r + 16u * (hh ^ ((r >> 1) & 7));
                const int q4 = (lane & 15) >> 2, p4 = lane & 3, g1 = (lane >> 4) & 1, xq = (q4 >> 1) & 1;
                const unsigned vb0 = SW_V + 128u * (4 * hh + q4) + 16u * ((4 * xq) | (2 * g1) | (p4 >> 1)) + 8u * (p4 & 1);
#pragma unroll 1
                for (int grp = 0; grp < 3; ++grp) {
                    f32x16 S[3];
#pragma unroll
                    for (int k3 = 0; k3 < 3; ++k3) {
                        const int kk = 3 * grp + k3, kt = st + kk, blk = kt >> 2;
                        const bool valid = !((blk == 0 && first) || (blk == 2 && last));
                        const unsigned rowb = 128u * (128u * ((unsigned)(qb - 1 + blk) & 3u) + 32u * (kt & 3));
                        if (valid) {
#pragma unroll
                            for (int i4 = 0; i4 < 4; ++i4) { const f32x4 bv = *(const LAS f32x4*)(lds + tbase + 4 * (32 * kk + 8 * i4));
#pragma unroll
                                for (int j = 0; j < 4; ++j) S[k3][4 * i4 + j] = bv[j]; }
#pragma unroll
                            for (int s = 0; s < 4; ++s) { const bf16x8 Kf = *(const LAS bf16x8*)(lds + (kb0 ^ (32u * s)) + rowb); S[k3] = MFMA32(Kf, Qf[s], S[k3]); }
                        } else {
#pragma unroll
                            for (int i = 0; i < 16; ++i) S[k3][i] = SW_NEG;
                        }
                    }
                    float mx4[4] = {SW_NEG, SW_NEG, SW_NEG, SW_NEG};
#pragma unroll
                    for (int k3 = 0; k3 < 3; ++k3)
#pragma unroll
                        for (int i = 0; i < 16; ++i) mx4[i & 3] = fmaxf(mx4[i & 3], S[k3][i]);
                    float mx = fmaxf(fmaxf(mx4[0], mx4[1]), fmaxf(mx4[2], mx4[3]));
                    mx = fmaxf(mx, __shfl_xor(mx, 32));
                    const float mn = fmaxf(m, mx), alpha = fexp(m - mn);
                    m = mn; l *= alpha;
#pragma unroll
                    for (int i = 0; i < 16; ++i) { O[0][i] *= alpha; O[1][i] *= alpha; }
                    bf16x8 Pf[3][2];
                    float l4[4] = {0.f, 0.f, 0.f, 0.f};
                    const float mL = m * 1.4426950408889634f;
#pragma unroll
                    for (int k3 = 0; k3 < 3; ++k3) {
#pragma unroll
                        for (int i = 0; i < 16; ++i) { const float pv = fexp2(__builtin_fmaf(S[k3][i], 1.4426950408889634f, -mL)); S[k3][i] = pv; l4[i & 3] += pv; }
#pragma unroll
                        for (int s2 = 0; s2 < 2; ++s2) {
                            u32x4 pw;
#pragma unroll
                            for (int j = 0; j < 4; ++j) pw[j] = pk2(S[k3][8 * s2 + 2 * j], S[k3][8 * s2 + 2 * j + 1]);
                            Pf[k3][s2] = __builtin_bit_cast(bf16x8, pw);
                        }
                    }
                    l += (l4[0] + l4[1]) + (l4[2] + l4[3]);
#pragma unroll
                    for (int k3 = 0; k3 < 3; ++k3) {
                        const int kt = st + 3 * grp + k3, blk = kt >> 2;
                        const unsigned rowb = 128u * (128u * ((unsigned)(qb - 1 + blk) & 3u) + 32u * (kt & 3));
#pragma unroll
                        for (int s2 = 0; s2 < 2; ++s2)
#pragma unroll
                            for (int dt = 0; dt < 2; ++dt) {
                                const unsigned va = (vb0 ^ (64u * dt)) + rowb + 2048u * s2;
                                const bf16x8 Vf = tr_read8(lds, va, va + 1024u);
                                O[dt] = MFMA32(Vf, Pf[k3][s2], O[dt]);
                            }
                    }
                }
                l += __shfl_xor(l, 32);
                const float inv = __builtin_amdgcn_rcpf(l);
#pragma unroll
                for (int dt = 0; dt < 2; ++dt)
#pragma unroll
                    for (int i4 = 0; i4 < 4; ++i4) {
                        const int d0 = 32 * dt + 8 * i4 + 4 * hh;
                        const u32x2 zv = zv8[dt][i4];
                        const float z0 = __uint_as_float(zv.x << 16), z1 = __uint_as_float(zv.x & 0xffff0000u), z2 = __uint_as_float(zv.y << 16), z3 = __uint_as_float(zv.y & 0xffff0000u);
                        u32x2 yw; yw.x = pk2(O[dt][4 * i4] * inv * silu(z0), O[dt][4 * i4 + 1] * inv * silu(z1)); yw.y = pk2(O[dt][4 * i4 + 2] * inv * silu(z2), O[dt][4 * i4 + 3] * inv * silu(z3));
                        *(u32x2*)(ymix + (size_t)qtok * DM + 512 + hq * 64 + d0) = yw;
                    }
            }
            if (qi < 2) swa_store_block(lds, qb + 2, tid, nk, nv);
            __syncthreads();
        }
    }
}
__device__ __forceinline__ void phase_convfix(const Args& a) {
    bf16_t* G = (bf16_t*)(a.ws + WS_XB); const float* Pb = (const float*)(a.ws + WS_PB); const float* Sb = (const float*)(a.ws + WS_SB);
    for (int idx = blockIdx.x * NTHR + tid_now(); idx < (NTOK / 64 - 1) * 256; idx += gridDim.x * NTHR) {
        const int k = idx / 256 + 1, c = (idx & 255) * 4, row = 64 * k; int s0, L; seq_of(row, s0, L);
        if (row == s0) continue;
        const f32x4 pl = *(const f32x4*)(Pb + (size_t)((k - 1) * 2 + 1) * 1024 + c), sl = *(const f32x4*)(Sb + (size_t)((k - 1) * 2 + 1) * 1024 + c);
        const f32x4 pf = *(const f32x4*)(Pb + (size_t)(k * 2) * 1024 + c), sf = *(const f32x4*)(Sb + (size_t)(k * 2) * 1024 + c);
        const f32x4 c0 = *(const f32x4*)(a.cw + c), c2 = *(const f32x4*)(a.cw + 2048 + c);
        u32x2* gl = (u32x2*)(G + (size_t)(row - 1) * DM + c); u32x2* gf = (u32x2*)(G + (size_t)row * DM + c);
        const u32x2 a0 = *gl, a1 = *gf;
        const f32x4 dl = sl * c2 * pf, df = sf * c0 * pl;
        u32x2 o0, o1;
        o0.x = pk2(__uint_as_float(a0.x << 16) + dl[0], __uint_as_float(a0.x & 0xffff0000u) + dl[1]); o0.y = pk2(__uint_as_float(a0.y << 16) + dl[2], __uint_as_float(a0.y & 0xffff0000u) + dl[3]);
        o1.x = pk2(__uint_as_float(a1.x << 16) + df[0], __uint_as_float(a1.x & 0xffff0000u) + df[1]); o1.y = pk2(__uint_as_float(a1.y << 16) + df[2], __uint_as_float(a1.y & 0xffff0000u) + df[3]);
        *gl = o0; *gf = o1;
    }
}
__global__ void __launch_bounds__(NTHR, 2) mega(Args a) {
    LAS unsigned char* lds = (LAS unsigned char*)lds_raw;
    volatile LAS unsigned* MISC = (volatile LAS unsigned*)(lds + MISC_OFF);
    if (threadIdx.x < 32) MISC[threadIdx.x] = 0u;
    if ((threadIdx.x & 63) == 0) ((volatile LAS unsigned*)(lds + SLOT_OFF))[hw_slot()] = threadIdx.x >> 6;
    __syncthreads();
    unsigned char* ws = a.ws; float* out = a.out;
    XcdBarrier bar = xcd_barrier_post((unsigned*)(ws + WS_CTL) + 4096, MISC + 8);
    bf16_t* W1t = (bf16_t*)(ws + WS_W1T); bf16_t* W2t = (bf16_t*)(ws + WS_W2T); bf16_t* W3t = (bf16_t*)(ws + WS_W3T); bf16_t* W4t = (bf16_t*)(ws + WS_W4T);
    bf16_t* xb = (bf16_t*)(ws + WS_XB); bf16_t* ymix = (bf16_t*)((unsigned char*)out + 96 * MiB); bf16_t* G = xb; bf16_t* U = (bf16_t*)(ws + WS_U);
    bf16_t* x1b = (bf16_t*)(ws + WS_X1B); bf16_t* P = (bf16_t*)(ws + WS_P); bf16_t* Sg = (bf16_t*)(ws + WS_S);
    f32x2* stat1 = (f32x2*)(ws + WS_STAT1); f32x2* stat2 = (f32x2*)(ws + WS_STAT2); f32x2* mr1 = (f32x2*)(ws + WS_MR1);

    phase_convert(a, lds);
    xcd_barrier(bar);
    { pg8::Gemm g{xb, W1t, NTOK, C_GD, DM, 0}; pg8::StaticOrder S; S.init(NTOK, C_GD, gridDim.x, blockIdx.x); EpiU E{U}; pg8::gemm_phase<EpiU, pg8::StaticOrder>(lds, g, S, E); }
    xcd_barrier(bar);
    phase_gla_pass1(a, lds);
    xcd_barrier(bar);
    phase_gla_pass2(a);
    phase_swa(a, lds);
    xcd_barrier(bar);
    phase_gla_pass3(a, lds);
    xcd_barrier(bar);
    { pg8::Gemm g{ymix, W2t, NTOK, DM, DM, 0}; pg8::StaticOrder S; S.init(NTOK, DM, gridDim.x, blockIdx.x);
      EpiLN<0> E{ws, nullptr, a.lng, a.lnb}; pg8::gemm_phase<EpiLN<0>, pg8::StaticOrder>(lds, g, S, E); }
    xcd_barrier(bar);
    { pg8::Gemm g{x1b, W3t, NTOK, 4096, DM, 0}; pg8::StaticOrder S; S.init(NTOK, 4096, gridDim.x, blockIdx.x); EpiG E{ws, a.cw}; pg8::gemm_phase<EpiG, pg8::StaticOrder>(lds, g, S, E); }
    xcd_barrier(bar);
    phase_convfix(a);
    xcd_barrier(bar);
    { pg8::Gemm g{G, W4t, NTOK, DM, DM, 0}; pg8::StaticOrder S; S.init(NTOK, DM, gridDim.x, blockIdx.x);
      EpiLN<1> E{ws, out, a.lng + DM, a.lnb + DM}; pg8::gemm_phase<EpiLN<1>, pg8::StaticOrder>(lds, g, S, E); }
}

extern "C" void kernel_launch(void* const* d_in, const int* in_sizes, int n_in, void* d_out, int out_size, void* d_ws, size_t ws_size, hipStream_t stream) {
    static int grid = 0;
    if (grid == 0) {
        if (n_in != 16 || out_size != NTOK * DM || ws_size < WS_END) { fprintf(stderr, "kernel_launch: unexpected shapes (n_in %d out %d ws %zu)\n", n_in, out_size, ws_size); grid = -1; return; }
        int dev = 0, cus = 0, per_cu = 0;
        if (hipGetDevice(&dev) != hipSuccess || hipDeviceGetAttribute(&cus, hipDeviceAttributeMultiprocessorCount, dev) != hipSuccess) { grid = -1; return; }
        if (hipFuncSetAttribute((const void*)mega, hipFuncAttributeMaxDynamicSharedMemorySize, LDS_BYTES) != hipSuccess) { fprintf(stderr, "kernel_launch: hipFuncSetAttribute failed\n"); grid = -1; return; }
        if (hipOccupancyMaxActiveBlocksPerMultiprocessor(&per_cu, (const void*)mega, NTHR, LDS_BYTES) != hipSuccess || per_cu < 1) { fprintf(stderr, "kernel_launch: occupancy query says %d blocks per CU\n", per_cu); (void)hipGetLastError(); grid = -1; return; }
        grid = cus;
    }
    if (grid < 0) return;
    (void)hipMemsetAsync((char*)d_ws + WS_CTL, 0, 262144, stream);
    Args a{};
    a.xp = (const float*)d_in[0]; a.xs = (const float*)d_in[1]; a.w_in_even = (const float*)d_in[2]; a.wuf = (const float*)d_in[3]; a.bfw = (const float*)d_in[4];
    a.wub = (const float*)d_in[5]; a.bbw = (const float*)d_in[6]; a.ng = (const float*)d_in[7]; a.sink = (const float*)d_in[8]; a.relb = (const float*)d_in[9];
    a.w_out_even = (const float*)d_in[10]; a.w_in_odd = (const float*)d_in[11]; a.cw = (const float*)d_in[12]; a.w_out_odd = (const float*)d_in[13];
    a.lng = (const float*)d_in[14]; a.lnb = (const float*)d_in[15]; a.out = (float*)d_out; a.ws = (unsigned char*)d_ws;
    hipLaunchKernelGGL(mega, dim3(grid), dim3(NTHR), LDS_BYTES, stream, a);
}
```

```cpp
#include <hip/hip_runtime.h>
#include <cstdio>

typedef unsigned short bf16_t;
typedef short bf16x8 __attribute__((ext_vector_type(8)));
typedef float f32x4 __attribute__((ext_vector_type(4)));
typedef float f32x2 __attribute__((ext_vector_type(2)));
typedef unsigned u32x4 __attribute__((ext_vector_type(4)));
typedef unsigned u32x2 __attribute__((ext_vector_type(2)));
#define LAS __attribute__((address_space(3)))
#define MFMA16(a, b, c) __builtin_amdgcn_mfma_f32_16x16x32_bf16((a), (b), (c), 0, 0, 0)
extern __shared__ __attribute__((aligned(16))) unsigned char lds_raw[];
constexpr int SLOT_OFF = 163840 - 1024;
__device__ __forceinline__ unsigned hw_slot() { return (unsigned)__builtin_amdgcn_s_getreg((5 << 11) | 4) & 63u; }
__device__ __forceinline__ int tid_fresh() {
    const int wid = __builtin_amdgcn_readfirstlane((int)((volatile LAS unsigned*)((LAS unsigned char*)lds_raw + SLOT_OFF))[hw_slot()]);
    int l; asm volatile("v_mbcnt_lo_u32_b32 %0, -1, 0\n\tv_mbcnt_hi_u32_b32 %0, -1, %0" : "=v"(l));
    return wid * 64 + l;
}
__device__ __forceinline__ int tid_now() {
    const int wid = __builtin_amdgcn_readfirstlane((int)((volatile LAS unsigned*)((LAS unsigned char*)lds_raw + SLOT_OFF))[hw_slot()]);
    return wid * 64 + (int)__lane_id();
}

constexpr int DM = 1024, NTOK = 49152, NPROMPT = 32768, LP = 16384, LS = 4096;
constexpr int UP = 3584;
constexpr int C_QA = 0, C_KA = 512, C_VA = 1024, C_ZA = 1536, C_QB = 2048, C_KB = 2560, C_VB = 2688, C_ZB = 2816, C_GD = 3328;
constexpr int EVEN_IN = 3360, ODD_IN = 4096;
constexpr float DN_ALPHA = 1.41421356237309515f;
constexpr float LN_EPS = 1e-5f, NORM_EPS = 1e-6f;

constexpr size_t MiB = 1u << 20;
constexpr size_t WS_CTL = 0, WS_W1T = 1 * MiB, WS_W2T = 8 * MiB, WS_W3T = 10 * MiB, WS_W4T = 18 * MiB, WS_STAT1 = 20 * MiB, WS_MR1 = 26 * MiB, WS_DEC = 27 * MiB, WS_GATE = 27 * MiB + 768 * 1024,
                 WS_XB = 28 * MiB  , WS_U = 124 * MiB, WS_ST = 460 * MiB, WS_END = 508 * MiB;
constexpr size_t WS_X1B = WS_U, WS_P = WS_U + 96 * MiB, WS_S = WS_U + 192 * MiB, WS_STAT2 = WS_U + 288 * MiB, WS_PB = WS_U + 296 * MiB, WS_SB = WS_U + 304 * MiB;

__device__ __forceinline__ float bf2f(bf16_t b) { return __uint_as_float(((unsigned)b) << 16); }
typedef __bf16 nbf16x2 __attribute__((ext_vector_type(2)));
__device__ __forceinline__ bf16_t f2bf(float f) { return __builtin_bit_cast(bf16_t, (__bf16)f); }
__device__ __forceinline__ unsigned pk2(float lo, float hi) { return __builtin_bit_cast(unsigned, __builtin_convertvector((f32x2){lo, hi}, nbf16x2)); }
__device__ __forceinline__ float fexp2(float x) { return __builtin_amdgcn_exp2f(x); }
__device__ __forceinline__ float fexp(float x) { return __builtin_amdgcn_exp2f(x * 1.4426950408889634f); }
__device__ __forceinline__ float flog2(float x) { return __builtin_amdgcn_logf(x); }
__device__ __forceinline__ float silu(float x) { return x * __builtin_amdgcn_rcpf(1.0f + fexp(-x)); }
__device__ __forceinline__ float wave_sum(float v) {
#pragma unroll
    for (int o = 1; o < 64; o <<= 1) v += __shfl_xor(v, o);
    return v;
}
__device__ __forceinline__ float wave_max(float v) {
#pragma unroll
    for (int o = 1; o < 64; o <<= 1) v = fmaxf(v, __shfl_xor(v, o));
    return v;
}
__device__ __forceinline__ void seq_of(int row, int& s0, int& L) {
    if (row < NPROMPT) { L = LP; s0 = row & ~(LP - 1); } else { L = LS; s0 = NPROMPT + ((row - NPROMPT) & ~(LS - 1)); }
}

namespace pg8 {
constexpr int BM = 256, BK = 64, HALF = 128, HTB = HALF * BK * 2, STAGE_BYTES = 8 * HTB, NXCD = 8, WGM = 8;
__host__ __device__ __forceinline__ int lds_byte(int r, int c) { const int st = (r >> 4) * 2 + (c >> 5), rr = r & 15, cc = c & 31, ob = rr * 64 + cc * 2; return st * 1024 + (ob ^ (((ob >> 9) & 1) << 5)); }
__host__ __device__ __forceinline__ void stage_rc(int b, int& R, int& C) { const int st = b / 1024, sb = b % 1024, swz = sb ^ (((sb >> 9) & 1) << 5); R = (st >> 1) * 16 + swz / 64; C = (st & 1) * 32 + (swz % 64) / 2; }
__host__ __device__ __forceinline__ int perm32(int rho) { const int n = rho >> 4, i = rho & 15; return 8 * (i >> 2) + 4 * n + (i & 3); }
struct Unit { int pm, pn; };
struct Gemm { const bf16_t* A; const bf16_t* Bt; int M, N, K, pad; };
struct StaticOrder {
    int nM, nN, nwg, G, c;
    __host__ __device__ void init(int M, int N, int G_, int c_) { nM = M / BM; nN = N / BM; nwg = nM * nN; G = G_; c = c_; }
    __host__ __device__ bool next(int i, Unit& u) const {
        const long L = (long)i * G + c; if (L >= nwg) return false;
        int wgid = (int)L; { const int q = nwg / NXCD, r = nwg % NXCD, xcd = wgid % NXCD, off = wgid / NXCD; wgid = (xcd < r ? xcd * (q + 1) : r * (q + 1) + (xcd - r) * q) + off; }
        const int nig = WGM * nN, gid = wgid / nig, fm = gid * WGM, gsz = (nM - fm) < WGM ? (nM - fm) : WGM;
        u.pm = fm + ((wgid % nig) % gsz); u.pn = (wgid % nig) / gsz; return true;
    }
    __device__ __forceinline__ void a_ready(const Unit&) const {}
    __device__ __forceinline__ void done(const Unit&) const {}
};

template <class Epi, class Sched>
__device__ __forceinline__ void gemm_phase(LAS unsigned char* lds, const Gemm g, const Sched& S, const Epi& E) {
    int tid = tid_now(); asm volatile("" : "+v"(tid));
    const int wid = __builtin_amdgcn_readfirstlane(tid >> 6), lane = tid & 63, wr = wid >> 2, wc = wid & 3, fr = lane & 15, fq = lane >> 4;
    const int K = g.K, nt = K / BK;
    unsigned voffA[2], voffB[2];
#pragma unroll
    for (int i = 0; i < 2; ++i) { int R, C; stage_rc(tid * 16 + i * 8192, R, C); const int Rb = Epi::PERM ? ((R & ~31) + perm32(R & 31)) : R;
        voffA[i] = (unsigned)(R * K + C) * 2u; voffB[i] = (unsigned)(Rb * K + C) * 2u; }
    const size_t kstep = (size_t)(BK * 2);
    const size_t hstep = (size_t)HALF * K * 2;
    const size_t tstep = 2 * hstep;
    const unsigned ldsw = (unsigned)wid * 1024u;
    const int aoff = lds_byte(wr * 64 + fr, fq * 8), boff = lds_byte(wc * 32 + fr, fq * 8);
#define PG8_SA(b, h) (((b) * 2 + (h)) * HTB)
#define PG8_SB(b, h) ((4 + (b) * 2 + (h)) * HTB)
#define PG8_STAGE(bufoff, gbase, voff) do { _Pragma("unroll") for (int _i = 0; _i < 2; ++_i) \
        __builtin_amdgcn_global_load_lds((const unsigned*)((const char*)(gbase) + (voff)[_i]), (LAS unsigned*)(lds + (bufoff) + ldsw + _i * 8192), 16, 0, 0); } while (0)
#define PG8_LDA(dst, b, h) do { _Pragma("unroll") for (int m = 0; m < 4; ++m) _Pragma("unroll") for (int k = 0; k < 2; ++k) dst[m][k] = *(const LAS bf16x8*)(lds + PG8_SA(b, h) + aoff + m * 2048 + k * 1024); } while (0)
#define PG8_LDB(dst, b, h) do { _Pragma("unroll") for (int n = 0; n < 2; ++n) _Pragma("unroll") for (int k = 0; k < 2; ++k) dst[n][k] = *(const LAS bf16x8*)(lds + PG8_SB(b, h) + boff + n * 2048 + k * 1024); } while (0)
#define PG8_MMA(ai, bj, At, Bt) do { __builtin_amdgcn_s_setprio(1); _Pragma("unroll") for (int m = 0; m < 4; ++m) _Pragma("unroll") for (int n = 0; n < 2; ++n) _Pragma("unroll") for (int k = 0; k < 2; ++k) \
        acc[ai][bj][m][n] = __builtin_amdgcn_mfma_f32_16x16x32_bf16(Bt[n][k], At[m][k], acc[ai][bj][m][n], 0, 0, 0); __builtin_amdgcn_s_setprio(0); } while (0)
#define PG8_WAIT_V(n) asm volatile("s_waitcnt vmcnt(" #n ")" ::: "memory")
#define PG8_WAIT_L(n) asm volatile("s_waitcnt lgkmcnt(" #n ")" ::: "memory")
#define PG8_BAR __builtin_amdgcn_s_barrier()
#define PG8_SCHED __builtin_amdgcn_sched_barrier(0)
    Unit cur, nxt; int ui = 0;
    if (!S.next(0, cur)) return;
    f32x4 acc[2][2][4][2];
#pragma unroll
    for (int a = 0; a < 2; ++a)
#pragma unroll
        for (int b = 0; b < 2; ++b)
#pragma unroll
            for (int m = 0; m < 4; ++m)
#pragma unroll
                for (int n = 0; n < 2; ++n) acc[a][b][m][n] = (f32x4){0.f, 0.f, 0.f, 0.f};
    bf16x8 At[4][2], B0[2][2], B1[2][2];
    const char* cA = (const char*)g.A + (size_t)cur.pm * tstep; const char* cB = (const char*)g.Bt + (size_t)cur.pn * tstep;
    S.a_ready(cur);
    PG8_STAGE(PG8_SB(0, 0), cB, voffB); PG8_STAGE(PG8_SA(0, 0), cA, voffA); PG8_STAGE(PG8_SB(0, 1), cB + hstep, voffB); PG8_STAGE(PG8_SA(0, 1), cA + hstep, voffA);
    if (wr == 1) PG8_BAR;
    PG8_WAIT_V(4); PG8_BAR;
    PG8_STAGE(PG8_SB(1, 0), cB + kstep, voffB); PG8_STAGE(PG8_SA(1, 0), cA + kstep, voffA); PG8_STAGE(PG8_SB(1, 1), cB + hstep + kstep, voffB);
    PG8_WAIT_V(6); PG8_BAR;
    for (;;) {
        const bool has_next = S.next(ui + 1, nxt);
        const char* nA = has_next ? (const char*)g.A + (size_t)nxt.pm * tstep : cA; const char* nB = has_next ? (const char*)g.Bt + (size_t)nxt.pn * tstep : cB;
        for (int t = 0; t < nt; t += 2) {
            const bool last = (t == nt - 2);
            const char* a1 = cA + (size_t)(t + 1) * kstep;
            const char* a2 = last ? nA : cA + (size_t)(t + 2) * kstep; const char* b2 = last ? nB : cB + (size_t)(t + 2) * kstep;
            const char* a3 = a2 + kstep; const char* b3 = b2 + kstep;
            if (last && has_next) S.a_ready(nxt);
            PG8_LDB(B0, 0, 0); PG8_SCHED; PG8_LDA(At, 0, 0); PG8_STAGE(PG8_SA(1, 1), a1 + hstep, voffA);
            PG8_WAIT_L(8); PG8_BAR; PG8_WAIT_L(0); PG8_MMA(0, 0, At, B0); PG8_BAR; PG8_SCHED;
            PG8_LDB(B1, 0, 1); PG8_STAGE(PG8_SB(0, 0), b2, voffB);
            PG8_BAR; PG8_WAIT_L(0); PG8_MMA(0, 1, At, B1); PG8_BAR;
            PG8_LDA(At, 0, 1); PG8_STAGE(PG8_SA(0, 0), a2, voffA);
            PG8_BAR; PG8_WAIT_L(0); PG8_MMA(1, 0, At, B0); PG8_BAR; PG8_SCHED;
            PG8_STAGE(PG8_SB(0, 1), b2 + hstep, voffB);
            PG8_WAIT_V(6); PG8_BAR; PG8_MMA(1, 1, At, B1); PG8_BAR;
            PG8_LDB(B0, 1, 0); PG8_SCHED; PG8_LDA(At, 1, 0); PG8_STAGE(PG8_SA(0, 1), a2 + hstep, voffA);
            PG8_WAIT_L(8); PG8_BAR; PG8_WAIT_L(0); PG8_MMA(0, 0, At, B0); PG8_BAR; PG8_SCHED;
            PG8_LDB(B1, 1, 1); PG8_STAGE(PG8_SB(1, 0), b3, voffB);
            PG8_BAR; PG8_WAIT_L(0); PG8_MMA(0, 1, At, B1); PG8_BAR;
            PG8_LDA(At, 1, 1); PG8_STAGE(PG8_SA(1, 0), a3, voffA);
            PG8_BAR; PG8_WAIT_L(0); PG8_MMA(1, 0, At, B0); PG8_BAR; PG8_SCHED;
            PG8_STAGE(PG8_SB(1, 1), b3 + hstep, voffB);
            PG8_WAIT_V(6); PG8_BAR; PG8_MMA(1, 1, At, B1); PG8_BAR;
        }
        if constexpr (Epi::REALIGN) { if (wr == 0) PG8_BAR; }
        E(acc, cur, wr, wc, fr, fq); S.done(cur);
        if constexpr (Epi::REALIGN) { if (wr == 1) PG8_BAR; }
        if (!has_next) break;
#pragma unroll
        for (int a = 0; a < 2; ++a)
#pragma unroll
            for (int b = 0; b < 2; ++b)
#pragma unroll
                for (int m = 0; m < 4; ++m)
#pragma unroll
                    for (int n = 0; n < 2; ++n) acc[a][b][m][n] = (f32x4){0.f, 0.f, 0.f, 0.f};
        cur = nxt; cA = nA; cB = nB; ++ui;
    }
    PG8_WAIT_V(0);
    if (wr == 0) PG8_BAR;
    PG8_BAR;
#undef PG8_SA
#undef PG8_SB
#undef PG8_STAGE
#undef PG8_LDA
#undef PG8_LDB
#undef PG8_MMA
#undef PG8_WAIT_V
#undef PG8_WAIT_L
#undef PG8_BAR
#undef PG8_SCHED
}
}

struct EpiU {
    static constexpr bool PERM = true, AFTER_DRAIN = false, REALIGN = false;
    bf16_t* O;
    __device__ __forceinline__ void operator()(const f32x4 (&acc)[2][2][4][2], const pg8::Unit& u, int wr, int wc, int fr, int fq) const {
        const int row0 = u.pm * 256 + wr * 64 + fr, col0 = u.pn * 256 + wc * 32 + 8 * fq;
#pragma unroll
        for (int ai = 0; ai < 2; ++ai)
#pragma unroll
            for (int m = 0; m < 4; ++m) { bf16_t* rowp = O + (size_t)(row0 + ai * 128 + m * 16) * UP + col0;
#pragma unroll
                for (int bj = 0; bj < 2; ++bj) { const f32x4 v0 = acc[ai][bj][m][0], v1 = acc[ai][bj][m][1];
                    u32x4 w; w.x = pk2(v0[0], v0[1]); w.y = pk2(v0[2], v0[3]); w.z = pk2(v1[0], v1[1]); w.w = pk2(v1[2], v1[3]);
                    *(u32x4*)(rowp + bj * 128) = w; } }
    }
};
#define RLX_AGENT __ATOMIC_RELAXED, __HIP_MEMORY_SCOPE_AGENT
template <int LAYER> struct EpiLN {
    static constexpr bool PERM = true, AFTER_DRAIN = false, REALIGN = true;
    unsigned char* ws; float* Of; const float* lg; const float* lb;
    __device__ __forceinline__ void operator()(f32x4 (&acc)[2][2][4][2], const pg8::Unit& u, int wr, int wc, int fr, int fq) const {
        unsigned char* w2 = ws; asm volatile("" : "+s"(w2));
        const bf16_t* R = (const bf16_t*)(w2 + (LAYER == 0 ? WS_XB : WS_X1B)); bf16_t* Ob = (bf16_t*)(w2 + WS_X1B);
        unsigned long long* xbuf = (unsigned long long*)(w2 + WS_STAT1 + (LAYER == 0 ? 0 : 3 * MiB));
        unsigned* cnt = (unsigned*)(w2 + WS_CTL) + 16384 + LAYER * 192 * 64;
        const int col0 = u.pn * 256 + wc * 32 + 8 * fq, rowb = u.pm * 256 + wr * 64 + fr;
        LAS f32x2* part = (LAS f32x2*)((LAS unsigned char*)lds_raw + 131072);
        float ps[2][4], pq[2][4];
#pragma unroll
        for (int ai = 0; ai < 2; ++ai) {
            u32x4 rwa[4][2];
#pragma unroll
            for (int m = 0; m < 4; ++m)
#pragma unroll
                for (int bj = 0; bj < 2; ++bj) rwa[m][bj] = *(const u32x4*)(R + (size_t)(rowb + ai * 128 + m * 16) * DM + col0 + bj * 128);
#pragma unroll
            for (int m = 0; m < 4; ++m) {
                float s = 0.f, q = 0.f;
#pragma unroll
                for (int bj = 0; bj < 2; ++bj) {
                    const u32x4 rw = rwa[m][bj];
                    f32x4 r0 = (f32x4){__uint_as_float(rw.x << 16), __uint_as_float(rw.x & 0xffff0000u), __uint_as_float(rw.y << 16), __uint_as_float(rw.y & 0xffff0000u)};
                    f32x4 r1 = (f32x4){__uint_as_float(rw.z << 16), __uint_as_float(rw.z & 0xffff0000u), __uint_as_float(rw.w << 16), __uint_as_float(rw.w & 0xffff0000u)};
                    const f32x4 v0 = r0 * DN_ALPHA + acc[ai][bj][m][0], v1 = r1 * DN_ALPHA + acc[ai][bj][m][1];
                    acc[ai][bj][m][0] = v0; acc[ai][bj][m][1] = v1;
                    s += ((v0[0] + v0[1]) + (v0[2] + v0[3])) + ((v1[0] + v1[1]) + (v1[2] + v1[3]));
                    q += ((v0[0] * v0[0] + v0[1] * v0[1]) + (v0[2] * v0[2] + v0[3] * v0[3])) + ((v1[0] * v1[0] + v1[1] * v1[1]) + (v1[2] * v1[2] + v1[3] * v1[3]));
                }
                s += __shfl_xor(s, 16); s += __shfl_xor(s, 32); q += __shfl_xor(q, 16); q += __shfl_xor(q, 32);
                if (fq == 0) part[(ai * 128 + wr * 64 + m * 16 + fr) * 4 + wc] = (f32x2){s, q};
            }
        }
        const int tid = (wr * 4 + wc) * 64 + fq * 16 + fr;
        asm volatile("s_waitcnt lgkmcnt(0)" ::: "memory"); __builtin_amdgcn_s_barrier(); asm volatile("" ::: "memory");
        if (tid < 256) {
            const LAS f32x4* pp = (const LAS f32x4*)(part + tid * 4); const f32x4 a01 = pp[0], a23 = pp[1];
            const float s = (a01[0] + a01[2]) + (a23[0] + a23[2]), q = (a01[1] + a01[3]) + (a23[1] + a23[3]);
            __hip_atomic_store(xbuf + (size_t)(u.pm * 256 + tid) * 4 + u.pn, ((unsigned long long)__float_as_uint(q) << 32) | __float_as_uint(s), RLX_AGENT);
        }
        asm volatile("s_waitcnt vmcnt(0)" ::: "memory"); __builtin_amdgcn_s_barrier(); asm volatile("" ::: "memory");
        unsigned* c = cnt + 64 * u.pm;
        if (tid == 0) __hip_atomic_fetch_add(c, 1u, RLX_AGENT);
        if (tid < 64) { unsigned spins = 0;
          while ((unsigned)__builtin_amdgcn_readfirstlane(__hip_atomic_load(c, RLX_AGENT)) < 4u) { __builtin_amdgcn_s_sleep(1); if (++spins > (1u << 16)) break; }
          __builtin_amdgcn_fence(__ATOMIC_ACQUIRE, "agent"); asm volatile("s_waitcnt vmcnt(0)" ::: "memory");
          const u32x4* sp = (const u32x4*)(xbuf + (size_t)u.pm * 256 * 4); u32x4 t8[8];
#pragma unroll
          for (int j = 0; j < 8; ++j) t8[j] = sp[j * 64 + tid];
#pragma unroll
          for (int j = 0; j < 8; ++j) *(LAS u32x4*)((LAS unsigned char*)lds_raw + 139264 + (j * 64 + tid) * 16) = t8[j];
          asm volatile("s_waitcnt lgkmcnt(0)" ::: "memory"); }
        __builtin_amdgcn_s_barrier(); asm volatile("" ::: "memory");
#pragma unroll
        for (int ai = 0; ai < 2; ++ai)
#pragma unroll
            for (int m = 0; m < 4; ++m) {
                const LAS f32x4* sp = (const LAS f32x4*)((LAS unsigned char*)lds_raw + 139264 + (wr * 64 + fr + ai * 128 + m * 16) * 32);
                const f32x4 a01 = sp[0], a23 = sp[1];
                const float s = (a01[0] + a01[2]) + (a23[0] + a23[2]), q = (a01[1] + a01[3]) + (a23[1] + a23[3]);
                const float mean = s * (1.0f / DM), var = q * (1.0f / DM) - mean * mean;
                ps[ai][m] = mean; pq[ai][m] = rsqrtf(fmaxf(var, 0.f) + LN_EPS);
            }
#pragma unroll
        for (int bj = 0; bj < 2; ++bj) {
            const f32x4 g0 = *(const f32x4*)(lg + col0 + bj * 128), g1 = *(const f32x4*)(lg + col0 + bj * 128 + 4), b0 = *(const f32x4*)(lb + col0 + bj * 128), b1 = *(const f32x4*)(lb + col0 + bj * 128 + 4);
#pragma unroll
            for (int ai = 0; ai < 2; ++ai)
#pragma unroll
                for (int m = 0; m < 4; ++m) {
                    const int row = rowb + ai * 128 + m * 16; const float mean = ps[ai][m], rstd = pq[ai][m];
                    const f32x4 o0 = (acc[ai][bj][m][0] - mean) * rstd * g0 + b0, o1 = (acc[ai][bj][m][1] - mean) * rstd * g1 + b1;
                    if (LAYER == 0) { u32x4 w; w.x = pk2(o0[0], o0[1]); w.y = pk2(o0[2], o0[3]); w.z = pk2(o1[0], o1[1]); w.w = pk2(o1[2], o1[3]); *(u32x4*)(Ob + (size_t)row * DM + col0 + bj * 128) = w; }
                    else { float* op = Of + (size_t)row * DM + col0 + bj * 128; __builtin_nontemporal_store(o0, (f32x4*)op); __builtin_nontemporal_store(o1, (f32x4*)(op + 4)); }
                }
        }
    }
};
template <int CTRL> __device__ __forceinline__ float dpp_f(float x);
template <int CTRL> __device__ __forceinline__ float dpp_fo(float old, float x) { return __int_as_float(__builtin_amdgcn_update_dpp(__float_as_int(old), __float_as_int(x), CTRL, 0xf, 0xf, false)); }
struct EpiG {
    static constexpr bool PERM = true, AFTER_DRAIN = false, REALIGN = false;
    unsigned char* ws; const float* cw;
    __device__ __forceinline__ void operator()(const f32x4 (&acc)[2][2][4][2], const pg8::Unit& u, int wr, int wc, int fr, int fq) const {
        unsigned char* w2 = ws; asm volatile("" : "+s"(w2));
        bf16_t* G = (bf16_t*)(w2 + WS_XB); float* Pb = (float*)(w2 + WS_PB); float* Sb = (float*)(w2 + WS_SB);
        const int ch0 = u.pn * 64 + 16 * wc + 4 * fq;
        const f32x4 c0 = *(const f32x4*)(cw + ch0), c1 = *(const f32x4*)(cw + 1024 + ch0), c2 = *(const f32x4*)(cw + 2048 + ch0);
#pragma unroll
        for (int ai = 0; ai < 2; ++ai) {
            f32x4 P[4], S[4];
#pragma unroll
            for (int m = 0; m < 4; ++m)
#pragma unroll
                for (int j = 0; j < 4; ++j) { P[m][j] = acc[ai][0][m][1][j] * acc[ai][1][m][1][j]; S[m][j] = silu(acc[ai][1][m][0][j]) * acc[ai][0][m][0][j]; }
            const int row0 = u.pm * 256 + ai * 128 + wr * 64 + fr;
#pragma unroll
            for (int m = 0; m < 4; ++m) {
                float o[4];
#pragma unroll
                for (int j = 0; j < 4; ++j) {
                    const float pr = m > 0 ? dpp_fo<0x111>(dpp_f<0x121>(P[m - 1][j]), P[m][j]) : dpp_f<0x111>(P[m][j]);
                    const float nx = m < 3 ? dpp_fo<0x101>(dpp_f<0x12F>(P[m + 1][j]), P[m][j]) : dpp_f<0x101>(P[m][j]);
                    o[j] = S[m][j] * (c0[j] * pr + c1[j] * P[m][j] + c2[j] * nx);
                }
                u32x2 w; w.x = pk2(o[0], o[1]); w.y = pk2(o[2], o[3]);
                *(u32x2*)(G + (size_t)(row0 + 16 * m) * DM + ch0) = w;
            }
            const int blk = u.pm * 4 + ai * 2 + wr;
            if (fr == 0) { *(f32x4*)(Pb + (size_t)(blk * 2) * 1024 + ch0) = P[0]; *(f32x4*)(Sb + (size_t)(blk * 2) * 1024 + ch0) = S[0]; }
            if (fr == 15) { *(f32x4*)(Pb + (size_t)(blk * 2 + 1) * 1024 + ch0) = P[3]; *(f32x4*)(Sb + (size_t)(blk * 2 + 1) * 1024 + ch0) = S[3]; }
        }
    }
};
#define XB_TMO      128
#define XB_XCNT(j)  (256  + 64 * (j))
#define XB_XSUB(j)  (1280 + 64 * (j))
#define XB_XGEN(j)  (2304 + 64 * (j))
#define XB_TOP      3328
#define XB_TOPGEN   3392
#define XCD_BAR_WORDS 3456
#define XB_SPIN_CAP (1u << 27)
__device__ __forceinline__ unsigned xb_ld(unsigned* p)              { return __hip_atomic_load(p, __ATOMIC_RELAXED, __HIP_MEMORY_SCOPE_AGENT); }
__device__ __forceinline__ unsigned xb_add(unsigned* p, unsigned v) { return __hip_atomic_fetch_add(p, v, __ATOMIC_RELAXED, __HIP_MEMORY_SCOPE_AGENT); }
__device__ __forceinline__ unsigned xb_xcc_id() { return (unsigned)__builtin_amdgcn_s_getreg((3 << 11) | 20) & 0xFu; }
#define XB_SPIN(cond, bar) do { unsigned _sp = 0; while (cond) { __builtin_amdgcn_s_sleep(1); \
    if ((++_sp & 255u) == 0u) { if (xb_ld(&(bar)[XB_TMO])) break; if (_sp > XB_SPIN_CAP) { atomicAdd(&(bar)[XB_TMO], 1u); break; } } } } while (0)
struct XcdBarrier { unsigned* bar; unsigned x; volatile LAS unsigned* st; };
__device__ __forceinline__ XcdBarrier xcd_barrier_post(unsigned* bar, volatile LAS unsigned* st) {
    XcdBarrier b; b.bar = bar; b.x = xb_xcc_id(); b.st = st;
    if (tid_now() == 0) (void)xb_add(&bar[XB_XCNT(b.x)], 1u);
    return b;
}
__device__ __forceinline__ void xcd_barrier_complete(unsigned* bar, unsigned x, unsigned& nloc, unsigned& nx) {
    const unsigned G = gridDim.x * gridDim.y * gridDim.z;
    unsigned sum, cnt, mine, sp = 0u;
    for (;;) {
        sum = 0u; cnt = 0u; mine = 0u;
#pragma unroll
        for (unsigned j = 0; j < 16; ++j) { const unsigned c = xb_ld(&bar[XB_XCNT(j)]); sum += c; cnt += (c > 0u) ? 1u : 0u; mine = (j == x) ? c : mine; }
        if (sum == G) break;
        __builtin_amdgcn_s_sleep(1);
        if ((++sp & 255u) == 0u) { if (xb_ld(&bar[XB_TMO])) break; if (sp > XB_SPIN_CAP) { atomicAdd(&bar[XB_TMO], 1u); break; } }
    }
    nloc = mine > 0u ? mine : 1u; nx = cnt > 0u ? cnt : 1u;
}
__device__ __forceinline__ void xcd_barrier(const XcdBarrier& b) {
    asm volatile("s_waitcnt vmcnt(0)" ::: "memory");
    __syncthreads();
    if (tid_now() == 0) {
        unsigned* bar = b.bar;
        __builtin_amdgcn_s_waitcnt(0);
        unsigned nloc = b.st[0], nx = b.st[1];
        if (nloc == 0u) { xcd_barrier_complete(bar, b.x, nloc, nx); b.st[0] = nloc; b.st[1] = nx; }
        const unsigned old = xb_add(&bar[XB_XSUB(b.x)], 1u);
        const unsigned gen = old / nloc;
        if (old + 1u == (gen + 1u) * nloc) {
            __builtin_amdgcn_fence(__ATOMIC_RELEASE, "agent");
            asm volatile("s_waitcnt vmcnt(0)" ::: "memory");
            const unsigned og = xb_add(&bar[XB_TOP], 1u);
            const unsigned tg = og / nx;
            if (og + 1u == (tg + 1u) * nx) xb_add(&bar[XB_TOPGEN], 1u);
            else XB_SPIN(xb_ld(&bar[XB_TOPGEN]) == tg, bar);
            __builtin_amdgcn_fence(__ATOMIC_ACQUIRE, "agent");
            xb_add(&bar[XB_XGEN(b.x)], 1u);
            asm volatile("s_waitcnt vmcnt(0)" ::: "memory");
        } else {
            XB_SPIN(xb_ld(&bar[XB_XGEN(b.x)]) == gen, bar);
            __builtin_amdgcn_fence(__ATOMIC_ACQUIRE, "agent");
            asm volatile("s_waitcnt vmcnt(0)" ::: "memory");
        }
    }
    __syncthreads();
}

struct Args {
    const float *xp, *xs, *w_in_even, *wuf, *bfw, *wub, *bbw, *ng, *sink, *relb, *w_out_even, *w_in_odd, *cw, *w_out_odd, *lng, *lnb;
    float* out; unsigned char* ws;
};
constexpr int NTHR = 512;
constexpr int LDS_BYTES = 163840, MISC_OFF = 163840 - 512;

template <int MODE> __device__ __forceinline__ int wmap(int n, float& sc) {
    sc = 1.f;
    if (MODE == 0) return n;
    if (MODE == 1) {
        if (n < 512) sc = 0.08838834764831845f;
        if (n >= C_QB && n < C_KB) sc = 0.125f;
        if (n < 2048) return n;
        if (n < C_GD) return n + 32;
        if (n < C_GD + 32) return n - C_GD + 2048;
        return -1;
    }
    const int c = n & 255, bj = (c >> 7) & 1, wc = (c >> 5) & 3, fq = (c >> 3) & 3, nn = (c >> 2) & 1, j = c & 3, q = 2 * bj + nn, ch = (n >> 8) * 64 + 16 * wc + 4 * fq + j;
    const int base = q == 0 ? 0 : (q == 1 ? 1024 : (q == 2 ? 3072 : 2048));
    return base + ch;
}
template <int MODE> __device__ __forceinline__ void p0_w_item(const float* __restrict__ W, int Nsrc, bf16_t* __restrict__ Wt, int Ndst, int item, LAS float* scr, int lane) {
    const int nblk = Ndst / 32, kb = item / nblk, nb = item - kb * nblk, k0 = 64 * kb, n0 = 32 * nb;
    float sc; const int src = wmap<MODE>(n0 + (lane & 31), sc);
    float wv[32];
#pragma unroll
    for (int i = 0; i < 32; ++i) { const int kk = 2 * i + (lane >> 5); wv[i] = src >= 0 ? W[(size_t)(k0 + kk) * Nsrc + src] * sc : 0.f; }
#pragma unroll
    for (int i = 0; i < 32; ++i) { const int kk = 2 * i + (lane >> 5); scr[kk * 33 + (lane & 31)] = wv[i]; }
    asm volatile("s_waitcnt lgkmcnt(0)" ::: "memory");
    const int c = lane & 7;
#pragma unroll
    for (int jj = 0; jj < 4; ++jj) { const int n = (lane >> 3) + 8 * jj; const LAS float* sp = scr + (8 * c) * 33 + n;
        u32x4 o; o.x = pk2(sp[0 * 33], sp[1 * 33]); o.y = pk2(sp[2 * 33], sp[3 * 33]); o.z = pk2(sp[4 * 33], sp[5 * 33]); o.w = pk2(sp[6 * 33], sp[7 * 33]);
        *(u32x4*)(Wt + (size_t)(n0 + n) * 1024 + k0 + 8 * c) = o; }
    asm volatile("s_waitcnt lgkmcnt(0)" ::: "memory");
}
__device__ __forceinline__ void build_gate_tables(const Args& a);
__device__ __forceinline__ void phase_convert(const Args& a, LAS unsigned char* lds) {
    unsigned char* ws = a.ws;
    bf16_t* W1t = (bf16_t*)(ws + WS_W1T); bf16_t* W2t = (bf16_t*)(ws + WS_W2T); bf16_t* W3t = (bf16_t*)(ws + WS_W3T); bf16_t* W4t = (bf16_t*)(ws + WS_W4T);
    {
        const int tidw = tid_now(), lanew = tidw & 63, ww = tidw >> 6;
        LAS float* scr = (LAS float*)(lds + ww * 8448);
        constexpr int I1 = 16 * (C_GD / 32), I2 = 16 * 32, I3H = 16 * 64  , I4 = 16 * 32, NW = I1 + I2 + I3H + I4;
        for (int wi = blockIdx.x * 8 + ww; wi < NW; wi += gridDim.x * 8) {
            int r = wi;
            if (r < I1) p0_w_item<1>(a.w_in_even, EVEN_IN, W1t, C_GD, r, scr, lanew);
            else if ((r -= I1) < I2) p0_w_item<0>(a.w_out_even, 1024, W2t, 1024, r, scr, lanew);
            else if ((r -= I2) < I3H) p0_w_item<2>(a.w_in_odd, ODD_IN, W3t, 4096, r, scr, lanew);
            else p0_w_item<0>(a.w_out_odd, 1024, W4t, 1024, r - I3H, scr, lanew);
        }
    }
    build_gate_tables(a);
    __syncthreads();
    {
        constexpr int WP = 1032, TP = 264;
        LAS bf16_t* wg = (LAS bf16_t*)lds; LAS bf16_t* tile0 = (LAS bf16_t*)(lds + 32 * WP * 2);
        const int tid = tid_now(), lane = tid & 63, w = tid >> 6, n = lane & 15, g = lane >> 4, rb = w & 3, ct = w >> 2;
        for (int e = tid; e < 32 * 1024; e += NTHR) { const int k = e >> 5, c = e & 31; wg[c * WP + k] = f2bf(a.w_in_even[(size_t)k * EVEN_IN + 2048 + c]); }
        bf16_t* xb = (bf16_t*)(ws + WS_XB); bf16_t* U = (bf16_t*)(ws + WS_U);
        f32x4 v[4][2];
        auto slab_load = [&](int it, int sl) {
#pragma unroll
            for (int i = 0; i < 4; ++i) { const int idx = tid + 512 * i, row = it * 64 + (idx >> 5), col = sl * 256 + 8 * (idx & 31);
                const float* src = (row < NPROMPT ? a.xp + (size_t)row * DM : a.xs + (size_t)(row - NPROMPT) * DM) + col;
                v[i][0] = __builtin_nontemporal_load((const f32x4*)src); v[i][1] = __builtin_nontemporal_load((const f32x4*)(src + 4)); } };
        const int ntrip = NTOK / 64;
        if ((int)blockIdx.x < ntrip) slab_load(blockIdx.x, 0);
        int par = 0;
        for (int it = blockIdx.x; it < ntrip; it += gridDim.x) {
            f32x4 acc = (f32x4){0.f, 0.f, 0.f, 0.f};
#pragma unroll 1
            for (int sl = 0; sl < 4; ++sl) {
                LAS bf16_t* tile = tile0 + par * (64 * TP);
#pragma unroll
                for (int i = 0; i < 4; ++i) { const int idx = tid + 512 * i, r64 = idx >> 5, c8 = idx & 31;
                    u32x4 pw; pw.x = pk2(v[i][0][0], v[i][0][1]); pw.y = pk2(v[i][0][2], v[i][0][3]); pw.z = pk2(v[i][1][0], v[i][1][1]); pw.w = pk2(v[i][1][2], v[i][1][3]);
                    *(u32x4*)(xb + (size_t)(it * 64 + r64) * DM + sl * 256 + 8 * c8) = pw;
                    *(LAS u32x4*)(tile + r64 * TP + 8 * c8) = pw; }
                { const int nsl = (sl + 1) & 3, nit = sl < 3 ? it : (it + (int)gridDim.x < ntrip ? it + (int)gridDim.x : it); slab_load(nit, nsl); }
                __syncthreads();
#pragma unroll
                for (int ks = 0; ks < 8; ++ks) {
                    const bf16x8 af = *(const LAS bf16x8*)(tile + (16 * rb + n) * TP + 32 * ks + 8 * g), bfr = *(const LAS bf16x8*)(wg + (16 * ct + n) * WP + sl * 256 + 32 * ks + 8 * g);
                    acc = MFMA16(af, bfr, acc);
                }
                par ^= 1;
            }
#pragma unroll
            for (int r = 0; r < 4; ++r) U[(size_t)(it * 64 + rb * 16 + 4 * g + r) * UP + C_GD + 16 * ct + n] = f2bf(acc[r]);
        }
        __syncthreads();
    }
}

__device__ __forceinline__ int t5_bucket(int rel) {
    const int n = rel < 0 ? -rel : rel;
    int b = n < 8 ? n : (n < 12 ? 8 : (n < 16 ? 9 : (n < 23 ? 10 : (n < 32 ? 11 : (n < 46 ? 12 : (n < 64 ? 13 : (n < 91 ? 14 : 15)))))));
    return b + (rel > 0 ? 16 : 0);
}
__device__ __forceinline__ void phase_w3_convert(const Args& a, LAS unsigned char* lds) {
    const int half = gridDim.x / 2;
    if ((int)blockIdx.x < half) return;
    const int tidw = tid_now(), lanew = tidw & 63, ww = tidw >> 6;
    LAS float* scr = (LAS float*)(lds + ww * 8448);
    bf16_t* W3t = (bf16_t*)(a.ws + WS_W3T);
    for (int wi = 16 * 64 + ((int)blockIdx.x - half) * 8 + ww; wi < 16 * 128; wi += ((int)gridDim.x - half) * 8) p0_w_item<2>(a.w_in_odd, ODD_IN, W3t, 4096, wi, scr, lanew);
}
typedef short s16x4 __attribute__((ext_vector_type(4)));
constexpr int GL_QT = 0, GL_KT = 16384, GL_VT = 32768, GL_PT = 49152, GL_B = 57344  , GL_GD = 94208  , GL_EBL = 96256  , GL_SSW = 97280, GL_RSTD = 99328;
constexpr int NSEG = NTOK / 256;
__device__ __forceinline__ unsigned offb(unsigned row, unsigned ch) { return 256u * row + 16u * (ch ^ (((row & 3) << 2) | ((row >> 2) & 3))); }
__device__ __forceinline__ unsigned offp(unsigned row, unsigned ch) { return 128u * row + 16u * (ch ^ (row & 7)); }
__device__ __forceinline__ unsigned rr16(unsigned lane, unsigned rb, unsigned s) { return offb((lane & 15) + 16 * rb, 4 * s + (lane >> 4)); }
__device__ __forceinline__ unsigned tr16(unsigned lane, unsigned c, unsigned ks, unsigned t) {
    const unsigned g = lane >> 4, q = (lane & 15) >> 2, p = lane & 3;
    return offb(32 * ks + 8 * g + 4 * t + q, 2 * c + (p >> 1)) + 8 * (p & 1);
}
__device__ __forceinline__ void unpack8(const u32x4 w, float (&f)[8]) {
#pragma unroll
    for (int j = 0; j < 4; ++j) { f[2 * j] = __uint_as_float(w[j] << 16); f[2 * j + 1] = __uint_as_float(w[j] & 0xffff0000u); }
}

struct GlaPre { u32x4 gdl; u32x4 q[2], k[2], v[2]; u32x4 wf; float wb; };
template <int MODE>
__device__ __forceinline__ void gla_prefetch(const Args& a, GlaPre& pre, int tid, int tb, int h, int dir, int stidx) {
    const bf16_t* U = (const bf16_t*)(a.ws + WS_U);
    const int lane = tid & 63, n = lane & 15, g = lane >> 4, w = tid >> 6;
#pragma unroll
    for (int i = 0; i < 2; ++i) {
        const int idx = tid + 512 * i, row = idx >> 4, ch = idx & 15, tok = dir ? tb + 63 - row : tb + row;
        const bf16_t* ur = U + (size_t)tok * UP + h * 128 + ch * 8;
        pre.v[i] = *(const u32x4*)(ur + C_VA); pre.k[i] = *(const u32x4*)(ur + C_KA);
        if (MODE != 0) pre.q[i] = *(const u32x4*)(ur + C_QA);
    }
    if (stidx != 0) {
        pre.wf = ((const u32x4*)(a.ws + WS_GATE))[(dir * 4 + h) * 512 + tid];
        pre.wb = ((const float*)(a.ws + WS_GATE + 65536))[(dir * 4 + h) * 128 + 16 * w + n]; }
}
__device__ __forceinline__ u32x4 gla_gd_load(const Args& a, int tid, int tb, int dir) {
    const int row = (tid & 127) >> 1, tok = dir ? tb + 63 - row : tb + row;
    return *(const u32x4*)((const bf16_t*)(a.ws + WS_U) + (size_t)tok * UP + C_GD + dir * 16 + 8 * (tid & 1));
}
__device__ __forceinline__ void gla_gd_park(LAS unsigned char* lds, int tid, const u32x4 v) { if (tid < 128) *(LAS u32x4*)(lds + GL_GD + tid * 16) = v; }
__device__ __forceinline__ bf16x8 tr_read8(LAS unsigned char* lds, unsigned a0, unsigned a1) {
    const s16x4 r0 = __builtin_amdgcn_ds_read_tr16_b64_v4i16((LAS s16x4*)(lds + a0)), r1 = __builtin_amdgcn_ds_read_tr16_b64_v4i16((LAS s16x4*)(lds + a1));
    return __builtin_shufflevector(r0, r1, 0, 1, 2, 3, 4, 5, 6, 7);
}
template <int CTRL> __device__ __forceinline__ float dpp_f(float x) { return __int_as_float(__builtin_amdgcn_update_dpp(0, __float_as_int(x), CTRL, 0xf, 0xf, true)); }
constexpr int GL_BP = 132;
__device__ __forceinline__ float gla_a1(LAS unsigned char* lds, const GlaPre& cur, const int w, const int n, const int g, const float lin, const int OFFB = GL_B) {
    const bf16x8 wfrag = __builtin_bit_cast(bf16x8, cur.wf); const float wbias = cur.wb;
    float tot = 0.f;
    {
        LAS float* B = (LAS float*)(lds + OFFB);
        bf16x8 vh[2], vl[2];
#pragma unroll
        for (int ks = 0; ks < 2; ++ks) {
            float vv[8];
#pragma unroll
            for (int half = 0; half < 2; ++half) {
                const f32x4 x = MFMA16(*(const LAS bf16x8*)(lds + GL_GD + (16 * (2 * ks + half) + n) * 32 + 16 * (g & 1)), wfrag, ((f32x4){wbias, wbias, wbias, wbias}));
#pragma unroll
                for (int r = 0; r < 4; ++r) vv[4 * half + r] = flog2(1.0f + fexp2(-fmaxf(x[r], -126.f))) * (-1.0f / 16.0f);
            }
            u32x4 hw, lw;
#pragma unroll
            for (int q = 0; q < 4; ++q) { const unsigned hp = pk2(vv[2 * q], vv[2 * q + 1]); hw[q] = hp;
                lw[q] = pk2(vv[2 * q] - __uint_as_float(hp << 16), vv[2 * q + 1] - __uint_as_float(hp & 0xffff0000u)); }
            vh[ks] = __builtin_bit_cast(bf16x8, hw); vl[ks] = __builtin_bit_cast(bf16x8, lw);
        }
        u32x4 ta, tbm;
#pragma unroll
        for (int q = 0; q < 2; ++q) { const unsigned lo = (4 * g + 2 * q <= n) ? 0x3f80u : 0u, hi = (4 * g + 2 * q + 1 <= n) ? 0x3f800000u : 0u; ta[q] = lo | hi; ta[2 + q] = 0u; tbm[q] = 0x3f803f80u; tbm[2 + q] = lo | hi; }
        const bf16x8 TA = __builtin_bit_cast(bf16x8, ta), TB = __builtin_bit_cast(bf16x8, tbm), ONES = __builtin_bit_cast(bf16x8, ((u32x4){0x3f803f80u, 0x3f803f80u, 0x3f803f80u, 0x3f803f80u}));
        const f32x4 z4 = (f32x4){lin, lin, lin, lin};
        f32x4 bt[4];
        bt[0] = MFMA16(TA, vl[0], MFMA16(TA, vh[0], z4));
        bt[1] = MFMA16(TB, vl[0], MFMA16(TB, vh[0], z4));
        const f32x4 s32 = MFMA16(ONES, vl[0], MFMA16(ONES, vh[0], z4));
        bt[2] = MFMA16(TA, vl[1], MFMA16(TA, vh[1], s32));
        bt[3] = MFMA16(TB, vl[1], MFMA16(TB, vh[1], s32));
#pragma unroll
        for (int it = 0; it < 4; ++it)
#pragma unroll
            for (int r = 0; r < 4; ++r) B[(16 * it + 4 * g + r) * GL_BP + 16 * w + n] = bt[it][r];
        {
            const auto u1 = __builtin_amdgcn_permlane32_swap(__float_as_uint(bt[3][3]), __float_as_uint(bt[3][3]), false, false);
            const auto u2 = __builtin_amdgcn_permlane16_swap(u1[1], u1[1], false, false);
            tot = __uint_as_float(u2[1]); }
    }
    return tot;
}
template <int MODE>
__device__ __forceinline__ void gla_chunk(const Args& a, LAS unsigned char* lds, const int tb, const int h, const int dir,
                                          f32x4 (&Sacc)[8], float& ntot, u32x4* stash, GlaPre& pre, const GlaPre& nxt, const int ntb, const int nh, const int ndir, const int n2tb, const int n2dir, const bool first, const int par) {
    const bf16_t* U = (const bf16_t*)(a.ws + WS_U);
    int tid = tid_now(); asm volatile("" : "+v"(tid));
    const int lane = tid & 63, w = __builtin_amdgcn_readfirstlane(tid >> 6), n = lane & 15, g = lane >> 4;
    const unsigned fn = ((n & 3) << 2) | ((n >> 2) & 3);
    const unsigned base_rr = 256u * n + 16u * (g ^ fn);
    const unsigned base_c = 256u * n + 16u * ((g >> 1) ^ fn) + 8u * (g & 1);
    const unsigned base_p = 128u * n + 16u * (g ^ (n & 7));
    const unsigned trb0 = tr16(lane, 0, 0, 0), trb1 = tr16(lane, 0, 0, 1);
    GlaPre& cur = pre;
    int prow[2], pch[2], ptok[2];
#pragma unroll
    for (int i = 0; i < 2; ++i) { const int idx = tid + 512 * i; prow[i] = idx >> 4; pch[i] = idx & 15; ptok[i] = dir ? tb + 63 - prow[i] : tb + prow[i]; }
    u32x4 st0, st1, zraw[2];
    __syncthreads();
    gla_gd_park(lds, tid, pre.gdl);
#pragma unroll
    for (int i = 0; i < 2; ++i) {
        const LAS f32x4* bp = (const LAS f32x4*)(lds + GL_B + (prow[i] * GL_BP + pch[i] * 8) * 4);
        const f32x4 b0 = bp[0], b1 = bp[1];
        float e[8], kf[8];
#pragma unroll
        for (int j = 0; j < 4; ++j) { e[j] = fexp2(b0[j]); e[4 + j] = fexp2(b1[j]); }
        unpack8(cur.k[i], kf);
        u32x4 kw;
#pragma unroll
        for (int j = 0; j < 4; ++j) kw[j] = pk2(kf[2 * j] * __builtin_amdgcn_rcpf(e[2 * j]), kf[2 * j + 1] * __builtin_amdgcn_rcpf(e[2 * j + 1]));
        *(LAS u32x4*)(lds + GL_KT + offb(prow[i], pch[i])) = kw;
        *(LAS u32x4*)(lds + GL_VT + offb(prow[i], pch[i])) = cur.v[i];
        if (MODE != 0) {
            float qf[8]; unpack8(cur.q[i], qf);
            u32x4 qw;
#pragma unroll
            for (int j = 0; j < 4; ++j) qw[j] = pk2(qf[2 * j] * e[2 * j], qf[2 * j + 1] * e[2 * j + 1]);
            *(LAS u32x4*)(lds + GL_QT + offb(prow[i], pch[i])) = qw;
        }
    }
    __syncthreads();
    gla_prefetch<MODE>(a, pre, tid, ntb, nh, ndir, (nh != h || ndir != dir) ? 1 : 0);
    if (w < 2) pre.gdl = gla_gd_load(a, tid, n2tb, n2dir);
    f32x4 Oacc[4];
    __builtin_amdgcn_s_setprio(1);
    if (MODE != 0) {
        const int it = w >> 1;
#pragma unroll
        for (int jj = 0; jj < 2; ++jj) {
            const int jt = 2 * (w & 1) + jj;
            f32x4 pacc = (f32x4){0.f, 0.f, 0.f, 0.f};
            if (jt <= it) {
#pragma unroll
                for (int s = 0; s < 4; ++s) {
                    const bf16x8 qa = *(const LAS bf16x8*)(lds + GL_QT + (base_rr ^ (64u * s)) + 4096u * it);
                    const bf16x8 kb = *(const LAS bf16x8*)(lds + GL_KT + (base_rr ^ (64u * s)) + 4096u * jt); pacc = MFMA16(kb, qa, pacc); }
            }
            const int i = 16 * it + n, j0 = 16 * jt + 4 * g;
            float pv[4];
#pragma unroll
            for (int r = 0; r < 4; ++r) { const bool keep = (MODE == 1) ? (j0 + r <= i) : (j0 + r < i); pv[r] = keep ? pacc[r] : 0.f; }
            u32x2 pw; pw.x = pk2(pv[0], pv[1]); pw.y = pk2(pv[2], pv[3]);
            *(LAS u32x2*)(lds + GL_PT + offp(i, 2 * jt + (g >> 1)) + 8 * (g & 1)) = pw;

        }
        if (first) {
#pragma unroll
            for (int kt = 0; kt < 8; ++kt) { const unsigned r0 = __float_as_uint(Sacc[kt][0]), r1 = __float_as_uint(Sacc[kt][1]);
                Sacc[kt] = (f32x4){__uint_as_float(r0 << 16), __uint_as_float(r0 & 0xffff0000u), __uint_as_float(r1 << 16), __uint_as_float(r1 & 0xffff0000u)}; }
        }
#pragma unroll
        for (int i2 = 0; i2 < 4; ++i2) Oacc[i2] = (f32x4){0.f, 0.f, 0.f, 0.f};
#pragma unroll
        for (int ks = 0; ks < 4; ++ks) {
            u32x4 pw; pw.x = pk2(Sacc[2 * ks][0], Sacc[2 * ks][1]); pw.y = pk2(Sacc[2 * ks][2], Sacc[2 * ks][3]); pw.z = pk2(Sacc[2 * ks + 1][0], Sacc[2 * ks + 1][1]); pw.w = pk2(Sacc[2 * ks + 1][2], Sacc[2 * ks + 1][3]);
            const bf16x8 sb = __builtin_bit_cast(bf16x8, pw);
            const unsigned alo = base_c ^ (64u * ks);
#pragma unroll
            for (int i2 = 0; i2 < 4; ++i2) {
                const u32x2 lo = *(const LAS u32x2*)(lds + GL_QT + 4096 * i2 + alo);
                const u32x2 hi = *(const LAS u32x2*)(lds + GL_QT + 4096 * i2 + (alo ^ 32u));
                u32x4 aw; aw.x = lo.x; aw.y = lo.y; aw.z = hi.x; aw.w = hi.y;
                Oacc[i2] = MFMA16(sb, __builtin_bit_cast(bf16x8, aw), Oacc[i2]);
            }

        }
        __syncthreads();
        if (MODE == 2) {
            st0 = stash[tid * 2]; st1 = stash[tid * 2 + 1];
#pragma unroll
            for (int i = 0; i < 2; ++i) zraw[i] = *(const u32x4*)(U + (size_t)ptok[i] * UP + C_ZA + h * 128 + pch[i] * 8);
        }
    }
    bf16x8 vf[2];
#pragma unroll
    for (int ks = 0; ks < 2; ++ks) vf[ks] = tr_read8(lds, GL_VT + 8192u * ks + (trb0 ^ (32u * w)), GL_VT + 8192u * ks + (trb1 ^ (32u * w)));
    if (MODE != 0) {
#pragma unroll
        for (int i2 = 0; i2 < 4; ++i2)
#pragma unroll
            for (int ks = 0; ks < 2; ++ks) {
                if (ks <= (i2 >> 1)) { const bf16x8 pa = *(const LAS bf16x8*)(lds + GL_PT + 2048 * i2 + (base_p ^ (64u * ks))); Oacc[i2] = MFMA16(vf[ks], pa, Oacc[i2]); }
            }
    }
#pragma unroll
    for (int kt = 0; kt < 8; ++kt) {
#pragma unroll
        for (int ks = 0; ks < 2; ++ks) { const bf16x8 ka = tr_read8(lds, GL_KT + 8192u * ks + (trb0 ^ (32u * kt)), GL_KT + 8192u * ks + (trb1 ^ (32u * kt))); Sacc[kt] = MFMA16(ka, vf[ks], Sacc[kt]); }
        if (kt & 1) __builtin_amdgcn_sched_barrier(0);
    }
    __builtin_amdgcn_s_setprio(0);
    ntot = gla_a1(lds, nxt, w, n, g, (nh != h || ndir != dir) ? 0.f : ntot);
    if (MODE == 1) {
        u32x4 s0, s1;
        s0.x = pk2(Oacc[3][0], Oacc[3][1]); s0.y = pk2(Oacc[3][2], Oacc[3][3]); s0.z = pk2(Oacc[2][0], Oacc[2][1]); s0.w = pk2(Oacc[2][2], Oacc[2][3]);
        s1.x = pk2(Oacc[1][0], Oacc[1][1]); s1.y = pk2(Oacc[1][2], Oacc[1][3]); s1.z = pk2(Oacc[0][0], Oacc[0][1]); s1.w = pk2(Oacc[0][2], Oacc[0][3]);
        const int tidm = tid ^ 15;
        stash[tidm * 2] = s0; stash[tidm * 2 + 1] = s1;
    }
    if (MODE == 2) {
        float fo[16]; { float t8[8]; unpack8(st0, t8);
#pragma unroll
            for (int j = 0; j < 8; ++j) fo[j] = t8[j]; unpack8(st1, t8);
#pragma unroll
            for (int j = 0; j < 8; ++j) fo[8 + j] = t8[j]; }
        LAS float* ssw = (LAS float*)(lds + GL_SSW);
        const f32x4 gn4 = *(const f32x4*)(a.ng + 16 * w + 4 * g);
        const unsigned stoff = GL_QT + 8u * (g & 1);
#pragma unroll
        for (int i2 = 0; i2 < 4; ++i2) {
            float o[4];
#pragma unroll
            for (int r = 0; r < 4; ++r) o[r] = Oacc[i2][r] + fo[4 * i2 + r];
            float v = (o[0] * o[0] + o[1] * o[1]) + (o[2] * o[2] + o[3] * o[3]);
            { const auto x = __builtin_amdgcn_permlane32_swap(__float_as_uint(v), __float_as_uint(v), false, false); v = __uint_as_float(x[0]) + __uint_as_float(x[1]); }
            { const auto x = __builtin_amdgcn_permlane16_swap(__float_as_uint(v), __float_as_uint(v), false, false); v = __uint_as_float(x[0]) + __uint_as_float(x[1]); }
            if (g == 0) ssw[(16 * i2 + n) * 8 + w] = v;
            u32x2 ow; ow.x = pk2(o[0] * gn4[0], o[1] * gn4[1]); ow.y = pk2(o[2] * gn4[2], o[3] * gn4[3]);
            *(LAS u32x2*)(lds + stoff + (16 * i2 + n) * 256 + (((unsigned)(2 * w + (g >> 1)) ^ (unsigned)n) * 16)) = ow;
        }
        __syncthreads();
        bf16_t* ymix = (bf16_t*)((unsigned char*)a.out + 96 * MiB);
#pragma unroll
        for (int i = 0; i < 2; ++i) {
            const f32x4 p0 = *(const LAS f32x4*)(ssw + prow[i] * 8), p1 = *(const LAS f32x4*)(ssw + prow[i] * 8 + 4);
            const float rs = rsqrtf((((p0[0] + p0[1]) + (p0[2] + p0[3])) + ((p1[0] + p1[1]) + (p1[2] + p1[3]))) * (1.0f / 128.0f) + NORM_EPS);
            const u32x4 ov = *(const LAS u32x4*)(lds + GL_QT + prow[i] * 256 + ((pch[i] ^ (prow[i] & 15)) * 16));
            float of[8], zf[8]; unpack8(ov, of); unpack8(zraw[i], zf);
            u32x4 yw;
#pragma unroll
            for (int j = 0; j < 4; ++j) yw[j] = pk2(of[2 * j] * rs * silu(zf[2 * j]), of[2 * j + 1] * rs * silu(zf[2 * j + 1]));
            *(u32x4*)(ymix + (size_t)ptok[i] * DM + h * 128 + pch[i] * 8) = yw;
        }
    }
}
__device__ __forceinline__ void build_gate_tables(const Args& a) {
    for (int e = blockIdx.x * NTHR + tid_now(); e < 8 * 512; e += gridDim.x * NTHR) {
        const int dh = e >> 9, tid = e & 511, dir = dh >> 2, h = dh & 3, lane = tid & 63, w = tid >> 6, n = lane & 15, g = lane >> 4, col = h * 128 + 16 * w + n;
        const float* wup = dir ? a.wub : a.wuf; const float* bias = dir ? a.bbw : a.bfw;
        u32x4 pw;
#pragma unroll
        for (int j = 0; j < 4; ++j) {
            const float v0 = wup[(8 * (g & 1) + 2 * j) * 512 + col] * 1.4426950408889634f, v1 = wup[(8 * (g & 1) + 2 * j + 1) * 512 + col] * 1.4426950408889634f;
            const float h0 = bf2f(f2bf(v0)), h1 = bf2f(f2bf(v1));
            pw[j] = g < 2 ? pk2(v0, v1) : pk2(v0 - h0, v1 - h1);
        }
        ((u32x4*)(a.ws + WS_GATE))[e] = pw;
        if (g == 0) ((float*)(a.ws + WS_GATE + 65536))[dh * 128 + 16 * w + n] = bias[col] * 1.4426950408889634f;
    }
}
constexpr int Q1_KF = 0, Q1_KB = 32768, Q1_V = 65536, Q1_EBL = 98304;
struct Q1Pre { u32x4 gdl, kr[2], wff, wfb; float wbf, wbb; u32x4 v[2]; };
constexpr int Q1_KR = 99328, Q1_GD = 132096, Q1_GDP = 80, Q1_GDB = 64 * Q1_GDP;
__device__ __forceinline__ void q1_params(int st, int nst, int& tb, int& h, int& item) {
    if (st >= nst) st = nst - 1;
    item = blockIdx.x + (st >> 2) * gridDim.x; h = item & 3; tb = (item >> 2) * 256 + (st & 3) * 64;
}
__device__ __forceinline__ void q1_load_gk(const Args& a, Q1Pre& pre, const int tid, const int w, const int st, const int nst) {
    const bf16_t* U = (const bf16_t*)(a.ws + WS_U);
    int tb, h, item; q1_params(st, nst, tb, h, item);
    if (w < 4) pre.gdl = *(const u32x4*)(U + (size_t)(tb + (tid >> 2)) * UP + C_GD + 8 * (tid & 3));
#pragma unroll
    for (int i = 0; i < 2; ++i) { const int idx = tid + 512 * i, row = idx >> 4, ch = idx & 15; pre.kr[i] = *(const u32x4*)(U + (size_t)(tb + row) * UP + C_KA + h * 128 + ch * 8); }
}
__device__ __forceinline__ void q1_park_gk(LAS unsigned char* lds, const Q1Pre& pre, const int tid, const int w, const int buf) {
    if (w < 4) *(LAS u32x4*)(lds + Q1_GD + buf * Q1_GDB + (tid >> 2) * Q1_GDP + 16 * (tid & 3)) = pre.gdl;
#pragma unroll
    for (int i = 0; i < 2; ++i) { const int idx = tid + 512 * i, row = idx >> 4, ch = idx & 15; *(LAS u32x4*)(lds + Q1_KR + buf * 16384 + row * 256 + ((ch ^ (row & 15)) * 16)) = pre.kr[i]; }
}
__device__ __forceinline__ void q1_load_wf(const Args& a, Q1Pre& pre, const int tid, const int h) {
    const int lane = tid & 63, n = lane & 15, w = tid >> 6;
    pre.wff = ((const u32x4*)(a.ws + WS_GATE))[h * 512 + tid]; pre.wfb = ((const u32x4*)(a.ws + WS_GATE))[(4 + h) * 512 + tid];
    pre.wbf = ((const float*)(a.ws + WS_GATE + 65536))[h * 128 + 16 * w + n]; pre.wbb = ((const float*)(a.ws + WS_GATE + 65536))[(4 + h) * 128 + 16 * w + n];
}
__device__ __forceinline__ void q1_prefetch_v(const Args& a, Q1Pre& pre, int tid, int tb, int h) {
    const bf16_t* U = (const bf16_t*)(a.ws + WS_U);
#pragma unroll
    for (int i = 0; i < 2; ++i) { const int idx = tid + 512 * i, row = idx >> 4, ch = idx & 15; pre.v[i] = *(const u32x4*)(U + (size_t)(tb + row) * UP + C_VA + h * 128 + ch * 8); }
}
template <bool EXCL>
__device__ __forceinline__ void q1_gate(const LAS unsigned char* gdp  , const u32x4 wf, const float wbias, const f32x4 init, const int n, const int g, f32x4 (&bt)[4], f32x4& s64) {
    const bf16x8 wfrag = __builtin_bit_cast(bf16x8, wf);
    bf16x8 vh[2], vl[2];
#pragma unroll
    for (int ks = 0; ks < 2; ++ks) {
        float vv[8];
#pragma unroll
        for (int half = 0; half < 2; ++half) {
            const f32x4 x = MFMA16(*(const LAS bf16x8*)(gdp + (16 * (2 * ks + half) + n) * Q1_GDP + 16 * (g & 1)), wfrag, ((f32x4){wbias, wbias, wbias, wbias}));
#pragma unroll
            for (int r = 0; r < 4; ++r) vv[4 * half + r] = flog2(1.0f + fexp2(-fmaxf(x[r], -126.f))) * (-1.0f / 16.0f);
        }
        u32x4 hw, lw;
#pragma unroll
        for (int q = 0; q < 4; ++q) { const unsigned hp = pk2(vv[2 * q], vv[2 * q + 1]); hw[q] = hp;
            lw[q] = pk2(vv[2 * q] - __uint_as_float(hp << 16), vv[2 * q + 1] - __uint_as_float(hp & 0xffff0000u)); }
        vh[ks] = __builtin_bit_cast(bf16x8, hw); vl[ks] = __builtin_bit_cast(bf16x8, lw);
    }
    u32x4 ta, tbm;
#pragma unroll
    for (int q = 0; q < 2; ++q) {
        const bool c0 = EXCL ? (4 * g + 2 * q < n) : (4 * g + 2 * q <= n), c1 = EXCL ? (4 * g + 2 * q + 1 < n) : (4 * g + 2 * q + 1 <= n);
        const unsigned lo = c0 ? 0x3f80u : 0u, hi = c1 ? 0x3f800000u : 0u; ta[q] = lo | hi; ta[2 + q] = 0u; tbm[q] = 0x3f803f80u; tbm[2 + q] = lo | hi; }
    const bf16x8 TA = __builtin_bit_cast(bf16x8, ta), TB = __builtin_bit_cast(bf16x8, tbm), ONES = __builtin_bit_cast(bf16x8, ((u32x4){0x3f803f80u, 0x3f803f80u, 0x3f803f80u, 0x3f803f80u}));
    bt[0] = MFMA16(vl[0], TA, MFMA16(vh[0], TA, init));
    bt[1] = MFMA16(vl[0], TB, MFMA16(vh[0], TB, init));
    const f32x4 s32 = MFMA16(vl[0], ONES, MFMA16(vh[0], ONES, init));
    bt[2] = MFMA16(vl[1], TA, MFMA16(vh[1], TA, s32));
    bt[3] = MFMA16(vl[1], TB, MFMA16(vh[1], TB, s32));
    s64 = MFMA16(vl[1], ONES, MFMA16(vh[1], ONES, s32));
}
__device__ __forceinline__ void q1_stage_a(const Args& a, LAS unsigned char* lds, Q1Pre& pre, f32x4& lamf, f32x4& lamb, const int st, const int nst, const int tid) {
    const int lane = tid & 63, w = tid >> 6, n = lane & 15, g = lane >> 4, set = st & 1;
    int tb, h, item, ntb, nh, nitem; q1_params(st, nst, tb, h, item); q1_params(st + 1, nst, ntb, nh, nitem);
    const f32x4 z4 = (f32x4){0.f, 0.f, 0.f, 0.f};
    if ((st & 3) == 0) { lamf = z4; lamb = z4; }
    f32x4 btf[4], btb[4], s64f, s64b;
    q1_gate<false>(lds + Q1_GD + set * Q1_GDB, pre.wff, pre.wbf, lamf, n, g, btf, s64f);
    q1_gate<true>(lds + Q1_GD + set * Q1_GDB + 32, pre.wfb, pre.wbb, lamb, n, g, btb, s64b);
    lamf = s64f; lamb = s64b;
    if (n == 0) {
        *(LAS f32x4*)(lds + Q1_EBL + set * 512 + (16 * w + 4 * g) * 4) = (f32x4){fexp2(s64f[0]), fexp2(s64f[1]), fexp2(s64f[2]), fexp2(s64f[3])};
        if ((st & 3) == 3) { float* DEC = (float*)(a.ws + WS_DEC) + (size_t)item * 256 + 16 * w + 4 * g; *(f32x4*)DEC = lamf; *(f32x4*)(DEC + 128) = lamb; }
    }
    const unsigned fn = ((n & 3) << 2) | ((n >> 2) & 3), koff = 256u * n + 16u * ((unsigned)(2 * w + (g >> 1)) ^ fn) + 8u * (g & 1);
    const unsigned kroff = Q1_KR + set * 16384 + 256u * n + 16u * ((unsigned)(2 * w + (g >> 1)) ^ (unsigned)n) + 8u * (g & 1);
#pragma unroll
    for (int it = 0; it < 4; ++it) {
        const u32x2 kk = *(const LAS u32x2*)(lds + kroff + 4096 * it);
        const float k0 = __uint_as_float(kk.x << 16), k1 = __uint_as_float(kk.x & 0xffff0000u), k2 = __uint_as_float(kk.y << 16), k3 = __uint_as_float(kk.y & 0xffff0000u);
        u32x2 of, ob;
        of.x = pk2(k0 * fexp2(-btf[it][0]), k1 * fexp2(-btf[it][1])); of.y = pk2(k2 * fexp2(-btf[it][2]), k3 * fexp2(-btf[it][3]));
        ob.x = pk2(k0 * fexp2(btb[it][0]), k1 * fexp2(btb[it][1])); ob.y = pk2(k2 * fexp2(btb[it][2]), k3 * fexp2(btb[it][3]));
        *(LAS u32x2*)(lds + Q1_KF + set * 16384 + 4096 * it + koff) = of;
        *(LAS u32x2*)(lds + Q1_KB + set * 16384 + 4096 * it + koff) = ob;
    }
#pragma unroll
    for (int i = 0; i < 2; ++i) { const int idx = tid + 512 * i; *(LAS u32x4*)(lds + Q1_V + set * 16384 + offb(idx >> 4, idx & 15)) = pre.v[i]; }
    q1_prefetch_v(a, pre, tid, ntb, nh);
}
__device__ __forceinline__ void phase_gla_pass1(const Args& a, LAS unsigned char* lds) {
    const int tid = tid_now(), w = __builtin_amdgcn_readfirstlane(tid >> 6), lane = tid & 63, g = lane >> 4;
    unsigned char* ST = a.ws + WS_ST;
    const int nst = ((NSEG * 4 - (int)blockIdx.x + (int)gridDim.x - 1) / (int)gridDim.x) * 4;
    const unsigned trb0 = tr16(lane, 0, 0, 0), trb1 = tr16(lane, 0, 0, 1);
    Q1Pre pre; f32x4 Sf[8], Sb[8], lamf = (f32x4){0.f, 0.f, 0.f, 0.f}, lamb = lamf;
    if (nst > 0) {
        int tb, h, item; q1_params(0, nst, tb, h, item);
        q1_load_wf(a, pre, tid, h); q1_load_gk(a, pre, tid, w, 0, nst); q1_prefetch_v(a, pre, tid, tb, h);
        q1_park_gk(lds, pre, tid, w, 0);
        q1_load_gk(a, pre, tid, w, 1, nst);
        __syncthreads();
        q1_stage_a(a, lds, pre, lamf, lamb, 0, nst, tid);
        q1_park_gk(lds, pre, tid, w, 1);
        q1_load_gk(a, pre, tid, w, 2, nst);
    }
#pragma unroll 1
    for (int st = 0; st < nst; ++st) {
        const int p = st & 1;
        if ((st & 3) == 0) {
#pragma unroll
            for (int kt = 0; kt < 8; ++kt) { Sf[kt] = (f32x4){0.f, 0.f, 0.f, 0.f}; Sb[kt] = (f32x4){0.f, 0.f, 0.f, 0.f}; }
        }
        __syncthreads();
        q1_park_gk(lds, pre, tid, w, p);
        q1_load_gk(a, pre, tid, w, st + 3, nst);
        if (((st + 1) & 3) == 0 && st + 1 < nst) { int tb, h, item; q1_params(st + 1, nst, tb, h, item); q1_load_wf(a, pre, tid, h); }
        {
            const int ea = w & 1, eb2 = w >> 1;
            bf16x8 vf[2][2];
#pragma unroll
            for (int j = 0; j < 2; ++j)
#pragma unroll
                for (int ks = 0; ks < 2; ++ks) vf[j][ks] = tr_read8(lds, Q1_V + p * 16384 + 8192u * ks + (trb0 ^ (32u * (2 * eb2 + j))), Q1_V + p * 16384 + 8192u * ks + (trb1 ^ (32u * (2 * eb2 + j))));
#pragma unroll
            for (int i = 0; i < 4; ++i) {
                const unsigned kt = 4 * ea + i;
#pragma unroll
                for (int ks = 0; ks < 2; ++ks) {
                    const bf16x8 kf = tr_read8(lds, Q1_KF + p * 16384 + 8192u * ks + (trb0 ^ (32u * kt)), Q1_KF + p * 16384 + 8192u * ks + (trb1 ^ (32u * kt)));
                    const bf16x8 kb = tr_read8(lds, Q1_KB + p * 16384 + 8192u * ks + (trb0 ^ (32u * kt)), Q1_KB + p * 16384 + 8192u * ks + (trb1 ^ (32u * kt)));
#pragma unroll
                    for (int j = 0; j < 2; ++j) { Sf[2 * i + j] = MFMA16(kf, vf[j][ks], Sf[2 * i + j]); Sb[2 * i + j] = MFMA16(kb, vf[j][ks], Sb[2 * i + j]); }
                }
                if ((st & 3) == 3) {
                    const f32x4 eb = *(const LAS f32x4*)(lds + Q1_EBL + p * 512 + (16 * kt + 4 * g) * 4);
                    Sf[2 * i] = Sf[2 * i] * eb; Sf[2 * i + 1] = Sf[2 * i + 1] * eb; }
            }
        }
        if ((st & 3) == 3) {
            const int item = blockIdx.x + (st >> 2) * gridDim.x, ea = w & 1, eb2 = w >> 1;
            u32x2* dst = (u32x2*)(ST + (size_t)item * 65536) + lane;
#pragma unroll
            for (int i = 0; i < 4; ++i)
#pragma unroll
                for (int j = 0; j < 2; ++j) { const int slot = ((2 * eb2 + j) * 8 + 4 * ea + i) * 64;
                    u32x2 v; v.x = pk2(Sf[2 * i + j][0], Sf[2 * i + j][1]); v.y = pk2(Sf[2 * i + j][2], Sf[2 * i + j][3]); dst[slot] = v;
                    u32x2 u; u.x = pk2(Sb[2 * i + j][0], Sb[2 * i + j][1]); u.y = pk2(Sb[2 * i + j][2], Sb[2 * i + j][3]); dst[4096 + slot] = u; }
        }
        if (st + 1 < nst) q1_stage_a(a, lds, pre, lamf, lamb, st + 1, nst, tid);
    }
    __syncthreads();
}
__device__ __forceinline__ void phase_gla_pass2(const Args& a) {
    unsigned char* ST = a.ws + WS_ST; const float* DEC = (const float*)(a.ws + WS_DEC);
    for (int gidx = blockIdx.x * NTHR + tid_fresh(); gidx < 48 * 4096; gidx += gridDim.x * NTHR) {
        const int chain = gidx >> 12, quad = gidx & 4095, dir = chain & 1, h = (chain >> 1) & 3, s = chain >> 3;
        const int nseg = s < 2 ? LP / 256 : LS / 256, seg0 = s < 2 ? s * (LP / 256) : 2 * (LP / 256) + (s - 2) * (LS / 256);
        const int kt = (quad >> 6) & 7, lane = quad & 63, dk0 = 16 * kt + 4 * (lane >> 4);
        f32x4 S = (f32x4){0.f, 0.f, 0.f, 0.f};
        for (int i0 = 0; i0 < nseg; i0 += 8) {
            u32x2 t[8]; f32x4 lm[8];
#pragma unroll
            for (int j = 0; j < 8; ++j) { const int seg = dir ? seg0 + nseg - 1 - (i0 + j) : seg0 + i0 + j; const size_t idx = (size_t)((seg * 4 + h) * 2 + dir);
                t[j] = ((const u32x2*)(ST + idx * 32768))[quad]; lm[j] = *(const f32x4*)(DEC + idx * 128 + dk0); }
#pragma unroll
            for (int j = 0; j < 8; ++j) { const int seg = dir ? seg0 + nseg - 1 - (i0 + j) : seg0 + i0 + j; const size_t idx = (size_t)((seg * 4 + h) * 2 + dir);
                u32x2 o; o.x = pk2(S[0], S[1]); o.y = pk2(S[2], S[3]); ((u32x2*)(ST + idx * 32768))[quad] = o;
                const f32x4 tv = (f32x4){__uint_as_float(t[j].x << 16), __uint_as_float(t[j].x & 0xffff0000u), __uint_as_float(t[j].y << 16), __uint_as_float(t[j].y & 0xffff0000u)};
                S = (f32x4){fexp2(lm[j][0]), fexp2(lm[j][1]), fexp2(lm[j][2]), fexp2(lm[j][3])} * S + tv; }
        }
    }
}
__device__ __forceinline__ void g3_step(int t, int nt, int& tb, int& h, int& dir) {
    if (t >= nt) t = nt - 1;
    const int item = blockIdx.x + (t >> 3) * gridDim.x; h = item & 3; dir = (t >> 2) & 1; tb = (item >> 2) * 256 + (dir ? 3 - (t & 3) : (t & 3)) * 64;
}
__device__ __forceinline__ void phase_gla_pass3(const Args& a, LAS unsigned char* lds) {
    const int tid = tid_now(), w = tid >> 6, lane = tid & 63;
    const int nt = ((NSEG * 4 - (int)blockIdx.x + (int)gridDim.x - 1) / (int)gridDim.x) * 8;
    GlaPre pre; int par = 0, t = 0; float ctot = 0.f;
    if (nt > 0) {
        int tb, h, dir; g3_step(0, nt, tb, h, dir);
        gla_prefetch<1>(a, pre, tid, tb, h, dir, -1);
        gla_gd_park(lds, tid, gla_gd_load(a, tid, tb, dir)); __syncthreads();
        ctot = gla_a1(lds, pre, w, lane & 15, lane >> 4, 0.f);
        g3_step(1, nt, tb, h, dir); if (w < 2) pre.gdl = gla_gd_load(a, tid, tb, dir);
    }
    for (int item = blockIdx.x; item < NSEG * 4; item += gridDim.x) {
        const int h = item & 3, seg = item >> 2;
        u32x4* stash = (u32x4*)a.out + (size_t)item * 4 * 1024;
#pragma unroll 1
        for (int dir = 0; dir < 2; ++dir) {
            f32x4 Sacc[8];
            const int tf = tid_fresh(), lo = (tf >> 6) * 512 + (tf & 63);
            const u32x2* src = (const u32x2*)(a.ws + WS_ST + (size_t)((seg * 4 + h) * 2 + dir) * 32768) + lo;
#pragma unroll
            for (int kt = 0; kt < 8; ++kt) { const u32x2 v = src[kt * 64]; Sacc[kt] = (f32x4){__uint_as_float(v.x), __uint_as_float(v.y), 0.f, 0.f}; }
            for (int cc = 0; cc < 4; ++cc) {
                const int c = dir ? 3 - cc : cc;
                int ntb, nh, ndir, n2tb, n2h, n2dir; g3_step(t + 1, nt, ntb, nh, ndir); g3_step(t + 2, nt, n2tb, n2h, n2dir);
                if (dir == 0) gla_chunk<1>(a, lds, seg * 256 + c * 64, h, 0, Sacc, ctot, stash + c * 1024, pre, pre, ntb, nh, ndir, n2tb, n2dir, cc == 0, par);
                else          gla_chunk<2>(a, lds, seg * 256 + c * 64, h, 1, Sacc, ctot, stash + c * 1024, pre, pre, ntb, nh, ndir, n2tb, n2dir, cc == 0, par);
                par ^= 1; ++t;
            }
        }
    }
    __syncthreads();
}
typedef float f32x16 __attribute__((ext_vector_type(16)));
#define MFMA32(a, b, c) __builtin_amdgcn_mfma_f32_32x32x16_bf16((a), (b), (c), 0, 0, 0)
constexpr int SW_K = 0, SW_V = 65536, SW_TB = 131072, SW_TBN = 336, SW_TBH = 4 * SW_TBN * 4;
constexpr float SW_NEG = -1e30f;
__device__ __forceinline__ unsigned offk(unsigned row, unsigned c8) { return 128u * row + 16u * (c8 ^ ((row >> 1) & 7)); }
__device__ __forceinline__ unsigned offv(unsigned row, unsigned c8) { return 128u * row + 16u * (c8 ^ (((row >> 1) & 1) << 2)); }
__device__ __forceinline__ void swa_load_block(const bf16_t* U, int gb, int kvh, bool valid, int tid, u32x4 (&kk)[2], u32x4 (&vv)[2]) {
#pragma unroll
    for (int i = 0; i < 2; ++i) {
        const int idx = tid + 512 * i, r = idx >> 3, c8 = idx & 7;
        kk[i] = (u32x4){0, 0, 0, 0}; vv[i] = (u32x4){0, 0, 0, 0};
        if (valid) { const bf16_t* ur = U + (size_t)(gb * 128 + r) * UP + kvh * 64 + c8 * 8; kk[i] = __builtin_nontemporal_load((const u32x4*)(ur + C_KB)); vv[i] = __builtin_nontemporal_load((const u32x4*)(ur + C_VB)); }
    }
}
__device__ __forceinline__ void swa_store_block(LAS unsigned char* lds, int gb, int tid, const u32x4 (&kk)[2], const u32x4 (&vv)[2]) {
#pragma unroll
    for (int i = 0; i < 2; ++i) {
        const int idx = tid + 512 * i, r = 128 * (gb & 3) + (idx >> 3), c8 = idx & 7;
        *(LAS u32x4*)(lds + SW_K + offk(r, c8)) = kk[i]; *(LAS u32x4*)(lds + SW_V + offv(r, c8)) = vv[i];
    }
}
__device__ __forceinline__ bool swa_exists(int gb) { return gb >= 0 && gb < NTOK / 128; }
__device__ __forceinline__ void phase_swa(const Args& a, LAS unsigned char* lds) {
    const bf16_t* U = (const bf16_t*)(a.ws + WS_U); bf16_t* ymix = (bf16_t*)((unsigned char*)a.out + 96 * MiB);
    const int tid = tid_now(), lane = tid & 63, w = __builtin_amdgcn_readfirstlane(tid >> 6), r = lane & 31, hh = lane >> 5;
    for (int su = blockIdx.x; su < (NTOK / 128 / 3) * 2; su += gridDim.x) {
        const int kvh = su & 1, qb0 = 3 * (su >> 1);
        __syncthreads();
        for (int e = tid; e < 4 * SW_TBN; e += NTHR) {
            const int hl = e / SW_TBN, idx = e - hl * SW_TBN, rel = idx - 160;
            const float val = (rel >= -128 && rel <= 128) ? a.relb[t5_bucket(rel) * 8 + kvh * 4 + hl] : SW_NEG;
            LAS float* tb = (LAS float*)(lds + SW_TB + hl * SW_TBH);
#pragma unroll
            for (int s = 0; s < 4; ++s) if (idx - s >= 0) tb[s * SW_TBN + idx - s] = val;
        }
#pragma unroll 1
        for (int bb = -1; bb <= 1; ++bb) { u32x4 kk[2], vv[2]; swa_load_block(U, qb0 + bb, kvh, swa_exists(qb0 + bb), tid, kk, vv); swa_store_block(lds, qb0 + bb, tid, kk, vv); }
        __syncthreads();
        const int hl = w >> 1, hq = kvh * 4 + hl;
        const float snk = a.sink[hq];
#pragma unroll 1
        for (int qi = 0; qi < 3; ++qi) {
            const int qb = qb0 + qi, tok0 = qb * 128; int s0, L; seq_of(tok0, s0, L);
            const bool first = tok0 == s0, last = tok0 + 128 == s0 + L;
            u32x4 nk[2], nv[2];
            if (qi < 2) swa_load_block(U, qb + 2, kvh, swa_exists(qb + 2), tid, nk, nv);
            bf16x8 Qn[4];
            { const int qt0 = tok0 + 32 * ((w & 1) * 2) + r;
#pragma unroll
              for (int s = 0; s < 4; ++s) Qn[s] = *(const bf16x8*)(U + (size_t)qt0 * UP + C_QB + hq * 64 + 16 * s + 8 * hh); }
#pragma unroll 1
            for (int ss = 0; ss < 2; ++ss) {
                const int st = (w & 1) * 2 + ss, qtok = tok0 + 32 * st + r;
                bf16x8 Qf[4];
#pragma unroll
                for (int s = 0; s < 4; ++s) Qf[s] = Qn[s];
                { const int qt1 = ss == 0 ? qtok + 32 : qtok;
#pragma unroll
                  for (int s = 0; s < 4; ++s) Qn[s] = *(const bf16x8*)(U + (size_t)qt1 * UP + C_QB + hq * 64 + 16 * s + 8 * hh); }
                u32x4 zz[2][2];
#pragma unroll
                for (int dt = 0; dt < 2; ++dt)
#pragma unroll
                    for (int aa = 0; aa < 2; ++aa) zz[dt][aa] = *(const u32x4*)(U + (size_t)qtok * UP + C_ZB + hq * 64 + 32 * dt + 16 * aa + 8 * hh);
                float m = snk, l = hh == 0 ? 1.0f : 0.0f;
                f32x16 O[2];
#pragma unroll
                for (int i = 0; i < 16; ++i) { O[0][i] = 0.f; O[1][i] = 0.f; }
                const int sft = (-r) & 3;
                const unsigned tbase = SW_TB + hl * SW_TBH + sft * (SW_TBN * 4) + 4 * (32 + 4 * hh - r - sft);
                const unsigned kb0 = SW_K + 128u * r + 16u * (hh ^ ((r >> 1) & 7));
                const int q4 = (lane & 15) >> 2, p4 = lane & 3, g1 = (lane >> 4) & 1, xq = (q4 >> 1) & 1;
                const unsigned vb0 = SW_V + 128u * (4 * hh + q4) + 16u * ((4 * xq) | (2 * g1) | (p4 >> 1)) + 8u * (p4 & 1);
#pragma unroll 1
                for (int grp = 0; grp < 3; ++grp) {
                    f32x16 S[3];
                    __builtin_amdgcn_s_setprio(1);
#pragma unroll
                    for (int k3 = 0; k3 < 3; ++k3) {
                        const int kk = 3 * grp + k3, kt = st + kk, blk = kt >> 2;
                        const bool valid = !((blk == 0 && first) || (blk == 2 && last));
                        const unsigned rowb = 128u * (128u * ((unsigned)(qb - 1 + blk) & 3u) + 32u * (kt & 3));
                        if (valid) {
#pragma unroll
                            for (int i4 = 0; i4 < 4; ++i4) { const f32x4 bv = *(const LAS f32x4*)(lds + tbase + 4 * (32 * kk + 8 * i4));
#pragma unroll
                                for (int j = 0; j < 4; ++j) S[k3][4 * i4 + j] = bv[j]; }
#pragma unroll
                            for (int s = 0; s < 4; ++s) { const bf16x8 Kf = *(const LAS bf16x8*)(lds + (kb0 ^ (32u * s)) + rowb); S[k3] = MFMA32(Kf, Qf[s], S[k3]); }
                        } else {
#pragma unroll
                            for (int i = 0; i < 16; ++i) S[k3][i] = SW_NEG;
                        }
                    }
                    __builtin_amdgcn_s_setprio(0);
                    float mx4[4] = {SW_NEG, SW_NEG, SW_NEG, SW_NEG};
#pragma unroll
                    for (int k3 = 0; k3 < 3; ++k3)
#pragma unroll
                        for (int i = 0; i < 16; ++i) mx4[i & 3] = fmaxf(mx4[i & 3], S[k3][i]);
                    float mx = fmaxf(fmaxf(mx4[0], mx4[1]), fmaxf(mx4[2], mx4[3]));
                    mx = fmaxf(mx, __shfl_xor(mx, 32));
                    if (__builtin_amdgcn_ballot_w64(mx > m + 4.0f) != 0ull) {
                        const float mn = fmaxf(m, mx), alpha = fexp(m - mn);
                        m = mn; l *= alpha;
#pragma unroll
                        for (int i = 0; i < 16; ++i) { O[0][i] *= alpha; O[1][i] *= alpha; }
                    }
                    bf16x8 Pf[3][2];
                    float l4[4] = {0.f, 0.f, 0.f, 0.f};
                    const float mL = m * 1.4426950408889634f;
#pragma unroll
                    for (int k3 = 0; k3 < 3; ++k3) {
#pragma unroll
                        for (int i = 0; i < 16; ++i) { const float pv = fexp2(__builtin_fmaf(S[k3][i], 1.4426950408889634f, -mL)); S[k3][i] = pv; l4[i & 3] += pv; }
#pragma unroll
                        for (int s2 = 0; s2 < 2; ++s2) {
                            u32x4 pw;
#pragma unroll
                            for (int j = 0; j < 4; ++j) pw[j] = pk2(S[k3][8 * s2 + 2 * j], S[k3][8 * s2 + 2 * j + 1]);
                            Pf[k3][s2] = __builtin_bit_cast(bf16x8, pw);
                        }
                    }
                    l += (l4[0] + l4[1]) + (l4[2] + l4[3]);
                    __builtin_amdgcn_s_setprio(1);
#pragma unroll
                    for (int k3 = 0; k3 < 3; ++k3) {
                        const int kt = st + 3 * grp + k3, blk = kt >> 2;
                        const unsigned rowb = 128u * (128u * ((unsigned)(qb - 1 + blk) & 3u) + 32u * (kt & 3));
#pragma unroll
                        for (int s2 = 0; s2 < 2; ++s2)
#pragma unroll
                            for (int dt = 0; dt < 2; ++dt) {
                                const unsigned va = (vb0 ^ (64u * dt)) + rowb + 2048u * s2;
                                const bf16x8 Vf = tr_read8(lds, va, va + 1024u);
                                O[dt] = MFMA32(Vf, Pf[k3][s2], O[dt]);
                            }
                    }
                    __builtin_amdgcn_s_setprio(0);
                }
                l += __shfl_xor(l, 32);
                const float inv = __builtin_amdgcn_rcpf(l);
#pragma unroll
                for (int dt = 0; dt < 2; ++dt)
#pragma unroll
                    for (int aa = 0; aa < 2; ++aa) {
                        const auto s0 = __builtin_amdgcn_permlane32_swap(zz[dt][aa].x, zz[dt][aa].z, false, false), s1 = __builtin_amdgcn_permlane32_swap(zz[dt][aa].y, zz[dt][aa].w, false, false);
                        u32x2 yw[2];
#pragma unroll
                        for (int e = 0; e < 2; ++e) {
                            const unsigned zx = e == 0 ? s0[0] : s0[1], zy = e == 0 ? s1[0] : s1[1]; const int i4 = 2 * aa + e;
                            const float z0 = __uint_as_float(zx << 16), z1 = __uint_as_float(zx & 0xffff0000u), z2 = __uint_as_float(zy << 16), z3 = __uint_as_float(zy & 0xffff0000u);
                            yw[e].x = pk2(O[dt][4 * i4] * inv * silu(z0), O[dt][4 * i4 + 1] * inv * silu(z1)); yw[e].y = pk2(O[dt][4 * i4 + 2] * inv * silu(z2), O[dt][4 * i4 + 3] * inv * silu(z3));
                        }
                        const auto o0 = __builtin_amdgcn_permlane32_swap(yw[0].x, yw[1].x, false, false), o1 = __builtin_amdgcn_permlane32_swap(yw[0].y, yw[1].y, false, false);
                        u32x4 ow; ow.x = o0[0]; ow.y = o1[0]; ow.z = o0[1]; ow.w = o1[1];
                        *(u32x4*)(ymix + (size_t)qtok * DM + 512 + hq * 64 + 32 * dt + 16 * aa + 8 * hh) = ow;
                    }
            }
            if (qi < 2) swa_store_block(lds, qb + 2, tid, nk, nv);
            __syncthreads();
        }
    }
}
__device__ __forceinline__ void phase_convfix(const Args& a) {
    bf16_t* G = (bf16_t*)(a.ws + WS_XB); const float* Pb = (const float*)(a.ws + WS_PB); const float* Sb = (const float*)(a.ws + WS_SB);
    for (int idx = blockIdx.x * NTHR + tid_fresh(); idx < (NTOK / 64 - 1) * 256; idx += gridDim.x * NTHR) {
        const int k = idx / 256 + 1, c = (idx & 255) * 4, row = 64 * k; int s0, L; seq_of(row, s0, L);
        if (row == s0) continue;
        const f32x4 pl = *(const f32x4*)(Pb + (size_t)((k - 1) * 2 + 1) * 1024 + c), sl = *(const f32x4*)(Sb + (size_t)((k - 1) * 2 + 1) * 1024 + c);
        const f32x4 pf = *(const f32x4*)(Pb + (size_t)(k * 2) * 1024 + c), sf = *(const f32x4*)(Sb + (size_t)(k * 2) * 1024 + c);
        const f32x4 c0 = *(const f32x4*)(a.cw + c), c2 = *(const f32x4*)(a.cw + 2048 + c);
        u32x2* gl = (u32x2*)(G + (size_t)(row - 1) * DM + c); u32x2* gf = (u32x2*)(G + (size_t)row * DM + c);
        const u32x2 a0 = *gl, a1 = *gf;
        const f32x4 dl = sl * c2 * pf, df = sf * c0 * pl;
        u32x2 o0, o1;
        o0.x = pk2(__uint_as_float(a0.x << 16) + dl[0], __uint_as_float(a0.x & 0xffff0000u) + dl[1]); o0.y = pk2(__uint_as_float(a0.y << 16) + dl[2], __uint_as_float(a0.y & 0xffff0000u) + dl[3]);
        o1.x = pk2(__uint_as_float(a1.x << 16) + df[0], __uint_as_float(a1.x & 0xffff0000u) + df[1]); o1.y = pk2(__uint_as_float(a1.y << 16) + df[2], __uint_as_float(a1.y & 0xffff0000u) + df[3]);
        *gl = o0; *gf = o1;
    }
}
__global__ void __launch_bounds__(NTHR, 2) mega(Args a) {
    LAS unsigned char* lds = (LAS unsigned char*)lds_raw;
    volatile LAS unsigned* MISC = (volatile LAS unsigned*)(lds + MISC_OFF);
    if (threadIdx.x < 32) MISC[threadIdx.x] = 0u;
    if ((threadIdx.x & 63) == 0) ((volatile LAS unsigned*)(lds + SLOT_OFF))[hw_slot()] = threadIdx.x >> 6;
    __syncthreads();
    unsigned char* ws = a.ws; float* out = a.out;
    XcdBarrier bar = xcd_barrier_post((unsigned*)(ws + WS_CTL) + 4096, MISC + 8);
    bf16_t* W1t = (bf16_t*)(ws + WS_W1T); bf16_t* W2t = (bf16_t*)(ws + WS_W2T); bf16_t* W3t = (bf16_t*)(ws + WS_W3T); bf16_t* W4t = (bf16_t*)(ws + WS_W4T);
    bf16_t* xb = (bf16_t*)(ws + WS_XB); bf16_t* ymix = (bf16_t*)((unsigned char*)out + 96 * MiB); bf16_t* G = xb; bf16_t* U = (bf16_t*)(ws + WS_U);
    bf16_t* x1b = (bf16_t*)(ws + WS_X1B); bf16_t* P = (bf16_t*)(ws + WS_P); bf16_t* Sg = (bf16_t*)(ws + WS_S);
    f32x2* stat1 = (f32x2*)(ws + WS_STAT1); f32x2* stat2 = (f32x2*)(ws + WS_STAT2); f32x2* mr1 = (f32x2*)(ws + WS_MR1);

    phase_convert(a, lds);
    xcd_barrier(bar);
    { pg8::Gemm g{xb, W1t, NTOK, C_GD, DM, 0}; pg8::StaticOrder S; S.init(NTOK, C_GD, gridDim.x, blockIdx.x); EpiU E{U}; pg8::gemm_phase<EpiU, pg8::StaticOrder>(lds, g, S, E); }
    xcd_barrier(bar);
    phase_gla_pass1(a, lds);
    xcd_barrier(bar);
    phase_w3_convert(a, lds);
    phase_gla_pass2(a);
    phase_swa(a, lds);
    xcd_barrier(bar);
    phase_gla_pass3(a, lds);
    xcd_barrier(bar);
    { pg8::Gemm g{ymix, W2t, NTOK, DM, DM, 0}; pg8::StaticOrder S; S.init(NTOK, DM, gridDim.x, blockIdx.x);
      EpiLN<0> E{ws, nullptr, a.lng, a.lnb}; pg8::gemm_phase<EpiLN<0>, pg8::StaticOrder>(lds, g, S, E); }
    xcd_barrier(bar);
    { pg8::Gemm g{x1b, W3t, NTOK, 4096, DM, 0}; pg8::StaticOrder S; S.init(NTOK, 4096, gridDim.x, blockIdx.x); EpiG E{ws, a.cw}; pg8::gemm_phase<EpiG, pg8::StaticOrder>(lds, g, S, E); }
    xcd_barrier(bar);
    phase_convfix(a);
    xcd_barrier(bar);
    { pg8::Gemm g{G, W4t, NTOK, DM, DM, 0}; pg8::StaticOrder S; S.init(NTOK, DM, gridDim.x, blockIdx.x);
      EpiLN<1> E{ws, out, a.lng + DM, a.lnb + DM}; pg8::gemm_phase<EpiLN<1>, pg8::StaticOrder>(lds, g, S, E); }
}

extern "C" void kernel_launch(void* const* d_in, const int* in_sizes, int n_in, void* d_out, int out_size, void* d_ws, size_t ws_size, hipStream_t stream) {
    static int grid = 0;
    if (grid == 0) {
        if (n_in != 16 || out_size != NTOK * DM || ws_size < WS_END) { fprintf(stderr, "kernel_launch: unexpected shapes (n_in %d out %d ws %zu)\n", n_in, out_size, ws_size); grid = -1; return; }
        int dev = 0, cus = 0, per_cu = 0;
        if (hipGetDevice(&dev) != hipSuccess || hipDeviceGetAttribute(&cus, hipDeviceAttributeMultiprocessorCount, dev) != hipSuccess) { grid = -1; return; }
        if (hipFuncSetAttribute((const void*)mega, hipFuncAttributeMaxDynamicSharedMemorySize, LDS_BYTES) != hipSuccess) { fprintf(stderr, "kernel_launch: hipFuncSetAttribute failed\n"); grid = -1; return; }
        if (hipOccupancyMaxActiveBlocksPerMultiprocessor(&per_cu, (const void*)mega, NTHR, LDS_BYTES) != hipSuccess || per_cu < 1) { fprintf(stderr, "kernel_launch: occupancy query says %d blocks per CU\n", per_cu); (void)hipGetLastError(); grid = -1; return; }
        grid = cus;
    }
    if (grid < 0) return;
    (void)hipMemsetAsync((char*)d_ws + WS_CTL, 0, 262144, stream);
    Args a{};
    a.xp = (const float*)d_in[0]; a.xs = (const float*)d_in[1]; a.w_in_even = (const float*)d_in[2]; a.wuf = (const float*)d_in[3]; a.bfw = (const float*)d_in[4];
    a.wub = (const float*)d_in[5]; a.bbw = (const float*)d_in[6]; a.ng = (const float*)d_in[7]; a.sink = (const float*)d_in[8]; a.relb = (const float*)d_in[9];
    a.w_out_even = (const float*)d_in[10]; a.w_in_odd = (const float*)d_in[11]; a.cw = (const float*)d_in[12]; a.w_out_odd = (const float*)d_in[13];
    a.lng = (const float*)d_in[14]; a.lnb = (const float*)d_in[15]; a.out = (float*)d_out; a.ws = (unsigned char*)d_ws;
    hipLaunchKernelGGL(mega, dim3(grid), dim3(NTHR), LDS_BYTES, stream, a);
}
```
